# Optimizing an MI355X kernel written in HIP

```python
import jax, jax.numpy as jnp
from jax import lax
import numpy as np

D_MODEL = 1024
BATCH = 2
SEQ = 8192
DEPTH = 4

N_MIXERS = 2
N_A_LAYERS = (DEPTH + N_MIXERS - 1) // N_MIXERS
N_B_LAYERS = DEPTH // N_MIXERS

HG_HEADS = 8
HG_DK = D_MODEL // HG_HEADS
HG_DV = D_MODEL // HG_HEADS
HG_CHUNK = 128
LRU_WIDTH = D_MODEL
LRU_BLOCKS = 4
LRU_BW = LRU_WIDTH // LRU_BLOCKS
CONV_W = 4
CONV_LEFT = 2
LRU_C = 8.0
PEER_HEADS = 8
PEER_NKEYS = 128
PEER_NEXPERTS = PEER_NKEYS * PEER_NKEYS
PEER_DQ = 256
PEER_TOPK = 16
PEER_BLOCK = 128
EPS = 1e-6

kernel_name = "hybrid_hgrn2_rglru_peer_encoder"


def rms_norm(x, gain):
    xf = x.astype(jnp.float32)
    inv = lax.rsqrt(jnp.mean(xf * xf, axis=-1, keepdims=True) + EPS)
    return (xf * inv).astype(x.dtype) * gain


def hgrn2_chunk_scan(q, k, v, log_f):
    B, S, H, DK = q.shape
    DV = v.shape[-1]
    C = HG_CHUNK
    nc = S // C

    def to_chunks(t):
        return t.reshape(B, nc, C, H, t.shape[-1]).transpose(1, 0, 3, 2, 4)

    qc, kc, vc, gc = to_chunks(q), to_chunks(k), to_chunks(v), to_chunks(log_f)
    lower = jnp.tril(jnp.ones((C, C), dtype=bool))[:, :, None]

    def step(state, inp):
        qi, ki, vi, gi = inp
        b = jnp.cumsum(gi.astype(jnp.float32), axis=-2)
        b_last = b[..., -1:, :]
        rel = b[..., :, None, :] - b[..., None, :, :]
        decay = jnp.exp(jnp.where(lower, rel, -jnp.inf))
        attn = jnp.sum((qi[..., :, None, :] * ki[..., None, :, :]) * decay, axis=-1)
        o_intra = jnp.einsum('bhts,bhsv->bhtv', attn, vi)
        o_inter = jnp.einsum('bhtd,bhdv->bhtv', qi * jnp.exp(b), state)
        k_dec = ki * jnp.exp(b_last - b)
        new_state = state * jnp.exp(b_last[..., 0, :])[..., None] + jnp.einsum('bhsd,bhsv->bhdv', k_dec, vi)
        return new_state, o_intra + o_inter

    state0 = jnp.zeros((B, H, DK, DV), jnp.float32)
    _, o = lax.scan(step, state0, (qc, kc, vc, gc))
    return o.transpose(1, 0, 3, 2, 4).reshape(B, S, H, DV)


def hgrn2_mixer(h, w_in, lb, norm_g, w_out):
    B, S, _ = h.shape
    proj = h @ w_in
    q, f_fw, f_bw, i_in, g = jnp.split(proj, 5, axis=-1)

    def heads(t):
        return t.reshape(B, S, HG_HEADS, -1)

    q, v, g = heads(q), heads(i_in), heads(g)

    def gates(f_logit):
        f = lb + (1.0 - lb) * jax.nn.sigmoid(f_logit.astype(jnp.float32))
        return heads(jnp.log(f)), heads(1.0 - f)

    logf_fw, k_fw = gates(f_fw)
    logf_bw, k_bw = gates(f_bw)
    rev = lambda t: t[:, ::-1]
    o_fw = hgrn2_chunk_scan(q, k_fw, v, logf_fw)
    o_bw = rev(hgrn2_chunk_scan(rev(q), rev(k_bw), rev(v), rev(logf_bw)))
    o = rms_norm(o_fw + o_bw, norm_g.reshape(HG_HEADS, HG_DV)) * jax.nn.silu(g)
    return o.reshape(B, S, D_MODEL) @ w_out


def block_diag_linear(x, w, b):
    B, S, _ = x.shape
    xr = x.reshape(B, S, LRU_BLOCKS, LRU_BW)
    return jnp.einsum('bsnk,nkj->bsnj', xr, w).reshape(B, S, LRU_WIDTH) + b


def lin_combine(left, right):
    a_l, b_l = left
    a_r, b_r = right
    return a_l * a_r, a_r * b_l + b_r


def rglru_mixer(h, w_in, conv_w, conv_b, w_a, b_a, w_x, b_x, lam, w_out):
    B, S, _ = h.shape
    proj = h @ w_in
    xb, yb = jnp.split(proj, 2, axis=-1)
    y_gate = jax.nn.gelu(yb)
    xp = jnp.pad(xb, ((0, 0), (CONV_LEFT, CONV_W - 1 - CONV_LEFT), (0, 0)))
    xc = sum(xp[:, j:j + S] * conv_w[j] for j in range(CONV_W)) + conv_b

    def direction(d, reverse):
        r = jax.nn.sigmoid(block_diag_linear(xc, w_a[d], b_a[d]).astype(jnp.float32))
        ig = jax.nn.sigmoid(block_diag_linear(xc, w_x[d], b_x[d]).astype(jnp.float32))
        log_a = -LRU_C * r * jax.nn.softplus(-lam[d].astype(jnp.float32))
        a = jnp.exp(log_a)
        mult = jnp.sqrt(-jnp.expm1(2.0 * log_a))
        _, hs = lax.associative_scan(lin_combine, (a, mult * ig * xc), axis=1, reverse=reverse)
        return hs

    hsum = direction(0, False) + direction(1, True)
    return (hsum * y_gate) @ w_out


def peer_ffn(h, w_q, sub_keys, u_tab, v_tab):
    B, S, D = h.shape
    q = (h @ w_q).reshape(B, S, PEER_HEADS, 2, PEER_DQ // 2)
    scores = jnp.einsum('bshpd,hpkd->bshpk', q, sub_keys).astype(jnp.float32)
    s1, i1 = lax.top_k(scores[..., 0, :], PEER_TOPK)
    s2, i2 = lax.top_k(scores[..., 1, :], PEER_TOPK)
    cand_s = (s1[..., :, None] + s2[..., None, :]).reshape(B, S, PEER_HEADS, PEER_TOPK * PEER_TOPK)
    cand_id = (i1[..., :, None] * PEER_NKEYS + i2[..., None, :]).reshape(B, S, PEER_HEADS, PEER_TOPK * PEER_TOPK)
    top_s, top_pos = lax.top_k(cand_s, PEER_TOPK)
    ids = jnp.take_along_axis(cand_id, top_pos, axis=-1)
    gate = jax.nn.softmax(top_s, axis=-1)

    nb = (B * S) // PEER_BLOCK
    hb = h.reshape(nb, PEER_BLOCK, D)
    idb = ids.reshape(nb, PEER_BLOCK, PEER_HEADS, PEER_TOPK)
    gb = gate.reshape(nb, PEER_BLOCK, PEER_HEADS, PEER_TOPK)

    def block(args):
        hx, idx, g = args
        u = u_tab[idx]
        act = jax.nn.gelu(jnp.einsum('thkd,td->thk', u, hx).astype(jnp.float32))
        return jnp.einsum('thk,thkd->td', g * act, v_tab[idx])

    out = lax.map(block, (hb, idb, gb))
    return out.reshape(B, S, D)


def setup_inputs(seed: int = 0) -> dict:
    key = jax.random.key(seed)
    ks = iter(jax.random.split(key, 32))
    D = D_MODEL

    def nrm(shape, scale):
        return jax.random.normal(next(ks), shape, jnp.float32) * scale

    x = nrm((BATCH, SEQ, D), 1.0)
    c = nrm((BATCH, D), 1.0)
    w_ada = nrm((DEPTH, D, 6 * D), 0.5 * D ** -0.5)
    b_ada = nrm((DEPTH, 6 * D), 0.02)
    norm_g = 1.0 + nrm((DEPTH, 2, D), 0.02)
    hg_w_in = nrm((N_A_LAYERS, D, 5 * D), D ** -0.5)
    hg_lb = nrm((N_A_LAYERS, D), 1.0)
    hg_norm_g = 1.0 + nrm((N_A_LAYERS, D), 0.02)
    hg_w_out = nrm((N_A_LAYERS, D, D), D ** -0.5)
    lru_w_in = nrm((N_B_LAYERS, D, 2 * LRU_WIDTH), D ** -0.5)
    lru_conv_w = nrm((N_B_LAYERS, CONV_W, LRU_WIDTH), 0.5)
    lru_conv_b = nrm((N_B_LAYERS, LRU_WIDTH), 0.02)
    lru_w_a = nrm((N_B_LAYERS, 2, LRU_BLOCKS, LRU_BW, LRU_BW), LRU_BW ** -0.5)
    lru_b_a = nrm((N_B_LAYERS, 2, LRU_WIDTH), 0.02)
    lru_w_x = nrm((N_B_LAYERS, 2, LRU_BLOCKS, LRU_BW, LRU_BW), LRU_BW ** -0.5)
    lru_b_x = nrm((N_B_LAYERS, 2, LRU_WIDTH), 0.02)
    a_c = jax.random.uniform(next(ks), (N_B_LAYERS, 2, LRU_WIDTH), jnp.float32, 0.9, 0.999)
    a_base = a_c ** (1.0 / LRU_C)
    lru_lam = jnp.log(a_base) - jnp.log1p(-a_base)
    lru_w_out = nrm((N_B_LAYERS, LRU_WIDTH, D), LRU_WIDTH ** -0.5)
    peer_w_q = nrm((DEPTH, D, PEER_HEADS * PEER_DQ), D ** -0.5)
    peer_keys = nrm((DEPTH, PEER_HEADS, 2, PEER_NKEYS, PEER_DQ // 2), (PEER_DQ // 2) ** -0.5)
    peer_u = nrm((DEPTH, PEER_NEXPERTS, D), D ** -0.5)
    peer_v = nrm((DEPTH, PEER_NEXPERTS, D), PEER_HEADS ** -0.5)
    final_g = 1.0 + nrm((D,), 0.02)
    return {"x": x, "c": c, "w_ada": w_ada, "b_ada": b_ada, "norm_g": norm_g,
            "hg_w_in": hg_w_in, "hg_lb": hg_lb, "hg_norm_g": hg_norm_g, "hg_w_out": hg_w_out,
            "lru_w_in": lru_w_in, "lru_conv_w": lru_conv_w, "lru_conv_b": lru_conv_b,
            "lru_w_a": lru_w_a, "lru_b_a": lru_b_a, "lru_w_x": lru_w_x, "lru_b_x": lru_b_x,
            "lru_lam": lru_lam, "lru_w_out": lru_w_out,
            "peer_w_q": peer_w_q, "peer_keys": peer_keys, "peer_u": peer_u, "peer_v": peer_v,
            "final_g": final_g}


def reference(x, c, w_ada, b_ada, norm_g, hg_w_in, hg_lb, hg_norm_g, hg_w_out,
              lru_w_in, lru_conv_w, lru_conv_b, lru_w_a, lru_b_a, lru_w_x, lru_b_x,
              lru_lam, lru_w_out, peer_w_q, peer_keys, peer_u, peer_v, final_g):
    p = jax.nn.softmax(hg_lb.astype(jnp.float32), axis=0)
    lbs = jnp.cumsum(p, axis=0) - p[0]
    cond = jax.nn.silu(c)
    for i in range(DEPTH):
        mod = (cond @ w_ada[i] + b_ada[i])[:, None, :]
        sh1, sc1, g1, sh2, sc2, g2 = jnp.split(mod, 6, axis=-1)
        h = rms_norm(x, norm_g[i, 0]) * (1.0 + sc1) + sh1
        j = i // N_MIXERS
        if i % N_MIXERS == 0:
            y = hgrn2_mixer(h, hg_w_in[j], lbs[j], hg_norm_g[j], hg_w_out[j])
        else:
            y = rglru_mixer(h, lru_w_in[j], lru_conv_w[j], lru_conv_b[j], lru_w_a[j], lru_b_a[j],
                            lru_w_x[j], lru_b_x[j], lru_lam[j], lru_w_out[j])
        x = x + g1 * y
        h = rms_norm(x, norm_g[i, 1]) * (1.0 + sc2) + sh2
        x = x + g2 * peer_ffn(h, peer_w_q[i], peer_keys[i], peer_u[i], peer_v[i])
    return rms_norm(x, final_g)
```

```cpp
#include <hip/hip_runtime.h>
#include <hip/hip_cooperative_groups.h>
#include <cstdio>
#include <cstdint>
namespace cg = cooperative_groups;

#define LAS __attribute__((address_space(3)))
#define PG8_LAS __attribute__((address_space(3)))
typedef unsigned short bf16_t;
typedef short bf16x8 __attribute__((ext_vector_type(8)));
typedef float f32x4 __attribute__((ext_vector_type(4)));
typedef float f32x2 __attribute__((ext_vector_type(2)));
typedef unsigned u32x4 __attribute__((ext_vector_type(4)));
typedef unsigned u32x2 __attribute__((ext_vector_type(2)));

constexpr int T = 16384, D = 1024, SEQ = 8192, DEPTH = 4;
constexpr float EPS = 1e-6f;
constexpr int NBLK = 256, NTHR = 512, NWAVE = 8, NGW = NBLK * NWAVE;

constexpr size_t MiB = 1u << 20;
constexpr size_t WS_CTL = 0;
constexpr size_t WS_MOD = 1 * MiB;
constexpr size_t WS_HGWIN = 2 * MiB;
constexpr size_t WS_HGWOUT = 22 * MiB;
constexpr size_t WS_LRWIN = 26 * MiB;
constexpr size_t WS_LRWG = 34 * MiB;
constexpr size_t WS_LRWOUT = 38 * MiB;
constexpr size_t WS_WQK = 42 * MiB;
constexpr size_t WS_TOPI = 58 * MiB;
constexpr size_t WS_TOPG = 66 * MiB;
constexpr size_t WS_DEC = 74 * MiB;
constexpr size_t WS_CP = 75 * MiB;
constexpr size_t WS_CH = 79 * MiB;
constexpr size_t WS_HIN = 83 * MiB;
constexpr size_t WS_XRES = 88 * MiB;
constexpr size_t WS_HBUF = 152 * MiB;
constexpr size_t WS_OB = 184 * MiB;
constexpr size_t WS_PROJ = 216 * MiB;
constexpr size_t WS_XB = WS_PROJ, WS_YG = WS_PROJ + 32 * MiB, WS_XC = WS_PROJ + 64 * MiB, WS_LOGA = WS_PROJ + 96 * MiB;
constexpr size_t WS_SCORES = WS_PROJ;
constexpr size_t WS_KV = 376 * MiB;
constexpr size_t WS_BTERM = WS_KV;
constexpr size_t WS_SIN = 504 * MiB;
constexpr size_t WS_UTAB = 568 * MiB;
constexpr size_t WS_VTAB = 696 * MiB;
constexpr size_t WS_END = 824 * MiB;

constexpr int LDS_BYTES = 155648;

#define LAUNDER_IDS int tidL = threadIdx.x, bidL = blockIdx.x; asm volatile("" : "+v"(tidL)); asm volatile("" : "+s"(bidL));
__device__ __forceinline__ float bf2f(bf16_t b) { return __uint_as_float(((unsigned)b) << 16); }
__device__ __forceinline__ float bflo(unsigned u) { return __uint_as_float(u << 16); }
__device__ __forceinline__ float bfhi(unsigned u) { return __uint_as_float(u & 0xffff0000u); }
__device__ __forceinline__ unsigned cvt_pk_bf16(float lo, float hi) { unsigned r; asm volatile("v_cvt_pk_bf16_f32 %0, %1, %2" : "=v"(r) : "v"(lo), "v"(hi)); return r; }
__device__ __forceinline__ bf16_t f2bf(float f) { return (bf16_t)(cvt_pk_bf16(f, 0.f) & 0xffffu); }
__device__ __forceinline__ float fast_exp(float x) { return __builtin_amdgcn_exp2f(x * 1.4426950408889634f); }
__device__ __forceinline__ float fast_log(float x) { return __builtin_amdgcn_logf(x) * 0.6931471805599453f; }
__device__ __forceinline__ float fast_rcp(float x) { return __builtin_amdgcn_rcpf(x); }
__device__ __forceinline__ float sigmoidf_(float x) { return fast_rcp(1.f + fast_exp(-x)); }
__device__ __forceinline__ float gelu_tanh(float x) { const float u = 1.5957691216057308f * (x + 0.044715f * x * x * x); return x * fast_rcp(1.f + fast_exp(-u)); }
__device__ __forceinline__ float silu_(float x) { return x * sigmoidf_(x); }
__device__ __forceinline__ float wave_sum(float v) {
#pragma unroll
    for (int o = 1; o < 64; o <<= 1) v += __shfl_xor(v, o);
    return v;
}
__device__ __forceinline__ float wave_max(float v) {
#pragma unroll
    for (int o = 1; o < 64; o <<= 1) v = fmaxf(v, __shfl_xor(v, o));
    return v;
}

namespace pg8 {
constexpr int BM = 256, BK = 64, HALF = 128, HTB = HALF * BK * 2, STAGE_BYTES = 8 * HTB, NXCD = 8, WGM = 8;
__host__ __device__ __forceinline__ int lds_byte(int r, int c) { const int st = (r >> 4) * 2 + (c >> 5), rr = r & 15, cc = c & 31, ob = rr * 64 + cc * 2; return st * 1024 + (ob ^ (((ob >> 9) & 1) << 5)); }
__host__ __device__ __forceinline__ void stage_rc(int b, int& R, int& C) { const int st = b / 1024, sb = b % 1024, swz = sb ^ (((sb >> 9) & 1) << 5); R = (st >> 1) * 16 + swz / 64; C = (st & 1) * 32 + (swz % 64) / 2; }
__host__ __device__ __forceinline__ int perm32(int rho) { const int n = rho >> 4, i = rho & 15; return 8 * (i >> 2) + 4 * n + (i & 3); }
struct Unit { int pm, pn; };
struct Gemm { const bf16_t* A; const bf16_t* Bt; int M, N, K, lda, ldb, a_pn_shift, a_pn_stride; };
struct StaticOrder {
    int nM, nN, nwg, G, c;
    __host__ __device__ void init(int M, int N, int G_, int c_) { nM = M / BM; nN = N / BM; nwg = nM * nN; G = G_; c = c_; }
    __host__ __device__ bool next(int i, Unit& u) const {
        const long L = (long)i * G + c; if (L >= nwg) return false;
        int wgid = (int)L; { const int q = nwg / NXCD, r = nwg % NXCD, xcd = wgid % NXCD, off = wgid / NXCD; wgid = (xcd < r ? xcd * (q + 1) : r * (q + 1) + (xcd - r) * q) + off; }
        const int nig = WGM * nN, gid = wgid / nig, fm = gid * WGM, gsz = (nM - fm) < WGM ? (nM - fm) : WGM;
        u.pm = fm + ((wgid % nig) % gsz); u.pn = (wgid % nig) / gsz; return true;
    }
    __device__ __forceinline__ void a_ready(const Unit&) const {}
    __device__ __forceinline__ void done(const Unit&) const {}
};
template <class Epi, class Sched, bool STAMP = false>
__device__ __forceinline__ void gemm_phase(PG8_LAS unsigned char* lds, const Gemm g, const Sched& S, const Epi& E, unsigned long long* stamps) {
    int tid = threadIdx.x; asm volatile("" : "+v"(tid)); const int wid = __builtin_amdgcn_readfirstlane(tid >> 6), lane = tid & 63, wr = wid >> 2, wc = wid & 3, fr = lane & 15, fq = lane >> 4;
    const int K = g.K, nt = K / BK;
    int ts_lo = 0, ts_hi = 0, nts = 0; const unsigned long long rt_entry = STAMP ? (unsigned long long)wall_clock64() : 0ull;
#define PG8_STAMP() do { if (STAMP && wid == 0 && nts < 64) { const unsigned long long _c = (unsigned long long)clock64(); \
        ts_lo = (lane == nts) ? (int)(unsigned)_c : ts_lo; ts_hi = (lane == nts) ? (int)(unsigned)(_c >> 32) : ts_hi; ++nts; } } while (0)
    PG8_STAMP();
    unsigned voffA[2], voffB[2];
#pragma unroll
    for (int i = 0; i < 2; ++i) { int R, C; stage_rc(tid * 16 + i * 8192, R, C); const int Rb = Epi::PERM ? ((R & ~31) + perm32(R & 31)) : R;
        voffA[i] = (unsigned)(R * g.lda + C) * 2u; voffB[i] = (unsigned)(Rb * g.ldb + C) * 2u; }
    const size_t kstep = (size_t)(BK * 2);
    const size_t hstepA = (size_t)HALF * g.lda * 2, hstepB = (size_t)HALF * g.ldb * 2;
    const size_t tstepA = 2 * hstepA, tstepB = 2 * hstepB;
    const unsigned ldsw = (unsigned)wid * 1024u;
    const int aoff = lds_byte(wr * 64 + fr, fq * 8), boff = lds_byte(wc * 32 + fr, fq * 8);
#define PG8_SA(b, h) (((b) * 2 + (h)) * HTB)
#define PG8_SB(b, h) ((4 + (b) * 2 + (h)) * HTB)
#define PG8_STAGE(bufoff, gbase, voff) do { _Pragma("unroll") for (int _i = 0; _i < 2; ++_i) \
        __builtin_amdgcn_global_load_lds((const unsigned*)((const char*)(gbase) + (voff)[_i]), (PG8_LAS unsigned*)(lds + (bufoff) + ldsw + _i * 8192), 16, 0, 0); } while (0)
#define PG8_LDA(dst, b, h) do { _Pragma("unroll") for (int m = 0; m < 4; ++m) _Pragma("unroll") for (int k = 0; k < 2; ++k) dst[m][k] = *(const PG8_LAS bf16x8*)(lds + PG8_SA(b, h) + aoff + m * 2048 + k * 1024); } while (0)
#define PG8_LDB(dst, b, h) do { _Pragma("unroll") for (int n = 0; n < 2; ++n) _Pragma("unroll") for (int k = 0; k < 2; ++k) dst[n][k] = *(const PG8_LAS bf16x8*)(lds + PG8_SB(b, h) + boff + n * 2048 + k * 1024); } while (0)
#define PG8_MMA(ai, bj, At, Bt) do { __builtin_amdgcn_s_setprio(1); _Pragma("unroll") for (int m = 0; m < 4; ++m) _Pragma("unroll") for (int n = 0; n < 2; ++n) _Pragma("unroll") for (int k = 0; k < 2; ++k) \
        acc[ai][bj][m][n] = __builtin_amdgcn_mfma_f32_16x16x32_bf16(Bt[n][k], At[m][k], acc[ai][bj][m][n], 0, 0, 0); __builtin_amdgcn_s_setprio(0); } while (0)
#define PG8_WAIT_V(n) asm volatile("s_waitcnt vmcnt(" #n ")" ::: "memory")
#define PG8_WAIT_L(n) asm volatile("s_waitcnt lgkmcnt(" #n ")" ::: "memory")
#define PG8_BAR __builtin_amdgcn_s_barrier()
#define PG8_SCHED __builtin_amdgcn_sched_barrier(0)
    Unit cur, nxt; int ui = 0;
    if (!S.next(0, cur)) return;
    f32x4 acc[2][2][4][2];
#pragma unroll
    for (int a = 0; a < 2; ++a)
#pragma unroll
        for (int b = 0; b < 2; ++b)
#pragma unroll
            for (int m = 0; m < 4; ++m)
#pragma unroll
                for (int n = 0; n < 2; ++n) acc[a][b][m][n] = (f32x4){0.f, 0.f, 0.f, 0.f};
    bf16x8 At[4][2], B0[2][2], B1[2][2];
    const char* cA = (const char*)g.A + (size_t)cur.pm * tstepA + (size_t)(cur.pn >> g.a_pn_shift) * g.a_pn_stride; const char* cB = (const char*)g.Bt + (size_t)cur.pn * tstepB;
    S.a_ready(cur);
    PG8_STAGE(PG8_SB(0, 0), cB, voffB); PG8_STAGE(PG8_SA(0, 0), cA, voffA); PG8_STAGE(PG8_SB(0, 1), cB + hstepB, voffB); PG8_STAGE(PG8_SA(0, 1), cA + hstepA, voffA);
    if (wr == 1) PG8_BAR;
    PG8_WAIT_V(4); PG8_BAR;
    PG8_STAGE(PG8_SB(1, 0), cB + kstep, voffB); PG8_STAGE(PG8_SA(1, 0), cA + kstep, voffA); PG8_STAGE(PG8_SB(1, 1), cB + hstepB + kstep, voffB);
    PG8_WAIT_V(6); PG8_BAR;
    PG8_STAMP();
    for (;;) {
        const bool has_next = S.next(ui + 1, nxt);
        const char* nA = has_next ? (const char*)g.A + (size_t)nxt.pm * tstepA + (size_t)(nxt.pn >> g.a_pn_shift) * g.a_pn_stride : cA; const char* nB = has_next ? (const char*)g.Bt + (size_t)nxt.pn * tstepB : cB;
#pragma unroll 1
        for (int t = 0; t < nt; t += 2) {
            const bool last = (t == nt - 2);
            const char* a1 = cA + (size_t)(t + 1) * kstep;
            const char* a2 = last ? nA : cA + (size_t)(t + 2) * kstep; const char* b2 = last ? nB : cB + (size_t)(t + 2) * kstep;
            const char* a3 = a2 + kstep; const char* b3 = b2 + kstep;
            if (last && has_next) S.a_ready(nxt);
            PG8_LDB(B0, 0, 0); PG8_SCHED; PG8_LDA(At, 0, 0); PG8_STAGE(PG8_SA(1, 1), a1 + hstepA, voffA);
            PG8_WAIT_L(8); PG8_BAR; PG8_WAIT_L(0); PG8_MMA(0, 0, At, B0); PG8_BAR; PG8_SCHED;
            PG8_LDB(B1, 0, 1); PG8_STAGE(PG8_SB(0, 0), b2, voffB);
            PG8_BAR; PG8_WAIT_L(0); PG8_MMA(0, 1, At, B1); PG8_BAR;
            PG8_LDA(At, 0, 1); PG8_STAGE(PG8_SA(0, 0), a2, voffA);
            PG8_BAR; PG8_WAIT_L(0); PG8_MMA(1, 0, At, B0); PG8_BAR; PG8_SCHED;
            PG8_STAGE(PG8_SB(0, 1), b2 + hstepB, voffB);
            PG8_WAIT_V(6); PG8_BAR; PG8_MMA(1, 1, At, B1); PG8_BAR;
            PG8_LDB(B0, 1, 0); PG8_SCHED; PG8_LDA(At, 1, 0); PG8_STAGE(PG8_SA(0, 1), a2 + hstepA, voffA);
            PG8_WAIT_L(8); PG8_BAR; PG8_WAIT_L(0); PG8_MMA(0, 0, At, B0); PG8_BAR; PG8_SCHED;
            PG8_LDB(B1, 1, 1); PG8_STAGE(PG8_SB(1, 0), b3, voffB);
            PG8_BAR; PG8_WAIT_L(0); PG8_MMA(0, 1, At, B1); PG8_BAR;
            PG8_LDA(At, 1, 1); PG8_STAGE(PG8_SA(1, 0), a3, voffA);
            PG8_BAR; PG8_WAIT_L(0); PG8_MMA(1, 0, At, B0); PG8_BAR; PG8_SCHED;
            PG8_STAGE(PG8_SB(1, 1), b3 + hstepB, voffB);
            PG8_WAIT_V(6); PG8_BAR; PG8_MMA(1, 1, At, B1); PG8_BAR;
        }
        PG8_STAMP();
        if constexpr (!Epi::AFTER_DRAIN) { E(acc, cur, wr, wc, fr, fq); S.done(cur); }
        PG8_STAMP();
        if (!has_next) break;
#pragma unroll
        for (int a = 0; a < 2; ++a)
#pragma unroll
            for (int b = 0; b < 2; ++b)
#pragma unroll
                for (int m = 0; m < 4; ++m)
#pragma unroll
                    for (int n = 0; n < 2; ++n) acc[a][b][m][n] = (f32x4){0.f, 0.f, 0.f, 0.f};
        cur = nxt; cA = nA; cB = nB; ++ui;
    }
    PG8_WAIT_V(0);
    if (wr == 0) PG8_BAR;
    PG8_BAR;
    if constexpr (Epi::AFTER_DRAIN) { E.fused(acc, cur, wr, wc, fr, fq, lds, wid, lane); S.done(cur); }
    PG8_STAMP();
    if (STAMP && wid == 0) { stamps[lane] = lane < nts ? (((unsigned long long)(unsigned)ts_hi << 32) | (unsigned)ts_lo) : 0ull;
        if (lane == 62) stamps[62] = rt_entry; if (lane == 63) stamps[63] = (unsigned long long)wall_clock64(); }
#undef PG8_STAMP
#undef PG8_SA
#undef PG8_SB
#undef PG8_STAGE
#undef PG8_LDA
#undef PG8_LDB
#undef PG8_MMA
#undef PG8_WAIT_V
#undef PG8_WAIT_L
#undef PG8_BAR
#undef PG8_SCHED
}
}
using pg8::Unit;

struct EpiBf16 {
    static constexpr bool PERM = true, AFTER_DRAIN = false;
    bf16_t* O; int ldc;
    __device__ __forceinline__ void operator()(const f32x4 (&acc)[2][2][4][2], const Unit& u, int wr, int wc, int fr, int fq) const {
        const int row0 = u.pm * 256 + wr * 64 + fr, col0 = u.pn * 256 + wc * 32 + 8 * fq;
#pragma unroll
        for (int ai = 0; ai < 2; ++ai)
#pragma unroll
            for (int m = 0; m < 4; ++m) { bf16_t* rowp = O + (size_t)(row0 + ai * 128 + m * 16) * ldc + col0;
#pragma unroll
                for (int bj = 0; bj < 2; ++bj) { const f32x4 v0 = acc[ai][bj][m][0], v1 = acc[ai][bj][m][1];
                    u32x4 o; o.x = cvt_pk_bf16(v0[0], v0[1]); o.y = cvt_pk_bf16(v0[2], v0[3]); o.z = cvt_pk_bf16(v1[0], v1[1]); o.w = cvt_pk_bf16(v1[2], v1[3]);
                    *(u32x4*)(rowp + bj * 128) = o; } }
    }
};
struct EpiLruIn {
    static constexpr bool PERM = true, AFTER_DRAIN = false;
    bf16_t* XB; bf16_t* YG;
    __device__ __forceinline__ void operator()(const f32x4 (&acc)[2][2][4][2], const Unit& u, int wr, int wc, int fr, int fq) const {
        const bool isy = u.pn >= 4;
        bf16_t* O = isy ? YG : XB;
        const int row0 = u.pm * 256 + wr * 64 + fr, col0 = (u.pn & 3) * 256 + wc * 32 + 8 * fq;
#pragma unroll
        for (int ai = 0; ai < 2; ++ai)
#pragma unroll
            for (int m = 0; m < 4; ++m) { bf16_t* rowp = O + (size_t)(row0 + ai * 128 + m * 16) * 1024 + col0;
#pragma unroll
                for (int bj = 0; bj < 2; ++bj) { f32x4 v0 = acc[ai][bj][m][0], v1 = acc[ai][bj][m][1];
                    if (isy) {
#pragma unroll
                        for (int i = 0; i < 4; ++i) { v0[i] = gelu_tanh(v0[i]); v1[i] = gelu_tanh(v1[i]); } }
                    u32x4 o; o.x = cvt_pk_bf16(v0[0], v0[1]); o.y = cvt_pk_bf16(v0[2], v0[3]); o.z = cvt_pk_bf16(v1[0], v1[1]); o.w = cvt_pk_bf16(v1[2], v1[3]);
                    *(u32x4*)(rowp + bj * 128) = o; } }
    }
};
struct EpiGates {
    static constexpr bool PERM = true, AFTER_DRAIN = false;
    bf16_t* LOGA; bf16_t* BTERM; const bf16_t* XC; const float* b_a; const float* b_x; const float* lam;
    __device__ __forceinline__ void operator()(const f32x4 (&acc)[2][2][4][2], const Unit& u, int wr, int wc, int fr_, int fq) const {
        int fr = fr_; asm volatile("" : "+v"(fr));
        const int nblk = u.pn >> 2, uu = u.pn & 3, d = uu >> 1, jh = uu & 1;
        const int colbase = nblk * 256 + jh * 128 + wc * 32 + 8 * fq;
        const unsigned off0 = (unsigned)(u.pm * 256 + wr * 64 + fr) * 1024u + (unsigned)colbase;
        const bf16_t* xcp = XC; bf16_t* lap = LOGA + (size_t)d * T * 1024; bf16_t* btp = BTERM + (size_t)d * T * 1024;
        const float* bap = b_a + d * 1024; const float* bxp = b_x + d * 1024; const float* lmp = lam + d * 1024;
#pragma unroll
        for (int ai = 0; ai < 2; ++ai)
#pragma unroll
            for (int m = 0; m < 4; ++m) { const unsigned off = off0 + (unsigned)(ai * 128 + m * 16) * 1024u;
                asm volatile("" ::: "memory"); __builtin_amdgcn_sched_barrier(0);
                const u32x4 xr = *(const u32x4*)(xcp + off);
                const float xv[8] = {bflo(xr.x), bfhi(xr.x), bflo(xr.y), bfhi(xr.y), bflo(xr.z), bfhi(xr.z), bflo(xr.w), bfhi(xr.w)};
                unsigned o1[4], o2[4];
#pragma unroll
                for (int n = 0; n < 2; ++n) { const f32x4 ba = *(const f32x4*)(bap + (unsigned)(colbase + 4 * n)), bx = *(const f32x4*)(bxp + (unsigned)(colbase + 4 * n)), lm = *(const f32x4*)(lmp + (unsigned)(colbase + 4 * n));
                    float la[4], bt[4];
#pragma unroll
                    for (int i = 0; i < 4; ++i) { const float r = sigmoidf_(acc[ai][0][m][n][i] + ba[i]), ig = sigmoidf_(acc[ai][1][m][n][i] + bx[i]);
                        const float l = -8.f * fast_log(1.f + fast_exp(-lm[i])) * r; const float mult = __builtin_sqrtf(fmaxf(1.f - fast_exp(2.f * l), 0.f));
                        la[i] = l; bt[i] = mult * ig * xv[n * 4 + i]; }
                    o1[n * 2] = cvt_pk_bf16(la[0], la[1]); o1[n * 2 + 1] = cvt_pk_bf16(la[2], la[3]); o2[n * 2] = cvt_pk_bf16(bt[0], bt[1]); o2[n * 2 + 1] = cvt_pk_bf16(bt[2], bt[3]); }
                *(u32x4*)(lap + off) = (u32x4){o1[0], o1[1], o1[2], o1[3]}; *(u32x4*)(btp + off) = (u32x4){o2[0], o2[1], o2[2], o2[3]}; }
    }
};
struct EpiResid {
    static constexpr bool PERM = false, AFTER_DRAIN = false;
    const float* xin; float* xout; const float* gate;
    __device__ __forceinline__ void operator()(const f32x4 (&acc)[2][2][4][2], const Unit& u, int wr, int wc, int fr, int fq) const {
        const int row0 = u.pm * 256 + wr * 64 + fr, col0 = u.pn * 256 + wc * 32 + 4 * fq;
        const float* gp = gate + ((u.pm * 256) >> 13) * 6144 + col0;
        f32x4 gv[2][2];
#pragma unroll
        for (int bj = 0; bj < 2; ++bj)
#pragma unroll
            for (int n = 0; n < 2; ++n) gv[bj][n] = *(const f32x4*)(gp + bj * 128 + n * 16);
#pragma unroll
        for (int ai = 0; ai < 2; ++ai)
#pragma unroll
            for (int m = 0; m < 4; ++m) { const size_t off = (size_t)(row0 + ai * 128 + m * 16) * 1024 + col0;
#pragma unroll
                for (int bj = 0; bj < 2; ++bj)
#pragma unroll
                    for (int n = 0; n < 2; ++n) { const f32x4 xv = *(const f32x4*)(xin + off + bj * 128 + n * 16);
                        *(f32x4*)(xout + off + bj * 128 + n * 16) = xv + gv[bj][n] * acc[ai][bj][m][n]; } }
    }
};
struct EpiF32 {
    static constexpr bool PERM = false, AFTER_DRAIN = false;
    float* C; int ldc;
    __device__ __forceinline__ void operator()(const f32x4 (&acc)[2][2][4][2], const Unit& u, int wr, int wc, int fr, int fq) const {
        const int row0 = u.pm * 256 + wr * 64 + fr, col0 = u.pn * 256 + wc * 32 + 4 * fq;
#pragma unroll
        for (int ai = 0; ai < 2; ++ai)
#pragma unroll
            for (int m = 0; m < 4; ++m) { float* rowp = C + (size_t)(row0 + ai * 128 + m * 16) * ldc + col0;
#pragma unroll
                for (int bj = 0; bj < 2; ++bj)
#pragma unroll
                    for (int n = 0; n < 2; ++n) *(f32x4*)(rowp + bj * 128 + n * 16) = acc[ai][bj][m][n]; }
    }
};

struct Params {
    const float *x, *c, *w_ada, *b_ada, *norm_g, *hg_w_in, *hg_lb, *hg_norm_g, *hg_w_out, *lru_w_in, *lru_conv_w, *lru_conv_b,
        *lru_w_a, *lru_b_a, *lru_w_x, *lru_b_x, *lru_lam, *lru_w_out, *peer_w_q, *peer_keys, *peer_u, *peer_v, *final_g;
    float* out; unsigned char* ws; int ph_lo, ph_hi;
};

typedef const __attribute__((address_space(4))) Params* KP;

template <class Epi>
__device__ __forceinline__ void run_gemm(LAS unsigned char* lds, const bf16_t* A, const bf16_t* Bt, int N, int K, int lda, int ldb, int a_pn_shift, int a_pn_stride, const Epi& E) {
    pg8::Gemm g; g.A = A; g.Bt = Bt; g.M = T; g.N = N; g.K = K; g.lda = lda; g.ldb = ldb; g.a_pn_shift = a_pn_shift; g.a_pn_stride = a_pn_stride;
    LAUNDER_IDS
    pg8::StaticOrder S; S.init(T, N, (int)gridDim.x, bidL); (void)tidL;
    pg8::gemm_phase<Epi, pg8::StaticOrder, false>(lds, g, S, E, nullptr);
    __syncthreads();
}

__device__ __forceinline__ void transpose_tile(const float* __restrict__ src, int ld_src, bf16_t* dst, int ld_dst, LAS float* tile, int tid) {
#pragma unroll
    for (int it = 0; it < 2; ++it) { const int r = (tid >> 4) + 32 * it, c4 = (tid & 15) * 4;
        const f32x4 v = *(const f32x4*)(src + (size_t)r * ld_src + c4);
        tile[r * 65 + c4 + 0] = v[0]; tile[r * 65 + c4 + 1] = v[1]; tile[r * 65 + c4 + 2] = v[2]; tile[r * 65 + c4 + 3] = v[3]; }
    __syncthreads();
    { const int n = tid >> 3, kc = tid & 7; const LAS float* s = tile + (kc * 8) * 65 + n;
        u32x4 o; o.x = cvt_pk_bf16(s[0], s[65]); o.y = cvt_pk_bf16(s[2 * 65], s[3 * 65]); o.z = cvt_pk_bf16(s[4 * 65], s[5 * 65]); o.w = cvt_pk_bf16(s[6 * 65], s[7 * 65]);
        *(u32x4*)(dst + (size_t)n * ld_dst + kc * 8) = o; }
    __syncthreads();
}

__device__ __forceinline__ void phase0(KP p, LAS unsigned char* lds) {
    LAUNDER_IDS
    const int tid = tidL, wave = tid >> 6, lane = tid & 63;
    unsigned char* ws = p->ws;
    LAS float* tile = (LAS float*)lds;
    constexpr int I_HGIN = 16 * 80, I_SQ = 16 * 16, I_LRIN = 16 * 32, I_G = 16;
    constexpr int N_A = 2 * I_HGIN + 2 * I_SQ + 2 * I_LRIN + 2 * I_SQ + 32 * I_G;
    for (int it = bidL; it < N_A; it += gridDim.x) {
        int r = it;
        if (r < 2 * I_HGIN) { const int j = r / I_HGIN, q = r % I_HGIN, kb = q / 80, nb = q % 80;
            transpose_tile(p->hg_w_in + (size_t)j * 1024 * 5120 + (size_t)kb * 64 * 5120 + nb * 64, 5120, (bf16_t*)(ws + WS_HGWIN) + (size_t)j * 5120 * 1024 + (size_t)nb * 64 * 1024 + kb * 64, 1024, tile, tid); continue; }
        r -= 2 * I_HGIN;
        if (r < 2 * I_SQ) { const int j = r / I_SQ, q = r % I_SQ, kb = q / 16, nb = q % 16;
            transpose_tile(p->hg_w_out + (size_t)j * 1024 * 1024 + (size_t)kb * 64 * 1024 + nb * 64, 1024, (bf16_t*)(ws + WS_HGWOUT) + (size_t)j * 1024 * 1024 + (size_t)nb * 64 * 1024 + kb * 64, 1024, tile, tid); continue; }
        r -= 2 * I_SQ;
        if (r < 2 * I_LRIN) { const int j = r / I_LRIN, q = r % I_LRIN, kb = q / 32, nb = q % 32;
            transpose_tile(p->lru_w_in + (size_t)j * 1024 * 2048 + (size_t)kb * 64 * 2048 + nb * 64, 2048, (bf16_t*)(ws + WS_LRWIN) + (size_t)j * 2048 * 1024 + (size_t)nb * 64 * 1024 + kb * 64, 1024, tile, tid); continue; }
        r -= 2 * I_LRIN;
        if (r < 2 * I_SQ) { const int j = r / I_SQ, q = r % I_SQ, kb = q / 16, nb = q % 16;
            transpose_tile(p->lru_w_out + (size_t)j * 1024 * 1024 + (size_t)kb * 64 * 1024 + nb * 64, 1024, (bf16_t*)(ws + WS_LRWOUT) + (size_t)j * 1024 * 1024 + (size_t)nb * 64 * 1024 + kb * 64, 1024, tile, tid); continue; }
        r -= 2 * I_SQ;
        { const int mat = r / I_G, q = r % I_G, kb = q / 4, nb = q % 4;
            const int nblk = mat & 3, gate = (mat >> 2) & 1, d = (mat >> 3) & 1, l = mat >> 4;
            const float* src = (gate ? p->lru_w_x : p->lru_w_a) + (size_t)((l * 2 + d) * 4 + nblk) * 65536 + (size_t)kb * 64 * 256 + nb * 64;
            const int n0 = nb * 64, jh = n0 >> 7;
            bf16_t* dst = (bf16_t*)(ws + WS_LRWG) + (size_t)l * 4 * 1024 * 256 + (size_t)nblk * 1024 * 256 + (size_t)((d * 2 + jh) * 256 + gate * 128 + (n0 & 127)) * 256 + kb * 64;
            transpose_tile(src, 256, dst, 256, tile, tid); }
    }
    {
        LAS float* keysL = (LAS float*)lds;
        LAS float* wqL = (LAS float*)(lds + 128 * 132 * 4);
        for (int it = bidL; it < 1024; it += gridDim.x) {
            const int l = it >> 8, hp = (it >> 4) & 15, dt = it & 15;
            const float* kp = p->peer_keys + ((size_t)l * 16 + hp) * 16384;
#pragma unroll
            for (int q = 0; q < 8; ++q) { const int e = (tid + 512 * q) * 4; const f32x4 v = *(const f32x4*)(kp + e); *(LAS f32x4*)(keysL + (e >> 7) * 132 + (e & 127)) = v; }
            const float* wp = p->peer_w_q + (size_t)l * 1024 * 2048 + (size_t)(dt * 64) * 2048 + hp * 128;
#pragma unroll
            for (int q = 0; q < 4; ++q) { const int e = (tid + 512 * q) * 4; const f32x4 v = *(const f32x4*)(wp + (size_t)(e >> 7) * 2048 + (e & 127)); *(LAS f32x4*)(wqL + e) = v; }
            __syncthreads();
            const int key = tid & 127, g = tid >> 7;
            float acc[16];
#pragma unroll
            for (int i = 0; i < 16; ++i) acc[i] = 0.f;
            for (int d4 = 0; d4 < 128; d4 += 4) {
                const f32x4 kv = *(const LAS f32x4*)(keysL + key * 132 + d4);
#pragma unroll
                for (int i = 0; i < 16; ++i) { const f32x4 wv = *(const LAS f32x4*)(wqL + (g * 16 + i) * 128 + d4);
                    acc[i] += kv[0] * wv[0] + kv[1] * wv[1] + kv[2] * wv[2] + kv[3] * wv[3]; }
            }
            bf16_t* op = (bf16_t*)(ws + WS_WQK) + (size_t)l * 2048 * 1024 + (size_t)(hp * 128 + key) * 1024 + dt * 64 + g * 16;
            u32x4 o1, o2; o1.x = cvt_pk_bf16(acc[0], acc[1]); o1.y = cvt_pk_bf16(acc[2], acc[3]); o1.z = cvt_pk_bf16(acc[4], acc[5]); o1.w = cvt_pk_bf16(acc[6], acc[7]);
            o2.x = cvt_pk_bf16(acc[8], acc[9]); o2.y = cvt_pk_bf16(acc[10], acc[11]); o2.z = cvt_pk_bf16(acc[12], acc[13]); o2.w = cvt_pk_bf16(acc[14], acc[15]);
            *(u32x4*)op = o1; *(u32x4*)(op + 8) = o2;
            __syncthreads();
        }
    }
    {
        LAS float* condL = (LAS float*)lds;
        LAS float* red = (LAS float*)(lds + 8192);
        for (int i = tid; i < 2048; i += NTHR) condL[i] = silu_(p->c[i]);
        __syncthreads();
        for (int it = bidL; it < 4 * 48; it += gridDim.x) {
            const int l = it / 48, col0 = (it % 48) * 128;
            const float* wp = p->w_ada + (size_t)l * 1024 * 6144 + col0 + 2 * lane;
            float a00 = 0.f, a01 = 0.f, a10 = 0.f, a11 = 0.f;
#pragma unroll 8
            for (int kk = 0; kk < 128; ++kk) { const int k = wave * 128 + kk; const f32x2 w = *(const f32x2*)(wp + (size_t)k * 6144);
                const float c0 = condL[k], c1 = condL[1024 + k];
                a00 += c0 * w[0]; a01 += c0 * w[1]; a10 += c1 * w[0]; a11 += c1 * w[1]; }
            red[(wave * 2 + 0) * 128 + 2 * lane] = a00; red[(wave * 2 + 0) * 128 + 2 * lane + 1] = a01;
            red[(wave * 2 + 1) * 128 + 2 * lane] = a10; red[(wave * 2 + 1) * 128 + 2 * lane + 1] = a11;
            __syncthreads();
            if (tid < 256) { const int b = tid >> 7, cc = tid & 127; float s = 0.f;
#pragma unroll
                for (int w = 0; w < 8; ++w) s += red[(w * 2 + b) * 128 + cc];
                ((float*)(ws + WS_MOD))[((size_t)l * 2 + b) * 6144 + col0 + cc] = s + p->b_ada[(size_t)l * 6144 + col0 + cc]; }
            __syncthreads();
        }
    }
    {
        const size_t n8 = (size_t)4 * 16384 * 1024 / 8;
        const size_t gt = (size_t)bidL * NTHR + tid, gs = (size_t)gridDim.x * NTHR;
        for (int tb = 0; tb < 2; ++tb) {
            const float* src = tb ? p->peer_v : p->peer_u; bf16_t* dst = (bf16_t*)(ws + (tb ? WS_VTAB : WS_UTAB));
            for (size_t i = gt; i < n8; i += gs) { const f32x4 a = __builtin_nontemporal_load((const f32x4*)(src + i * 8)), b = __builtin_nontemporal_load((const f32x4*)(src + i * 8 + 4));
                u32x4 o; o.x = cvt_pk_bf16(a[0], a[1]); o.y = cvt_pk_bf16(a[2], a[3]); o.z = cvt_pk_bf16(b[0], b[1]); o.w = cvt_pk_bf16(b[2], b[3]);
                *(u32x4*)(dst + i * 8) = o; }
        }
    }
}

__device__ __forceinline__ void phase_rms(const float* xin, const float* gain, const float* shift, const float* scale, bf16_t* hout) {
    LAUNDER_IDS
    const int tid = tidL, wave = tid >> 6, lane = tid & 63;
    for (int row = bidL * NWAVE + wave; row < T; row += gridDim.x * NWAVE) {
        const int b = row >> 13;
        const float* xr = xin + (size_t)row * 1024 + lane * 4;
        f32x4 v[4]; float ss = 0.f;
#pragma unroll
        for (int j = 0; j < 4; ++j) { v[j] = *(const f32x4*)(xr + j * 256); ss += v[j][0] * v[j][0] + v[j][1] * v[j][1] + v[j][2] * v[j][2] + v[j][3] * v[j][3]; }
        const float inv = __builtin_amdgcn_rsqf(wave_sum(ss) * (1.f / 1024.f) + EPS);
#pragma unroll
        for (int j = 0; j < 4; ++j) { const int col = j * 256 + lane * 4;
            const f32x4 g = *(const f32x4*)(gain + col), sh = *(const f32x4*)(shift + b * 6144 + col), sc = *(const f32x4*)(scale + b * 6144 + col);
            const f32x4 y = (v[j] * inv) * g * (1.f + sc) + sh;
            u32x2 o; o.x = cvt_pk_bf16(y[0], y[1]); o.y = cvt_pk_bf16(y[2], y[3]);
            *(u32x2*)(hout + (size_t)row * 1024 + col) = o; }
    }
}

constexpr int LROW = 136;
__device__ __forceinline__ float hg_lower_bound(const float* hg_lb, int j, int col) {
    if (j == 0) return 0.f;
    const float l0 = hg_lb[col], l1 = hg_lb[1024 + col];
    return fast_rcp(1.f + fast_exp(l0 - l1));
}
__device__ __forceinline__ f32x4 mfma16(bf16x8 a, bf16x8 b, f32x4 c) { return __builtin_amdgcn_mfma_f32_16x16x32_bf16(a, b, c, 0, 0, 0); }

__device__ __forceinline__ void load_vt(const bf16_t* proj, LAS bf16_t* VT, int t0, int dir, int h, int tid) {
#pragma unroll
    for (int it = 0; it < 4; ++it) { const int idx = tid + 512 * it, tau = idx & 127, cv = idx >> 7;
        const int tok = dir ? t0 + 127 - tau : t0 + tau;
        const u32x4 v = *(const u32x4*)(proj + (size_t)tok * 5120 + 3072 + h * 128 + cv * 8);
        LAS bf16_t* d = VT + (cv * 8) * LROW + tau;
        d[0 * LROW] = (bf16_t)(v.x & 0xffff); d[1 * LROW] = (bf16_t)(v.x >> 16); d[2 * LROW] = (bf16_t)(v.y & 0xffff); d[3 * LROW] = (bf16_t)(v.y >> 16);
        d[4 * LROW] = (bf16_t)(v.z & 0xffff); d[5 * LROW] = (bf16_t)(v.z >> 16); d[6 * LROW] = (bf16_t)(v.w & 0xffff); d[7 * LROW] = (bf16_t)(v.w >> 16); }
}

__device__ __forceinline__ void hg_pass_a(KP p, LAS unsigned char* lds, int j) {
    LAUNDER_IDS
    const bf16_t* proj = (const bf16_t*)(p->ws + WS_PROJ);
    float* KV = (float*)(p->ws + WS_KV); float* DEC = (float*)(p->ws + WS_DEC);
    LAS bf16_t* VT = (LAS bf16_t*)lds; LAS bf16_t* KT = (LAS bf16_t*)(lds + 34816); LAS float* TOT = (LAS float*)(lds + 69632);
    for (int u = bidL; u < 2048; u += gridDim.x) {
        int tid = tidL; asm volatile("" : "+v"(tid));
        const int wave = tid >> 6, lane = tid & 63;
        const int seq = u >> 6, c = u & 63, dir = seq & 1, h = (seq >> 1) & 7, b = seq >> 4;
        const int t0 = b * SEQ + c * 128;
        const int dk = tid & 127, g = tid >> 7;
        const float lb = hg_lower_bound(p->hg_lb, j, h * 128 + dk);
        float lcs[32], kks[32]; float lc = 0.f;
        const bf16_t* zp = proj + 1024 * (1 + dir) + h * 128 + dk;
#pragma unroll
        for (int q = 0; q < 32; ++q) { const int tau = 32 * g + q, tok = dir ? t0 + 127 - tau : t0 + tau;
            const float z = bf2f(zp[(size_t)tok * 5120]);
            const float f = lb + (1.f - lb) * sigmoidf_(z);
            lc += fast_log(f); lcs[q] = lc; kks[q] = 1.f - f; }
        TOT[g * 128 + dk] = lc;
        load_vt(proj, VT, t0, dir, h, tid);
        __syncthreads();
        float rg = 0.f, total = 0.f;
#pragma unroll
        for (int gg = 0; gg < 4; ++gg) { const float tv = TOT[gg * 128 + dk]; total += tv; if (gg < g) rg += tv; }
        const float base = total - rg;
#pragma unroll
        for (int q8 = 0; q8 < 4; ++q8) { unsigned w[4];
#pragma unroll
            for (int e = 0; e < 4; ++e) { const int q = q8 * 8 + e * 2;
                w[e] = cvt_pk_bf16(kks[q] * fast_exp(base - lcs[q]), kks[q + 1] * fast_exp(base - lcs[q + 1])); }
            u32x4 o; o.x = w[0]; o.y = w[1]; o.z = w[2]; o.w = w[3];
            *(LAS u32x4*)(KT + dk * LROW + 32 * g + q8 * 8) = o; }
        if (g == 0) DEC[(size_t)u * 128 + dk] = fast_exp(total);
        __syncthreads();
        f32x4 acc[2][4];
#pragma unroll
        for (int a = 0; a < 2; ++a)
#pragma unroll
            for (int bb = 0; bb < 4; ++bb) acc[a][bb] = (f32x4){0.f, 0.f, 0.f, 0.f};
        const int l15 = lane & 15, lq = lane >> 4;
#pragma unroll
        for (int ks = 0; ks < 4; ++ks) {
            bf16x8 af[2], bfr[4];
#pragma unroll
            for (int a = 0; a < 2; ++a) af[a] = *(const LAS bf16x8*)(VT + (((wave & 3) * 2 + a) * 16 + l15) * LROW + ks * 32 + lq * 8);
#pragma unroll
            for (int bb = 0; bb < 4; ++bb) bfr[bb] = *(const LAS bf16x8*)(KT + (((wave >> 2) * 4 + bb) * 16 + l15) * LROW + ks * 32 + lq * 8);
#pragma unroll
            for (int a = 0; a < 2; ++a)
#pragma unroll
                for (int bb = 0; bb < 4; ++bb) acc[a][bb] = mfma16(af[a], bfr[bb], acc[a][bb]);
        }
        float* kvp = KV + (size_t)u * 16384;
#pragma unroll
        for (int a = 0; a < 2; ++a)
#pragma unroll
            for (int bb = 0; bb < 4; ++bb)
#pragma unroll
                for (int r = 0; r < 4; ++r) kvp[(((wave & 3) * 2 + a) * 16 + lq * 4 + r) * 128 + ((wave >> 2) * 4 + bb) * 16 + l15] = acc[a][bb][r];
        __syncthreads();
    }
}

__device__ __forceinline__ void hg_pass_b(KP p) {
    LAUNDER_IDS
    const float* KV = (const float*)(p->ws + WS_KV); const float* DEC = (const float*)(p->ws + WS_DEC);
    bf16_t* SIN = (bf16_t*)(p->ws + WS_SIN);
    for (int e = bidL * NTHR + tidL; e < 131072; e += gridDim.x * NTHR) {
    const int seq = e >> 12, i4 = e & 4095, dir = seq & 1, dk = (i4 * 4) & 127;
    f32x4 S = {0.f, 0.f, 0.f, 0.f};
#pragma unroll 8
    for (int step = 0; step < 64; ++step) {
        const int c = dir ? 63 - step : step; const size_t u = (size_t)seq * 64 + c;
        const f32x4 kv = *(const f32x4*)(KV + u * 16384 + i4 * 4); const f32x4 dc = *(const f32x4*)(DEC + u * 128 + dk);
        u32x2 o; o.x = cvt_pk_bf16(S[0], S[1]); o.y = cvt_pk_bf16(S[2], S[3]);
        *(u32x2*)(SIN + u * 16384 + i4 * 4) = o;
        S = dc * S + kv;
    }
    }
}

__device__ __forceinline__ void hg_pass_c(KP p, LAS unsigned char* lds, int j) {
    LAUNDER_IDS
    const bf16_t* proj = (const bf16_t*)(p->ws + WS_PROJ);
    const bf16_t* SIN = (const bf16_t*)(p->ws + WS_SIN);
    bf16_t* OB = (bf16_t*)(p->ws + WS_OB);
    LAS bf16_t* QT = (LAS bf16_t*)lds; LAS bf16_t* QI = (LAS bf16_t*)(lds + 34816); LAS bf16_t* KT = (LAS bf16_t*)(lds + 69632);
    LAS bf16_t* VT = (LAS bf16_t*)(lds + 104448); LAS bf16_t* PI = (LAS bf16_t*)(lds + 139264); LAS float* TOT = (LAS float*)(lds + 147968);
    LAS float* OSUM = (LAS float*)(lds + 69632);
    for (int u = bidL; u < 1024; u += gridDim.x) {
        int tid = tidL; asm volatile("" : "+v"(tid));
        const int wave = tid >> 6, lane = tid & 63, l15 = lane & 15, lq = lane >> 4;
        const int c = u & 63, h = (u >> 6) & 7, b = u >> 9;
        const int t0 = b * SEQ + c * 128;
        const int dk = tid & 127, g = tid >> 7;
        const float lb = hg_lower_bound(p->hg_lb, j, h * 128 + dk);
        const int tt = wave & 1, dvt0 = (wave >> 1) * 2;
        f32x4 oacc[2][4][2];
#pragma unroll
        for (int dir = 0; dir < 2; ++dir) {
            const size_t su = ((size_t)((b * 8 + h) * 2 + dir) * 64 + c);
            unsigned k0p[16]; float lc = 0.f; float kprev = 0.f;
            const bf16_t* zp = proj + 1024 * (1 + dir) + h * 128 + dk; const bf16_t* qp = proj + h * 128 + dk;
#pragma unroll
            for (int q = 0; q < 32; ++q) { const int tau = 32 * g + q, tok = dir ? t0 + 127 - tau : t0 + tau;
                const float z = bf2f(zp[(size_t)tok * 5120]), qv = bf2f(qp[(size_t)tok * 5120]);
                const float f = lb + (1.f - lb) * sigmoidf_(z);
                lc += fast_log(f);
                const float el = fast_exp(fmaxf(lc, -80.f));
                QT[tau * LROW + dk] = f2bf(qv * el);
                const float kcur = (1.f - f) * fast_rcp(el);
                if (q & 1) k0p[q >> 1] = cvt_pk_bf16(kprev, kcur); else kprev = kcur; }
            TOT[g * 128 + dk] = lc;
            __syncthreads();
            float r[4]; { float run = 0.f;
#pragma unroll
                for (int gg = 0; gg < 4; ++gg) { r[gg] = run; run += TOT[gg * 128 + dk]; } }
            float rg = 0.f;
#pragma unroll
            for (int gg = 0; gg < 4; ++gg) if (gg == g) rg = r[gg];
            { const float eg = fast_exp(rg);
#pragma unroll
                for (int q = 0; q < 32; ++q) QI[(32 * g + q) * LROW + dk] = f2bf(bf2f(QT[(32 * g + q) * LROW + dk]) * eg); }
            load_vt(proj, VT, t0, dir, h, tid);
            bf16x8 sfr[2][4];
#pragma unroll
            for (int n = 0; n < 2; ++n)
#pragma unroll
                for (int ks = 0; ks < 4; ++ks) sfr[n][ks] = *(const bf16x8*)(SIN + su * 16384 + (size_t)((dvt0 + n) * 16 + l15) * 128 + ks * 32 + lq * 8);
#pragma unroll
            for (int i = 0; i < 4; ++i) {
                if (g <= i) { const float e = fast_exp(r[i] - rg);
#pragma unroll
                    for (int q = 0; q < 32; ++q) KT[(32 * g + q) * LROW + dk] = f2bf(((q & 1) ? bfhi(k0p[q >> 1]) : bflo(k0p[q >> 1])) * e); }
                __syncthreads();
                for (int tl = wave; tl < 4 * (i + 1); tl += 8) { const int sm = tl >> 1, tn = tl & 1;
                    f32x4 a4 = {0.f, 0.f, 0.f, 0.f};
#pragma unroll
                    for (int ks = 0; ks < 4; ++ks) { const bf16x8 af = *(const LAS bf16x8*)(KT + (sm * 16 + l15) * LROW + ks * 32 + lq * 8);
                        const bf16x8 bq = *(const LAS bf16x8*)(QT + (32 * i + tn * 16 + l15) * LROW + ks * 32 + lq * 8);
                        a4 = mfma16(af, bq, a4); }
                    const int tloc = tn * 16 + l15, s0 = sm * 16 + lq * 4, tg = 32 * i + tloc;
                    u32x2 o; o.x = cvt_pk_bf16(s0 + 0 <= tg ? a4[0] : 0.f, s0 + 1 <= tg ? a4[1] : 0.f); o.y = cvt_pk_bf16(s0 + 2 <= tg ? a4[2] : 0.f, s0 + 3 <= tg ? a4[3] : 0.f);
                    *(LAS u32x2*)(PI + tloc * LROW + s0) = o; }
                __syncthreads();
                f32x4 a0 = {0.f, 0.f, 0.f, 0.f}, a1 = {0.f, 0.f, 0.f, 0.f};
                for (int ks = 0; ks <= i; ++ks) { const bf16x8 af = *(const LAS bf16x8*)(PI + (tt * 16 + l15) * LROW + ks * 32 + lq * 8);
                    const bf16x8 b0 = *(const LAS bf16x8*)(VT + ((dvt0 + 0) * 16 + l15) * LROW + ks * 32 + lq * 8);
                    const bf16x8 b1 = *(const LAS bf16x8*)(VT + ((dvt0 + 1) * 16 + l15) * LROW + ks * 32 + lq * 8);
                    a0 = mfma16(af, b0, a0); a1 = mfma16(af, b1, a1); }
#pragma unroll
                for (int ks = 0; ks < 4; ++ks) { const bf16x8 af = *(const LAS bf16x8*)(QI + (32 * i + tt * 16 + l15) * LROW + ks * 32 + lq * 8);
                    a0 = mfma16(af, sfr[0][ks], a0); a1 = mfma16(af, sfr[1][ks], a1); }
                oacc[dir][i][0] = a0; oacc[dir][i][1] = a1;
            }
        }
        __syncthreads();
#pragma unroll
        for (int i = 0; i < 4; ++i)
#pragma unroll
            for (int n = 0; n < 2; ++n)
#pragma unroll
                for (int rr = 0; rr < 4; ++rr) OSUM[(32 * i + tt * 16 + lq * 4 + rr) * 132 + (dvt0 + n) * 16 + l15] = oacc[0][i][n][rr];
        __syncthreads();
#pragma unroll
        for (int i = 0; i < 4; ++i)
#pragma unroll
            for (int n = 0; n < 2; ++n)
#pragma unroll
                for (int rr = 0; rr < 4; ++rr) OSUM[(127 - (32 * i + tt * 16 + lq * 4 + rr)) * 132 + (dvt0 + n) * 16 + l15] += oacc[1][i][n][rr];
        __syncthreads();
        { const int row = tid >> 2, part = tid & 3; const int tok = t0 + row;
            float ov[32]; float ss = 0.f;
#pragma unroll
            for (int q = 0; q < 8; ++q) { const f32x4 v = *(const LAS f32x4*)(OSUM + row * 132 + part * 32 + q * 4);
                ov[q * 4 + 0] = v[0]; ov[q * 4 + 1] = v[1]; ov[q * 4 + 2] = v[2]; ov[q * 4 + 3] = v[3]; ss += v[0] * v[0] + v[1] * v[1] + v[2] * v[2] + v[3] * v[3]; }
            ss += __shfl_xor(ss, 1); ss += __shfl_xor(ss, 2);
            const float inv = __builtin_amdgcn_rsqf(ss * (1.f / 128.f) + EPS);
            const int col = h * 128 + part * 32;
            const bf16_t* gp = proj + (size_t)tok * 5120 + 4096 + col; const float* ng = p->hg_norm_g + j * 1024 + col;
#pragma unroll
            for (int q = 0; q < 4; ++q) { const u32x4 gr = *(const u32x4*)(gp + q * 8);
                const float gv[8] = {bflo(gr.x), bfhi(gr.x), bflo(gr.y), bfhi(gr.y), bflo(gr.z), bfhi(gr.z), bflo(gr.w), bfhi(gr.w)};
                float y[8];
#pragma unroll
                for (int e = 0; e < 8; ++e) y[e] = ov[q * 8 + e] * inv * ng[q * 8 + e] * silu_(gv[e]);
                u32x4 o; o.x = cvt_pk_bf16(y[0], y[1]); o.y = cvt_pk_bf16(y[2], y[3]); o.z = cvt_pk_bf16(y[4], y[5]); o.w = cvt_pk_bf16(y[6], y[7]);
                *(u32x4*)(OB + (size_t)tok * 1024 + col + q * 8) = o; }
        }
        __syncthreads();
    }
}

__device__ __forceinline__ void lru_conv(KP p, int l) {
    LAUNDER_IDS
    const bf16_t* XB = (const bf16_t*)(p->ws + WS_XB); bf16_t* XC = (bf16_t*)(p->ws + WS_XC);
    const float* cw = p->lru_conv_w + (size_t)l * 4 * 1024; const float* cb = p->lru_conv_b + (size_t)l * 1024;
    const int gs = gridDim.x * NTHR;
    for (int it = bidL * NTHR + tidL; it < T * 128; it += gs) {
        const int tok = it >> 7, c8 = (it & 127) * 8, s = tok & (SEQ - 1);
        float acc[8];
        { const f32x4 b0 = *(const f32x4*)(cb + c8), b1 = *(const f32x4*)(cb + c8 + 4);
            acc[0] = b0[0]; acc[1] = b0[1]; acc[2] = b0[2]; acc[3] = b0[3]; acc[4] = b1[0]; acc[5] = b1[1]; acc[6] = b1[2]; acc[7] = b1[3]; }
#pragma unroll
        for (int jj = 0; jj < 4; ++jj) { const int ts = s + jj - 2;
            if (ts >= 0 && ts < SEQ) { const u32x4 xr = *(const u32x4*)(XB + (size_t)(tok + jj - 2) * 1024 + c8);
                const f32x4 w0 = *(const f32x4*)(cw + jj * 1024 + c8), w1 = *(const f32x4*)(cw + jj * 1024 + c8 + 4);
                acc[0] += bflo(xr.x) * w0[0]; acc[1] += bfhi(xr.x) * w0[1]; acc[2] += bflo(xr.y) * w0[2]; acc[3] += bfhi(xr.y) * w0[3];
                acc[4] += bflo(xr.z) * w1[0]; acc[5] += bfhi(xr.z) * w1[1]; acc[6] += bflo(xr.w) * w1[2]; acc[7] += bfhi(xr.w) * w1[3]; } }
        u32x4 o; o.x = cvt_pk_bf16(acc[0], acc[1]); o.y = cvt_pk_bf16(acc[2], acc[3]); o.z = cvt_pk_bf16(acc[4], acc[5]); o.w = cvt_pk_bf16(acc[6], acc[7]);
        *(u32x4*)(XC + (size_t)tok * 1024 + c8) = o;
    }
}
__device__ __forceinline__ void lru_scan1(KP p) {
    LAUNDER_IDS
    const bf16_t* LOGA = (const bf16_t*)(p->ws + WS_LOGA); const bf16_t* BT = (const bf16_t*)(p->ws + WS_BTERM);
    float* CP = (float*)(p->ws + WS_CP); float* CH = (float*)(p->ws + WS_CH);
    const int ch = 2 * tidL;
    for (int u = bidL; u < 1024; u += gridDim.x) {
        const int chunk = u & 255, dir = (u >> 8) & 1, b = u >> 9;
        const size_t base = ((size_t)dir * T + b * SEQ + chunk * 32) * 1024 + ch;
        float h0 = 0.f, h1 = 0.f, s0 = 0.f, s1 = 0.f;
#pragma unroll 8
        for (int q = 0; q < 32; ++q) { const int t = dir ? 31 - q : q;
            const unsigned lw = *(const unsigned*)(LOGA + base + (size_t)t * 1024), bw = *(const unsigned*)(BT + base + (size_t)t * 1024);
            const float l0 = bflo(lw), l1 = bfhi(lw);
            h0 = fast_exp(l0) * h0 + bflo(bw); h1 = fast_exp(l1) * h1 + bfhi(bw); s0 += l0; s1 += l1; }
        const size_t o = ((size_t)(b * 2 + dir) * 256 + chunk) * 1024 + ch;
        *(f32x2*)(CP + o) = (f32x2){fast_exp(s0), fast_exp(s1)}; *(f32x2*)(CH + o) = (f32x2){h0, h1};
    }
}
__device__ __forceinline__ void lru_scan2(KP p) {
    LAUNDER_IDS
    const float* CP = (const float*)(p->ws + WS_CP); const float* CH = (const float*)(p->ws + WS_CH); float* HIN = (float*)(p->ws + WS_HIN);
    const int wave = tidL >> 6, lane = tidL & 63;
    for (int item = bidL * NWAVE + wave; item < 4096; item += gridDim.x * NWAVE) {
        const int ch = item & 1023, bd = item >> 10, dir = bd & 1;
        float pp[4], hh[4]; float Pl = 1.f, Hl = 0.f;
#pragma unroll
        for (int q = 0; q < 4; ++q) { const int ci = 4 * lane + q, chunk = dir ? 255 - ci : ci; const size_t o = ((size_t)bd * 256 + chunk) * 1024 + ch;
            pp[q] = CP[o]; hh[q] = CH[o]; Hl = pp[q] * Hl + hh[q]; Pl *= pp[q]; }
#pragma unroll
        for (int off = 1; off < 64; off <<= 1) { const float Pp = __shfl_up(Pl, off), Hp = __shfl_up(Hl, off);
            if (lane >= off) { Hl = Pl * Hp + Hl; Pl = Pl * Pp; } }
        float carry = __shfl_up(Hl, 1); if (lane == 0) carry = 0.f;
#pragma unroll
        for (int q = 0; q < 4; ++q) { const int ci = 4 * lane + q, chunk = dir ? 255 - ci : ci; const size_t o = ((size_t)bd * 256 + chunk) * 1024 + ch;
            HIN[o] = carry; carry = pp[q] * carry + hh[q]; }
    }
}
__device__ __forceinline__ void lru_scan3(KP p) {
    LAUNDER_IDS
    const bf16_t* LOGA = (const bf16_t*)(p->ws + WS_LOGA); const bf16_t* BT = (const bf16_t*)(p->ws + WS_BTERM); const bf16_t* YG = (const bf16_t*)(p->ws + WS_YG);
    const float* HIN = (const float*)(p->ws + WS_HIN); bf16_t* OB = (bf16_t*)(p->ws + WS_OB);
    const int ch = 2 * tidL;
    for (int u = bidL; u < 512; u += gridDim.x) {
        const int chunk = u & 255, b = u >> 8;
        const size_t tok0 = (size_t)b * SEQ + chunk * 32;
        const f32x2 hf = *(const f32x2*)(HIN + ((size_t)(b * 2 + 0) * 256 + chunk) * 1024 + ch), hb = *(const f32x2*)(HIN + ((size_t)(b * 2 + 1) * 256 + chunk) * 1024 + ch);
        float hs0[32], hs1[32]; float h0 = hf[0], h1 = hf[1];
#pragma unroll
        for (int q = 0; q < 32; ++q) { const size_t o = (tok0 + q) * 1024 + ch;
            const unsigned lw = *(const unsigned*)(LOGA + o), bw = *(const unsigned*)(BT + o);
            h0 = fast_exp(bflo(lw)) * h0 + bflo(bw); h1 = fast_exp(bfhi(lw)) * h1 + bfhi(bw); hs0[q] = h0; hs1[q] = h1; }
        h0 = hb[0]; h1 = hb[1];
#pragma unroll
        for (int q = 31; q >= 0; --q) { const size_t o = (tok0 + q) * 1024 + ch;
            const unsigned lw = *(const unsigned*)(LOGA + (size_t)T * 1024 + o), bw = *(const unsigned*)(BT + (size_t)T * 1024 + o), yw = *(const unsigned*)(YG + o);
            h0 = fast_exp(bflo(lw)) * h0 + bflo(bw); h1 = fast_exp(bfhi(lw)) * h1 + bfhi(bw);
            *(unsigned*)(OB + o) = cvt_pk_bf16((hs0[q] + h0) * bflo(yw), (hs1[q] + h1) * bfhi(yw)); }
    }
}

__device__ const unsigned char STAIR[64] = {
    0x00, 0x01, 0x02, 0x03, 0x04, 0x05, 0x06, 0x07, 0x08, 0x09, 0x0a, 0x0b, 0x0c, 0x0d, 0x0e, 0x0f,
    0x10, 0x11, 0x12, 0x13, 0x14, 0x15, 0x16, 0x17, 0x20, 0x21, 0x22, 0x23, 0x24, 0x30, 0x31, 0x32,
    0x33, 0x40, 0x41, 0x42, 0x50, 0x51, 0x60, 0x61, 0x70, 0x71, 0x80, 0x90, 0xa0, 0xb0, 0xc0, 0xd0,
    0xe0, 0xf0, 0, 0, 0, 0, 0, 0, 0, 0, 0, 0, 0, 0, 0, 0};
__device__ __forceinline__ unsigned mono_key(float f) { const unsigned b = __float_as_uint(f); return b ^ ((b >> 31) ? 0xffffffffu : 0x80000000u); }

__device__ __forceinline__ void peer_topk(KP p, LAS unsigned char* lds) {
    LAUNDER_IDS
    const int tid = tidL, wave = tid >> 6, lane = tid & 63;
    const float* scores = (const float*)(p->ws + WS_SCORES);
    int* TOPI = (int*)(p->ws + WS_TOPI); float* TOPG = (float*)(p->ws + WS_TOPG);
    LAS float* SV = (LAS float*)(lds + wave * 256);
    LAS int* SI = (LAS int*)(lds + wave * 256 + 128);
    const unsigned st = STAIR[lane]; const int si = st >> 4, sj = st & 15;
    for (int item = bidL * NWAVE + wave; item < T * 8; item += gridDim.x * NWAVE) {
        const int tok = item >> 3, hd = item & 7;
        const float* sp = scores + (size_t)tok * 2048 + hd * 256;
#pragma unroll
        for (int half = 0; half < 2; ++half) {
            const float a0 = sp[half * 128 + lane], a1 = sp[half * 128 + 64 + lane];
            const unsigned k0 = (mono_key(a0) & ~0x7fu) | (unsigned)lane, k1 = (mono_key(a1) & ~0x7fu) | (unsigned)(lane + 64);
            unsigned r0 = 0, r1 = 0;
#pragma unroll
            for (int jj = 0; jj < 64; ++jj) { const unsigned x0 = __builtin_amdgcn_readlane(k0, jj), x1 = __builtin_amdgcn_readlane(k1, jj);
                r0 += (x0 > k0) + (x1 > k0); r1 += (x0 > k1) + (x1 > k1); }
            if (r0 < 16) { SV[half * 16 + r0] = a0; SI[half * 16 + r0] = lane; }
            if (r1 < 16) { SV[half * 16 + r1] = a1; SI[half * 16 + r1] = lane + 64; }
        }
        asm volatile("s_waitcnt lgkmcnt(0)" ::: "memory");
        const bool valid = lane < 50;
        const float cs = valid ? SV[si] + SV[16 + sj] : 0.f;
        const int id = SI[si] * 128 + SI[16 + sj];
        const unsigned key = valid ? ((mono_key(cs) & ~0x3fu) | (unsigned)lane) : 0u;
        unsigned r = 0;
#pragma unroll
        for (int jj = 0; jj < 50; ++jj) { const unsigned xk = __builtin_amdgcn_readlane(key, jj); r += (xk > key); }
        const bool sel = valid && r < 16;
        const float m = wave_max(sel ? cs : -3.0e38f);
        const float e = sel ? fast_exp(cs - m) : 0.f;
        const float sum = wave_sum(e);
        if (sel) { TOPI[(size_t)tok * 128 + hd * 16 + r] = id; TOPG[(size_t)tok * 128 + hd * 16 + r] = e * fast_rcp(sum); }
        asm volatile("s_waitcnt lgkmcnt(0)" ::: "memory");
    }
}

__device__ __forceinline__ void peer_gather(KP p, int l) {
    LAUNDER_IDS
    const int wave = tidL >> 6, lane = tidL & 63;
    const bf16_t* HB = (const bf16_t*)(p->ws + WS_HBUF); bf16_t* HBW = (bf16_t*)(p->ws + WS_HBUF);
    const int* TOPI = (const int*)(p->ws + WS_TOPI); const float* TOPG = (const float*)(p->ws + WS_TOPG);
    const bf16_t* UT = (const bf16_t*)(p->ws + WS_UTAB) + (size_t)l * 16384 * 1024; const bf16_t* VTb = (const bf16_t*)(p->ws + WS_VTAB) + (size_t)l * 16384 * 1024;
    float* XRES = (float*)(p->ws + WS_XRES); const float* MOD = (const float*)(p->ws + WS_MOD);
    for (int tok = bidL * NWAVE + wave; tok < T; tok += gridDim.x * NWAVE) {
        const int b = tok >> 13;
        float hv[16];
        { const u32x4 h0 = *(const u32x4*)(HB + (size_t)tok * 1024 + 8 * lane), h1 = *(const u32x4*)(HB + (size_t)tok * 1024 + 512 + 8 * lane);
            hv[0] = bflo(h0.x); hv[1] = bfhi(h0.x); hv[2] = bflo(h0.y); hv[3] = bfhi(h0.y); hv[4] = bflo(h0.z); hv[5] = bfhi(h0.z); hv[6] = bflo(h0.w); hv[7] = bfhi(h0.w);
            hv[8] = bflo(h1.x); hv[9] = bfhi(h1.x); hv[10] = bflo(h1.y); hv[11] = bfhi(h1.y); hv[12] = bflo(h1.z); hv[13] = bfhi(h1.z); hv[14] = bflo(h1.w); hv[15] = bfhi(h1.w); }
        const int id0 = TOPI[(size_t)tok * 128 + lane], id1 = TOPI[(size_t)tok * 128 + 64 + lane];
        const float g0 = TOPG[(size_t)tok * 128 + lane], g1 = TOPG[(size_t)tok * 128 + 64 + lane];
        float acc[16];
#pragma unroll
        for (int i = 0; i < 16; ++i) acc[i] = 0.f;
#pragma unroll 1
        for (int e0 = 0; e0 < 128; e0 += 4) {
            u32x4 uu[4][2], vv[4][2]; float gk[4];
#pragma unroll
            for (int k = 0; k < 4; ++k) { const int e = e0 + k;
                int id = __builtin_amdgcn_readlane(e0 < 64 ? id0 : id1, e & 63);
                id &= 16383;
                gk[k] = __uint_as_float(__builtin_amdgcn_readlane(__float_as_uint(e0 < 64 ? g0 : g1), e & 63));
                const bf16_t* up = UT + (size_t)id * 1024 + 8 * lane; const bf16_t* vp = VTb + (size_t)id * 1024 + 8 * lane;
                uu[k][0] = *(const u32x4*)up; uu[k][1] = *(const u32x4*)(up + 512); vv[k][0] = *(const u32x4*)vp; vv[k][1] = *(const u32x4*)(vp + 512); }
            float dt[4];
#pragma unroll
            for (int k = 0; k < 4; ++k) { float d = 0.f;
#pragma unroll
                for (int hh = 0; hh < 2; ++hh) { const u32x4 w = uu[k][hh];
                    d += bflo(w.x) * hv[hh * 8 + 0] + bfhi(w.x) * hv[hh * 8 + 1] + bflo(w.y) * hv[hh * 8 + 2] + bfhi(w.y) * hv[hh * 8 + 3]
                       + bflo(w.z) * hv[hh * 8 + 4] + bfhi(w.z) * hv[hh * 8 + 5] + bflo(w.w) * hv[hh * 8 + 6] + bfhi(w.w) * hv[hh * 8 + 7]; }
                dt[k] = d; }
#pragma unroll
            for (int o = 1; o < 64; o <<= 1) {
#pragma unroll
                for (int k = 0; k < 4; ++k) dt[k] += __shfl_xor(dt[k], o); }
#pragma unroll
            for (int k = 0; k < 4; ++k) { const float cf = gk[k] * gelu_tanh(dt[k]);
#pragma unroll
                for (int hh = 0; hh < 2; ++hh) { const u32x4 w = vv[k][hh];
                    acc[hh * 8 + 0] += cf * bflo(w.x); acc[hh * 8 + 1] += cf * bfhi(w.x); acc[hh * 8 + 2] += cf * bflo(w.y); acc[hh * 8 + 3] += cf * bfhi(w.y);
                    acc[hh * 8 + 4] += cf * bflo(w.z); acc[hh * 8 + 5] += cf * bfhi(w.z); acc[hh * 8 + 6] += cf * bflo(w.w); acc[hh * 8 + 7] += cf * bfhi(w.w); } }
        }
        const float* g2 = MOD + ((size_t)l * 2 + b) * 6144 + 5 * 1024;
        float xn[16]; float ss = 0.f;
#pragma unroll
        for (int hh = 0; hh < 2; ++hh) { const int col = hh * 512 + 8 * lane;
#pragma unroll
            for (int q = 0; q < 2; ++q) { const f32x4 xr = *(const f32x4*)(XRES + (size_t)tok * 1024 + col + 4 * q), gg = *(const f32x4*)(g2 + col + 4 * q);
#pragma unroll
                for (int i = 0; i < 4; ++i) { const float v = xr[i] + gg[i] * acc[hh * 8 + q * 4 + i]; xn[hh * 8 + q * 4 + i] = v; ss += v * v; } } }
        const float inv = __builtin_amdgcn_rsqf(wave_sum(ss) * (1.f / 1024.f) + EPS);
        if (l < DEPTH - 1) {
            const float* gain = p->norm_g + (size_t)(l + 1) * 2 * 1024; const float* sh = MOD + ((size_t)(l + 1) * 2 + b) * 6144; const float* sc = sh + 1024;
#pragma unroll
            for (int hh = 0; hh < 2; ++hh) { const int col = hh * 512 + 8 * lane; float y[8];
#pragma unroll
                for (int q = 0; q < 2; ++q) { const f32x4 gn = *(const f32x4*)(gain + col + 4 * q), s1 = *(const f32x4*)(sh + col + 4 * q), c1 = *(const f32x4*)(sc + col + 4 * q);
                    *(f32x4*)(XRES + (size_t)tok * 1024 + col + 4 * q) = (f32x4){xn[hh * 8 + q * 4], xn[hh * 8 + q * 4 + 1], xn[hh * 8 + q * 4 + 2], xn[hh * 8 + q * 4 + 3]};
#pragma unroll
                    for (int i = 0; i < 4; ++i) y[q * 4 + i] = (xn[hh * 8 + q * 4 + i] * inv) * gn[i] * (1.f + c1[i]) + s1[i]; }
                u32x4 o; o.x = cvt_pk_bf16(y[0], y[1]); o.y = cvt_pk_bf16(y[2], y[3]); o.z = cvt_pk_bf16(y[4], y[5]); o.w = cvt_pk_bf16(y[6], y[7]);
                *(u32x4*)(HBW + (size_t)tok * 1024 + col) = o; }
        } else {
#pragma unroll
            for (int hh = 0; hh < 2; ++hh) { const int col = hh * 512 + 8 * lane;
#pragma unroll
                for (int q = 0; q < 2; ++q) { const f32x4 gn = *(const f32x4*)(p->final_g + col + 4 * q); f32x4 o;
#pragma unroll
                    for (int i = 0; i < 4; ++i) o[i] = (xn[hh * 8 + q * 4 + i] * inv) * gn[i];
                    *(f32x4*)(p->out + (size_t)tok * 1024 + col + 4 * q) = o; } }
        }
    }
}

#ifndef OPMASK
#define OPMASK 0xFFFFFFFFu
#endif
#define EN(o) ((OPMASK >> (o)) & 1u)
enum { OP_P0 = 0, OP_RMS1, OP_HG_IN, OP_HG_A, OP_HG_B, OP_HG_C, OP_MIX_OUT, OP_LR_IN, OP_LR_CONV, OP_LR_G, OP_LR_S1, OP_LR_S2, OP_LR_S3, OP_RMS2, OP_QK, OP_TOPK, OP_GATHER };
constexpr int NPH = 42;
__device__ __forceinline__ void decode_phase(int ph, int& l, int& op) {
    if (ph == 0) { l = 0; op = OP_P0; return; }
    if (ph == 1) { l = 0; op = OP_RMS1; return; }
    int q = ph - 2;
    if (q < 9) { l = 0; } else if (q < 20) { l = 1; q -= 9; } else if (q < 29) { l = 2; q -= 20; } else { l = 3; q -= 29; }
    if ((l & 1) == 0) { op = q == 0 ? OP_HG_IN : q == 1 ? OP_HG_A : q == 2 ? OP_HG_B : q == 3 ? OP_HG_C : q == 4 ? OP_MIX_OUT : q == 5 ? OP_RMS2 : q == 6 ? OP_QK : q == 7 ? OP_TOPK : OP_GATHER; }
    else { op = q == 0 ? OP_LR_IN : q == 1 ? OP_LR_CONV : q == 2 ? OP_LR_G : q == 3 ? OP_LR_S1 : q == 4 ? OP_LR_S2 : q == 5 ? OP_LR_S3 : q == 6 ? OP_MIX_OUT : q == 7 ? OP_RMS2 : q == 8 ? OP_QK : q == 9 ? OP_TOPK : OP_GATHER; }
}

__global__ __launch_bounds__(512, 2) void mk_fwd(Params p_arg) {
    extern __shared__ __attribute__((aligned(16))) unsigned char shm[];
    LAS unsigned char* lds = (LAS unsigned char*)shm;
    cg::grid_group grid = cg::this_grid();
    unsigned long long kpv = (unsigned long long)__builtin_amdgcn_kernarg_segment_ptr();
    const int ph_lo = p_arg.ph_lo, ph_hi = p_arg.ph_hi;
    for (int ph = ph_lo; ph < ph_hi; ++ph) {
        if (ph > ph_lo) grid.sync();
        asm volatile("" : "+s"(kpv));
        KP p = (KP)kpv;
        unsigned char* ws = p->ws;
        const float* MOD = (const float*)(ws + WS_MOD);
        int l, op; decode_phase(ph, l, op);
        const int j = l >> 1;
#ifdef ONLY
        switch (ONLY) {
#else
        switch (op) {
#endif
        case OP_P0: if (EN(OP_P0)) phase0(p, lds); break;
        case OP_RMS1: if (EN(OP_RMS1)) phase_rms(p->x, p->norm_g, MOD, MOD + 1024, (bf16_t*)(ws + WS_HBUF)); break;
        case OP_HG_IN: if (EN(OP_HG_IN)) { EpiBf16 E; E.O = (bf16_t*)(ws + WS_PROJ); E.ldc = 5120;
            run_gemm(lds, (const bf16_t*)(ws + WS_HBUF), (const bf16_t*)(ws + WS_HGWIN) + (size_t)j * 5120 * 1024, 5120, 1024, 1024, 1024, 0, 0, E); } break;
        case OP_HG_A: if (EN(OP_HG_A)) hg_pass_a(p, lds, j); break;
        case OP_HG_B: if (EN(OP_HG_B)) hg_pass_b(p); break;
        case OP_HG_C: if (EN(OP_HG_C)) hg_pass_c(p, lds, j); break;
        case OP_MIX_OUT: if (EN(OP_MIX_OUT)) { EpiResid E; E.xin = (l == 0) ? p->x : (const float*)(ws + WS_XRES); E.xout = (float*)(ws + WS_XRES); E.gate = MOD + (size_t)l * 2 * 6144 + 2 * 1024;
            const bf16_t* W = (l & 1) ? (const bf16_t*)(ws + WS_LRWOUT) + (size_t)j * 1024 * 1024 : (const bf16_t*)(ws + WS_HGWOUT) + (size_t)j * 1024 * 1024;
            run_gemm(lds, (const bf16_t*)(ws + WS_OB), W, 1024, 1024, 1024, 1024, 0, 0, E); } break;
        case OP_LR_IN: if (EN(OP_LR_IN)) { EpiLruIn E; E.XB = (bf16_t*)(ws + WS_XB); E.YG = (bf16_t*)(ws + WS_YG);
            run_gemm(lds, (const bf16_t*)(ws + WS_HBUF), (const bf16_t*)(ws + WS_LRWIN) + (size_t)j * 2048 * 1024, 2048, 1024, 1024, 1024, 0, 0, E); } break;
        case OP_LR_CONV: if (EN(OP_LR_CONV)) lru_conv(p, j); break;
        case OP_LR_G: if (EN(OP_LR_G)) { EpiGates E; E.LOGA = (bf16_t*)(ws + WS_LOGA); E.BTERM = (bf16_t*)(ws + WS_BTERM); E.XC = (const bf16_t*)(ws + WS_XC);
            E.b_a = p->lru_b_a + (size_t)j * 2048; E.b_x = p->lru_b_x + (size_t)j * 2048; E.lam = p->lru_lam + (size_t)j * 2048;
            run_gemm(lds, (const bf16_t*)(ws + WS_XC), (const bf16_t*)(ws + WS_LRWG) + (size_t)j * 4 * 1024 * 256, 4096, 256, 1024, 256, 2, 512, E); } break;
        case OP_LR_S1: if (EN(OP_LR_S1)) lru_scan1(p); break;
        case OP_LR_S2: if (EN(OP_LR_S2)) lru_scan2(p); break;
        case OP_LR_S3: if (EN(OP_LR_S3)) lru_scan3(p); break;
        case OP_RMS2: if (EN(OP_RMS2)) phase_rms((const float*)(ws + WS_XRES), p->norm_g + ((size_t)l * 2 + 1) * 1024, MOD + (size_t)l * 2 * 6144 + 3 * 1024, MOD + (size_t)l * 2 * 6144 + 4 * 1024, (bf16_t*)(ws + WS_HBUF)); break;
        case OP_QK: if (EN(OP_QK)) { EpiF32 E; E.C = (float*)(ws + WS_SCORES); E.ldc = 2048;
            run_gemm(lds, (const bf16_t*)(ws + WS_HBUF), (const bf16_t*)(ws + WS_WQK) + (size_t)l * 2048 * 1024, 2048, 1024, 1024, 1024, 0, 0, E); } break;
        case OP_TOPK: if (EN(OP_TOPK)) peer_topk(p, lds); break;
        case OP_GATHER: if (EN(OP_GATHER)) peer_gather(p, l); break;
        default: break;
        }
    }
}

extern "C" void kernel_launch(void* const* d_in, const int* in_sizes, int n_in, void* d_out, int out_size, void* d_ws, size_t ws_size, hipStream_t stream) {
    static int grid = 0;
    if (grid == 0) {
        if (n_in != 23 || ws_size < WS_END) { fprintf(stderr, "kernel_launch: unexpected n_in %d / ws_size %zu (need %zu)\n", n_in, ws_size, (size_t)WS_END); grid = -1; return; }
        int dev = 0, cus = 0, per_cu = 0;
        hipGetDevice(&dev); hipDeviceGetAttribute(&cus, hipDeviceAttributeMultiprocessorCount, dev);
        if (hipFuncSetAttribute((const void*)mk_fwd, hipFuncAttributeMaxDynamicSharedMemorySize, LDS_BYTES) != hipSuccess) { fprintf(stderr, "kernel_launch: hipFuncSetAttribute failed\n"); grid = -1; return; }
        if (hipOccupancyMaxActiveBlocksPerMultiprocessor(&per_cu, (const void*)mk_fwd, NTHR, LDS_BYTES) != hipSuccess || per_cu < 1) { fprintf(stderr, "kernel_launch: occupancy query failed (%d)\n", per_cu); (void)hipGetLastError(); per_cu = 1; }
        grid = cus * 1;
        fprintf(stderr, "kernel_launch: cus %d per_cu %d grid %d\n", cus, per_cu, grid);
    }
    if (grid < 0) return;
    Params p{};
    const float** pp = (const float**)&p;
    for (int i = 0; i < 23; ++i) pp[i] = (const float*)d_in[i];
    p.out = (float*)d_out; p.ws = (unsigned char*)d_ws; p.ph_lo = 0; p.ph_hi = NPH;
    void* args[] = {&p};
    hipError_t e = hipLaunchCooperativeKernel((const void*)mk_fwd, dim3(grid), dim3(NTHR), args, LDS_BYTES, stream);
    if (e != hipSuccess) fprintf(stderr, "kernel_launch: cooperative launch failed: %s (grid %d)\n", hipGetErrorString(e), grid);
}
```

```cpp
#include <hip/hip_runtime.h>
#include <hip/hip_cooperative_groups.h>
#include <cstdio>
#include <cstdint>
namespace cg = cooperative_groups;

#define LAS __attribute__((address_space(3)))
#define PG8_LAS __attribute__((address_space(3)))
typedef unsigned short bf16_t;
typedef short bf16x8 __attribute__((ext_vector_type(8)));
typedef float f32x4 __attribute__((ext_vector_type(4)));
typedef float f32x2 __attribute__((ext_vector_type(2)));
typedef unsigned u32x4 __attribute__((ext_vector_type(4)));
typedef unsigned u32x2 __attribute__((ext_vector_type(2)));

constexpr int T = 16384, D = 1024, SEQ = 8192, DEPTH = 4;
constexpr float EPS = 1e-6f;
constexpr int NBLK = 256, NTHR = 512, NWAVE = 8, NGW = NBLK * NWAVE;

constexpr size_t MiB = 1u << 20;
constexpr size_t WS_CTL = 0;
constexpr size_t WS_MOD = 1 * MiB;
constexpr size_t WS_HGWIN = 2 * MiB;
constexpr size_t WS_HGWOUT = 22 * MiB;
constexpr size_t WS_LRWIN = 26 * MiB;
constexpr size_t WS_LRWG = 34 * MiB;
constexpr size_t WS_LRWOUT = 38 * MiB;
constexpr size_t WS_WQK = 42 * MiB;
constexpr size_t WS_TOPI = 58 * MiB;
constexpr size_t WS_TOPG = 66 * MiB;
constexpr size_t WS_DEC = 74 * MiB;
constexpr size_t WS_CP = 75 * MiB;
constexpr size_t WS_CH = 79 * MiB;
constexpr size_t WS_HIN = 83 * MiB;
constexpr size_t WS_XRES = 88 * MiB;
constexpr size_t WS_HBUF = 152 * MiB;
constexpr size_t WS_OB = 184 * MiB;
constexpr size_t WS_PROJ = 216 * MiB;
constexpr size_t WS_XB = WS_PROJ, WS_YG = WS_PROJ + 32 * MiB, WS_XC = WS_PROJ + 64 * MiB, WS_LOGA = WS_PROJ + 96 * MiB;
constexpr size_t WS_SCORES = WS_PROJ;
constexpr size_t WS_KV = 376 * MiB;
constexpr size_t WS_BTERM = WS_KV;
constexpr size_t WS_SIN = 504 * MiB;
constexpr size_t WS_UTAB = 568 * MiB;
constexpr size_t WS_VTAB = 696 * MiB;
constexpr size_t WS_END = 824 * MiB;

constexpr int LDS_BYTES = 155648;

#define LAUNDER_IDS int tidL = threadIdx.x, bidL = blockIdx.x; asm volatile("" : "+v"(tidL)); asm volatile("" : "+s"(bidL));
__device__ __forceinline__ float bf2f(bf16_t b) { return __uint_as_float(((unsigned)b) << 16); }
__device__ __forceinline__ float bflo(unsigned u) { return __uint_as_float(u << 16); }
__device__ __forceinline__ float bfhi(unsigned u) { return __uint_as_float(u & 0xffff0000u); }
__device__ __forceinline__ unsigned cvt_pk_bf16(float lo, float hi) { unsigned r; asm volatile("v_cvt_pk_bf16_f32 %0, %1, %2" : "=v"(r) : "v"(lo), "v"(hi)); return r; }
__device__ __forceinline__ bf16_t f2bf(float f) { return (bf16_t)(cvt_pk_bf16(f, 0.f) & 0xffffu); }
__device__ __forceinline__ float fast_exp(float x) { return __builtin_amdgcn_exp2f(x * 1.4426950408889634f); }
__device__ __forceinline__ float fast_log(float x) { return __builtin_amdgcn_logf(x) * 0.6931471805599453f; }
__device__ __forceinline__ float fast_rcp(float x) { return __builtin_amdgcn_rcpf(x); }
__device__ __forceinline__ float sigmoidf_(float x) { return fast_rcp(1.f + fast_exp(-x)); }
__device__ __forceinline__ float gelu_tanh(float x) { const float u = 1.5957691216057308f * (x + 0.044715f * x * x * x); return x * fast_rcp(1.f + fast_exp(-u)); }
__device__ __forceinline__ float silu_(float x) { return x * sigmoidf_(x); }
__device__ __forceinline__ float wave_sum(float v) {
#pragma unroll
    for (int o = 1; o < 64; o <<= 1) v += __shfl_xor(v, o);
    return v;
}
__device__ __forceinline__ float wave_max(float v) {
#pragma unroll
    for (int o = 1; o < 64; o <<= 1) v = fmaxf(v, __shfl_xor(v, o));
    return v;
}

namespace pg8 {
constexpr int BM = 256, BK = 64, HALF = 128, HTB = HALF * BK * 2, STAGE_BYTES = 8 * HTB, NXCD = 8, WGM = 8;
__host__ __device__ __forceinline__ int lds_byte(int r, int c) { const int st = (r >> 4) * 2 + (c >> 5), rr = r & 15, cc = c & 31, ob = rr * 64 + cc * 2; return st * 1024 + (ob ^ (((ob >> 9) & 1) << 5)); }
__host__ __device__ __forceinline__ void stage_rc(int b, int& R, int& C) { const int st = b / 1024, sb = b % 1024, swz = sb ^ (((sb >> 9) & 1) << 5); R = (st >> 1) * 16 + swz / 64; C = (st & 1) * 32 + (swz % 64) / 2; }
__host__ __device__ __forceinline__ int perm32(int rho) { const int n = rho >> 4, i = rho & 15; return 8 * (i >> 2) + 4 * n + (i & 3); }
struct Unit { int pm, pn; };
struct Gemm { const bf16_t* A; const bf16_t* Bt; int M, N, K, lda, ldb, a_pn_shift, a_pn_stride; };
struct StaticOrder {
    int nM, nN, nwg, G, c;
    __host__ __device__ void init(int M, int N, int G_, int c_) { nM = M / BM; nN = N / BM; nwg = nM * nN; G = G_; c = c_; }
    __host__ __device__ bool next(int i, Unit& u) const {
        const long L = (long)i * G + c; if (L >= nwg) return false;
        int wgid = (int)L; { const int q = nwg / NXCD, r = nwg % NXCD, xcd = wgid % NXCD, off = wgid / NXCD; wgid = (xcd < r ? xcd * (q + 1) : r * (q + 1) + (xcd - r) * q) + off; }
        const int nig = WGM * nN, gid = wgid / nig, fm = gid * WGM, gsz = (nM - fm) < WGM ? (nM - fm) : WGM;
        u.pm = fm + ((wgid % nig) % gsz); u.pn = (wgid % nig) / gsz; return true;
    }
    __device__ __forceinline__ void a_ready(const Unit&) const {}
    __device__ __forceinline__ void done(const Unit&) const {}
};
template <class Epi, class Sched, bool STAMP = false>
__device__ __forceinline__ void gemm_phase(PG8_LAS unsigned char* lds, const Gemm g, const Sched& S, const Epi& E, unsigned long long* stamps) {
    int tid = threadIdx.x; asm volatile("" : "+v"(tid)); const int wid = __builtin_amdgcn_readfirstlane(tid >> 6), lane = tid & 63, wr = wid >> 2, wc = wid & 3, fr = lane & 15, fq = lane >> 4;
    const int K = g.K, nt = K / BK;
    int ts_lo = 0, ts_hi = 0, nts = 0; const unsigned long long rt_entry = STAMP ? (unsigned long long)wall_clock64() : 0ull;
#define PG8_STAMP() do { if (STAMP && wid == 0 && nts < 64) { const unsigned long long _c = (unsigned long long)clock64(); \
        ts_lo = (lane == nts) ? (int)(unsigned)_c : ts_lo; ts_hi = (lane == nts) ? (int)(unsigned)(_c >> 32) : ts_hi; ++nts; } } while (0)
    PG8_STAMP();
    unsigned voffA[2], voffB[2];
#pragma unroll
    for (int i = 0; i < 2; ++i) { int R, C; stage_rc(tid * 16 + i * 8192, R, C); const int Rb = Epi::PERM ? ((R & ~31) + perm32(R & 31)) : R;
        voffA[i] = (unsigned)(R * g.lda + C) * 2u; voffB[i] = (unsigned)(Rb * g.ldb + C) * 2u; }
    const size_t kstep = (size_t)(BK * 2);
    const size_t hstepA = (size_t)HALF * g.lda * 2, hstepB = (size_t)HALF * g.ldb * 2;
    const size_t tstepA = 2 * hstepA, tstepB = 2 * hstepB;
    const unsigned ldsw = (unsigned)wid * 1024u;
    const int aoff = lds_byte(wr * 64 + fr, fq * 8), boff = lds_byte(wc * 32 + fr, fq * 8);
#define PG8_SA(b, h) (((b) * 2 + (h)) * HTB)
#define PG8_SB(b, h) ((4 + (b) * 2 + (h)) * HTB)
#define PG8_STAGE(bufoff, gbase, voff) do { _Pragma("unroll") for (int _i = 0; _i < 2; ++_i) \
        __builtin_amdgcn_global_load_lds((const unsigned*)((const char*)(gbase) + (voff)[_i]), (PG8_LAS unsigned*)(lds + (bufoff) + ldsw + _i * 8192), 16, 0, 0); } while (0)
#define PG8_LDA(dst, b, h) do { _Pragma("unroll") for (int m = 0; m < 4; ++m) _Pragma("unroll") for (int k = 0; k < 2; ++k) dst[m][k] = *(const PG8_LAS bf16x8*)(lds + PG8_SA(b, h) + aoff + m * 2048 + k * 1024); } while (0)
#define PG8_LDB(dst, b, h) do { _Pragma("unroll") for (int n = 0; n < 2; ++n) _Pragma("unroll") for (int k = 0; k < 2; ++k) dst[n][k] = *(const PG8_LAS bf16x8*)(lds + PG8_SB(b, h) + boff + n * 2048 + k * 1024); } while (0)
#define PG8_MMA(ai, bj, At, Bt) do { __builtin_amdgcn_s_setprio(1); _Pragma("unroll") for (int m = 0; m < 4; ++m) _Pragma("unroll") for (int n = 0; n < 2; ++n) _Pragma("unroll") for (int k = 0; k < 2; ++k) \
        acc[ai][bj][m][n] = __builtin_amdgcn_mfma_f32_16x16x32_bf16(Bt[n][k], At[m][k], acc[ai][bj][m][n], 0, 0, 0); __builtin_amdgcn_s_setprio(0); } while (0)
#define PG8_WAIT_V(n) asm volatile("s_waitcnt vmcnt(" #n ")" ::: "memory")
#define PG8_WAIT_L(n) asm volatile("s_waitcnt lgkmcnt(" #n ")" ::: "memory")
#define PG8_BAR __builtin_amdgcn_s_barrier()
#define PG8_SCHED __builtin_amdgcn_sched_barrier(0)
    Unit cur, nxt; int ui = 0;
    if (!S.next(0, cur)) return;
    f32x4 acc[2][2][4][2];
#pragma unroll
    for (int a = 0; a < 2; ++a)
#pragma unroll
        for (int b = 0; b < 2; ++b)
#pragma unroll
            for (int m = 0; m < 4; ++m)
#pragma unroll
                for (int n = 0; n < 2; ++n) acc[a][b][m][n] = (f32x4){0.f, 0.f, 0.f, 0.f};
    bf16x8 At[4][2], B0[2][2], B1[2][2];
    const char* cA = (const char*)g.A + (size_t)cur.pm * tstepA + (size_t)(cur.pn >> g.a_pn_shift) * g.a_pn_stride; const char* cB = (const char*)g.Bt + (size_t)cur.pn * tstepB;
    S.a_ready(cur);
    PG8_STAGE(PG8_SB(0, 0), cB, voffB); PG8_STAGE(PG8_SA(0, 0), cA, voffA); PG8_STAGE(PG8_SB(0, 1), cB + hstepB, voffB); PG8_STAGE(PG8_SA(0, 1), cA + hstepA, voffA);
    if (wr == 1) PG8_BAR;
    PG8_WAIT_V(4); PG8_BAR;
    PG8_STAGE(PG8_SB(1, 0), cB + kstep, voffB); PG8_STAGE(PG8_SA(1, 0), cA + kstep, voffA); PG8_STAGE(PG8_SB(1, 1), cB + hstepB + kstep, voffB);
    PG8_WAIT_V(6); PG8_BAR;
    PG8_STAMP();
    for (;;) {
        const bool has_next = S.next(ui + 1, nxt);
        const char* nA = has_next ? (const char*)g.A + (size_t)nxt.pm * tstepA + (size_t)(nxt.pn >> g.a_pn_shift) * g.a_pn_stride : cA; const char* nB = has_next ? (const char*)g.Bt + (size_t)nxt.pn * tstepB : cB;
#pragma unroll 1
        for (int t = 0; t < nt; t += 2) {
            const bool last = (t == nt - 2);
            const char* a1 = cA + (size_t)(t + 1) * kstep;
            const char* a2 = last ? nA : cA + (size_t)(t + 2) * kstep; const char* b2 = last ? nB : cB + (size_t)(t + 2) * kstep;
            const char* a3 = a2 + kstep; const char* b3 = b2 + kstep;
            if (last && has_next) S.a_ready(nxt);
            PG8_LDB(B0, 0, 0); PG8_SCHED; PG8_LDA(At, 0, 0); PG8_STAGE(PG8_SA(1, 1), a1 + hstepA, voffA);
            PG8_WAIT_L(8); PG8_BAR; PG8_WAIT_L(0); PG8_MMA(0, 0, At, B0); PG8_BAR; PG8_SCHED;
            PG8_LDB(B1, 0, 1); PG8_STAGE(PG8_SB(0, 0), b2, voffB);
            PG8_BAR; PG8_WAIT_L(0); PG8_MMA(0, 1, At, B1); PG8_BAR;
            PG8_LDA(At, 0, 1); PG8_STAGE(PG8_SA(0, 0), a2, voffA);
            PG8_BAR; PG8_WAIT_L(0); PG8_MMA(1, 0, At, B0); PG8_BAR; PG8_SCHED;
            PG8_STAGE(PG8_SB(0, 1), b2 + hstepB, voffB);
            PG8_WAIT_V(6); PG8_BAR; PG8_MMA(1, 1, At, B1); PG8_BAR;
            PG8_LDB(B0, 1, 0); PG8_SCHED; PG8_LDA(At, 1, 0); PG8_STAGE(PG8_SA(0, 1), a2 + hstepA, voffA);
            PG8_WAIT_L(8); PG8_BAR; PG8_WAIT_L(0); PG8_MMA(0, 0, At, B0); PG8_BAR; PG8_SCHED;
            PG8_LDB(B1, 1, 1); PG8_STAGE(PG8_SB(1, 0), b3, voffB);
            PG8_BAR; PG8_WAIT_L(0); PG8_MMA(0, 1, At, B1); PG8_BAR;
            PG8_LDA(At, 1, 1); PG8_STAGE(PG8_SA(1, 0), a3, voffA);
            PG8_BAR; PG8_WAIT_L(0); PG8_MMA(1, 0, At, B0); PG8_BAR; PG8_SCHED;
            PG8_STAGE(PG8_SB(1, 1), b3 + hstepB, voffB);
            PG8_WAIT_V(6); PG8_BAR; PG8_MMA(1, 1, At, B1); PG8_BAR;
        }
        PG8_STAMP();
        if constexpr (!Epi::AFTER_DRAIN) { E(acc, cur, wr, wc, fr, fq); S.done(cur); }
        PG8_STAMP();
        if (!has_next) break;
#pragma unroll
        for (int a = 0; a < 2; ++a)
#pragma unroll
            for (int b = 0; b < 2; ++b)
#pragma unroll
                for (int m = 0; m < 4; ++m)
#pragma unroll
                    for (int n = 0; n < 2; ++n) acc[a][b][m][n] = (f32x4){0.f, 0.f, 0.f, 0.f};
        cur = nxt; cA = nA; cB = nB; ++ui;
    }
    PG8_WAIT_V(0);
    if (wr == 0) PG8_BAR;
    PG8_BAR;
    if constexpr (Epi::AFTER_DRAIN) { E.fused(acc, cur, wr, wc, fr, fq, lds, wid, lane); S.done(cur); }
    PG8_STAMP();
    if (STAMP && wid == 0) { stamps[lane] = lane < nts ? (((unsigned long long)(unsigned)ts_hi << 32) | (unsigned)ts_lo) : 0ull;
        if (lane == 62) stamps[62] = rt_entry; if (lane == 63) stamps[63] = (unsigned long long)wall_clock64(); }
#undef PG8_STAMP
#undef PG8_SA
#undef PG8_SB
#undef PG8_STAGE
#undef PG8_LDA
#undef PG8_LDB
#undef PG8_MMA
#undef PG8_WAIT_V
#undef PG8_WAIT_L
#undef PG8_BAR
#undef PG8_SCHED
}
}
using pg8::Unit;

struct EpiBf16 {
    static constexpr bool PERM = true, AFTER_DRAIN = false;
    bf16_t* O; int ldc;
    __device__ __forceinline__ void operator()(const f32x4 (&acc)[2][2][4][2], const Unit& u, int wr, int wc, int fr, int fq) const {
        const int row0 = u.pm * 256 + wr * 64 + fr, col0 = u.pn * 256 + wc * 32 + 8 * fq;
#pragma unroll
        for (int ai = 0; ai < 2; ++ai)
#pragma unroll
            for (int m = 0; m < 4; ++m) { bf16_t* rowp = O + (size_t)(row0 + ai * 128 + m * 16) * ldc + col0;
#pragma unroll
                for (int bj = 0; bj < 2; ++bj) { const f32x4 v0 = acc[ai][bj][m][0], v1 = acc[ai][bj][m][1];
                    u32x4 o; o.x = cvt_pk_bf16(v0[0], v0[1]); o.y = cvt_pk_bf16(v0[2], v0[3]); o.z = cvt_pk_bf16(v1[0], v1[1]); o.w = cvt_pk_bf16(v1[2], v1[3]);
                    *(u32x4*)(rowp + bj * 128) = o; } }
    }
};
struct EpiLruIn {
    static constexpr bool PERM = true, AFTER_DRAIN = false;
    bf16_t* XB; bf16_t* YG;
    __device__ __forceinline__ void operator()(const f32x4 (&acc)[2][2][4][2], const Unit& u, int wr, int wc, int fr, int fq) const {
        const bool isy = u.pn >= 4;
        bf16_t* O = isy ? YG : XB;
        const int row0 = u.pm * 256 + wr * 64 + fr, col0 = (u.pn & 3) * 256 + wc * 32 + 8 * fq;
#pragma unroll
        for (int ai = 0; ai < 2; ++ai)
#pragma unroll
            for (int m = 0; m < 4; ++m) { bf16_t* rowp = O + (size_t)(row0 + ai * 128 + m * 16) * 1024 + col0;
#pragma unroll
                for (int bj = 0; bj < 2; ++bj) { f32x4 v0 = acc[ai][bj][m][0], v1 = acc[ai][bj][m][1];
                    if (isy) {
#pragma unroll
                        for (int i = 0; i < 4; ++i) { v0[i] = gelu_tanh(v0[i]); v1[i] = gelu_tanh(v1[i]); } }
                    u32x4 o; o.x = cvt_pk_bf16(v0[0], v0[1]); o.y = cvt_pk_bf16(v0[2], v0[3]); o.z = cvt_pk_bf16(v1[0], v1[1]); o.w = cvt_pk_bf16(v1[2], v1[3]);
                    *(u32x4*)(rowp + bj * 128) = o; } }
    }
};
struct EpiGates {
    static constexpr bool PERM = true, AFTER_DRAIN = false;
    bf16_t* LOGA; bf16_t* BTERM; const bf16_t* XC; const float* b_a; const float* b_x; const float* lam;
    __device__ __forceinline__ void operator()(const f32x4 (&acc)[2][2][4][2], const Unit& u, int wr, int wc, int fr_, int fq) const {
        int fr = fr_; asm volatile("" : "+v"(fr));
        const int nblk = u.pn >> 2, uu = u.pn & 3, d = uu >> 1, jh = uu & 1;
        const int colbase = nblk * 256 + jh * 128 + wc * 32 + 8 * fq;
        const unsigned off0 = (unsigned)(u.pm * 256 + wr * 64 + fr) * 1024u + (unsigned)colbase;
        const bf16_t* xcp = XC; bf16_t* lap = LOGA + (size_t)d * T * 1024; bf16_t* btp = BTERM + (size_t)d * T * 1024;
        const float* bap = b_a + d * 1024; const float* bxp = b_x + d * 1024; const float* lmp = lam + d * 1024;
#pragma unroll
        for (int ai = 0; ai < 2; ++ai)
#pragma unroll
            for (int m = 0; m < 4; ++m) { const unsigned off = off0 + (unsigned)(ai * 128 + m * 16) * 1024u;
                asm volatile("" ::: "memory"); __builtin_amdgcn_sched_barrier(0);
                const u32x4 xr = *(const u32x4*)(xcp + off);
                const float xv[8] = {bflo(xr.x), bfhi(xr.x), bflo(xr.y), bfhi(xr.y), bflo(xr.z), bfhi(xr.z), bflo(xr.w), bfhi(xr.w)};
                unsigned o1[4], o2[4];
#pragma unroll
                for (int n = 0; n < 2; ++n) { const f32x4 ba = *(const f32x4*)(bap + (unsigned)(colbase + 4 * n)), bx = *(const f32x4*)(bxp + (unsigned)(colbase + 4 * n)), lm = *(const f32x4*)(lmp + (unsigned)(colbase + 4 * n));
                    float la[4], bt[4];
#pragma unroll
                    for (int i = 0; i < 4; ++i) { const float r = sigmoidf_(acc[ai][0][m][n][i] + ba[i]), ig = sigmoidf_(acc[ai][1][m][n][i] + bx[i]);
                        const float l = -8.f * fast_log(1.f + fast_exp(-lm[i])) * r; const float mult = __builtin_sqrtf(fmaxf(1.f - fast_exp(2.f * l), 0.f));
                        la[i] = l; bt[i] = mult * ig * xv[n * 4 + i]; }
                    o1[n * 2] = cvt_pk_bf16(la[0], la[1]); o1[n * 2 + 1] = cvt_pk_bf16(la[2], la[3]); o2[n * 2] = cvt_pk_bf16(bt[0], bt[1]); o2[n * 2 + 1] = cvt_pk_bf16(bt[2], bt[3]); }
                *(u32x4*)(lap + off) = (u32x4){o1[0], o1[1], o1[2], o1[3]}; *(u32x4*)(btp + off) = (u32x4){o2[0], o2[1], o2[2], o2[3]}; }
    }
};
struct EpiResid {
    static constexpr bool PERM = false, AFTER_DRAIN = false;
    const float* xin; float* xout; const float* gate;
    __device__ __forceinline__ void operator()(const f32x4 (&acc)[2][2][4][2], const Unit& u, int wr, int wc, int fr, int fq) const {
        const int row0 = u.pm * 256 + wr * 64 + fr, col0 = u.pn * 256 + wc * 32 + 4 * fq;
        const float* gp = gate + ((u.pm * 256) >> 13) * 6144 + col0;
        f32x4 gv[2][2];
#pragma unroll
        for (int bj = 0; bj < 2; ++bj)
#pragma unroll
            for (int n = 0; n < 2; ++n) gv[bj][n] = *(const f32x4*)(gp + bj * 128 + n * 16);
#pragma unroll
        for (int ai = 0; ai < 2; ++ai)
#pragma unroll
            for (int m = 0; m < 4; ++m) { const size_t off = (size_t)(row0 + ai * 128 + m * 16) * 1024 + col0;
#pragma unroll
                for (int bj = 0; bj < 2; ++bj)
#pragma unroll
                    for (int n = 0; n < 2; ++n) { const f32x4 xv = *(const f32x4*)(xin + off + bj * 128 + n * 16);
                        *(f32x4*)(xout + off + bj * 128 + n * 16) = xv + gv[bj][n] * acc[ai][bj][m][n]; } }
    }
};
struct EpiF32 {
    static constexpr bool PERM = false, AFTER_DRAIN = false;
    float* C; int ldc;
    __device__ __forceinline__ void operator()(const f32x4 (&acc)[2][2][4][2], const Unit& u, int wr, int wc, int fr, int fq) const {
        const int row0 = u.pm * 256 + wr * 64 + fr, col0 = u.pn * 256 + wc * 32 + 4 * fq;
#pragma unroll
        for (int ai = 0; ai < 2; ++ai)
#pragma unroll
            for (int m = 0; m < 4; ++m) { float* rowp = C + (size_t)(row0 + ai * 128 + m * 16) * ldc + col0;
#pragma unroll
                for (int bj = 0; bj < 2; ++bj)
#pragma unroll
                    for (int n = 0; n < 2; ++n) *(f32x4*)(rowp + bj * 128 + n * 16) = acc[ai][bj][m][n]; }
    }
};

struct Params {
    const float *x, *c, *w_ada, *b_ada, *norm_g, *hg_w_in, *hg_lb, *hg_norm_g, *hg_w_out, *lru_w_in, *lru_conv_w, *lru_conv_b,
        *lru_w_a, *lru_b_a, *lru_w_x, *lru_b_x, *lru_lam, *lru_w_out, *peer_w_q, *peer_keys, *peer_u, *peer_v, *final_g;
    float* out; unsigned char* ws; int ph_lo, ph_hi;
};

typedef const __attribute__((address_space(4))) Params* KP;

template <class Epi>
__device__ __forceinline__ void run_gemm(LAS unsigned char* lds, const bf16_t* A, const bf16_t* Bt, int N, int K, int lda, int ldb, int a_pn_shift, int a_pn_stride, const Epi& E) {
    pg8::Gemm g; g.A = A; g.Bt = Bt; g.M = T; g.N = N; g.K = K; g.lda = lda; g.ldb = ldb; g.a_pn_shift = a_pn_shift; g.a_pn_stride = a_pn_stride;
    LAUNDER_IDS
    pg8::StaticOrder S; S.init(T, N, (int)gridDim.x, bidL); (void)tidL;
    pg8::gemm_phase<Epi, pg8::StaticOrder, false>(lds, g, S, E, nullptr);
    __syncthreads();
}

__device__ __forceinline__ void transpose_tile(const float* __restrict__ src, int ld_src, bf16_t* dst, int ld_dst, LAS float* tile, int tid) {
#pragma unroll
    for (int it = 0; it < 2; ++it) { const int r = (tid >> 4) + 32 * it, c4 = (tid & 15) * 4;
        const f32x4 v = *(const f32x4*)(src + (size_t)r * ld_src + c4);
        tile[r * 65 + c4 + 0] = v[0]; tile[r * 65 + c4 + 1] = v[1]; tile[r * 65 + c4 + 2] = v[2]; tile[r * 65 + c4 + 3] = v[3]; }
    __syncthreads();
    { const int n = tid >> 3, kc = tid & 7; const LAS float* s = tile + (kc * 8) * 65 + n;
        u32x4 o; o.x = cvt_pk_bf16(s[0], s[65]); o.y = cvt_pk_bf16(s[2 * 65], s[3 * 65]); o.z = cvt_pk_bf16(s[4 * 65], s[5 * 65]); o.w = cvt_pk_bf16(s[6 * 65], s[7 * 65]);
        *(u32x4*)(dst + (size_t)n * ld_dst + kc * 8) = o; }
    __syncthreads();
}

__device__ __forceinline__ void phase0(KP p, LAS unsigned char* lds) {
    LAUNDER_IDS
    const int tid = tidL, wave = tid >> 6, lane = tid & 63;
    unsigned char* ws = p->ws;
    LAS float* tile = (LAS float*)lds;
    constexpr int I_HGIN = 16 * 80, I_SQ = 16 * 16, I_LRIN = 16 * 32, I_G = 16;
    constexpr int N_A = 2 * I_HGIN + 2 * I_SQ + 2 * I_LRIN + 2 * I_SQ + 32 * I_G;
    for (int it = bidL; it < N_A; it += gridDim.x) {
        int r = it;
        if (r < 2 * I_HGIN) { const int j = r / I_HGIN, q = r % I_HGIN, kb = q / 80, nb = q % 80;
            transpose_tile(p->hg_w_in + (size_t)j * 1024 * 5120 + (size_t)kb * 64 * 5120 + nb * 64, 5120, (bf16_t*)(ws + WS_HGWIN) + (size_t)j * 5120 * 1024 + (size_t)nb * 64 * 1024 + kb * 64, 1024, tile, tid); continue; }
        r -= 2 * I_HGIN;
        if (r < 2 * I_SQ) { const int j = r / I_SQ, q = r % I_SQ, kb = q / 16, nb = q % 16;
            transpose_tile(p->hg_w_out + (size_t)j * 1024 * 1024 + (size_t)kb * 64 * 1024 + nb * 64, 1024, (bf16_t*)(ws + WS_HGWOUT) + (size_t)j * 1024 * 1024 + (size_t)nb * 64 * 1024 + kb * 64, 1024, tile, tid); continue; }
        r -= 2 * I_SQ;
        if (r < 2 * I_LRIN) { const int j = r / I_LRIN, q = r % I_LRIN, kb = q / 32, nb = q % 32;
            transpose_tile(p->lru_w_in + (size_t)j * 1024 * 2048 + (size_t)kb * 64 * 2048 + nb * 64, 2048, (bf16_t*)(ws + WS_LRWIN) + (size_t)j * 2048 * 1024 + (size_t)nb * 64 * 1024 + kb * 64, 1024, tile, tid); continue; }
        r -= 2 * I_LRIN;
        if (r < 2 * I_SQ) { const int j = r / I_SQ, q = r % I_SQ, kb = q / 16, nb = q % 16;
            transpose_tile(p->lru_w_out + (size_t)j * 1024 * 1024 + (size_t)kb * 64 * 1024 + nb * 64, 1024, (bf16_t*)(ws + WS_LRWOUT) + (size_t)j * 1024 * 1024 + (size_t)nb * 64 * 1024 + kb * 64, 1024, tile, tid); continue; }
        r -= 2 * I_SQ;
        { const int mat = r / I_G, q = r % I_G, kb = q / 4, nb = q % 4;
            const int nblk = mat & 3, gate = (mat >> 2) & 1, d = (mat >> 3) & 1, l = mat >> 4;
            const float* src = (gate ? p->lru_w_x : p->lru_w_a) + (size_t)((l * 2 + d) * 4 + nblk) * 65536 + (size_t)kb * 64 * 256 + nb * 64;
            const int n0 = nb * 64, jh = n0 >> 7;
            bf16_t* dst = (bf16_t*)(ws + WS_LRWG) + (size_t)l * 4 * 1024 * 256 + (size_t)nblk * 1024 * 256 + (size_t)((d * 2 + jh) * 256 + gate * 128 + (n0 & 127)) * 256 + kb * 64;
            transpose_tile(src, 256, dst, 256, tile, tid); }
    }
    {
        LAS float* keysL = (LAS float*)lds;
        LAS float* wqL = (LAS float*)(lds + 128 * 132 * 4);
        for (int it = bidL; it < 1024; it += gridDim.x) {
            const int l = it >> 8, hp = (it >> 4) & 15, dt = it & 15;
            const float* kp = p->peer_keys + ((size_t)l * 16 + hp) * 16384;
#pragma unroll
            for (int q = 0; q < 8; ++q) { const int e = (tid + 512 * q) * 4; const f32x4 v = *(const f32x4*)(kp + e); *(LAS f32x4*)(keysL + (e >> 7) * 132 + (e & 127)) = v; }
            const float* wp = p->peer_w_q + (size_t)l * 1024 * 2048 + (size_t)(dt * 64) * 2048 + hp * 128;
#pragma unroll
            for (int q = 0; q < 4; ++q) { const int e = (tid + 512 * q) * 4; const f32x4 v = *(const f32x4*)(wp + (size_t)(e >> 7) * 2048 + (e & 127)); *(LAS f32x4*)(wqL + e) = v; }
            __syncthreads();
            const int key = tid & 127, g = tid >> 7;
            float acc[16];
#pragma unroll
            for (int i = 0; i < 16; ++i) acc[i] = 0.f;
            for (int d4 = 0; d4 < 128; d4 += 4) {
                const f32x4 kv = *(const LAS f32x4*)(keysL + key * 132 + d4);
#pragma unroll
                for (int i = 0; i < 16; ++i) { const f32x4 wv = *(const LAS f32x4*)(wqL + (g * 16 + i) * 128 + d4);
                    acc[i] += kv[0] * wv[0] + kv[1] * wv[1] + kv[2] * wv[2] + kv[3] * wv[3]; }
            }
            bf16_t* op = (bf16_t*)(ws + WS_WQK) + (size_t)l * 2048 * 1024 + (size_t)(hp * 128 + key) * 1024 + dt * 64 + g * 16;
            u32x4 o1, o2; o1.x = cvt_pk_bf16(acc[0], acc[1]); o1.y = cvt_pk_bf16(acc[2], acc[3]); o1.z = cvt_pk_bf16(acc[4], acc[5]); o1.w = cvt_pk_bf16(acc[6], acc[7]);
            o2.x = cvt_pk_bf16(acc[8], acc[9]); o2.y = cvt_pk_bf16(acc[10], acc[11]); o2.z = cvt_pk_bf16(acc[12], acc[13]); o2.w = cvt_pk_bf16(acc[14], acc[15]);
            *(u32x4*)op = o1; *(u32x4*)(op + 8) = o2;
            __syncthreads();
        }
    }
    {
        LAS float* condL = (LAS float*)lds;
        LAS float* red = (LAS float*)(lds + 8192);
        for (int i = tid; i < 2048; i += NTHR) condL[i] = silu_(p->c[i]);
        __syncthreads();
        for (int it = bidL; it < 4 * 48; it += gridDim.x) {
            const int l = it / 48, col0 = (it % 48) * 128;
            const float* wp = p->w_ada + (size_t)l * 1024 * 6144 + col0 + 2 * lane;
            float a00 = 0.f, a01 = 0.f, a10 = 0.f, a11 = 0.f;
#pragma unroll 8
            for (int kk = 0; kk < 128; ++kk) { const int k = wave * 128 + kk; const f32x2 w = *(const f32x2*)(wp + (size_t)k * 6144);
                const float c0 = condL[k], c1 = condL[1024 + k];
                a00 += c0 * w[0]; a01 += c0 * w[1]; a10 += c1 * w[0]; a11 += c1 * w[1]; }
            red[(wave * 2 + 0) * 128 + 2 * lane] = a00; red[(wave * 2 + 0) * 128 + 2 * lane + 1] = a01;
            red[(wave * 2 + 1) * 128 + 2 * lane] = a10; red[(wave * 2 + 1) * 128 + 2 * lane + 1] = a11;
            __syncthreads();
            if (tid < 256) { const int b = tid >> 7, cc = tid & 127; float s = 0.f;
#pragma unroll
                for (int w = 0; w < 8; ++w) s += red[(w * 2 + b) * 128 + cc];
                ((float*)(ws + WS_MOD))[((size_t)l * 2 + b) * 6144 + col0 + cc] = s + p->b_ada[(size_t)l * 6144 + col0 + cc]; }
            __syncthreads();
        }
    }
    {
        const size_t n8 = (size_t)4 * 16384 * 1024 / 8;
        const size_t gt = (size_t)bidL * NTHR + tid, gs = (size_t)gridDim.x * NTHR;
        for (int tb = 0; tb < 2; ++tb) {
            const float* src = tb ? p->peer_v : p->peer_u; bf16_t* dst = (bf16_t*)(ws + (tb ? WS_VTAB : WS_UTAB));
            for (size_t i = gt; i < n8; i += gs) { const f32x4 a = __builtin_nontemporal_load((const f32x4*)(src + i * 8)), b = __builtin_nontemporal_load((const f32x4*)(src + i * 8 + 4));
                u32x4 o; o.x = cvt_pk_bf16(a[0], a[1]); o.y = cvt_pk_bf16(a[2], a[3]); o.z = cvt_pk_bf16(b[0], b[1]); o.w = cvt_pk_bf16(b[2], b[3]);
                *(u32x4*)(dst + i * 8) = o; }
        }
    }
}

__device__ __forceinline__ void phase_rms(const float* xin, const float* gain, const float* shift, const float* scale, bf16_t* hout) {
    LAUNDER_IDS
    const int tid = tidL, wave = tid >> 6, lane = tid & 63;
    for (int row = bidL * NWAVE + wave; row < T; row += gridDim.x * NWAVE) {
        const int b = row >> 13;
        const float* xr = xin + (size_t)row * 1024 + lane * 4;
        f32x4 v[4]; float ss = 0.f;
#pragma unroll
        for (int j = 0; j < 4; ++j) { v[j] = *(const f32x4*)(xr + j * 256); ss += v[j][0] * v[j][0] + v[j][1] * v[j][1] + v[j][2] * v[j][2] + v[j][3] * v[j][3]; }
        const float inv = __builtin_amdgcn_rsqf(wave_sum(ss) * (1.f / 1024.f) + EPS);
#pragma unroll
        for (int j = 0; j < 4; ++j) { const int col = j * 256 + lane * 4;
            const f32x4 g = *(const f32x4*)(gain + col), sh = *(const f32x4*)(shift + b * 6144 + col), sc = *(const f32x4*)(scale + b * 6144 + col);
            const f32x4 y = (v[j] * inv) * g * (1.f + sc) + sh;
            u32x2 o; o.x = cvt_pk_bf16(y[0], y[1]); o.y = cvt_pk_bf16(y[2], y[3]);
            *(u32x2*)(hout + (size_t)row * 1024 + col) = o; }
    }
}

constexpr int LROW = 136;
__device__ __forceinline__ float hg_lower_bound(const float* hg_lb, int j, int col) {
    if (j == 0) return 0.f;
    const float l0 = hg_lb[col], l1 = hg_lb[1024 + col];
    return fast_rcp(1.f + fast_exp(l0 - l1));
}
__device__ __forceinline__ f32x4 mfma16(bf16x8 a, bf16x8 b, f32x4 c) { return __builtin_amdgcn_mfma_f32_16x16x32_bf16(a, b, c, 0, 0, 0); }

__device__ __forceinline__ void load_vt(const bf16_t* proj, LAS bf16_t* VT, int t0, int dir, int h, int tid) {
#pragma unroll
    for (int it = 0; it < 4; ++it) { const int idx = tid + 512 * it, tau = idx & 127, cv = idx >> 7;
        const int tok = dir ? t0 + 127 - tau : t0 + tau;
        const u32x4 v = *(const u32x4*)(proj + (size_t)tok * 5120 + 3072 + h * 128 + cv * 8);
        LAS bf16_t* d = VT + (cv * 8) * LROW + tau;
        d[0 * LROW] = (bf16_t)(v.x & 0xffff); d[1 * LROW] = (bf16_t)(v.x >> 16); d[2 * LROW] = (bf16_t)(v.y & 0xffff); d[3 * LROW] = (bf16_t)(v.y >> 16);
        d[4 * LROW] = (bf16_t)(v.z & 0xffff); d[5 * LROW] = (bf16_t)(v.z >> 16); d[6 * LROW] = (bf16_t)(v.w & 0xffff); d[7 * LROW] = (bf16_t)(v.w >> 16); }
}

__device__ __forceinline__ void hg_pass_a(KP p, LAS unsigned char* lds, int j) {
    LAUNDER_IDS
    const bf16_t* proj = (const bf16_t*)(p->ws + WS_PROJ);
    float* KV = (float*)(p->ws + WS_KV); float* DEC = (float*)(p->ws + WS_DEC);
    LAS bf16_t* VT = (LAS bf16_t*)lds; LAS bf16_t* KT = (LAS bf16_t*)(lds + 34816); LAS float* TOT = (LAS float*)(lds + 69632);
    for (int u = bidL; u < 2048; u += gridDim.x) {
        int tid = tidL; asm volatile("" : "+v"(tid));
        const int wave = tid >> 6, lane = tid & 63;
        const int seq = u >> 6, c = u & 63, dir = seq & 1, h = (seq >> 1) & 7, b = seq >> 4;
        const int t0 = b * SEQ + c * 128;
        const int dk = tid & 127, g = tid >> 7;
        const float lb = hg_lower_bound(p->hg_lb, j, h * 128 + dk);
        float lcs[32], kks[32]; float lc = 0.f;
        const bf16_t* zp = proj + 1024 * (1 + dir) + h * 128 + dk;
#pragma unroll
        for (int q = 0; q < 32; ++q) { const int tau = 32 * g + q, tok = dir ? t0 + 127 - tau : t0 + tau;
            const float z = bf2f(zp[(size_t)tok * 5120]);
            const float f = lb + (1.f - lb) * sigmoidf_(z);
            lc += fast_log(f); lcs[q] = lc; kks[q] = 1.f - f; }
        TOT[g * 128 + dk] = lc;
        load_vt(proj, VT, t0, dir, h, tid);
        __syncthreads();
        float rg = 0.f, total = 0.f;
#pragma unroll
        for (int gg = 0; gg < 4; ++gg) { const float tv = TOT[gg * 128 + dk]; total += tv; if (gg < g) rg += tv; }
        const float base = total - rg;
#pragma unroll
        for (int q8 = 0; q8 < 4; ++q8) { unsigned w[4];
#pragma unroll
            for (int e = 0; e < 4; ++e) { const int q = q8 * 8 + e * 2;
                w[e] = cvt_pk_bf16(kks[q] * fast_exp(base - lcs[q]), kks[q + 1] * fast_exp(base - lcs[q + 1])); }
            u32x4 o; o.x = w[0]; o.y = w[1]; o.z = w[2]; o.w = w[3];
            *(LAS u32x4*)(KT + dk * LROW + 32 * g + q8 * 8) = o; }
        if (g == 0) DEC[(size_t)u * 128 + dk] = fast_exp(total);
        __syncthreads();
        f32x4 acc[2][4];
#pragma unroll
        for (int a = 0; a < 2; ++a)
#pragma unroll
            for (int bb = 0; bb < 4; ++bb) acc[a][bb] = (f32x4){0.f, 0.f, 0.f, 0.f};
        const int l15 = lane & 15, lq = lane >> 4;
#pragma unroll
        for (int ks = 0; ks < 4; ++ks) {
            bf16x8 af[2], bfr[4];
#pragma unroll
            for (int a = 0; a < 2; ++a) af[a] = *(const LAS bf16x8*)(VT + (((wave & 3) * 2 + a) * 16 + l15) * LROW + ks * 32 + lq * 8);
#pragma unroll
            for (int bb = 0; bb < 4; ++bb) bfr[bb] = *(const LAS bf16x8*)(KT + (((wave >> 2) * 4 + bb) * 16 + l15) * LROW + ks * 32 + lq * 8);
#pragma unroll
            for (int a = 0; a < 2; ++a)
#pragma unroll
                for (int bb = 0; bb < 4; ++bb) acc[a][bb] = mfma16(af[a], bfr[bb], acc[a][bb]);
        }
        float* kvp = KV + (size_t)u * 16384;
#pragma unroll
        for (int a = 0; a < 2; ++a)
#pragma unroll
            for (int bb = 0; bb < 4; ++bb)
#pragma unroll
                for (int r = 0; r < 4; ++r) kvp[(((wave & 3) * 2 + a) * 16 + lq * 4 + r) * 128 + ((wave >> 2) * 4 + bb) * 16 + l15] = acc[a][bb][r];
        __syncthreads();
    }
}

__device__ __forceinline__ void hg_pass_b(KP p) {
    LAUNDER_IDS
    const float* KV = (const float*)(p->ws + WS_KV); const float* DEC = (const float*)(p->ws + WS_DEC);
    bf16_t* SIN = (bf16_t*)(p->ws + WS_SIN);
    for (int e = bidL * NTHR + tidL; e < 131072; e += gridDim.x * NTHR) {
    const int seq = e >> 12, i4 = e & 4095, dir = seq & 1, dk = (i4 * 4) & 127;
    f32x4 S = {0.f, 0.f, 0.f, 0.f};
#pragma unroll 8
    for (int step = 0; step < 64; ++step) {
        const int c = dir ? 63 - step : step; const size_t u = (size_t)seq * 64 + c;
        const f32x4 kv = *(const f32x4*)(KV + u * 16384 + i4 * 4); const f32x4 dc = *(const f32x4*)(DEC + u * 128 + dk);
        u32x2 o; o.x = cvt_pk_bf16(S[0], S[1]); o.y = cvt_pk_bf16(S[2], S[3]);
        *(u32x2*)(SIN + u * 16384 + i4 * 4) = o;
        S = dc * S + kv;
    }
    }
}

__device__ __forceinline__ void hg_pass_c(KP p, LAS unsigned char* lds, int j) {
    LAUNDER_IDS
    const bf16_t* proj = (const bf16_t*)(p->ws + WS_PROJ);
    const bf16_t* SIN = (const bf16_t*)(p->ws + WS_SIN);
    bf16_t* OB = (bf16_t*)(p->ws + WS_OB);
    LAS bf16_t* QT = (LAS bf16_t*)lds; LAS bf16_t* QI = (LAS bf16_t*)(lds + 34816); LAS bf16_t* KT = (LAS bf16_t*)(lds + 69632);
    LAS bf16_t* VT = (LAS bf16_t*)(lds + 104448); LAS bf16_t* PI = (LAS bf16_t*)(lds + 139264); LAS float* TOT = (LAS float*)(lds + 147968);
    LAS float* OSUM = (LAS float*)(lds + 69632);
    for (int u = bidL; u < 1024; u += gridDim.x) {
        int tid = tidL; asm volatile("" : "+v"(tid));
        const int wave = tid >> 6, lane = tid & 63, l15 = lane & 15, lq = lane >> 4;
        const int c = u & 63, h = (u >> 6) & 7, b = u >> 9;
        const int t0 = b * SEQ + c * 128;
        const int dk = tid & 127, g = tid >> 7;
        const float lb = hg_lower_bound(p->hg_lb, j, h * 128 + dk);
        const int tt = wave & 1, dvt0 = (wave >> 1) * 2;
        f32x4 oacc[2][4][2];
#pragma unroll
        for (int dir = 0; dir < 2; ++dir) {
            const size_t su = ((size_t)((b * 8 + h) * 2 + dir) * 64 + c);
            unsigned k0p[16]; float lc = 0.f; float kprev = 0.f;
            const bf16_t* zp = proj + 1024 * (1 + dir) + h * 128 + dk; const bf16_t* qp = proj + h * 128 + dk;
#pragma unroll
            for (int q = 0; q < 32; ++q) { const int tau = 32 * g + q, tok = dir ? t0 + 127 - tau : t0 + tau;
                const float z = bf2f(zp[(size_t)tok * 5120]), qv = bf2f(qp[(size_t)tok * 5120]);
                const float f = lb + (1.f - lb) * sigmoidf_(z);
                lc += fast_log(f);
                const float el = fast_exp(fmaxf(lc, -80.f));
                QT[tau * LROW + dk] = f2bf(qv * el);
                const float kcur = (1.f - f) * fast_rcp(el);
                if (q & 1) k0p[q >> 1] = cvt_pk_bf16(kprev, kcur); else kprev = kcur; }
            TOT[g * 128 + dk] = lc;
            __syncthreads();
            float r[4]; { float run = 0.f;
#pragma unroll
                for (int gg = 0; gg < 4; ++gg) { r[gg] = run; run += TOT[gg * 128 + dk]; } }
            float rg = 0.f;
#pragma unroll
            for (int gg = 0; gg < 4; ++gg) if (gg == g) rg = r[gg];
            { const float eg = fast_exp(rg);
#pragma unroll
                for (int q = 0; q < 32; ++q) QI[(32 * g + q) * LROW + dk] = f2bf(bf2f(QT[(32 * g + q) * LROW + dk]) * eg); }
            load_vt(proj, VT, t0, dir, h, tid);
            bf16x8 sfr[2][4];
#pragma unroll
            for (int n = 0; n < 2; ++n)
#pragma unroll
                for (int ks = 0; ks < 4; ++ks) sfr[n][ks] = *(const bf16x8*)(SIN + su * 16384 + (size_t)((dvt0 + n) * 16 + l15) * 128 + ks * 32 + lq * 8);
#pragma unroll
            for (int i = 0; i < 4; ++i) {
                if (g <= i) { const float e = fast_exp(r[i] - rg);
#pragma unroll
                    for (int q = 0; q < 32; ++q) KT[(32 * g + q) * LROW + dk] = f2bf(((q & 1) ? bfhi(k0p[q >> 1]) : bflo(k0p[q >> 1])) * e); }
                __syncthreads();
                for (int tl = wave; tl < 4 * (i + 1); tl += 8) { const int sm = tl >> 1, tn = tl & 1;
                    f32x4 a4 = {0.f, 0.f, 0.f, 0.f};
#pragma unroll
                    for (int ks = 0; ks < 4; ++ks) { const bf16x8 af = *(const LAS bf16x8*)(KT + (sm * 16 + l15) * LROW + ks * 32 + lq * 8);
                        const bf16x8 bq = *(const LAS bf16x8*)(QT + (32 * i + tn * 16 + l15) * LROW + ks * 32 + lq * 8);
                        a4 = mfma16(af, bq, a4); }
                    const int tloc = tn * 16 + l15, s0 = sm * 16 + lq * 4, tg = 32 * i + tloc;
                    u32x2 o; o.x = cvt_pk_bf16(s0 + 0 <= tg ? a4[0] : 0.f, s0 + 1 <= tg ? a4[1] : 0.f); o.y = cvt_pk_bf16(s0 + 2 <= tg ? a4[2] : 0.f, s0 + 3 <= tg ? a4[3] : 0.f);
                    *(LAS u32x2*)(PI + tloc * LROW + s0) = o; }
                __syncthreads();
                f32x4 a0 = {0.f, 0.f, 0.f, 0.f}, a1 = {0.f, 0.f, 0.f, 0.f};
                for (int ks = 0; ks <= i; ++ks) { const bf16x8 af = *(const LAS bf16x8*)(PI + (tt * 16 + l15) * LROW + ks * 32 + lq * 8);
                    const bf16x8 b0 = *(const LAS bf16x8*)(VT + ((dvt0 + 0) * 16 + l15) * LROW + ks * 32 + lq * 8);
                    const bf16x8 b1 = *(const LAS bf16x8*)(VT + ((dvt0 + 1) * 16 + l15) * LROW + ks * 32 + lq * 8);
                    a0 = mfma16(af, b0, a0); a1 = mfma16(af, b1, a1); }
#pragma unroll
                for (int ks = 0; ks < 4; ++ks) { const bf16x8 af = *(const LAS bf16x8*)(QI + (32 * i + tt * 16 + l15) * LROW + ks * 32 + lq * 8);
                    a0 = mfma16(af, sfr[0][ks], a0); a1 = mfma16(af, sfr[1][ks], a1); }
                oacc[dir][i][0] = a0; oacc[dir][i][1] = a1;
            }
        }
        __syncthreads();
#pragma unroll
        for (int i = 0; i < 4; ++i)
#pragma unroll
            for (int n = 0; n < 2; ++n)
#pragma unroll
                for (int rr = 0; rr < 4; ++rr) OSUM[(32 * i + tt * 16 + lq * 4 + rr) * 132 + (dvt0 + n) * 16 + l15] = oacc[0][i][n][rr];
        __syncthreads();
#pragma unroll
        for (int i = 0; i < 4; ++i)
#pragma unroll
            for (int n = 0; n < 2; ++n)
#pragma unroll
                for (int rr = 0; rr < 4; ++rr) OSUM[(127 - (32 * i + tt * 16 + lq * 4 + rr)) * 132 + (dvt0 + n) * 16 + l15] += oacc[1][i][n][rr];
        __syncthreads();
        { const int row = tid >> 2, part = tid & 3; const int tok = t0 + row;
            float ov[32]; float ss = 0.f;
#pragma unroll
            for (int q = 0; q < 8; ++q) { const f32x4 v = *(const LAS f32x4*)(OSUM + row * 132 + part * 32 + q * 4);
                ov[q * 4 + 0] = v[0]; ov[q * 4 + 1] = v[1]; ov[q * 4 + 2] = v[2]; ov[q * 4 + 3] = v[3]; ss += v[0] * v[0] + v[1] * v[1] + v[2] * v[2] + v[3] * v[3]; }
            ss += __shfl_xor(ss, 1); ss += __shfl_xor(ss, 2);
            const float inv = __builtin_amdgcn_rsqf(ss * (1.f / 128.f) + EPS);
            const int col = h * 128 + part * 32;
            const bf16_t* gp = proj + (size_t)tok * 5120 + 4096 + col; const float* ng = p->hg_norm_g + j * 1024 + col;
#pragma unroll
            for (int q = 0; q < 4; ++q) { const u32x4 gr = *(const u32x4*)(gp + q * 8);
                const float gv[8] = {bflo(gr.x), bfhi(gr.x), bflo(gr.y), bfhi(gr.y), bflo(gr.z), bfhi(gr.z), bflo(gr.w), bfhi(gr.w)};
                float y[8];
#pragma unroll
                for (int e = 0; e < 8; ++e) y[e] = ov[q * 8 + e] * inv * ng[q * 8 + e] * silu_(gv[e]);
                u32x4 o; o.x = cvt_pk_bf16(y[0], y[1]); o.y = cvt_pk_bf16(y[2], y[3]); o.z = cvt_pk_bf16(y[4], y[5]); o.w = cvt_pk_bf16(y[6], y[7]);
                *(u32x4*)(OB + (size_t)tok * 1024 + col + q * 8) = o; }
        }
        __syncthreads();
    }
}

__device__ __forceinline__ void lru_conv(KP p, int l) {
    LAUNDER_IDS
    const bf16_t* XB = (const bf16_t*)(p->ws + WS_XB); bf16_t* XC = (bf16_t*)(p->ws + WS_XC);
    const float* cw = p->lru_conv_w + (size_t)l * 4 * 1024; const float* cb = p->lru_conv_b + (size_t)l * 1024;
    const int gs = gridDim.x * NTHR;
    for (int it = bidL * NTHR + tidL; it < T * 128; it += gs) {
        const int tok = it >> 7, c8 = (it & 127) * 8, s = tok & (SEQ - 1);
        float acc[8];
        { const f32x4 b0 = *(const f32x4*)(cb + c8), b1 = *(const f32x4*)(cb + c8 + 4);
            acc[0] = b0[0]; acc[1] = b0[1]; acc[2] = b0[2]; acc[3] = b0[3]; acc[4] = b1[0]; acc[5] = b1[1]; acc[6] = b1[2]; acc[7] = b1[3]; }
#pragma unroll
        for (int jj = 0; jj < 4; ++jj) { const int ts = s + jj - 2;
            if (ts >= 0 && ts < SEQ) { const u32x4 xr = *(const u32x4*)(XB + (size_t)(tok + jj - 2) * 1024 + c8);
                const f32x4 w0 = *(const f32x4*)(cw + jj * 1024 + c8), w1 = *(const f32x4*)(cw + jj * 1024 + c8 + 4);
                acc[0] += bflo(xr.x) * w0[0]; acc[1] += bfhi(xr.x) * w0[1]; acc[2] += bflo(xr.y) * w0[2]; acc[3] += bfhi(xr.y) * w0[3];
                acc[4] += bflo(xr.z) * w1[0]; acc[5] += bfhi(xr.z) * w1[1]; acc[6] += bflo(xr.w) * w1[2]; acc[7] += bfhi(xr.w) * w1[3]; } }
        u32x4 o; o.x = cvt_pk_bf16(acc[0], acc[1]); o.y = cvt_pk_bf16(acc[2], acc[3]); o.z = cvt_pk_bf16(acc[4], acc[5]); o.w = cvt_pk_bf16(acc[6], acc[7]);
        *(u32x4*)(XC + (size_t)tok * 1024 + c8) = o;
    }
}
__device__ __forceinline__ void lru_scan1(KP p) {
    LAUNDER_IDS
    const bf16_t* LOGA = (const bf16_t*)(p->ws + WS_LOGA); const bf16_t* BT = (const bf16_t*)(p->ws + WS_BTERM);
    float* CP = (float*)(p->ws + WS_CP); float* CH = (float*)(p->ws + WS_CH);
    const int ch = 2 * tidL;
    for (int u = bidL; u < 1024; u += gridDim.x) {
        const int chunk = u & 255, dir = (u >> 8) & 1, b = u >> 9;
        const size_t base = ((size_t)dir * T + b * SEQ + chunk * 32) * 1024 + ch;
        float h0 = 0.f, h1 = 0.f, s0 = 0.f, s1 = 0.f;
#pragma unroll 8
        for (int q = 0; q < 32; ++q) { const int t = dir ? 31 - q : q;
            const unsigned lw = *(const unsigned*)(LOGA + base + (size_t)t * 1024), bw = *(const unsigned*)(BT + base + (size_t)t * 1024);
            const float l0 = bflo(lw), l1 = bfhi(lw);
            h0 = fast_exp(l0) * h0 + bflo(bw); h1 = fast_exp(l1) * h1 + bfhi(bw); s0 += l0; s1 += l1; }
        const size_t o = ((size_t)(b * 2 + dir) * 256 + chunk) * 1024 + ch;
        *(f32x2*)(CP + o) = (f32x2){fast_exp(s0), fast_exp(s1)}; *(f32x2*)(CH + o) = (f32x2){h0, h1};
    }
}
__device__ __forceinline__ void lru_scan2(KP p) {
    LAUNDER_IDS
    const float* CP = (const float*)(p->ws + WS_CP); const float* CH = (const float*)(p->ws + WS_CH); float* HIN = (float*)(p->ws + WS_HIN);
    const int wave = tidL >> 6, lane = tidL & 63;
    for (int item = bidL * NWAVE + wave; item < 4096; item += gridDim.x * NWAVE) {
        const int ch = item & 1023, bd = item >> 10, dir = bd & 1;
        float pp[4], hh[4]; float Pl = 1.f, Hl = 0.f;
#pragma unroll
        for (int q = 0; q < 4; ++q) { const int ci = 4 * lane + q, chunk = dir ? 255 - ci : ci; const size_t o = ((size_t)bd * 256 + chunk) * 1024 + ch;
            pp[q] = CP[o]; hh[q] = CH[o]; Hl = pp[q] * Hl + hh[q]; Pl *= pp[q]; }
#pragma unroll
        for (int off = 1; off < 64; off <<= 1) { const float Pp = __shfl_up(Pl, off), Hp = __shfl_up(Hl, off);
            if (lane >= off) { Hl = Pl * Hp + Hl; Pl = Pl * Pp; } }
        float carry = __shfl_up(Hl, 1); if (lane == 0) carry = 0.f;
#pragma unroll
        for (int q = 0; q < 4; ++q) { const int ci = 4 * lane + q, chunk = dir ? 255 - ci : ci; const size_t o = ((size_t)bd * 256 + chunk) * 1024 + ch;
            HIN[o] = carry; carry = pp[q] * carry + hh[q]; }
    }
}
__device__ __forceinline__ void lru_scan3(KP p) {
    LAUNDER_IDS
    const bf16_t* LOGA = (const bf16_t*)(p->ws + WS_LOGA); const bf16_t* BT = (const bf16_t*)(p->ws + WS_BTERM); const bf16_t* YG = (const bf16_t*)(p->ws + WS_YG);
    const float* HIN = (const float*)(p->ws + WS_HIN); bf16_t* OB = (bf16_t*)(p->ws + WS_OB);
    const int ch = 2 * tidL;
    for (int u = bidL; u < 512; u += gridDim.x) {
        const int chunk = u & 255, b = u >> 8;
        const size_t tok0 = (size_t)b * SEQ + chunk * 32;
        const f32x2 hf = *(const f32x2*)(HIN + ((size_t)(b * 2 + 0) * 256 + chunk) * 1024 + ch), hb = *(const f32x2*)(HIN + ((size_t)(b * 2 + 1) * 256 + chunk) * 1024 + ch);
        float hs0[32], hs1[32]; float h0 = hf[0], h1 = hf[1];
#pragma unroll
        for (int q = 0; q < 32; ++q) { const size_t o = (tok0 + q) * 1024 + ch;
            const unsigned lw = *(const unsigned*)(LOGA + o), bw = *(const unsigned*)(BT + o);
            h0 = fast_exp(bflo(lw)) * h0 + bflo(bw); h1 = fast_exp(bfhi(lw)) * h1 + bfhi(bw); hs0[q] = h0; hs1[q] = h1; }
        h0 = hb[0]; h1 = hb[1];
#pragma unroll
        for (int q = 31; q >= 0; --q) { const size_t o = (tok0 + q) * 1024 + ch;
            const unsigned lw = *(const unsigned*)(LOGA + (size_t)T * 1024 + o), bw = *(const unsigned*)(BT + (size_t)T * 1024 + o), yw = *(const unsigned*)(YG + o);
            h0 = fast_exp(bflo(lw)) * h0 + bflo(bw); h1 = fast_exp(bfhi(lw)) * h1 + bfhi(bw);
            *(unsigned*)(OB + o) = cvt_pk_bf16((hs0[q] + h0) * bflo(yw), (hs1[q] + h1) * bfhi(yw)); }
    }
}

__device__ const unsigned char STAIR[64] = {
    0x00, 0x01, 0x02, 0x03, 0x04, 0x05, 0x06, 0x07, 0x08, 0x09, 0x0a, 0x0b, 0x0c, 0x0d, 0x0e, 0x0f,
    0x10, 0x11, 0x12, 0x13, 0x14, 0x15, 0x16, 0x17, 0x20, 0x21, 0x22, 0x23, 0x24, 0x30, 0x31, 0x32,
    0x33, 0x40, 0x41, 0x42, 0x50, 0x51, 0x60, 0x61, 0x70, 0x71, 0x80, 0x90, 0xa0, 0xb0, 0xc0, 0xd0,
    0xe0, 0xf0, 0, 0, 0, 0, 0, 0, 0, 0, 0, 0, 0, 0, 0, 0};
__device__ __forceinline__ unsigned mono_key(float f) { const unsigned b = __float_as_uint(f); return b ^ ((b >> 31) ? 0xffffffffu : 0x80000000u); }

__device__ __forceinline__ void peer_topk(KP p, LAS unsigned char* lds) {
    LAUNDER_IDS
    const int tid = tidL, wave = tid >> 6, lane = tid & 63;
    const float* scores = (const float*)(p->ws + WS_SCORES);
    int* TOPI = (int*)(p->ws + WS_TOPI); float* TOPG = (float*)(p->ws + WS_TOPG);
    LAS float* SV = (LAS float*)(lds + wave * 256);
    LAS int* SI = (LAS int*)(lds + wave * 256 + 128);
    const unsigned st = STAIR[lane]; const int si = st >> 4, sj = st & 15;
    for (int item = bidL * NWAVE + wave; item < T * 8; item += gridDim.x * NWAVE) {
        const int tok = item >> 3, hd = item & 7;
        const float* sp = scores + (size_t)tok * 2048 + hd * 256;
#pragma unroll
        for (int half = 0; half < 2; ++half) {
            const float a0 = sp[half * 128 + lane], a1 = sp[half * 128 + 64 + lane];
            const unsigned k0 = (mono_key(a0) & ~0x7fu) | (unsigned)lane, k1 = (mono_key(a1) & ~0x7fu) | (unsigned)(lane + 64);
            unsigned r0 = 0, r1 = 0;
#pragma unroll
            for (int jj = 0; jj < 64; ++jj) { const unsigned x0 = __builtin_amdgcn_readlane(k0, jj), x1 = __builtin_amdgcn_readlane(k1, jj);
                r0 += (x0 > k0) + (x1 > k0); r1 += (x0 > k1) + (x1 > k1); }
            if (r0 < 16) { SV[half * 16 + r0] = a0; SI[half * 16 + r0] = lane; }
            if (r1 < 16) { SV[half * 16 + r1] = a1; SI[half * 16 + r1] = lane + 64; }
        }
        asm volatile("s_waitcnt lgkmcnt(0)" ::: "memory");
        const bool valid = lane < 50;
        const float cs = valid ? SV[si] + SV[16 + sj] : 0.f;
        const int id = SI[si] * 128 + SI[16 + sj];
        const unsigned key = valid ? ((mono_key(cs) & ~0x3fu) | (unsigned)lane) : 0u;
        unsigned r = 0;
#pragma unroll
        for (int jj = 0; jj < 50; ++jj) { const unsigned xk = __builtin_amdgcn_readlane(key, jj); r += (xk > key); }
        const bool sel = valid && r < 16;
        const float m = wave_max(sel ? cs : -3.0e38f);
        const float e = sel ? fast_exp(cs - m) : 0.f;
        const float sum = wave_sum(e);
        if (sel) { TOPI[(size_t)tok * 128 + hd * 16 + r] = id; TOPG[(size_t)tok * 128 + hd * 16 + r] = e * fast_rcp(sum); }
        asm volatile("s_waitcnt lgkmcnt(0)" ::: "memory");
    }
}

__device__ __forceinline__ void peer_gather(KP p, int l) {
    LAUNDER_IDS
    const int wave = tidL >> 6, lane = tidL & 63;
    const bf16_t* HB = (const bf16_t*)(p->ws + WS_HBUF); bf16_t* HBW = (bf16_t*)(p->ws + WS_HBUF);
    const int* TOPI = (const int*)(p->ws + WS_TOPI); const float* TOPG = (const float*)(p->ws + WS_TOPG);
    const bf16_t* UT = (const bf16_t*)(p->ws + WS_UTAB) + (size_t)l * 16384 * 1024; const bf16_t* VTb = (const bf16_t*)(p->ws + WS_VTAB) + (size_t)l * 16384 * 1024;
    float* XRES = (float*)(p->ws + WS_XRES); const float* MOD = (const float*)(p->ws + WS_MOD);
    for (int tok = bidL * NWAVE + wave; tok < T; tok += gridDim.x * NWAVE) {
        const int b = tok >> 13;
        float hv[16];
        { const u32x4 h0 = *(const u32x4*)(HB + (size_t)tok * 1024 + 8 * lane), h1 = *(const u32x4*)(HB + (size_t)tok * 1024 + 512 + 8 * lane);
            hv[0] = bflo(h0.x); hv[1] = bfhi(h0.x); hv[2] = bflo(h0.y); hv[3] = bfhi(h0.y); hv[4] = bflo(h0.z); hv[5] = bfhi(h0.z); hv[6] = bflo(h0.w); hv[7] = bfhi(h0.w);
            hv[8] = bflo(h1.x); hv[9] = bfhi(h1.x); hv[10] = bflo(h1.y); hv[11] = bfhi(h1.y); hv[12] = bflo(h1.z); hv[13] = bfhi(h1.z); hv[14] = bflo(h1.w); hv[15] = bfhi(h1.w); }
        const int id0 = TOPI[(size_t)tok * 128 + lane], id1 = TOPI[(size_t)tok * 128 + 64 + lane];
        const float g0 = TOPG[(size_t)tok * 128 + lane], g1 = TOPG[(size_t)tok * 128 + 64 + lane];
        float acc[16];
#pragma unroll
        for (int i = 0; i < 16; ++i) acc[i] = 0.f;
#pragma unroll 1
        for (int e0 = 0; e0 < 128; e0 += 4) {
            u32x4 uu[4][2], vv[4][2]; float gk[4];
#pragma unroll
            for (int k = 0; k < 4; ++k) { const int e = e0 + k;
                int id = __builtin_amdgcn_readlane(e0 < 64 ? id0 : id1, e & 63);
                id &= 16383;
                gk[k] = __uint_as_float(__builtin_amdgcn_readlane(__float_as_uint(e0 < 64 ? g0 : g1), e & 63));
                const bf16_t* up = UT + (size_t)id * 1024 + 8 * lane; const bf16_t* vp = VTb + (size_t)id * 1024 + 8 * lane;
                uu[k][0] = *(const u32x4*)up; uu[k][1] = *(const u32x4*)(up + 512); vv[k][0] = *(const u32x4*)vp; vv[k][1] = *(const u32x4*)(vp + 512); }
            float dt[4];
#pragma unroll
            for (int k = 0; k < 4; ++k) { float d = 0.f;
#pragma unroll
                for (int hh = 0; hh < 2; ++hh) { const u32x4 w = uu[k][hh];
                    d += bflo(w.x) * hv[hh * 8 + 0] + bfhi(w.x) * hv[hh * 8 + 1] + bflo(w.y) * hv[hh * 8 + 2] + bfhi(w.y) * hv[hh * 8 + 3]
                       + bflo(w.z) * hv[hh * 8 + 4] + bfhi(w.z) * hv[hh * 8 + 5] + bflo(w.w) * hv[hh * 8 + 6] + bfhi(w.w) * hv[hh * 8 + 7]; }
                dt[k] = d; }
#pragma unroll
            for (int o = 1; o < 64; o <<= 1) {
#pragma unroll
                for (int k = 0; k < 4; ++k) dt[k] += __shfl_xor(dt[k], o); }
#pragma unroll
            for (int k = 0; k < 4; ++k) { const float cf = gk[k] * gelu_tanh(dt[k]);
#pragma unroll
                for (int hh = 0; hh < 2; ++hh) { const u32x4 w = vv[k][hh];
                    acc[hh * 8 + 0] += cf * bflo(w.x); acc[hh * 8 + 1] += cf * bfhi(w.x); acc[hh * 8 + 2] += cf * bflo(w.y); acc[hh * 8 + 3] += cf * bfhi(w.y);
                    acc[hh * 8 + 4] += cf * bflo(w.z); acc[hh * 8 + 5] += cf * bfhi(w.z); acc[hh * 8 + 6] += cf * bflo(w.w); acc[hh * 8 + 7] += cf * bfhi(w.w); } }
        }
        const float* g2 = MOD + ((size_t)l * 2 + b) * 6144 + 5 * 1024;
        float xn[16]; float ss = 0.f;
#pragma unroll
        for (int hh = 0; hh < 2; ++hh) { const int col = hh * 512 + 8 * lane;
#pragma unroll
            for (int q = 0; q < 2; ++q) { const f32x4 xr = *(const f32x4*)(XRES + (size_t)tok * 1024 + col + 4 * q), gg = *(const f32x4*)(g2 + col + 4 * q);
#pragma unroll
                for (int i = 0; i < 4; ++i) { const float v = xr[i] + gg[i] * acc[hh * 8 + q * 4 + i]; xn[hh * 8 + q * 4 + i] = v; ss += v * v; } } }
        const float inv = __builtin_amdgcn_rsqf(wave_sum(ss) * (1.f / 1024.f) + EPS);
        if (l < DEPTH - 1) {
            const float* gain = p->norm_g + (size_t)(l + 1) * 2 * 1024; const float* sh = MOD + ((size_t)(l + 1) * 2 + b) * 6144; const float* sc = sh + 1024;
#pragma unroll
            for (int hh = 0; hh < 2; ++hh) { const int col = hh * 512 + 8 * lane; float y[8];
#pragma unroll
                for (int q = 0; q < 2; ++q) { const f32x4 gn = *(const f32x4*)(gain + col + 4 * q), s1 = *(const f32x4*)(sh + col + 4 * q), c1 = *(const f32x4*)(sc + col + 4 * q);
                    *(f32x4*)(XRES + (size_t)tok * 1024 + col + 4 * q) = (f32x4){xn[hh * 8 + q * 4], xn[hh * 8 + q * 4 + 1], xn[hh * 8 + q * 4 + 2], xn[hh * 8 + q * 4 + 3]};
#pragma unroll
                    for (int i = 0; i < 4; ++i) y[q * 4 + i] = (xn[hh * 8 + q * 4 + i] * inv) * gn[i] * (1.f + c1[i]) + s1[i]; }
                u32x4 o; o.x = cvt_pk_bf16(y[0], y[1]); o.y = cvt_pk_bf16(y[2], y[3]); o.z = cvt_pk_bf16(y[4], y[5]); o.w = cvt_pk_bf16(y[6], y[7]);
                *(u32x4*)(HBW + (size_t)tok * 1024 + col) = o; }
        } else {
#pragma unroll
            for (int hh = 0; hh < 2; ++hh) { const int col = hh * 512 + 8 * lane;
#pragma unroll
                for (int q = 0; q < 2; ++q) { const f32x4 gn = *(const f32x4*)(p->final_g + col + 4 * q); f32x4 o;
#pragma unroll
                    for (int i = 0; i < 4; ++i) o[i] = (xn[hh * 8 + q * 4 + i] * inv) * gn[i];
                    *(f32x4*)(p->out + (size_t)tok * 1024 + col + 4 * q) = o; } }
        }
    }
}

#define XB_TMO      128
#define XB_XCNT(j)  (256  + 64 * (j))
#define XB_XSUB(j)  (1280 + 64 * (j))
#define XB_XGEN(j)  (2304 + 64 * (j))
#define XB_TOP      3328
#define XB_TOPGEN   3392
#define XCD_BAR_WORDS 3456
#define XB_SPIN_CAP (1u << 18)

__device__ __forceinline__ unsigned xb_ld(unsigned* p)              { return __hip_atomic_load(p, __ATOMIC_RELAXED, __HIP_MEMORY_SCOPE_AGENT); }
__device__ __forceinline__ unsigned xb_add(unsigned* p, unsigned v) { return __hip_atomic_fetch_add(p, v, __ATOMIC_RELAXED, __HIP_MEMORY_SCOPE_AGENT); }
__device__ __forceinline__ unsigned xb_xcc_id() { return (unsigned)__builtin_amdgcn_s_getreg((3 << 11) | 20) & 0xFu; }
#define XB_SPIN(cond, bar) do { unsigned _sp = 0; while (cond) { __builtin_amdgcn_s_sleep(1); \
    if ((++_sp & 255u) == 0u) { if (xb_ld(&(bar)[XB_TMO])) break; if (_sp > XB_SPIN_CAP) { atomicAdd(&(bar)[XB_TMO], 1u); break; } } } } while (0)

struct XcdBarrier {
    unsigned* bar; unsigned x;
    volatile LAS unsigned* st;
};

__device__ __forceinline__ XcdBarrier xcd_barrier_post(unsigned* bar, volatile LAS unsigned* st) {
    XcdBarrier b; b.bar = bar; b.x = xb_xcc_id(); b.st = st;
    if (threadIdx.x == 0) (void)xb_add(&bar[XB_XCNT(b.x)], 1u);
    return b;
}
__device__ __forceinline__ void xcd_barrier_complete(unsigned* bar, unsigned x, unsigned& nloc, unsigned& nx) {
    const unsigned G = gridDim.x * gridDim.y * gridDim.z;
    unsigned sum, cnt, mine, sp = 0u;
    for (;;) {
        sum = 0u; cnt = 0u; mine = 0u;
#pragma unroll
        for (unsigned j = 0; j < 16; ++j) { const unsigned c = xb_ld(&bar[XB_XCNT(j)]); sum += c; cnt += (c > 0u) ? 1u : 0u; mine = (j == x) ? c : mine; }
        if (sum == G) break;
        __builtin_amdgcn_s_sleep(1);
        if ((++sp & 255u) == 0u) { if (xb_ld(&bar[XB_TMO])) break; if (sp > XB_SPIN_CAP) { atomicAdd(&bar[XB_TMO], 1u); break; } }
    }
    nloc = mine > 0u ? mine : 1u; nx = cnt > 0u ? cnt : 1u;
}

__device__ __forceinline__ void xcd_barrier(const XcdBarrier& b) {
    asm volatile("s_waitcnt vmcnt(0)" ::: "memory");
    __syncthreads();
    if (threadIdx.x == 0) {
        unsigned* bar = b.bar;
        __builtin_amdgcn_s_waitcnt(0);
        unsigned nloc = b.st[0], nx = b.st[1];
        if (nloc == 0u) { xcd_barrier_complete(bar, b.x, nloc, nx); b.st[0] = nloc; b.st[1] = nx; }
        const unsigned old = xb_add(&bar[XB_XSUB(b.x)], 1u);
        const unsigned gen = old / nloc;
        if (old + 1u == (gen + 1u) * nloc) {
            __builtin_amdgcn_fence(__ATOMIC_RELEASE, "agent");
            asm volatile("s_waitcnt vmcnt(0)" ::: "memory");
            const unsigned og = xb_add(&bar[XB_TOP], 1u);
            const unsigned tg = og / nx;
            if (og + 1u == (tg + 1u) * nx) xb_add(&bar[XB_TOPGEN], 1u);
            else XB_SPIN(xb_ld(&bar[XB_TOPGEN]) == tg, bar);
            __builtin_amdgcn_fence(__ATOMIC_ACQUIRE, "agent");
            xb_add(&bar[XB_XGEN(b.x)], 1u);
            asm volatile("s_waitcnt vmcnt(0)" ::: "memory");
        } else {
            XB_SPIN(xb_ld(&bar[XB_XGEN(b.x)]) == gen, bar);
            __builtin_amdgcn_fence(__ATOMIC_ACQUIRE, "agent");
            asm volatile("s_waitcnt vmcnt(0)" ::: "memory");
        }
    }
    __syncthreads();
}

#ifndef OPMASK
#define OPMASK 0xFFFFFFFFu
#endif
#define EN(o) ((OPMASK >> (o)) & 1u)
enum { OP_P0 = 0, OP_RMS1, OP_HG_IN, OP_HG_A, OP_HG_B, OP_HG_C, OP_MIX_OUT, OP_LR_IN, OP_LR_CONV, OP_LR_G, OP_LR_S1, OP_LR_S2, OP_LR_S3, OP_RMS2, OP_QK, OP_TOPK, OP_GATHER };
constexpr int NPH = 42;
__device__ __forceinline__ void decode_phase(int ph, int& l, int& op) {
    if (ph == 0) { l = 0; op = OP_P0; return; }
    if (ph == 1) { l = 0; op = OP_RMS1; return; }
    int q = ph - 2;
    if (q < 9) { l = 0; } else if (q < 20) { l = 1; q -= 9; } else if (q < 29) { l = 2; q -= 20; } else { l = 3; q -= 29; }
    if ((l & 1) == 0) { op = q == 0 ? OP_HG_IN : q == 1 ? OP_HG_A : q == 2 ? OP_HG_B : q == 3 ? OP_HG_C : q == 4 ? OP_MIX_OUT : q == 5 ? OP_RMS2 : q == 6 ? OP_QK : q == 7 ? OP_TOPK : OP_GATHER; }
    else { op = q == 0 ? OP_LR_IN : q == 1 ? OP_LR_CONV : q == 2 ? OP_LR_G : q == 3 ? OP_LR_S1 : q == 4 ? OP_LR_S2 : q == 5 ? OP_LR_S3 : q == 6 ? OP_MIX_OUT : q == 7 ? OP_RMS2 : q == 8 ? OP_QK : q == 9 ? OP_TOPK : OP_GATHER; }
}

__global__ __launch_bounds__(512, 2) void mk_fwd(Params p_arg) {
    extern __shared__ __attribute__((aligned(16))) unsigned char shm[];
    LAS unsigned char* lds = (LAS unsigned char*)shm;
    cg::grid_group grid = cg::this_grid();
    unsigned long long kpv = (unsigned long long)__builtin_amdgcn_kernarg_segment_ptr();
    const int ph_lo = p_arg.ph_lo, ph_hi = p_arg.ph_hi;
    volatile LAS unsigned* xst = (volatile LAS unsigned*)(lds + LDS_BYTES - 16);
    if (threadIdx.x == 0) { xst[0] = 0u; xst[1] = 0u; }
    __syncthreads();
    const XcdBarrier xb = xcd_barrier_post((unsigned*)(p_arg.ws + WS_CTL) + 1024, xst);
    for (int ph = ph_lo; ph < ph_hi; ++ph) {
        if (ph > ph_lo) { if (ph == 1) grid.sync(); else xcd_barrier(xb); }
        asm volatile("" : "+s"(kpv));
        KP p = (KP)kpv;
        unsigned char* ws = p->ws;
        const float* MOD = (const float*)(ws + WS_MOD);
        int l, op; decode_phase(ph, l, op);
        const int j = l >> 1;
#ifdef ONLY
        switch (ONLY) {
#else
        switch (op) {
#endif
        case OP_P0: if (EN(OP_P0)) phase0(p, lds); break;
        case OP_RMS1: if (EN(OP_RMS1)) phase_rms(p->x, p->norm_g, MOD, MOD + 1024, (bf16_t*)(ws + WS_HBUF)); break;
        case OP_HG_IN: if (EN(OP_HG_IN)) { EpiBf16 E; E.O = (bf16_t*)(ws + WS_PROJ); E.ldc = 5120;
            run_gemm(lds, (const bf16_t*)(ws + WS_HBUF), (const bf16_t*)(ws + WS_HGWIN) + (size_t)j * 5120 * 1024, 5120, 1024, 1024, 1024, 0, 0, E); } break;
        case OP_HG_A: if (EN(OP_HG_A)) hg_pass_a(p, lds, j); break;
        case OP_HG_B: if (EN(OP_HG_B)) hg_pass_b(p); break;
        case OP_HG_C: if (EN(OP_HG_C)) hg_pass_c(p, lds, j); break;
        case OP_MIX_OUT: if (EN(OP_MIX_OUT)) { EpiResid E; E.xin = (l == 0) ? p->x : (const float*)(ws + WS_XRES); E.xout = (float*)(ws + WS_XRES); E.gate = MOD + (size_t)l * 2 * 6144 + 2 * 1024;
            const bf16_t* W = (l & 1) ? (const bf16_t*)(ws + WS_LRWOUT) + (size_t)j * 1024 * 1024 : (const bf16_t*)(ws + WS_HGWOUT) + (size_t)j * 1024 * 1024;
            run_gemm(lds, (const bf16_t*)(ws + WS_OB), W, 1024, 1024, 1024, 1024, 0, 0, E); } break;
        case OP_LR_IN: if (EN(OP_LR_IN)) { EpiLruIn E; E.XB = (bf16_t*)(ws + WS_XB); E.YG = (bf16_t*)(ws + WS_YG);
            run_gemm(lds, (const bf16_t*)(ws + WS_HBUF), (const bf16_t*)(ws + WS_LRWIN) + (size_t)j * 2048 * 1024, 2048, 1024, 1024, 1024, 0, 0, E); } break;
        case OP_LR_CONV: if (EN(OP_LR_CONV)) lru_conv(p, j); break;
        case OP_LR_G: if (EN(OP_LR_G)) { EpiGates E; E.LOGA = (bf16_t*)(ws + WS_LOGA); E.BTERM = (bf16_t*)(ws + WS_BTERM); E.XC = (const bf16_t*)(ws + WS_XC);
            E.b_a = p->lru_b_a + (size_t)j * 2048; E.b_x = p->lru_b_x + (size_t)j * 2048; E.lam = p->lru_lam + (size_t)j * 2048;
            run_gemm(lds, (const bf16_t*)(ws + WS_XC), (const bf16_t*)(ws + WS_LRWG) + (size_t)j * 4 * 1024 * 256, 4096, 256, 1024, 256, 2, 512, E); } break;
        case OP_LR_S1: if (EN(OP_LR_S1)) lru_scan1(p); break;
        case OP_LR_S2: if (EN(OP_LR_S2)) lru_scan2(p); break;
        case OP_LR_S3: if (EN(OP_LR_S3)) lru_scan3(p); break;
        case OP_RMS2: if (EN(OP_RMS2)) phase_rms((const float*)(ws + WS_XRES), p->norm_g + ((size_t)l * 2 + 1) * 1024, MOD + (size_t)l * 2 * 6144 + 3 * 1024, MOD + (size_t)l * 2 * 6144 + 4 * 1024, (bf16_t*)(ws + WS_HBUF)); break;
        case OP_QK: if (EN(OP_QK)) { EpiF32 E; E.C = (float*)(ws + WS_SCORES); E.ldc = 2048;
            run_gemm(lds, (const bf16_t*)(ws + WS_HBUF), (const bf16_t*)(ws + WS_WQK) + (size_t)l * 2048 * 1024, 2048, 1024, 1024, 1024, 0, 0, E); } break;
        case OP_TOPK: if (EN(OP_TOPK)) peer_topk(p, lds); break;
        case OP_GATHER: if (EN(OP_GATHER)) peer_gather(p, l); break;
        default: break;
        }
    }
}

extern "C" void kernel_launch(void* const* d_in, const int* in_sizes, int n_in, void* d_out, int out_size, void* d_ws, size_t ws_size, hipStream_t stream) {
    static int grid = 0;
    if (grid == 0) {
        if (n_in != 23 || ws_size < WS_END) { fprintf(stderr, "kernel_launch: unexpected n_in %d / ws_size %zu (need %zu)\n", n_in, ws_size, (size_t)WS_END); grid = -1; return; }
        int dev = 0, cus = 0, per_cu = 0;
        hipGetDevice(&dev); hipDeviceGetAttribute(&cus, hipDeviceAttributeMultiprocessorCount, dev);
        if (hipFuncSetAttribute((const void*)mk_fwd, hipFuncAttributeMaxDynamicSharedMemorySize, LDS_BYTES) != hipSuccess) { fprintf(stderr, "kernel_launch: hipFuncSetAttribute failed\n"); grid = -1; return; }
        if (hipOccupancyMaxActiveBlocksPerMultiprocessor(&per_cu, (const void*)mk_fwd, NTHR, LDS_BYTES) != hipSuccess || per_cu < 1) { fprintf(stderr, "kernel_launch: occupancy query failed (%d)\n", per_cu); (void)hipGetLastError(); per_cu = 1; }
        grid = cus * 1;
        fprintf(stderr, "kernel_launch: cus %d per_cu %d grid %d\n", cus, per_cu, grid);
    }
    if (grid < 0) return;
    if (hipMemsetAsync((char*)d_ws + WS_CTL, 0, 65536, stream) != hipSuccess) { fprintf(stderr, "kernel_launch: memset failed\n"); return; }
    Params p{};
    const float** pp = (const float**)&p;
    for (int i = 0; i < 23; ++i) pp[i] = (const float*)d_in[i];
    p.out = (float*)d_out; p.ws = (unsigned char*)d_ws; p.ph_lo = 0; p.ph_hi = NPH;
    void* args[] = {&p};
    hipError_t e = hipLaunchCooperativeKernel((const void*)mk_fwd, dim3(grid), dim3(NTHR), args, LDS_BYTES, stream);
    if (e != hipSuccess) fprintf(stderr, "kernel_launch: cooperative launch failed: %s (grid %d)\n", hipGetErrorString(e), grid);
}
```

```cpp
#include <hip/hip_runtime.h>
#include <hip/hip_cooperative_groups.h>
#include <cstdio>
#include <cstdint>
namespace cg = cooperative_groups;

#define LAS __attribute__((address_space(3)))
#define PG8_LAS __attribute__((address_space(3)))
typedef unsigned short bf16_t;
typedef short bf16x8 __attribute__((ext_vector_type(8)));
typedef float f32x4 __attribute__((ext_vector_type(4)));
typedef float f32x2 __attribute__((ext_vector_type(2)));
typedef unsigned u32x4 __attribute__((ext_vector_type(4)));
typedef unsigned u32x2 __attribute__((ext_vector_type(2)));

constexpr int T = 16384, D = 1024, SEQ = 8192, DEPTH = 4;
constexpr float EPS = 1e-6f;
constexpr int NBLK = 256, NTHR = 512, NWAVE = 8, NGW = NBLK * NWAVE;

constexpr size_t MiB = 1u << 20;
constexpr size_t WS_CTL = 0;
constexpr size_t WS_MOD = 1 * MiB;
constexpr size_t WS_HGWIN = 2 * MiB;
constexpr size_t WS_HGWOUT = 22 * MiB;
constexpr size_t WS_LRWIN = 26 * MiB;
constexpr size_t WS_LRWG = 34 * MiB;
constexpr size_t WS_LRWOUT = 38 * MiB;
constexpr size_t WS_WQK = 42 * MiB;
constexpr size_t WS_TOPI = 58 * MiB;
constexpr size_t WS_TOPG = 66 * MiB;
constexpr size_t WS_DEC = 74 * MiB;
constexpr size_t WS_CP = 75 * MiB;
constexpr size_t WS_CH = 79 * MiB;
constexpr size_t WS_HIN = 83 * MiB;
constexpr size_t WS_XRES = 88 * MiB;
constexpr size_t WS_HBUF = 152 * MiB;
constexpr size_t WS_OB = 184 * MiB;
constexpr size_t WS_PROJ = 216 * MiB;
constexpr size_t WS_XB = WS_PROJ, WS_YG = WS_PROJ + 32 * MiB, WS_XC = WS_PROJ + 64 * MiB, WS_LOGA = WS_PROJ + 96 * MiB;
constexpr size_t WS_SCORES = WS_PROJ;
constexpr size_t WS_KV = 376 * MiB;
constexpr size_t WS_BTERM = WS_KV;
constexpr size_t WS_SIN = 504 * MiB;
constexpr size_t WS_UTAB = 568 * MiB;
constexpr size_t WS_VTAB = 696 * MiB;
constexpr size_t WS_END = 824 * MiB;

constexpr int LDS_BYTES = 155648;

#define LAUNDER_IDS int tidL = threadIdx.x, bidL = blockIdx.x; asm volatile("" : "+v"(tidL)); asm volatile("" : "+s"(bidL));
__device__ __forceinline__ float bf2f(bf16_t b) { return __uint_as_float(((unsigned)b) << 16); }
__device__ __forceinline__ float bflo(unsigned u) { return __uint_as_float(u << 16); }
__device__ __forceinline__ float bfhi(unsigned u) { return __uint_as_float(u & 0xffff0000u); }
__device__ __forceinline__ unsigned cvt_pk_bf16(float lo, float hi) { unsigned r; asm volatile("v_cvt_pk_bf16_f32 %0, %1, %2" : "=v"(r) : "v"(lo), "v"(hi)); return r; }
__device__ __forceinline__ bf16_t f2bf(float f) { return (bf16_t)(cvt_pk_bf16(f, 0.f) & 0xffffu); }
__device__ __forceinline__ float fast_exp(float x) { return __builtin_amdgcn_exp2f(x * 1.4426950408889634f); }
__device__ __forceinline__ float fast_log(float x) { return __builtin_amdgcn_logf(x) * 0.6931471805599453f; }
__device__ __forceinline__ float fast_rcp(float x) { return __builtin_amdgcn_rcpf(x); }
__device__ __forceinline__ float sigmoidf_(float x) { return fast_rcp(1.f + fast_exp(-x)); }
__device__ __forceinline__ float gelu_tanh(float x) { const float u = 1.5957691216057308f * (x + 0.044715f * x * x * x); return x * fast_rcp(1.f + fast_exp(-u)); }
__device__ __forceinline__ float silu_(float x) { return x * sigmoidf_(x); }
__device__ __forceinline__ float wave_sum(float v) {
#pragma unroll
    for (int o = 1; o < 64; o <<= 1) v += __shfl_xor(v, o);
    return v;
}
__device__ __forceinline__ float wave_max(float v) {
#pragma unroll
    for (int o = 1; o < 64; o <<= 1) v = fmaxf(v, __shfl_xor(v, o));
    return v;
}

namespace pg8 {
constexpr int BM = 256, BK = 64, HALF = 128, HTB = HALF * BK * 2, STAGE_BYTES = 8 * HTB, NXCD = 8, WGM = 8;
__host__ __device__ __forceinline__ int lds_byte(int r, int c) { const int st = (r >> 4) * 2 + (c >> 5), rr = r & 15, cc = c & 31, ob = rr * 64 + cc * 2; return st * 1024 + (ob ^ (((ob >> 9) & 1) << 5)); }
__host__ __device__ __forceinline__ void stage_rc(int b, int& R, int& C) { const int st = b / 1024, sb = b % 1024, swz = sb ^ (((sb >> 9) & 1) << 5); R = (st >> 1) * 16 + swz / 64; C = (st & 1) * 32 + (swz % 64) / 2; }
__host__ __device__ __forceinline__ int perm32(int rho) { const int n = rho >> 4, i = rho & 15; return 8 * (i >> 2) + 4 * n + (i & 3); }
struct Unit { int pm, pn; };
struct Gemm { const bf16_t* A; const bf16_t* Bt; int M, N, K, lda, ldb, a_pn_shift, a_pn_stride; };
struct StaticOrder {
    int nM, nN, nwg, G, c;
    __host__ __device__ void init(int M, int N, int G_, int c_) { nM = M / BM; nN = N / BM; nwg = nM * nN; G = G_; c = c_; }
    __host__ __device__ bool next(int i, Unit& u) const {
        const long L = (long)i * G + c; if (L >= nwg) return false;
        int wgid = (int)L; { const int q = nwg / NXCD, r = nwg % NXCD, xcd = wgid % NXCD, off = wgid / NXCD; wgid = (xcd < r ? xcd * (q + 1) : r * (q + 1) + (xcd - r) * q) + off; }
        const int nig = WGM * nN, gid = wgid / nig, fm = gid * WGM, gsz = (nM - fm) < WGM ? (nM - fm) : WGM;
        u.pm = fm + ((wgid % nig) % gsz); u.pn = (wgid % nig) / gsz; return true;
    }
    __device__ __forceinline__ void a_ready(const Unit&) const {}
    __device__ __forceinline__ void done(const Unit&) const {}
};
template <class Epi, class Sched, bool STAMP = false>
__device__ __forceinline__ void gemm_phase(PG8_LAS unsigned char* lds, const Gemm g, const Sched& S, const Epi& E, unsigned long long* stamps) {
    int tid = threadIdx.x; asm volatile("" : "+v"(tid)); const int wid = __builtin_amdgcn_readfirstlane(tid >> 6), lane = tid & 63, wr = wid >> 2, wc = wid & 3, fr = lane & 15, fq = lane >> 4;
    const int K = g.K, nt = K / BK;
    int ts_lo = 0, ts_hi = 0, nts = 0; const unsigned long long rt_entry = STAMP ? (unsigned long long)wall_clock64() : 0ull;
#define PG8_STAMP() do { if (STAMP && wid == 0 && nts < 64) { const unsigned long long _c = (unsigned long long)clock64(); \
        ts_lo = (lane == nts) ? (int)(unsigned)_c : ts_lo; ts_hi = (lane == nts) ? (int)(unsigned)(_c >> 32) : ts_hi; ++nts; } } while (0)
    PG8_STAMP();
    unsigned voffA[2], voffB[2];
#pragma unroll
    for (int i = 0; i < 2; ++i) { int R, C; stage_rc(tid * 16 + i * 8192, R, C); const int Rb = Epi::PERM ? ((R & ~31) + perm32(R & 31)) : R;
        voffA[i] = (unsigned)(R * g.lda + C) * 2u; voffB[i] = (unsigned)(Rb * g.ldb + C) * 2u; }
    const size_t kstep = (size_t)(BK * 2);
    const size_t hstepA = (size_t)HALF * g.lda * 2, hstepB = (size_t)HALF * g.ldb * 2;
    const size_t tstepA = 2 * hstepA, tstepB = 2 * hstepB;
    const unsigned ldsw = (unsigned)wid * 1024u;
    const int aoff = lds_byte(wr * 64 + fr, fq * 8), boff = lds_byte(wc * 32 + fr, fq * 8);
#define PG8_SA(b, h) (((b) * 2 + (h)) * HTB)
#define PG8_SB(b, h) ((4 + (b) * 2 + (h)) * HTB)
#define PG8_STAGE(bufoff, gbase, voff) do { _Pragma("unroll") for (int _i = 0; _i < 2; ++_i) \
        __builtin_amdgcn_global_load_lds((const unsigned*)((const char*)(gbase) + (voff)[_i]), (PG8_LAS unsigned*)(lds + (bufoff) + ldsw + _i * 8192), 16, 0, 0); } while (0)
#define PG8_LDA(dst, b, h) do { _Pragma("unroll") for (int m = 0; m < 4; ++m) _Pragma("unroll") for (int k = 0; k < 2; ++k) dst[m][k] = *(const PG8_LAS bf16x8*)(lds + PG8_SA(b, h) + aoff + m * 2048 + k * 1024); } while (0)
#define PG8_LDB(dst, b, h) do { _Pragma("unroll") for (int n = 0; n < 2; ++n) _Pragma("unroll") for (int k = 0; k < 2; ++k) dst[n][k] = *(const PG8_LAS bf16x8*)(lds + PG8_SB(b, h) + boff + n * 2048 + k * 1024); } while (0)
#define PG8_MMA(ai, bj, At, Bt) do { __builtin_amdgcn_s_setprio(1); _Pragma("unroll") for (int m = 0; m < 4; ++m) _Pragma("unroll") for (int n = 0; n < 2; ++n) _Pragma("unroll") for (int k = 0; k < 2; ++k) \
        acc[ai][bj][m][n] = Epi::SWAP ? __builtin_amdgcn_mfma_f32_16x16x32_bf16(At[m][k], Bt[n][k], acc[ai][bj][m][n], 0, 0, 0) : __builtin_amdgcn_mfma_f32_16x16x32_bf16(Bt[n][k], At[m][k], acc[ai][bj][m][n], 0, 0, 0); __builtin_amdgcn_s_setprio(0); } while (0)
#define PG8_WAIT_V(n) asm volatile("s_waitcnt vmcnt(" #n ")" ::: "memory")
#define PG8_WAIT_L(n) asm volatile("s_waitcnt lgkmcnt(" #n ")" ::: "memory")
#define PG8_BAR __builtin_amdgcn_s_barrier()
#define PG8_SCHED __builtin_amdgcn_sched_barrier(0)
    Unit cur, nxt; int ui = 0;
    if (!S.next(0, cur)) return;
    f32x4 acc[2][2][4][2];
#pragma unroll
    for (int a = 0; a < 2; ++a)
#pragma unroll
        for (int b = 0; b < 2; ++b)
#pragma unroll
            for (int m = 0; m < 4; ++m)
#pragma unroll
                for (int n = 0; n < 2; ++n) acc[a][b][m][n] = (f32x4){0.f, 0.f, 0.f, 0.f};
    bf16x8 At[4][2], B0[2][2], B1[2][2];
    const char* cA = (const char*)g.A + (size_t)cur.pm * tstepA + (size_t)(cur.pn >> g.a_pn_shift) * g.a_pn_stride; const char* cB = (const char*)g.Bt + (size_t)cur.pn * tstepB;
    S.a_ready(cur);
    PG8_STAGE(PG8_SB(0, 0), cB, voffB); PG8_STAGE(PG8_SA(0, 0), cA, voffA); PG8_STAGE(PG8_SB(0, 1), cB + hstepB, voffB); PG8_STAGE(PG8_SA(0, 1), cA + hstepA, voffA);
    if (wr == 1) PG8_BAR;
    PG8_WAIT_V(4); PG8_BAR;
    PG8_STAGE(PG8_SB(1, 0), cB + kstep, voffB); PG8_STAGE(PG8_SA(1, 0), cA + kstep, voffA); PG8_STAGE(PG8_SB(1, 1), cB + hstepB + kstep, voffB);
    PG8_WAIT_V(6); PG8_BAR;
    PG8_STAMP();
    for (;;) {
        const bool has_next = S.next(ui + 1, nxt);
        const char* nA = has_next ? (const char*)g.A + (size_t)nxt.pm * tstepA + (size_t)(nxt.pn >> g.a_pn_shift) * g.a_pn_stride : cA; const char* nB = has_next ? (const char*)g.Bt + (size_t)nxt.pn * tstepB : cB;
#pragma unroll 1
        for (int t = 0; t < nt; t += 2) {
            const bool last = (t == nt - 2);
            const char* a1 = cA + (size_t)(t + 1) * kstep;
            const char* a2 = last ? nA : cA + (size_t)(t + 2) * kstep; const char* b2 = last ? nB : cB + (size_t)(t + 2) * kstep;
            const char* a3 = a2 + kstep; const char* b3 = b2 + kstep;
            if (last && has_next) S.a_ready(nxt);
            PG8_LDB(B0, 0, 0); PG8_SCHED; PG8_LDA(At, 0, 0); PG8_STAGE(PG8_SA(1, 1), a1 + hstepA, voffA);
            PG8_WAIT_L(8); PG8_BAR; PG8_WAIT_L(0); PG8_MMA(0, 0, At, B0); PG8_BAR; PG8_SCHED;
            PG8_LDB(B1, 0, 1); PG8_STAGE(PG8_SB(0, 0), b2, voffB);
            PG8_BAR; PG8_WAIT_L(0); PG8_MMA(0, 1, At, B1); PG8_BAR;
            PG8_LDA(At, 0, 1); PG8_STAGE(PG8_SA(0, 0), a2, voffA);
            PG8_BAR; PG8_WAIT_L(0); PG8_MMA(1, 0, At, B0); PG8_BAR; PG8_SCHED;
            PG8_STAGE(PG8_SB(0, 1), b2 + hstepB, voffB);
            PG8_WAIT_V(6); PG8_BAR; PG8_MMA(1, 1, At, B1); PG8_BAR;
            PG8_LDB(B0, 1, 0); PG8_SCHED; PG8_LDA(At, 1, 0); PG8_STAGE(PG8_SA(0, 1), a2 + hstepA, voffA);
            PG8_WAIT_L(8); PG8_BAR; PG8_WAIT_L(0); PG8_MMA(0, 0, At, B0); PG8_BAR; PG8_SCHED;
            PG8_LDB(B1, 1, 1); PG8_STAGE(PG8_SB(1, 0), b3, voffB);
            PG8_BAR; PG8_WAIT_L(0); PG8_MMA(0, 1, At, B1); PG8_BAR;
            PG8_LDA(At, 1, 1); PG8_STAGE(PG8_SA(1, 0), a3, voffA);
            PG8_BAR; PG8_WAIT_L(0); PG8_MMA(1, 0, At, B0); PG8_BAR; PG8_SCHED;
            PG8_STAGE(PG8_SB(1, 1), b3 + hstepB, voffB);
            PG8_WAIT_V(6); PG8_BAR; PG8_MMA(1, 1, At, B1); PG8_BAR;
        }
        PG8_STAMP();
        if constexpr (!Epi::AFTER_DRAIN) { E(acc, cur, wr, wc, fr, fq); S.done(cur); }
        PG8_STAMP();
        if (!has_next) break;
#pragma unroll
        for (int a = 0; a < 2; ++a)
#pragma unroll
            for (int b = 0; b < 2; ++b)
#pragma unroll
                for (int m = 0; m < 4; ++m)
#pragma unroll
                    for (int n = 0; n < 2; ++n) acc[a][b][m][n] = (f32x4){0.f, 0.f, 0.f, 0.f};
        cur = nxt; cA = nA; cB = nB; ++ui;
    }
    PG8_WAIT_V(0);
    if (wr == 0) PG8_BAR;
    PG8_BAR;
    if constexpr (Epi::AFTER_DRAIN) { E.fused(acc, cur, wr, wc, fr, fq, lds, wid, lane); S.done(cur); }
    PG8_STAMP();
    if (STAMP && wid == 0) { stamps[lane] = lane < nts ? (((unsigned long long)(unsigned)ts_hi << 32) | (unsigned)ts_lo) : 0ull;
        if (lane == 62) stamps[62] = rt_entry; if (lane == 63) stamps[63] = (unsigned long long)wall_clock64(); }
#undef PG8_STAMP
#undef PG8_SA
#undef PG8_SB
#undef PG8_STAGE
#undef PG8_LDA
#undef PG8_LDB
#undef PG8_MMA
#undef PG8_WAIT_V
#undef PG8_WAIT_L
#undef PG8_BAR
#undef PG8_SCHED
}
}
using pg8::Unit;

struct EpiBf16 {
    static constexpr bool PERM = true, AFTER_DRAIN = false, SWAP = false;
    bf16_t* O; int ldc;
    __device__ __forceinline__ void operator()(const f32x4 (&acc)[2][2][4][2], const Unit& u, int wr, int wc, int fr, int fq) const {
        const int row0 = u.pm * 256 + wr * 64 + fr, col0 = u.pn * 256 + wc * 32 + 8 * fq;
#pragma unroll
        for (int ai = 0; ai < 2; ++ai)
#pragma unroll
            for (int m = 0; m < 4; ++m) { bf16_t* rowp = O + (size_t)(row0 + ai * 128 + m * 16) * ldc + col0;
#pragma unroll
                for (int bj = 0; bj < 2; ++bj) { const f32x4 v0 = acc[ai][bj][m][0], v1 = acc[ai][bj][m][1];
                    u32x4 o; o.x = cvt_pk_bf16(v0[0], v0[1]); o.y = cvt_pk_bf16(v0[2], v0[3]); o.z = cvt_pk_bf16(v1[0], v1[1]); o.w = cvt_pk_bf16(v1[2], v1[3]);
                    *(u32x4*)(rowp + bj * 128) = o; } }
    }
};
struct EpiLruIn {
    static constexpr bool PERM = true, AFTER_DRAIN = false, SWAP = false;
    bf16_t* XB; bf16_t* YG;
    __device__ __forceinline__ void operator()(const f32x4 (&acc)[2][2][4][2], const Unit& u, int wr, int wc, int fr, int fq) const {
        const bool isy = u.pn >= 4;
        bf16_t* O = isy ? YG : XB;
        const int row0 = u.pm * 256 + wr * 64 + fr, col0 = (u.pn & 3) * 256 + wc * 32 + 8 * fq;
#pragma unroll
        for (int ai = 0; ai < 2; ++ai)
#pragma unroll
            for (int m = 0; m < 4; ++m) { bf16_t* rowp = O + (size_t)(row0 + ai * 128 + m * 16) * 1024 + col0;
#pragma unroll
                for (int bj = 0; bj < 2; ++bj) { f32x4 v0 = acc[ai][bj][m][0], v1 = acc[ai][bj][m][1];
                    if (isy) {
#pragma unroll
                        for (int i = 0; i < 4; ++i) { v0[i] = gelu_tanh(v0[i]); v1[i] = gelu_tanh(v1[i]); } }
                    u32x4 o; o.x = cvt_pk_bf16(v0[0], v0[1]); o.y = cvt_pk_bf16(v0[2], v0[3]); o.z = cvt_pk_bf16(v1[0], v1[1]); o.w = cvt_pk_bf16(v1[2], v1[3]);
                    *(u32x4*)(rowp + bj * 128) = o; } }
    }
};
struct EpiGates {
    static constexpr bool PERM = true, AFTER_DRAIN = false, SWAP = false;
    bf16_t* LOGA; bf16_t* BTERM; const bf16_t* XC; const float* b_a; const float* b_x; const float* lam;
    __device__ __forceinline__ void operator()(const f32x4 (&acc)[2][2][4][2], const Unit& u, int wr, int wc, int fr_, int fq) const {
        int fr = fr_; asm volatile("" : "+v"(fr));
        const int nblk = u.pn >> 2, uu = u.pn & 3, d = uu >> 1, jh = uu & 1;
        const int colbase = nblk * 256 + jh * 128 + wc * 32 + 8 * fq;
        const unsigned off0 = (unsigned)(u.pm * 256 + wr * 64 + fr) * 1024u + (unsigned)colbase;
        const bf16_t* xcp = XC; bf16_t* lap = LOGA + (size_t)d * T * 1024; bf16_t* btp = BTERM + (size_t)d * T * 1024;
        const float* bap = b_a + d * 1024; const float* bxp = b_x + d * 1024; const float* lmp = lam + d * 1024;
#pragma unroll
        for (int ai = 0; ai < 2; ++ai)
#pragma unroll
            for (int m = 0; m < 4; ++m) { const unsigned off = off0 + (unsigned)(ai * 128 + m * 16) * 1024u;
                asm volatile("" ::: "memory"); __builtin_amdgcn_sched_barrier(0);
                const u32x4 xr = *(const u32x4*)(xcp + off);
                const float xv[8] = {bflo(xr.x), bfhi(xr.x), bflo(xr.y), bfhi(xr.y), bflo(xr.z), bfhi(xr.z), bflo(xr.w), bfhi(xr.w)};
                unsigned o1[4], o2[4];
#pragma unroll
                for (int n = 0; n < 2; ++n) { const f32x4 ba = *(const f32x4*)(bap + (unsigned)(colbase + 4 * n)), bx = *(const f32x4*)(bxp + (unsigned)(colbase + 4 * n)), lm = *(const f32x4*)(lmp + (unsigned)(colbase + 4 * n));
                    float la[4], bt[4];
#pragma unroll
                    for (int i = 0; i < 4; ++i) { const float r = sigmoidf_(acc[ai][0][m][n][i] + ba[i]), ig = sigmoidf_(acc[ai][1][m][n][i] + bx[i]);
                        const float l = -8.f * fast_log(1.f + fast_exp(-lm[i])) * r; const float mult = __builtin_sqrtf(fmaxf(1.f - fast_exp(2.f * l), 0.f));
                        la[i] = l; bt[i] = mult * ig * xv[n * 4 + i]; }
                    o1[n * 2] = cvt_pk_bf16(la[0], la[1]); o1[n * 2 + 1] = cvt_pk_bf16(la[2], la[3]); o2[n * 2] = cvt_pk_bf16(bt[0], bt[1]); o2[n * 2 + 1] = cvt_pk_bf16(bt[2], bt[3]); }
                *(u32x4*)(lap + off) = (u32x4){o1[0], o1[1], o1[2], o1[3]}; *(u32x4*)(btp + off) = (u32x4){o2[0], o2[1], o2[2], o2[3]}; }
    }
};
struct EpiResid {
    static constexpr bool PERM = false, AFTER_DRAIN = false, SWAP = false;
    const float* xin; float* xout; const float* gate; bool dry;
    __device__ __forceinline__ void operator()(const f32x4 (&acc)[2][2][4][2], const Unit& u, int wr, int wc, int fr, int fq) const {
        const int row0 = u.pm * 256 + wr * 64 + fr, col0 = u.pn * 256 + wc * 32 + 4 * fq;
        const float* gp = gate + ((u.pm * 256) >> 13) * 6144 + col0;
        f32x4 gv[2][2];
#pragma unroll
        for (int bj = 0; bj < 2; ++bj)
#pragma unroll
            for (int n = 0; n < 2; ++n) gv[bj][n] = *(const f32x4*)(gp + bj * 128 + n * 16);
#pragma unroll
        for (int ai = 0; ai < 2; ++ai)
#pragma unroll
            for (int m = 0; m < 4; ++m) { const size_t off = (size_t)(row0 + ai * 128 + m * 16) * 1024 + col0;
#pragma unroll
                for (int bj = 0; bj < 2; ++bj)
#pragma unroll
                    for (int n = 0; n < 2; ++n) { const f32x4 xv = *(const f32x4*)(xin + off + bj * 128 + n * 16);
                        if (!dry) *(f32x4*)(xout + off + bj * 128 + n * 16) = xv + gv[bj][n] * acc[ai][bj][m][n]; } }
    }
};
struct EpiScoresT {
    static constexpr bool PERM = false, AFTER_DRAIN = false, SWAP = true;
    float* C;
    __device__ __forceinline__ void operator()(const f32x4 (&acc)[2][2][4][2], const Unit& u, int wr, int wc, int fr_, int fq) const {
        int fr = fr_; asm volatile("" : "+v"(fr));
        const unsigned off0 = (unsigned)(u.pn * 256 + wc * 32 + fr) * (unsigned)T + (unsigned)(u.pm * 256 + wr * 64 + 4 * fq);
#pragma unroll
        for (int ai = 0; ai < 2; ++ai)
#pragma unroll
            for (int m = 0; m < 4; ++m)
#pragma unroll
                for (int bj = 0; bj < 2; ++bj)
#pragma unroll
                    for (int n = 0; n < 2; ++n) *(f32x4*)(C + (off0 + (unsigned)(bj * 128 + n * 16) * (unsigned)T + (unsigned)(ai * 128 + m * 16))) = acc[ai][bj][m][n];
    }
};

struct Params {
    const float *x, *c, *w_ada, *b_ada, *norm_g, *hg_w_in, *hg_lb, *hg_norm_g, *hg_w_out, *lru_w_in, *lru_conv_w, *lru_conv_b,
        *lru_w_a, *lru_b_a, *lru_w_x, *lru_b_x, *lru_lam, *lru_w_out, *peer_w_q, *peer_keys, *peer_u, *peer_v, *final_g;
    float* out; unsigned char* ws; int ph_lo, ph_hi; unsigned rep_mask; int pad_;
};

typedef const __attribute__((address_space(4))) Params* KP;

template <class Epi>
__device__ __forceinline__ void run_gemm(LAS unsigned char* lds, const bf16_t* A, const bf16_t* Bt, int N, int K, int lda, int ldb, int a_pn_shift, int a_pn_stride, const Epi& E) {
    pg8::Gemm g; g.A = A; g.Bt = Bt; g.M = T; g.N = N; g.K = K; g.lda = lda; g.ldb = ldb; g.a_pn_shift = a_pn_shift; g.a_pn_stride = a_pn_stride;
    LAUNDER_IDS
    pg8::StaticOrder S; S.init(T, N, (int)gridDim.x, bidL); (void)tidL;
    pg8::gemm_phase<Epi, pg8::StaticOrder, false>(lds, g, S, E, nullptr);
    __syncthreads();
}

__device__ __forceinline__ void transpose_tile(const float* __restrict__ src, int ld_src, bf16_t* dst, int ld_dst, LAS float* tile, int tid) {
#pragma unroll
    for (int it = 0; it < 2; ++it) { const int r = (tid >> 4) + 32 * it, c4 = (tid & 15) * 4;
        const f32x4 v = *(const f32x4*)(src + (size_t)r * ld_src + c4);
        tile[r * 65 + c4 + 0] = v[0]; tile[r * 65 + c4 + 1] = v[1]; tile[r * 65 + c4 + 2] = v[2]; tile[r * 65 + c4 + 3] = v[3]; }
    __syncthreads();
    { const int n = tid >> 3, kc = tid & 7; const LAS float* s = tile + (kc * 8) * 65 + n;
        u32x4 o; o.x = cvt_pk_bf16(s[0], s[65]); o.y = cvt_pk_bf16(s[2 * 65], s[3 * 65]); o.z = cvt_pk_bf16(s[4 * 65], s[5 * 65]); o.w = cvt_pk_bf16(s[6 * 65], s[7 * 65]);
        *(u32x4*)(dst + (size_t)n * ld_dst + kc * 8) = o; }
    __syncthreads();
}

__device__ __forceinline__ void phase0(KP p, LAS unsigned char* lds) {
    LAUNDER_IDS
    const int tid = tidL, wave = tid >> 6, lane = tid & 63;
    unsigned char* ws = p->ws;
    LAS float* tile = (LAS float*)lds;
    constexpr int I_HGIN = 16 * 80, I_SQ = 16 * 16, I_LRIN = 16 * 32, I_G = 16;
    constexpr int N_A = 2 * I_HGIN + 2 * I_SQ + 2 * I_LRIN + 2 * I_SQ + 32 * I_G;
    for (int it = bidL; it < N_A; it += gridDim.x) {
        int r = it;
        if (r < 2 * I_HGIN) { const int j = r / I_HGIN, q = r % I_HGIN, kb = q / 80, nb = q % 80;
            transpose_tile(p->hg_w_in + (size_t)j * 1024 * 5120 + (size_t)kb * 64 * 5120 + nb * 64, 5120, (bf16_t*)(ws + WS_HGWIN) + (size_t)j * 5120 * 1024 + (size_t)nb * 64 * 1024 + kb * 64, 1024, tile, tid); continue; }
        r -= 2 * I_HGIN;
        if (r < 2 * I_SQ) { const int j = r / I_SQ, q = r % I_SQ, kb = q / 16, nb = q % 16;
            transpose_tile(p->hg_w_out + (size_t)j * 1024 * 1024 + (size_t)kb * 64 * 1024 + nb * 64, 1024, (bf16_t*)(ws + WS_HGWOUT) + (size_t)j * 1024 * 1024 + (size_t)nb * 64 * 1024 + kb * 64, 1024, tile, tid); continue; }
        r -= 2 * I_SQ;
        if (r < 2 * I_LRIN) { const int j = r / I_LRIN, q = r % I_LRIN, kb = q / 32, nb = q % 32;
            transpose_tile(p->lru_w_in + (size_t)j * 1024 * 2048 + (size_t)kb * 64 * 2048 + nb * 64, 2048, (bf16_t*)(ws + WS_LRWIN) + (size_t)j * 2048 * 1024 + (size_t)nb * 64 * 1024 + kb * 64, 1024, tile, tid); continue; }
        r -= 2 * I_LRIN;
        if (r < 2 * I_SQ) { const int j = r / I_SQ, q = r % I_SQ, kb = q / 16, nb = q % 16;
            transpose_tile(p->lru_w_out + (size_t)j * 1024 * 1024 + (size_t)kb * 64 * 1024 + nb * 64, 1024, (bf16_t*)(ws + WS_LRWOUT) + (size_t)j * 1024 * 1024 + (size_t)nb * 64 * 1024 + kb * 64, 1024, tile, tid); continue; }
        r -= 2 * I_SQ;
        { const int mat = r / I_G, q = r % I_G, kb = q / 4, nb = q % 4;
            const int nblk = mat & 3, gate = (mat >> 2) & 1, d = (mat >> 3) & 1, l = mat >> 4;
            const float* src = (gate ? p->lru_w_x : p->lru_w_a) + (size_t)((l * 2 + d) * 4 + nblk) * 65536 + (size_t)kb * 64 * 256 + nb * 64;
            const int n0 = nb * 64, jh = n0 >> 7;
            bf16_t* dst = (bf16_t*)(ws + WS_LRWG) + (size_t)l * 4 * 1024 * 256 + (size_t)nblk * 1024 * 256 + (size_t)((d * 2 + jh) * 256 + gate * 128 + (n0 & 127)) * 256 + kb * 64;
            transpose_tile(src, 256, dst, 256, tile, tid); }
    }
    {
        LAS float* keysL = (LAS float*)lds;
        LAS float* wqL = (LAS float*)(lds + 128 * 132 * 4);
        for (int it = bidL; it < 1024; it += gridDim.x) {
            const int l = it >> 8, hp = (it >> 4) & 15, dt = it & 15;
            const float* kp = p->peer_keys + ((size_t)l * 16 + hp) * 16384;
#pragma unroll
            for (int q = 0; q < 8; ++q) { const int e = (tid + 512 * q) * 4; const f32x4 v = *(const f32x4*)(kp + e); *(LAS f32x4*)(keysL + (e >> 7) * 132 + (e & 127)) = v; }
            const float* wp = p->peer_w_q + (size_t)l * 1024 * 2048 + (size_t)(dt * 64) * 2048 + hp * 128;
#pragma unroll
            for (int q = 0; q < 4; ++q) { const int e = (tid + 512 * q) * 4; const f32x4 v = *(const f32x4*)(wp + (size_t)(e >> 7) * 2048 + (e & 127)); *(LAS f32x4*)(wqL + e) = v; }
            __syncthreads();
            const int key = tid & 127, g = tid >> 7;
            float acc[16];
#pragma unroll
            for (int i = 0; i < 16; ++i) acc[i] = 0.f;
            for (int d4 = 0; d4 < 128; d4 += 4) {
                const f32x4 kv = *(const LAS f32x4*)(keysL + key * 132 + d4);
#pragma unroll
                for (int i = 0; i < 16; ++i) { const f32x4 wv = *(const LAS f32x4*)(wqL + (g * 16 + i) * 128 + d4);
                    acc[i] += kv[0] * wv[0] + kv[1] * wv[1] + kv[2] * wv[2] + kv[3] * wv[3]; }
            }
            bf16_t* op = (bf16_t*)(ws + WS_WQK) + (size_t)l * 2048 * 1024 + (size_t)(hp * 128 + key) * 1024 + dt * 64 + g * 16;
            u32x4 o1, o2; o1.x = cvt_pk_bf16(acc[0], acc[1]); o1.y = cvt_pk_bf16(acc[2], acc[3]); o1.z = cvt_pk_bf16(acc[4], acc[5]); o1.w = cvt_pk_bf16(acc[6], acc[7]);
            o2.x = cvt_pk_bf16(acc[8], acc[9]); o2.y = cvt_pk_bf16(acc[10], acc[11]); o2.z = cvt_pk_bf16(acc[12], acc[13]); o2.w = cvt_pk_bf16(acc[14], acc[15]);
            *(u32x4*)op = o1; *(u32x4*)(op + 8) = o2;
            __syncthreads();
        }
    }
    {
        LAS float* condL = (LAS float*)lds;
        LAS float* red = (LAS float*)(lds + 8192);
        for (int i = tid; i < 2048; i += NTHR) condL[i] = silu_(p->c[i]);
        __syncthreads();
        for (int it = bidL; it < 4 * 48; it += gridDim.x) {
            const int l = it / 48, col0 = (it % 48) * 128;
            const float* wp = p->w_ada + (size_t)l * 1024 * 6144 + col0 + 2 * lane;
            float a00 = 0.f, a01 = 0.f, a10 = 0.f, a11 = 0.f;
#pragma unroll 8
            for (int kk = 0; kk < 128; ++kk) { const int k = wave * 128 + kk; const f32x2 w = *(const f32x2*)(wp + (size_t)k * 6144);
                const float c0 = condL[k], c1 = condL[1024 + k];
                a00 += c0 * w[0]; a01 += c0 * w[1]; a10 += c1 * w[0]; a11 += c1 * w[1]; }
            red[(wave * 2 + 0) * 128 + 2 * lane] = a00; red[(wave * 2 + 0) * 128 + 2 * lane + 1] = a01;
            red[(wave * 2 + 1) * 128 + 2 * lane] = a10; red[(wave * 2 + 1) * 128 + 2 * lane + 1] = a11;
            __syncthreads();
            if (tid < 256) { const int b = tid >> 7, cc = tid & 127; float s = 0.f;
#pragma unroll
                for (int w = 0; w < 8; ++w) s += red[(w * 2 + b) * 128 + cc];
                ((float*)(ws + WS_MOD))[((size_t)l * 2 + b) * 6144 + col0 + cc] = s + p->b_ada[(size_t)l * 6144 + col0 + cc]; }
            __syncthreads();
        }
    }
    {
        const size_t n8 = (size_t)4 * 16384 * 1024 / 8;
        const size_t gt = (size_t)bidL * NTHR + tid, gs = (size_t)gridDim.x * NTHR;
        for (int tb = 0; tb < 2; ++tb) {
            const float* src = tb ? p->peer_v : p->peer_u; bf16_t* dst = (bf16_t*)(ws + (tb ? WS_VTAB : WS_UTAB));
            for (size_t i = gt; i < n8; i += gs) { const f32x4 a = __builtin_nontemporal_load((const f32x4*)(src + i * 8)), b = __builtin_nontemporal_load((const f32x4*)(src + i * 8 + 4));
                u32x4 o; o.x = cvt_pk_bf16(a[0], a[1]); o.y = cvt_pk_bf16(a[2], a[3]); o.z = cvt_pk_bf16(b[0], b[1]); o.w = cvt_pk_bf16(b[2], b[3]);
                *(u32x4*)(dst + i * 8) = o; }
        }
    }
}

__device__ __forceinline__ void phase_rms(const float* xin, const float* gain, const float* shift, const float* scale, bf16_t* hout) {
    LAUNDER_IDS
    const int tid = tidL, wave = tid >> 6, lane = tid & 63;
    for (int row = bidL * NWAVE + wave; row < T; row += gridDim.x * NWAVE) {
        const int b = row >> 13;
        const float* xr = xin + (size_t)row * 1024 + lane * 4;
        f32x4 v[4]; float ss = 0.f;
#pragma unroll
        for (int j = 0; j < 4; ++j) { v[j] = *(const f32x4*)(xr + j * 256); ss += v[j][0] * v[j][0] + v[j][1] * v[j][1] + v[j][2] * v[j][2] + v[j][3] * v[j][3]; }
        const float inv = __builtin_amdgcn_rsqf(wave_sum(ss) * (1.f / 1024.f) + EPS);
#pragma unroll
        for (int j = 0; j < 4; ++j) { const int col = j * 256 + lane * 4;
            const f32x4 g = *(const f32x4*)(gain + col), sh = *(const f32x4*)(shift + b * 6144 + col), sc = *(const f32x4*)(scale + b * 6144 + col);
            const f32x4 y = (v[j] * inv) * g * (1.f + sc) + sh;
            u32x2 o; o.x = cvt_pk_bf16(y[0], y[1]); o.y = cvt_pk_bf16(y[2], y[3]);
            *(u32x2*)(hout + (size_t)row * 1024 + col) = o; }
    }
}

constexpr int LROW = 136;
__device__ __forceinline__ float hg_lower_bound(const float* hg_lb, int j, int col) {
    if (j == 0) return 0.f;
    const float l0 = hg_lb[col], l1 = hg_lb[1024 + col];
    return fast_rcp(1.f + fast_exp(l0 - l1));
}
__device__ __forceinline__ f32x4 mfma16(bf16x8 a, bf16x8 b, f32x4 c) { return __builtin_amdgcn_mfma_f32_16x16x32_bf16(a, b, c, 0, 0, 0); }

__device__ __forceinline__ void load_vt(const bf16_t* proj, LAS bf16_t* VT, int t0, int dir, int h, int tid) {
#pragma unroll
    for (int it = 0; it < 4; ++it) { const int idx = tid + 512 * it, tau = idx & 127, cv = idx >> 7;
        const int tok = dir ? t0 + 127 - tau : t0 + tau;
        const u32x4 v = *(const u32x4*)(proj + (size_t)tok * 5120 + 3072 + h * 128 + cv * 8);
        LAS bf16_t* d = VT + (cv * 8) * LROW + tau;
        d[0 * LROW] = (bf16_t)(v.x & 0xffff); d[1 * LROW] = (bf16_t)(v.x >> 16); d[2 * LROW] = (bf16_t)(v.y & 0xffff); d[3 * LROW] = (bf16_t)(v.y >> 16);
        d[4 * LROW] = (bf16_t)(v.z & 0xffff); d[5 * LROW] = (bf16_t)(v.z >> 16); d[6 * LROW] = (bf16_t)(v.w & 0xffff); d[7 * LROW] = (bf16_t)(v.w >> 16); }
}

__device__ __forceinline__ void hg_pass_a(KP p, LAS unsigned char* lds, int j) {
    LAUNDER_IDS
    const bf16_t* proj = (const bf16_t*)(p->ws + WS_PROJ);
    float* KV = (float*)(p->ws + WS_KV); float* DEC = (float*)(p->ws + WS_DEC);
    LAS bf16_t* VT = (LAS bf16_t*)lds; LAS bf16_t* KT = (LAS bf16_t*)(lds + 34816); LAS float* TOT = (LAS float*)(lds + 69632);
    for (int u = bidL; u < 2048; u += gridDim.x) {
        int tid = tidL; asm volatile("" : "+v"(tid));
        const int wave = tid >> 6, lane = tid & 63;
        const int seq = u >> 6, c = u & 63, dir = seq & 1, h = (seq >> 1) & 7, b = seq >> 4;
        const int t0 = b * SEQ + c * 128;
        const int dk = tid & 127, g = tid >> 7;
        const float lb = hg_lower_bound(p->hg_lb, j, h * 128 + dk);
        float lcs[32], kks[32]; float lc = 0.f;
        const bf16_t* zp = proj + 1024 * (1 + dir) + h * 128 + dk;
#pragma unroll
        for (int q = 0; q < 32; ++q) { const int tau = 32 * g + q, tok = dir ? t0 + 127 - tau : t0 + tau;
            const float z = bf2f(zp[(size_t)tok * 5120]);
            const float f = lb + (1.f - lb) * sigmoidf_(z);
            lc += fast_log(f); lcs[q] = lc; kks[q] = 1.f - f; }
        TOT[g * 128 + dk] = lc;
        load_vt(proj, VT, t0, dir, h, tid);
        __syncthreads();
        float rg = 0.f, total = 0.f;
#pragma unroll
        for (int gg = 0; gg < 4; ++gg) { const float tv = TOT[gg * 128 + dk]; total += tv; if (gg < g) rg += tv; }
        const float base = total - rg;
#pragma unroll
        for (int q8 = 0; q8 < 4; ++q8) { unsigned w[4];
#pragma unroll
            for (int e = 0; e < 4; ++e) { const int q = q8 * 8 + e * 2;
                w[e] = cvt_pk_bf16(kks[q] * fast_exp(base - lcs[q]), kks[q + 1] * fast_exp(base - lcs[q + 1])); }
            u32x4 o; o.x = w[0]; o.y = w[1]; o.z = w[2]; o.w = w[3];
            *(LAS u32x4*)(KT + dk * LROW + 32 * g + q8 * 8) = o; }
        if (g == 0) DEC[(size_t)u * 128 + dk] = fast_exp(total);
        __syncthreads();
        f32x4 acc[2][4];
#pragma unroll
        for (int a = 0; a < 2; ++a)
#pragma unroll
            for (int bb = 0; bb < 4; ++bb) acc[a][bb] = (f32x4){0.f, 0.f, 0.f, 0.f};
        const int l15 = lane & 15, lq = lane >> 4;
#pragma unroll
        for (int ks = 0; ks < 4; ++ks) {
            bf16x8 af[2], bfr[4];
#pragma unroll
            for (int a = 0; a < 2; ++a) af[a] = *(const LAS bf16x8*)(VT + (((wave & 3) * 2 + a) * 16 + l15) * LROW + ks * 32 + lq * 8);
#pragma unroll
            for (int bb = 0; bb < 4; ++bb) bfr[bb] = *(const LAS bf16x8*)(KT + (((wave >> 2) * 4 + bb) * 16 + l15) * LROW + ks * 32 + lq * 8);
#pragma unroll
            for (int a = 0; a < 2; ++a)
#pragma unroll
                for (int bb = 0; bb < 4; ++bb) acc[a][bb] = mfma16(af[a], bfr[bb], acc[a][bb]);
        }
        float* kvp = KV + (size_t)u * 16384;
#pragma unroll
        for (int a = 0; a < 2; ++a)
#pragma unroll
            for (int bb = 0; bb < 4; ++bb)
#pragma unroll
                for (int r = 0; r < 4; ++r) kvp[(((wave & 3) * 2 + a) * 16 + lq * 4 + r) * 128 + ((wave >> 2) * 4 + bb) * 16 + l15] = acc[a][bb][r];
        __syncthreads();
    }
}

__device__ __forceinline__ void hg_pass_b(KP p) {
    LAUNDER_IDS
    const float* KV = (const float*)(p->ws + WS_KV); const float* DEC = (const float*)(p->ws + WS_DEC);
    bf16_t* SIN = (bf16_t*)(p->ws + WS_SIN);
    for (int e = bidL * NTHR + tidL; e < 131072; e += gridDim.x * NTHR) {
    const int seq = e >> 12, i4 = e & 4095, dir = seq & 1, dk = (i4 * 4) & 127;
    f32x4 S = {0.f, 0.f, 0.f, 0.f};
#pragma unroll 8
    for (int step = 0; step < 64; ++step) {
        const int c = dir ? 63 - step : step; const size_t u = (size_t)seq * 64 + c;
        const f32x4 kv = *(const f32x4*)(KV + u * 16384 + i4 * 4); const f32x4 dc = *(const f32x4*)(DEC + u * 128 + dk);
        u32x2 o; o.x = cvt_pk_bf16(S[0], S[1]); o.y = cvt_pk_bf16(S[2], S[3]);
        *(u32x2*)(SIN + u * 16384 + i4 * 4) = o;
        S = dc * S + kv;
    }
    }
}

__device__ __forceinline__ void hg_pass_c(KP p, LAS unsigned char* lds, int j) {
    LAUNDER_IDS
    const bf16_t* proj = (const bf16_t*)(p->ws + WS_PROJ);
    const bf16_t* SIN = (const bf16_t*)(p->ws + WS_SIN);
    bf16_t* OB = (bf16_t*)(p->ws + WS_OB);
    LAS bf16_t* QT = (LAS bf16_t*)lds; LAS bf16_t* QI = (LAS bf16_t*)(lds + 34816); LAS bf16_t* KT = (LAS bf16_t*)(lds + 69632);
    LAS bf16_t* VT = (LAS bf16_t*)(lds + 104448); LAS bf16_t* PI = (LAS bf16_t*)(lds + 139264); LAS float* TOT = (LAS float*)(lds + 147968);
    LAS float* OSUM = (LAS float*)(lds + 69632);
    for (int u = bidL; u < 1024; u += gridDim.x) {
        int tid = tidL; asm volatile("" : "+v"(tid));
        const int wave = tid >> 6, lane = tid & 63, l15 = lane & 15, lq = lane >> 4;
        const int c = u & 63, h = (u >> 6) & 7, b = u >> 9;
        const int t0 = b * SEQ + c * 128;
        const int dk = tid & 127, g = tid >> 7;
        const float lb = hg_lower_bound(p->hg_lb, j, h * 128 + dk);
        const int tt = wave & 1, dvt0 = (wave >> 1) * 2;
        f32x4 oacc[2][4][2];
#pragma unroll
        for (int dir = 0; dir < 2; ++dir) {
            const size_t su = ((size_t)((b * 8 + h) * 2 + dir) * 64 + c);
            unsigned k0p[16]; float lc = 0.f; float kprev = 0.f;
            const bf16_t* zp = proj + 1024 * (1 + dir) + h * 128 + dk; const bf16_t* qp = proj + h * 128 + dk;
#pragma unroll
            for (int q = 0; q < 32; ++q) { const int tau = 32 * g + q, tok = dir ? t0 + 127 - tau : t0 + tau;
                const float z = bf2f(zp[(size_t)tok * 5120]), qv = bf2f(qp[(size_t)tok * 5120]);
                const float f = lb + (1.f - lb) * sigmoidf_(z);
                lc += fast_log(f);
                const float el = fast_exp(fmaxf(lc, -80.f));
                QT[tau * LROW + dk] = f2bf(qv * el);
                const float kcur = (1.f - f) * fast_rcp(el);
                if (q & 1) k0p[q >> 1] = cvt_pk_bf16(kprev, kcur); else kprev = kcur; }
            TOT[g * 128 + dk] = lc;
            __syncthreads();
            float r[4]; { float run = 0.f;
#pragma unroll
                for (int gg = 0; gg < 4; ++gg) { r[gg] = run; run += TOT[gg * 128 + dk]; } }
            float rg = 0.f;
#pragma unroll
            for (int gg = 0; gg < 4; ++gg) if (gg == g) rg = r[gg];
            { const float eg = fast_exp(rg);
#pragma unroll
                for (int q = 0; q < 32; ++q) QI[(32 * g + q) * LROW + dk] = f2bf(bf2f(QT[(32 * g + q) * LROW + dk]) * eg); }
            load_vt(proj, VT, t0, dir, h, tid);
            bf16x8 sfr[2][4];
#pragma unroll
            for (int n = 0; n < 2; ++n)
#pragma unroll
                for (int ks = 0; ks < 4; ++ks) sfr[n][ks] = *(const bf16x8*)(SIN + su * 16384 + (size_t)((dvt0 + n) * 16 + l15) * 128 + ks * 32 + lq * 8);
#pragma unroll
            for (int i = 0; i < 4; ++i) {
                if (g <= i) { const float e = fast_exp(r[i] - rg);
#pragma unroll
                    for (int q = 0; q < 32; ++q) KT[(32 * g + q) * LROW + dk] = f2bf(((q & 1) ? bfhi(k0p[q >> 1]) : bflo(k0p[q >> 1])) * e); }
                __syncthreads();
                for (int tl = wave; tl < 4 * (i + 1); tl += 8) { const int sm = tl >> 1, tn = tl & 1;
                    f32x4 a4 = {0.f, 0.f, 0.f, 0.f};
#pragma unroll
                    for (int ks = 0; ks < 4; ++ks) { const bf16x8 af = *(const LAS bf16x8*)(KT + (sm * 16 + l15) * LROW + ks * 32 + lq * 8);
                        const bf16x8 bq = *(const LAS bf16x8*)(QT + (32 * i + tn * 16 + l15) * LROW + ks * 32 + lq * 8);
                        a4 = mfma16(af, bq, a4); }
                    const int tloc = tn * 16 + l15, s0 = sm * 16 + lq * 4, tg = 32 * i + tloc;
                    u32x2 o; o.x = cvt_pk_bf16(s0 + 0 <= tg ? a4[0] : 0.f, s0 + 1 <= tg ? a4[1] : 0.f); o.y = cvt_pk_bf16(s0 + 2 <= tg ? a4[2] : 0.f, s0 + 3 <= tg ? a4[3] : 0.f);
                    *(LAS u32x2*)(PI + tloc * LROW + s0) = o; }
                __syncthreads();
                f32x4 a0 = {0.f, 0.f, 0.f, 0.f}, a1 = {0.f, 0.f, 0.f, 0.f};
                for (int ks = 0; ks <= i; ++ks) { const bf16x8 af = *(const LAS bf16x8*)(PI + (tt * 16 + l15) * LROW + ks * 32 + lq * 8);
                    const bf16x8 b0 = *(const LAS bf16x8*)(VT + ((dvt0 + 0) * 16 + l15) * LROW + ks * 32 + lq * 8);
                    const bf16x8 b1 = *(const LAS bf16x8*)(VT + ((dvt0 + 1) * 16 + l15) * LROW + ks * 32 + lq * 8);
                    a0 = mfma16(af, b0, a0); a1 = mfma16(af, b1, a1); }
#pragma unroll
                for (int ks = 0; ks < 4; ++ks) { const bf16x8 af = *(const LAS bf16x8*)(QI + (32 * i + tt * 16 + l15) * LROW + ks * 32 + lq * 8);
                    a0 = mfma16(af, sfr[0][ks], a0); a1 = mfma16(af, sfr[1][ks], a1); }
                oacc[dir][i][0] = a0; oacc[dir][i][1] = a1;
            }
        }
        __syncthreads();
#pragma unroll
        for (int i = 0; i < 4; ++i)
#pragma unroll
            for (int n = 0; n < 2; ++n)
#pragma unroll
                for (int rr = 0; rr < 4; ++rr) OSUM[(32 * i + tt * 16 + lq * 4 + rr) * 132 + (dvt0 + n) * 16 + l15] = oacc[0][i][n][rr];
        __syncthreads();
#pragma unroll
        for (int i = 0; i < 4; ++i)
#pragma unroll
            for (int n = 0; n < 2; ++n)
#pragma unroll
                for (int rr = 0; rr < 4; ++rr) OSUM[(127 - (32 * i + tt * 16 + lq * 4 + rr)) * 132 + (dvt0 + n) * 16 + l15] += oacc[1][i][n][rr];
        __syncthreads();
        { const int row = tid >> 2, part = tid & 3; const int tok = t0 + row;
            float ov[32]; float ss = 0.f;
#pragma unroll
            for (int q = 0; q < 8; ++q) { const f32x4 v = *(const LAS f32x4*)(OSUM + row * 132 + part * 32 + q * 4);
                ov[q * 4 + 0] = v[0]; ov[q * 4 + 1] = v[1]; ov[q * 4 + 2] = v[2]; ov[q * 4 + 3] = v[3]; ss += v[0] * v[0] + v[1] * v[1] + v[2] * v[2] + v[3] * v[3]; }
            ss += __shfl_xor(ss, 1); ss += __shfl_xor(ss, 2);
            const float inv = __builtin_amdgcn_rsqf(ss * (1.f / 128.f) + EPS);
            const int col = h * 128 + part * 32;
            const bf16_t* gp = proj + (size_t)tok * 5120 + 4096 + col; const float* ng = p->hg_norm_g + j * 1024 + col;
#pragma unroll
            for (int q = 0; q < 4; ++q) { const u32x4 gr = *(const u32x4*)(gp + q * 8);
                const float gv[8] = {bflo(gr.x), bfhi(gr.x), bflo(gr.y), bfhi(gr.y), bflo(gr.z), bfhi(gr.z), bflo(gr.w), bfhi(gr.w)};
                float y[8];
#pragma unroll
                for (int e = 0; e < 8; ++e) y[e] = ov[q * 8 + e] * inv * ng[q * 8 + e] * silu_(gv[e]);
                u32x4 o; o.x = cvt_pk_bf16(y[0], y[1]); o.y = cvt_pk_bf16(y[2], y[3]); o.z = cvt_pk_bf16(y[4], y[5]); o.w = cvt_pk_bf16(y[6], y[7]);
                *(u32x4*)(OB + (size_t)tok * 1024 + col + q * 8) = o; }
        }
        __syncthreads();
    }
}

__device__ __forceinline__ void lru_conv(KP p, int l) {
    LAUNDER_IDS
    const bf16_t* XB = (const bf16_t*)(p->ws + WS_XB); bf16_t* XC = (bf16_t*)(p->ws + WS_XC);
    const float* cw = p->lru_conv_w + (size_t)l * 4 * 1024; const float* cb = p->lru_conv_b + (size_t)l * 1024;
    const int gs = gridDim.x * NTHR;
    for (int it = bidL * NTHR + tidL; it < T * 128; it += gs) {
        const int tok = it >> 7, c8 = (it & 127) * 8, s = tok & (SEQ - 1);
        float acc[8];
        { const f32x4 b0 = *(const f32x4*)(cb + c8), b1 = *(const f32x4*)(cb + c8 + 4);
            acc[0] = b0[0]; acc[1] = b0[1]; acc[2] = b0[2]; acc[3] = b0[3]; acc[4] = b1[0]; acc[5] = b1[1]; acc[6] = b1[2]; acc[7] = b1[3]; }
#pragma unroll
        for (int jj = 0; jj < 4; ++jj) { const int ts = s + jj - 2;
            if (ts >= 0 && ts < SEQ) { const u32x4 xr = *(const u32x4*)(XB + (size_t)(tok + jj - 2) * 1024 + c8);
                const f32x4 w0 = *(const f32x4*)(cw + jj * 1024 + c8), w1 = *(const f32x4*)(cw + jj * 1024 + c8 + 4);
                acc[0] += bflo(xr.x) * w0[0]; acc[1] += bfhi(xr.x) * w0[1]; acc[2] += bflo(xr.y) * w0[2]; acc[3] += bfhi(xr.y) * w0[3];
                acc[4] += bflo(xr.z) * w1[0]; acc[5] += bfhi(xr.z) * w1[1]; acc[6] += bflo(xr.w) * w1[2]; acc[7] += bfhi(xr.w) * w1[3]; } }
        u32x4 o; o.x = cvt_pk_bf16(acc[0], acc[1]); o.y = cvt_pk_bf16(acc[2], acc[3]); o.z = cvt_pk_bf16(acc[4], acc[5]); o.w = cvt_pk_bf16(acc[6], acc[7]);
        *(u32x4*)(XC + (size_t)tok * 1024 + c8) = o;
    }
}
__device__ __forceinline__ void lru_scan1(KP p) {
    LAUNDER_IDS
    const bf16_t* LOGA = (const bf16_t*)(p->ws + WS_LOGA); const bf16_t* BT = (const bf16_t*)(p->ws + WS_BTERM);
    float* CP = (float*)(p->ws + WS_CP); float* CH = (float*)(p->ws + WS_CH);
    const int ch = 2 * tidL;
    for (int u = bidL; u < 1024; u += gridDim.x) {
        const int chunk = u & 255, dir = (u >> 8) & 1, b = u >> 9;
        const size_t base = ((size_t)dir * T + b * SEQ + chunk * 32) * 1024 + ch;
        float h0 = 0.f, h1 = 0.f, s0 = 0.f, s1 = 0.f;
#pragma unroll 8
        for (int q = 0; q < 32; ++q) { const int t = dir ? 31 - q : q;
            const unsigned lw = *(const unsigned*)(LOGA + base + (size_t)t * 1024), bw = *(const unsigned*)(BT + base + (size_t)t * 1024);
            const float l0 = bflo(lw), l1 = bfhi(lw);
            h0 = fast_exp(l0) * h0 + bflo(bw); h1 = fast_exp(l1) * h1 + bfhi(bw); s0 += l0; s1 += l1; }
        const size_t o = ((size_t)(b * 2 + dir) * 256 + chunk) * 1024 + ch;
        *(f32x2*)(CP + o) = (f32x2){fast_exp(s0), fast_exp(s1)}; *(f32x2*)(CH + o) = (f32x2){h0, h1};
    }
}
__device__ __forceinline__ void lru_scan2(KP p) {
    LAUNDER_IDS
    const float* CP = (const float*)(p->ws + WS_CP); const float* CH = (const float*)(p->ws + WS_CH); float* HIN = (float*)(p->ws + WS_HIN);
    const int wave = tidL >> 6, lane = tidL & 63;
    for (int item = bidL * NWAVE + wave; item < 4096; item += gridDim.x * NWAVE) {
        const int ch = item & 1023, bd = item >> 10, dir = bd & 1;
        float pp[4], hh[4]; float Pl = 1.f, Hl = 0.f;
#pragma unroll
        for (int q = 0; q < 4; ++q) { const int ci = 4 * lane + q, chunk = dir ? 255 - ci : ci; const size_t o = ((size_t)bd * 256 + chunk) * 1024 + ch;
            pp[q] = CP[o]; hh[q] = CH[o]; Hl = pp[q] * Hl + hh[q]; Pl *= pp[q]; }
#pragma unroll
        for (int off = 1; off < 64; off <<= 1) { const float Pp = __shfl_up(Pl, off), Hp = __shfl_up(Hl, off);
            if (lane >= off) { Hl = Pl * Hp + Hl; Pl = Pl * Pp; } }
        float carry = __shfl_up(Hl, 1); if (lane == 0) carry = 0.f;
#pragma unroll
        for (int q = 0; q < 4; ++q) { const int ci = 4 * lane + q, chunk = dir ? 255 - ci : ci; const size_t o = ((size_t)bd * 256 + chunk) * 1024 + ch;
            HIN[o] = carry; carry = pp[q] * carry + hh[q]; }
    }
}
__device__ __forceinline__ void lru_scan3(KP p) {
    LAUNDER_IDS
    const bf16_t* LOGA = (const bf16_t*)(p->ws + WS_LOGA); const bf16_t* BT = (const bf16_t*)(p->ws + WS_BTERM); const bf16_t* YG = (const bf16_t*)(p->ws + WS_YG);
    const float* HIN = (const float*)(p->ws + WS_HIN); bf16_t* OB = (bf16_t*)(p->ws + WS_OB);
    const int ch = 2 * tidL;
    for (int u = bidL; u < 512; u += gridDim.x) {
        const int chunk = u & 255, b = u >> 8;
        const size_t tok0 = (size_t)b * SEQ + chunk * 32;
        const f32x2 hf = *(const f32x2*)(HIN + ((size_t)(b * 2 + 0) * 256 + chunk) * 1024 + ch), hb = *(const f32x2*)(HIN + ((size_t)(b * 2 + 1) * 256 + chunk) * 1024 + ch);
        float hs0[32], hs1[32]; float h0 = hf[0], h1 = hf[1];
#pragma unroll
        for (int q = 0; q < 32; ++q) { const size_t o = (tok0 + q) * 1024 + ch;
            const unsigned lw = *(const unsigned*)(LOGA + o), bw = *(const unsigned*)(BT + o);
            h0 = fast_exp(bflo(lw)) * h0 + bflo(bw); h1 = fast_exp(bfhi(lw)) * h1 + bfhi(bw); hs0[q] = h0; hs1[q] = h1; }
        h0 = hb[0]; h1 = hb[1];
#pragma unroll
        for (int q = 31; q >= 0; --q) { const size_t o = (tok0 + q) * 1024 + ch;
            const unsigned lw = *(const unsigned*)(LOGA + (size_t)T * 1024 + o), bw = *(const unsigned*)(BT + (size_t)T * 1024 + o), yw = *(const unsigned*)(YG + o);
            h0 = fast_exp(bflo(lw)) * h0 + bflo(bw); h1 = fast_exp(bfhi(lw)) * h1 + bfhi(bw);
            *(unsigned*)(OB + o) = cvt_pk_bf16((hs0[q] + h0) * bflo(yw), (hs1[q] + h1) * bfhi(yw)); }
    }
}

__device__ const unsigned char STAIR[64] = {
    0x00, 0x01, 0x02, 0x03, 0x04, 0x05, 0x06, 0x07, 0x08, 0x09, 0x0a, 0x0b, 0x0c, 0x0d, 0x0e, 0x0f,
    0x10, 0x11, 0x12, 0x13, 0x14, 0x15, 0x16, 0x17, 0x20, 0x21, 0x22, 0x23, 0x24, 0x30, 0x31, 0x32,
    0x33, 0x40, 0x41, 0x42, 0x50, 0x51, 0x60, 0x61, 0x70, 0x71, 0x80, 0x90, 0xa0, 0xb0, 0xc0, 0xd0,
    0xe0, 0xf0, 0, 0, 0, 0, 0, 0, 0, 0, 0, 0, 0, 0, 0, 0};
__device__ __forceinline__ unsigned mono_key(float f) { const unsigned b = __float_as_uint(f); return b ^ ((b >> 31) ? 0xffffffffu : 0x80000000u); }

__device__ __forceinline__ float inv_mono(unsigned k) { return __uint_as_float(k ^ ((k >> 31) ? 0x80000000u : 0xffffffffu)); }
#define TK_INSERT(L, x) do { _Pragma("unroll") for (int q_ = 0; q_ < 16; ++q_) { const unsigned hi_ = max(L[q_], x); x = min(L[q_], x); L[q_] = hi_; } } while (0)
__device__ __forceinline__ void peer_topk(KP p, LAS unsigned char* lds) {
    LAUNDER_IDS
    (void)bidL;
    const int tid = tidL, wave = tid >> 6, lane = tid & 63;
    const float* SCT = (const float*)(p->ws + WS_SCORES);
    int* TOPI = (int*)(p->ws + WS_TOPI); float* TOPG = (float*)(p->ws + WS_TOPG);
    LAS unsigned char* IX = lds + wave * 2048 + lane * 32;
    for (int item = bidL * NWAVE + wave; item < 2048; item += gridDim.x * NWAVE) {
        const int tg = item >> 3, hd = item & 7, tok = tg * 64 + lane;
        float V[2][16];
#pragma unroll
        for (int half = 0; half < 2; ++half) {
            unsigned L[16];
#pragma unroll
            for (int q = 0; q < 16; ++q) L[q] = 0u;
            const float* sc = SCT + (size_t)(hd * 256 + half * 128) * T + tok;
#pragma unroll 4
            for (int k = 0; k < 128; ++k) { unsigned x = (mono_key(sc[(size_t)k * T]) & ~0x7fu) | (unsigned)k; TK_INSERT(L, x); }
            u32x4 w0, w1;
            w0.x = (L[0] & 0x7f) | ((L[1] & 0x7f) << 8) | ((L[2] & 0x7f) << 16) | ((L[3] & 0x7f) << 24); w0.y = (L[4] & 0x7f) | ((L[5] & 0x7f) << 8) | ((L[6] & 0x7f) << 16) | ((L[7] & 0x7f) << 24);
            w0.z = (L[8] & 0x7f) | ((L[9] & 0x7f) << 8) | ((L[10] & 0x7f) << 16) | ((L[11] & 0x7f) << 24); w0.w = (L[12] & 0x7f) | ((L[13] & 0x7f) << 8) | ((L[14] & 0x7f) << 16) | ((L[15] & 0x7f) << 24);
            *(LAS u32x4*)(IX + half * 16) = w0;
#pragma unroll
            for (int q = 0; q < 16; ++q) V[half][q] = inv_mono(L[q]);
        }
        unsigned C[16];
#pragma unroll
        for (int q = 0; q < 16; ++q) C[q] = 0u;
#pragma unroll
        for (int i = 0; i < 16; ++i)
#pragma unroll
            for (int jj = 0; jj < 16; ++jj) if ((i + 1) * (jj + 1) <= 16) { unsigned x = (mono_key(V[0][i] + V[1][jj]) & ~0xffu) | (unsigned)(i * 16 + jj); TK_INSERT(C, x); }
        asm volatile("s_waitcnt lgkmcnt(0)" ::: "memory");
        const float s0 = inv_mono(C[0] & ~0xffu);
        float e[16]; float sum = 0.f; int ids[16];
#pragma unroll
        for (int q = 0; q < 16; ++q) { e[q] = fast_exp(inv_mono(C[q] & ~0xffu) - s0); sum += e[q];
            const unsigned code = C[q] & 0xffu; ids[q] = (int)IX[code >> 4] * 128 + (int)IX[16 + (code & 15u)]; }
        const float rs = fast_rcp(sum);
        int* ip = TOPI + (size_t)tok * 128 + hd * 16; float* gp = TOPG + (size_t)tok * 128 + hd * 16;
#pragma unroll
        for (int q = 0; q < 4; ++q) { *(u32x4*)(ip + 4 * q) = (u32x4){(unsigned)ids[4 * q], (unsigned)ids[4 * q + 1], (unsigned)ids[4 * q + 2], (unsigned)ids[4 * q + 3]};
            *(f32x4*)(gp + 4 * q) = (f32x4){e[4 * q] * rs, e[4 * q + 1] * rs, e[4 * q + 2] * rs, e[4 * q + 3] * rs}; }
        asm volatile("s_waitcnt lgkmcnt(0)" ::: "memory");
    }
}

__device__ __forceinline__ void peer_gather(KP p, int l, bool dry) {
    LAUNDER_IDS
    const int wave = tidL >> 6, lane = tidL & 63;
    const bf16_t* HB = (const bf16_t*)(p->ws + WS_HBUF); bf16_t* HBW = (bf16_t*)(p->ws + WS_HBUF);
    const int* TOPI = (const int*)(p->ws + WS_TOPI); const float* TOPG = (const float*)(p->ws + WS_TOPG);
    const bf16_t* UT = (const bf16_t*)(p->ws + WS_UTAB) + (size_t)l * 16384 * 1024; const bf16_t* VTb = (const bf16_t*)(p->ws + WS_VTAB) + (size_t)l * 16384 * 1024;
    float* XRES = (float*)(p->ws + WS_XRES); const float* MOD = (const float*)(p->ws + WS_MOD);
    for (int tok = bidL * NWAVE + wave; tok < T; tok += gridDim.x * NWAVE) {
        const int b = tok >> 13;
        float hv[16];
        { const u32x4 h0 = *(const u32x4*)(HB + (size_t)tok * 1024 + 8 * lane), h1 = *(const u32x4*)(HB + (size_t)tok * 1024 + 512 + 8 * lane);
            hv[0] = bflo(h0.x); hv[1] = bfhi(h0.x); hv[2] = bflo(h0.y); hv[3] = bfhi(h0.y); hv[4] = bflo(h0.z); hv[5] = bfhi(h0.z); hv[6] = bflo(h0.w); hv[7] = bfhi(h0.w);
            hv[8] = bflo(h1.x); hv[9] = bfhi(h1.x); hv[10] = bflo(h1.y); hv[11] = bfhi(h1.y); hv[12] = bflo(h1.z); hv[13] = bfhi(h1.z); hv[14] = bflo(h1.w); hv[15] = bfhi(h1.w); }
        const int id0 = TOPI[(size_t)tok * 128 + lane], id1 = TOPI[(size_t)tok * 128 + 64 + lane];
        const float g0 = TOPG[(size_t)tok * 128 + lane], g1 = TOPG[(size_t)tok * 128 + 64 + lane];
        float acc[16];
#pragma unroll
        for (int i = 0; i < 16; ++i) acc[i] = 0.f;
#pragma unroll 1
        for (int e0 = 0; e0 < 128; e0 += 4) {
            u32x4 uu[4][2], vv[4][2]; float gk[4];
#pragma unroll
            for (int k = 0; k < 4; ++k) { const int e = e0 + k;
                int id = __builtin_amdgcn_readlane(e0 < 64 ? id0 : id1, e & 63);
                id &= 16383;
                gk[k] = __uint_as_float(__builtin_amdgcn_readlane(__float_as_uint(e0 < 64 ? g0 : g1), e & 63));
                const bf16_t* up = UT + (size_t)id * 1024 + 8 * lane; const bf16_t* vp = VTb + (size_t)id * 1024 + 8 * lane;
                uu[k][0] = *(const u32x4*)up; uu[k][1] = *(const u32x4*)(up + 512); vv[k][0] = *(const u32x4*)vp; vv[k][1] = *(const u32x4*)(vp + 512); }
            float dt[4];
#pragma unroll
            for (int k = 0; k < 4; ++k) { float d = 0.f;
#pragma unroll
                for (int hh = 0; hh < 2; ++hh) { const u32x4 w = uu[k][hh];
                    d += bflo(w.x) * hv[hh * 8 + 0] + bfhi(w.x) * hv[hh * 8 + 1] + bflo(w.y) * hv[hh * 8 + 2] + bfhi(w.y) * hv[hh * 8 + 3]
                       + bflo(w.z) * hv[hh * 8 + 4] + bfhi(w.z) * hv[hh * 8 + 5] + bflo(w.w) * hv[hh * 8 + 6] + bfhi(w.w) * hv[hh * 8 + 7]; }
                dt[k] = d; }
#pragma unroll
            for (int o = 1; o < 64; o <<= 1) {
#pragma unroll
                for (int k = 0; k < 4; ++k) dt[k] += __shfl_xor(dt[k], o); }
#pragma unroll
            for (int k = 0; k < 4; ++k) { const float cf = gk[k] * gelu_tanh(dt[k]);
#pragma unroll
                for (int hh = 0; hh < 2; ++hh) { const u32x4 w = vv[k][hh];
                    acc[hh * 8 + 0] += cf * bflo(w.x); acc[hh * 8 + 1] += cf * bfhi(w.x); acc[hh * 8 + 2] += cf * bflo(w.y); acc[hh * 8 + 3] += cf * bfhi(w.y);
                    acc[hh * 8 + 4] += cf * bflo(w.z); acc[hh * 8 + 5] += cf * bfhi(w.z); acc[hh * 8 + 6] += cf * bflo(w.w); acc[hh * 8 + 7] += cf * bfhi(w.w); } }
        }
        const float* g2 = MOD + ((size_t)l * 2 + b) * 6144 + 5 * 1024;
        float xn[16]; float ss = 0.f;
#pragma unroll
        for (int hh = 0; hh < 2; ++hh) { const int col = hh * 512 + 8 * lane;
#pragma unroll
            for (int q = 0; q < 2; ++q) { const f32x4 xr = *(const f32x4*)(XRES + (size_t)tok * 1024 + col + 4 * q), gg = *(const f32x4*)(g2 + col + 4 * q);
#pragma unroll
                for (int i = 0; i < 4; ++i) { const float v = xr[i] + gg[i] * acc[hh * 8 + q * 4 + i]; xn[hh * 8 + q * 4 + i] = v; ss += v * v; } } }
        const float inv = __builtin_amdgcn_rsqf(wave_sum(ss) * (1.f / 1024.f) + EPS);
        if (dry) { if (inv == 123.456f) p->out[tok] = inv; continue; }
        if (l < DEPTH - 1) {
            const float* gain = p->norm_g + (size_t)(l + 1) * 2 * 1024; const float* sh = MOD + ((size_t)(l + 1) * 2 + b) * 6144; const float* sc = sh + 1024;
#pragma unroll
            for (int hh = 0; hh < 2; ++hh) { const int col = hh * 512 + 8 * lane; float y[8];
#pragma unroll
                for (int q = 0; q < 2; ++q) { const f32x4 gn = *(const f32x4*)(gain + col + 4 * q), s1 = *(const f32x4*)(sh + col + 4 * q), c1 = *(const f32x4*)(sc + col + 4 * q);
                    *(f32x4*)(XRES + (size_t)tok * 1024 + col + 4 * q) = (f32x4){xn[hh * 8 + q * 4], xn[hh * 8 + q * 4 + 1], xn[hh * 8 + q * 4 + 2], xn[hh * 8 + q * 4 + 3]};
#pragma unroll
                    for (int i = 0; i < 4; ++i) y[q * 4 + i] = (xn[hh * 8 + q * 4 + i] * inv) * gn[i] * (1.f + c1[i]) + s1[i]; }
                u32x4 o; o.x = cvt_pk_bf16(y[0], y[1]); o.y = cvt_pk_bf16(y[2], y[3]); o.z = cvt_pk_bf16(y[4], y[5]); o.w = cvt_pk_bf16(y[6], y[7]);
                *(u32x4*)(HBW + (size_t)tok * 1024 + col) = o; }
        } else {
#pragma unroll
            for (int hh = 0; hh < 2; ++hh) { const int col = hh * 512 + 8 * lane;
#pragma unroll
                for (int q = 0; q < 2; ++q) { const f32x4 gn = *(const f32x4*)(p->final_g + col + 4 * q); f32x4 o;
#pragma unroll
                    for (int i = 0; i < 4; ++i) o[i] = (xn[hh * 8 + q * 4 + i] * inv) * gn[i];
                    *(f32x4*)(p->out + (size_t)tok * 1024 + col + 4 * q) = o; } }
        }
    }
}

#define XB_TMO      128
#define XB_XCNT(j)  (256  + 64 * (j))
#define XB_XSUB(j)  (1280 + 64 * (j))
#define XB_XGEN(j)  (2304 + 64 * (j))
#define XB_TOP      3328
#define XB_TOPGEN   3392
#define XCD_BAR_WORDS 3456
#define XB_SPIN_CAP (1u << 18)

__device__ __forceinline__ unsigned xb_ld(unsigned* p)              { return __hip_atomic_load(p, __ATOMIC_RELAXED, __HIP_MEMORY_SCOPE_AGENT); }
__device__ __forceinline__ unsigned xb_add(unsigned* p, unsigned v) { return __hip_atomic_fetch_add(p, v, __ATOMIC_RELAXED, __HIP_MEMORY_SCOPE_AGENT); }
__device__ __forceinline__ unsigned xb_xcc_id() { return (unsigned)__builtin_amdgcn_s_getreg((3 << 11) | 20) & 0xFu; }
#define XB_SPIN(cond, bar) do { unsigned _sp = 0; while (cond) { __builtin_amdgcn_s_sleep(1); \
    if ((++_sp & 255u) == 0u) { if (xb_ld(&(bar)[XB_TMO])) break; if (_sp > XB_SPIN_CAP) { atomicAdd(&(bar)[XB_TMO], 1u); break; } } } } while (0)

struct XcdBarrier {
    unsigned* bar; unsigned x;
    volatile LAS unsigned* st;
};

__device__ __forceinline__ XcdBarrier xcd_barrier_post(unsigned* bar, volatile LAS unsigned* st) {
    XcdBarrier b; b.bar = bar; b.x = xb_xcc_id(); b.st = st;
    if (threadIdx.x == 0) (void)xb_add(&bar[XB_XCNT(b.x)], 1u);
    return b;
}
__device__ __forceinline__ void xcd_barrier_complete(unsigned* bar, unsigned x, unsigned& nloc, unsigned& nx) {
    const unsigned G = gridDim.x * gridDim.y * gridDim.z;
    unsigned sum, cnt, mine, sp = 0u;
    for (;;) {
        sum = 0u; cnt = 0u; mine = 0u;
#pragma unroll
        for (unsigned j = 0; j < 16; ++j) { const unsigned c = xb_ld(&bar[XB_XCNT(j)]); sum += c; cnt += (c > 0u) ? 1u : 0u; mine = (j == x) ? c : mine; }
        if (sum == G) break;
        __builtin_amdgcn_s_sleep(1);
        if ((++sp & 255u) == 0u) { if (xb_ld(&bar[XB_TMO])) break; if (sp > XB_SPIN_CAP) { atomicAdd(&bar[XB_TMO], 1u); break; } }
    }
    nloc = mine > 0u ? mine : 1u; nx = cnt > 0u ? cnt : 1u;
}

__device__ __forceinline__ void xcd_barrier(const XcdBarrier& b) {
    asm volatile("s_waitcnt vmcnt(0)" ::: "memory");
    __syncthreads();
    if (threadIdx.x == 0) {
        unsigned* bar = b.bar;
        __builtin_amdgcn_s_waitcnt(0);
        unsigned nloc = b.st[0], nx = b.st[1];
        if (nloc == 0u) { xcd_barrier_complete(bar, b.x, nloc, nx); b.st[0] = nloc; b.st[1] = nx; }
        const unsigned old = xb_add(&bar[XB_XSUB(b.x)], 1u);
        const unsigned gen = old / nloc;
        if (old + 1u == (gen + 1u) * nloc) {
            __builtin_amdgcn_fence(__ATOMIC_RELEASE, "agent");
            asm volatile("s_waitcnt vmcnt(0)" ::: "memory");
            const unsigned og = xb_add(&bar[XB_TOP], 1u);
            const unsigned tg = og / nx;
            if (og + 1u == (tg + 1u) * nx) xb_add(&bar[XB_TOPGEN], 1u);
            else XB_SPIN(xb_ld(&bar[XB_TOPGEN]) == tg, bar);
            __builtin_amdgcn_fence(__ATOMIC_ACQUIRE, "agent");
            xb_add(&bar[XB_XGEN(b.x)], 1u);
            asm volatile("s_waitcnt vmcnt(0)" ::: "memory");
        } else {
            XB_SPIN(xb_ld(&bar[XB_XGEN(b.x)]) == gen, bar);
            __builtin_amdgcn_fence(__ATOMIC_ACQUIRE, "agent");
            asm volatile("s_waitcnt vmcnt(0)" ::: "memory");
        }
    }
    __syncthreads();
}

#ifndef OPMASK
#define OPMASK 0xFFFFFFFFu
#endif
#define EN(o) ((OPMASK >> (o)) & 1u)
enum { OP_P0 = 0, OP_RMS1, OP_HG_IN, OP_HG_A, OP_HG_B, OP_HG_C, OP_MIX_OUT, OP_LR_IN, OP_LR_CONV, OP_LR_G, OP_LR_S1, OP_LR_S2, OP_LR_S3, OP_RMS2, OP_QK, OP_TOPK, OP_GATHER };
constexpr int NPH = 42;
#define REP_MASK 0u
__device__ __forceinline__ void decode_phase(int ph, int& l, int& op) {
    if (ph == 0) { l = 0; op = OP_P0; return; }
    if (ph == 1) { l = 0; op = OP_RMS1; return; }
    int q = ph - 2;
    if (q < 9) { l = 0; } else if (q < 20) { l = 1; q -= 9; } else if (q < 29) { l = 2; q -= 20; } else { l = 3; q -= 29; }
    if ((l & 1) == 0) { op = q == 0 ? OP_HG_IN : q == 1 ? OP_HG_A : q == 2 ? OP_HG_B : q == 3 ? OP_HG_C : q == 4 ? OP_MIX_OUT : q == 5 ? OP_RMS2 : q == 6 ? OP_QK : q == 7 ? OP_TOPK : OP_GATHER; }
    else { op = q == 0 ? OP_LR_IN : q == 1 ? OP_LR_CONV : q == 2 ? OP_LR_G : q == 3 ? OP_LR_S1 : q == 4 ? OP_LR_S2 : q == 5 ? OP_LR_S3 : q == 6 ? OP_MIX_OUT : q == 7 ? OP_RMS2 : q == 8 ? OP_QK : q == 9 ? OP_TOPK : OP_GATHER; }
}

__global__ __launch_bounds__(512, 2) void mk_fwd(Params p_arg) {
    extern __shared__ __attribute__((aligned(16))) unsigned char shm[];
    LAS unsigned char* lds = (LAS unsigned char*)shm;
    cg::grid_group grid = cg::this_grid();
    unsigned long long kpv = (unsigned long long)__builtin_amdgcn_kernarg_segment_ptr();
    const int ph_lo = p_arg.ph_lo, ph_hi = p_arg.ph_hi;
    volatile LAS unsigned* xst = (volatile LAS unsigned*)(lds + LDS_BYTES - 16);
    if (threadIdx.x == 0) { xst[0] = 0u; xst[1] = 0u; }
    __syncthreads();
    const XcdBarrier xb = xcd_barrier_post((unsigned*)(p_arg.ws + WS_CTL) + 1024, xst);
    for (int ph = ph_lo; ph < ph_hi; ++ph) {
        if (ph > ph_lo) { if (ph == 1) grid.sync(); else xcd_barrier(xb); }
        asm volatile("" : "+s"(kpv));
        KP p = (KP)kpv;
        unsigned char* ws = p->ws;
        const float* MOD = (const float*)(ws + WS_MOD);
        int l, op; decode_phase(ph, l, op);
        const int j = l >> 1;
        const int nrep = ((p->rep_mask >> op) & 1u) ? 2 : 1;
        for (int rep = 0; rep < nrep; ++rep) {
        const bool dry = rep + 1 < nrep;
#ifdef ONLY
        switch (ONLY) {
#else
        switch (op) {
#endif
        case OP_P0: if (EN(OP_P0)) phase0(p, lds); break;
        case OP_RMS1: if (EN(OP_RMS1)) phase_rms(p->x, p->norm_g, MOD, MOD + 1024, (bf16_t*)(ws + WS_HBUF)); break;
        case OP_HG_IN: if (EN(OP_HG_IN)) { EpiBf16 E; E.O = (bf16_t*)(ws + WS_PROJ); E.ldc = 5120;
            run_gemm(lds, (const bf16_t*)(ws + WS_HBUF), (const bf16_t*)(ws + WS_HGWIN) + (size_t)j * 5120 * 1024, 5120, 1024, 1024, 1024, 0, 0, E); } break;
        case OP_HG_A: if (EN(OP_HG_A)) hg_pass_a(p, lds, j); break;
        case OP_HG_B: if (EN(OP_HG_B)) hg_pass_b(p); break;
        case OP_HG_C: if (EN(OP_HG_C)) hg_pass_c(p, lds, j); break;
        case OP_MIX_OUT: if (EN(OP_MIX_OUT)) { EpiResid E; E.xin = (l == 0) ? p->x : (const float*)(ws + WS_XRES); E.xout = (float*)(ws + WS_XRES); E.gate = MOD + (size_t)l * 2 * 6144 + 2 * 1024; E.dry = dry;
            const bf16_t* W = (l & 1) ? (const bf16_t*)(ws + WS_LRWOUT) + (size_t)j * 1024 * 1024 : (const bf16_t*)(ws + WS_HGWOUT) + (size_t)j * 1024 * 1024;
            run_gemm(lds, (const bf16_t*)(ws + WS_OB), W, 1024, 1024, 1024, 1024, 0, 0, E); } break;
        case OP_LR_IN: if (EN(OP_LR_IN)) { EpiLruIn E; E.XB = (bf16_t*)(ws + WS_XB); E.YG = (bf16_t*)(ws + WS_YG);
            run_gemm(lds, (const bf16_t*)(ws + WS_HBUF), (const bf16_t*)(ws + WS_LRWIN) + (size_t)j * 2048 * 1024, 2048, 1024, 1024, 1024, 0, 0, E); } break;
        case OP_LR_CONV: if (EN(OP_LR_CONV)) lru_conv(p, j); break;
        case OP_LR_G: if (EN(OP_LR_G)) { EpiGates E; E.LOGA = (bf16_t*)(ws + WS_LOGA); E.BTERM = (bf16_t*)(ws + WS_BTERM); E.XC = (const bf16_t*)(ws + WS_XC);
            E.b_a = p->lru_b_a + (size_t)j * 2048; E.b_x = p->lru_b_x + (size_t)j * 2048; E.lam = p->lru_lam + (size_t)j * 2048;
            run_gemm(lds, (const bf16_t*)(ws + WS_XC), (const bf16_t*)(ws + WS_LRWG) + (size_t)j * 4 * 1024 * 256, 4096, 256, 1024, 256, 2, 512, E); } break;
        case OP_LR_S1: if (EN(OP_LR_S1)) lru_scan1(p); break;
        case OP_LR_S2: if (EN(OP_LR_S2)) lru_scan2(p); break;
        case OP_LR_S3: if (EN(OP_LR_S3)) lru_scan3(p); break;
        case OP_RMS2: if (EN(OP_RMS2)) phase_rms((const float*)(ws + WS_XRES), p->norm_g + ((size_t)l * 2 + 1) * 1024, MOD + (size_t)l * 2 * 6144 + 3 * 1024, MOD + (size_t)l * 2 * 6144 + 4 * 1024, (bf16_t*)(ws + WS_HBUF)); break;
        case OP_QK: if (EN(OP_QK)) { EpiScoresT E; E.C = (float*)(ws + WS_SCORES);
            run_gemm(lds, (const bf16_t*)(ws + WS_HBUF), (const bf16_t*)(ws + WS_WQK) + (size_t)l * 2048 * 1024, 2048, 1024, 1024, 1024, 0, 0, E); } break;
        case OP_TOPK: if (EN(OP_TOPK)) peer_topk(p, lds); break;
        case OP_GATHER: if (EN(OP_GATHER)) peer_gather(p, l, dry); break;
        default: break;
        }
        }
    }
}

extern "C" void kernel_launch(void* const* d_in, const int* in_sizes, int n_in, void* d_out, int out_size, void* d_ws, size_t ws_size, hipStream_t stream) {
    static int grid = 0;
    if (grid == 0) {
        if (n_in != 23 || ws_size < WS_END) { fprintf(stderr, "kernel_launch: unexpected n_in %d / ws_size %zu (need %zu)\n", n_in, ws_size, (size_t)WS_END); grid = -1; return; }
        int dev = 0, cus = 0, per_cu = 0;
        hipGetDevice(&dev); hipDeviceGetAttribute(&cus, hipDeviceAttributeMultiprocessorCount, dev);
        if (hipFuncSetAttribute((const void*)mk_fwd, hipFuncAttributeMaxDynamicSharedMemorySize, LDS_BYTES) != hipSuccess) { fprintf(stderr, "kernel_launch: hipFuncSetAttribute failed\n"); grid = -1; return; }
        if (hipOccupancyMaxActiveBlocksPerMultiprocessor(&per_cu, (const void*)mk_fwd, NTHR, LDS_BYTES) != hipSuccess || per_cu < 1) { fprintf(stderr, "kernel_launch: occupancy query failed (%d)\n", per_cu); (void)hipGetLastError(); per_cu = 1; }
        grid = cus * 1;
        fprintf(stderr, "kernel_launch: cus %d per_cu %d grid %d\n", cus, per_cu, grid);
    }
    if (grid < 0) return;
    if (hipMemsetAsync((char*)d_ws + WS_CTL, 0, 65536, stream) != hipSuccess) { fprintf(stderr, "kernel_launch: memset failed\n"); return; }
    Params p{};
    const float** pp = (const float**)&p;
    for (int i = 0; i < 23; ++i) pp[i] = (const float*)d_in[i];
    p.out = (float*)d_out; p.ws = (unsigned char*)d_ws; p.ph_lo = 0; p.ph_hi = NPH; p.rep_mask = REP_MASK;
    void* args[] = {&p};
    hipError_t e = hipLaunchCooperativeKernel((const void*)mk_fwd, dim3(grid), dim3(NTHR), args, LDS_BYTES, stream);
    if (e != hipSuccess) fprintf(stderr, "kernel_launch: cooperative launch failed: %s (grid %d)\n", hipGetErrorString(e), grid);
}
```

```cpp
#include <hip/hip_runtime.h>
#include <hip/hip_cooperative_groups.h>
#include <cstdio>
#include <cstdint>
namespace cg = cooperative_groups;

#define LAS __attribute__((address_space(3)))
#define PG8_LAS __attribute__((address_space(3)))
typedef unsigned short bf16_t;
typedef short bf16x8 __attribute__((ext_vector_type(8)));
typedef float f32x4 __attribute__((ext_vector_type(4)));
typedef float f32x2 __attribute__((ext_vector_type(2)));
typedef unsigned u32x4 __attribute__((ext_vector_type(4)));
typedef unsigned u32x2 __attribute__((ext_vector_type(2)));

constexpr int T = 16384, D = 1024, SEQ = 8192, DEPTH = 4;
constexpr float EPS = 1e-6f;
constexpr int NBLK = 256, NTHR = 512, NWAVE = 8, NGW = NBLK * NWAVE;

constexpr size_t MiB = 1u << 20;
constexpr size_t WS_CTL = 0;
constexpr size_t WS_MOD = 1 * MiB;
constexpr size_t WS_HGWIN = 2 * MiB;
constexpr size_t WS_HGWOUT = 22 * MiB;
constexpr size_t WS_LRWIN = 26 * MiB;
constexpr size_t WS_LRWG = 34 * MiB;
constexpr size_t WS_LRWOUT = 38 * MiB;
constexpr size_t WS_WQK = 42 * MiB;
constexpr size_t WS_TOPI = 58 * MiB;
constexpr size_t WS_TOPG = 66 * MiB;
constexpr size_t WS_DEC = 74 * MiB;
constexpr size_t WS_CP = 75 * MiB;
constexpr size_t WS_CH = 79 * MiB;
constexpr size_t WS_HIN = 83 * MiB;
constexpr size_t WS_USC = 87 * MiB;
constexpr size_t WS_VSC = 87 * MiB + 262144;
constexpr size_t WS_XRES = 88 * MiB;
constexpr size_t WS_HBUF = 152 * MiB;
constexpr size_t WS_OB = 184 * MiB;
constexpr size_t WS_PROJ = 216 * MiB;
constexpr size_t WS_XB = WS_PROJ, WS_YG = WS_PROJ + 32 * MiB, WS_XC = WS_PROJ + 64 * MiB, WS_LOGA = WS_PROJ + 96 * MiB;
constexpr size_t WS_SCORES = WS_PROJ;
constexpr size_t WS_KV = 376 * MiB;
constexpr size_t WS_BTERM = WS_KV;
constexpr size_t WS_SIN = 504 * MiB;
constexpr size_t WS_UTAB = 568 * MiB;
constexpr size_t WS_VTAB = 696 * MiB;
constexpr size_t WS_END = 824 * MiB;

constexpr int LDS_BYTES = 155648;

#define LAUNDER_IDS int tidL = threadIdx.x, bidL = blockIdx.x; asm volatile("" : "+v"(tidL)); asm volatile("" : "+s"(bidL));
__device__ __forceinline__ float bf2f(bf16_t b) { return __uint_as_float(((unsigned)b) << 16); }
__device__ __forceinline__ float bflo(unsigned u) { return __uint_as_float(u << 16); }
__device__ __forceinline__ float bfhi(unsigned u) { return __uint_as_float(u & 0xffff0000u); }
__device__ __forceinline__ unsigned cvt_pk_bf16(float lo, float hi) { unsigned r; asm volatile("v_cvt_pk_bf16_f32 %0, %1, %2" : "=v"(r) : "v"(lo), "v"(hi)); return r; }
__device__ __forceinline__ bf16_t f2bf(float f) { return (bf16_t)(cvt_pk_bf16(f, 0.f) & 0xffffu); }
__device__ __forceinline__ float fast_exp(float x) { return __builtin_amdgcn_exp2f(x * 1.4426950408889634f); }
__device__ __forceinline__ float fast_log(float x) { return __builtin_amdgcn_logf(x) * 0.6931471805599453f; }
__device__ __forceinline__ float fast_rcp(float x) { return __builtin_amdgcn_rcpf(x); }
__device__ __forceinline__ float sigmoidf_(float x) { return fast_rcp(1.f + fast_exp(-x)); }
__device__ __forceinline__ float gelu_tanh(float x) { const float u = 1.5957691216057308f * (x + 0.044715f * x * x * x); return x * fast_rcp(1.f + fast_exp(-u)); }
__device__ __forceinline__ float silu_(float x) { return x * sigmoidf_(x); }
__device__ __forceinline__ float wave_sum(float v) {
#pragma unroll
    for (int o = 1; o < 64; o <<= 1) v += __shfl_xor(v, o);
    return v;
}
__device__ __forceinline__ float wave_max(float v) {
#pragma unroll
    for (int o = 1; o < 64; o <<= 1) v = fmaxf(v, __shfl_xor(v, o));
    return v;
}

namespace pg8 {
constexpr int BM = 256, BK = 64, HALF = 128, HTB = HALF * BK * 2, STAGE_BYTES = 8 * HTB, NXCD = 8, WGM = 8;
__host__ __device__ __forceinline__ int lds_byte(int r, int c) { const int st = (r >> 4) * 2 + (c >> 5), rr = r & 15, cc = c & 31, ob = rr * 64 + cc * 2; return st * 1024 + (ob ^ (((ob >> 9) & 1) << 5)); }
__host__ __device__ __forceinline__ void stage_rc(int b, int& R, int& C) { const int st = b / 1024, sb = b % 1024, swz = sb ^ (((sb >> 9) & 1) << 5); R = (st >> 1) * 16 + swz / 64; C = (st & 1) * 32 + (swz % 64) / 2; }
__host__ __device__ __forceinline__ int perm32(int rho) { const int n = rho >> 4, i = rho & 15; return 8 * (i >> 2) + 4 * n + (i & 3); }
struct Unit { int pm, pn; };
struct Gemm { const bf16_t* A; const bf16_t* Bt; int M, N, K, lda, ldb, a_pn_shift, a_pn_stride; };
struct StaticOrder {
    int nM, nN, nwg, G, c;
    __host__ __device__ void init(int M, int N, int G_, int c_) { nM = M / BM; nN = N / BM; nwg = nM * nN; G = G_; c = c_; }
    __host__ __device__ bool next(int i, Unit& u) const {
        const long L = (long)i * G + c; if (L >= nwg) return false;
        int wgid = (int)L; { const int q = nwg / NXCD, r = nwg % NXCD, xcd = wgid % NXCD, off = wgid / NXCD; wgid = (xcd < r ? xcd * (q + 1) : r * (q + 1) + (xcd - r) * q) + off; }
        const int nig = WGM * nN, gid = wgid / nig, fm = gid * WGM, gsz = (nM - fm) < WGM ? (nM - fm) : WGM;
        u.pm = fm + ((wgid % nig) % gsz); u.pn = (wgid % nig) / gsz; return true;
    }
    __device__ __forceinline__ void a_ready(const Unit&) const {}
    __device__ __forceinline__ void done(const Unit&) const {}
};
template <class Epi, class Sched, bool STAMP = false>
__device__ __forceinline__ void gemm_phase(PG8_LAS unsigned char* lds, const Gemm g, const Sched& S, const Epi& E, unsigned long long* stamps) {
    int tid = threadIdx.x; asm volatile("" : "+v"(tid)); const int wid = __builtin_amdgcn_readfirstlane(tid >> 6), lane = tid & 63, wr = wid >> 2, wc = wid & 3, fr = lane & 15, fq = lane >> 4;
    const int K = g.K, nt = K / BK;
    int ts_lo = 0, ts_hi = 0, nts = 0; const unsigned long long rt_entry = STAMP ? (unsigned long long)wall_clock64() : 0ull;
#define PG8_STAMP() do { if (STAMP && wid == 0 && nts < 64) { const unsigned long long _c = (unsigned long long)clock64(); \
        ts_lo = (lane == nts) ? (int)(unsigned)_c : ts_lo; ts_hi = (lane == nts) ? (int)(unsigned)(_c >> 32) : ts_hi; ++nts; } } while (0)
    PG8_STAMP();
    unsigned voffA[2], voffB[2];
#pragma unroll
    for (int i = 0; i < 2; ++i) { int R, C; stage_rc(tid * 16 + i * 8192, R, C); const int Rb = Epi::PERM ? ((R & ~31) + perm32(R & 31)) : R;
        voffA[i] = (unsigned)(R * g.lda + C) * 2u; voffB[i] = (unsigned)(Rb * g.ldb + C) * 2u; }
    const size_t kstep = (size_t)(BK * 2);
    const size_t hstepA = (size_t)HALF * g.lda * 2, hstepB = (size_t)HALF * g.ldb * 2;
    const size_t tstepA = 2 * hstepA, tstepB = 2 * hstepB;
    const unsigned ldsw = (unsigned)wid * 1024u;
    const int aoff = lds_byte(wr * 64 + fr, fq * 8), boff = lds_byte(wc * 32 + fr, fq * 8);
#define PG8_SA(b, h) (((b) * 2 + (h)) * HTB)
#define PG8_SB(b, h) ((4 + (b) * 2 + (h)) * HTB)
#define PG8_STAGE(bufoff, gbase, voff) do { _Pragma("unroll") for (int _i = 0; _i < 2; ++_i) \
        __builtin_amdgcn_global_load_lds((const unsigned*)((const char*)(gbase) + (voff)[_i]), (PG8_LAS unsigned*)(lds + (bufoff) + ldsw + _i * 8192), 16, 0, 0); } while (0)
#define PG8_LDA(dst, b, h) do { _Pragma("unroll") for (int m = 0; m < 4; ++m) _Pragma("unroll") for (int k = 0; k < 2; ++k) dst[m][k] = *(const PG8_LAS bf16x8*)(lds + PG8_SA(b, h) + aoff + m * 2048 + k * 1024); } while (0)
#define PG8_LDB(dst, b, h) do { _Pragma("unroll") for (int n = 0; n < 2; ++n) _Pragma("unroll") for (int k = 0; k < 2; ++k) dst[n][k] = *(const PG8_LAS bf16x8*)(lds + PG8_SB(b, h) + boff + n * 2048 + k * 1024); } while (0)
#define PG8_MMA(ai, bj, At, Bt) do { __builtin_amdgcn_s_setprio(1); _Pragma("unroll") for (int m = 0; m < 4; ++m) _Pragma("unroll") for (int n = 0; n < 2; ++n) _Pragma("unroll") for (int k = 0; k < 2; ++k) \
        acc[ai][bj][m][n] = Epi::SWAP ? __builtin_amdgcn_mfma_f32_16x16x32_bf16(At[m][k], Bt[n][k], acc[ai][bj][m][n], 0, 0, 0) : __builtin_amdgcn_mfma_f32_16x16x32_bf16(Bt[n][k], At[m][k], acc[ai][bj][m][n], 0, 0, 0); __builtin_amdgcn_s_setprio(0); } while (0)
#define PG8_WAIT_V(n) asm volatile("s_waitcnt vmcnt(" #n ")" ::: "memory")
#define PG8_WAIT_L(n) asm volatile("s_waitcnt lgkmcnt(" #n ")" ::: "memory")
#define PG8_BAR __builtin_amdgcn_s_barrier()
#define PG8_SCHED __builtin_amdgcn_sched_barrier(0)
    Unit cur, nxt; int ui = 0;
    if (!S.next(0, cur)) return;
    f32x4 acc[2][2][4][2];
#pragma unroll
    for (int a = 0; a < 2; ++a)
#pragma unroll
        for (int b = 0; b < 2; ++b)
#pragma unroll
            for (int m = 0; m < 4; ++m)
#pragma unroll
                for (int n = 0; n < 2; ++n) acc[a][b][m][n] = (f32x4){0.f, 0.f, 0.f, 0.f};
    bf16x8 At[4][2], B0[2][2], B1[2][2];
    const char* cA = (const char*)g.A + (size_t)cur.pm * tstepA + (size_t)(cur.pn >> g.a_pn_shift) * g.a_pn_stride; const char* cB = (const char*)g.Bt + (size_t)cur.pn * tstepB;
    S.a_ready(cur);
    PG8_STAGE(PG8_SB(0, 0), cB, voffB); PG8_STAGE(PG8_SA(0, 0), cA, voffA); PG8_STAGE(PG8_SB(0, 1), cB + hstepB, voffB); PG8_STAGE(PG8_SA(0, 1), cA + hstepA, voffA);
    if (wr == 1) PG8_BAR;
    PG8_WAIT_V(4); PG8_BAR;
    PG8_STAGE(PG8_SB(1, 0), cB + kstep, voffB); PG8_STAGE(PG8_SA(1, 0), cA + kstep, voffA); PG8_STAGE(PG8_SB(1, 1), cB + hstepB + kstep, voffB);
    PG8_WAIT_V(6); PG8_BAR;
    PG8_STAMP();
    for (;;) {
        const bool has_next = S.next(ui + 1, nxt);
        const char* nA = has_next ? (const char*)g.A + (size_t)nxt.pm * tstepA + (size_t)(nxt.pn >> g.a_pn_shift) * g.a_pn_stride : cA; const char* nB = has_next ? (const char*)g.Bt + (size_t)nxt.pn * tstepB : cB;
#pragma unroll 1
        for (int t = 0; t < nt; t += 2) {
            const bool last = (t == nt - 2);
            const char* a1 = cA + (size_t)(t + 1) * kstep;
            const char* a2 = last ? nA : cA + (size_t)(t + 2) * kstep; const char* b2 = last ? nB : cB + (size_t)(t + 2) * kstep;
            const char* a3 = a2 + kstep; const char* b3 = b2 + kstep;
            if (last && has_next) S.a_ready(nxt);
            PG8_LDB(B0, 0, 0); PG8_SCHED; PG8_LDA(At, 0, 0); PG8_STAGE(PG8_SA(1, 1), a1 + hstepA, voffA);
            PG8_WAIT_L(8); PG8_BAR; PG8_WAIT_L(0); PG8_MMA(0, 0, At, B0); PG8_BAR; PG8_SCHED;
            PG8_LDB(B1, 0, 1); PG8_STAGE(PG8_SB(0, 0), b2, voffB);
            PG8_BAR; PG8_WAIT_L(0); PG8_MMA(0, 1, At, B1); PG8_BAR;
            PG8_LDA(At, 0, 1); PG8_STAGE(PG8_SA(0, 0), a2, voffA);
            PG8_BAR; PG8_WAIT_L(0); PG8_MMA(1, 0, At, B0); PG8_BAR; PG8_SCHED;
            PG8_STAGE(PG8_SB(0, 1), b2 + hstepB, voffB);
            PG8_WAIT_V(6); PG8_BAR; PG8_MMA(1, 1, At, B1); PG8_BAR;
            PG8_LDB(B0, 1, 0); PG8_SCHED; PG8_LDA(At, 1, 0); PG8_STAGE(PG8_SA(0, 1), a2 + hstepA, voffA);
            PG8_WAIT_L(8); PG8_BAR; PG8_WAIT_L(0); PG8_MMA(0, 0, At, B0); PG8_BAR; PG8_SCHED;
            PG8_LDB(B1, 1, 1); PG8_STAGE(PG8_SB(1, 0), b3, voffB);
            PG8_BAR; PG8_WAIT_L(0); PG8_MMA(0, 1, At, B1); PG8_BAR;
            PG8_LDA(At, 1, 1); PG8_STAGE(PG8_SA(1, 0), a3, voffA);
            PG8_BAR; PG8_WAIT_L(0); PG8_MMA(1, 0, At, B0); PG8_BAR; PG8_SCHED;
            PG8_STAGE(PG8_SB(1, 1), b3 + hstepB, voffB);
            PG8_WAIT_V(6); PG8_BAR; PG8_MMA(1, 1, At, B1); PG8_BAR;
        }
        PG8_STAMP();
        if constexpr (!Epi::AFTER_DRAIN) { E(acc, cur, wr, wc, fr, fq); S.done(cur); }
        PG8_STAMP();
        if (!has_next) break;
#pragma unroll
        for (int a = 0; a < 2; ++a)
#pragma unroll
            for (int b = 0; b < 2; ++b)
#pragma unroll
                for (int m = 0; m < 4; ++m)
#pragma unroll
                    for (int n = 0; n < 2; ++n) acc[a][b][m][n] = (f32x4){0.f, 0.f, 0.f, 0.f};
        cur = nxt; cA = nA; cB = nB; ++ui;
    }
    PG8_WAIT_V(0);
    if (wr == 0) PG8_BAR;
    PG8_BAR;
    if constexpr (Epi::AFTER_DRAIN) { E.fused(acc, cur, wr, wc, fr, fq, lds, wid, lane); S.done(cur); }
    PG8_STAMP();
    if (STAMP && wid == 0) { stamps[lane] = lane < nts ? (((unsigned long long)(unsigned)ts_hi << 32) | (unsigned)ts_lo) : 0ull;
        if (lane == 62) stamps[62] = rt_entry; if (lane == 63) stamps[63] = (unsigned long long)wall_clock64(); }
#undef PG8_STAMP
#undef PG8_SA
#undef PG8_SB
#undef PG8_STAGE
#undef PG8_LDA
#undef PG8_LDB
#undef PG8_MMA
#undef PG8_WAIT_V
#undef PG8_WAIT_L
#undef PG8_BAR
#undef PG8_SCHED
}
}
using pg8::Unit;

struct EpiBf16 {
    static constexpr bool PERM = true, AFTER_DRAIN = false, SWAP = false;
    bf16_t* O; int ldc;
    __device__ __forceinline__ void operator()(const f32x4 (&acc)[2][2][4][2], const Unit& u, int wr, int wc, int fr, int fq) const {
        const int row0 = u.pm * 256 + wr * 64 + fr, col0 = u.pn * 256 + wc * 32 + 8 * fq;
#pragma unroll
        for (int ai = 0; ai < 2; ++ai)
#pragma unroll
            for (int m = 0; m < 4; ++m) { bf16_t* rowp = O + (size_t)(row0 + ai * 128 + m * 16) * ldc + col0;
#pragma unroll
                for (int bj = 0; bj < 2; ++bj) { const f32x4 v0 = acc[ai][bj][m][0], v1 = acc[ai][bj][m][1];
                    u32x4 o; o.x = cvt_pk_bf16(v0[0], v0[1]); o.y = cvt_pk_bf16(v0[2], v0[3]); o.z = cvt_pk_bf16(v1[0], v1[1]); o.w = cvt_pk_bf16(v1[2], v1[3]);
                    *(u32x4*)(rowp + bj * 128) = o; } }
    }
};
struct EpiLruIn {
    static constexpr bool PERM = true, AFTER_DRAIN = false, SWAP = false;
    bf16_t* XB; bf16_t* YG;
    __device__ __forceinline__ void operator()(const f32x4 (&acc)[2][2][4][2], const Unit& u, int wr, int wc, int fr, int fq) const {
        const bool isy = u.pn >= 4;
        bf16_t* O = isy ? YG : XB;
        const int row0 = u.pm * 256 + wr * 64 + fr, col0 = (u.pn & 3) * 256 + wc * 32 + 8 * fq;
#pragma unroll
        for (int ai = 0; ai < 2; ++ai)
#pragma unroll
            for (int m = 0; m < 4; ++m) { bf16_t* rowp = O + (size_t)(row0 + ai * 128 + m * 16) * 1024 + col0;
#pragma unroll
                for (int bj = 0; bj < 2; ++bj) { f32x4 v0 = acc[ai][bj][m][0], v1 = acc[ai][bj][m][1];
                    if (isy) {
#pragma unroll
                        for (int i = 0; i < 4; ++i) { v0[i] = gelu_tanh(v0[i]); v1[i] = gelu_tanh(v1[i]); } }
                    u32x4 o; o.x = cvt_pk_bf16(v0[0], v0[1]); o.y = cvt_pk_bf16(v0[2], v0[3]); o.z = cvt_pk_bf16(v1[0], v1[1]); o.w = cvt_pk_bf16(v1[2], v1[3]);
                    *(u32x4*)(rowp + bj * 128) = o; } }
    }
};
struct EpiGates {
    static constexpr bool PERM = true, AFTER_DRAIN = false, SWAP = false;
    bf16_t* LOGA; bf16_t* BTERM; const bf16_t* XC; const float* b_a; const float* b_x; const float* lam;
    __device__ __forceinline__ void operator()(const f32x4 (&acc)[2][2][4][2], const Unit& u, int wr, int wc, int fr_, int fq) const {
        int fr = fr_; asm volatile("" : "+v"(fr));
        const int nblk = u.pn >> 2, uu = u.pn & 3, d = uu >> 1, jh = uu & 1;
        const int colbase = nblk * 256 + jh * 128 + wc * 32 + 8 * fq;
        const unsigned off0 = (unsigned)(u.pm * 256 + wr * 64 + fr) * 1024u + (unsigned)colbase;
        const bf16_t* xcp = XC; bf16_t* lap = LOGA + (size_t)d * T * 1024; bf16_t* btp = BTERM + (size_t)d * T * 1024;
        const float* bap = b_a + d * 1024; const float* bxp = b_x + d * 1024; const float* lmp = lam + d * 1024;
#pragma unroll
        for (int ai = 0; ai < 2; ++ai)
#pragma unroll
            for (int m = 0; m < 4; ++m) { const unsigned off = off0 + (unsigned)(ai * 128 + m * 16) * 1024u;
                asm volatile("" ::: "memory"); __builtin_amdgcn_sched_barrier(0);
                const u32x4 xr = *(const u32x4*)(xcp + off);
                const float xv[8] = {bflo(xr.x), bfhi(xr.x), bflo(xr.y), bfhi(xr.y), bflo(xr.z), bfhi(xr.z), bflo(xr.w), bfhi(xr.w)};
                unsigned o1[4], o2[4];
#pragma unroll
                for (int n = 0; n < 2; ++n) { const f32x4 ba = *(const f32x4*)(bap + (unsigned)(colbase + 4 * n)), bx = *(const f32x4*)(bxp + (unsigned)(colbase + 4 * n)), lm = *(const f32x4*)(lmp + (unsigned)(colbase + 4 * n));
                    float la[4], bt[4];
#pragma unroll
                    for (int i = 0; i < 4; ++i) { const float r = sigmoidf_(acc[ai][0][m][n][i] + ba[i]), ig = sigmoidf_(acc[ai][1][m][n][i] + bx[i]);
                        const float l = -8.f * fast_log(1.f + fast_exp(-lm[i])) * r; const float mult = __builtin_sqrtf(fmaxf(1.f - fast_exp(2.f * l), 0.f));
                        la[i] = l; bt[i] = mult * ig * xv[n * 4 + i]; }
                    o1[n * 2] = cvt_pk_bf16(la[0], la[1]); o1[n * 2 + 1] = cvt_pk_bf16(la[2], la[3]); o2[n * 2] = cvt_pk_bf16(bt[0], bt[1]); o2[n * 2 + 1] = cvt_pk_bf16(bt[2], bt[3]); }
                *(u32x4*)(lap + off) = (u32x4){o1[0], o1[1], o1[2], o1[3]}; *(u32x4*)(btp + off) = (u32x4){o2[0], o2[1], o2[2], o2[3]}; }
    }
};
struct EpiResid {
    static constexpr bool PERM = false, AFTER_DRAIN = false, SWAP = false;
    const float* xin; float* xout; const float* gate; bool dry;
    __device__ __forceinline__ void operator()(const f32x4 (&acc)[2][2][4][2], const Unit& u, int wr, int wc, int fr, int fq) const {
        const int row0 = u.pm * 256 + wr * 64 + fr, col0 = u.pn * 256 + wc * 32 + 4 * fq;
        const float* gp = gate + ((u.pm * 256) >> 13) * 6144 + col0;
        f32x4 gv[2][2];
#pragma unroll
        for (int bj = 0; bj < 2; ++bj)
#pragma unroll
            for (int n = 0; n < 2; ++n) gv[bj][n] = *(const f32x4*)(gp + bj * 128 + n * 16);
#pragma unroll
        for (int ai = 0; ai < 2; ++ai)
#pragma unroll
            for (int m = 0; m < 4; ++m) { const size_t off = (size_t)(row0 + ai * 128 + m * 16) * 1024 + col0;
#pragma unroll
                for (int bj = 0; bj < 2; ++bj)
#pragma unroll
                    for (int n = 0; n < 2; ++n) { const f32x4 xv = *(const f32x4*)(xin + off + bj * 128 + n * 16);
                        if (!dry) *(f32x4*)(xout + off + bj * 128 + n * 16) = xv + gv[bj][n] * acc[ai][bj][m][n]; } }
    }
};
struct EpiScoresT {
    static constexpr bool PERM = false, AFTER_DRAIN = false, SWAP = true;
    float* C;
    __device__ __forceinline__ void operator()(const f32x4 (&acc)[2][2][4][2], const Unit& u, int wr, int wc, int fr_, int fq) const {
        int fr = fr_; asm volatile("" : "+v"(fr));
        const unsigned off0 = (unsigned)(u.pn * 256 + wc * 32 + fr) * (unsigned)T + (unsigned)(u.pm * 256 + wr * 64 + 4 * fq);
#pragma unroll
        for (int ai = 0; ai < 2; ++ai)
#pragma unroll
            for (int m = 0; m < 4; ++m)
#pragma unroll
                for (int bj = 0; bj < 2; ++bj)
#pragma unroll
                    for (int n = 0; n < 2; ++n) *(f32x4*)(C + (off0 + (unsigned)(bj * 128 + n * 16) * (unsigned)T + (unsigned)(ai * 128 + m * 16))) = acc[ai][bj][m][n];
    }
};

struct Params {
    const float *x, *c, *w_ada, *b_ada, *norm_g, *hg_w_in, *hg_lb, *hg_norm_g, *hg_w_out, *lru_w_in, *lru_conv_w, *lru_conv_b,
        *lru_w_a, *lru_b_a, *lru_w_x, *lru_b_x, *lru_lam, *lru_w_out, *peer_w_q, *peer_keys, *peer_u, *peer_v, *final_g;
    float* out; unsigned char* ws; int ph_lo, ph_hi; unsigned rep_mask; int pad_;
};

typedef const __attribute__((address_space(4))) Params* KP;

template <class Epi>
__device__ __forceinline__ void run_gemm(LAS unsigned char* lds, const bf16_t* A, const bf16_t* Bt, int N, int K, int lda, int ldb, int a_pn_shift, int a_pn_stride, const Epi& E) {
    pg8::Gemm g; g.A = A; g.Bt = Bt; g.M = T; g.N = N; g.K = K; g.lda = lda; g.ldb = ldb; g.a_pn_shift = a_pn_shift; g.a_pn_stride = a_pn_stride;
    LAUNDER_IDS
    pg8::StaticOrder S; S.init(T, N, (int)gridDim.x, bidL); (void)tidL;
    pg8::gemm_phase<Epi, pg8::StaticOrder, false>(lds, g, S, E, nullptr);
    __syncthreads();
}

__device__ __forceinline__ void transpose_tile(const float* __restrict__ src, int ld_src, bf16_t* dst, int ld_dst, LAS float* tile, int tid) {
#pragma unroll
    for (int it = 0; it < 2; ++it) { const int r = (tid >> 4) + 32 * it, c4 = (tid & 15) * 4;
        const f32x4 v = *(const f32x4*)(src + (size_t)r * ld_src + c4);
        tile[r * 65 + c4 + 0] = v[0]; tile[r * 65 + c4 + 1] = v[1]; tile[r * 65 + c4 + 2] = v[2]; tile[r * 65 + c4 + 3] = v[3]; }
    __syncthreads();
    { const int n = tid >> 3, kc = tid & 7; const LAS float* s = tile + (kc * 8) * 65 + n;
        u32x4 o; o.x = cvt_pk_bf16(s[0], s[65]); o.y = cvt_pk_bf16(s[2 * 65], s[3 * 65]); o.z = cvt_pk_bf16(s[4 * 65], s[5 * 65]); o.w = cvt_pk_bf16(s[6 * 65], s[7 * 65]);
        *(u32x4*)(dst + (size_t)n * ld_dst + kc * 8) = o; }
    __syncthreads();
}

__device__ __forceinline__ void phase0(KP p, LAS unsigned char* lds) {
    LAUNDER_IDS
    const int tid = tidL, wave = tid >> 6, lane = tid & 63;
    unsigned char* ws = p->ws;
    LAS float* tile = (LAS float*)lds;
    constexpr int I_HGIN = 16 * 80, I_SQ = 16 * 16, I_LRIN = 16 * 32, I_G = 16;
    constexpr int N_A = 2 * I_HGIN + 2 * I_SQ + 2 * I_LRIN + 2 * I_SQ + 32 * I_G;
    for (int it = bidL; it < N_A; it += gridDim.x) {
        int r = it;
        if (r < 2 * I_HGIN) { const int j = r / I_HGIN, q = r % I_HGIN, kb = q / 80, nb = q % 80;
            transpose_tile(p->hg_w_in + (size_t)j * 1024 * 5120 + (size_t)kb * 64 * 5120 + nb * 64, 5120, (bf16_t*)(ws + WS_HGWIN) + (size_t)j * 5120 * 1024 + (size_t)nb * 64 * 1024 + kb * 64, 1024, tile, tid); continue; }
        r -= 2 * I_HGIN;
        if (r < 2 * I_SQ) { const int j = r / I_SQ, q = r % I_SQ, kb = q / 16, nb = q % 16;
            transpose_tile(p->hg_w_out + (size_t)j * 1024 * 1024 + (size_t)kb * 64 * 1024 + nb * 64, 1024, (bf16_t*)(ws + WS_HGWOUT) + (size_t)j * 1024 * 1024 + (size_t)nb * 64 * 1024 + kb * 64, 1024, tile, tid); continue; }
        r -= 2 * I_SQ;
        if (r < 2 * I_LRIN) { const int j = r / I_LRIN, q = r % I_LRIN, kb = q / 32, nb = q % 32;
            transpose_tile(p->lru_w_in + (size_t)j * 1024 * 2048 + (size_t)kb * 64 * 2048 + nb * 64, 2048, (bf16_t*)(ws + WS_LRWIN) + (size_t)j * 2048 * 1024 + (size_t)nb * 64 * 1024 + kb * 64, 1024, tile, tid); continue; }
        r -= 2 * I_LRIN;
        if (r < 2 * I_SQ) { const int j = r / I_SQ, q = r % I_SQ, kb = q / 16, nb = q % 16;
            transpose_tile(p->lru_w_out + (size_t)j * 1024 * 1024 + (size_t)kb * 64 * 1024 + nb * 64, 1024, (bf16_t*)(ws + WS_LRWOUT) + (size_t)j * 1024 * 1024 + (size_t)nb * 64 * 1024 + kb * 64, 1024, tile, tid); continue; }
        r -= 2 * I_SQ;
        { const int mat = r / I_G, q = r % I_G, kb = q / 4, nb = q % 4;
            const int nblk = mat & 3, gate = (mat >> 2) & 1, d = (mat >> 3) & 1, l = mat >> 4;
            const float* src = (gate ? p->lru_w_x : p->lru_w_a) + (size_t)((l * 2 + d) * 4 + nblk) * 65536 + (size_t)kb * 64 * 256 + nb * 64;
            const int n0 = nb * 64, jh = n0 >> 7;
            bf16_t* dst = (bf16_t*)(ws + WS_LRWG) + (size_t)l * 4 * 1024 * 256 + (size_t)nblk * 1024 * 256 + (size_t)((d * 2 + jh) * 256 + gate * 128 + (n0 & 127)) * 256 + kb * 64;
            transpose_tile(src, 256, dst, 256, tile, tid); }
    }
    {
        LAS float* keysL = (LAS float*)lds;
        LAS float* wqL = (LAS float*)(lds + 128 * 132 * 4);
        for (int it = bidL; it < 1024; it += gridDim.x) {
            const int l = it >> 8, hp = (it >> 4) & 15, dt = it & 15;
            const float* kp = p->peer_keys + ((size_t)l * 16 + hp) * 16384;
#pragma unroll
            for (int q = 0; q < 8; ++q) { const int e = (tid + 512 * q) * 4; const f32x4 v = *(const f32x4*)(kp + e); *(LAS f32x4*)(keysL + (e >> 7) * 132 + (e & 127)) = v; }
            const float* wp = p->peer_w_q + (size_t)l * 1024 * 2048 + (size_t)(dt * 64) * 2048 + hp * 128;
#pragma unroll
            for (int q = 0; q < 4; ++q) { const int e = (tid + 512 * q) * 4; const f32x4 v = *(const f32x4*)(wp + (size_t)(e >> 7) * 2048 + (e & 127)); *(LAS f32x4*)(wqL + e) = v; }
            __syncthreads();
            const int key = tid & 127, g = tid >> 7;
            float acc[16];
#pragma unroll
            for (int i = 0; i < 16; ++i) acc[i] = 0.f;
            for (int d4 = 0; d4 < 128; d4 += 4) {
                const f32x4 kv = *(const LAS f32x4*)(keysL + key * 132 + d4);
#pragma unroll
                for (int i = 0; i < 16; ++i) { const f32x4 wv = *(const LAS f32x4*)(wqL + (g * 16 + i) * 128 + d4);
                    acc[i] += kv[0] * wv[0] + kv[1] * wv[1] + kv[2] * wv[2] + kv[3] * wv[3]; }
            }
            bf16_t* op = (bf16_t*)(ws + WS_WQK) + (size_t)l * 2048 * 1024 + (size_t)(hp * 128 + key) * 1024 + dt * 64 + g * 16;
            u32x4 o1, o2; o1.x = cvt_pk_bf16(acc[0], acc[1]); o1.y = cvt_pk_bf16(acc[2], acc[3]); o1.z = cvt_pk_bf16(acc[4], acc[5]); o1.w = cvt_pk_bf16(acc[6], acc[7]);
            o2.x = cvt_pk_bf16(acc[8], acc[9]); o2.y = cvt_pk_bf16(acc[10], acc[11]); o2.z = cvt_pk_bf16(acc[12], acc[13]); o2.w = cvt_pk_bf16(acc[14], acc[15]);
            *(u32x4*)op = o1; *(u32x4*)(op + 8) = o2;
            __syncthreads();
        }
    }
    {
        LAS float* condL = (LAS float*)lds;
        LAS float* red = (LAS float*)(lds + 8192);
        for (int i = tid; i < 2048; i += NTHR) condL[i] = silu_(p->c[i]);
        __syncthreads();
        for (int it = bidL; it < 4 * 48; it += gridDim.x) {
            const int l = it / 48, col0 = (it % 48) * 128;
            const float* wp = p->w_ada + (size_t)l * 1024 * 6144 + col0 + 2 * lane;
            float a00 = 0.f, a01 = 0.f, a10 = 0.f, a11 = 0.f;
#pragma unroll 8
            for (int kk = 0; kk < 128; ++kk) { const int k = wave * 128 + kk; const f32x2 w = *(const f32x2*)(wp + (size_t)k * 6144);
                const float c0 = condL[k], c1 = condL[1024 + k];
                a00 += c0 * w[0]; a01 += c0 * w[1]; a10 += c1 * w[0]; a11 += c1 * w[1]; }
            red[(wave * 2 + 0) * 128 + 2 * lane] = a00; red[(wave * 2 + 0) * 128 + 2 * lane + 1] = a01;
            red[(wave * 2 + 1) * 128 + 2 * lane] = a10; red[(wave * 2 + 1) * 128 + 2 * lane + 1] = a11;
            __syncthreads();
            if (tid < 256) { const int b = tid >> 7, cc = tid & 127; float s = 0.f;
#pragma unroll
                for (int w = 0; w < 8; ++w) s += red[(w * 2 + b) * 128 + cc];
                ((float*)(ws + WS_MOD))[((size_t)l * 2 + b) * 6144 + col0 + cc] = s + p->b_ada[(size_t)l * 6144 + col0 + cc]; }
            __syncthreads();
        }
    }
    {
        for (int row = bidL * NWAVE + wave; row < 2 * 65536; row += gridDim.x * NWAVE) {
            const int tb = row >> 16, r = row & 65535;
            const float* src = (tb ? p->peer_v : p->peer_u) + (size_t)r * 1024 + 4 * lane;
            f32x4 v[4]; float am = 0.f;
#pragma unroll
            for (int jx = 0; jx < 4; ++jx) { v[jx] = __builtin_nontemporal_load((const f32x4*)(src + 256 * jx));
                am = fmaxf(am, fmaxf(fmaxf(fabsf(v[jx][0]), fabsf(v[jx][1])), fmaxf(fabsf(v[jx][2]), fabsf(v[jx][3])))); }
            am = wave_max(am);
            const float sc = am > 0.f ? am * (1.f / 448.f) : 1.f, inv = am > 0.f ? 448.f / am : 1.f;
            unsigned char* dst = ws + (tb ? WS_VTAB : WS_UTAB) + (size_t)r * 1024 + 4 * lane;
#pragma unroll
            for (int jx = 0; jx < 4; ++jx) { int w = __builtin_amdgcn_cvt_pk_fp8_f32(v[jx][0] * inv, v[jx][1] * inv, 0, false);
                w = __builtin_amdgcn_cvt_pk_fp8_f32(v[jx][2] * inv, v[jx][3] * inv, w, true);
                *(int*)(dst + 256 * jx) = w; }
            if (lane == 0) ((float*)(ws + (tb ? WS_VSC : WS_USC)))[r] = sc;
        }
    }
}

__device__ __forceinline__ void phase_rms(const float* xin, const float* gain, const float* shift, const float* scale, bf16_t* hout) {
    LAUNDER_IDS
    const int tid = tidL, wave = tid >> 6, lane = tid & 63;
    for (int row = bidL * NWAVE + wave; row < T; row += gridDim.x * NWAVE) {
        const int b = row >> 13;
        const float* xr = xin + (size_t)row * 1024 + lane * 4;
        f32x4 v[4]; float ss = 0.f;
#pragma unroll
        for (int j = 0; j < 4; ++j) { v[j] = *(const f32x4*)(xr + j * 256); ss += v[j][0] * v[j][0] + v[j][1] * v[j][1] + v[j][2] * v[j][2] + v[j][3] * v[j][3]; }
        const float inv = __builtin_amdgcn_rsqf(wave_sum(ss) * (1.f / 1024.f) + EPS);
#pragma unroll
        for (int j = 0; j < 4; ++j) { const int col = j * 256 + lane * 4;
            const f32x4 g = *(const f32x4*)(gain + col), sh = *(const f32x4*)(shift + b * 6144 + col), sc = *(const f32x4*)(scale + b * 6144 + col);
            const f32x4 y = (v[j] * inv) * g * (1.f + sc) + sh;
            u32x2 o; o.x = cvt_pk_bf16(y[0], y[1]); o.y = cvt_pk_bf16(y[2], y[3]);
            *(u32x2*)(hout + (size_t)row * 1024 + col) = o; }
    }
}

constexpr int LROW = 136;
__device__ __forceinline__ float hg_lower_bound(const float* hg_lb, int j, int col) {
    if (j == 0) return 0.f;
    const float l0 = hg_lb[col], l1 = hg_lb[1024 + col];
    return fast_rcp(1.f + fast_exp(l0 - l1));
}
__device__ __forceinline__ f32x4 mfma16(bf16x8 a, bf16x8 b, f32x4 c) { return __builtin_amdgcn_mfma_f32_16x16x32_bf16(a, b, c, 0, 0, 0); }

__device__ __forceinline__ void load_vt(const bf16_t* proj, LAS bf16_t* VT, int t0, int dir, int h, int tid) {
#pragma unroll
    for (int it = 0; it < 4; ++it) { const int idx = tid + 512 * it, tau = idx & 127, cv = idx >> 7;
        const int tok = dir ? t0 + 127 - tau : t0 + tau;
        const u32x4 v = *(const u32x4*)(proj + (size_t)tok * 5120 + 3072 + h * 128 + cv * 8);
        LAS bf16_t* d = VT + (cv * 8) * LROW + tau;
        d[0 * LROW] = (bf16_t)(v.x & 0xffff); d[1 * LROW] = (bf16_t)(v.x >> 16); d[2 * LROW] = (bf16_t)(v.y & 0xffff); d[3 * LROW] = (bf16_t)(v.y >> 16);
        d[4 * LROW] = (bf16_t)(v.z & 0xffff); d[5 * LROW] = (bf16_t)(v.z >> 16); d[6 * LROW] = (bf16_t)(v.w & 0xffff); d[7 * LROW] = (bf16_t)(v.w >> 16); }
}

__device__ __forceinline__ void hg_pass_a(KP p, LAS unsigned char* lds, int j) {
    LAUNDER_IDS
    const bf16_t* proj = (const bf16_t*)(p->ws + WS_PROJ);
    float* KV = (float*)(p->ws + WS_KV); float* DEC = (float*)(p->ws + WS_DEC);
    LAS bf16_t* VT = (LAS bf16_t*)lds; LAS bf16_t* KT = (LAS bf16_t*)(lds + 34816); LAS float* TOT = (LAS float*)(lds + 69632);
    for (int u = bidL; u < 2048; u += gridDim.x) {
        int tid = tidL; asm volatile("" : "+v"(tid));
        const int wave = tid >> 6, lane = tid & 63;
        const int seq = u >> 6, c = u & 63, dir = seq & 1, h = (seq >> 1) & 7, b = seq >> 4;
        const int t0 = b * SEQ + c * 128;
        const int dk = tid & 127, g = tid >> 7;
        const float lb = hg_lower_bound(p->hg_lb, j, h * 128 + dk);
        float lcs[32], kks[32]; float lc = 0.f;
        const bf16_t* zp = proj + 1024 * (1 + dir) + h * 128 + dk;
#pragma unroll
        for (int q = 0; q < 32; ++q) { const int tau = 32 * g + q, tok = dir ? t0 + 127 - tau : t0 + tau;
            const float z = bf2f(zp[(size_t)tok * 5120]);
            const float f = lb + (1.f - lb) * sigmoidf_(z);
            lc += fast_log(f); lcs[q] = lc; kks[q] = 1.f - f; }
        TOT[g * 128 + dk] = lc;
        load_vt(proj, VT, t0, dir, h, tid);
        __syncthreads();
        float rg = 0.f, total = 0.f;
#pragma unroll
        for (int gg = 0; gg < 4; ++gg) { const float tv = TOT[gg * 128 + dk]; total += tv; if (gg < g) rg += tv; }
        const float base = total - rg;
#pragma unroll
        for (int q8 = 0; q8 < 4; ++q8) { unsigned w[4];
#pragma unroll
            for (int e = 0; e < 4; ++e) { const int q = q8 * 8 + e * 2;
                w[e] = cvt_pk_bf16(kks[q] * fast_exp(base - lcs[q]), kks[q + 1] * fast_exp(base - lcs[q + 1])); }
            u32x4 o; o.x = w[0]; o.y = w[1]; o.z = w[2]; o.w = w[3];
            *(LAS u32x4*)(KT + dk * LROW + 32 * g + q8 * 8) = o; }
        if (g == 0) DEC[(size_t)u * 128 + dk] = fast_exp(total);
        __syncthreads();
        f32x4 acc[2][4];
#pragma unroll
        for (int a = 0; a < 2; ++a)
#pragma unroll
            for (int bb = 0; bb < 4; ++bb) acc[a][bb] = (f32x4){0.f, 0.f, 0.f, 0.f};
        const int l15 = lane & 15, lq = lane >> 4;
#pragma unroll
        for (int ks = 0; ks < 4; ++ks) {
            bf16x8 af[2], bfr[4];
#pragma unroll
            for (int a = 0; a < 2; ++a) af[a] = *(const LAS bf16x8*)(VT + (((wave & 3) * 2 + a) * 16 + l15) * LROW + ks * 32 + lq * 8);
#pragma unroll
            for (int bb = 0; bb < 4; ++bb) bfr[bb] = *(const LAS bf16x8*)(KT + (((wave >> 2) * 4 + bb) * 16 + l15) * LROW + ks * 32 + lq * 8);
#pragma unroll
            for (int a = 0; a < 2; ++a)
#pragma unroll
                for (int bb = 0; bb < 4; ++bb) acc[a][bb] = mfma16(af[a], bfr[bb], acc[a][bb]);
        }
        float* kvp = KV + (size_t)u * 16384;
#pragma unroll
        for (int a = 0; a < 2; ++a)
#pragma unroll
            for (int bb = 0; bb < 4; ++bb)
#pragma unroll
                for (int r = 0; r < 4; ++r) kvp[(((wave & 3) * 2 + a) * 16 + lq * 4 + r) * 128 + ((wave >> 2) * 4 + bb) * 16 + l15] = acc[a][bb][r];
        __syncthreads();
    }
}

__device__ __forceinline__ void hg_pass_b(KP p) {
    LAUNDER_IDS
    const float* KV = (const float*)(p->ws + WS_KV); const float* DEC = (const float*)(p->ws + WS_DEC);
    bf16_t* SIN = (bf16_t*)(p->ws + WS_SIN);
    for (int e = bidL * NTHR + tidL; e < 131072; e += gridDim.x * NTHR) {
    const int seq = e >> 12, i4 = e & 4095, dir = seq & 1, dk = (i4 * 4) & 127;
    f32x4 S = {0.f, 0.f, 0.f, 0.f};
#pragma unroll 8
    for (int step = 0; step < 64; ++step) {
        const int c = dir ? 63 - step : step; const size_t u = (size_t)seq * 64 + c;
        const f32x4 kv = *(const f32x4*)(KV + u * 16384 + i4 * 4); const f32x4 dc = *(const f32x4*)(DEC + u * 128 + dk);
        u32x2 o; o.x = cvt_pk_bf16(S[0], S[1]); o.y = cvt_pk_bf16(S[2], S[3]);
        *(u32x2*)(SIN + u * 16384 + i4 * 4) = o;
        S = dc * S + kv;
    }
    }
}

__device__ __forceinline__ void hg_pass_c(KP p, LAS unsigned char* lds, int j) {
    LAUNDER_IDS
    const bf16_t* proj = (const bf16_t*)(p->ws + WS_PROJ);
    const bf16_t* SIN = (const bf16_t*)(p->ws + WS_SIN);
    bf16_t* OB = (bf16_t*)(p->ws + WS_OB);
    LAS bf16_t* QT = (LAS bf16_t*)lds; LAS bf16_t* QI = (LAS bf16_t*)(lds + 34816); LAS bf16_t* KT = (LAS bf16_t*)(lds + 69632);
    LAS bf16_t* VT = (LAS bf16_t*)(lds + 104448); LAS bf16_t* PI = (LAS bf16_t*)(lds + 139264); LAS float* TOT = (LAS float*)(lds + 147968);
    LAS float* OSUM = (LAS float*)(lds + 69632);
    for (int u = bidL; u < 1024; u += gridDim.x) {
        int tid = tidL; asm volatile("" : "+v"(tid));
        const int wave = tid >> 6, lane = tid & 63, l15 = lane & 15, lq = lane >> 4;
        const int c = u & 63, h = (u >> 6) & 7, b = u >> 9;
        const int t0 = b * SEQ + c * 128;
        const int dk = tid & 127, g = tid >> 7;
        const float lb = hg_lower_bound(p->hg_lb, j, h * 128 + dk);
        const int tt = wave & 1, dvt0 = (wave >> 1) * 2;
        f32x4 oacc[2][4][2];
#pragma unroll
        for (int dir = 0; dir < 2; ++dir) {
            const size_t su = ((size_t)((b * 8 + h) * 2 + dir) * 64 + c);
            unsigned k0p[16]; float lc = 0.f; float kprev = 0.f;
            const bf16_t* zp = proj + 1024 * (1 + dir) + h * 128 + dk; const bf16_t* qp = proj + h * 128 + dk;
#pragma unroll
            for (int q = 0; q < 32; ++q) { const int tau = 32 * g + q, tok = dir ? t0 + 127 - tau : t0 + tau;
                const float z = bf2f(zp[(size_t)tok * 5120]), qv = bf2f(qp[(size_t)tok * 5120]);
                const float f = lb + (1.f - lb) * sigmoidf_(z);
                lc += fast_log(f);
                const float el = fast_exp(fmaxf(lc, -80.f));
                QT[tau * LROW + dk] = f2bf(qv * el);
                const float kcur = (1.f - f) * fast_rcp(el);
                if (q & 1) k0p[q >> 1] = cvt_pk_bf16(kprev, kcur); else kprev = kcur; }
            TOT[g * 128 + dk] = lc;
            __syncthreads();
            float r[4]; { float run = 0.f;
#pragma unroll
                for (int gg = 0; gg < 4; ++gg) { r[gg] = run; run += TOT[gg * 128 + dk]; } }
            float rg = 0.f;
#pragma unroll
            for (int gg = 0; gg < 4; ++gg) if (gg == g) rg = r[gg];
            { const float eg = fast_exp(rg);
#pragma unroll
                for (int q = 0; q < 32; ++q) QI[(32 * g + q) * LROW + dk] = f2bf(bf2f(QT[(32 * g + q) * LROW + dk]) * eg); }
            load_vt(proj, VT, t0, dir, h, tid);
            bf16x8 sfr[2][4];
#pragma unroll
            for (int n = 0; n < 2; ++n)
#pragma unroll
                for (int ks = 0; ks < 4; ++ks) sfr[n][ks] = *(const bf16x8*)(SIN + su * 16384 + (size_t)((dvt0 + n) * 16 + l15) * 128 + ks * 32 + lq * 8);
#pragma unroll
            for (int i = 0; i < 4; ++i) {
                if (g <= i) { const float e = fast_exp(r[i] - rg);
#pragma unroll
                    for (int q = 0; q < 32; ++q) KT[(32 * g + q) * LROW + dk] = f2bf(((q & 1) ? bfhi(k0p[q >> 1]) : bflo(k0p[q >> 1])) * e); }
                __syncthreads();
                for (int tl = wave; tl < 4 * (i + 1); tl += 8) { const int sm = tl >> 1, tn = tl & 1;
                    f32x4 a4 = {0.f, 0.f, 0.f, 0.f};
#pragma unroll
                    for (int ks = 0; ks < 4; ++ks) { const bf16x8 af = *(const LAS bf16x8*)(KT + (sm * 16 + l15) * LROW + ks * 32 + lq * 8);
                        const bf16x8 bq = *(const LAS bf16x8*)(QT + (32 * i + tn * 16 + l15) * LROW + ks * 32 + lq * 8);
                        a4 = mfma16(af, bq, a4); }
                    const int tloc = tn * 16 + l15, s0 = sm * 16 + lq * 4, tg = 32 * i + tloc;
                    u32x2 o; o.x = cvt_pk_bf16(s0 + 0 <= tg ? a4[0] : 0.f, s0 + 1 <= tg ? a4[1] : 0.f); o.y = cvt_pk_bf16(s0 + 2 <= tg ? a4[2] : 0.f, s0 + 3 <= tg ? a4[3] : 0.f);
                    *(LAS u32x2*)(PI + tloc * LROW + s0) = o; }
                __syncthreads();
                f32x4 a0 = {0.f, 0.f, 0.f, 0.f}, a1 = {0.f, 0.f, 0.f, 0.f};
                for (int ks = 0; ks <= i; ++ks) { const bf16x8 af = *(const LAS bf16x8*)(PI + (tt * 16 + l15) * LROW + ks * 32 + lq * 8);
                    const bf16x8 b0 = *(const LAS bf16x8*)(VT + ((dvt0 + 0) * 16 + l15) * LROW + ks * 32 + lq * 8);
                    const bf16x8 b1 = *(const LAS bf16x8*)(VT + ((dvt0 + 1) * 16 + l15) * LROW + ks * 32 + lq * 8);
                    a0 = mfma16(af, b0, a0); a1 = mfma16(af, b1, a1); }
#pragma unroll
                for (int ks = 0; ks < 4; ++ks) { const bf16x8 af = *(const LAS bf16x8*)(QI + (32 * i + tt * 16 + l15) * LROW + ks * 32 + lq * 8);
                    a0 = mfma16(af, sfr[0][ks], a0); a1 = mfma16(af, sfr[1][ks], a1); }
                oacc[dir][i][0] = a0; oacc[dir][i][1] = a1;
            }
        }
        __syncthreads();
#pragma unroll
        for (int i = 0; i < 4; ++i)
#pragma unroll
            for (int n = 0; n < 2; ++n)
#pragma unroll
                for (int rr = 0; rr < 4; ++rr) OSUM[(32 * i + tt * 16 + lq * 4 + rr) * 132 + (dvt0 + n) * 16 + l15] = oacc[0][i][n][rr];
        __syncthreads();
#pragma unroll
        for (int i = 0; i < 4; ++i)
#pragma unroll
            for (int n = 0; n < 2; ++n)
#pragma unroll
                for (int rr = 0; rr < 4; ++rr) OSUM[(127 - (32 * i + tt * 16 + lq * 4 + rr)) * 132 + (dvt0 + n) * 16 + l15] += oacc[1][i][n][rr];
        __syncthreads();
        { const int row = tid >> 2, part = tid & 3; const int tok = t0 + row;
            float ov[32]; float ss = 0.f;
#pragma unroll
            for (int q = 0; q < 8; ++q) { const f32x4 v = *(const LAS f32x4*)(OSUM + row * 132 + part * 32 + q * 4);
                ov[q * 4 + 0] = v[0]; ov[q * 4 + 1] = v[1]; ov[q * 4 + 2] = v[2]; ov[q * 4 + 3] = v[3]; ss += v[0] * v[0] + v[1] * v[1] + v[2] * v[2] + v[3] * v[3]; }
            ss += __shfl_xor(ss, 1); ss += __shfl_xor(ss, 2);
            const float inv = __builtin_amdgcn_rsqf(ss * (1.f / 128.f) + EPS);
            const int col = h * 128 + part * 32;
            const bf16_t* gp = proj + (size_t)tok * 5120 + 4096 + col; const float* ng = p->hg_norm_g + j * 1024 + col;
#pragma unroll
            for (int q = 0; q < 4; ++q) { const u32x4 gr = *(const u32x4*)(gp + q * 8);
                const float gv[8] = {bflo(gr.x), bfhi(gr.x), bflo(gr.y), bfhi(gr.y), bflo(gr.z), bfhi(gr.z), bflo(gr.w), bfhi(gr.w)};
                float y[8];
#pragma unroll
                for (int e = 0; e < 8; ++e) y[e] = ov[q * 8 + e] * inv * ng[q * 8 + e] * silu_(gv[e]);
                u32x4 o; o.x = cvt_pk_bf16(y[0], y[1]); o.y = cvt_pk_bf16(y[2], y[3]); o.z = cvt_pk_bf16(y[4], y[5]); o.w = cvt_pk_bf16(y[6], y[7]);
                *(u32x4*)(OB + (size_t)tok * 1024 + col + q * 8) = o; }
        }
        __syncthreads();
    }
}

__device__ __forceinline__ void lru_conv(KP p, int l) {
    LAUNDER_IDS
    const bf16_t* XB = (const bf16_t*)(p->ws + WS_XB); bf16_t* XC = (bf16_t*)(p->ws + WS_XC);
    const float* cw = p->lru_conv_w + (size_t)l * 4 * 1024; const float* cb = p->lru_conv_b + (size_t)l * 1024;
    const int gs = gridDim.x * NTHR;
    for (int it = bidL * NTHR + tidL; it < T * 128; it += gs) {
        const int tok = it >> 7, c8 = (it & 127) * 8, s = tok & (SEQ - 1);
        float acc[8];
        { const f32x4 b0 = *(const f32x4*)(cb + c8), b1 = *(const f32x4*)(cb + c8 + 4);
            acc[0] = b0[0]; acc[1] = b0[1]; acc[2] = b0[2]; acc[3] = b0[3]; acc[4] = b1[0]; acc[5] = b1[1]; acc[6] = b1[2]; acc[7] = b1[3]; }
#pragma unroll
        for (int jj = 0; jj < 4; ++jj) { const int ts = s + jj - 2;
            if (ts >= 0 && ts < SEQ) { const u32x4 xr = *(const u32x4*)(XB + (size_t)(tok + jj - 2) * 1024 + c8);
                const f32x4 w0 = *(const f32x4*)(cw + jj * 1024 + c8), w1 = *(const f32x4*)(cw + jj * 1024 + c8 + 4);
                acc[0] += bflo(xr.x) * w0[0]; acc[1] += bfhi(xr.x) * w0[1]; acc[2] += bflo(xr.y) * w0[2]; acc[3] += bfhi(xr.y) * w0[3];
                acc[4] += bflo(xr.z) * w1[0]; acc[5] += bfhi(xr.z) * w1[1]; acc[6] += bflo(xr.w) * w1[2]; acc[7] += bfhi(xr.w) * w1[3]; } }
        u32x4 o; o.x = cvt_pk_bf16(acc[0], acc[1]); o.y = cvt_pk_bf16(acc[2], acc[3]); o.z = cvt_pk_bf16(acc[4], acc[5]); o.w = cvt_pk_bf16(acc[6], acc[7]);
        *(u32x4*)(XC + (size_t)tok * 1024 + c8) = o;
    }
}
__device__ __forceinline__ void lru_scan1(KP p) {
    LAUNDER_IDS
    const bf16_t* LOGA = (const bf16_t*)(p->ws + WS_LOGA); const bf16_t* BT = (const bf16_t*)(p->ws + WS_BTERM);
    float* CP = (float*)(p->ws + WS_CP); float* CH = (float*)(p->ws + WS_CH);
    const int ch = 2 * tidL;
    for (int u = bidL; u < 1024; u += gridDim.x) {
        const int chunk = u & 255, dir = (u >> 8) & 1, b = u >> 9;
        const size_t base = ((size_t)dir * T + b * SEQ + chunk * 32) * 1024 + ch;
        float h0 = 0.f, h1 = 0.f, s0 = 0.f, s1 = 0.f;
#pragma unroll 8
        for (int q = 0; q < 32; ++q) { const int t = dir ? 31 - q : q;
            const unsigned lw = *(const unsigned*)(LOGA + base + (size_t)t * 1024), bw = *(const unsigned*)(BT + base + (size_t)t * 1024);
            const float l0 = bflo(lw), l1 = bfhi(lw);
            h0 = fast_exp(l0) * h0 + bflo(bw); h1 = fast_exp(l1) * h1 + bfhi(bw); s0 += l0; s1 += l1; }
        const size_t o = ((size_t)(b * 2 + dir) * 256 + chunk) * 1024 + ch;
        *(f32x2*)(CP + o) = (f32x2){fast_exp(s0), fast_exp(s1)}; *(f32x2*)(CH + o) = (f32x2){h0, h1};
    }
}
__device__ __forceinline__ void lru_scan2(KP p) {
    LAUNDER_IDS
    const float* CP = (const float*)(p->ws + WS_CP); const float* CH = (const float*)(p->ws + WS_CH); float* HIN = (float*)(p->ws + WS_HIN);
    const int wave = tidL >> 6, lane = tidL & 63;
    for (int item = bidL * NWAVE + wave; item < 4096; item += gridDim.x * NWAVE) {
        const int ch = item & 1023, bd = item >> 10, dir = bd & 1;
        float pp[4], hh[4]; float Pl = 1.f, Hl = 0.f;
#pragma unroll
        for (int q = 0; q < 4; ++q) { const int ci = 4 * lane + q, chunk = dir ? 255 - ci : ci; const size_t o = ((size_t)bd * 256 + chunk) * 1024 + ch;
            pp[q] = CP[o]; hh[q] = CH[o]; Hl = pp[q] * Hl + hh[q]; Pl *= pp[q]; }
#pragma unroll
        for (int off = 1; off < 64; off <<= 1) { const float Pp = __shfl_up(Pl, off), Hp = __shfl_up(Hl, off);
            if (lane >= off) { Hl = Pl * Hp + Hl; Pl = Pl * Pp; } }
        float carry = __shfl_up(Hl, 1); if (lane == 0) carry = 0.f;
#pragma unroll
        for (int q = 0; q < 4; ++q) { const int ci = 4 * lane + q, chunk = dir ? 255 - ci : ci; const size_t o = ((size_t)bd * 256 + chunk) * 1024 + ch;
            HIN[o] = carry; carry = pp[q] * carry + hh[q]; }
    }
}
__device__ __forceinline__ void lru_scan3(KP p) {
    LAUNDER_IDS
    const bf16_t* LOGA = (const bf16_t*)(p->ws + WS_LOGA); const bf16_t* BT = (const bf16_t*)(p->ws + WS_BTERM); const bf16_t* YG = (const bf16_t*)(p->ws + WS_YG);
    const float* HIN = (const float*)(p->ws + WS_HIN); bf16_t* OB = (bf16_t*)(p->ws + WS_OB);
    const int ch = 2 * tidL;
    for (int u = bidL; u < 512; u += gridDim.x) {
        const int chunk = u & 255, b = u >> 8;
        const size_t tok0 = (size_t)b * SEQ + chunk * 32;
        const f32x2 hf = *(const f32x2*)(HIN + ((size_t)(b * 2 + 0) * 256 + chunk) * 1024 + ch), hb = *(const f32x2*)(HIN + ((size_t)(b * 2 + 1) * 256 + chunk) * 1024 + ch);
        float hs0[32], hs1[32]; float h0 = hf[0], h1 = hf[1];
#pragma unroll
        for (int q = 0; q < 32; ++q) { const size_t o = (tok0 + q) * 1024 + ch;
            const unsigned lw = *(const unsigned*)(LOGA + o), bw = *(const unsigned*)(BT + o);
            h0 = fast_exp(bflo(lw)) * h0 + bflo(bw); h1 = fast_exp(bfhi(lw)) * h1 + bfhi(bw); hs0[q] = h0; hs1[q] = h1; }
        h0 = hb[0]; h1 = hb[1];
#pragma unroll
        for (int q = 31; q >= 0; --q) { const size_t o = (tok0 + q) * 1024 + ch;
            const unsigned lw = *(const unsigned*)(LOGA + (size_t)T * 1024 + o), bw = *(const unsigned*)(BT + (size_t)T * 1024 + o), yw = *(const unsigned*)(YG + o);
            h0 = fast_exp(bflo(lw)) * h0 + bflo(bw); h1 = fast_exp(bfhi(lw)) * h1 + bfhi(bw);
            *(unsigned*)(OB + o) = cvt_pk_bf16((hs0[q] + h0) * bflo(yw), (hs1[q] + h1) * bfhi(yw)); }
    }
}

__device__ const unsigned char STAIR[64] = {
    0x00, 0x01, 0x02, 0x03, 0x04, 0x05, 0x06, 0x07, 0x08, 0x09, 0x0a, 0x0b, 0x0c, 0x0d, 0x0e, 0x0f,
    0x10, 0x11, 0x12, 0x13, 0x14, 0x15, 0x16, 0x17, 0x20, 0x21, 0x22, 0x23, 0x24, 0x30, 0x31, 0x32,
    0x33, 0x40, 0x41, 0x42, 0x50, 0x51, 0x60, 0x61, 0x70, 0x71, 0x80, 0x90, 0xa0, 0xb0, 0xc0, 0xd0,
    0xe0, 0xf0, 0, 0, 0, 0, 0, 0, 0, 0, 0, 0, 0, 0, 0, 0};
__device__ __forceinline__ unsigned mono_key(float f) { const unsigned b = __float_as_uint(f); return b ^ ((b >> 31) ? 0xffffffffu : 0x80000000u); }

__device__ __forceinline__ float inv_mono(unsigned k) { return __uint_as_float(k ^ ((k >> 31) ? 0x80000000u : 0xffffffffu)); }
#define TK_INSERT(L, x) do { _Pragma("unroll") for (int q_ = 0; q_ < 16; ++q_) { const unsigned hi_ = max(L[q_], x); x = min(L[q_], x); L[q_] = hi_; } } while (0)
__device__ __forceinline__ void peer_topk(KP p, LAS unsigned char* lds) {
    LAUNDER_IDS
    (void)bidL;
    const int tid = tidL, wave = tid >> 6, lane = tid & 63;
    const float* SCT = (const float*)(p->ws + WS_SCORES);
    int* TOPI = (int*)(p->ws + WS_TOPI); float* TOPG = (float*)(p->ws + WS_TOPG);
    LAS unsigned char* IX = lds + wave * 2048 + lane * 32;
    for (int item = bidL * NWAVE + wave; item < 2048; item += gridDim.x * NWAVE) {
        const int tg = item >> 3, hd = item & 7, tok = tg * 64 + lane;
        float V[2][16];
#pragma unroll
        for (int half = 0; half < 2; ++half) {
            unsigned L[16];
#pragma unroll
            for (int q = 0; q < 16; ++q) L[q] = 0u;
            const float* sc = SCT + (size_t)(hd * 256 + half * 128) * T + tok;
#pragma unroll 4
            for (int k = 0; k < 128; ++k) { unsigned x = (mono_key(sc[(size_t)k * T]) & ~0x7fu) | (unsigned)k; TK_INSERT(L, x); }
            u32x4 w0, w1;
            w0.x = (L[0] & 0x7f) | ((L[1] & 0x7f) << 8) | ((L[2] & 0x7f) << 16) | ((L[3] & 0x7f) << 24); w0.y = (L[4] & 0x7f) | ((L[5] & 0x7f) << 8) | ((L[6] & 0x7f) << 16) | ((L[7] & 0x7f) << 24);
            w0.z = (L[8] & 0x7f) | ((L[9] & 0x7f) << 8) | ((L[10] & 0x7f) << 16) | ((L[11] & 0x7f) << 24); w0.w = (L[12] & 0x7f) | ((L[13] & 0x7f) << 8) | ((L[14] & 0x7f) << 16) | ((L[15] & 0x7f) << 24);
            *(LAS u32x4*)(IX + half * 16) = w0;
#pragma unroll
            for (int q = 0; q < 16; ++q) V[half][q] = inv_mono(L[q]);
        }
        unsigned C[16];
#pragma unroll
        for (int q = 0; q < 16; ++q) C[q] = 0u;
#pragma unroll
        for (int i = 0; i < 16; ++i)
#pragma unroll
            for (int jj = 0; jj < 16; ++jj) if ((i + 1) * (jj + 1) <= 16) { unsigned x = (mono_key(V[0][i] + V[1][jj]) & ~0xffu) | (unsigned)(i * 16 + jj); TK_INSERT(C, x); }
        asm volatile("s_waitcnt lgkmcnt(0)" ::: "memory");
        const float s0 = inv_mono(C[0] & ~0xffu);
        float e[16]; float sum = 0.f; int ids[16];
#pragma unroll
        for (int q = 0; q < 16; ++q) { e[q] = fast_exp(inv_mono(C[q] & ~0xffu) - s0); sum += e[q];
            const unsigned code = C[q] & 0xffu; ids[q] = (int)IX[code >> 4] * 128 + (int)IX[16 + (code & 15u)]; }
        const float rs = fast_rcp(sum);
        int* ip = TOPI + (size_t)tok * 128 + hd * 16; float* gp = TOPG + (size_t)tok * 128 + hd * 16;
#pragma unroll
        for (int q = 0; q < 4; ++q) { *(u32x4*)(ip + 4 * q) = (u32x4){(unsigned)ids[4 * q], (unsigned)ids[4 * q + 1], (unsigned)ids[4 * q + 2], (unsigned)ids[4 * q + 3]};
            *(f32x4*)(gp + 4 * q) = (f32x4){e[4 * q] * rs, e[4 * q + 1] * rs, e[4 * q + 2] * rs, e[4 * q + 3] * rs}; }
        asm volatile("s_waitcnt lgkmcnt(0)" ::: "memory");
    }
}

__device__ __forceinline__ void peer_gather(KP p, int l, bool dry) {
    LAUNDER_IDS
    const int wave = tidL >> 6, lane = tidL & 63;
    const bf16_t* HB = (const bf16_t*)(p->ws + WS_HBUF); bf16_t* HBW = (bf16_t*)(p->ws + WS_HBUF);
    const int* TOPI = (const int*)(p->ws + WS_TOPI); const float* TOPG = (const float*)(p->ws + WS_TOPG);
    const unsigned char* U8 = p->ws + WS_UTAB + (size_t)l * 16384 * 1024 + 16 * lane; const unsigned char* V8 = p->ws + WS_VTAB + (size_t)l * 16384 * 1024 + 16 * lane;
    const float* USC = (const float*)(p->ws + WS_USC) + l * 16384; const float* VSC = (const float*)(p->ws + WS_VSC) + l * 16384;
    float* XRES = (float*)(p->ws + WS_XRES); const float* MOD = (const float*)(p->ws + WS_MOD);
    for (int tok = bidL * NWAVE + wave; tok < T; tok += gridDim.x * NWAVE) {
        const int b = tok >> 13;
        f32x2 hv2[8];
        { const u32x4 h0 = *(const u32x4*)(HB + (size_t)tok * 1024 + 16 * lane), h1 = *(const u32x4*)(HB + (size_t)tok * 1024 + 16 * lane + 8);
            hv2[0] = (f32x2){bflo(h0.x), bfhi(h0.x)}; hv2[1] = (f32x2){bflo(h0.y), bfhi(h0.y)}; hv2[2] = (f32x2){bflo(h0.z), bfhi(h0.z)}; hv2[3] = (f32x2){bflo(h0.w), bfhi(h0.w)};
            hv2[4] = (f32x2){bflo(h1.x), bfhi(h1.x)}; hv2[5] = (f32x2){bflo(h1.y), bfhi(h1.y)}; hv2[6] = (f32x2){bflo(h1.z), bfhi(h1.z)}; hv2[7] = (f32x2){bflo(h1.w), bfhi(h1.w)}; }
        const int id0 = TOPI[(size_t)tok * 128 + lane], id1 = TOPI[(size_t)tok * 128 + 64 + lane];
        const float g0 = TOPG[(size_t)tok * 128 + lane], g1 = TOPG[(size_t)tok * 128 + 64 + lane];
        f32x2 acc2[8];
#pragma unroll
        for (int i = 0; i < 8; ++i) acc2[i] = (f32x2){0.f, 0.f};
#pragma unroll 1
        for (int e0 = 0; e0 < 128; e0 += 8) {
            u32x4 uq[8], vq[8]; float gk[8], su[8], sv[8];
#pragma unroll
            for (int k = 0; k < 8; ++k) { const int e = e0 + k;
                int id = __builtin_amdgcn_readlane(e0 < 64 ? id0 : id1, e & 63);
                id &= 16383;
                gk[k] = __uint_as_float(__builtin_amdgcn_readlane(__float_as_uint(e0 < 64 ? g0 : g1), e & 63));
                uq[k] = *(const u32x4*)(U8 + (size_t)id * 1024); vq[k] = *(const u32x4*)(V8 + (size_t)id * 1024);
                su[k] = USC[id]; sv[k] = VSC[id]; }
            float d[8];
#pragma unroll
            for (int k = 0; k < 8; ++k) { f32x2 s2 = (f32x2){0.f, 0.f};
#pragma unroll
                for (int w = 0; w < 4; ++w) { const f32x2 lo = __builtin_amdgcn_cvt_pk_f32_fp8((int)uq[k][w], false), hi = __builtin_amdgcn_cvt_pk_f32_fp8((int)uq[k][w], true);
                    s2 = lo * hv2[2 * w] + s2; s2 = hi * hv2[2 * w + 1] + s2; }
                d[k] = s2[0] + s2[1]; }
            const bool b32 = lane & 32, b16 = lane & 16, b8 = lane & 8;
            float d4[4], d2[2], r;
#pragma unroll
            for (int k = 0; k < 4; ++k) { const float recv = __shfl_xor(b32 ? d[k] : d[k + 4], 32); d4[k] = (b32 ? d[k + 4] : d[k]) + recv; }
#pragma unroll
            for (int k = 0; k < 2; ++k) { const float recv = __shfl_xor(b16 ? d4[k] : d4[k + 2], 16); d2[k] = (b16 ? d4[k + 2] : d4[k]) + recv; }
            { const float recv = __shfl_xor(b8 ? d2[0] : d2[1], 8); r = (b8 ? d2[1] : d2[0]) + recv; }
            r += __shfl_xor(r, 4); r += __shfl_xor(r, 2); r += __shfl_xor(r, 1);
#pragma unroll
            for (int k = 0; k < 8; ++k) { const float dot = __uint_as_float(__builtin_amdgcn_readlane(__float_as_uint(r), ((k >> 2) & 1) * 32 + ((k >> 1) & 1) * 16 + (k & 1) * 8));
                const float cf = gk[k] * gelu_tanh(dot * su[k]) * sv[k]; const f32x2 cf2 = (f32x2){cf, cf};
#pragma unroll
                for (int w = 0; w < 4; ++w) { const f32x2 lo = __builtin_amdgcn_cvt_pk_f32_fp8((int)vq[k][w], false), hi = __builtin_amdgcn_cvt_pk_f32_fp8((int)vq[k][w], true);
                    acc2[2 * w] = lo * cf2 + acc2[2 * w]; acc2[2 * w + 1] = hi * cf2 + acc2[2 * w + 1]; } }
        }
        const float* g2 = MOD + ((size_t)l * 2 + b) * 6144 + 5 * 1024 + 16 * lane;
        float* xrow = XRES + (size_t)tok * 1024 + 16 * lane;
        float xn[16]; float ss = 0.f;
#pragma unroll
        for (int q = 0; q < 4; ++q) { const f32x4 xr = *(const f32x4*)(xrow + 4 * q), gg = *(const f32x4*)(g2 + 4 * q);
            const float a0 = acc2[2 * q][0], a1 = acc2[2 * q][1], a2 = acc2[2 * q + 1][0], a3 = acc2[2 * q + 1][1];
            xn[4 * q + 0] = xr[0] + gg[0] * a0; xn[4 * q + 1] = xr[1] + gg[1] * a1; xn[4 * q + 2] = xr[2] + gg[2] * a2; xn[4 * q + 3] = xr[3] + gg[3] * a3; }
#pragma unroll
        for (int i = 0; i < 16; ++i) ss += xn[i] * xn[i];
        const float inv = __builtin_amdgcn_rsqf(wave_sum(ss) * (1.f / 1024.f) + EPS);
        if (dry) { if (inv == 123.456f) p->out[tok] = inv; continue; }
        if (l < DEPTH - 1) {
            const float* gain = p->norm_g + (size_t)(l + 1) * 2 * 1024 + 16 * lane; const float* sh = MOD + ((size_t)(l + 1) * 2 + b) * 6144 + 16 * lane; const float* sc = sh + 1024;
            float y[16];
#pragma unroll
            for (int q = 0; q < 4; ++q) { const f32x4 gn = *(const f32x4*)(gain + 4 * q), s1 = *(const f32x4*)(sh + 4 * q), c1 = *(const f32x4*)(sc + 4 * q);
                *(f32x4*)(xrow + 4 * q) = (f32x4){xn[4 * q], xn[4 * q + 1], xn[4 * q + 2], xn[4 * q + 3]};
#pragma unroll
                for (int i = 0; i < 4; ++i) y[4 * q + i] = (xn[4 * q + i] * inv) * gn[i] * (1.f + c1[i]) + s1[i]; }
            u32x4 o0, o1; o0.x = cvt_pk_bf16(y[0], y[1]); o0.y = cvt_pk_bf16(y[2], y[3]); o0.z = cvt_pk_bf16(y[4], y[5]); o0.w = cvt_pk_bf16(y[6], y[7]);
            o1.x = cvt_pk_bf16(y[8], y[9]); o1.y = cvt_pk_bf16(y[10], y[11]); o1.z = cvt_pk_bf16(y[12], y[13]); o1.w = cvt_pk_bf16(y[14], y[15]);
            *(u32x4*)(HBW + (size_t)tok * 1024 + 16 * lane) = o0; *(u32x4*)(HBW + (size_t)tok * 1024 + 16 * lane + 8) = o1;
        } else {
            const float* fg = p->final_g + 16 * lane; float* orow = p->out + (size_t)tok * 1024 + 16 * lane;
#pragma unroll
            for (int q = 0; q < 4; ++q) { const f32x4 gn = *(const f32x4*)(fg + 4 * q); f32x4 o;
#pragma unroll
                for (int i = 0; i < 4; ++i) o[i] = (xn[4 * q + i] * inv) * gn[i];
                *(f32x4*)(orow + 4 * q) = o; }
        }
    }
}

#define XB_TMO      128
#define XB_XCNT(j)  (256  + 64 * (j))
#define XB_XSUB(j)  (1280 + 64 * (j))
#define XB_XGEN(j)  (2304 + 64 * (j))
#define XB_TOP      3328
#define XB_TOPGEN   3392
#define XCD_BAR_WORDS 3456
#define XB_SPIN_CAP (1u << 18)

__device__ __forceinline__ unsigned xb_ld(unsigned* p)              { return __hip_atomic_load(p, __ATOMIC_RELAXED, __HIP_MEMORY_SCOPE_AGENT); }
__device__ __forceinline__ unsigned xb_add(unsigned* p, unsigned v) { return __hip_atomic_fetch_add(p, v, __ATOMIC_RELAXED, __HIP_MEMORY_SCOPE_AGENT); }
__device__ __forceinline__ unsigned xb_xcc_id() { return (unsigned)__builtin_amdgcn_s_getreg((3 << 11) | 20) & 0xFu; }
#define XB_SPIN(cond, bar) do { unsigned _sp = 0; while (cond) { __builtin_amdgcn_s_sleep(1); \
    if ((++_sp & 255u) == 0u) { if (xb_ld(&(bar)[XB_TMO])) break; if (_sp > XB_SPIN_CAP) { atomicAdd(&(bar)[XB_TMO], 1u); break; } } } } while (0)

struct XcdBarrier {
    unsigned* bar; unsigned x;
    volatile LAS unsigned* st;
};

__device__ __forceinline__ XcdBarrier xcd_barrier_post(unsigned* bar, volatile LAS unsigned* st) {
    XcdBarrier b; b.bar = bar; b.x = xb_xcc_id(); b.st = st;
    if (threadIdx.x == 0) (void)xb_add(&bar[XB_XCNT(b.x)], 1u);
    return b;
}
__device__ __forceinline__ void xcd_barrier_complete(unsigned* bar, unsigned x, unsigned& nloc, unsigned& nx) {
    const unsigned G = gridDim.x * gridDim.y * gridDim.z;
    unsigned sum, cnt, mine, sp = 0u;
    for (;;) {
        sum = 0u; cnt = 0u; mine = 0u;
#pragma unroll
        for (unsigned j = 0; j < 16; ++j) { const unsigned c = xb_ld(&bar[XB_XCNT(j)]); sum += c; cnt += (c > 0u) ? 1u : 0u; mine = (j == x) ? c : mine; }
        if (sum == G) break;
        __builtin_amdgcn_s_sleep(1);
        if ((++sp & 255u) == 0u) { if (xb_ld(&bar[XB_TMO])) break; if (sp > XB_SPIN_CAP) { atomicAdd(&bar[XB_TMO], 1u); break; } }
    }
    nloc = mine > 0u ? mine : 1u; nx = cnt > 0u ? cnt : 1u;
}

__device__ __forceinline__ void xcd_barrier(const XcdBarrier& b) {
    asm volatile("s_waitcnt vmcnt(0)" ::: "memory");
    __syncthreads();
    if (threadIdx.x == 0) {
        unsigned* bar = b.bar;
        __builtin_amdgcn_s_waitcnt(0);
        unsigned nloc = b.st[0], nx = b.st[1];
        if (nloc == 0u) { xcd_barrier_complete(bar, b.x, nloc, nx); b.st[0] = nloc; b.st[1] = nx; }
        const unsigned old = xb_add(&bar[XB_XSUB(b.x)], 1u);
        const unsigned gen = old / nloc;
        if (old + 1u == (gen + 1u) * nloc) {
            __builtin_amdgcn_fence(__ATOMIC_RELEASE, "agent");
            asm volatile("s_waitcnt vmcnt(0)" ::: "memory");
            const unsigned og = xb_add(&bar[XB_TOP], 1u);
            const unsigned tg = og / nx;
            if (og + 1u == (tg + 1u) * nx) xb_add(&bar[XB_TOPGEN], 1u);
            else XB_SPIN(xb_ld(&bar[XB_TOPGEN]) == tg, bar);
            __builtin_amdgcn_fence(__ATOMIC_ACQUIRE, "agent");
            xb_add(&bar[XB_XGEN(b.x)], 1u);
            asm volatile("s_waitcnt vmcnt(0)" ::: "memory");
        } else {
            XB_SPIN(xb_ld(&bar[XB_XGEN(b.x)]) == gen, bar);
            __builtin_amdgcn_fence(__ATOMIC_ACQUIRE, "agent");
            asm volatile("s_waitcnt vmcnt(0)" ::: "memory");
        }
    }
    __syncthreads();
}

#ifndef OPMASK
#define OPMASK 0xFFFFFFFFu
#endif
#define EN(o) ((OPMASK >> (o)) & 1u)
enum { OP_P0 = 0, OP_RMS1, OP_HG_IN, OP_HG_A, OP_HG_B, OP_HG_C, OP_MIX_OUT, OP_LR_IN, OP_LR_CONV, OP_LR_G, OP_LR_S1, OP_LR_S2, OP_LR_S3, OP_RMS2, OP_QK, OP_TOPK, OP_GATHER };
constexpr int NPH = 42;
#define REP_MASK 0u
__device__ __forceinline__ void decode_phase(int ph, int& l, int& op) {
    if (ph == 0) { l = 0; op = OP_P0; return; }
    if (ph == 1) { l = 0; op = OP_RMS1; return; }
    int q = ph - 2;
    if (q < 9) { l = 0; } else if (q < 20) { l = 1; q -= 9; } else if (q < 29) { l = 2; q -= 20; } else { l = 3; q -= 29; }
    if ((l & 1) == 0) { op = q == 0 ? OP_HG_IN : q == 1 ? OP_HG_A : q == 2 ? OP_HG_B : q == 3 ? OP_HG_C : q == 4 ? OP_MIX_OUT : q == 5 ? OP_RMS2 : q == 6 ? OP_QK : q == 7 ? OP_TOPK : OP_GATHER; }
    else { op = q == 0 ? OP_LR_IN : q == 1 ? OP_LR_CONV : q == 2 ? OP_LR_G : q == 3 ? OP_LR_S1 : q == 4 ? OP_LR_S2 : q == 5 ? OP_LR_S3 : q == 6 ? OP_MIX_OUT : q == 7 ? OP_RMS2 : q == 8 ? OP_QK : q == 9 ? OP_TOPK : OP_GATHER; }
}

__global__ __launch_bounds__(512, 2) void mk_fwd(Params p_arg) {
    extern __shared__ __attribute__((aligned(16))) unsigned char shm[];
    LAS unsigned char* lds = (LAS unsigned char*)shm;
    cg::grid_group grid = cg::this_grid();
    unsigned long long kpv = (unsigned long long)__builtin_amdgcn_kernarg_segment_ptr();
    const int ph_lo = p_arg.ph_lo, ph_hi = p_arg.ph_hi;
    volatile LAS unsigned* xst = (volatile LAS unsigned*)(lds + LDS_BYTES - 16);
    if (threadIdx.x == 0) { xst[0] = 0u; xst[1] = 0u; }
    __syncthreads();
    const XcdBarrier xb = xcd_barrier_post((unsigned*)(p_arg.ws + WS_CTL) + 1024, xst);
    for (int ph = ph_lo; ph < ph_hi; ++ph) {
        if (ph > ph_lo) { if (ph == 1) grid.sync(); else xcd_barrier(xb); }
        asm volatile("" : "+s"(kpv));
        KP p = (KP)kpv;
        unsigned char* ws = p->ws;
        const float* MOD = (const float*)(ws + WS_MOD);
        int l, op; decode_phase(ph, l, op);
        const int j = l >> 1;
        const int nrep = ((p->rep_mask >> op) & 1u) ? 2 : 1;
        for (int rep = 0; rep < nrep; ++rep) {
        const bool dry = rep + 1 < nrep;
#ifdef ONLY
        switch (ONLY) {
#else
        switch (op) {
#endif
        case OP_P0: if (EN(OP_P0)) phase0(p, lds); break;
        case OP_RMS1: if (EN(OP_RMS1)) phase_rms(p->x, p->norm_g, MOD, MOD + 1024, (bf16_t*)(ws + WS_HBUF)); break;
        case OP_HG_IN: if (EN(OP_HG_IN)) { EpiBf16 E; E.O = (bf16_t*)(ws + WS_PROJ); E.ldc = 5120;
            run_gemm(lds, (const bf16_t*)(ws + WS_HBUF), (const bf16_t*)(ws + WS_HGWIN) + (size_t)j * 5120 * 1024, 5120, 1024, 1024, 1024, 0, 0, E); } break;
        case OP_HG_A: if (EN(OP_HG_A)) hg_pass_a(p, lds, j); break;
        case OP_HG_B: if (EN(OP_HG_B)) hg_pass_b(p); break;
        case OP_HG_C: if (EN(OP_HG_C)) hg_pass_c(p, lds, j); break;
        case OP_MIX_OUT: if (EN(OP_MIX_OUT)) { EpiResid E; E.xin = (l == 0) ? p->x : (const float*)(ws + WS_XRES); E.xout = (float*)(ws + WS_XRES); E.gate = MOD + (size_t)l * 2 * 6144 + 2 * 1024; E.dry = dry;
            const bf16_t* W = (l & 1) ? (const bf16_t*)(ws + WS_LRWOUT) + (size_t)j * 1024 * 1024 : (const bf16_t*)(ws + WS_HGWOUT) + (size_t)j * 1024 * 1024;
            run_gemm(lds, (const bf16_t*)(ws + WS_OB), W, 1024, 1024, 1024, 1024, 0, 0, E); } break;
        case OP_LR_IN: if (EN(OP_LR_IN)) { EpiLruIn E; E.XB = (bf16_t*)(ws + WS_XB); E.YG = (bf16_t*)(ws + WS_YG);
            run_gemm(lds, (const bf16_t*)(ws + WS_HBUF), (const bf16_t*)(ws + WS_LRWIN) + (size_t)j * 2048 * 1024, 2048, 1024, 1024, 1024, 0, 0, E); } break;
        case OP_LR_CONV: if (EN(OP_LR_CONV)) lru_conv(p, j); break;
        case OP_LR_G: if (EN(OP_LR_G)) { EpiGates E; E.LOGA = (bf16_t*)(ws + WS_LOGA); E.BTERM = (bf16_t*)(ws + WS_BTERM); E.XC = (const bf16_t*)(ws + WS_XC);
            E.b_a = p->lru_b_a + (size_t)j * 2048; E.b_x = p->lru_b_x + (size_t)j * 2048; E.lam = p->lru_lam + (size_t)j * 2048;
            run_gemm(lds, (const bf16_t*)(ws + WS_XC), (const bf16_t*)(ws + WS_LRWG) + (size_t)j * 4 * 1024 * 256, 4096, 256, 1024, 256, 2, 512, E); } break;
        case OP_LR_S1: if (EN(OP_LR_S1)) lru_scan1(p); break;
        case OP_LR_S2: if (EN(OP_LR_S2)) lru_scan2(p); break;
        case OP_LR_S3: if (EN(OP_LR_S3)) lru_scan3(p); break;
        case OP_RMS2: if (EN(OP_RMS2)) phase_rms((const float*)(ws + WS_XRES), p->norm_g + ((size_t)l * 2 + 1) * 1024, MOD + (size_t)l * 2 * 6144 + 3 * 1024, MOD + (size_t)l * 2 * 6144 + 4 * 1024, (bf16_t*)(ws + WS_HBUF)); break;
        case OP_QK: if (EN(OP_QK)) { EpiScoresT E; E.C = (float*)(ws + WS_SCORES);
            run_gemm(lds, (const bf16_t*)(ws + WS_HBUF), (const bf16_t*)(ws + WS_WQK) + (size_t)l * 2048 * 1024, 2048, 1024, 1024, 1024, 0, 0, E); } break;
        case OP_TOPK: if (EN(OP_TOPK)) peer_topk(p, lds); break;
        case OP_GATHER: if (EN(OP_GATHER)) peer_gather(p, l, dry); break;
        default: break;
        }
        }
    }
}

extern "C" void kernel_launch(void* const* d_in, const int* in_sizes, int n_in, void* d_out, int out_size, void* d_ws, size_t ws_size, hipStream_t stream) {
    static int grid = 0;
    if (grid == 0) {
        if (n_in != 23 || ws_size < WS_END) { fprintf(stderr, "kernel_launch: unexpected n_in %d / ws_size %zu (need %zu)\n", n_in, ws_size, (size_t)WS_END); grid = -1; return; }
        int dev = 0, cus = 0, per_cu = 0;
        hipGetDevice(&dev); hipDeviceGetAttribute(&cus, hipDeviceAttributeMultiprocessorCount, dev);
        if (hipFuncSetAttribute((const void*)mk_fwd, hipFuncAttributeMaxDynamicSharedMemorySize, LDS_BYTES) != hipSuccess) { fprintf(stderr, "kernel_launch: hipFuncSetAttribute failed\n"); grid = -1; return; }
        if (hipOccupancyMaxActiveBlocksPerMultiprocessor(&per_cu, (const void*)mk_fwd, NTHR, LDS_BYTES) != hipSuccess || per_cu < 1) { fprintf(stderr, "kernel_launch: occupancy query failed (%d)\n", per_cu); (void)hipGetLastError(); per_cu = 1; }
        grid = cus * 1;
        fprintf(stderr, "kernel_launch: cus %d per_cu %d grid %d\n", cus, per_cu, grid);
    }
    if (grid < 0) return;
    if (hipMemsetAsync((char*)d_ws + WS_CTL, 0, 65536, stream) != hipSuccess) { fprintf(stderr, "kernel_launch: memset failed\n"); return; }
    Params p{};
    const float** pp = (const float**)&p;
    for (int i = 0; i < 23; ++i) pp[i] = (const float*)d_in[i];
    p.out = (float*)d_out; p.ws = (unsigned char*)d_ws; p.ph_lo = 0; p.ph_hi = NPH; p.rep_mask = REP_MASK;
    void* args[] = {&p};
    hipError_t e = hipLaunchCooperativeKernel((const void*)mk_fwd, dim3(grid), dim3(NTHR), args, LDS_BYTES, stream);
    if (e != hipSuccess) fprintf(stderr, "kernel_launch: cooperative launch failed: %s (grid %d)\n", hipGetErrorString(e), grid);
}
```

```cpp
#include <hip/hip_runtime.h>
#include <hip/hip_cooperative_groups.h>
#include <cstdio>
#include <cstdint>
namespace cg = cooperative_groups;

#define LAS __attribute__((address_space(3)))
#define PG8_LAS __attribute__((address_space(3)))
typedef unsigned short bf16_t;
typedef short bf16x8 __attribute__((ext_vector_type(8)));
typedef float f32x4 __attribute__((ext_vector_type(4)));
typedef float f32x2 __attribute__((ext_vector_type(2)));
typedef unsigned u32x4 __attribute__((ext_vector_type(4)));
typedef unsigned u32x2 __attribute__((ext_vector_type(2)));

constexpr int T = 16384, D = 1024, SEQ = 8192, DEPTH = 4;
constexpr float EPS = 1e-6f;
constexpr int NBLK = 256, NTHR = 512, NWAVE = 8, NGW = NBLK * NWAVE;

constexpr size_t MiB = 1u << 20;
constexpr size_t WS_CTL = 0;
constexpr size_t WS_MOD = 1 * MiB;
constexpr size_t WS_HGWIN = 2 * MiB;
constexpr size_t WS_HGWOUT = 22 * MiB;
constexpr size_t WS_LRWIN = 26 * MiB;
constexpr size_t WS_LRWG = 34 * MiB;
constexpr size_t WS_LRWOUT = 38 * MiB;
constexpr size_t WS_WQK = 42 * MiB;
constexpr size_t WS_TOPI = 58 * MiB;
constexpr size_t WS_TOPG = 66 * MiB;
constexpr size_t WS_DEC = 74 * MiB;
constexpr size_t WS_CP = 75 * MiB;
constexpr size_t WS_CH = 79 * MiB;
constexpr size_t WS_HIN = 83 * MiB;
constexpr size_t WS_USC = 87 * MiB;
constexpr size_t WS_VSC = 87 * MiB + 262144;
constexpr size_t WS_XRES = 88 * MiB;
constexpr size_t WS_HBUF = 152 * MiB;
constexpr size_t WS_OB = 184 * MiB;
constexpr size_t WS_PROJ = 216 * MiB;
constexpr size_t WS_XB = WS_PROJ, WS_YG = WS_PROJ + 32 * MiB, WS_XC = WS_PROJ + 64 * MiB, WS_LOGA = WS_PROJ + 96 * MiB;
constexpr size_t WS_SCORES = WS_PROJ;
constexpr size_t WS_KV = 376 * MiB;
constexpr size_t WS_BTERM = WS_KV;
constexpr size_t WS_SIN = 504 * MiB;
constexpr size_t WS_UTAB = 568 * MiB;
constexpr size_t WS_VTAB = 696 * MiB;
constexpr size_t WS_END = 824 * MiB;

constexpr int LDS_BYTES = 155648;

#define LAUNDER_IDS int tidL = threadIdx.x, bidL = blockIdx.x; asm volatile("" : "+v"(tidL)); asm volatile("" : "+s"(bidL));
__device__ __forceinline__ float bf2f(bf16_t b) { return __uint_as_float(((unsigned)b) << 16); }
__device__ __forceinline__ float bflo(unsigned u) { return __uint_as_float(u << 16); }
__device__ __forceinline__ float bfhi(unsigned u) { return __uint_as_float(u & 0xffff0000u); }
__device__ __forceinline__ unsigned cvt_pk_bf16(float lo, float hi) { unsigned r; asm volatile("v_cvt_pk_bf16_f32 %0, %1, %2" : "=v"(r) : "v"(lo), "v"(hi)); return r; }
__device__ __forceinline__ bf16_t f2bf(float f) { return (bf16_t)(cvt_pk_bf16(f, 0.f) & 0xffffu); }
__device__ __forceinline__ float fast_exp(float x) { return __builtin_amdgcn_exp2f(x * 1.4426950408889634f); }
__device__ __forceinline__ float fast_log(float x) { return __builtin_amdgcn_logf(x) * 0.6931471805599453f; }
__device__ __forceinline__ float fast_rcp(float x) { return __builtin_amdgcn_rcpf(x); }
__device__ __forceinline__ float sigmoidf_(float x) { return fast_rcp(1.f + fast_exp(-x)); }
__device__ __forceinline__ float gelu_tanh(float x) { const float u = 1.5957691216057308f * (x + 0.044715f * x * x * x); return x * fast_rcp(1.f + fast_exp(-u)); }
__device__ __forceinline__ float silu_(float x) { return x * sigmoidf_(x); }
__device__ __forceinline__ float wave_sum(float v) {
#pragma unroll
    for (int o = 1; o < 64; o <<= 1) v += __shfl_xor(v, o);
    return v;
}
__device__ __forceinline__ float wave_max(float v) {
#pragma unroll
    for (int o = 1; o < 64; o <<= 1) v = fmaxf(v, __shfl_xor(v, o));
    return v;
}

namespace pg8 {
constexpr int BM = 256, BK = 64, HALF = 128, HTB = HALF * BK * 2, STAGE_BYTES = 8 * HTB, NXCD = 8, WGM = 8;
__host__ __device__ __forceinline__ int lds_byte(int r, int c) { const int st = (r >> 4) * 2 + (c >> 5), rr = r & 15, cc = c & 31, ob = rr * 64 + cc * 2; return st * 1024 + (ob ^ (((ob >> 9) & 1) << 5)); }
__host__ __device__ __forceinline__ void stage_rc(int b, int& R, int& C) { const int st = b / 1024, sb = b % 1024, swz = sb ^ (((sb >> 9) & 1) << 5); R = (st >> 1) * 16 + swz / 64; C = (st & 1) * 32 + (swz % 64) / 2; }
__host__ __device__ __forceinline__ int perm32(int rho) { const int n = rho >> 4, i = rho & 15; return 8 * (i >> 2) + 4 * n + (i & 3); }
struct Unit { int pm, pn; };
struct Gemm { const bf16_t* A; const bf16_t* Bt; int M, N, K, lda, ldb, a_pn_shift, a_pn_stride; };
struct StaticOrder {
    int nM, nN, nwg, G, c;
    __host__ __device__ void init(int M, int N, int G_, int c_) { nM = M / BM; nN = N / BM; nwg = nM * nN; G = G_; c = c_; }
    __host__ __device__ bool next(int i, Unit& u) const {
        const long L = (long)i * G + c; if (L >= nwg) return false;
        int wgid = (int)L; { const int q = nwg / NXCD, r = nwg % NXCD, xcd = wgid % NXCD, off = wgid / NXCD; wgid = (xcd < r ? xcd * (q + 1) : r * (q + 1) + (xcd - r) * q) + off; }
        const int nig = WGM * nN, gid = wgid / nig, fm = gid * WGM, gsz = (nM - fm) < WGM ? (nM - fm) : WGM;
        u.pm = fm + ((wgid % nig) % gsz); u.pn = (wgid % nig) / gsz; return true;
    }
    __device__ __forceinline__ void a_ready(const Unit&) const {}
    __device__ __forceinline__ void done(const Unit&) const {}
};
template <class Epi, class Sched, bool STAMP = false>
__device__ __forceinline__ void gemm_phase(PG8_LAS unsigned char* lds, const Gemm g, const Sched& S, const Epi& E, unsigned long long* stamps) {
    int tid = threadIdx.x; asm volatile("" : "+v"(tid)); const int wid = __builtin_amdgcn_readfirstlane(tid >> 6), lane = tid & 63, wr = wid >> 2, wc = wid & 3, fr = lane & 15, fq = lane >> 4;
    const int K = g.K, nt = K / BK;
    int ts_lo = 0, ts_hi = 0, nts = 0; const unsigned long long rt_entry = STAMP ? (unsigned long long)wall_clock64() : 0ull;
#define PG8_STAMP() do { if (STAMP && wid == 0 && nts < 64) { const unsigned long long _c = (unsigned long long)clock64(); \
        ts_lo = (lane == nts) ? (int)(unsigned)_c : ts_lo; ts_hi = (lane == nts) ? (int)(unsigned)(_c >> 32) : ts_hi; ++nts; } } while (0)
    PG8_STAMP();
    unsigned voffA[2], voffB[2];
#pragma unroll
    for (int i = 0; i < 2; ++i) { int R, C; stage_rc(tid * 16 + i * 8192, R, C); const int Rb = Epi::PERM ? ((R & ~31) + perm32(R & 31)) : R;
        voffA[i] = (unsigned)(R * g.lda + C) * 2u; voffB[i] = (unsigned)(Rb * g.ldb + C) * 2u; }
    const size_t kstep = (size_t)(BK * 2);
    const size_t hstepA = (size_t)HALF * g.lda * 2, hstepB = (size_t)HALF * g.ldb * 2;
    const size_t tstepA = 2 * hstepA, tstepB = 2 * hstepB;
    const unsigned ldsw = (unsigned)wid * 1024u;
    const int aoff = lds_byte(wr * 64 + fr, fq * 8), boff = lds_byte(wc * 32 + fr, fq * 8);
#define PG8_SA(b, h) (((b) * 2 + (h)) * HTB)
#define PG8_SB(b, h) ((4 + (b) * 2 + (h)) * HTB)
#define PG8_STAGE(bufoff, gbase, voff) do { _Pragma("unroll") for (int _i = 0; _i < 2; ++_i) \
        __builtin_amdgcn_global_load_lds((const unsigned*)((const char*)(gbase) + (voff)[_i]), (PG8_LAS unsigned*)(lds + (bufoff) + ldsw + _i * 8192), 16, 0, 0); } while (0)
#define PG8_LDA(dst, b, h) do { _Pragma("unroll") for (int m = 0; m < 4; ++m) _Pragma("unroll") for (int k = 0; k < 2; ++k) dst[m][k] = *(const PG8_LAS bf16x8*)(lds + PG8_SA(b, h) + aoff + m * 2048 + k * 1024); } while (0)
#define PG8_LDB(dst, b, h) do { _Pragma("unroll") for (int n = 0; n < 2; ++n) _Pragma("unroll") for (int k = 0; k < 2; ++k) dst[n][k] = *(const PG8_LAS bf16x8*)(lds + PG8_SB(b, h) + boff + n * 2048 + k * 1024); } while (0)
#define PG8_MMA(ai, bj, At, Bt) do { __builtin_amdgcn_s_setprio(1); _Pragma("unroll") for (int m = 0; m < 4; ++m) _Pragma("unroll") for (int n = 0; n < 2; ++n) _Pragma("unroll") for (int k = 0; k < 2; ++k) \
        acc[ai][bj][m][n] = Epi::SWAP ? __builtin_amdgcn_mfma_f32_16x16x32_bf16(At[m][k], Bt[n][k], acc[ai][bj][m][n], 0, 0, 0) : __builtin_amdgcn_mfma_f32_16x16x32_bf16(Bt[n][k], At[m][k], acc[ai][bj][m][n], 0, 0, 0); __builtin_amdgcn_s_setprio(0); } while (0)
#define PG8_WAIT_V(n) asm volatile("s_waitcnt vmcnt(" #n ")" ::: "memory")
#define PG8_WAIT_L(n) asm volatile("s_waitcnt lgkmcnt(" #n ")" ::: "memory")
#define PG8_BAR __builtin_amdgcn_s_barrier()
#define PG8_SCHED __builtin_amdgcn_sched_barrier(0)
    Unit cur, nxt; int ui = 0;
    if (!S.next(0, cur)) return;
    f32x4 acc[2][2][4][2];
#pragma unroll
    for (int a = 0; a < 2; ++a)
#pragma unroll
        for (int b = 0; b < 2; ++b)
#pragma unroll
            for (int m = 0; m < 4; ++m)
#pragma unroll
                for (int n = 0; n < 2; ++n) acc[a][b][m][n] = (f32x4){0.f, 0.f, 0.f, 0.f};
    bf16x8 At[4][2], B0[2][2], B1[2][2];
    const char* cA = (const char*)g.A + (size_t)cur.pm * tstepA + (size_t)(cur.pn >> g.a_pn_shift) * g.a_pn_stride; const char* cB = (const char*)g.Bt + (size_t)cur.pn * tstepB;
    S.a_ready(cur);
    PG8_STAGE(PG8_SB(0, 0), cB, voffB); PG8_STAGE(PG8_SA(0, 0), cA, voffA); PG8_STAGE(PG8_SB(0, 1), cB + hstepB, voffB); PG8_STAGE(PG8_SA(0, 1), cA + hstepA, voffA);
    if (wr == 1) PG8_BAR;
    PG8_WAIT_V(4); PG8_BAR;
    PG8_STAGE(PG8_SB(1, 0), cB + kstep, voffB); PG8_STAGE(PG8_SA(1, 0), cA + kstep, voffA); PG8_STAGE(PG8_SB(1, 1), cB + hstepB + kstep, voffB);
    PG8_WAIT_V(6); PG8_BAR;
    PG8_STAMP();
    for (;;) {
        const bool has_next = S.next(ui + 1, nxt);
        const char* nA = has_next ? (const char*)g.A + (size_t)nxt.pm * tstepA + (size_t)(nxt.pn >> g.a_pn_shift) * g.a_pn_stride : cA; const char* nB = has_next ? (const char*)g.Bt + (size_t)nxt.pn * tstepB : cB;
#pragma unroll 1
        for (int t = 0; t < nt; t += 2) {
            const bool last = (t == nt - 2);
            const char* a1 = cA + (size_t)(t + 1) * kstep;
            const char* a2 = last ? nA : cA + (size_t)(t + 2) * kstep; const char* b2 = last ? nB : cB + (size_t)(t + 2) * kstep;
            const char* a3 = a2 + kstep; const char* b3 = b2 + kstep;
            if (last && has_next) S.a_ready(nxt);
            PG8_LDB(B0, 0, 0); PG8_SCHED; PG8_LDA(At, 0, 0); PG8_STAGE(PG8_SA(1, 1), a1 + hstepA, voffA);
            PG8_WAIT_L(8); PG8_BAR; PG8_WAIT_L(0); PG8_MMA(0, 0, At, B0); PG8_BAR; PG8_SCHED;
            PG8_LDB(B1, 0, 1); PG8_STAGE(PG8_SB(0, 0), b2, voffB);
            PG8_BAR; PG8_WAIT_L(0); PG8_MMA(0, 1, At, B1); PG8_BAR;
            PG8_LDA(At, 0, 1); PG8_STAGE(PG8_SA(0, 0), a2, voffA);
            PG8_BAR; PG8_WAIT_L(0); PG8_MMA(1, 0, At, B0); PG8_BAR; PG8_SCHED;
            PG8_STAGE(PG8_SB(0, 1), b2 + hstepB, voffB);
            PG8_WAIT_V(6); PG8_BAR; PG8_MMA(1, 1, At, B1); PG8_BAR;
            PG8_LDB(B0, 1, 0); PG8_SCHED; PG8_LDA(At, 1, 0); PG8_STAGE(PG8_SA(0, 1), a2 + hstepA, voffA);
            PG8_WAIT_L(8); PG8_BAR; PG8_WAIT_L(0); PG8_MMA(0, 0, At, B0); PG8_BAR; PG8_SCHED;
            PG8_LDB(B1, 1, 1); PG8_STAGE(PG8_SB(1, 0), b3, voffB);
            PG8_BAR; PG8_WAIT_L(0); PG8_MMA(0, 1, At, B1); PG8_BAR;
            PG8_LDA(At, 1, 1); PG8_STAGE(PG8_SA(1, 0), a3, voffA);
            PG8_BAR; PG8_WAIT_L(0); PG8_MMA(1, 0, At, B0); PG8_BAR; PG8_SCHED;
            PG8_STAGE(PG8_SB(1, 1), b3 + hstepB, voffB);
            PG8_WAIT_V(6); PG8_BAR; PG8_MMA(1, 1, At, B1); PG8_BAR;
        }
        PG8_STAMP();
        if constexpr (!Epi::AFTER_DRAIN) { E(acc, cur, wr, wc, fr, fq); S.done(cur); }
        PG8_STAMP();
        if (!has_next) break;
#pragma unroll
        for (int a = 0; a < 2; ++a)
#pragma unroll
            for (int b = 0; b < 2; ++b)
#pragma unroll
                for (int m = 0; m < 4; ++m)
#pragma unroll
                    for (int n = 0; n < 2; ++n) acc[a][b][m][n] = (f32x4){0.f, 0.f, 0.f, 0.f};
        cur = nxt; cA = nA; cB = nB; ++ui;
    }
    PG8_WAIT_V(0);
    if (wr == 0) PG8_BAR;
    PG8_BAR;
    if constexpr (Epi::AFTER_DRAIN) { E.fused(acc, cur, wr, wc, fr, fq, lds, wid, lane); S.done(cur); }
    PG8_STAMP();
    if (STAMP && wid == 0) { stamps[lane] = lane < nts ? (((unsigned long long)(unsigned)ts_hi << 32) | (unsigned)ts_lo) : 0ull;
        if (lane == 62) stamps[62] = rt_entry; if (lane == 63) stamps[63] = (unsigned long long)wall_clock64(); }
#undef PG8_STAMP
#undef PG8_SA
#undef PG8_SB
#undef PG8_STAGE
#undef PG8_LDA
#undef PG8_LDB
#undef PG8_MMA
#undef PG8_WAIT_V
#undef PG8_WAIT_L
#undef PG8_BAR
#undef PG8_SCHED
}
}
using pg8::Unit;

struct EpiBf16 {
    static constexpr bool PERM = true, AFTER_DRAIN = false, SWAP = false;
    bf16_t* O; int ldc;
    __device__ __forceinline__ void operator()(const f32x4 (&acc)[2][2][4][2], const Unit& u, int wr, int wc, int fr, int fq) const {
        const int row0 = u.pm * 256 + wr * 64 + fr, col0 = u.pn * 256 + wc * 32 + 8 * fq;
#pragma unroll
        for (int ai = 0; ai < 2; ++ai)
#pragma unroll
            for (int m = 0; m < 4; ++m) { bf16_t* rowp = O + (size_t)(row0 + ai * 128 + m * 16) * ldc + col0;
#pragma unroll
                for (int bj = 0; bj < 2; ++bj) { const f32x4 v0 = acc[ai][bj][m][0], v1 = acc[ai][bj][m][1];
                    u32x4 o; o.x = cvt_pk_bf16(v0[0], v0[1]); o.y = cvt_pk_bf16(v0[2], v0[3]); o.z = cvt_pk_bf16(v1[0], v1[1]); o.w = cvt_pk_bf16(v1[2], v1[3]);
                    *(u32x4*)(rowp + bj * 128) = o; } }
    }
};
struct EpiLruIn {
    static constexpr bool PERM = true, AFTER_DRAIN = false, SWAP = false;
    bf16_t* XB; bf16_t* YG;
    __device__ __forceinline__ void operator()(const f32x4 (&acc)[2][2][4][2], const Unit& u, int wr, int wc, int fr, int fq) const {
        const bool isy = u.pn >= 4;
        bf16_t* O = isy ? YG : XB;
        const int row0 = u.pm * 256 + wr * 64 + fr, col0 = (u.pn & 3) * 256 + wc * 32 + 8 * fq;
#pragma unroll
        for (int ai = 0; ai < 2; ++ai)
#pragma unroll
            for (int m = 0; m < 4; ++m) { bf16_t* rowp = O + (size_t)(row0 + ai * 128 + m * 16) * 1024 + col0;
#pragma unroll
                for (int bj = 0; bj < 2; ++bj) { f32x4 v0 = acc[ai][bj][m][0], v1 = acc[ai][bj][m][1];
                    if (isy) {
#pragma unroll
                        for (int i = 0; i < 4; ++i) { v0[i] = gelu_tanh(v0[i]); v1[i] = gelu_tanh(v1[i]); } }
                    u32x4 o; o.x = cvt_pk_bf16(v0[0], v0[1]); o.y = cvt_pk_bf16(v0[2], v0[3]); o.z = cvt_pk_bf16(v1[0], v1[1]); o.w = cvt_pk_bf16(v1[2], v1[3]);
                    *(u32x4*)(rowp + bj * 128) = o; } }
    }
};
struct EpiGates {
    static constexpr bool PERM = true, AFTER_DRAIN = false, SWAP = false;
    bf16_t* LOGA; bf16_t* BTERM; const bf16_t* XC; const float* b_a; const float* b_x; const float* lam;
    __device__ __forceinline__ void operator()(const f32x4 (&acc)[2][2][4][2], const Unit& u, int wr, int wc, int fr_, int fq) const {
        int fr = fr_; asm volatile("" : "+v"(fr));
        const int nblk = u.pn >> 2, uu = u.pn & 3, d = uu >> 1, jh = uu & 1;
        const int colbase = nblk * 256 + jh * 128 + wc * 32 + 8 * fq;
        const unsigned off0 = (unsigned)(u.pm * 256 + wr * 64 + fr) * 1024u + (unsigned)colbase;
        const bf16_t* xcp = XC; bf16_t* lap = LOGA + (size_t)d * T * 1024; bf16_t* btp = BTERM + (size_t)d * T * 1024;
        const float* bap = b_a + d * 1024; const float* bxp = b_x + d * 1024; const float* lmp = lam + d * 1024;
#pragma unroll
        for (int ai = 0; ai < 2; ++ai)
#pragma unroll
            for (int m = 0; m < 4; ++m) { const unsigned off = off0 + (unsigned)(ai * 128 + m * 16) * 1024u;
                asm volatile("" ::: "memory"); __builtin_amdgcn_sched_barrier(0);
                const u32x4 xr = *(const u32x4*)(xcp + off);
                const float xv[8] = {bflo(xr.x), bfhi(xr.x), bflo(xr.y), bfhi(xr.y), bflo(xr.z), bfhi(xr.z), bflo(xr.w), bfhi(xr.w)};
                unsigned o1[4], o2[4];
#pragma unroll
                for (int n = 0; n < 2; ++n) { const f32x4 ba = *(const f32x4*)(bap + (unsigned)(colbase + 4 * n)), bx = *(const f32x4*)(bxp + (unsigned)(colbase + 4 * n)), lm = *(const f32x4*)(lmp + (unsigned)(colbase + 4 * n));
                    float la[4], bt[4];
#pragma unroll
                    for (int i = 0; i < 4; ++i) { const float r = sigmoidf_(acc[ai][0][m][n][i] + ba[i]), ig = sigmoidf_(acc[ai][1][m][n][i] + bx[i]);
                        const float l = -8.f * fast_log(1.f + fast_exp(-lm[i])) * r; const float mult = __builtin_sqrtf(fmaxf(1.f - fast_exp(2.f * l), 0.f));
                        la[i] = l; bt[i] = mult * ig * xv[n * 4 + i]; }
                    o1[n * 2] = cvt_pk_bf16(la[0], la[1]); o1[n * 2 + 1] = cvt_pk_bf16(la[2], la[3]); o2[n * 2] = cvt_pk_bf16(bt[0], bt[1]); o2[n * 2 + 1] = cvt_pk_bf16(bt[2], bt[3]); }
                *(u32x4*)(lap + off) = (u32x4){o1[0], o1[1], o1[2], o1[3]}; *(u32x4*)(btp + off) = (u32x4){o2[0], o2[1], o2[2], o2[3]}; }
    }
};
struct EpiResid {
    static constexpr bool PERM = false, AFTER_DRAIN = false, SWAP = false;
    const float* xin; float* xout; const float* gate; bool dry;
    __device__ __forceinline__ void operator()(const f32x4 (&acc)[2][2][4][2], const Unit& u, int wr, int wc, int fr, int fq) const {
        const int row0 = u.pm * 256 + wr * 64 + fr, col0 = u.pn * 256 + wc * 32 + 4 * fq;
        const float* gp = gate + ((u.pm * 256) >> 13) * 6144 + col0;
        f32x4 gv[2][2];
#pragma unroll
        for (int bj = 0; bj < 2; ++bj)
#pragma unroll
            for (int n = 0; n < 2; ++n) gv[bj][n] = *(const f32x4*)(gp + bj * 128 + n * 16);
#pragma unroll
        for (int ai = 0; ai < 2; ++ai)
#pragma unroll
            for (int m = 0; m < 4; ++m) { const size_t off = (size_t)(row0 + ai * 128 + m * 16) * 1024 + col0;
#pragma unroll
                for (int bj = 0; bj < 2; ++bj)
#pragma unroll
                    for (int n = 0; n < 2; ++n) { const f32x4 xv = *(const f32x4*)(xin + off + bj * 128 + n * 16);
                        if (!dry) *(f32x4*)(xout + off + bj * 128 + n * 16) = xv + gv[bj][n] * acc[ai][bj][m][n]; } }
    }
};
struct EpiScoresT {
    static constexpr bool PERM = false, AFTER_DRAIN = false, SWAP = true;
    float* C;
    __device__ __forceinline__ void operator()(const f32x4 (&acc)[2][2][4][2], const Unit& u, int wr, int wc, int fr_, int fq) const {
        int fr = fr_; asm volatile("" : "+v"(fr));
        const unsigned off0 = (unsigned)(u.pn * 256 + wc * 32 + fr) * (unsigned)T + (unsigned)(u.pm * 256 + wr * 64 + 4 * fq);
#pragma unroll
        for (int ai = 0; ai < 2; ++ai)
#pragma unroll
            for (int m = 0; m < 4; ++m)
#pragma unroll
                for (int bj = 0; bj < 2; ++bj)
#pragma unroll
                    for (int n = 0; n < 2; ++n) *(f32x4*)(C + (off0 + (unsigned)(bj * 128 + n * 16) * (unsigned)T + (unsigned)(ai * 128 + m * 16))) = acc[ai][bj][m][n];
    }
};

struct Params {
    const float *x, *c, *w_ada, *b_ada, *norm_g, *hg_w_in, *hg_lb, *hg_norm_g, *hg_w_out, *lru_w_in, *lru_conv_w, *lru_conv_b,
        *lru_w_a, *lru_b_a, *lru_w_x, *lru_b_x, *lru_lam, *lru_w_out, *peer_w_q, *peer_keys, *peer_u, *peer_v, *final_g;
    float* out; unsigned char* ws; int ph_lo, ph_hi; unsigned rep_mask; int pad_;
};

typedef const __attribute__((address_space(4))) Params* KP;

template <class Epi>
__device__ __forceinline__ void run_gemm(LAS unsigned char* lds, const bf16_t* A, const bf16_t* Bt, int N, int K, int lda, int ldb, int a_pn_shift, int a_pn_stride, const Epi& E) {
    pg8::Gemm g; g.A = A; g.Bt = Bt; g.M = T; g.N = N; g.K = K; g.lda = lda; g.ldb = ldb; g.a_pn_shift = a_pn_shift; g.a_pn_stride = a_pn_stride;
    LAUNDER_IDS
    pg8::StaticOrder S; S.init(T, N, (int)gridDim.x, bidL); (void)tidL;
    pg8::gemm_phase<Epi, pg8::StaticOrder, false>(lds, g, S, E, nullptr);
    __syncthreads();
}

__device__ __forceinline__ void transpose_tile(const float* __restrict__ src, int ld_src, bf16_t* dst, int ld_dst, LAS float* tile, int tid) {
#pragma unroll
    for (int it = 0; it < 2; ++it) { const int r = (tid >> 4) + 32 * it, c4 = (tid & 15) * 4;
        const f32x4 v = *(const f32x4*)(src + (size_t)r * ld_src + c4);
        tile[r * 65 + c4 + 0] = v[0]; tile[r * 65 + c4 + 1] = v[1]; tile[r * 65 + c4 + 2] = v[2]; tile[r * 65 + c4 + 3] = v[3]; }
    __syncthreads();
    { const int n = tid >> 3, kc = tid & 7; const LAS float* s = tile + (kc * 8) * 65 + n;
        u32x4 o; o.x = cvt_pk_bf16(s[0], s[65]); o.y = cvt_pk_bf16(s[2 * 65], s[3 * 65]); o.z = cvt_pk_bf16(s[4 * 65], s[5 * 65]); o.w = cvt_pk_bf16(s[6 * 65], s[7 * 65]);
        *(u32x4*)(dst + (size_t)n * ld_dst + kc * 8) = o; }
    __syncthreads();
}

__device__ __forceinline__ void phase0(KP p, LAS unsigned char* lds) {
    LAUNDER_IDS
    const int tid = tidL, wave = tid >> 6, lane = tid & 63;
    unsigned char* ws = p->ws;
    LAS float* tile = (LAS float*)lds;
    constexpr int I_HGIN = 16 * 80, I_SQ = 16 * 16, I_LRIN = 16 * 32, I_G = 16;
    constexpr int N_A = 2 * I_HGIN + 2 * I_SQ + 2 * I_LRIN + 2 * I_SQ + 32 * I_G;
    for (int it = bidL; it < N_A; it += gridDim.x) {
        int r = it;
        if (r < 2 * I_HGIN) { const int j = r / I_HGIN, q = r % I_HGIN, kb = q / 80, nb = q % 80;
            transpose_tile(p->hg_w_in + (size_t)j * 1024 * 5120 + (size_t)kb * 64 * 5120 + nb * 64, 5120, (bf16_t*)(ws + WS_HGWIN) + (size_t)j * 5120 * 1024 + (size_t)nb * 64 * 1024 + kb * 64, 1024, tile, tid); continue; }
        r -= 2 * I_HGIN;
        if (r < 2 * I_SQ) { const int j = r / I_SQ, q = r % I_SQ, kb = q / 16, nb = q % 16;
            transpose_tile(p->hg_w_out + (size_t)j * 1024 * 1024 + (size_t)kb * 64 * 1024 + nb * 64, 1024, (bf16_t*)(ws + WS_HGWOUT) + (size_t)j * 1024 * 1024 + (size_t)nb * 64 * 1024 + kb * 64, 1024, tile, tid); continue; }
        r -= 2 * I_SQ;
        if (r < 2 * I_LRIN) { const int j = r / I_LRIN, q = r % I_LRIN, kb = q / 32, nb = q % 32;
            transpose_tile(p->lru_w_in + (size_t)j * 1024 * 2048 + (size_t)kb * 64 * 2048 + nb * 64, 2048, (bf16_t*)(ws + WS_LRWIN) + (size_t)j * 2048 * 1024 + (size_t)nb * 64 * 1024 + kb * 64, 1024, tile, tid); continue; }
        r -= 2 * I_LRIN;
        if (r < 2 * I_SQ) { const int j = r / I_SQ, q = r % I_SQ, kb = q / 16, nb = q % 16;
            transpose_tile(p->lru_w_out + (size_t)j * 1024 * 1024 + (size_t)kb * 64 * 1024 + nb * 64, 1024, (bf16_t*)(ws + WS_LRWOUT) + (size_t)j * 1024 * 1024 + (size_t)nb * 64 * 1024 + kb * 64, 1024, tile, tid); continue; }
        r -= 2 * I_SQ;
        { const int mat = r / I_G, q = r % I_G, kb = q / 4, nb = q % 4;
            const int nblk = mat & 3, gate = (mat >> 2) & 1, d = (mat >> 3) & 1, l = mat >> 4;
            const float* src = (gate ? p->lru_w_x : p->lru_w_a) + (size_t)((l * 2 + d) * 4 + nblk) * 65536 + (size_t)kb * 64 * 256 + nb * 64;
            const int n0 = nb * 64, jh = n0 >> 7;
            bf16_t* dst = (bf16_t*)(ws + WS_LRWG) + (size_t)l * 4 * 1024 * 256 + (size_t)nblk * 1024 * 256 + (size_t)((d * 2 + jh) * 256 + gate * 128 + (n0 & 127)) * 256 + kb * 64;
            transpose_tile(src, 256, dst, 256, tile, tid); }
    }
    {
        LAS float* keysL = (LAS float*)lds;
        LAS float* wqL = (LAS float*)(lds + 128 * 132 * 4);
        for (int it = bidL; it < 1024; it += gridDim.x) {
            const int l = it >> 8, hp = (it >> 4) & 15, dt = it & 15;
            const float* kp = p->peer_keys + ((size_t)l * 16 + hp) * 16384;
#pragma unroll
            for (int q = 0; q < 8; ++q) { const int e = (tid + 512 * q) * 4; const f32x4 v = *(const f32x4*)(kp + e); *(LAS f32x4*)(keysL + (e >> 7) * 132 + (e & 127)) = v; }
            const float* wp = p->peer_w_q + (size_t)l * 1024 * 2048 + (size_t)(dt * 64) * 2048 + hp * 128;
#pragma unroll
            for (int q = 0; q < 4; ++q) { const int e = (tid + 512 * q) * 4; const f32x4 v = *(const f32x4*)(wp + (size_t)(e >> 7) * 2048 + (e & 127)); *(LAS f32x4*)(wqL + e) = v; }
            __syncthreads();
            const int key = tid & 127, g = tid >> 7;
            float acc[16];
#pragma unroll
            for (int i = 0; i < 16; ++i) acc[i] = 0.f;
            for (int d4 = 0; d4 < 128; d4 += 4) {
                const f32x4 kv = *(const LAS f32x4*)(keysL + key * 132 + d4);
#pragma unroll
                for (int i = 0; i < 16; ++i) { const f32x4 wv = *(const LAS f32x4*)(wqL + (g * 16 + i) * 128 + d4);
                    acc[i] += kv[0] * wv[0] + kv[1] * wv[1] + kv[2] * wv[2] + kv[3] * wv[3]; }
            }
            bf16_t* op = (bf16_t*)(ws + WS_WQK) + (size_t)l * 2048 * 1024 + (size_t)(hp * 128 + key) * 1024 + dt * 64 + g * 16;
            u32x4 o1, o2; o1.x = cvt_pk_bf16(acc[0], acc[1]); o1.y = cvt_pk_bf16(acc[2], acc[3]); o1.z = cvt_pk_bf16(acc[4], acc[5]); o1.w = cvt_pk_bf16(acc[6], acc[7]);
            o2.x = cvt_pk_bf16(acc[8], acc[9]); o2.y = cvt_pk_bf16(acc[10], acc[11]); o2.z = cvt_pk_bf16(acc[12], acc[13]); o2.w = cvt_pk_bf16(acc[14], acc[15]);
            *(u32x4*)op = o1; *(u32x4*)(op + 8) = o2;
            __syncthreads();
        }
    }
    {
        LAS float* condL = (LAS float*)lds;
        LAS float* red = (LAS float*)(lds + 8192);
        for (int i = tid; i < 2048; i += NTHR) condL[i] = silu_(p->c[i]);
        __syncthreads();
        for (int it = bidL; it < 4 * 48; it += gridDim.x) {
            const int l = it / 48, col0 = (it % 48) * 128;
            const float* wp = p->w_ada + (size_t)l * 1024 * 6144 + col0 + 2 * lane;
            float a00 = 0.f, a01 = 0.f, a10 = 0.f, a11 = 0.f;
#pragma unroll 8
            for (int kk = 0; kk < 128; ++kk) { const int k = wave * 128 + kk; const f32x2 w = *(const f32x2*)(wp + (size_t)k * 6144);
                const float c0 = condL[k], c1 = condL[1024 + k];
                a00 += c0 * w[0]; a01 += c0 * w[1]; a10 += c1 * w[0]; a11 += c1 * w[1]; }
            red[(wave * 2 + 0) * 128 + 2 * lane] = a00; red[(wave * 2 + 0) * 128 + 2 * lane + 1] = a01;
            red[(wave * 2 + 1) * 128 + 2 * lane] = a10; red[(wave * 2 + 1) * 128 + 2 * lane + 1] = a11;
            __syncthreads();
            if (tid < 256) { const int b = tid >> 7, cc = tid & 127; float s = 0.f;
#pragma unroll
                for (int w = 0; w < 8; ++w) s += red[(w * 2 + b) * 128 + cc];
                ((float*)(ws + WS_MOD))[((size_t)l * 2 + b) * 6144 + col0 + cc] = s + p->b_ada[(size_t)l * 6144 + col0 + cc]; }
            __syncthreads();
        }
    }
    {
        const int nw = gridDim.x * NWAVE;
        for (int row0 = bidL * NWAVE + wave; row0 < 2 * 65536; row0 += 4 * nw) {
            f32x4 v[4][4];
#pragma unroll
            for (int rr = 0; rr < 4; ++rr) { const int row = row0 + rr * nw; const int tb = row >> 16, r = row & 65535;
                const float* src = (tb ? p->peer_v : p->peer_u) + (size_t)r * 1024 + 4 * lane;
#pragma unroll
                for (int jx = 0; jx < 4; ++jx) v[rr][jx] = __builtin_nontemporal_load((const f32x4*)(src + 256 * jx)); }
#pragma unroll
            for (int rr = 0; rr < 4; ++rr) { const int row = row0 + rr * nw; const int tb = row >> 16, r = row & 65535;
                float am = 0.f;
#pragma unroll
                for (int jx = 0; jx < 4; ++jx) am = fmaxf(am, fmaxf(fmaxf(fabsf(v[rr][jx][0]), fabsf(v[rr][jx][1])), fmaxf(fabsf(v[rr][jx][2]), fabsf(v[rr][jx][3]))));
                am = wave_max(am);
                const float sc = am > 0.f ? am * (1.f / 448.f) : 1.f, inv = am > 0.f ? 448.f / am : 1.f;
                unsigned char* dst = ws + (tb ? WS_VTAB : WS_UTAB) + (size_t)r * 1024 + 4 * lane;
#pragma unroll
                for (int jx = 0; jx < 4; ++jx) { int w = __builtin_amdgcn_cvt_pk_fp8_f32(v[rr][jx][0] * inv, v[rr][jx][1] * inv, 0, false);
                    w = __builtin_amdgcn_cvt_pk_fp8_f32(v[rr][jx][2] * inv, v[rr][jx][3] * inv, w, true);
                    *(int*)(dst + 256 * jx) = w; }
                if (lane == 0) ((float*)(ws + (tb ? WS_VSC : WS_USC)))[r] = sc; }
        }
    }
}

__device__ __forceinline__ void phase_rms(const float* xin, const float* gain, const float* shift, const float* scale, bf16_t* hout) {
    LAUNDER_IDS
    const int tid = tidL, wave = tid >> 6, lane = tid & 63;
    for (int row = bidL * NWAVE + wave; row < T; row += gridDim.x * NWAVE) {
        const int b = row >> 13;
        const float* xr = xin + (size_t)row * 1024 + lane * 4;
        f32x4 v[4]; float ss = 0.f;
#pragma unroll
        for (int j = 0; j < 4; ++j) { v[j] = *(const f32x4*)(xr + j * 256); ss += v[j][0] * v[j][0] + v[j][1] * v[j][1] + v[j][2] * v[j][2] + v[j][3] * v[j][3]; }
        const float inv = __builtin_amdgcn_rsqf(wave_sum(ss) * (1.f / 1024.f) + EPS);
#pragma unroll
        for (int j = 0; j < 4; ++j) { const int col = j * 256 + lane * 4;
            const f32x4 g = *(const f32x4*)(gain + col), sh = *(const f32x4*)(shift + b * 6144 + col), sc = *(const f32x4*)(scale + b * 6144 + col);
            const f32x4 y = (v[j] * inv) * g * (1.f + sc) + sh;
            u32x2 o; o.x = cvt_pk_bf16(y[0], y[1]); o.y = cvt_pk_bf16(y[2], y[3]);
            *(u32x2*)(hout + (size_t)row * 1024 + col) = o; }
    }
}

constexpr int LROW = 136;
__device__ __forceinline__ float hg_lower_bound(const float* hg_lb, int j, int col) {
    if (j == 0) return 0.f;
    const float l0 = hg_lb[col], l1 = hg_lb[1024 + col];
    return fast_rcp(1.f + fast_exp(l0 - l1));
}
__device__ __forceinline__ f32x4 mfma16(bf16x8 a, bf16x8 b, f32x4 c) { return __builtin_amdgcn_mfma_f32_16x16x32_bf16(a, b, c, 0, 0, 0); }

__device__ __forceinline__ void load_vt(const bf16_t* proj, LAS bf16_t* VT, int t0, int dir, int h, int tid) {
#pragma unroll
    for (int it = 0; it < 4; ++it) { const int idx = tid + 512 * it, tau = idx & 127, cv = idx >> 7;
        const int tok = dir ? t0 + 127 - tau : t0 + tau;
        const u32x4 v = *(const u32x4*)(proj + (size_t)tok * 5120 + 3072 + h * 128 + cv * 8);
        LAS bf16_t* d = VT + (cv * 8) * LROW + tau;
        d[0 * LROW] = (bf16_t)(v.x & 0xffff); d[1 * LROW] = (bf16_t)(v.x >> 16); d[2 * LROW] = (bf16_t)(v.y & 0xffff); d[3 * LROW] = (bf16_t)(v.y >> 16);
        d[4 * LROW] = (bf16_t)(v.z & 0xffff); d[5 * LROW] = (bf16_t)(v.z >> 16); d[6 * LROW] = (bf16_t)(v.w & 0xffff); d[7 * LROW] = (bf16_t)(v.w >> 16); }
}

__device__ __forceinline__ void hg_pass_a(KP p, LAS unsigned char* lds, int j) {
    LAUNDER_IDS
    const bf16_t* proj = (const bf16_t*)(p->ws + WS_PROJ);
    float* KV = (float*)(p->ws + WS_KV); float* DEC = (float*)(p->ws + WS_DEC);
    LAS bf16_t* VT = (LAS bf16_t*)lds; LAS bf16_t* KT = (LAS bf16_t*)(lds + 34816); LAS float* TOT = (LAS float*)(lds + 69632);
    for (int u = bidL; u < 2048; u += gridDim.x) {
        int tid = tidL; asm volatile("" : "+v"(tid));
        const int wave = tid >> 6, lane = tid & 63;
        const int seq = u >> 6, c = u & 63, dir = seq & 1, h = (seq >> 1) & 7, b = seq >> 4;
        const int t0 = b * SEQ + c * 128;
        const int dk = tid & 127, g = tid >> 7;
        const float lb = hg_lower_bound(p->hg_lb, j, h * 128 + dk);
        float lcs[32], kks[32]; float lc = 0.f;
        const bf16_t* zp = proj + 1024 * (1 + dir) + h * 128 + dk;
#pragma unroll
        for (int q = 0; q < 32; ++q) { const int tau = 32 * g + q, tok = dir ? t0 + 127 - tau : t0 + tau;
            const float z = bf2f(zp[(size_t)tok * 5120]);
            const float f = lb + (1.f - lb) * sigmoidf_(z);
            lc += fast_log(f); lcs[q] = lc; kks[q] = 1.f - f; }
        TOT[g * 128 + dk] = lc;
        load_vt(proj, VT, t0, dir, h, tid);
        __syncthreads();
        float rg = 0.f, total = 0.f;
#pragma unroll
        for (int gg = 0; gg < 4; ++gg) { const float tv = TOT[gg * 128 + dk]; total += tv; if (gg < g) rg += tv; }
        const float base = total - rg;
#pragma unroll
        for (int q8 = 0; q8 < 4; ++q8) { unsigned w[4];
#pragma unroll
            for (int e = 0; e < 4; ++e) { const int q = q8 * 8 + e * 2;
                w[e] = cvt_pk_bf16(kks[q] * fast_exp(base - lcs[q]), kks[q + 1] * fast_exp(base - lcs[q + 1])); }
            u32x4 o; o.x = w[0]; o.y = w[1]; o.z = w[2]; o.w = w[3];
            *(LAS u32x4*)(KT + dk * LROW + 32 * g + q8 * 8) = o; }
        if (g == 0) DEC[(size_t)u * 128 + dk] = fast_exp(total);
        __syncthreads();
        f32x4 acc[2][4];
#pragma unroll
        for (int a = 0; a < 2; ++a)
#pragma unroll
            for (int bb = 0; bb < 4; ++bb) acc[a][bb] = (f32x4){0.f, 0.f, 0.f, 0.f};
        const int l15 = lane & 15, lq = lane >> 4;
#pragma unroll
        for (int ks = 0; ks < 4; ++ks) {
            bf16x8 af[2], bfr[4];
#pragma unroll
            for (int a = 0; a < 2; ++a) af[a] = *(const LAS bf16x8*)(VT + (((wave & 3) * 2 + a) * 16 + l15) * LROW + ks * 32 + lq * 8);
#pragma unroll
            for (int bb = 0; bb < 4; ++bb) bfr[bb] = *(const LAS bf16x8*)(KT + (((wave >> 2) * 4 + bb) * 16 + l15) * LROW + ks * 32 + lq * 8);
#pragma unroll
            for (int a = 0; a < 2; ++a)
#pragma unroll
                for (int bb = 0; bb < 4; ++bb) acc[a][bb] = mfma16(af[a], bfr[bb], acc[a][bb]);
        }
        float* kvp = KV + (size_t)u * 16384;
#pragma unroll
        for (int a = 0; a < 2; ++a)
#pragma unroll
            for (int bb = 0; bb < 4; ++bb)
#pragma unroll
                for (int r = 0; r < 4; ++r) kvp[(((wave & 3) * 2 + a) * 16 + lq * 4 + r) * 128 + ((wave >> 2) * 4 + bb) * 16 + l15] = acc[a][bb][r];
        __syncthreads();
    }
}

__device__ __forceinline__ void hg_pass_b(KP p) {
    LAUNDER_IDS
    const float* KV = (const float*)(p->ws + WS_KV); const float* DEC = (const float*)(p->ws + WS_DEC);
    bf16_t* SIN = (bf16_t*)(p->ws + WS_SIN);
    for (int e = bidL * NTHR + tidL; e < 131072; e += gridDim.x * NTHR) {
    const int seq = e >> 12, i4 = e & 4095, dir = seq & 1, dk = (i4 * 4) & 127;
    f32x4 S = {0.f, 0.f, 0.f, 0.f};
#pragma unroll 8
    for (int step = 0; step < 64; ++step) {
        const int c = dir ? 63 - step : step; const size_t u = (size_t)seq * 64 + c;
        const f32x4 kv = *(const f32x4*)(KV + u * 16384 + i4 * 4); const f32x4 dc = *(const f32x4*)(DEC + u * 128 + dk);
        u32x2 o; o.x = cvt_pk_bf16(S[0], S[1]); o.y = cvt_pk_bf16(S[2], S[3]);
        *(u32x2*)(SIN + u * 16384 + i4 * 4) = o;
        S = dc * S + kv;
    }
    }
}

__device__ __forceinline__ void hg_pass_c(KP p, LAS unsigned char* lds, int j) {
    LAUNDER_IDS
    const bf16_t* proj = (const bf16_t*)(p->ws + WS_PROJ);
    const bf16_t* SIN = (const bf16_t*)(p->ws + WS_SIN);
    bf16_t* OB = (bf16_t*)(p->ws + WS_OB);
    LAS bf16_t* QT = (LAS bf16_t*)lds; LAS bf16_t* QI = (LAS bf16_t*)(lds + 34816); LAS bf16_t* KT = (LAS bf16_t*)(lds + 69632);
    LAS bf16_t* VT = (LAS bf16_t*)(lds + 104448); LAS bf16_t* PI = (LAS bf16_t*)(lds + 139264); LAS float* TOT = (LAS float*)(lds + 147968);
    LAS float* OSUM = (LAS float*)(lds + 69632);
    for (int u = bidL; u < 1024; u += gridDim.x) {
        int tid = tidL; asm volatile("" : "+v"(tid));
        const int wave = tid >> 6, lane = tid & 63, l15 = lane & 15, lq = lane >> 4;
        const int c = u & 63, h = (u >> 6) & 7, b = u >> 9;
        const int t0 = b * SEQ + c * 128;
        const int dk = tid & 127, g = tid >> 7;
        const float lb = hg_lower_bound(p->hg_lb, j, h * 128 + dk);
        const int tt = wave & 1, dvt0 = (wave >> 1) * 2;
        f32x4 oacc[2][4][2];
#pragma unroll
        for (int dir = 0; dir < 2; ++dir) {
            const size_t su = ((size_t)((b * 8 + h) * 2 + dir) * 64 + c);
            unsigned k0p[16]; float lc = 0.f; float kprev = 0.f;
            const bf16_t* zp = proj + 1024 * (1 + dir) + h * 128 + dk; const bf16_t* qp = proj + h * 128 + dk;
#pragma unroll
            for (int q = 0; q < 32; ++q) { const int tau = 32 * g + q, tok = dir ? t0 + 127 - tau : t0 + tau;
                const float z = bf2f(zp[(size_t)tok * 5120]), qv = bf2f(qp[(size_t)tok * 5120]);
                const float f = lb + (1.f - lb) * sigmoidf_(z);
                lc += fast_log(f);
                const float el = fast_exp(fmaxf(lc, -80.f));
                QT[tau * LROW + dk] = f2bf(qv * el);
                const float kcur = (1.f - f) * fast_rcp(el);
                if (q & 1) k0p[q >> 1] = cvt_pk_bf16(kprev, kcur); else kprev = kcur; }
            TOT[g * 128 + dk] = lc;
            __syncthreads();
            float r[4]; { float run = 0.f;
#pragma unroll
                for (int gg = 0; gg < 4; ++gg) { r[gg] = run; run += TOT[gg * 128 + dk]; } }
            float rg = 0.f;
#pragma unroll
            for (int gg = 0; gg < 4; ++gg) if (gg == g) rg = r[gg];
            { const float eg = fast_exp(rg);
#pragma unroll
                for (int q = 0; q < 32; ++q) QI[(32 * g + q) * LROW + dk] = f2bf(bf2f(QT[(32 * g + q) * LROW + dk]) * eg); }
            load_vt(proj, VT, t0, dir, h, tid);
            bf16x8 sfr[2][4];
#pragma unroll
            for (int n = 0; n < 2; ++n)
#pragma unroll
                for (int ks = 0; ks < 4; ++ks) sfr[n][ks] = *(const bf16x8*)(SIN + su * 16384 + (size_t)((dvt0 + n) * 16 + l15) * 128 + ks * 32 + lq * 8);
#pragma unroll
            for (int i = 0; i < 4; ++i) {
                if (g <= i) { const float e = fast_exp(r[i] - rg);
#pragma unroll
                    for (int q = 0; q < 32; ++q) KT[(32 * g + q) * LROW + dk] = f2bf(((q & 1) ? bfhi(k0p[q >> 1]) : bflo(k0p[q >> 1])) * e); }
                __syncthreads();
                for (int tl = wave; tl < 4 * (i + 1); tl += 8) { const int sm = tl >> 1, tn = tl & 1;
                    f32x4 a4 = {0.f, 0.f, 0.f, 0.f};
#pragma unroll
                    for (int ks = 0; ks < 4; ++ks) { const bf16x8 af = *(const LAS bf16x8*)(KT + (sm * 16 + l15) * LROW + ks * 32 + lq * 8);
                        const bf16x8 bq = *(const LAS bf16x8*)(QT + (32 * i + tn * 16 + l15) * LROW + ks * 32 + lq * 8);
                        a4 = mfma16(af, bq, a4); }
                    const int tloc = tn * 16 + l15, s0 = sm * 16 + lq * 4, tg = 32 * i + tloc;
                    u32x2 o; o.x = cvt_pk_bf16(s0 + 0 <= tg ? a4[0] : 0.f, s0 + 1 <= tg ? a4[1] : 0.f); o.y = cvt_pk_bf16(s0 + 2 <= tg ? a4[2] : 0.f, s0 + 3 <= tg ? a4[3] : 0.f);
                    *(LAS u32x2*)(PI + tloc * LROW + s0) = o; }
                __syncthreads();
                f32x4 a0 = {0.f, 0.f, 0.f, 0.f}, a1 = {0.f, 0.f, 0.f, 0.f};
                for (int ks = 0; ks <= i; ++ks) { const bf16x8 af = *(const LAS bf16x8*)(PI + (tt * 16 + l15) * LROW + ks * 32 + lq * 8);
                    const bf16x8 b0 = *(const LAS bf16x8*)(VT + ((dvt0 + 0) * 16 + l15) * LROW + ks * 32 + lq * 8);
                    const bf16x8 b1 = *(const LAS bf16x8*)(VT + ((dvt0 + 1) * 16 + l15) * LROW + ks * 32 + lq * 8);
                    a0 = mfma16(af, b0, a0); a1 = mfma16(af, b1, a1); }
#pragma unroll
                for (int ks = 0; ks < 4; ++ks) { const bf16x8 af = *(const LAS bf16x8*)(QI + (32 * i + tt * 16 + l15) * LROW + ks * 32 + lq * 8);
                    a0 = mfma16(af, sfr[0][ks], a0); a1 = mfma16(af, sfr[1][ks], a1); }
                oacc[dir][i][0] = a0; oacc[dir][i][1] = a1;
            }
        }
        __syncthreads();
#pragma unroll
        for (int i = 0; i < 4; ++i)
#pragma unroll
            for (int n = 0; n < 2; ++n)
#pragma unroll
                for (int rr = 0; rr < 4; ++rr) OSUM[(32 * i + tt * 16 + lq * 4 + rr) * 132 + (dvt0 + n) * 16 + l15] = oacc[0][i][n][rr];
        __syncthreads();
#pragma unroll
        for (int i = 0; i < 4; ++i)
#pragma unroll
            for (int n = 0; n < 2; ++n)
#pragma unroll
                for (int rr = 0; rr < 4; ++rr) OSUM[(127 - (32 * i + tt * 16 + lq * 4 + rr)) * 132 + (dvt0 + n) * 16 + l15] += oacc[1][i][n][rr];
        __syncthreads();
        { const int row = tid >> 2, part = tid & 3; const int tok = t0 + row;
            float ov[32]; float ss = 0.f;
#pragma unroll
            for (int q = 0; q < 8; ++q) { const f32x4 v = *(const LAS f32x4*)(OSUM + row * 132 + part * 32 + q * 4);
                ov[q * 4 + 0] = v[0]; ov[q * 4 + 1] = v[1]; ov[q * 4 + 2] = v[2]; ov[q * 4 + 3] = v[3]; ss += v[0] * v[0] + v[1] * v[1] + v[2] * v[2] + v[3] * v[3]; }
            ss += __shfl_xor(ss, 1); ss += __shfl_xor(ss, 2);
            const float inv = __builtin_amdgcn_rsqf(ss * (1.f / 128.f) + EPS);
            const int col = h * 128 + part * 32;
            const bf16_t* gp = proj + (size_t)tok * 5120 + 4096 + col; const float* ng = p->hg_norm_g + j * 1024 + col;
#pragma unroll
            for (int q = 0; q < 4; ++q) { const u32x4 gr = *(const u32x4*)(gp + q * 8);
                const float gv[8] = {bflo(gr.x), bfhi(gr.x), bflo(gr.y), bfhi(gr.y), bflo(gr.z), bfhi(gr.z), bflo(gr.w), bfhi(gr.w)};
                float y[8];
#pragma unroll
                for (int e = 0; e < 8; ++e) y[e] = ov[q * 8 + e] * inv * ng[q * 8 + e] * silu_(gv[e]);
                u32x4 o; o.x = cvt_pk_bf16(y[0], y[1]); o.y = cvt_pk_bf16(y[2], y[3]); o.z = cvt_pk_bf16(y[4], y[5]); o.w = cvt_pk_bf16(y[6], y[7]);
                *(u32x4*)(OB + (size_t)tok * 1024 + col + q * 8) = o; }
        }
        __syncthreads();
    }
}

__device__ __forceinline__ void lru_conv(KP p, int l) {
    LAUNDER_IDS
    const bf16_t* XB = (const bf16_t*)(p->ws + WS_XB); bf16_t* XC = (bf16_t*)(p->ws + WS_XC);
    const float* cw = p->lru_conv_w + (size_t)l * 4 * 1024; const float* cb = p->lru_conv_b + (size_t)l * 1024;
    const int gs = gridDim.x * NTHR;
    for (int it = bidL * NTHR + tidL; it < T * 128; it += gs) {
        const int tok = it >> 7, c8 = (it & 127) * 8, s = tok & (SEQ - 1);
        float acc[8];
        { const f32x4 b0 = *(const f32x4*)(cb + c8), b1 = *(const f32x4*)(cb + c8 + 4);
            acc[0] = b0[0]; acc[1] = b0[1]; acc[2] = b0[2]; acc[3] = b0[3]; acc[4] = b1[0]; acc[5] = b1[1]; acc[6] = b1[2]; acc[7] = b1[3]; }
#pragma unroll
        for (int jj = 0; jj < 4; ++jj) { const int ts = s + jj - 2;
            if (ts >= 0 && ts < SEQ) { const u32x4 xr = *(const u32x4*)(XB + (size_t)(tok + jj - 2) * 1024 + c8);
                const f32x4 w0 = *(const f32x4*)(cw + jj * 1024 + c8), w1 = *(const f32x4*)(cw + jj * 1024 + c8 + 4);
                acc[0] += bflo(xr.x) * w0[0]; acc[1] += bfhi(xr.x) * w0[1]; acc[2] += bflo(xr.y) * w0[2]; acc[3] += bfhi(xr.y) * w0[3];
                acc[4] += bflo(xr.z) * w1[0]; acc[5] += bfhi(xr.z) * w1[1]; acc[6] += bflo(xr.w) * w1[2]; acc[7] += bfhi(xr.w) * w1[3]; } }
        u32x4 o; o.x = cvt_pk_bf16(acc[0], acc[1]); o.y = cvt_pk_bf16(acc[2], acc[3]); o.z = cvt_pk_bf16(acc[4], acc[5]); o.w = cvt_pk_bf16(acc[6], acc[7]);
        *(u32x4*)(XC + (size_t)tok * 1024 + c8) = o;
    }
}
__device__ __forceinline__ void lru_scan1(KP p) {
    LAUNDER_IDS
    const bf16_t* LOGA = (const bf16_t*)(p->ws + WS_LOGA); const bf16_t* BT = (const bf16_t*)(p->ws + WS_BTERM);
    float* CP = (float*)(p->ws + WS_CP); float* CH = (float*)(p->ws + WS_CH);
    const int ch = 2 * tidL;
    for (int u = bidL; u < 1024; u += gridDim.x) {
        const int chunk = u & 255, dir = (u >> 8) & 1, b = u >> 9;
        const size_t base = ((size_t)dir * T + b * SEQ + chunk * 32) * 1024 + ch;
        float h0 = 0.f, h1 = 0.f, s0 = 0.f, s1 = 0.f;
#pragma unroll 8
        for (int q = 0; q < 32; ++q) { const int t = dir ? 31 - q : q;
            const unsigned lw = *(const unsigned*)(LOGA + base + (size_t)t * 1024), bw = *(const unsigned*)(BT + base + (size_t)t * 1024);
            const float l0 = bflo(lw), l1 = bfhi(lw);
            h0 = fast_exp(l0) * h0 + bflo(bw); h1 = fast_exp(l1) * h1 + bfhi(bw); s0 += l0; s1 += l1; }
        const size_t o = ((size_t)(b * 2 + dir) * 256 + chunk) * 1024 + ch;
        *(f32x2*)(CP + o) = (f32x2){fast_exp(s0), fast_exp(s1)}; *(f32x2*)(CH + o) = (f32x2){h0, h1};
    }
}
__device__ __forceinline__ void lru_scan2(KP p) {
    LAUNDER_IDS
    const float* CP = (const float*)(p->ws + WS_CP); const float* CH = (const float*)(p->ws + WS_CH); float* HIN = (float*)(p->ws + WS_HIN);
    const int wave = tidL >> 6, lane = tidL & 63;
    for (int item = bidL * NWAVE + wave; item < 4096; item += gridDim.x * NWAVE) {
        const int ch = item & 1023, bd = item >> 10, dir = bd & 1;
        float pp[4], hh[4]; float Pl = 1.f, Hl = 0.f;
#pragma unroll
        for (int q = 0; q < 4; ++q) { const int ci = 4 * lane + q, chunk = dir ? 255 - ci : ci; const size_t o = ((size_t)bd * 256 + chunk) * 1024 + ch;
            pp[q] = CP[o]; hh[q] = CH[o]; Hl = pp[q] * Hl + hh[q]; Pl *= pp[q]; }
#pragma unroll
        for (int off = 1; off < 64; off <<= 1) { const float Pp = __shfl_up(Pl, off), Hp = __shfl_up(Hl, off);
            if (lane >= off) { Hl = Pl * Hp + Hl; Pl = Pl * Pp; } }
        float carry = __shfl_up(Hl, 1); if (lane == 0) carry = 0.f;
#pragma unroll
        for (int q = 0; q < 4; ++q) { const int ci = 4 * lane + q, chunk = dir ? 255 - ci : ci; const size_t o = ((size_t)bd * 256 + chunk) * 1024 + ch;
            HIN[o] = carry; carry = pp[q] * carry + hh[q]; }
    }
}
__device__ __forceinline__ void lru_scan3(KP p) {
    LAUNDER_IDS
    const bf16_t* LOGA = (const bf16_t*)(p->ws + WS_LOGA); const bf16_t* BT = (const bf16_t*)(p->ws + WS_BTERM); const bf16_t* YG = (const bf16_t*)(p->ws + WS_YG);
    const float* HIN = (const float*)(p->ws + WS_HIN); bf16_t* OB = (bf16_t*)(p->ws + WS_OB);
    const int ch = 2 * tidL;
    for (int u = bidL; u < 512; u += gridDim.x) {
        const int chunk = u & 255, b = u >> 8;
        const size_t tok0 = (size_t)b * SEQ + chunk * 32;
        const f32x2 hf = *(const f32x2*)(HIN + ((size_t)(b * 2 + 0) * 256 + chunk) * 1024 + ch), hb = *(const f32x2*)(HIN + ((size_t)(b * 2 + 1) * 256 + chunk) * 1024 + ch);
        float hs0[32], hs1[32]; float h0 = hf[0], h1 = hf[1];
#pragma unroll
        for (int q = 0; q < 32; ++q) { const size_t o = (tok0 + q) * 1024 + ch;
            const unsigned lw = *(const unsigned*)(LOGA + o), bw = *(const unsigned*)(BT + o);
            h0 = fast_exp(bflo(lw)) * h0 + bflo(bw); h1 = fast_exp(bfhi(lw)) * h1 + bfhi(bw); hs0[q] = h0; hs1[q] = h1; }
        h0 = hb[0]; h1 = hb[1];
#pragma unroll
        for (int q = 31; q >= 0; --q) { const size_t o = (tok0 + q) * 1024 + ch;
            const unsigned lw = *(const unsigned*)(LOGA + (size_t)T * 1024 + o), bw = *(const unsigned*)(BT + (size_t)T * 1024 + o), yw = *(const unsigned*)(YG + o);
            h0 = fast_exp(bflo(lw)) * h0 + bflo(bw); h1 = fast_exp(bfhi(lw)) * h1 + bfhi(bw);
            *(unsigned*)(OB + o) = cvt_pk_bf16((hs0[q] + h0) * bflo(yw), (hs1[q] + h1) * bfhi(yw)); }
    }
}

__device__ const unsigned char STAIR[64] = {
    0x00, 0x01, 0x02, 0x03, 0x04, 0x05, 0x06, 0x07, 0x08, 0x09, 0x0a, 0x0b, 0x0c, 0x0d, 0x0e, 0x0f,
    0x10, 0x11, 0x12, 0x13, 0x14, 0x15, 0x16, 0x17, 0x20, 0x21, 0x22, 0x23, 0x24, 0x30, 0x31, 0x32,
    0x33, 0x40, 0x41, 0x42, 0x50, 0x51, 0x60, 0x61, 0x70, 0x71, 0x80, 0x90, 0xa0, 0xb0, 0xc0, 0xd0,
    0xe0, 0xf0, 0, 0, 0, 0, 0, 0, 0, 0, 0, 0, 0, 0, 0, 0};
__device__ __forceinline__ unsigned mono_key(float f) { const unsigned b = __float_as_uint(f); return b ^ ((b >> 31) ? 0xffffffffu : 0x80000000u); }

__device__ __forceinline__ float inv_mono(unsigned k) { return __uint_as_float(k ^ ((k >> 31) ? 0x80000000u : 0xffffffffu)); }
#define TK_INSERT(L, x) do { _Pragma("unroll") for (int q_ = 0; q_ < 16; ++q_) { const unsigned hi_ = max(L[q_], x); x = min(L[q_], x); L[q_] = hi_; } } while (0)
__device__ __forceinline__ void peer_topk(KP p, LAS unsigned char* lds) {
    LAUNDER_IDS
    (void)bidL;
    const int tid = tidL, wave = tid >> 6, lane = tid & 63;
    const float* SCT = (const float*)(p->ws + WS_SCORES);
    int* TOPI = (int*)(p->ws + WS_TOPI); float* TOPG = (float*)(p->ws + WS_TOPG);
    LAS unsigned char* IX = lds + wave * 2048 + lane * 32;
    for (int item = bidL * NWAVE + wave; item < 2048; item += gridDim.x * NWAVE) {
        const int tg = item >> 3, hd = item & 7, tok = tg * 64 + lane;
        float V[2][16];
#pragma unroll
        for (int half = 0; half < 2; ++half) {
            unsigned L[16];
#pragma unroll
            for (int q = 0; q < 16; ++q) L[q] = 0u;
            const float* sc = SCT + (size_t)(hd * 256 + half * 128) * T + tok;
            float cur[16], nxt[16];
#pragma unroll
            for (int i = 0; i < 16; ++i) cur[i] = sc[(size_t)i * T];
#pragma unroll 1
            for (int kb = 0; kb < 8; ++kb) {
                const int kn = kb < 7 ? kb + 1 : kb;
#pragma unroll
                for (int i = 0; i < 16; ++i) nxt[i] = sc[(size_t)(kn * 16 + i) * T];
#pragma unroll
                for (int i = 0; i < 16; ++i) { unsigned x = (mono_key(cur[i]) & ~0x7fu) | (unsigned)(kb * 16 + i); TK_INSERT(L, x); }
#pragma unroll
                for (int i = 0; i < 16; ++i) cur[i] = nxt[i];
            }
            u32x4 w0, w1;
            w0.x = (L[0] & 0x7f) | ((L[1] & 0x7f) << 8) | ((L[2] & 0x7f) << 16) | ((L[3] & 0x7f) << 24); w0.y = (L[4] & 0x7f) | ((L[5] & 0x7f) << 8) | ((L[6] & 0x7f) << 16) | ((L[7] & 0x7f) << 24);
            w0.z = (L[8] & 0x7f) | ((L[9] & 0x7f) << 8) | ((L[10] & 0x7f) << 16) | ((L[11] & 0x7f) << 24); w0.w = (L[12] & 0x7f) | ((L[13] & 0x7f) << 8) | ((L[14] & 0x7f) << 16) | ((L[15] & 0x7f) << 24);
            *(LAS u32x4*)(IX + half * 16) = w0;
#pragma unroll
            for (int q = 0; q < 16; ++q) V[half][q] = inv_mono(L[q]);
        }
        unsigned C[16];
#pragma unroll
        for (int q = 0; q < 16; ++q) C[q] = 0u;
#pragma unroll
        for (int i = 0; i < 16; ++i)
#pragma unroll
            for (int jj = 0; jj < 16; ++jj) if ((i + 1) * (jj + 1) <= 16) { unsigned x = (mono_key(V[0][i] + V[1][jj]) & ~0xffu) | (unsigned)(i * 16 + jj); TK_INSERT(C, x); }
        asm volatile("s_waitcnt lgkmcnt(0)" ::: "memory");
        const float s0 = inv_mono(C[0] & ~0xffu);
        float e[16]; float sum = 0.f; int ids[16];
#pragma unroll
        for (int q = 0; q < 16; ++q) { e[q] = fast_exp(inv_mono(C[q] & ~0xffu) - s0); sum += e[q];
            const unsigned code = C[q] & 0xffu; ids[q] = (int)IX[code >> 4] * 128 + (int)IX[16 + (code & 15u)]; }
        const float rs = fast_rcp(sum);
        int* ip = TOPI + (size_t)tok * 128 + hd * 16; float* gp = TOPG + (size_t)tok * 128 + hd * 16;
#pragma unroll
        for (int q = 0; q < 4; ++q) { *(u32x4*)(ip + 4 * q) = (u32x4){(unsigned)ids[4 * q], (unsigned)ids[4 * q + 1], (unsigned)ids[4 * q + 2], (unsigned)ids[4 * q + 3]};
            *(f32x4*)(gp + 4 * q) = (f32x4){e[4 * q] * rs, e[4 * q + 1] * rs, e[4 * q + 2] * rs, e[4 * q + 3] * rs}; }
        asm volatile("s_waitcnt lgkmcnt(0)" ::: "memory");
    }
}

__device__ __forceinline__ void peer_gather(KP p, int l, bool dry) {
    LAUNDER_IDS
    const int wave = tidL >> 6, lane = tidL & 63;
    const bf16_t* HB = (const bf16_t*)(p->ws + WS_HBUF); bf16_t* HBW = (bf16_t*)(p->ws + WS_HBUF);
    const int* TOPI = (const int*)(p->ws + WS_TOPI); const float* TOPG = (const float*)(p->ws + WS_TOPG);
    const unsigned char* U8 = p->ws + WS_UTAB + (size_t)l * 16384 * 1024 + 16 * lane; const unsigned char* V8 = p->ws + WS_VTAB + (size_t)l * 16384 * 1024 + 16 * lane;
    const float* USC = (const float*)(p->ws + WS_USC) + l * 16384; const float* VSC = (const float*)(p->ws + WS_VSC) + l * 16384;
    float* XRES = (float*)(p->ws + WS_XRES); const float* MOD = (const float*)(p->ws + WS_MOD);
    for (int tok = bidL * NWAVE + wave; tok < T; tok += gridDim.x * NWAVE) {
        const int b = tok >> 13;
        f32x2 hv2[8];
        { const u32x4 h0 = *(const u32x4*)(HB + (size_t)tok * 1024 + 16 * lane), h1 = *(const u32x4*)(HB + (size_t)tok * 1024 + 16 * lane + 8);
            hv2[0] = (f32x2){bflo(h0.x), bfhi(h0.x)}; hv2[1] = (f32x2){bflo(h0.y), bfhi(h0.y)}; hv2[2] = (f32x2){bflo(h0.z), bfhi(h0.z)}; hv2[3] = (f32x2){bflo(h0.w), bfhi(h0.w)};
            hv2[4] = (f32x2){bflo(h1.x), bfhi(h1.x)}; hv2[5] = (f32x2){bflo(h1.y), bfhi(h1.y)}; hv2[6] = (f32x2){bflo(h1.z), bfhi(h1.z)}; hv2[7] = (f32x2){bflo(h1.w), bfhi(h1.w)}; }
        const int id0 = TOPI[(size_t)tok * 128 + lane], id1 = TOPI[(size_t)tok * 128 + 64 + lane];
        const float g0 = TOPG[(size_t)tok * 128 + lane], g1 = TOPG[(size_t)tok * 128 + 64 + lane];
        f32x2 acc2[8];
#pragma unroll
        for (int i = 0; i < 8; ++i) acc2[i] = (f32x2){0.f, 0.f};
#pragma unroll 1
        for (int e0 = 0; e0 < 128; e0 += 8) {
            u32x4 uq[8], vq[8]; float gk[8], su[8], sv[8];
#pragma unroll
            for (int k = 0; k < 8; ++k) { const int e = e0 + k;
                int id = __builtin_amdgcn_readlane(e0 < 64 ? id0 : id1, e & 63);
                id &= 16383;
                gk[k] = __uint_as_float(__builtin_amdgcn_readlane(__float_as_uint(e0 < 64 ? g0 : g1), e & 63));
                uq[k] = *(const u32x4*)(U8 + (size_t)id * 1024); vq[k] = *(const u32x4*)(V8 + (size_t)id * 1024);
                su[k] = USC[id]; sv[k] = VSC[id]; }
            float d[8];
#pragma unroll
            for (int k = 0; k < 8; ++k) { f32x2 s2 = (f32x2){0.f, 0.f};
#pragma unroll
                for (int w = 0; w < 4; ++w) { const f32x2 lo = __builtin_amdgcn_cvt_pk_f32_fp8((int)uq[k][w], false), hi = __builtin_amdgcn_cvt_pk_f32_fp8((int)uq[k][w], true);
                    s2 = lo * hv2[2 * w] + s2; s2 = hi * hv2[2 * w + 1] + s2; }
                d[k] = s2[0] + s2[1]; }
            const bool b32 = lane & 32, b16 = lane & 16, b8 = lane & 8;
            float d4[4], d2[2], r;
#pragma unroll
            for (int k = 0; k < 4; ++k) { const float recv = __shfl_xor(b32 ? d[k] : d[k + 4], 32); d4[k] = (b32 ? d[k + 4] : d[k]) + recv; }
#pragma unroll
            for (int k = 0; k < 2; ++k) { const float recv = __shfl_xor(b16 ? d4[k] : d4[k + 2], 16); d2[k] = (b16 ? d4[k + 2] : d4[k]) + recv; }
            { const float recv = __shfl_xor(b8 ? d2[0] : d2[1], 8); r = (b8 ? d2[1] : d2[0]) + recv; }
            r += __shfl_xor(r, 4); r += __shfl_xor(r, 2); r += __shfl_xor(r, 1);
#pragma unroll
            for (int k = 0; k < 8; ++k) { const float dot = __uint_as_float(__builtin_amdgcn_readlane(__float_as_uint(r), ((k >> 2) & 1) * 32 + ((k >> 1) & 1) * 16 + (k & 1) * 8));
                const float cf = gk[k] * gelu_tanh(dot * su[k]) * sv[k]; const f32x2 cf2 = (f32x2){cf, cf};
#pragma unroll
                for (int w = 0; w < 4; ++w) { const f32x2 lo = __builtin_amdgcn_cvt_pk_f32_fp8((int)vq[k][w], false), hi = __builtin_amdgcn_cvt_pk_f32_fp8((int)vq[k][w], true);
                    acc2[2 * w] = lo * cf2 + acc2[2 * w]; acc2[2 * w + 1] = hi * cf2 + acc2[2 * w + 1]; } }
        }
        const float* g2 = MOD + ((size_t)l * 2 + b) * 6144 + 5 * 1024 + 16 * lane;
        float* xrow = XRES + (size_t)tok * 1024 + 16 * lane;
        float xn[16]; float ss = 0.f;
#pragma unroll
        for (int q = 0; q < 4; ++q) { const f32x4 xr = *(const f32x4*)(xrow + 4 * q), gg = *(const f32x4*)(g2 + 4 * q);
            const float a0 = acc2[2 * q][0], a1 = acc2[2 * q][1], a2 = acc2[2 * q + 1][0], a3 = acc2[2 * q + 1][1];
            xn[4 * q + 0] = xr[0] + gg[0] * a0; xn[4 * q + 1] = xr[1] + gg[1] * a1; xn[4 * q + 2] = xr[2] + gg[2] * a2; xn[4 * q + 3] = xr[3] + gg[3] * a3; }
#pragma unroll
        for (int i = 0; i < 16; ++i) ss += xn[i] * xn[i];
        const float inv = __builtin_amdgcn_rsqf(wave_sum(ss) * (1.f / 1024.f) + EPS);
        if (dry) { if (inv == 123.456f) p->out[tok] = inv; continue; }
        if (l < DEPTH - 1) {
            const float* gain = p->norm_g + (size_t)(l + 1) * 2 * 1024 + 16 * lane; const float* sh = MOD + ((size_t)(l + 1) * 2 + b) * 6144 + 16 * lane; const float* sc = sh + 1024;
            float y[16];
#pragma unroll
            for (int q = 0; q < 4; ++q) { const f32x4 gn = *(const f32x4*)(gain + 4 * q), s1 = *(const f32x4*)(sh + 4 * q), c1 = *(const f32x4*)(sc + 4 * q);
                *(f32x4*)(xrow + 4 * q) = (f32x4){xn[4 * q], xn[4 * q + 1], xn[4 * q + 2], xn[4 * q + 3]};
#pragma unroll
                for (int i = 0; i < 4; ++i) y[4 * q + i] = (xn[4 * q + i] * inv) * gn[i] * (1.f + c1[i]) + s1[i]; }
            u32x4 o0, o1; o0.x = cvt_pk_bf16(y[0], y[1]); o0.y = cvt_pk_bf16(y[2], y[3]); o0.z = cvt_pk_bf16(y[4], y[5]); o0.w = cvt_pk_bf16(y[6], y[7]);
            o1.x = cvt_pk_bf16(y[8], y[9]); o1.y = cvt_pk_bf16(y[10], y[11]); o1.z = cvt_pk_bf16(y[12], y[13]); o1.w = cvt_pk_bf16(y[14], y[15]);
            *(u32x4*)(HBW + (size_t)tok * 1024 + 16 * lane) = o0; *(u32x4*)(HBW + (size_t)tok * 1024 + 16 * lane + 8) = o1;
        } else {
            const float* fg = p->final_g + 16 * lane; float* orow = p->out + (size_t)tok * 1024 + 16 * lane;
#pragma unroll
            for (int q = 0; q < 4; ++q) { const f32x4 gn = *(const f32x4*)(fg + 4 * q); f32x4 o;
#pragma unroll
                for (int i = 0; i < 4; ++i) o[i] = (xn[4 * q + i] * inv) * gn[i];
                *(f32x4*)(orow + 4 * q) = o; }
        }
    }
}

#define XB_TMO      128
#define XB_XCNT(j)  (256  + 64 * (j))
#define XB_XSUB(j)  (1280 + 64 * (j))
#define XB_XGEN(j)  (2304 + 64 * (j))
#define XB_TOP      3328
#define XB_TOPGEN   3392
#define XCD_BAR_WORDS 3456
#define XB_SPIN_CAP (1u << 18)

__device__ __forceinline__ unsigned xb_ld(unsigned* p)              { return __hip_atomic_load(p, __ATOMIC_RELAXED, __HIP_MEMORY_SCOPE_AGENT); }
__device__ __forceinline__ unsigned xb_add(unsigned* p, unsigned v) { return __hip_atomic_fetch_add(p, v, __ATOMIC_RELAXED, __HIP_MEMORY_SCOPE_AGENT); }
__device__ __forceinline__ unsigned xb_xcc_id() { return (unsigned)__builtin_amdgcn_s_getreg((3 << 11) | 20) & 0xFu; }
#define XB_SPIN(cond, bar) do { unsigned _sp = 0; while (cond) { __builtin_amdgcn_s_sleep(1); \
    if ((++_sp & 255u) == 0u) { if (xb_ld(&(bar)[XB_TMO])) break; if (_sp > XB_SPIN_CAP) { atomicAdd(&(bar)[XB_TMO], 1u); break; } } } } while (0)

struct XcdBarrier {
    unsigned* bar; unsigned x;
    volatile LAS unsigned* st;
};

__device__ __forceinline__ XcdBarrier xcd_barrier_post(unsigned* bar, volatile LAS unsigned* st) {
    XcdBarrier b; b.bar = bar; b.x = xb_xcc_id(); b.st = st;
    if (threadIdx.x == 0) (void)xb_add(&bar[XB_XCNT(b.x)], 1u);
    return b;
}
__device__ __forceinline__ void xcd_barrier_complete(unsigned* bar, unsigned x, unsigned& nloc, unsigned& nx) {
    const unsigned G = gridDim.x * gridDim.y * gridDim.z;
    unsigned sum, cnt, mine, sp = 0u;
    for (;;) {
        sum = 0u; cnt = 0u; mine = 0u;
#pragma unroll
        for (unsigned j = 0; j < 16; ++j) { const unsigned c = xb_ld(&bar[XB_XCNT(j)]); sum += c; cnt += (c > 0u) ? 1u : 0u; mine = (j == x) ? c : mine; }
        if (sum == G) break;
        __builtin_amdgcn_s_sleep(1);
        if ((++sp & 255u) == 0u) { if (xb_ld(&bar[XB_TMO])) break; if (sp > XB_SPIN_CAP) { atomicAdd(&bar[XB_TMO], 1u); break; } }
    }
    nloc = mine > 0u ? mine : 1u; nx = cnt > 0u ? cnt : 1u;
}

__device__ __forceinline__ void xcd_barrier(const XcdBarrier& b) {
    asm volatile("s_waitcnt vmcnt(0)" ::: "memory");
    __syncthreads();
    if (threadIdx.x == 0) {
        unsigned* bar = b.bar;
        __builtin_amdgcn_s_waitcnt(0);
        unsigned nloc = b.st[0], nx = b.st[1];
        if (nloc == 0u) { xcd_barrier_complete(bar, b.x, nloc, nx); b.st[0] = nloc; b.st[1] = nx; }
        const unsigned old = xb_add(&bar[XB_XSUB(b.x)], 1u);
        const unsigned gen = old / nloc;
        if (old + 1u == (gen + 1u) * nloc) {
            __builtin_amdgcn_fence(__ATOMIC_RELEASE, "agent");
            asm volatile("s_waitcnt vmcnt(0)" ::: "memory");
            const unsigned og = xb_add(&bar[XB_TOP], 1u);
            const unsigned tg = og / nx;
            if (og + 1u == (tg + 1u) * nx) xb_add(&bar[XB_TOPGEN], 1u);
            else XB_SPIN(xb_ld(&bar[XB_TOPGEN]) == tg, bar);
            __builtin_amdgcn_fence(__ATOMIC_ACQUIRE, "agent");
            xb_add(&bar[XB_XGEN(b.x)], 1u);
            asm volatile("s_waitcnt vmcnt(0)" ::: "memory");
        } else {
            XB_SPIN(xb_ld(&bar[XB_XGEN(b.x)]) == gen, bar);
            __builtin_amdgcn_fence(__ATOMIC_ACQUIRE, "agent");
            asm volatile("s_waitcnt vmcnt(0)" ::: "memory");
        }
    }
    __syncthreads();
}

#ifndef OPMASK
#define OPMASK 0xFFFFFFFFu
#endif
#define EN(o) ((OPMASK >> (o)) & 1u)
enum { OP_P0 = 0, OP_RMS1, OP_HG_IN, OP_HG_A, OP_HG_B, OP_HG_C, OP_MIX_OUT, OP_LR_IN, OP_LR_CONV, OP_LR_G, OP_LR_S1, OP_LR_S2, OP_LR_S3, OP_RMS2, OP_QK, OP_TOPK, OP_GATHER };
constexpr int NPH = 42;
#define REP_MASK 0u
__device__ __forceinline__ void decode_phase(int ph, int& l, int& op) {
    if (ph == 0) { l = 0; op = OP_P0; return; }
    if (ph == 1) { l = 0; op = OP_RMS1; return; }
    int q = ph - 2;
    if (q < 9) { l = 0; } else if (q < 20) { l = 1; q -= 9; } else if (q < 29) { l = 2; q -= 20; } else { l = 3; q -= 29; }
    if ((l & 1) == 0) { op = q == 0 ? OP_HG_IN : q == 1 ? OP_HG_A : q == 2 ? OP_HG_B : q == 3 ? OP_HG_C : q == 4 ? OP_MIX_OUT : q == 5 ? OP_RMS2 : q == 6 ? OP_QK : q == 7 ? OP_TOPK : OP_GATHER; }
    else { op = q == 0 ? OP_LR_IN : q == 1 ? OP_LR_CONV : q == 2 ? OP_LR_G : q == 3 ? OP_LR_S1 : q == 4 ? OP_LR_S2 : q == 5 ? OP_LR_S3 : q == 6 ? OP_MIX_OUT : q == 7 ? OP_RMS2 : q == 8 ? OP_QK : q == 9 ? OP_TOPK : OP_GATHER; }
}

__global__ __launch_bounds__(512, 2) void mk_fwd(Params p_arg) {
    extern __shared__ __attribute__((aligned(16))) unsigned char shm[];
    LAS unsigned char* lds = (LAS unsigned char*)shm;
    cg::grid_group grid = cg::this_grid();
    unsigned long long kpv = (unsigned long long)__builtin_amdgcn_kernarg_segment_ptr();
    const int ph_lo = p_arg.ph_lo, ph_hi = p_arg.ph_hi;
    volatile LAS unsigned* xst = (volatile LAS unsigned*)(lds + LDS_BYTES - 16);
    if (threadIdx.x == 0) { xst[0] = 0u; xst[1] = 0u; }
    __syncthreads();
    const XcdBarrier xb = xcd_barrier_post((unsigned*)(p_arg.ws + WS_CTL) + 1024, xst);
    for (int ph = ph_lo; ph < ph_hi; ++ph) {
        if (ph > ph_lo) { if (ph == 1) grid.sync(); else xcd_barrier(xb); }
        asm volatile("" : "+s"(kpv));
        KP p = (KP)kpv;
        unsigned char* ws = p->ws;
        const float* MOD = (const float*)(ws + WS_MOD);
        int l, op; decode_phase(ph, l, op);
        const int j = l >> 1;
        const int nrep = ((p->rep_mask >> op) & 1u) ? 2 : 1;
        for (int rep = 0; rep < nrep; ++rep) {
        const bool dry = rep + 1 < nrep;
#ifdef ONLY
        switch (ONLY) {
#else
        switch (op) {
#endif
        case OP_P0: if (EN(OP_P0)) phase0(p, lds); break;
        case OP_RMS1: if (EN(OP_RMS1)) phase_rms(p->x, p->norm_g, MOD, MOD + 1024, (bf16_t*)(ws + WS_HBUF)); break;
        case OP_HG_IN: if (EN(OP_HG_IN)) { EpiBf16 E; E.O = (bf16_t*)(ws + WS_PROJ); E.ldc = 5120;
            run_gemm(lds, (const bf16_t*)(ws + WS_HBUF), (const bf16_t*)(ws + WS_HGWIN) + (size_t)j * 5120 * 1024, 5120, 1024, 1024, 1024, 0, 0, E); } break;
        case OP_HG_A: if (EN(OP_HG_A)) hg_pass_a(p, lds, j); break;
        case OP_HG_B: if (EN(OP_HG_B)) hg_pass_b(p); break;
        case OP_HG_C: if (EN(OP_HG_C)) hg_pass_c(p, lds, j); break;
        case OP_MIX_OUT: if (EN(OP_MIX_OUT)) { EpiResid E; E.xin = (l == 0) ? p->x : (const float*)(ws + WS_XRES); E.xout = (float*)(ws + WS_XRES); E.gate = MOD + (size_t)l * 2 * 6144 + 2 * 1024; E.dry = dry;
            const bf16_t* W = (l & 1) ? (const bf16_t*)(ws + WS_LRWOUT) + (size_t)j * 1024 * 1024 : (const bf16_t*)(ws + WS_HGWOUT) + (size_t)j * 1024 * 1024;
            run_gemm(lds, (const bf16_t*)(ws + WS_OB), W, 1024, 1024, 1024, 1024, 0, 0, E); } break;
        case OP_LR_IN: if (EN(OP_LR_IN)) { EpiLruIn E; E.XB = (bf16_t*)(ws + WS_XB); E.YG = (bf16_t*)(ws + WS_YG);
            run_gemm(lds, (const bf16_t*)(ws + WS_HBUF), (const bf16_t*)(ws + WS_LRWIN) + (size_t)j * 2048 * 1024, 2048, 1024, 1024, 1024, 0, 0, E); } break;
        case OP_LR_CONV: if (EN(OP_LR_CONV)) lru_conv(p, j); break;
        case OP_LR_G: if (EN(OP_LR_G)) { EpiGates E; E.LOGA = (bf16_t*)(ws + WS_LOGA); E.BTERM = (bf16_t*)(ws + WS_BTERM); E.XC = (const bf16_t*)(ws + WS_XC);
            E.b_a = p->lru_b_a + (size_t)j * 2048; E.b_x = p->lru_b_x + (size_t)j * 2048; E.lam = p->lru_lam + (size_t)j * 2048;
            run_gemm(lds, (const bf16_t*)(ws + WS_XC), (const bf16_t*)(ws + WS_LRWG) + (size_t)j * 4 * 1024 * 256, 4096, 256, 1024, 256, 2, 512, E); } break;
        case OP_LR_S1: if (EN(OP_LR_S1)) lru_scan1(p); break;
        case OP_LR_S2: if (EN(OP_LR_S2)) lru_scan2(p); break;
        case OP_LR_S3: if (EN(OP_LR_S3)) lru_scan3(p); break;
        case OP_RMS2: if (EN(OP_RMS2)) phase_rms((const float*)(ws + WS_XRES), p->norm_g + ((size_t)l * 2 + 1) * 1024, MOD + (size_t)l * 2 * 6144 + 3 * 1024, MOD + (size_t)l * 2 * 6144 + 4 * 1024, (bf16_t*)(ws + WS_HBUF)); break;
        case OP_QK: if (EN(OP_QK)) { EpiScoresT E; E.C = (float*)(ws + WS_SCORES);
            run_gemm(lds, (const bf16_t*)(ws + WS_HBUF), (const bf16_t*)(ws + WS_WQK) + (size_t)l * 2048 * 1024, 2048, 1024, 1024, 1024, 0, 0, E); } break;
        case OP_TOPK: if (EN(OP_TOPK)) peer_topk(p, lds); break;
        case OP_GATHER: if (EN(OP_GATHER)) peer_gather(p, l, dry); break;
        default: break;
        }
        }
    }
}

extern "C" void kernel_launch(void* const* d_in, const int* in_sizes, int n_in, void* d_out, int out_size, void* d_ws, size_t ws_size, hipStream_t stream) {
    static int grid = 0;
    if (grid == 0) {
        if (n_in != 23 || ws_size < WS_END) { fprintf(stderr, "kernel_launch: unexpected n_in %d / ws_size %zu (need %zu)\n", n_in, ws_size, (size_t)WS_END); grid = -1; return; }
        int dev = 0, cus = 0, per_cu = 0;
        hipGetDevice(&dev); hipDeviceGetAttribute(&cus, hipDeviceAttributeMultiprocessorCount, dev);
        if (hipFuncSetAttribute((const void*)mk_fwd, hipFuncAttributeMaxDynamicSharedMemorySize, LDS_BYTES) != hipSuccess) { fprintf(stderr, "kernel_launch: hipFuncSetAttribute failed\n"); grid = -1; return; }
        if (hipOccupancyMaxActiveBlocksPerMultiprocessor(&per_cu, (const void*)mk_fwd, NTHR, LDS_BYTES) != hipSuccess || per_cu < 1) { fprintf(stderr, "kernel_launch: occupancy query failed (%d)\n", per_cu); (void)hipGetLastError(); per_cu = 1; }
        grid = cus * 1;
        fprintf(stderr, "kernel_launch: cus %d per_cu %d grid %d\n", cus, per_cu, grid);
    }
    if (grid < 0) return;
    if (hipMemsetAsync((char*)d_ws + WS_CTL, 0, 65536, stream) != hipSuccess) { fprintf(stderr, "kernel_launch: memset failed\n"); return; }
    Params p{};
    const float** pp = (const float**)&p;
    for (int i = 0; i < 23; ++i) pp[i] = (const float*)d_in[i];
    p.out = (float*)d_out; p.ws = (unsigned char*)d_ws; p.ph_lo = 0; p.ph_hi = NPH; p.rep_mask = REP_MASK;
    void* args[] = {&p};
    hipError_t e = hipLaunchCooperativeKernel((const void*)mk_fwd, dim3(grid), dim3(NTHR), args, LDS_BYTES, stream);
    if (e != hipSuccess) fprintf(stderr, "kernel_launch: cooperative launch failed: %s (grid %d)\n", hipGetErrorString(e), grid);
}
```

```cpp
#include <hip/hip_runtime.h>
#include <hip/hip_cooperative_groups.h>
#include <cstdio>
#include <cstdint>
namespace cg = cooperative_groups;

#define LAS __attribute__((address_space(3)))
#define PG8_LAS __attribute__((address_space(3)))
typedef unsigned short bf16_t;
typedef short bf16x8 __attribute__((ext_vector_type(8)));
typedef float f32x4 __attribute__((ext_vector_type(4)));
typedef float f32x2 __attribute__((ext_vector_type(2)));
typedef unsigned u32x4 __attribute__((ext_vector_type(4)));
typedef unsigned u32x2 __attribute__((ext_vector_type(2)));

constexpr int T = 16384, D = 1024, SEQ = 8192, DEPTH = 4;
constexpr float EPS = 1e-6f;
constexpr int NBLK = 256, NTHR = 512, NWAVE = 8, NGW = NBLK * NWAVE;

constexpr size_t MiB = 1u << 20;
constexpr size_t WS_CTL = 0;
constexpr size_t WS_MOD = 1 * MiB;
constexpr size_t WS_HGWIN = 2 * MiB;
constexpr size_t WS_HGWOUT = 22 * MiB;
constexpr size_t WS_LRWIN = 26 * MiB;
constexpr size_t WS_LRWG = 34 * MiB;
constexpr size_t WS_LRWOUT = 38 * MiB;
constexpr size_t WS_WQK = 42 * MiB;
constexpr size_t WS_TOPI = 58 * MiB;
constexpr size_t WS_TOPG = 66 * MiB;
constexpr size_t WS_DEC = 74 * MiB;
constexpr size_t WS_CP = 75 * MiB;
constexpr size_t WS_CH = 79 * MiB;
constexpr size_t WS_HIN = 83 * MiB;
constexpr size_t WS_USC = 87 * MiB;
constexpr size_t WS_VSC = 87 * MiB + 262144;
constexpr size_t WS_XRES = 88 * MiB;
constexpr size_t WS_HBUF = 152 * MiB;
constexpr size_t WS_OB = 184 * MiB;
constexpr size_t WS_PROJ = 216 * MiB;
constexpr size_t WS_XB = WS_PROJ, WS_YG = WS_PROJ + 32 * MiB, WS_XC = WS_PROJ + 64 * MiB, WS_LOGA = WS_PROJ + 96 * MiB;
constexpr size_t WS_SCORES = WS_PROJ;
constexpr size_t WS_KV = 376 * MiB;
constexpr size_t WS_BTERM = WS_KV;
constexpr size_t WS_SIN = 504 * MiB;
constexpr size_t WS_UTAB = 568 * MiB;
constexpr size_t WS_VTAB = 696 * MiB;
constexpr size_t WS_END = 824 * MiB;

constexpr int LDS_BYTES = 155648;

#define LAUNDER_IDS int tidL = threadIdx.x, bidL = blockIdx.x; asm volatile("" : "+v"(tidL)); asm volatile("" : "+s"(bidL));
__device__ __forceinline__ float bf2f(bf16_t b) { return __uint_as_float(((unsigned)b) << 16); }
__device__ __forceinline__ float bflo(unsigned u) { return __uint_as_float(u << 16); }
__device__ __forceinline__ float bfhi(unsigned u) { return __uint_as_float(u & 0xffff0000u); }
__device__ __forceinline__ unsigned cvt_pk_bf16(float lo, float hi) { unsigned r; asm volatile("v_cvt_pk_bf16_f32 %0, %1, %2" : "=v"(r) : "v"(lo), "v"(hi)); return r; }
__device__ __forceinline__ bf16_t f2bf(float f) { return (bf16_t)(cvt_pk_bf16(f, 0.f) & 0xffffu); }
__device__ __forceinline__ float fast_exp(float x) { return __builtin_amdgcn_exp2f(x * 1.4426950408889634f); }
__device__ __forceinline__ float fast_log(float x) { return __builtin_amdgcn_logf(x) * 0.6931471805599453f; }
__device__ __forceinline__ float fast_rcp(float x) { return __builtin_amdgcn_rcpf(x); }
__device__ __forceinline__ float sigmoidf_(float x) { return fast_rcp(1.f + fast_exp(-x)); }
__device__ __forceinline__ float gelu_tanh(float x) { const float u = 1.5957691216057308f * (x + 0.044715f * x * x * x); return x * fast_rcp(1.f + fast_exp(-u)); }
__device__ __forceinline__ float silu_(float x) { return x * sigmoidf_(x); }
__device__ __forceinline__ float wave_sum(float v) {
#pragma unroll
    for (int o = 1; o < 64; o <<= 1) v += __shfl_xor(v, o);
    return v;
}
__device__ __forceinline__ float wave_max(float v) {
#pragma unroll
    for (int o = 1; o < 64; o <<= 1) v = fmaxf(v, __shfl_xor(v, o));
    return v;
}

namespace pg8 {
constexpr int BM = 256, BK = 64, HALF = 128, HTB = HALF * BK * 2, STAGE_BYTES = 8 * HTB, NXCD = 8, WGM = 8;
__host__ __device__ __forceinline__ int lds_byte(int r, int c) { const int st = (r >> 4) * 2 + (c >> 5), rr = r & 15, cc = c & 31, ob = rr * 64 + cc * 2; return st * 1024 + (ob ^ (((ob >> 9) & 1) << 5)); }
__host__ __device__ __forceinline__ void stage_rc(int b, int& R, int& C) { const int st = b / 1024, sb = b % 1024, swz = sb ^ (((sb >> 9) & 1) << 5); R = (st >> 1) * 16 + swz / 64; C = (st & 1) * 32 + (swz % 64) / 2; }
__host__ __device__ __forceinline__ int perm32(int rho) { const int n = rho >> 4, i = rho & 15; return 8 * (i >> 2) + 4 * n + (i & 3); }
struct Unit { int pm, pn; };
struct Gemm { const bf16_t* A; const bf16_t* Bt; int M, N, K, lda, ldb, a_pn_shift, a_pn_stride; };
struct StaticOrder {
    int nM, nN, nwg, G, c;
    __host__ __device__ void init(int M, int N, int G_, int c_) { nM = M / BM; nN = N / BM; nwg = nM * nN; G = G_; c = c_; }
    __host__ __device__ bool next(int i, Unit& u) const {
        const long L = (long)i * G + c; if (L >= nwg) return false;
        int wgid = (int)L; { const int q = nwg / NXCD, r = nwg % NXCD, xcd = wgid % NXCD, off = wgid / NXCD; wgid = (xcd < r ? xcd * (q + 1) : r * (q + 1) + (xcd - r) * q) + off; }
        const int nig = WGM * nN, gid = wgid / nig, fm = gid * WGM, gsz = (nM - fm) < WGM ? (nM - fm) : WGM;
        u.pm = fm + ((wgid % nig) % gsz); u.pn = (wgid % nig) / gsz; return true;
    }
    __device__ __forceinline__ void a_ready(const Unit&) const {}
    __device__ __forceinline__ void done(const Unit&) const {}
};
template <class Epi, class Sched, bool STAMP = false>
__device__ __forceinline__ void gemm_phase(PG8_LAS unsigned char* lds, const Gemm g, const Sched& S, const Epi& E, unsigned long long* stamps) {
    int tid = threadIdx.x; asm volatile("" : "+v"(tid)); const int wid = __builtin_amdgcn_readfirstlane(tid >> 6), lane = tid & 63, wr = wid >> 2, wc = wid & 3, fr = lane & 15, fq = lane >> 4;
    const int K = g.K, nt = K / BK;
    int ts_lo = 0, ts_hi = 0, nts = 0; const unsigned long long rt_entry = STAMP ? (unsigned long long)wall_clock64() : 0ull;
#define PG8_STAMP() do { if (STAMP && wid == 0 && nts < 64) { const unsigned long long _c = (unsigned long long)clock64(); \
        ts_lo = (lane == nts) ? (int)(unsigned)_c : ts_lo; ts_hi = (lane == nts) ? (int)(unsigned)(_c >> 32) : ts_hi; ++nts; } } while (0)
    PG8_STAMP();
    unsigned voffA[2], voffB[2];
#pragma unroll
    for (int i = 0; i < 2; ++i) { int R, C; stage_rc(tid * 16 + i * 8192, R, C); const int Rb = Epi::PERM ? ((R & ~31) + perm32(R & 31)) : R;
        voffA[i] = (unsigned)(R * g.lda + C) * 2u; voffB[i] = (unsigned)(Rb * g.ldb + C) * 2u; }
    const size_t kstep = (size_t)(BK * 2);
    const size_t hstepA = (size_t)HALF * g.lda * 2, hstepB = (size_t)HALF * g.ldb * 2;
    const size_t tstepA = 2 * hstepA, tstepB = 2 * hstepB;
    const unsigned ldsw = (unsigned)wid * 1024u;
    const int aoff = lds_byte(wr * 64 + fr, fq * 8), boff = lds_byte(wc * 32 + fr, fq * 8);
#define PG8_SA(b, h) (((b) * 2 + (h)) * HTB)
#define PG8_SB(b, h) ((4 + (b) * 2 + (h)) * HTB)
#define PG8_STAGE(bufoff, gbase, voff) do { _Pragma("unroll") for (int _i = 0; _i < 2; ++_i) \
        __builtin_amdgcn_global_load_lds((const unsigned*)((const char*)(gbase) + (voff)[_i]), (PG8_LAS unsigned*)(lds + (bufoff) + ldsw + _i * 8192), 16, 0, 0); } while (0)
#define PG8_LDA(dst, b, h) do { _Pragma("unroll") for (int m = 0; m < 4; ++m) _Pragma("unroll") for (int k = 0; k < 2; ++k) dst[m][k] = *(const PG8_LAS bf16x8*)(lds + PG8_SA(b, h) + aoff + m * 2048 + k * 1024); } while (0)
#define PG8_LDB(dst, b, h) do { _Pragma("unroll") for (int n = 0; n < 2; ++n) _Pragma("unroll") for (int k = 0; k < 2; ++k) dst[n][k] = *(const PG8_LAS bf16x8*)(lds + PG8_SB(b, h) + boff + n * 2048 + k * 1024); } while (0)
#define PG8_MMA(ai, bj, At, Bt) do { __builtin_amdgcn_s_setprio(1); _Pragma("unroll") for (int m = 0; m < 4; ++m) _Pragma("unroll") for (int n = 0; n < 2; ++n) _Pragma("unroll") for (int k = 0; k < 2; ++k) \
        acc[ai][bj][m][n] = Epi::SWAP ? __builtin_amdgcn_mfma_f32_16x16x32_bf16(At[m][k], Bt[n][k], acc[ai][bj][m][n], 0, 0, 0) : __builtin_amdgcn_mfma_f32_16x16x32_bf16(Bt[n][k], At[m][k], acc[ai][bj][m][n], 0, 0, 0); __builtin_amdgcn_s_setprio(0); } while (0)
#define PG8_WAIT_V(n) asm volatile("s_waitcnt vmcnt(" #n ")" ::: "memory")
#define PG8_WAIT_L(n) asm volatile("s_waitcnt lgkmcnt(" #n ")" ::: "memory")
#define PG8_BAR __builtin_amdgcn_s_barrier()
#define PG8_SCHED __builtin_amdgcn_sched_barrier(0)
    Unit cur, nxt; int ui = 0;
    if (!S.next(0, cur)) return;
    f32x4 acc[2][2][4][2];
#pragma unroll
    for (int a = 0; a < 2; ++a)
#pragma unroll
        for (int b = 0; b < 2; ++b)
#pragma unroll
            for (int m = 0; m < 4; ++m)
#pragma unroll
                for (int n = 0; n < 2; ++n) acc[a][b][m][n] = (f32x4){0.f, 0.f, 0.f, 0.f};
    bf16x8 At[4][2], B0[2][2], B1[2][2];
    const char* cA = (const char*)g.A + (size_t)cur.pm * tstepA + (size_t)(cur.pn >> g.a_pn_shift) * g.a_pn_stride; const char* cB = (const char*)g.Bt + (size_t)cur.pn * tstepB;
    S.a_ready(cur);
    PG8_STAGE(PG8_SB(0, 0), cB, voffB); PG8_STAGE(PG8_SA(0, 0), cA, voffA); PG8_STAGE(PG8_SB(0, 1), cB + hstepB, voffB); PG8_STAGE(PG8_SA(0, 1), cA + hstepA, voffA);
    if (wr == 1) PG8_BAR;
    PG8_WAIT_V(4); PG8_BAR;
    PG8_STAGE(PG8_SB(1, 0), cB + kstep, voffB); PG8_STAGE(PG8_SA(1, 0), cA + kstep, voffA); PG8_STAGE(PG8_SB(1, 1), cB + hstepB + kstep, voffB);
    PG8_WAIT_V(6); PG8_BAR;
    PG8_STAMP();
    for (;;) {
        const bool has_next = S.next(ui + 1, nxt);
        const char* nA = has_next ? (const char*)g.A + (size_t)nxt.pm * tstepA + (size_t)(nxt.pn >> g.a_pn_shift) * g.a_pn_stride : cA; const char* nB = has_next ? (const char*)g.Bt + (size_t)nxt.pn * tstepB : cB;
#pragma unroll 1
        for (int t = 0; t < nt; t += 2) {
            const bool last = (t == nt - 2);
            const char* a1 = cA + (size_t)(t + 1) * kstep;
            const char* a2 = last ? nA : cA + (size_t)(t + 2) * kstep; const char* b2 = last ? nB : cB + (size_t)(t + 2) * kstep;
            const char* a3 = a2 + kstep; const char* b3 = b2 + kstep;
            if (last && has_next) S.a_ready(nxt);
            PG8_LDB(B0, 0, 0); PG8_SCHED; PG8_LDA(At, 0, 0); PG8_STAGE(PG8_SA(1, 1), a1 + hstepA, voffA);
            PG8_WAIT_L(8); PG8_BAR; PG8_WAIT_L(0); PG8_MMA(0, 0, At, B0); PG8_BAR; PG8_SCHED;
            PG8_LDB(B1, 0, 1); PG8_STAGE(PG8_SB(0, 0), b2, voffB);
            PG8_BAR; PG8_WAIT_L(0); PG8_MMA(0, 1, At, B1); PG8_BAR;
            PG8_LDA(At, 0, 1); PG8_STAGE(PG8_SA(0, 0), a2, voffA);
            PG8_BAR; PG8_WAIT_L(0); PG8_MMA(1, 0, At, B0); PG8_BAR; PG8_SCHED;
            PG8_STAGE(PG8_SB(0, 1), b2 + hstepB, voffB);
            PG8_WAIT_V(6); PG8_BAR; PG8_MMA(1, 1, At, B1); PG8_BAR;
            PG8_LDB(B0, 1, 0); PG8_SCHED; PG8_LDA(At, 1, 0); PG8_STAGE(PG8_SA(0, 1), a2 + hstepA, voffA);
            PG8_WAIT_L(8); PG8_BAR; PG8_WAIT_L(0); PG8_MMA(0, 0, At, B0); PG8_BAR; PG8_SCHED;
            PG8_LDB(B1, 1, 1); PG8_STAGE(PG8_SB(1, 0), b3, voffB);
            PG8_BAR; PG8_WAIT_L(0); PG8_MMA(0, 1, At, B1); PG8_BAR;
            PG8_LDA(At, 1, 1); PG8_STAGE(PG8_SA(1, 0), a3, voffA);
            PG8_BAR; PG8_WAIT_L(0); PG8_MMA(1, 0, At, B0); PG8_BAR; PG8_SCHED;
            PG8_STAGE(PG8_SB(1, 1), b3 + hstepB, voffB);
            PG8_WAIT_V(6); PG8_BAR; PG8_MMA(1, 1, At, B1); PG8_BAR;
        }
        PG8_STAMP();
        if constexpr (!Epi::AFTER_DRAIN) { E(acc, cur, wr, wc, fr, fq); S.done(cur); }
        PG8_STAMP();
        if (!has_next) break;
#pragma unroll
        for (int a = 0; a < 2; ++a)
#pragma unroll
            for (int b = 0; b < 2; ++b)
#pragma unroll
                for (int m = 0; m < 4; ++m)
#pragma unroll
                    for (int n = 0; n < 2; ++n) acc[a][b][m][n] = (f32x4){0.f, 0.f, 0.f, 0.f};
        cur = nxt; cA = nA; cB = nB; ++ui;
    }
    PG8_WAIT_V(0);
    if (wr == 0) PG8_BAR;
    PG8_BAR;
    if constexpr (Epi::AFTER_DRAIN) { E.fused(acc, cur, wr, wc, fr, fq, lds, wid, lane); S.done(cur); }
    PG8_STAMP();
    if (STAMP && wid == 0) { stamps[lane] = lane < nts ? (((unsigned long long)(unsigned)ts_hi << 32) | (unsigned)ts_lo) : 0ull;
        if (lane == 62) stamps[62] = rt_entry; if (lane == 63) stamps[63] = (unsigned long long)wall_clock64(); }
#undef PG8_STAMP
#undef PG8_SA
#undef PG8_SB
#undef PG8_STAGE
#undef PG8_LDA
#undef PG8_LDB
#undef PG8_MMA
#undef PG8_WAIT_V
#undef PG8_WAIT_L
#undef PG8_BAR
#undef PG8_SCHED
}
}
using pg8::Unit;

struct EpiBf16 {
    static constexpr bool PERM = true, AFTER_DRAIN = false, SWAP = false;
    bf16_t* O; int ldc;
    __device__ __forceinline__ void operator()(const f32x4 (&acc)[2][2][4][2], const Unit& u, int wr, int wc, int fr, int fq) const {
        const int row0 = u.pm * 256 + wr * 64 + fr, col0 = u.pn * 256 + wc * 32 + 8 * fq;
#pragma unroll
        for (int ai = 0; ai < 2; ++ai)
#pragma unroll
            for (int m = 0; m < 4; ++m) { bf16_t* rowp = O + (size_t)(row0 + ai * 128 + m * 16) * ldc + col0;
#pragma unroll
                for (int bj = 0; bj < 2; ++bj) { const f32x4 v0 = acc[ai][bj][m][0], v1 = acc[ai][bj][m][1];
                    u32x4 o; o.x = cvt_pk_bf16(v0[0], v0[1]); o.y = cvt_pk_bf16(v0[2], v0[3]); o.z = cvt_pk_bf16(v1[0], v1[1]); o.w = cvt_pk_bf16(v1[2], v1[3]);
                    *(u32x4*)(rowp + bj * 128) = o; } }
    }
};
struct EpiLruIn {
    static constexpr bool PERM = true, AFTER_DRAIN = false, SWAP = false;
    bf16_t* XB; bf16_t* YG;
    __device__ __forceinline__ void operator()(const f32x4 (&acc)[2][2][4][2], const Unit& u, int wr, int wc, int fr, int fq) const {
        const bool isy = u.pn >= 4;
        bf16_t* O = isy ? YG : XB;
        const int row0 = u.pm * 256 + wr * 64 + fr, col0 = (u.pn & 3) * 256 + wc * 32 + 8 * fq;
#pragma unroll
        for (int ai = 0; ai < 2; ++ai)
#pragma unroll
            for (int m = 0; m < 4; ++m) { bf16_t* rowp = O + (size_t)(row0 + ai * 128 + m * 16) * 1024 + col0;
#pragma unroll
                for (int bj = 0; bj < 2; ++bj) { f32x4 v0 = acc[ai][bj][m][0], v1 = acc[ai][bj][m][1];
                    if (isy) {
#pragma unroll
                        for (int i = 0; i < 4; ++i) { v0[i] = gelu_tanh(v0[i]); v1[i] = gelu_tanh(v1[i]); } }
                    u32x4 o; o.x = cvt_pk_bf16(v0[0], v0[1]); o.y = cvt_pk_bf16(v0[2], v0[3]); o.z = cvt_pk_bf16(v1[0], v1[1]); o.w = cvt_pk_bf16(v1[2], v1[3]);
                    *(u32x4*)(rowp + bj * 128) = o; } }
    }
};
struct EpiGates {
    static constexpr bool PERM = true, AFTER_DRAIN = false, SWAP = false;
    bf16_t* LOGA; bf16_t* BTERM; const bf16_t* XC; const float* b_a; const float* b_x; const float* lam;
    __device__ __forceinline__ void operator()(const f32x4 (&acc)[2][2][4][2], const Unit& u, int wr, int wc, int fr_, int fq) const {
        int fr = fr_; asm volatile("" : "+v"(fr));
        const int nblk = u.pn >> 2, uu = u.pn & 3, d = uu >> 1, jh = uu & 1;
        const int colbase = nblk * 256 + jh * 128 + wc * 32 + 8 * fq;
        const unsigned off0 = (unsigned)(u.pm * 256 + wr * 64 + fr) * 1024u + (unsigned)colbase;
        const bf16_t* xcp = XC; bf16_t* lap = LOGA + (size_t)d * T * 1024; bf16_t* btp = BTERM + (size_t)d * T * 1024;
        const float* bap = b_a + d * 1024; const float* bxp = b_x + d * 1024; const float* lmp = lam + d * 1024;
#pragma unroll
        for (int ai = 0; ai < 2; ++ai)
#pragma unroll
            for (int m = 0; m < 4; ++m) { const unsigned off = off0 + (unsigned)(ai * 128 + m * 16) * 1024u;
                asm volatile("" ::: "memory"); __builtin_amdgcn_sched_barrier(0);
                const u32x4 xr = *(const u32x4*)(xcp + off);
                const float xv[8] = {bflo(xr.x), bfhi(xr.x), bflo(xr.y), bfhi(xr.y), bflo(xr.z), bfhi(xr.z), bflo(xr.w), bfhi(xr.w)};
                unsigned o1[4], o2[4];
#pragma unroll
                for (int n = 0; n < 2; ++n) { const f32x4 ba = *(const f32x4*)(bap + (unsigned)(colbase + 4 * n)), bx = *(const f32x4*)(bxp + (unsigned)(colbase + 4 * n)), lm = *(const f32x4*)(lmp + (unsigned)(colbase + 4 * n));
                    float la[4], bt[4];
#pragma unroll
                    for (int i = 0; i < 4; ++i) { const float r = sigmoidf_(acc[ai][0][m][n][i] + ba[i]), ig = sigmoidf_(acc[ai][1][m][n][i] + bx[i]);
                        const float l = -8.f * fast_log(1.f + fast_exp(-lm[i])) * r; const float mult = __builtin_sqrtf(fmaxf(1.f - fast_exp(2.f * l), 0.f));
                        la[i] = l; bt[i] = mult * ig * xv[n * 4 + i]; }
                    o1[n * 2] = cvt_pk_bf16(la[0], la[1]); o1[n * 2 + 1] = cvt_pk_bf16(la[2], la[3]); o2[n * 2] = cvt_pk_bf16(bt[0], bt[1]); o2[n * 2 + 1] = cvt_pk_bf16(bt[2], bt[3]); }
                *(u32x4*)(lap + off) = (u32x4){o1[0], o1[1], o1[2], o1[3]}; *(u32x4*)(btp + off) = (u32x4){o2[0], o2[1], o2[2], o2[3]}; }
    }
};
struct EpiResid {
    static constexpr bool PERM = false, AFTER_DRAIN = false, SWAP = false;
    const float* xin; float* xout; const float* gate; bool dry;
    __device__ __forceinline__ void operator()(const f32x4 (&acc)[2][2][4][2], const Unit& u, int wr, int wc, int fr, int fq) const {
        const int row0 = u.pm * 256 + wr * 64 + fr, col0 = u.pn * 256 + wc * 32 + 4 * fq;
        const float* gp = gate + ((u.pm * 256) >> 13) * 6144 + col0;
        f32x4 gv[2][2];
#pragma unroll
        for (int bj = 0; bj < 2; ++bj)
#pragma unroll
            for (int n = 0; n < 2; ++n) gv[bj][n] = *(const f32x4*)(gp + bj * 128 + n * 16);
#pragma unroll
        for (int ai = 0; ai < 2; ++ai)
#pragma unroll
            for (int m = 0; m < 4; ++m) { const size_t off = (size_t)(row0 + ai * 128 + m * 16) * 1024 + col0;
#pragma unroll
                for (int bj = 0; bj < 2; ++bj)
#pragma unroll
                    for (int n = 0; n < 2; ++n) { const f32x4 xv = *(const f32x4*)(xin + off + bj * 128 + n * 16);
                        if (!dry) *(f32x4*)(xout + off + bj * 128 + n * 16) = xv + gv[bj][n] * acc[ai][bj][m][n]; } }
    }
};
struct EpiScoresT {
    static constexpr bool PERM = false, AFTER_DRAIN = false, SWAP = true;
    float* C;
    __device__ __forceinline__ void operator()(const f32x4 (&acc)[2][2][4][2], const Unit& u, int wr, int wc, int fr_, int fq) const {
        int fr = fr_; asm volatile("" : "+v"(fr));
        const unsigned off0 = (unsigned)(u.pn * 256 + wc * 32 + fr) * (unsigned)T + (unsigned)(u.pm * 256 + wr * 64 + 4 * fq);
#pragma unroll
        for (int ai = 0; ai < 2; ++ai)
#pragma unroll
            for (int m = 0; m < 4; ++m)
#pragma unroll
                for (int bj = 0; bj < 2; ++bj)
#pragma unroll
                    for (int n = 0; n < 2; ++n) *(f32x4*)(C + (off0 + (unsigned)(bj * 128 + n * 16) * (unsigned)T + (unsigned)(ai * 128 + m * 16))) = acc[ai][bj][m][n];
    }
};

struct Params {
    const float *x, *c, *w_ada, *b_ada, *norm_g, *hg_w_in, *hg_lb, *hg_norm_g, *hg_w_out, *lru_w_in, *lru_conv_w, *lru_conv_b,
        *lru_w_a, *lru_b_a, *lru_w_x, *lru_b_x, *lru_lam, *lru_w_out, *peer_w_q, *peer_keys, *peer_u, *peer_v, *final_g;
    float* out; unsigned char* ws; int ph_lo, ph_hi; unsigned rep_mask; int pad_;
};

typedef const __attribute__((address_space(4))) Params* KP;

template <class Epi>
__device__ __forceinline__ void run_gemm(LAS unsigned char* lds, const bf16_t* A, const bf16_t* Bt, int N, int K, int lda, int ldb, int a_pn_shift, int a_pn_stride, const Epi& E) {
    pg8::Gemm g; g.A = A; g.Bt = Bt; g.M = T; g.N = N; g.K = K; g.lda = lda; g.ldb = ldb; g.a_pn_shift = a_pn_shift; g.a_pn_stride = a_pn_stride;
    LAUNDER_IDS
    pg8::StaticOrder S; S.init(T, N, (int)gridDim.x, bidL); (void)tidL;
    pg8::gemm_phase<Epi, pg8::StaticOrder, false>(lds, g, S, E, nullptr);
    __syncthreads();
}

__device__ __forceinline__ void transpose_tile(const float* __restrict__ src, int ld_src, bf16_t* dst, int ld_dst, LAS float* tile, int tid) {
#pragma unroll
    for (int it = 0; it < 2; ++it) { const int r = (tid >> 4) + 32 * it, c4 = (tid & 15) * 4;
        const f32x4 v = *(const f32x4*)(src + (size_t)r * ld_src + c4);
        tile[r * 65 + c4 + 0] = v[0]; tile[r * 65 + c4 + 1] = v[1]; tile[r * 65 + c4 + 2] = v[2]; tile[r * 65 + c4 + 3] = v[3]; }
    __syncthreads();
    { const int n = tid >> 3, kc = tid & 7; const LAS float* s = tile + (kc * 8) * 65 + n;
        u32x4 o; o.x = cvt_pk_bf16(s[0], s[65]); o.y = cvt_pk_bf16(s[2 * 65], s[3 * 65]); o.z = cvt_pk_bf16(s[4 * 65], s[5 * 65]); o.w = cvt_pk_bf16(s[6 * 65], s[7 * 65]);
        *(u32x4*)(dst + (size_t)n * ld_dst + kc * 8) = o; }
    __syncthreads();
}

__device__ __forceinline__ void phase0(KP p, LAS unsigned char* lds) {
    LAUNDER_IDS
    const int tid = tidL, wave = tid >> 6, lane = tid & 63;
    unsigned char* ws = p->ws;
    LAS float* tile = (LAS float*)lds;
    constexpr int I_HGIN = 16 * 80, I_SQ = 16 * 16, I_LRIN = 16 * 32, I_G = 16;
    constexpr int N_A = 2 * I_HGIN + 2 * I_SQ + 2 * I_LRIN + 2 * I_SQ + 32 * I_G;
    for (int it = bidL; it < N_A; it += gridDim.x) {
        int r = it;
        if (r < 2 * I_HGIN) { const int j = r / I_HGIN, q = r % I_HGIN, kb = q / 80, nb = q % 80;
            transpose_tile(p->hg_w_in + (size_t)j * 1024 * 5120 + (size_t)kb * 64 * 5120 + nb * 64, 5120, (bf16_t*)(ws + WS_HGWIN) + (size_t)j * 5120 * 1024 + (size_t)nb * 64 * 1024 + kb * 64, 1024, tile, tid); continue; }
        r -= 2 * I_HGIN;
        if (r < 2 * I_SQ) { const int j = r / I_SQ, q = r % I_SQ, kb = q / 16, nb = q % 16;
            transpose_tile(p->hg_w_out + (size_t)j * 1024 * 1024 + (size_t)kb * 64 * 1024 + nb * 64, 1024, (bf16_t*)(ws + WS_HGWOUT) + (size_t)j * 1024 * 1024 + (size_t)nb * 64 * 1024 + kb * 64, 1024, tile, tid); continue; }
        r -= 2 * I_SQ;
        if (r < 2 * I_LRIN) { const int j = r / I_LRIN, q = r % I_LRIN, kb = q / 32, nb = q % 32;
            transpose_tile(p->lru_w_in + (size_t)j * 1024 * 2048 + (size_t)kb * 64 * 2048 + nb * 64, 2048, (bf16_t*)(ws + WS_LRWIN) + (size_t)j * 2048 * 1024 + (size_t)nb * 64 * 1024 + kb * 64, 1024, tile, tid); continue; }
        r -= 2 * I_LRIN;
        if (r < 2 * I_SQ) { const int j = r / I_SQ, q = r % I_SQ, kb = q / 16, nb = q % 16;
            transpose_tile(p->lru_w_out + (size_t)j * 1024 * 1024 + (size_t)kb * 64 * 1024 + nb * 64, 1024, (bf16_t*)(ws + WS_LRWOUT) + (size_t)j * 1024 * 1024 + (size_t)nb * 64 * 1024 + kb * 64, 1024, tile, tid); continue; }
        r -= 2 * I_SQ;
        { const int mat = r / I_G, q = r % I_G, kb = q / 4, nb = q % 4;
            const int nblk = mat & 3, gate = (mat >> 2) & 1, d = (mat >> 3) & 1, l = mat >> 4;
            const float* src = (gate ? p->lru_w_x : p->lru_w_a) + (size_t)((l * 2 + d) * 4 + nblk) * 65536 + (size_t)kb * 64 * 256 + nb * 64;
            const int n0 = nb * 64, jh = n0 >> 7;
            bf16_t* dst = (bf16_t*)(ws + WS_LRWG) + (size_t)l * 4 * 1024 * 256 + (size_t)nblk * 1024 * 256 + (size_t)((d * 2 + jh) * 256 + gate * 128 + (n0 & 127)) * 256 + kb * 64;
            transpose_tile(src, 256, dst, 256, tile, tid); }
    }
    {
        LAS float* keysL = (LAS float*)lds;
        LAS float* wqL = (LAS float*)(lds + 128 * 132 * 4);
        for (int it = bidL; it < 1024; it += gridDim.x) {
            const int l = it >> 8, hp = (it >> 4) & 15, dt = it & 15;
            const float* kp = p->peer_keys + ((size_t)l * 16 + hp) * 16384;
#pragma unroll
            for (int q = 0; q < 8; ++q) { const int e = (tid + 512 * q) * 4; const f32x4 v = *(const f32x4*)(kp + e); *(LAS f32x4*)(keysL + (e >> 7) * 132 + (e & 127)) = v; }
            const float* wp = p->peer_w_q + (size_t)l * 1024 * 2048 + (size_t)(dt * 64) * 2048 + hp * 128;
#pragma unroll
            for (int q = 0; q < 4; ++q) { const int e = (tid + 512 * q) * 4; const f32x4 v = *(const f32x4*)(wp + (size_t)(e >> 7) * 2048 + (e & 127)); *(LAS f32x4*)(wqL + e) = v; }
            __syncthreads();
            const int key = tid & 127, g = tid >> 7;
            float acc[16];
#pragma unroll
            for (int i = 0; i < 16; ++i) acc[i] = 0.f;
            for (int d4 = 0; d4 < 128; d4 += 4) {
                const f32x4 kv = *(const LAS f32x4*)(keysL + key * 132 + d4);
#pragma unroll
                for (int i = 0; i < 16; ++i) { const f32x4 wv = *(const LAS f32x4*)(wqL + (g * 16 + i) * 128 + d4);
                    acc[i] += kv[0] * wv[0] + kv[1] * wv[1] + kv[2] * wv[2] + kv[3] * wv[3]; }
            }
            bf16_t* op = (bf16_t*)(ws + WS_WQK) + (size_t)l * 2048 * 1024 + (size_t)(hp * 128 + key) * 1024 + dt * 64 + g * 16;
            u32x4 o1, o2; o1.x = cvt_pk_bf16(acc[0], acc[1]); o1.y = cvt_pk_bf16(acc[2], acc[3]); o1.z = cvt_pk_bf16(acc[4], acc[5]); o1.w = cvt_pk_bf16(acc[6], acc[7]);
            o2.x = cvt_pk_bf16(acc[8], acc[9]); o2.y = cvt_pk_bf16(acc[10], acc[11]); o2.z = cvt_pk_bf16(acc[12], acc[13]); o2.w = cvt_pk_bf16(acc[14], acc[15]);
            *(u32x4*)op = o1; *(u32x4*)(op + 8) = o2;
            __syncthreads();
        }
    }
    {
        LAS float* condL = (LAS float*)lds;
        LAS float* red = (LAS float*)(lds + 8192);
        for (int i = tid; i < 2048; i += NTHR) condL[i] = silu_(p->c[i]);
        __syncthreads();
        for (int it = bidL; it < 4 * 48; it += gridDim.x) {
            const int l = it / 48, col0 = (it % 48) * 128;
            const float* wp = p->w_ada + (size_t)l * 1024 * 6144 + col0 + 2 * lane;
            float a00 = 0.f, a01 = 0.f, a10 = 0.f, a11 = 0.f;
#pragma unroll 8
            for (int kk = 0; kk < 128; ++kk) { const int k = wave * 128 + kk; const f32x2 w = *(const f32x2*)(wp + (size_t)k * 6144);
                const float c0 = condL[k], c1 = condL[1024 + k];
                a00 += c0 * w[0]; a01 += c0 * w[1]; a10 += c1 * w[0]; a11 += c1 * w[1]; }
            red[(wave * 2 + 0) * 128 + 2 * lane] = a00; red[(wave * 2 + 0) * 128 + 2 * lane + 1] = a01;
            red[(wave * 2 + 1) * 128 + 2 * lane] = a10; red[(wave * 2 + 1) * 128 + 2 * lane + 1] = a11;
            __syncthreads();
            if (tid < 256) { const int b = tid >> 7, cc = tid & 127; float s = 0.f;
#pragma unroll
                for (int w = 0; w < 8; ++w) s += red[(w * 2 + b) * 128 + cc];
                ((float*)(ws + WS_MOD))[((size_t)l * 2 + b) * 6144 + col0 + cc] = s + p->b_ada[(size_t)l * 6144 + col0 + cc]; }
            __syncthreads();
        }
    }
    {
        const int nw = gridDim.x * NWAVE;
        for (int row0 = bidL * NWAVE + wave; row0 < 2 * 65536; row0 += 4 * nw) {
            f32x4 v[4][4];
#pragma unroll
            for (int rr = 0; rr < 4; ++rr) { const int row = row0 + rr * nw; const int tb = row >> 16, r = row & 65535;
                const float* src = (tb ? p->peer_v : p->peer_u) + (size_t)r * 1024 + 4 * lane;
#pragma unroll
                for (int jx = 0; jx < 4; ++jx) v[rr][jx] = __builtin_nontemporal_load((const f32x4*)(src + 256 * jx)); }
#pragma unroll
            for (int rr = 0; rr < 4; ++rr) { const int row = row0 + rr * nw; const int tb = row >> 16, r = row & 65535;
                float am = 0.f;
#pragma unroll
                for (int jx = 0; jx < 4; ++jx) am = fmaxf(am, fmaxf(fmaxf(fabsf(v[rr][jx][0]), fabsf(v[rr][jx][1])), fmaxf(fabsf(v[rr][jx][2]), fabsf(v[rr][jx][3]))));
                am = wave_max(am);
                const float sc = am > 0.f ? am * (1.f / 448.f) : 1.f, inv = am > 0.f ? 448.f / am : 1.f;
                unsigned char* dst = ws + (tb ? WS_VTAB : WS_UTAB) + (size_t)r * 1024 + 4 * lane;
#pragma unroll
                for (int jx = 0; jx < 4; ++jx) { int w = __builtin_amdgcn_cvt_pk_fp8_f32(v[rr][jx][0] * inv, v[rr][jx][1] * inv, 0, false);
                    w = __builtin_amdgcn_cvt_pk_fp8_f32(v[rr][jx][2] * inv, v[rr][jx][3] * inv, w, true);
                    *(int*)(dst + 256 * jx) = w; }
                if (lane == 0) ((float*)(ws + (tb ? WS_VSC : WS_USC)))[r] = sc; }
        }
    }
}

__device__ __forceinline__ void phase_rms(const float* xin, const float* gain, const float* shift, const float* scale, bf16_t* hout) {
    LAUNDER_IDS
    const int tid = tidL, wave = tid >> 6, lane = tid & 63;
    for (int row = bidL * NWAVE + wave; row < T; row += gridDim.x * NWAVE) {
        const int b = row >> 13;
        const float* xr = xin + (size_t)row * 1024 + lane * 4;
        f32x4 v[4]; float ss = 0.f;
#pragma unroll
        for (int j = 0; j < 4; ++j) { v[j] = *(const f32x4*)(xr + j * 256); ss += v[j][0] * v[j][0] + v[j][1] * v[j][1] + v[j][2] * v[j][2] + v[j][3] * v[j][3]; }
        const float inv = __builtin_amdgcn_rsqf(wave_sum(ss) * (1.f / 1024.f) + EPS);
#pragma unroll
        for (int j = 0; j < 4; ++j) { const int col = j * 256 + lane * 4;
            const f32x4 g = *(const f32x4*)(gain + col), sh = *(const f32x4*)(shift + b * 6144 + col), sc = *(const f32x4*)(scale + b * 6144 + col);
            const f32x4 y = (v[j] * inv) * g * (1.f + sc) + sh;
            u32x2 o; o.x = cvt_pk_bf16(y[0], y[1]); o.y = cvt_pk_bf16(y[2], y[3]);
            *(u32x2*)(hout + (size_t)row * 1024 + col) = o; }
    }
}

constexpr int LROW = 136;
__device__ __forceinline__ float hg_lower_bound(const float* hg_lb, int j, int col) {
    if (j == 0) return 0.f;
    const float l0 = hg_lb[col], l1 = hg_lb[1024 + col];
    return fast_rcp(1.f + fast_exp(l0 - l1));
}
__device__ __forceinline__ f32x4 mfma16(bf16x8 a, bf16x8 b, f32x4 c) { return __builtin_amdgcn_mfma_f32_16x16x32_bf16(a, b, c, 0, 0, 0); }

__device__ __forceinline__ void load_v_regs(const bf16_t* proj, u32x4 (&vr)[4], int t0, int dir, int h, int tid) {
#pragma unroll
    for (int it = 0; it < 4; ++it) { const int idx = tid + 512 * it, tau = idx & 127, cv = idx >> 7;
        const int tok = dir ? t0 + 127 - tau : t0 + tau;
        vr[it] = *(const u32x4*)(proj + (size_t)tok * 5120 + 3072 + h * 128 + cv * 8); }
}
__device__ __forceinline__ void store_vt(LAS bf16_t* VT, const u32x4 (&vr)[4], int tid) {
#pragma unroll
    for (int it = 0; it < 4; ++it) { const int idx = tid + 512 * it, tau = idx & 127, cv = idx >> 7; const u32x4 v = vr[it];
        LAS bf16_t* d = VT + (cv * 8) * LROW + tau;
        d[0 * LROW] = (bf16_t)(v.x & 0xffff); d[1 * LROW] = (bf16_t)(v.x >> 16); d[2 * LROW] = (bf16_t)(v.y & 0xffff); d[3 * LROW] = (bf16_t)(v.y >> 16);
        d[4 * LROW] = (bf16_t)(v.z & 0xffff); d[5 * LROW] = (bf16_t)(v.z >> 16); d[6 * LROW] = (bf16_t)(v.w & 0xffff); d[7 * LROW] = (bf16_t)(v.w >> 16); }
}
__device__ __forceinline__ void load_tile_regs(const bf16_t* proj, u32x4 (&r)[4], int t0, int dir, int col0, int tid) {
#pragma unroll
    for (int it = 0; it < 4; ++it) { const int idx = tid + 512 * it, tau = idx >> 4, c16 = idx & 15;
        const int tok = dir ? t0 + 127 - tau : t0 + tau;
        r[it] = *(const u32x4*)(proj + (size_t)tok * 5120 + col0 + c16 * 8); }
}
__device__ __forceinline__ void store_tile(LAS bf16_t* TL, const u32x4 (&r)[4], int tid) {
#pragma unroll
    for (int it = 0; it < 4; ++it) { const int idx = tid + 512 * it, tau = idx >> 4, c16 = idx & 15; *(LAS u32x4*)(TL + tau * LROW + c16 * 8) = r[it]; }
}

__device__ __forceinline__ void hg_pass_a(KP p, LAS unsigned char* lds, int j) {
    LAUNDER_IDS
    const bf16_t* proj = (const bf16_t*)(p->ws + WS_PROJ);
    float* KV = (float*)(p->ws + WS_KV); float* DEC = (float*)(p->ws + WS_DEC);
    LAS bf16_t* VT = (LAS bf16_t*)lds; LAS bf16_t* KT = (LAS bf16_t*)(lds + 34816); LAS float* TOT = (LAS float*)(lds + 69632); LAS bf16_t* ZT = (LAS bf16_t*)(lds + 71680);
    for (int u = bidL; u < 2048; u += gridDim.x) {
        int tid = tidL; asm volatile("" : "+v"(tid));
        const int wave = tid >> 6, lane = tid & 63;
        const int seq = u >> 6, c = u & 63, dir = seq & 1, h = (seq >> 1) & 7, b = seq >> 4;
        const int t0 = b * SEQ + c * 128;
        const int dk = tid & 127, g = tid >> 7;
        const float lb = hg_lower_bound(p->hg_lb, j, h * 128 + dk);
        float lcs[32], kks[32]; float lc = 0.f;
        { u32x4 zr[4], vr[4];
            load_tile_regs(proj, zr, t0, dir, 1024 * (1 + dir) + h * 128, tid); load_v_regs(proj, vr, t0, dir, h, tid);
            store_tile(ZT, zr, tid); store_vt(VT, vr, tid); }
        __syncthreads();
#pragma unroll
        for (int q = 0; q < 32; ++q) { const int tau = 32 * g + q;
            const float z = bf2f(ZT[tau * LROW + dk]);
            const float f = lb + (1.f - lb) * sigmoidf_(z);
            lc += fast_log(f); lcs[q] = lc; kks[q] = 1.f - f; }
        TOT[g * 128 + dk] = lc;
        __syncthreads();
        float rg = 0.f, total = 0.f;
#pragma unroll
        for (int gg = 0; gg < 4; ++gg) { const float tv = TOT[gg * 128 + dk]; total += tv; if (gg < g) rg += tv; }
        const float base = total - rg;
#pragma unroll
        for (int q8 = 0; q8 < 4; ++q8) { unsigned w[4];
#pragma unroll
            for (int e = 0; e < 4; ++e) { const int q = q8 * 8 + e * 2;
                w[e] = cvt_pk_bf16(kks[q] * fast_exp(base - lcs[q]), kks[q + 1] * fast_exp(base - lcs[q + 1])); }
            u32x4 o; o.x = w[0]; o.y = w[1]; o.z = w[2]; o.w = w[3];
            *(LAS u32x4*)(KT + dk * LROW + 32 * g + q8 * 8) = o; }
        if (g == 0) DEC[(size_t)u * 128 + dk] = fast_exp(total);
        __syncthreads();
        f32x4 acc[2][4];
#pragma unroll
        for (int a = 0; a < 2; ++a)
#pragma unroll
            for (int bb = 0; bb < 4; ++bb) acc[a][bb] = (f32x4){0.f, 0.f, 0.f, 0.f};
        const int l15 = lane & 15, lq = lane >> 4;
#pragma unroll
        for (int ks = 0; ks < 4; ++ks) {
            bf16x8 af[2], bfr[4];
#pragma unroll
            for (int a = 0; a < 2; ++a) af[a] = *(const LAS bf16x8*)(VT + (((wave & 3) * 2 + a) * 16 + l15) * LROW + ks * 32 + lq * 8);
#pragma unroll
            for (int bb = 0; bb < 4; ++bb) bfr[bb] = *(const LAS bf16x8*)(KT + (((wave >> 2) * 4 + bb) * 16 + l15) * LROW + ks * 32 + lq * 8);
#pragma unroll
            for (int a = 0; a < 2; ++a)
#pragma unroll
                for (int bb = 0; bb < 4; ++bb) acc[a][bb] = mfma16(af[a], bfr[bb], acc[a][bb]);
        }
        float* kvp = KV + (size_t)u * 16384;
#pragma unroll
        for (int a = 0; a < 2; ++a)
#pragma unroll
            for (int bb = 0; bb < 4; ++bb)
#pragma unroll
                for (int r = 0; r < 4; ++r) kvp[(((wave & 3) * 2 + a) * 16 + lq * 4 + r) * 128 + ((wave >> 2) * 4 + bb) * 16 + l15] = acc[a][bb][r];
        __syncthreads();
    }
}

__device__ __forceinline__ void hg_pass_b(KP p) {
    LAUNDER_IDS
    const float* KV = (const float*)(p->ws + WS_KV); const float* DEC = (const float*)(p->ws + WS_DEC);
    bf16_t* SIN = (bf16_t*)(p->ws + WS_SIN);
    for (int e = bidL * NTHR + tidL; e < 131072; e += gridDim.x * NTHR) {
    const int seq = e >> 12, i4 = e & 4095, dir = seq & 1, dk = (i4 * 4) & 127;
    f32x4 S = {0.f, 0.f, 0.f, 0.f};
#pragma unroll 8
    for (int step = 0; step < 64; ++step) {
        const int c = dir ? 63 - step : step; const size_t u = (size_t)seq * 64 + c;
        const f32x4 kv = *(const f32x4*)(KV + u * 16384 + i4 * 4); const f32x4 dc = *(const f32x4*)(DEC + u * 128 + dk);
        u32x2 o; o.x = cvt_pk_bf16(S[0], S[1]); o.y = cvt_pk_bf16(S[2], S[3]);
        *(u32x2*)(SIN + u * 16384 + i4 * 4) = o;
        S = dc * S + kv;
    }
    }
}

__device__ __forceinline__ void hg_pass_c(KP p, LAS unsigned char* lds, int j) {
    LAUNDER_IDS
    const bf16_t* proj = (const bf16_t*)(p->ws + WS_PROJ);
    const bf16_t* SIN = (const bf16_t*)(p->ws + WS_SIN);
    bf16_t* OB = (bf16_t*)(p->ws + WS_OB);
    LAS bf16_t* QT = (LAS bf16_t*)lds; LAS bf16_t* QI = (LAS bf16_t*)(lds + 34816); LAS bf16_t* KT = (LAS bf16_t*)(lds + 69632);
    LAS bf16_t* VT = (LAS bf16_t*)(lds + 104448); LAS bf16_t* PI = (LAS bf16_t*)(lds + 139264); LAS float* TOT = (LAS float*)(lds + 147968);
    LAS float* OSUM = (LAS float*)(lds + 69632);
    for (int u = bidL; u < 1024; u += gridDim.x) {
        int tid = tidL; asm volatile("" : "+v"(tid));
        const int wave = tid >> 6, lane = tid & 63, l15 = lane & 15, lq = lane >> 4;
        const int c = u & 63, h = (u >> 6) & 7, b = u >> 9;
        const int t0 = b * SEQ + c * 128;
        const int dk = tid & 127, g = tid >> 7;
        const float lb = hg_lower_bound(p->hg_lb, j, h * 128 + dk);
        const int tt = wave & 1, dvt0 = (wave >> 1) * 2;
        f32x4 oacc[2][4][2];
#pragma unroll
        for (int dir = 0; dir < 2; ++dir) {
            const size_t su = ((size_t)((b * 8 + h) * 2 + dir) * 64 + c);
            unsigned k0p[16]; float lc = 0.f; float kprev = 0.f;
            u32x4 vr[4];
            { u32x4 zr[4], qr[4];
                load_tile_regs(proj, zr, t0, dir, 1024 * (1 + dir) + h * 128, tid); load_tile_regs(proj, qr, t0, dir, h * 128, tid); load_v_regs(proj, vr, t0, dir, h, tid);
                __syncthreads();
                store_tile(KT, zr, tid); store_tile(VT, qr, tid); }
            __syncthreads();
#pragma unroll
            for (int q = 0; q < 32; ++q) { const int tau = 32 * g + q;
                const float z = bf2f(KT[tau * LROW + dk]), qv = bf2f(VT[tau * LROW + dk]);
                const float f = lb + (1.f - lb) * sigmoidf_(z);
                lc += fast_log(f);
                const float el = fast_exp(fmaxf(lc, -80.f));
                QT[tau * LROW + dk] = f2bf(qv * el);
                const float kcur = (1.f - f) * fast_rcp(el);
                if (q & 1) k0p[q >> 1] = cvt_pk_bf16(kprev, kcur); else kprev = kcur; }
            TOT[g * 128 + dk] = lc;
            __syncthreads();
            float r[4]; { float run = 0.f;
#pragma unroll
                for (int gg = 0; gg < 4; ++gg) { r[gg] = run; run += TOT[gg * 128 + dk]; } }
            float rg = 0.f;
#pragma unroll
            for (int gg = 0; gg < 4; ++gg) if (gg == g) rg = r[gg];
            { const float eg = fast_exp(rg);
#pragma unroll
                for (int q = 0; q < 32; ++q) QI[(32 * g + q) * LROW + dk] = f2bf(bf2f(QT[(32 * g + q) * LROW + dk]) * eg); }
            store_vt(VT, vr, tid);
            bf16x8 sfr[2][4];
#pragma unroll
            for (int n = 0; n < 2; ++n)
#pragma unroll
                for (int ks = 0; ks < 4; ++ks) sfr[n][ks] = *(const bf16x8*)(SIN + su * 16384 + (size_t)((dvt0 + n) * 16 + l15) * 128 + ks * 32 + lq * 8);
#pragma unroll
            for (int i = 0; i < 4; ++i) {
                if (g <= i) { const float e = fast_exp(r[i] - rg);
#pragma unroll
                    for (int q = 0; q < 32; ++q) KT[(32 * g + q) * LROW + dk] = f2bf(((q & 1) ? bfhi(k0p[q >> 1]) : bflo(k0p[q >> 1])) * e); }
                __syncthreads();
                for (int tl = wave; tl < 4 * (i + 1); tl += 8) { const int sm = tl >> 1, tn = tl & 1;
                    f32x4 a4 = {0.f, 0.f, 0.f, 0.f};
#pragma unroll
                    for (int ks = 0; ks < 4; ++ks) { const bf16x8 af = *(const LAS bf16x8*)(KT + (sm * 16 + l15) * LROW + ks * 32 + lq * 8);
                        const bf16x8 bq = *(const LAS bf16x8*)(QT + (32 * i + tn * 16 + l15) * LROW + ks * 32 + lq * 8);
                        a4 = mfma16(af, bq, a4); }
                    const int tloc = tn * 16 + l15, s0 = sm * 16 + lq * 4, tg = 32 * i + tloc;
                    u32x2 o; o.x = cvt_pk_bf16(s0 + 0 <= tg ? a4[0] : 0.f, s0 + 1 <= tg ? a4[1] : 0.f); o.y = cvt_pk_bf16(s0 + 2 <= tg ? a4[2] : 0.f, s0 + 3 <= tg ? a4[3] : 0.f);
                    *(LAS u32x2*)(PI + tloc * LROW + s0) = o; }
                __syncthreads();
                f32x4 a0 = {0.f, 0.f, 0.f, 0.f}, a1 = {0.f, 0.f, 0.f, 0.f};
                for (int ks = 0; ks <= i; ++ks) { const bf16x8 af = *(const LAS bf16x8*)(PI + (tt * 16 + l15) * LROW + ks * 32 + lq * 8);
                    const bf16x8 b0 = *(const LAS bf16x8*)(VT + ((dvt0 + 0) * 16 + l15) * LROW + ks * 32 + lq * 8);
                    const bf16x8 b1 = *(const LAS bf16x8*)(VT + ((dvt0 + 1) * 16 + l15) * LROW + ks * 32 + lq * 8);
                    a0 = mfma16(af, b0, a0); a1 = mfma16(af, b1, a1); }
#pragma unroll
                for (int ks = 0; ks < 4; ++ks) { const bf16x8 af = *(const LAS bf16x8*)(QI + (32 * i + tt * 16 + l15) * LROW + ks * 32 + lq * 8);
                    a0 = mfma16(af, sfr[0][ks], a0); a1 = mfma16(af, sfr[1][ks], a1); }
                oacc[dir][i][0] = a0; oacc[dir][i][1] = a1;
            }
        }
        __syncthreads();
#pragma unroll
        for (int i = 0; i < 4; ++i)
#pragma unroll
            for (int n = 0; n < 2; ++n)
#pragma unroll
                for (int rr = 0; rr < 4; ++rr) OSUM[(32 * i + tt * 16 + lq * 4 + rr) * 132 + (dvt0 + n) * 16 + l15] = oacc[0][i][n][rr];
        __syncthreads();
#pragma unroll
        for (int i = 0; i < 4; ++i)
#pragma unroll
            for (int n = 0; n < 2; ++n)
#pragma unroll
                for (int rr = 0; rr < 4; ++rr) OSUM[(127 - (32 * i + tt * 16 + lq * 4 + rr)) * 132 + (dvt0 + n) * 16 + l15] += oacc[1][i][n][rr];
        __syncthreads();
        { const int row = tid >> 2, part = tid & 3; const int tok = t0 + row;
            float ov[32]; float ss = 0.f;
#pragma unroll
            for (int q = 0; q < 8; ++q) { const f32x4 v = *(const LAS f32x4*)(OSUM + row * 132 + part * 32 + q * 4);
                ov[q * 4 + 0] = v[0]; ov[q * 4 + 1] = v[1]; ov[q * 4 + 2] = v[2]; ov[q * 4 + 3] = v[3]; ss += v[0] * v[0] + v[1] * v[1] + v[2] * v[2] + v[3] * v[3]; }
            ss += __shfl_xor(ss, 1); ss += __shfl_xor(ss, 2);
            const float inv = __builtin_amdgcn_rsqf(ss * (1.f / 128.f) + EPS);
            const int col = h * 128 + part * 32;
            const bf16_t* gp = proj + (size_t)tok * 5120 + 4096 + col; const float* ng = p->hg_norm_g + j * 1024 + col;
#pragma unroll
            for (int q = 0; q < 4; ++q) { const u32x4 gr = *(const u32x4*)(gp + q * 8);
                const float gv[8] = {bflo(gr.x), bfhi(gr.x), bflo(gr.y), bfhi(gr.y), bflo(gr.z), bfhi(gr.z), bflo(gr.w), bfhi(gr.w)};
                float y[8];
#pragma unroll
                for (int e = 0; e < 8; ++e) y[e] = ov[q * 8 + e] * inv * ng[q * 8 + e] * silu_(gv[e]);
                u32x4 o; o.x = cvt_pk_bf16(y[0], y[1]); o.y = cvt_pk_bf16(y[2], y[3]); o.z = cvt_pk_bf16(y[4], y[5]); o.w = cvt_pk_bf16(y[6], y[7]);
                *(u32x4*)(OB + (size_t)tok * 1024 + col + q * 8) = o; }
        }
        __syncthreads();
    }
}

__device__ __forceinline__ void lru_conv(KP p, int l) {
    LAUNDER_IDS
    const bf16_t* XB = (const bf16_t*)(p->ws + WS_XB); bf16_t* XC = (bf16_t*)(p->ws + WS_XC);
    const float* cw = p->lru_conv_w + (size_t)l * 4 * 1024; const float* cb = p->lru_conv_b + (size_t)l * 1024;
    const int gs = gridDim.x * NTHR;
    for (int it = bidL * NTHR + tidL; it < T * 128; it += gs) {
        const int tok = it >> 7, c8 = (it & 127) * 8, s = tok & (SEQ - 1);
        float acc[8];
        { const f32x4 b0 = *(const f32x4*)(cb + c8), b1 = *(const f32x4*)(cb + c8 + 4);
            acc[0] = b0[0]; acc[1] = b0[1]; acc[2] = b0[2]; acc[3] = b0[3]; acc[4] = b1[0]; acc[5] = b1[1]; acc[6] = b1[2]; acc[7] = b1[3]; }
#pragma unroll
        for (int jj = 0; jj < 4; ++jj) { const int ts = s + jj - 2;
            if (ts >= 0 && ts < SEQ) { const u32x4 xr = *(const u32x4*)(XB + (size_t)(tok + jj - 2) * 1024 + c8);
                const f32x4 w0 = *(const f32x4*)(cw + jj * 1024 + c8), w1 = *(const f32x4*)(cw + jj * 1024 + c8 + 4);
                acc[0] += bflo(xr.x) * w0[0]; acc[1] += bfhi(xr.x) * w0[1]; acc[2] += bflo(xr.y) * w0[2]; acc[3] += bfhi(xr.y) * w0[3];
                acc[4] += bflo(xr.z) * w1[0]; acc[5] += bfhi(xr.z) * w1[1]; acc[6] += bflo(xr.w) * w1[2]; acc[7] += bfhi(xr.w) * w1[3]; } }
        u32x4 o; o.x = cvt_pk_bf16(acc[0], acc[1]); o.y = cvt_pk_bf16(acc[2], acc[3]); o.z = cvt_pk_bf16(acc[4], acc[5]); o.w = cvt_pk_bf16(acc[6], acc[7]);
        *(u32x4*)(XC + (size_t)tok * 1024 + c8) = o;
    }
}
__device__ __forceinline__ void lru_scan1(KP p) {
    LAUNDER_IDS
    const bf16_t* LOGA = (const bf16_t*)(p->ws + WS_LOGA); const bf16_t* BT = (const bf16_t*)(p->ws + WS_BTERM);
    float* CP = (float*)(p->ws + WS_CP); float* CH = (float*)(p->ws + WS_CH);
    const int ch = 2 * tidL;
    for (int u = bidL; u < 1024; u += gridDim.x) {
        const int chunk = u & 255, dir = (u >> 8) & 1, b = u >> 9;
        const size_t base = ((size_t)dir * T + b * SEQ + chunk * 32) * 1024 + ch;
        float h0 = 0.f, h1 = 0.f, s0 = 0.f, s1 = 0.f;
#pragma unroll 8
        for (int q = 0; q < 32; ++q) { const int t = dir ? 31 - q : q;
            const unsigned lw = *(const unsigned*)(LOGA + base + (size_t)t * 1024), bw = *(const unsigned*)(BT + base + (size_t)t * 1024);
            const float l0 = bflo(lw), l1 = bfhi(lw);
            h0 = fast_exp(l0) * h0 + bflo(bw); h1 = fast_exp(l1) * h1 + bfhi(bw); s0 += l0; s1 += l1; }
        const size_t o = ((size_t)(b * 2 + dir) * 256 + chunk) * 1024 + ch;
        *(f32x2*)(CP + o) = (f32x2){fast_exp(s0), fast_exp(s1)}; *(f32x2*)(CH + o) = (f32x2){h0, h1};
    }
}
__device__ __forceinline__ void lru_scan2(KP p) {
    LAUNDER_IDS
    const float* CP = (const float*)(p->ws + WS_CP); const float* CH = (const float*)(p->ws + WS_CH); float* HIN = (float*)(p->ws + WS_HIN);
    const int wave = tidL >> 6, lane = tidL & 63;
    for (int item = bidL * NWAVE + wave; item < 4096; item += gridDim.x * NWAVE) {
        const int ch = item & 1023, bd = item >> 10, dir = bd & 1;
        float pp[4], hh[4]; float Pl = 1.f, Hl = 0.f;
#pragma unroll
        for (int q = 0; q < 4; ++q) { const int ci = 4 * lane + q, chunk = dir ? 255 - ci : ci; const size_t o = ((size_t)bd * 256 + chunk) * 1024 + ch;
            pp[q] = CP[o]; hh[q] = CH[o]; Hl = pp[q] * Hl + hh[q]; Pl *= pp[q]; }
#pragma unroll
        for (int off = 1; off < 64; off <<= 1) { const float Pp = __shfl_up(Pl, off), Hp = __shfl_up(Hl, off);
            if (lane >= off) { Hl = Pl * Hp + Hl; Pl = Pl * Pp; } }
        float carry = __shfl_up(Hl, 1); if (lane == 0) carry = 0.f;
#pragma unroll
        for (int q = 0; q < 4; ++q) { const int ci = 4 * lane + q, chunk = dir ? 255 - ci : ci; const size_t o = ((size_t)bd * 256 + chunk) * 1024 + ch;
            HIN[o] = carry; carry = pp[q] * carry + hh[q]; }
    }
}
__device__ __forceinline__ void lru_scan3(KP p) {
    LAUNDER_IDS
    const bf16_t* LOGA = (const bf16_t*)(p->ws + WS_LOGA); const bf16_t* BT = (const bf16_t*)(p->ws + WS_BTERM); const bf16_t* YG = (const bf16_t*)(p->ws + WS_YG);
    const float* HIN = (const float*)(p->ws + WS_HIN); bf16_t* OB = (bf16_t*)(p->ws + WS_OB);
    const int ch = 2 * tidL;
    for (int u = bidL; u < 512; u += gridDim.x) {
        const int chunk = u & 255, b = u >> 8;
        const size_t tok0 = (size_t)b * SEQ + chunk * 32;
        const f32x2 hf = *(const f32x2*)(HIN + ((size_t)(b * 2 + 0) * 256 + chunk) * 1024 + ch), hb = *(const f32x2*)(HIN + ((size_t)(b * 2 + 1) * 256 + chunk) * 1024 + ch);
        float hs0[32], hs1[32]; float h0 = hf[0], h1 = hf[1];
#pragma unroll
        for (int q = 0; q < 32; ++q) { const size_t o = (tok0 + q) * 1024 + ch;
            const unsigned lw = *(const unsigned*)(LOGA + o), bw = *(const unsigned*)(BT + o);
            h0 = fast_exp(bflo(lw)) * h0 + bflo(bw); h1 = fast_exp(bfhi(lw)) * h1 + bfhi(bw); hs0[q] = h0; hs1[q] = h1; }
        h0 = hb[0]; h1 = hb[1];
#pragma unroll
        for (int q = 31; q >= 0; --q) { const size_t o = (tok0 + q) * 1024 + ch;
            const unsigned lw = *(const unsigned*)(LOGA + (size_t)T * 1024 + o), bw = *(const unsigned*)(BT + (size_t)T * 1024 + o), yw = *(const unsigned*)(YG + o);
            h0 = fast_exp(bflo(lw)) * h0 + bflo(bw); h1 = fast_exp(bfhi(lw)) * h1 + bfhi(bw);
            *(unsigned*)(OB + o) = cvt_pk_bf16((hs0[q] + h0) * bflo(yw), (hs1[q] + h1) * bfhi(yw)); }
    }
}

__device__ const unsigned char STAIR[64] = {
    0x00, 0x01, 0x02, 0x03, 0x04, 0x05, 0x06, 0x07, 0x08, 0x09, 0x0a, 0x0b, 0x0c, 0x0d, 0x0e, 0x0f,
    0x10, 0x11, 0x12, 0x13, 0x14, 0x15, 0x16, 0x17, 0x20, 0x21, 0x22, 0x23, 0x24, 0x30, 0x31, 0x32,
    0x33, 0x40, 0x41, 0x42, 0x50, 0x51, 0x60, 0x61, 0x70, 0x71, 0x80, 0x90, 0xa0, 0xb0, 0xc0, 0xd0,
    0xe0, 0xf0, 0, 0, 0, 0, 0, 0, 0, 0, 0, 0, 0, 0, 0, 0};
__device__ __forceinline__ unsigned mono_key(float f) { const unsigned b = __float_as_uint(f); return b ^ ((b >> 31) ? 0xffffffffu : 0x80000000u); }

__device__ __forceinline__ float inv_mono(unsigned k) { return __uint_as_float(k ^ ((k >> 31) ? 0x80000000u : 0xffffffffu)); }
#define TK_INSERT(L, x) do { _Pragma("unroll") for (int q_ = 0; q_ < 16; ++q_) { const unsigned hi_ = max(L[q_], x); x = min(L[q_], x); L[q_] = hi_; } } while (0)
__device__ __forceinline__ void peer_topk(KP p, LAS unsigned char* lds) {
    LAUNDER_IDS
    (void)bidL;
    const int tid = tidL, wave = tid >> 6, lane = tid & 63;
    const float* SCT = (const float*)(p->ws + WS_SCORES);
    int* TOPI = (int*)(p->ws + WS_TOPI); float* TOPG = (float*)(p->ws + WS_TOPG);
    LAS unsigned char* IX = lds + wave * 2048 + lane * 32;
    for (int item = bidL * NWAVE + wave; item < 2048; item += gridDim.x * NWAVE) {
        const int tg = item >> 3, hd = item & 7, tok = tg * 64 + lane;
        float V[2][16];
#pragma unroll
        for (int half = 0; half < 2; ++half) {
            unsigned L[16];
#pragma unroll
            for (int q = 0; q < 16; ++q) L[q] = 0u;
            const float* sc = SCT + (size_t)(hd * 256 + half * 128) * T + tok;
            float cur[16], nxt[16];
#pragma unroll
            for (int i = 0; i < 16; ++i) cur[i] = sc[(size_t)i * T];
#pragma unroll 1
            for (int kb = 0; kb < 8; ++kb) {
                const int kn = kb < 7 ? kb + 1 : kb;
#pragma unroll
                for (int i = 0; i < 16; ++i) nxt[i] = sc[(size_t)(kn * 16 + i) * T];
#pragma unroll
                for (int i = 0; i < 16; ++i) { unsigned x = (mono_key(cur[i]) & ~0x7fu) | (unsigned)(kb * 16 + i); TK_INSERT(L, x); }
#pragma unroll
                for (int i = 0; i < 16; ++i) cur[i] = nxt[i];
            }
            u32x4 w0, w1;
            w0.x = (L[0] & 0x7f) | ((L[1] & 0x7f) << 8) | ((L[2] & 0x7f) << 16) | ((L[3] & 0x7f) << 24); w0.y = (L[4] & 0x7f) | ((L[5] & 0x7f) << 8) | ((L[6] & 0x7f) << 16) | ((L[7] & 0x7f) << 24);
            w0.z = (L[8] & 0x7f) | ((L[9] & 0x7f) << 8) | ((L[10] & 0x7f) << 16) | ((L[11] & 0x7f) << 24); w0.w = (L[12] & 0x7f) | ((L[13] & 0x7f) << 8) | ((L[14] & 0x7f) << 16) | ((L[15] & 0x7f) << 24);
            *(LAS u32x4*)(IX + half * 16) = w0;
#pragma unroll
            for (int q = 0; q < 16; ++q) V[half][q] = inv_mono(L[q]);
        }
        unsigned C[16];
#pragma unroll
        for (int q = 0; q < 16; ++q) C[q] = 0u;
#pragma unroll
        for (int i = 0; i < 16; ++i)
#pragma unroll
            for (int jj = 0; jj < 16; ++jj) if ((i + 1) * (jj + 1) <= 16) { unsigned x = (mono_key(V[0][i] + V[1][jj]) & ~0xffu) | (unsigned)(i * 16 + jj); TK_INSERT(C, x); }
        asm volatile("s_waitcnt lgkmcnt(0)" ::: "memory");
        const float s0 = inv_mono(C[0] & ~0xffu);
        float e[16]; float sum = 0.f; int ids[16];
#pragma unroll
        for (int q = 0; q < 16; ++q) { e[q] = fast_exp(inv_mono(C[q] & ~0xffu) - s0); sum += e[q];
            const unsigned code = C[q] & 0xffu; ids[q] = (int)IX[code >> 4] * 128 + (int)IX[16 + (code & 15u)]; }
        const float rs = fast_rcp(sum);
        int* ip = TOPI + (size_t)tok * 128 + hd * 16; float* gp = TOPG + (size_t)tok * 128 + hd * 16;
#pragma unroll
        for (int q = 0; q < 4; ++q) { *(u32x4*)(ip + 4 * q) = (u32x4){(unsigned)ids[4 * q], (unsigned)ids[4 * q + 1], (unsigned)ids[4 * q + 2], (unsigned)ids[4 * q + 3]};
            *(f32x4*)(gp + 4 * q) = (f32x4){e[4 * q] * rs, e[4 * q + 1] * rs, e[4 * q + 2] * rs, e[4 * q + 3] * rs}; }
        asm volatile("s_waitcnt lgkmcnt(0)" ::: "memory");
    }
}

__device__ __forceinline__ void peer_gather(KP p, int l, bool dry) {
    LAUNDER_IDS
    const int wave = tidL >> 6, lane = tidL & 63;
    const bf16_t* HB = (const bf16_t*)(p->ws + WS_HBUF); bf16_t* HBW = (bf16_t*)(p->ws + WS_HBUF);
    const int* TOPI = (const int*)(p->ws + WS_TOPI); const float* TOPG = (const float*)(p->ws + WS_TOPG);
    const unsigned char* U8 = p->ws + WS_UTAB + (size_t)l * 16384 * 1024 + 16 * lane; const unsigned char* V8 = p->ws + WS_VTAB + (size_t)l * 16384 * 1024 + 16 * lane;
    const float* USC = (const float*)(p->ws + WS_USC) + l * 16384; const float* VSC = (const float*)(p->ws + WS_VSC) + l * 16384;
    float* XRES = (float*)(p->ws + WS_XRES); const float* MOD = (const float*)(p->ws + WS_MOD);
    for (int tok = bidL * NWAVE + wave; tok < T; tok += gridDim.x * NWAVE) {
        const int b = tok >> 13;
        f32x2 hv2[8];
        { const u32x4 h0 = *(const u32x4*)(HB + (size_t)tok * 1024 + 16 * lane), h1 = *(const u32x4*)(HB + (size_t)tok * 1024 + 16 * lane + 8);
            hv2[0] = (f32x2){bflo(h0.x), bfhi(h0.x)}; hv2[1] = (f32x2){bflo(h0.y), bfhi(h0.y)}; hv2[2] = (f32x2){bflo(h0.z), bfhi(h0.z)}; hv2[3] = (f32x2){bflo(h0.w), bfhi(h0.w)};
            hv2[4] = (f32x2){bflo(h1.x), bfhi(h1.x)}; hv2[5] = (f32x2){bflo(h1.y), bfhi(h1.y)}; hv2[6] = (f32x2){bflo(h1.z), bfhi(h1.z)}; hv2[7] = (f32x2){bflo(h1.w), bfhi(h1.w)}; }
        const int id0 = TOPI[(size_t)tok * 128 + lane], id1 = TOPI[(size_t)tok * 128 + 64 + lane];
        const float g0 = TOPG[(size_t)tok * 128 + lane], g1 = TOPG[(size_t)tok * 128 + 64 + lane];
        f32x2 acc2[8];
#pragma unroll
        for (int i = 0; i < 8; ++i) acc2[i] = (f32x2){0.f, 0.f};
#pragma unroll 1
        for (int e0 = 0; e0 < 128; e0 += 8) {
            u32x4 uq[8], vq[8]; float gk[8], su[8], sv[8];
#pragma unroll
            for (int k = 0; k < 8; ++k) { const int e = e0 + k;
                int id = __builtin_amdgcn_readlane(e0 < 64 ? id0 : id1, e & 63);
                id &= 16383;
                gk[k] = __uint_as_float(__builtin_amdgcn_readlane(__float_as_uint(e0 < 64 ? g0 : g1), e & 63));
                uq[k] = *(const u32x4*)(U8 + (size_t)id * 1024); vq[k] = *(const u32x4*)(V8 + (size_t)id * 1024);
                su[k] = USC[id]; sv[k] = VSC[id]; }
            float d[8];
#pragma unroll
            for (int k = 0; k < 8; ++k) { f32x2 s2 = (f32x2){0.f, 0.f};
#pragma unroll
                for (int w = 0; w < 4; ++w) { const f32x2 lo = __builtin_amdgcn_cvt_pk_f32_fp8((int)uq[k][w], false), hi = __builtin_amdgcn_cvt_pk_f32_fp8((int)uq[k][w], true);
                    s2 = lo * hv2[2 * w] + s2; s2 = hi * hv2[2 * w + 1] + s2; }
                d[k] = s2[0] + s2[1]; }
            const bool b32 = lane & 32, b16 = lane & 16, b8 = lane & 8;
            float d4[4], d2[2], r;
#pragma unroll
            for (int k = 0; k < 4; ++k) { const float recv = __shfl_xor(b32 ? d[k] : d[k + 4], 32); d4[k] = (b32 ? d[k + 4] : d[k]) + recv; }
#pragma unroll
            for (int k = 0; k < 2; ++k) { const float recv = __shfl_xor(b16 ? d4[k] : d4[k + 2], 16); d2[k] = (b16 ? d4[k + 2] : d4[k]) + recv; }
            { const float recv = __shfl_xor(b8 ? d2[0] : d2[1], 8); r = (b8 ? d2[1] : d2[0]) + recv; }
            r += __shfl_xor(r, 4); r += __shfl_xor(r, 2); r += __shfl_xor(r, 1);
#pragma unroll
            for (int k = 0; k < 8; ++k) { const float dot = __uint_as_float(__builtin_amdgcn_readlane(__float_as_uint(r), ((k >> 2) & 1) * 32 + ((k >> 1) & 1) * 16 + (k & 1) * 8));
                const float cf = gk[k] * gelu_tanh(dot * su[k]) * sv[k]; const f32x2 cf2 = (f32x2){cf, cf};
#pragma unroll
                for (int w = 0; w < 4; ++w) { const f32x2 lo = __builtin_amdgcn_cvt_pk_f32_fp8((int)vq[k][w], false), hi = __builtin_amdgcn_cvt_pk_f32_fp8((int)vq[k][w], true);
                    acc2[2 * w] = lo * cf2 + acc2[2 * w]; acc2[2 * w + 1] = hi * cf2 + acc2[2 * w + 1]; } }
        }
        const float* g2 = MOD + ((size_t)l * 2 + b) * 6144 + 5 * 1024 + 16 * lane;
        float* xrow = XRES + (size_t)tok * 1024 + 16 * lane;
        float xn[16]; float ss = 0.f;
#pragma unroll
        for (int q = 0; q < 4; ++q) { const f32x4 xr = *(const f32x4*)(xrow + 4 * q), gg = *(const f32x4*)(g2 + 4 * q);
            const float a0 = acc2[2 * q][0], a1 = acc2[2 * q][1], a2 = acc2[2 * q + 1][0], a3 = acc2[2 * q + 1][1];
            xn[4 * q + 0] = xr[0] + gg[0] * a0; xn[4 * q + 1] = xr[1] + gg[1] * a1; xn[4 * q + 2] = xr[2] + gg[2] * a2; xn[4 * q + 3] = xr[3] + gg[3] * a3; }
#pragma unroll
        for (int i = 0; i < 16; ++i) ss += xn[i] * xn[i];
        const float inv = __builtin_amdgcn_rsqf(wave_sum(ss) * (1.f / 1024.f) + EPS);
        if (dry) { if (inv == 123.456f) p->out[tok] = inv; continue; }
        if (l < DEPTH - 1) {
            const float* gain = p->norm_g + (size_t)(l + 1) * 2 * 1024 + 16 * lane; const float* sh = MOD + ((size_t)(l + 1) * 2 + b) * 6144 + 16 * lane; const float* sc = sh + 1024;
            float y[16];
#pragma unroll
            for (int q = 0; q < 4; ++q) { const f32x4 gn = *(const f32x4*)(gain + 4 * q), s1 = *(const f32x4*)(sh + 4 * q), c1 = *(const f32x4*)(sc + 4 * q);
                *(f32x4*)(xrow + 4 * q) = (f32x4){xn[4 * q], xn[4 * q + 1], xn[4 * q + 2], xn[4 * q + 3]};
#pragma unroll
                for (int i = 0; i < 4; ++i) y[4 * q + i] = (xn[4 * q + i] * inv) * gn[i] * (1.f + c1[i]) + s1[i]; }
            u32x4 o0, o1; o0.x = cvt_pk_bf16(y[0], y[1]); o0.y = cvt_pk_bf16(y[2], y[3]); o0.z = cvt_pk_bf16(y[4], y[5]); o0.w = cvt_pk_bf16(y[6], y[7]);
            o1.x = cvt_pk_bf16(y[8], y[9]); o1.y = cvt_pk_bf16(y[10], y[11]); o1.z = cvt_pk_bf16(y[12], y[13]); o1.w = cvt_pk_bf16(y[14], y[15]);
            *(u32x4*)(HBW + (size_t)tok * 1024 + 16 * lane) = o0; *(u32x4*)(HBW + (size_t)tok * 1024 + 16 * lane + 8) = o1;
        } else {
            const float* fg = p->final_g + 16 * lane; float* orow = p->out + (size_t)tok * 1024 + 16 * lane;
#pragma unroll
            for (int q = 0; q < 4; ++q) { const f32x4 gn = *(const f32x4*)(fg + 4 * q); f32x4 o;
#pragma unroll
                for (int i = 0; i < 4; ++i) o[i] = (xn[4 * q + i] * inv) * gn[i];
                *(f32x4*)(orow + 4 * q) = o; }
        }
    }
}

#define XB_TMO      128
#define XB_XCNT(j)  (256  + 64 * (j))
#define XB_XSUB(j)  (1280 + 64 * (j))
#define XB_XGEN(j)  (2304 + 64 * (j))
#define XB_TOP      3328
#define XB_TOPGEN   3392
#define XCD_BAR_WORDS 3456
#define XB_SPIN_CAP (1u << 18)

__device__ __forceinline__ unsigned xb_ld(unsigned* p)              { return __hip_atomic_load(p, __ATOMIC_RELAXED, __HIP_MEMORY_SCOPE_AGENT); }
__device__ __forceinline__ unsigned xb_add(unsigned* p, unsigned v) { return __hip_atomic_fetch_add(p, v, __ATOMIC_RELAXED, __HIP_MEMORY_SCOPE_AGENT); }
__device__ __forceinline__ unsigned xb_xcc_id() { return (unsigned)__builtin_amdgcn_s_getreg((3 << 11) | 20) & 0xFu; }
#define XB_SPIN(cond, bar) do { unsigned _sp = 0; while (cond) { __builtin_amdgcn_s_sleep(1); \
    if ((++_sp & 255u) == 0u) { if (xb_ld(&(bar)[XB_TMO])) break; if (_sp > XB_SPIN_CAP) { atomicAdd(&(bar)[XB_TMO], 1u); break; } } } } while (0)

struct XcdBarrier {
    unsigned* bar; unsigned x;
    volatile LAS unsigned* st;
};

__device__ __forceinline__ XcdBarrier xcd_barrier_post(unsigned* bar, volatile LAS unsigned* st) {
    XcdBarrier b; b.bar = bar; b.x = xb_xcc_id(); b.st = st;
    if (threadIdx.x == 0) (void)xb_add(&bar[XB_XCNT(b.x)], 1u);
    return b;
}
__device__ __forceinline__ void xcd_barrier_complete(unsigned* bar, unsigned x, unsigned& nloc, unsigned& nx) {
    const unsigned G = gridDim.x * gridDim.y * gridDim.z;
    unsigned sum, cnt, mine, sp = 0u;
    for (;;) {
        sum = 0u; cnt = 0u; mine = 0u;
#pragma unroll
        for (unsigned j = 0; j < 16; ++j) { const unsigned c = xb_ld(&bar[XB_XCNT(j)]); sum += c; cnt += (c > 0u) ? 1u : 0u; mine = (j == x) ? c : mine; }
        if (sum == G) break;
        __builtin_amdgcn_s_sleep(1);
        if ((++sp & 255u) == 0u) { if (xb_ld(&bar[XB_TMO])) break; if (sp > XB_SPIN_CAP) { atomicAdd(&bar[XB_TMO], 1u); break; } }
    }
    nloc = mine > 0u ? mine : 1u; nx = cnt > 0u ? cnt : 1u;
}

__device__ __forceinline__ void xcd_barrier(const XcdBarrier& b) {
    asm volatile("s_waitcnt vmcnt(0)" ::: "memory");
    __syncthreads();
    if (threadIdx.x == 0) {
        unsigned* bar = b.bar;
        __builtin_amdgcn_s_waitcnt(0);
        unsigned nloc = b.st[0], nx = b.st[1];
        if (nloc == 0u) { xcd_barrier_complete(bar, b.x, nloc, nx); b.st[0] = nloc; b.st[1] = nx; }
        const unsigned old = xb_add(&bar[XB_XSUB(b.x)], 1u);
        const unsigned gen = old / nloc;
        if (old + 1u == (gen + 1u) * nloc) {
            __builtin_amdgcn_fence(__ATOMIC_RELEASE, "agent");
            asm volatile("s_waitcnt vmcnt(0)" ::: "memory");
            const unsigned og = xb_add(&bar[XB_TOP], 1u);
            const unsigned tg = og / nx;
            if (og + 1u == (tg + 1u) * nx) xb_add(&bar[XB_TOPGEN], 1u);
            else XB_SPIN(xb_ld(&bar[XB_TOPGEN]) == tg, bar);
            __builtin_amdgcn_fence(__ATOMIC_ACQUIRE, "agent");
            xb_add(&bar[XB_XGEN(b.x)], 1u);
            asm volatile("s_waitcnt vmcnt(0)" ::: "memory");
        } else {
            XB_SPIN(xb_ld(&bar[XB_XGEN(b.x)]) == gen, bar);
            __builtin_amdgcn_fence(__ATOMIC_ACQUIRE, "agent");
            asm volatile("s_waitcnt vmcnt(0)" ::: "memory");
        }
    }
    __syncthreads();
}

#ifndef OPMASK
#define OPMASK 0xFFFFFFFFu
#endif
#define EN(o) ((OPMASK >> (o)) & 1u)
enum { OP_P0 = 0, OP_RMS1, OP_HG_IN, OP_HG_A, OP_HG_B, OP_HG_C, OP_MIX_OUT, OP_LR_IN, OP_LR_CONV, OP_LR_G, OP_LR_S1, OP_LR_S2, OP_LR_S3, OP_RMS2, OP_QK, OP_TOPK, OP_GATHER };
constexpr int NPH = 42;
#define REP_MASK 0u
__device__ __forceinline__ void decode_phase(int ph, int& l, int& op) {
    if (ph == 0) { l = 0; op = OP_P0; return; }
    if (ph == 1) { l = 0; op = OP_RMS1; return; }
    int q = ph - 2;
    if (q < 9) { l = 0; } else if (q < 20) { l = 1; q -= 9; } else if (q < 29) { l = 2; q -= 20; } else { l = 3; q -= 29; }
    if ((l & 1) == 0) { op = q == 0 ? OP_HG_IN : q == 1 ? OP_HG_A : q == 2 ? OP_HG_B : q == 3 ? OP_HG_C : q == 4 ? OP_MIX_OUT : q == 5 ? OP_RMS2 : q == 6 ? OP_QK : q == 7 ? OP_TOPK : OP_GATHER; }
    else { op = q == 0 ? OP_LR_IN : q == 1 ? OP_LR_CONV : q == 2 ? OP_LR_G : q == 3 ? OP_LR_S1 : q == 4 ? OP_LR_S2 : q == 5 ? OP_LR_S3 : q == 6 ? OP_MIX_OUT : q == 7 ? OP_RMS2 : q == 8 ? OP_QK : q == 9 ? OP_TOPK : OP_GATHER; }
}

__global__ __launch_bounds__(512, 2) void mk_fwd(Params p_arg) {
    extern __shared__ __attribute__((aligned(16))) unsigned char shm[];
    LAS unsigned char* lds = (LAS unsigned char*)shm;
    cg::grid_group grid = cg::this_grid();
    unsigned long long kpv = (unsigned long long)__builtin_amdgcn_kernarg_segment_ptr();
    const int ph_lo = p_arg.ph_lo, ph_hi = p_arg.ph_hi;
    volatile LAS unsigned* xst = (volatile LAS unsigned*)(lds + LDS_BYTES - 16);
    if (threadIdx.x == 0) { xst[0] = 0u; xst[1] = 0u; }
    __syncthreads();
    const XcdBarrier xb = xcd_barrier_post((unsigned*)(p_arg.ws + WS_CTL) + 1024, xst);
    for (int ph = ph_lo; ph < ph_hi; ++ph) {
        if (ph > ph_lo) { if (ph == 1) grid.sync(); else xcd_barrier(xb); }
        asm volatile("" : "+s"(kpv));
        KP p = (KP)kpv;
        unsigned char* ws = p->ws;
        const float* MOD = (const float*)(ws + WS_MOD);
        int l, op; decode_phase(ph, l, op);
        const int j = l >> 1;
        const int nrep = ((p->rep_mask >> op) & 1u) ? 2 : 1;
        for (int rep = 0; rep < nrep; ++rep) {
        const bool dry = rep + 1 < nrep;
#ifdef ONLY
        switch (ONLY) {
#else
        switch (op) {
#endif
        case OP_P0: if (EN(OP_P0)) phase0(p, lds); break;
        case OP_RMS1: if (EN(OP_RMS1)) phase_rms(p->x, p->norm_g, MOD, MOD + 1024, (bf16_t*)(ws + WS_HBUF)); break;
        case OP_HG_IN: if (EN(OP_HG_IN)) { EpiBf16 E; E.O = (bf16_t*)(ws + WS_PROJ); E.ldc = 5120;
            run_gemm(lds, (const bf16_t*)(ws + WS_HBUF), (const bf16_t*)(ws + WS_HGWIN) + (size_t)j * 5120 * 1024, 5120, 1024, 1024, 1024, 0, 0, E); } break;
        case OP_HG_A: if (EN(OP_HG_A)) hg_pass_a(p, lds, j); break;
        case OP_HG_B: if (EN(OP_HG_B)) hg_pass_b(p); break;
        case OP_HG_C: if (EN(OP_HG_C)) hg_pass_c(p, lds, j); break;
        case OP_MIX_OUT: if (EN(OP_MIX_OUT)) { EpiResid E; E.xin = (l == 0) ? p->x : (const float*)(ws + WS_XRES); E.xout = (float*)(ws + WS_XRES); E.gate = MOD + (size_t)l * 2 * 6144 + 2 * 1024; E.dry = dry;
            const bf16_t* W = (l & 1) ? (const bf16_t*)(ws + WS_LRWOUT) + (size_t)j * 1024 * 1024 : (const bf16_t*)(ws + WS_HGWOUT) + (size_t)j * 1024 * 1024;
            run_gemm(lds, (const bf16_t*)(ws + WS_OB), W, 1024, 1024, 1024, 1024, 0, 0, E); } break;
        case OP_LR_IN: if (EN(OP_LR_IN)) { EpiLruIn E; E.XB = (bf16_t*)(ws + WS_XB); E.YG = (bf16_t*)(ws + WS_YG);
            run_gemm(lds, (const bf16_t*)(ws + WS_HBUF), (const bf16_t*)(ws + WS_LRWIN) + (size_t)j * 2048 * 1024, 2048, 1024, 1024, 1024, 0, 0, E); } break;
        case OP_LR_CONV: if (EN(OP_LR_CONV)) lru_conv(p, j); break;
        case OP_LR_G: if (EN(OP_LR_G)) { EpiGates E; E.LOGA = (bf16_t*)(ws + WS_LOGA); E.BTERM = (bf16_t*)(ws + WS_BTERM); E.XC = (const bf16_t*)(ws + WS_XC);
            E.b_a = p->lru_b_a + (size_t)j * 2048; E.b_x = p->lru_b_x + (size_t)j * 2048; E.lam = p->lru_lam + (size_t)j * 2048;
            run_gemm(lds, (const bf16_t*)(ws + WS_XC), (const bf16_t*)(ws + WS_LRWG) + (size_t)j * 4 * 1024 * 256, 4096, 256, 1024, 256, 2, 512, E); } break;
        case OP_LR_S1: if (EN(OP_LR_S1)) lru_scan1(p); break;
        case OP_LR_S2: if (EN(OP_LR_S2)) lru_scan2(p); break;
        case OP_LR_S3: if (EN(OP_LR_S3)) lru_scan3(p); break;
        case OP_RMS2: if (EN(OP_RMS2)) phase_rms((const float*)(ws + WS_XRES), p->norm_g + ((size_t)l * 2 + 1) * 1024, MOD + (size_t)l * 2 * 6144 + 3 * 1024, MOD + (size_t)l * 2 * 6144 + 4 * 1024, (bf16_t*)(ws + WS_HBUF)); break;
        case OP_QK: if (EN(OP_QK)) { EpiScoresT E; E.C = (float*)(ws + WS_SCORES);
            run_gemm(lds, (const bf16_t*)(ws + WS_HBUF), (const bf16_t*)(ws + WS_WQK) + (size_t)l * 2048 * 1024, 2048, 1024, 1024, 1024, 0, 0, E); } break;
        case OP_TOPK: if (EN(OP_TOPK)) peer_topk(p, lds); break;
        case OP_GATHER: if (EN(OP_GATHER)) peer_gather(p, l, dry); break;
        default: break;
        }
        }
    }
}

extern "C" void kernel_launch(void* const* d_in, const int* in_sizes, int n_in, void* d_out, int out_size, void* d_ws, size_t ws_size, hipStream_t stream) {
    static int grid = 0;
    if (grid == 0) {
        if (n_in != 23 || ws_size < WS_END) { fprintf(stderr, "kernel_launch: unexpected n_in %d / ws_size %zu (need %zu)\n", n_in, ws_size, (size_t)WS_END); grid = -1; return; }
        int dev = 0, cus = 0, per_cu = 0;
        hipGetDevice(&dev); hipDeviceGetAttribute(&cus, hipDeviceAttributeMultiprocessorCount, dev);
        if (hipFuncSetAttribute((const void*)mk_fwd, hipFuncAttributeMaxDynamicSharedMemorySize, LDS_BYTES) != hipSuccess) { fprintf(stderr, "kernel_launch: hipFuncSetAttribute failed\n"); grid = -1; return; }
        if (hipOccupancyMaxActiveBlocksPerMultiprocessor(&per_cu, (const void*)mk_fwd, NTHR, LDS_BYTES) != hipSuccess || per_cu < 1) { fprintf(stderr, "kernel_launch: occupancy query failed (%d)\n", per_cu); (void)hipGetLastError(); per_cu = 1; }
        grid = cus * 1;
        fprintf(stderr, "kernel_launch: cus %d per_cu %d grid %d\n", cus, per_cu, grid);
    }
    if (grid < 0) return;
    if (hipMemsetAsync((char*)d_ws + WS_CTL, 0, 65536, stream) != hipSuccess) { fprintf(stderr, "kernel_launch: memset failed\n"); return; }
    Params p{};
    const float** pp = (const float**)&p;
    for (int i = 0; i < 23; ++i) pp[i] = (const float*)d_in[i];
    p.out = (float*)d_out; p.ws = (unsigned char*)d_ws; p.ph_lo = 0; p.ph_hi = NPH; p.rep_mask = REP_MASK;
    void* args[] = {&p};
    hipError_t e = hipLaunchCooperativeKernel((const void*)mk_fwd, dim3(grid), dim3(NTHR), args, LDS_BYTES, stream);
    if (e != hipSuccess) fprintf(stderr, "kernel_launch: cooperative launch failed: %s (grid %d)\n", hipGetErrorString(e), grid);
}
```

```cpp
#include <hip/hip_runtime.h>
#include <hip/hip_cooperative_groups.h>
#include <cstdio>
#include <cstdint>
namespace cg = cooperative_groups;

#define LAS __attribute__((address_space(3)))
#define PG8_LAS __attribute__((address_space(3)))
typedef unsigned short bf16_t;
typedef short bf16x8 __attribute__((ext_vector_type(8)));
typedef float f32x4 __attribute__((ext_vector_type(4)));
typedef float f32x2 __attribute__((ext_vector_type(2)));
typedef unsigned u32x4 __attribute__((ext_vector_type(4)));
typedef unsigned u32x2 __attribute__((ext_vector_type(2)));

constexpr int T = 16384, D = 1024, SEQ = 8192, DEPTH = 4;
constexpr float EPS = 1e-6f;
constexpr int NBLK = 256, NTHR = 512, NWAVE = 8, NGW = NBLK * NWAVE;

constexpr size_t MiB = 1u << 20;
constexpr size_t WS_CTL = 0;
constexpr size_t WS_MOD = 1 * MiB;
constexpr size_t WS_HGWIN = 2 * MiB;
constexpr size_t WS_HGWOUT = 22 * MiB;
constexpr size_t WS_LRWIN = 26 * MiB;
constexpr size_t WS_LRWG = 34 * MiB;
constexpr size_t WS_LRWOUT = 38 * MiB;
constexpr size_t WS_WQK = 42 * MiB;
constexpr size_t WS_TOPI = 58 * MiB;
constexpr size_t WS_TOPG = 66 * MiB;
constexpr size_t WS_DEC = 74 * MiB;
constexpr size_t WS_CP = 75 * MiB;
constexpr size_t WS_CH = 79 * MiB;
constexpr size_t WS_HIN = 83 * MiB;
constexpr size_t WS_USC = 87 * MiB;
constexpr size_t WS_VSC = 87 * MiB + 262144;
constexpr size_t WS_XRES = 88 * MiB;
constexpr size_t WS_HBUF = 152 * MiB;
constexpr size_t WS_OB = 184 * MiB;
constexpr size_t WS_PROJ = 216 * MiB;
constexpr size_t WS_XB = WS_PROJ, WS_YG = WS_PROJ + 32 * MiB, WS_XC = WS_PROJ + 64 * MiB, WS_LOGA = WS_PROJ + 96 * MiB;
constexpr size_t WS_SCORES = WS_PROJ;
constexpr size_t WS_KV = 376 * MiB;
constexpr size_t WS_BTERM = WS_KV;
constexpr size_t WS_SIN = 504 * MiB;
constexpr size_t WS_UTAB = 568 * MiB;
constexpr size_t WS_VTAB = 696 * MiB;
constexpr size_t WS_END = 824 * MiB;

constexpr int LDS_BYTES = 155648;

#define LAUNDER_IDS int tidL = threadIdx.x, bidL = blockIdx.x; asm volatile("" : "+v"(tidL)); asm volatile("" : "+s"(bidL));
__device__ __forceinline__ float bf2f(bf16_t b) { return __uint_as_float(((unsigned)b) << 16); }
__device__ __forceinline__ float bflo(unsigned u) { return __uint_as_float(u << 16); }
__device__ __forceinline__ float bfhi(unsigned u) { return __uint_as_float(u & 0xffff0000u); }
__device__ __forceinline__ unsigned cvt_pk_bf16(float lo, float hi) { unsigned r; asm volatile("v_cvt_pk_bf16_f32 %0, %1, %2" : "=v"(r) : "v"(lo), "v"(hi)); return r; }
__device__ __forceinline__ bf16_t f2bf(float f) { return (bf16_t)(cvt_pk_bf16(f, 0.f) & 0xffffu); }
__device__ __forceinline__ float fast_exp(float x) { return __builtin_amdgcn_exp2f(x * 1.4426950408889634f); }
__device__ __forceinline__ float fast_log(float x) { return __builtin_amdgcn_logf(x) * 0.6931471805599453f; }
__device__ __forceinline__ float fast_rcp(float x) { return __builtin_amdgcn_rcpf(x); }
__device__ __forceinline__ float sigmoidf_(float x) { return fast_rcp(1.f + fast_exp(-x)); }
__device__ __forceinline__ float gelu_tanh(float x) { const float u = 1.5957691216057308f * (x + 0.044715f * x * x * x); return x * fast_rcp(1.f + fast_exp(-u)); }
__device__ __forceinline__ float silu_(float x) { return x * sigmoidf_(x); }
__device__ __forceinline__ float wave_sum(float v) {
#pragma unroll
    for (int o = 1; o < 64; o <<= 1) v += __shfl_xor(v, o);
    return v;
}
__device__ __forceinline__ float wave_max(float v) {
#pragma unroll
    for (int o = 1; o < 64; o <<= 1) v = fmaxf(v, __shfl_xor(v, o));
    return v;
}

namespace pg8 {
constexpr int BM = 256, BK = 64, HALF = 128, HTB = HALF * BK * 2, STAGE_BYTES = 8 * HTB, NXCD = 8, WGM = 8;
__host__ __device__ __forceinline__ int lds_byte(int r, int c) { const int st = (r >> 4) * 2 + (c >> 5), rr = r & 15, cc = c & 31, ob = rr * 64 + cc * 2; return st * 1024 + (ob ^ (((ob >> 9) & 1) << 5)); }
__host__ __device__ __forceinline__ void stage_rc(int b, int& R, int& C) { const int st = b / 1024, sb = b % 1024, swz = sb ^ (((sb >> 9) & 1) << 5); R = (st >> 1) * 16 + swz / 64; C = (st & 1) * 32 + (swz % 64) / 2; }
__host__ __device__ __forceinline__ int perm32(int rho) { const int n = rho >> 4, i = rho & 15; return 8 * (i >> 2) + 4 * n + (i & 3); }
struct Unit { int pm, pn; };
struct Gemm { const bf16_t* A; const bf16_t* Bt; int M, N, K, lda, ldb, a_pn_shift, a_pn_stride; };
struct StaticOrder {
    int nM, nN, nwg, G, c;
    __host__ __device__ void init(int M, int N, int G_, int c_) { nM = M / BM; nN = N / BM; nwg = nM * nN; G = G_; c = c_; }
    __host__ __device__ bool next(int i, Unit& u) const {
        const long L = (long)i * G + c; if (L >= nwg) return false;
        int wgid = (int)L; { const int q = nwg / NXCD, r = nwg % NXCD, xcd = wgid % NXCD, off = wgid / NXCD; wgid = (xcd < r ? xcd * (q + 1) : r * (q + 1) + (xcd - r) * q) + off; }
        const int nig = WGM * nN, gid = wgid / nig, fm = gid * WGM, gsz = (nM - fm) < WGM ? (nM - fm) : WGM;
        u.pm = fm + ((wgid % nig) % gsz); u.pn = (wgid % nig) / gsz; return true;
    }
    __device__ __forceinline__ void a_ready(const Unit&) const {}
    __device__ __forceinline__ void done(const Unit&) const {}
};
template <class Epi, class Sched, bool STAMP = false>
__device__ __forceinline__ void gemm_phase(PG8_LAS unsigned char* lds, const Gemm g, const Sched& S, const Epi& E, unsigned long long* stamps) {
    int tid = threadIdx.x; asm volatile("" : "+v"(tid)); const int wid = __builtin_amdgcn_readfirstlane(tid >> 6), lane = tid & 63, wr = wid >> 2, wc = wid & 3, fr = lane & 15, fq = lane >> 4;
    const int K = g.K, nt = K / BK;
    int ts_lo = 0, ts_hi = 0, nts = 0; const unsigned long long rt_entry = STAMP ? (unsigned long long)wall_clock64() : 0ull;
#define PG8_STAMP() do { if (STAMP && wid == 0 && nts < 64) { const unsigned long long _c = (unsigned long long)clock64(); \
        ts_lo = (lane == nts) ? (int)(unsigned)_c : ts_lo; ts_hi = (lane == nts) ? (int)(unsigned)(_c >> 32) : ts_hi; ++nts; } } while (0)
    PG8_STAMP();
    unsigned voffA[2], voffB[2];
#pragma unroll
    for (int i = 0; i < 2; ++i) { int R, C; stage_rc(tid * 16 + i * 8192, R, C); const int Rb = Epi::PERM ? ((R & ~31) + perm32(R & 31)) : R;
        voffA[i] = (unsigned)(R * g.lda + C) * 2u; voffB[i] = (unsigned)(Rb * g.ldb + C) * 2u; }
    const size_t kstep = (size_t)(BK * 2);
    const size_t hstepA = (size_t)HALF * g.lda * 2, hstepB = (size_t)HALF * g.ldb * 2;
    const size_t tstepA = 2 * hstepA, tstepB = 2 * hstepB;
    const unsigned ldsw = (unsigned)wid * 1024u;
    const int aoff = lds_byte(wr * 64 + fr, fq * 8), boff = lds_byte(wc * 32 + fr, fq * 8);
#define PG8_SA(b, h) (((b) * 2 + (h)) * HTB)
#define PG8_SB(b, h) ((4 + (b) * 2 + (h)) * HTB)
#define PG8_STAGE(bufoff, gbase, voff) do { _Pragma("unroll") for (int _i = 0; _i < 2; ++_i) \
        __builtin_amdgcn_global_load_lds((const unsigned*)((const char*)(gbase) + (voff)[_i]), (PG8_LAS unsigned*)(lds + (bufoff) + ldsw + _i * 8192), 16, 0, 0); } while (0)
#define PG8_LDA(dst, b, h) do { _Pragma("unroll") for (int m = 0; m < 4; ++m) _Pragma("unroll") for (int k = 0; k < 2; ++k) dst[m][k] = *(const PG8_LAS bf16x8*)(lds + PG8_SA(b, h) + aoff + m * 2048 + k * 1024); } while (0)
#define PG8_LDB(dst, b, h) do { _Pragma("unroll") for (int n = 0; n < 2; ++n) _Pragma("unroll") for (int k = 0; k < 2; ++k) dst[n][k] = *(const PG8_LAS bf16x8*)(lds + PG8_SB(b, h) + boff + n * 2048 + k * 1024); } while (0)
#define PG8_MMA(ai, bj, At, Bt) do { __builtin_amdgcn_s_setprio(1); _Pragma("unroll") for (int m = 0; m < 4; ++m) _Pragma("unroll") for (int n = 0; n < 2; ++n) _Pragma("unroll") for (int k = 0; k < 2; ++k) \
        acc[ai][bj][m][n] = Epi::SWAP ? __builtin_amdgcn_mfma_f32_16x16x32_bf16(At[m][k], Bt[n][k], acc[ai][bj][m][n], 0, 0, 0) : __builtin_amdgcn_mfma_f32_16x16x32_bf16(Bt[n][k], At[m][k], acc[ai][bj][m][n], 0, 0, 0); __builtin_amdgcn_s_setprio(0); } while (0)
#define PG8_WAIT_V(n) asm volatile("s_waitcnt vmcnt(" #n ")" ::: "memory")
#define PG8_WAIT_L(n) asm volatile("s_waitcnt lgkmcnt(" #n ")" ::: "memory")
#define PG8_BAR __builtin_amdgcn_s_barrier()
#define PG8_SCHED __builtin_amdgcn_sched_barrier(0)
    Unit cur, nxt; int ui = 0;
    if (!S.next(0, cur)) return;
    f32x4 acc[2][2][4][2];
#pragma unroll
    for (int a = 0; a < 2; ++a)
#pragma unroll
        for (int b = 0; b < 2; ++b)
#pragma unroll
            for (int m = 0; m < 4; ++m)
#pragma unroll
                for (int n = 0; n < 2; ++n) acc[a][b][m][n] = (f32x4){0.f, 0.f, 0.f, 0.f};
    bf16x8 At[4][2], B0[2][2], B1[2][2];
    const char* cA = (const char*)g.A + (size_t)cur.pm * tstepA + (size_t)(cur.pn >> g.a_pn_shift) * g.a_pn_stride; const char* cB = (const char*)g.Bt + (size_t)cur.pn * tstepB;
    S.a_ready(cur);
    PG8_STAGE(PG8_SB(0, 0), cB, voffB); PG8_STAGE(PG8_SA(0, 0), cA, voffA); PG8_STAGE(PG8_SB(0, 1), cB + hstepB, voffB); PG8_STAGE(PG8_SA(0, 1), cA + hstepA, voffA);
    if (wr == 1) PG8_BAR;
    PG8_WAIT_V(4); PG8_BAR;
    PG8_STAGE(PG8_SB(1, 0), cB + kstep, voffB); PG8_STAGE(PG8_SA(1, 0), cA + kstep, voffA); PG8_STAGE(PG8_SB(1, 1), cB + hstepB + kstep, voffB);
    PG8_WAIT_V(6); PG8_BAR;
    PG8_STAMP();
    for (;;) {
        const bool has_next = S.next(ui + 1, nxt);
        const char* nA = has_next ? (const char*)g.A + (size_t)nxt.pm * tstepA + (size_t)(nxt.pn >> g.a_pn_shift) * g.a_pn_stride : cA; const char* nB = has_next ? (const char*)g.Bt + (size_t)nxt.pn * tstepB : cB;
#pragma unroll 1
        for (int t = 0; t < nt; t += 2) {
            const bool last = (t == nt - 2);
            const char* a1 = cA + (size_t)(t + 1) * kstep;
            const char* a2 = last ? nA : cA + (size_t)(t + 2) * kstep; const char* b2 = last ? nB : cB + (size_t)(t + 2) * kstep;
            const char* a3 = a2 + kstep; const char* b3 = b2 + kstep;
            if (last && has_next) S.a_ready(nxt);
            PG8_LDB(B0, 0, 0); PG8_SCHED; PG8_LDA(At, 0, 0); PG8_STAGE(PG8_SA(1, 1), a1 + hstepA, voffA);
            PG8_WAIT_L(8); PG8_BAR; PG8_WAIT_L(0); PG8_MMA(0, 0, At, B0); PG8_BAR; PG8_SCHED;
            PG8_LDB(B1, 0, 1); PG8_STAGE(PG8_SB(0, 0), b2, voffB);
            PG8_BAR; PG8_WAIT_L(0); PG8_MMA(0, 1, At, B1); PG8_BAR;
            PG8_LDA(At, 0, 1); PG8_STAGE(PG8_SA(0, 0), a2, voffA);
            PG8_BAR; PG8_WAIT_L(0); PG8_MMA(1, 0, At, B0); PG8_BAR; PG8_SCHED;
            PG8_STAGE(PG8_SB(0, 1), b2 + hstepB, voffB);
            PG8_WAIT_V(6); PG8_BAR; PG8_MMA(1, 1, At, B1); PG8_BAR;
            PG8_LDB(B0, 1, 0); PG8_SCHED; PG8_LDA(At, 1, 0); PG8_STAGE(PG8_SA(0, 1), a2 + hstepA, voffA);
            PG8_WAIT_L(8); PG8_BAR; PG8_WAIT_L(0); PG8_MMA(0, 0, At, B0); PG8_BAR; PG8_SCHED;
            PG8_LDB(B1, 1, 1); PG8_STAGE(PG8_SB(1, 0), b3, voffB);
            PG8_BAR; PG8_WAIT_L(0); PG8_MMA(0, 1, At, B1); PG8_BAR;
            PG8_LDA(At, 1, 1); PG8_STAGE(PG8_SA(1, 0), a3, voffA);
            PG8_BAR; PG8_WAIT_L(0); PG8_MMA(1, 0, At, B0); PG8_BAR; PG8_SCHED;
            PG8_STAGE(PG8_SB(1, 1), b3 + hstepB, voffB);
            PG8_WAIT_V(6); PG8_BAR; PG8_MMA(1, 1, At, B1); PG8_BAR;
        }
        PG8_STAMP();
        if constexpr (!Epi::AFTER_DRAIN) { E(acc, cur, wr, wc, fr, fq); S.done(cur); }
        PG8_STAMP();
        if (!has_next) break;
#pragma unroll
        for (int a = 0; a < 2; ++a)
#pragma unroll
            for (int b = 0; b < 2; ++b)
#pragma unroll
                for (int m = 0; m < 4; ++m)
#pragma unroll
                    for (int n = 0; n < 2; ++n) acc[a][b][m][n] = (f32x4){0.f, 0.f, 0.f, 0.f};
        cur = nxt; cA = nA; cB = nB; ++ui;
    }
    PG8_WAIT_V(0);
    if (wr == 0) PG8_BAR;
    PG8_BAR;
    if constexpr (Epi::AFTER_DRAIN) { E.fused(acc, cur, wr, wc, fr, fq, lds, wid, lane); S.done(cur); }
    PG8_STAMP();
    if (STAMP && wid == 0) { stamps[lane] = lane < nts ? (((unsigned long long)(unsigned)ts_hi << 32) | (unsigned)ts_lo) : 0ull;
        if (lane == 62) stamps[62] = rt_entry; if (lane == 63) stamps[63] = (unsigned long long)wall_clock64(); }
#undef PG8_STAMP
#undef PG8_SA
#undef PG8_SB
#undef PG8_STAGE
#undef PG8_LDA
#undef PG8_LDB
#undef PG8_MMA
#undef PG8_WAIT_V
#undef PG8_WAIT_L
#undef PG8_BAR
#undef PG8_SCHED
}
}
using pg8::Unit;

struct EpiBf16 {
    static constexpr bool PERM = true, AFTER_DRAIN = false, SWAP = false;
    bf16_t* O; int ldc;
    __device__ __forceinline__ void operator()(const f32x4 (&acc)[2][2][4][2], const Unit& u, int wr, int wc, int fr, int fq) const {
        const int row0 = u.pm * 256 + wr * 64 + fr, col0 = u.pn * 256 + wc * 32 + 8 * fq;
#pragma unroll
        for (int ai = 0; ai < 2; ++ai)
#pragma unroll
            for (int m = 0; m < 4; ++m) { bf16_t* rowp = O + (size_t)(row0 + ai * 128 + m * 16) * ldc + col0;
#pragma unroll
                for (int bj = 0; bj < 2; ++bj) { const f32x4 v0 = acc[ai][bj][m][0], v1 = acc[ai][bj][m][1];
                    u32x4 o; o.x = cvt_pk_bf16(v0[0], v0[1]); o.y = cvt_pk_bf16(v0[2], v0[3]); o.z = cvt_pk_bf16(v1[0], v1[1]); o.w = cvt_pk_bf16(v1[2], v1[3]);
                    *(u32x4*)(rowp + bj * 128) = o; } }
    }
};
struct EpiLruIn {
    static constexpr bool PERM = true, AFTER_DRAIN = false, SWAP = false;
    bf16_t* XB; bf16_t* YG;
    __device__ __forceinline__ void operator()(const f32x4 (&acc)[2][2][4][2], const Unit& u, int wr, int wc, int fr, int fq) const {
        const bool isy = u.pn >= 4;
        bf16_t* O = isy ? YG : XB;
        const int row0 = u.pm * 256 + wr * 64 + fr, col0 = (u.pn & 3) * 256 + wc * 32 + 8 * fq;
#pragma unroll
        for (int ai = 0; ai < 2; ++ai)
#pragma unroll
            for (int m = 0; m < 4; ++m) { bf16_t* rowp = O + (size_t)(row0 + ai * 128 + m * 16) * 1024 + col0;
#pragma unroll
                for (int bj = 0; bj < 2; ++bj) { f32x4 v0 = acc[ai][bj][m][0], v1 = acc[ai][bj][m][1];
                    if (isy) {
#pragma unroll
                        for (int i = 0; i < 4; ++i) { v0[i] = gelu_tanh(v0[i]); v1[i] = gelu_tanh(v1[i]); } }
                    u32x4 o; o.x = cvt_pk_bf16(v0[0], v0[1]); o.y = cvt_pk_bf16(v0[2], v0[3]); o.z = cvt_pk_bf16(v1[0], v1[1]); o.w = cvt_pk_bf16(v1[2], v1[3]);
                    *(u32x4*)(rowp + bj * 128) = o; } }
    }
};
struct EpiGates {
    static constexpr bool PERM = true, AFTER_DRAIN = false, SWAP = false;
    bf16_t* LOGA; bf16_t* BTERM; const bf16_t* XC; const float* b_a; const float* b_x; const float* lam;
    __device__ __forceinline__ void operator()(const f32x4 (&acc)[2][2][4][2], const Unit& u, int wr, int wc, int fr_, int fq) const {
        int fr = fr_; asm volatile("" : "+v"(fr));
        const int nblk = u.pn >> 2, uu = u.pn & 3, d = uu >> 1, jh = uu & 1;
        const int colbase = nblk * 256 + jh * 128 + wc * 32 + 8 * fq;
        const unsigned off0 = (unsigned)(u.pm * 256 + wr * 64 + fr) * 1024u + (unsigned)colbase;
        const bf16_t* xcp = XC; bf16_t* lap = LOGA + (size_t)d * T * 1024; bf16_t* btp = BTERM + (size_t)d * T * 1024;
        const float* bap = b_a + d * 1024; const float* bxp = b_x + d * 1024; const float* lmp = lam + d * 1024;
#pragma unroll
        for (int ai = 0; ai < 2; ++ai)
#pragma unroll
            for (int m = 0; m < 4; ++m) { const unsigned off = off0 + (unsigned)(ai * 128 + m * 16) * 1024u;
                asm volatile("" ::: "memory"); __builtin_amdgcn_sched_barrier(0);
                const u32x4 xr = *(const u32x4*)(xcp + off);
                const float xv[8] = {bflo(xr.x), bfhi(xr.x), bflo(xr.y), bfhi(xr.y), bflo(xr.z), bfhi(xr.z), bflo(xr.w), bfhi(xr.w)};
                unsigned o1[4], o2[4];
#pragma unroll
                for (int n = 0; n < 2; ++n) { const f32x4 ba = *(const f32x4*)(bap + (unsigned)(colbase + 4 * n)), bx = *(const f32x4*)(bxp + (unsigned)(colbase + 4 * n)), lm = *(const f32x4*)(lmp + (unsigned)(colbase + 4 * n));
                    float la[4], bt[4];
#pragma unroll
                    for (int i = 0; i < 4; ++i) { const float r = sigmoidf_(acc[ai][0][m][n][i] + ba[i]), ig = sigmoidf_(acc[ai][1][m][n][i] + bx[i]);
                        const float l = -8.f * fast_log(1.f + fast_exp(-lm[i])) * r; const float mult = __builtin_sqrtf(fmaxf(1.f - fast_exp(2.f * l), 0.f));
                        la[i] = l; bt[i] = mult * ig * xv[n * 4 + i]; }
                    o1[n * 2] = cvt_pk_bf16(la[0], la[1]); o1[n * 2 + 1] = cvt_pk_bf16(la[2], la[3]); o2[n * 2] = cvt_pk_bf16(bt[0], bt[1]); o2[n * 2 + 1] = cvt_pk_bf16(bt[2], bt[3]); }
                *(u32x4*)(lap + off) = (u32x4){o1[0], o1[1], o1[2], o1[3]}; *(u32x4*)(btp + off) = (u32x4){o2[0], o2[1], o2[2], o2[3]}; }
    }
};
struct EpiResid {
    static constexpr bool PERM = false, AFTER_DRAIN = false, SWAP = false;
    const float* xin; float* xout; const float* gate; bool dry;
    __device__ __forceinline__ void operator()(const f32x4 (&acc)[2][2][4][2], const Unit& u, int wr, int wc, int fr, int fq) const {
        const int row0 = u.pm * 256 + wr * 64 + fr, col0 = u.pn * 256 + wc * 32 + 4 * fq;
        const float* gp = gate + ((u.pm * 256) >> 13) * 6144 + col0;
        f32x4 gv[2][2];
#pragma unroll
        for (int bj = 0; bj < 2; ++bj)
#pragma unroll
            for (int n = 0; n < 2; ++n) gv[bj][n] = *(const f32x4*)(gp + bj * 128 + n * 16);
#pragma unroll
        for (int ai = 0; ai < 2; ++ai)
#pragma unroll
            for (int m = 0; m < 4; ++m) { const size_t off = (size_t)(row0 + ai * 128 + m * 16) * 1024 + col0;
#pragma unroll
                for (int bj = 0; bj < 2; ++bj)
#pragma unroll
                    for (int n = 0; n < 2; ++n) { const f32x4 xv = *(const f32x4*)(xin + off + bj * 128 + n * 16);
                        if (!dry) *(f32x4*)(xout + off + bj * 128 + n * 16) = xv + gv[bj][n] * acc[ai][bj][m][n]; } }
    }
};
struct EpiScoresT {
    static constexpr bool PERM = false, AFTER_DRAIN = false, SWAP = true;
    float* C;
    __device__ __forceinline__ void operator()(const f32x4 (&acc)[2][2][4][2], const Unit& u, int wr, int wc, int fr_, int fq) const {
        int fr = fr_; asm volatile("" : "+v"(fr));
        const unsigned off0 = (unsigned)(u.pn * 256 + wc * 32 + fr) * (unsigned)T + (unsigned)(u.pm * 256 + wr * 64 + 4 * fq);
#pragma unroll
        for (int ai = 0; ai < 2; ++ai)
#pragma unroll
            for (int m = 0; m < 4; ++m)
#pragma unroll
                for (int bj = 0; bj < 2; ++bj)
#pragma unroll
                    for (int n = 0; n < 2; ++n) *(f32x4*)(C + (off0 + (unsigned)(bj * 128 + n * 16) * (unsigned)T + (unsigned)(ai * 128 + m * 16))) = acc[ai][bj][m][n];
    }
};

struct Params {
    const float *x, *c, *w_ada, *b_ada, *norm_g, *hg_w_in, *hg_lb, *hg_norm_g, *hg_w_out, *lru_w_in, *lru_conv_w, *lru_conv_b,
        *lru_w_a, *lru_b_a, *lru_w_x, *lru_b_x, *lru_lam, *lru_w_out, *peer_w_q, *peer_keys, *peer_u, *peer_v, *final_g;
    float* out; unsigned char* ws; int ph_lo, ph_hi; unsigned rep_mask; int pad_;
};

typedef const __attribute__((address_space(4))) Params* KP;

template <class Epi>
__device__ __forceinline__ void run_gemm(LAS unsigned char* lds, const bf16_t* A, const bf16_t* Bt, int N, int K, int lda, int ldb, int a_pn_shift, int a_pn_stride, const Epi& E) {
    pg8::Gemm g; g.A = A; g.Bt = Bt; g.M = T; g.N = N; g.K = K; g.lda = lda; g.ldb = ldb; g.a_pn_shift = a_pn_shift; g.a_pn_stride = a_pn_stride;
    LAUNDER_IDS
    pg8::StaticOrder S; S.init(T, N, (int)gridDim.x, bidL); (void)tidL;
    pg8::gemm_phase<Epi, pg8::StaticOrder, false>(lds, g, S, E, nullptr);
    __syncthreads();
}

__device__ __forceinline__ void transpose_tile(const float* __restrict__ src, int ld_src, bf16_t* dst, int ld_dst, LAS float* tile, int tid) {
#pragma unroll
    for (int it = 0; it < 2; ++it) { const int r = (tid >> 4) + 32 * it, c4 = (tid & 15) * 4;
        const f32x4 v = *(const f32x4*)(src + (size_t)r * ld_src + c4);
        tile[r * 65 + c4 + 0] = v[0]; tile[r * 65 + c4 + 1] = v[1]; tile[r * 65 + c4 + 2] = v[2]; tile[r * 65 + c4 + 3] = v[3]; }
    __syncthreads();
    { const int n = tid >> 3, kc = tid & 7; const LAS float* s = tile + (kc * 8) * 65 + n;
        u32x4 o; o.x = cvt_pk_bf16(s[0], s[65]); o.y = cvt_pk_bf16(s[2 * 65], s[3 * 65]); o.z = cvt_pk_bf16(s[4 * 65], s[5 * 65]); o.w = cvt_pk_bf16(s[6 * 65], s[7 * 65]);
        *(u32x4*)(dst + (size_t)n * ld_dst + kc * 8) = o; }
    __syncthreads();
}

__device__ __forceinline__ void phase0(KP p, LAS unsigned char* lds) {
    LAUNDER_IDS
    const int tid = tidL, wave = tid >> 6, lane = tid & 63;
    unsigned char* ws = p->ws;
    LAS float* tile = (LAS float*)lds;
    constexpr int I_HGIN = 16 * 80, I_SQ = 16 * 16, I_LRIN = 16 * 32, I_G = 16;
    constexpr int N_A = 2 * I_HGIN + 2 * I_SQ + 2 * I_LRIN + 2 * I_SQ + 32 * I_G;
    for (int it = bidL; it < N_A; it += gridDim.x) {
        int r = it;
        if (r < 2 * I_HGIN) { const int j = r / I_HGIN, q = r % I_HGIN, kb = q / 80, nb = q % 80;
            transpose_tile(p->hg_w_in + (size_t)j * 1024 * 5120 + (size_t)kb * 64 * 5120 + nb * 64, 5120, (bf16_t*)(ws + WS_HGWIN) + (size_t)j * 5120 * 1024 + (size_t)nb * 64 * 1024 + kb * 64, 1024, tile, tid); continue; }
        r -= 2 * I_HGIN;
        if (r < 2 * I_SQ) { const int j = r / I_SQ, q = r % I_SQ, kb = q / 16, nb = q % 16;
            transpose_tile(p->hg_w_out + (size_t)j * 1024 * 1024 + (size_t)kb * 64 * 1024 + nb * 64, 1024, (bf16_t*)(ws + WS_HGWOUT) + (size_t)j * 1024 * 1024 + (size_t)nb * 64 * 1024 + kb * 64, 1024, tile, tid); continue; }
        r -= 2 * I_SQ;
        if (r < 2 * I_LRIN) { const int j = r / I_LRIN, q = r % I_LRIN, kb = q / 32, nb = q % 32;
            transpose_tile(p->lru_w_in + (size_t)j * 1024 * 2048 + (size_t)kb * 64 * 2048 + nb * 64, 2048, (bf16_t*)(ws + WS_LRWIN) + (size_t)j * 2048 * 1024 + (size_t)nb * 64 * 1024 + kb * 64, 1024, tile, tid); continue; }
        r -= 2 * I_LRIN;
        if (r < 2 * I_SQ) { const int j = r / I_SQ, q = r % I_SQ, kb = q / 16, nb = q % 16;
            transpose_tile(p->lru_w_out + (size_t)j * 1024 * 1024 + (size_t)kb * 64 * 1024 + nb * 64, 1024, (bf16_t*)(ws + WS_LRWOUT) + (size_t)j * 1024 * 1024 + (size_t)nb * 64 * 1024 + kb * 64, 1024, tile, tid); continue; }
        r -= 2 * I_SQ;
        { const int mat = r / I_G, q = r % I_G, kb = q / 4, nb = q % 4;
            const int nblk = mat & 3, gate = (mat >> 2) & 1, d = (mat >> 3) & 1, l = mat >> 4;
            const float* src = (gate ? p->lru_w_x : p->lru_w_a) + (size_t)((l * 2 + d) * 4 + nblk) * 65536 + (size_t)kb * 64 * 256 + nb * 64;
            const int n0 = nb * 64, jh = n0 >> 7;
            bf16_t* dst = (bf16_t*)(ws + WS_LRWG) + (size_t)l * 4 * 1024 * 256 + (size_t)nblk * 1024 * 256 + (size_t)((d * 2 + jh) * 256 + gate * 128 + (n0 & 127)) * 256 + kb * 64;
            transpose_tile(src, 256, dst, 256, tile, tid); }
    }
    {
        LAS float* keysL = (LAS float*)lds;
        LAS float* wqL = (LAS float*)(lds + 128 * 132 * 4);
        for (int it = bidL; it < 1024; it += gridDim.x) {
            const int l = it >> 8, hp = (it >> 4) & 15, dt = it & 15;
            const float* kp = p->peer_keys + ((size_t)l * 16 + hp) * 16384;
#pragma unroll
            for (int q = 0; q < 8; ++q) { const int e = (tid + 512 * q) * 4; const f32x4 v = *(const f32x4*)(kp + e); *(LAS f32x4*)(keysL + (e >> 7) * 132 + (e & 127)) = v; }
            const float* wp = p->peer_w_q + (size_t)l * 1024 * 2048 + (size_t)(dt * 64) * 2048 + hp * 128;
#pragma unroll
            for (int q = 0; q < 4; ++q) { const int e = (tid + 512 * q) * 4; const f32x4 v = *(const f32x4*)(wp + (size_t)(e >> 7) * 2048 + (e & 127)); *(LAS f32x4*)(wqL + e) = v; }
            __syncthreads();
            const int key = tid & 127, g = tid >> 7;
            float acc[16];
#pragma unroll
            for (int i = 0; i < 16; ++i) acc[i] = 0.f;
            for (int d4 = 0; d4 < 128; d4 += 4) {
                const f32x4 kv = *(const LAS f32x4*)(keysL + key * 132 + d4);
#pragma unroll
                for (int i = 0; i < 16; ++i) { const f32x4 wv = *(const LAS f32x4*)(wqL + (g * 16 + i) * 128 + d4);
                    acc[i] += kv[0] * wv[0] + kv[1] * wv[1] + kv[2] * wv[2] + kv[3] * wv[3]; }
            }
            bf16_t* op = (bf16_t*)(ws + WS_WQK) + (size_t)l * 2048 * 1024 + (size_t)(hp * 128 + key) * 1024 + dt * 64 + g * 16;
            u32x4 o1, o2; o1.x = cvt_pk_bf16(acc[0], acc[1]); o1.y = cvt_pk_bf16(acc[2], acc[3]); o1.z = cvt_pk_bf16(acc[4], acc[5]); o1.w = cvt_pk_bf16(acc[6], acc[7]);
            o2.x = cvt_pk_bf16(acc[8], acc[9]); o2.y = cvt_pk_bf16(acc[10], acc[11]); o2.z = cvt_pk_bf16(acc[12], acc[13]); o2.w = cvt_pk_bf16(acc[14], acc[15]);
            *(u32x4*)op = o1; *(u32x4*)(op + 8) = o2;
            __syncthreads();
        }
    }
    {
        LAS float* condL = (LAS float*)lds;
        LAS float* red = (LAS float*)(lds + 8192);
        for (int i = tid; i < 2048; i += NTHR) condL[i] = silu_(p->c[i]);
        __syncthreads();
        for (int it = bidL; it < 4 * 48; it += gridDim.x) {
            const int l = it / 48, col0 = (it % 48) * 128;
            const float* wp = p->w_ada + (size_t)l * 1024 * 6144 + col0 + 2 * lane;
            float a00 = 0.f, a01 = 0.f, a10 = 0.f, a11 = 0.f;
#pragma unroll 8
            for (int kk = 0; kk < 128; ++kk) { const int k = wave * 128 + kk; const f32x2 w = *(const f32x2*)(wp + (size_t)k * 6144);
                const float c0 = condL[k], c1 = condL[1024 + k];
                a00 += c0 * w[0]; a01 += c0 * w[1]; a10 += c1 * w[0]; a11 += c1 * w[1]; }
            red[(wave * 2 + 0) * 128 + 2 * lane] = a00; red[(wave * 2 + 0) * 128 + 2 * lane + 1] = a01;
            red[(wave * 2 + 1) * 128 + 2 * lane] = a10; red[(wave * 2 + 1) * 128 + 2 * lane + 1] = a11;
            __syncthreads();
            if (tid < 256) { const int b = tid >> 7, cc = tid & 127; float s = 0.f;
#pragma unroll
                for (int w = 0; w < 8; ++w) s += red[(w * 2 + b) * 128 + cc];
                ((float*)(ws + WS_MOD))[((size_t)l * 2 + b) * 6144 + col0 + cc] = s + p->b_ada[(size_t)l * 6144 + col0 + cc]; }
            __syncthreads();
        }
    }
    {
        const int nw = gridDim.x * NWAVE;
        for (int row0 = bidL * NWAVE + wave; row0 < 2 * 65536; row0 += 4 * nw) {
            f32x4 v[4][4];
#pragma unroll
            for (int rr = 0; rr < 4; ++rr) { const int row = row0 + rr * nw; const int tb = row >> 16, r = row & 65535;
                const float* src = (tb ? p->peer_v : p->peer_u) + (size_t)r * 1024 + 4 * lane;
#pragma unroll
                for (int jx = 0; jx < 4; ++jx) v[rr][jx] = __builtin_nontemporal_load((const f32x4*)(src + 256 * jx)); }
#pragma unroll
            for (int rr = 0; rr < 4; ++rr) { const int row = row0 + rr * nw; const int tb = row >> 16, r = row & 65535;
                float am = 0.f;
#pragma unroll
                for (int jx = 0; jx < 4; ++jx) am = fmaxf(am, fmaxf(fmaxf(fabsf(v[rr][jx][0]), fabsf(v[rr][jx][1])), fmaxf(fabsf(v[rr][jx][2]), fabsf(v[rr][jx][3]))));
                am = wave_max(am);
                const float sc = am > 0.f ? am * (1.f / 448.f) : 1.f, inv = am > 0.f ? 448.f / am : 1.f;
                unsigned char* dst = ws + (tb ? WS_VTAB : WS_UTAB) + (size_t)r * 1024 + 4 * lane;
#pragma unroll
                for (int jx = 0; jx < 4; ++jx) { int w = __builtin_amdgcn_cvt_pk_fp8_f32(v[rr][jx][0] * inv, v[rr][jx][1] * inv, 0, false);
                    w = __builtin_amdgcn_cvt_pk_fp8_f32(v[rr][jx][2] * inv, v[rr][jx][3] * inv, w, true);
                    *(int*)(dst + 256 * jx) = w; }
                if (lane == 0) ((float*)(ws + (tb ? WS_VSC : WS_USC)))[r] = sc; }
        }
    }
}

__device__ __forceinline__ void phase_rms(const float* xin, const float* gain, const float* shift, const float* scale, bf16_t* hout) {
    LAUNDER_IDS
    const int tid = tidL, wave = tid >> 6, lane = tid & 63;
    for (int row = bidL * NWAVE + wave; row < T; row += gridDim.x * NWAVE) {
        const int b = row >> 13;
        const float* xr = xin + (size_t)row * 1024 + lane * 4;
        f32x4 v[4]; float ss = 0.f;
#pragma unroll
        for (int j = 0; j < 4; ++j) { v[j] = *(const f32x4*)(xr + j * 256); ss += v[j][0] * v[j][0] + v[j][1] * v[j][1] + v[j][2] * v[j][2] + v[j][3] * v[j][3]; }
        const float inv = __builtin_amdgcn_rsqf(wave_sum(ss) * (1.f / 1024.f) + EPS);
#pragma unroll
        for (int j = 0; j < 4; ++j) { const int col = j * 256 + lane * 4;
            const f32x4 g = *(const f32x4*)(gain + col), sh = *(const f32x4*)(shift + b * 6144 + col), sc = *(const f32x4*)(scale + b * 6144 + col);
            const f32x4 y = (v[j] * inv) * g * (1.f + sc) + sh;
            u32x2 o; o.x = cvt_pk_bf16(y[0], y[1]); o.y = cvt_pk_bf16(y[2], y[3]);
            *(u32x2*)(hout + (size_t)row * 1024 + col) = o; }
    }
}

constexpr int LROW = 136;
__device__ __forceinline__ float hg_lower_bound(const float* hg_lb, int j, int col) {
    if (j == 0) return 0.f;
    const float l0 = hg_lb[col], l1 = hg_lb[1024 + col];
    return fast_rcp(1.f + fast_exp(l0 - l1));
}
__device__ __forceinline__ f32x4 mfma16(bf16x8 a, bf16x8 b, f32x4 c) { return __builtin_amdgcn_mfma_f32_16x16x32_bf16(a, b, c, 0, 0, 0); }

__device__ __forceinline__ void load_v_regs(const bf16_t* proj, u32x4 (&vr)[4], int t0, int dir, int h, int tid) {
#pragma unroll
    for (int it = 0; it < 4; ++it) { const int idx = tid + 512 * it, tau = idx & 127, cv = idx >> 7;
        const int tok = dir ? t0 + 127 - tau : t0 + tau;
        vr[it] = *(const u32x4*)(proj + (size_t)tok * 5120 + 3072 + h * 128 + cv * 8); }
}
__device__ __forceinline__ void store_vt(LAS bf16_t* VT, const u32x4 (&vr)[4], int tid) {
#pragma unroll
    for (int it = 0; it < 4; ++it) { const int idx = tid + 512 * it, tau = idx & 127, cv = idx >> 7; const u32x4 v = vr[it];
        LAS bf16_t* d = VT + (cv * 8) * LROW + tau;
        d[0 * LROW] = (bf16_t)(v.x & 0xffff); d[1 * LROW] = (bf16_t)(v.x >> 16); d[2 * LROW] = (bf16_t)(v.y & 0xffff); d[3 * LROW] = (bf16_t)(v.y >> 16);
        d[4 * LROW] = (bf16_t)(v.z & 0xffff); d[5 * LROW] = (bf16_t)(v.z >> 16); d[6 * LROW] = (bf16_t)(v.w & 0xffff); d[7 * LROW] = (bf16_t)(v.w >> 16); }
}
__device__ __forceinline__ void load_tile_regs(const bf16_t* proj, u32x4 (&r)[4], int t0, int dir, int col0, int tid) {
#pragma unroll
    for (int it = 0; it < 4; ++it) { const int idx = tid + 512 * it, tau = idx >> 4, c16 = idx & 15;
        const int tok = dir ? t0 + 127 - tau : t0 + tau;
        r[it] = *(const u32x4*)(proj + (size_t)tok * 5120 + col0 + c16 * 8); }
}
__device__ __forceinline__ void store_tile(LAS bf16_t* TL, const u32x4 (&r)[4], int tid) {
#pragma unroll
    for (int it = 0; it < 4; ++it) { const int idx = tid + 512 * it, tau = idx >> 4, c16 = idx & 15; *(LAS u32x4*)(TL + tau * LROW + c16 * 8) = r[it]; }
}

__device__ __forceinline__ void hg_pass_a(KP p, LAS unsigned char* lds, int j) {
    LAUNDER_IDS
    const bf16_t* proj = (const bf16_t*)(p->ws + WS_PROJ);
    float* KV = (float*)(p->ws + WS_KV); float* DEC = (float*)(p->ws + WS_DEC);
    LAS bf16_t* VT = (LAS bf16_t*)lds; LAS bf16_t* KT = (LAS bf16_t*)(lds + 34816); LAS float* TOT = (LAS float*)(lds + 69632); LAS bf16_t* ZT = (LAS bf16_t*)(lds + 71680);
    for (int u = bidL; u < 2048; u += gridDim.x) {
        int tid = tidL; asm volatile("" : "+v"(tid));
        const int wave = tid >> 6, lane = tid & 63;
        const int seq = u >> 6, c = u & 63, dir = seq & 1, h = (seq >> 1) & 7, b = seq >> 4;
        const int t0 = b * SEQ + c * 128;
        const int dk = tid & 127, g = tid >> 7;
        const float lb = hg_lower_bound(p->hg_lb, j, h * 128 + dk);
        float lcs[32], kks[32]; float lc = 0.f;
        { u32x4 zr[4], vr[4];
            load_tile_regs(proj, zr, t0, dir, 1024 * (1 + dir) + h * 128, tid); load_v_regs(proj, vr, t0, dir, h, tid);
            store_tile(ZT, zr, tid); store_vt(VT, vr, tid); }
        __syncthreads();
#pragma unroll
        for (int q = 0; q < 32; ++q) { const int tau = 32 * g + q;
            const float z = bf2f(ZT[tau * LROW + dk]);
            const float f = lb + (1.f - lb) * sigmoidf_(z);
            lc += fast_log(f); lcs[q] = lc; kks[q] = 1.f - f; }
        TOT[g * 128 + dk] = lc;
        __syncthreads();
        float rg = 0.f, total = 0.f;
#pragma unroll
        for (int gg = 0; gg < 4; ++gg) { const float tv = TOT[gg * 128 + dk]; total += tv; if (gg < g) rg += tv; }
        const float base = total - rg;
#pragma unroll
        for (int q8 = 0; q8 < 4; ++q8) { unsigned w[4];
#pragma unroll
            for (int e = 0; e < 4; ++e) { const int q = q8 * 8 + e * 2;
                w[e] = cvt_pk_bf16(kks[q] * fast_exp(base - lcs[q]), kks[q + 1] * fast_exp(base - lcs[q + 1])); }
            u32x4 o; o.x = w[0]; o.y = w[1]; o.z = w[2]; o.w = w[3];
            *(LAS u32x4*)(KT + dk * LROW + 32 * g + q8 * 8) = o; }
        if (g == 0) DEC[(size_t)u * 128 + dk] = fast_exp(total);
        __syncthreads();
        f32x4 acc[2][4];
#pragma unroll
        for (int a = 0; a < 2; ++a)
#pragma unroll
            for (int bb = 0; bb < 4; ++bb) acc[a][bb] = (f32x4){0.f, 0.f, 0.f, 0.f};
        const int l15 = lane & 15, lq = lane >> 4;
#pragma unroll
        for (int ks = 0; ks < 4; ++ks) {
            bf16x8 af[2], bfr[4];
#pragma unroll
            for (int a = 0; a < 2; ++a) af[a] = *(const LAS bf16x8*)(VT + (((wave & 3) * 2 + a) * 16 + l15) * LROW + ks * 32 + lq * 8);
#pragma unroll
            for (int bb = 0; bb < 4; ++bb) bfr[bb] = *(const LAS bf16x8*)(KT + (((wave >> 2) * 4 + bb) * 16 + l15) * LROW + ks * 32 + lq * 8);
#pragma unroll
            for (int a = 0; a < 2; ++a)
#pragma unroll
                for (int bb = 0; bb < 4; ++bb) acc[a][bb] = mfma16(af[a], bfr[bb], acc[a][bb]);
        }
        float* kvp = KV + (size_t)u * 16384;
#pragma unroll
        for (int a = 0; a < 2; ++a)
#pragma unroll
            for (int bb = 0; bb < 4; ++bb)
#pragma unroll
                for (int r = 0; r < 4; ++r) kvp[(((wave & 3) * 2 + a) * 16 + lq * 4 + r) * 128 + ((wave >> 2) * 4 + bb) * 16 + l15] = acc[a][bb][r];
        __syncthreads();
    }
}

__device__ __forceinline__ void hg_pass_b(KP p) {
    LAUNDER_IDS
    const float* KV = (const float*)(p->ws + WS_KV); const float* DEC = (const float*)(p->ws + WS_DEC);
    bf16_t* SIN = (bf16_t*)(p->ws + WS_SIN);
    for (int e = bidL * NTHR + tidL; e < 131072; e += gridDim.x * NTHR) {
    const int seq = e >> 12, i4 = e & 4095, dir = seq & 1, dk = (i4 * 4) & 127;
    f32x4 S = {0.f, 0.f, 0.f, 0.f};
#pragma unroll 8
    for (int step = 0; step < 64; ++step) {
        const int c = dir ? 63 - step : step; const size_t u = (size_t)seq * 64 + c;
        const f32x4 kv = *(const f32x4*)(KV + u * 16384 + i4 * 4); const f32x4 dc = *(const f32x4*)(DEC + u * 128 + dk);
        u32x2 o; o.x = cvt_pk_bf16(S[0], S[1]); o.y = cvt_pk_bf16(S[2], S[3]);
        *(u32x2*)(SIN + u * 16384 + i4 * 4) = o;
        S = dc * S + kv;
    }
    }
}

__device__ __forceinline__ void hg_pass_c(KP p, LAS unsigned char* lds, int j) {
    LAUNDER_IDS
    const bf16_t* proj = (const bf16_t*)(p->ws + WS_PROJ);
    const bf16_t* SIN = (const bf16_t*)(p->ws + WS_SIN);
    bf16_t* OB = (bf16_t*)(p->ws + WS_OB);
    LAS bf16_t* QT = (LAS bf16_t*)lds; LAS bf16_t* QI = (LAS bf16_t*)(lds + 34816); LAS bf16_t* KT = (LAS bf16_t*)(lds + 69632);
    LAS bf16_t* VT = (LAS bf16_t*)(lds + 104448); LAS bf16_t* PI = (LAS bf16_t*)(lds + 139264); LAS float* TOT = (LAS float*)(lds + 147968);
    LAS float* OSUM = (LAS float*)(lds + 69632);
    for (int u = bidL; u < 1024; u += gridDim.x) {
        int tid = tidL; asm volatile("" : "+v"(tid));
        const int wave = tid >> 6, lane = tid & 63, l15 = lane & 15, lq = lane >> 4;
        const int c = u & 63, h = (u >> 6) & 7, b = u >> 9;
        const int t0 = b * SEQ + c * 128;
        const int dk = tid & 127, g = tid >> 7;
        const float lb = hg_lower_bound(p->hg_lb, j, h * 128 + dk);
        const int tt = wave & 1, dvt0 = (wave >> 1) * 2;
        f32x4 oacc[2][4][2];
#pragma unroll
        for (int dir = 0; dir < 2; ++dir) {
            const size_t su = ((size_t)((b * 8 + h) * 2 + dir) * 64 + c);
            unsigned k0p[16]; float lc = 0.f; float kprev = 0.f;
            u32x4 vr[4];
            { u32x4 zr[4], qr[4];
                load_tile_regs(proj, zr, t0, dir, 1024 * (1 + dir) + h * 128, tid); load_tile_regs(proj, qr, t0, dir, h * 128, tid); load_v_regs(proj, vr, t0, dir, h, tid);
                __syncthreads();
                store_tile(KT, zr, tid); store_tile(VT, qr, tid); }
            __syncthreads();
#pragma unroll
            for (int q = 0; q < 32; ++q) { const int tau = 32 * g + q;
                const float z = bf2f(KT[tau * LROW + dk]), qv = bf2f(VT[tau * LROW + dk]);
                const float f = lb + (1.f - lb) * sigmoidf_(z);
                lc += fast_log(f);
                const float el = fast_exp(fmaxf(lc, -80.f));
                QT[tau * LROW + dk] = f2bf(qv * el);
                const float kcur = (1.f - f) * fast_rcp(el);
                if (q & 1) k0p[q >> 1] = cvt_pk_bf16(kprev, kcur); else kprev = kcur; }
            TOT[g * 128 + dk] = lc;
            __syncthreads();
            float r[4]; { float run = 0.f;
#pragma unroll
                for (int gg = 0; gg < 4; ++gg) { r[gg] = run; run += TOT[gg * 128 + dk]; } }
            float rg = 0.f;
#pragma unroll
            for (int gg = 0; gg < 4; ++gg) if (gg == g) rg = r[gg];
            { const float eg = fast_exp(rg);
#pragma unroll
                for (int q = 0; q < 32; ++q) QI[(32 * g + q) * LROW + dk] = f2bf(bf2f(QT[(32 * g + q) * LROW + dk]) * eg); }
            store_vt(VT, vr, tid);
            bf16x8 sfr[2][4];
#pragma unroll
            for (int n = 0; n < 2; ++n)
#pragma unroll
                for (int ks = 0; ks < 4; ++ks) sfr[n][ks] = *(const bf16x8*)(SIN + su * 16384 + (size_t)((dvt0 + n) * 16 + l15) * 128 + ks * 32 + lq * 8);
#pragma unroll
            for (int i = 0; i < 4; ++i) {
                if (g <= i) { const float e = fast_exp(r[i] - rg);
#pragma unroll
                    for (int q = 0; q < 32; ++q) KT[(32 * g + q) * LROW + dk] = f2bf(((q & 1) ? bfhi(k0p[q >> 1]) : bflo(k0p[q >> 1])) * e); }
                __syncthreads();
                for (int tl = wave; tl < 4 * (i + 1); tl += 8) { const int sm = tl >> 1, tn = tl & 1;
                    f32x4 a4 = {0.f, 0.f, 0.f, 0.f};
#pragma unroll
                    for (int ks = 0; ks < 4; ++ks) { const bf16x8 af = *(const LAS bf16x8*)(KT + (sm * 16 + l15) * LROW + ks * 32 + lq * 8);
                        const bf16x8 bq = *(const LAS bf16x8*)(QT + (32 * i + tn * 16 + l15) * LROW + ks * 32 + lq * 8);
                        a4 = mfma16(af, bq, a4); }
                    const int tloc = tn * 16 + l15, s0 = sm * 16 + lq * 4, tg = 32 * i + tloc;
                    u32x2 o; o.x = cvt_pk_bf16(s0 + 0 <= tg ? a4[0] : 0.f, s0 + 1 <= tg ? a4[1] : 0.f); o.y = cvt_pk_bf16(s0 + 2 <= tg ? a4[2] : 0.f, s0 + 3 <= tg ? a4[3] : 0.f);
                    *(LAS u32x2*)(PI + tloc * LROW + s0) = o; }
                __syncthreads();
                f32x4 a0 = {0.f, 0.f, 0.f, 0.f}, a1 = {0.f, 0.f, 0.f, 0.f};
                for (int ks = 0; ks <= i; ++ks) { const bf16x8 af = *(const LAS bf16x8*)(PI + (tt * 16 + l15) * LROW + ks * 32 + lq * 8);
                    const bf16x8 b0 = *(const LAS bf16x8*)(VT + ((dvt0 + 0) * 16 + l15) * LROW + ks * 32 + lq * 8);
                    const bf16x8 b1 = *(const LAS bf16x8*)(VT + ((dvt0 + 1) * 16 + l15) * LROW + ks * 32 + lq * 8);
                    a0 = mfma16(af, b0, a0); a1 = mfma16(af, b1, a1); }
#pragma unroll
                for (int ks = 0; ks < 4; ++ks) { const bf16x8 af = *(const LAS bf16x8*)(QI + (32 * i + tt * 16 + l15) * LROW + ks * 32 + lq * 8);
                    a0 = mfma16(af, sfr[0][ks], a0); a1 = mfma16(af, sfr[1][ks], a1); }
                oacc[dir][i][0] = a0; oacc[dir][i][1] = a1;
            }
        }
        __syncthreads();
#pragma unroll
        for (int i = 0; i < 4; ++i)
#pragma unroll
            for (int n = 0; n < 2; ++n)
#pragma unroll
                for (int rr = 0; rr < 4; ++rr) OSUM[(32 * i + tt * 16 + lq * 4 + rr) * 132 + (dvt0 + n) * 16 + l15] = oacc[0][i][n][rr];
        __syncthreads();
#pragma unroll
        for (int i = 0; i < 4; ++i)
#pragma unroll
            for (int n = 0; n < 2; ++n)
#pragma unroll
                for (int rr = 0; rr < 4; ++rr) OSUM[(127 - (32 * i + tt * 16 + lq * 4 + rr)) * 132 + (dvt0 + n) * 16 + l15] += oacc[1][i][n][rr];
        __syncthreads();
        { const int row = tid >> 2, part = tid & 3; const int tok = t0 + row;
            float ov[32]; float ss = 0.f;
#pragma unroll
            for (int q = 0; q < 8; ++q) { const f32x4 v = *(const LAS f32x4*)(OSUM + row * 132 + part * 32 + q * 4);
                ov[q * 4 + 0] = v[0]; ov[q * 4 + 1] = v[1]; ov[q * 4 + 2] = v[2]; ov[q * 4 + 3] = v[3]; ss += v[0] * v[0] + v[1] * v[1] + v[2] * v[2] + v[3] * v[3]; }
            ss += __shfl_xor(ss, 1); ss += __shfl_xor(ss, 2);
            const float inv = __builtin_amdgcn_rsqf(ss * (1.f / 128.f) + EPS);
            const int col = h * 128 + part * 32;
            const bf16_t* gp = proj + (size_t)tok * 5120 + 4096 + col; const float* ng = p->hg_norm_g + j * 1024 + col;
#pragma unroll
            for (int q = 0; q < 4; ++q) { const u32x4 gr = *(const u32x4*)(gp + q * 8);
                const float gv[8] = {bflo(gr.x), bfhi(gr.x), bflo(gr.y), bfhi(gr.y), bflo(gr.z), bfhi(gr.z), bflo(gr.w), bfhi(gr.w)};
                float y[8];
#pragma unroll
                for (int e = 0; e < 8; ++e) y[e] = ov[q * 8 + e] * inv * ng[q * 8 + e] * silu_(gv[e]);
                u32x4 o; o.x = cvt_pk_bf16(y[0], y[1]); o.y = cvt_pk_bf16(y[2], y[3]); o.z = cvt_pk_bf16(y[4], y[5]); o.w = cvt_pk_bf16(y[6], y[7]);
                *(u32x4*)(OB + (size_t)tok * 1024 + col + q * 8) = o; }
        }
        __syncthreads();
    }
}

__device__ __forceinline__ void lru_conv(KP p, int l) {
    LAUNDER_IDS
    const bf16_t* XB = (const bf16_t*)(p->ws + WS_XB); bf16_t* XC = (bf16_t*)(p->ws + WS_XC);
    const float* cw = p->lru_conv_w + (size_t)l * 4 * 1024; const float* cb = p->lru_conv_b + (size_t)l * 1024;
    const int gs = gridDim.x * NTHR;
    for (int it = bidL * NTHR + tidL; it < T * 128; it += gs) {
        const int tok = it >> 7, c8 = (it & 127) * 8, s = tok & (SEQ - 1);
        float acc[8];
        { const f32x4 b0 = *(const f32x4*)(cb + c8), b1 = *(const f32x4*)(cb + c8 + 4);
            acc[0] = b0[0]; acc[1] = b0[1]; acc[2] = b0[2]; acc[3] = b0[3]; acc[4] = b1[0]; acc[5] = b1[1]; acc[6] = b1[2]; acc[7] = b1[3]; }
#pragma unroll
        for (int jj = 0; jj < 4; ++jj) { const int ts = s + jj - 2;
            if (ts >= 0 && ts < SEQ) { const u32x4 xr = *(const u32x4*)(XB + (size_t)(tok + jj - 2) * 1024 + c8);
                const f32x4 w0 = *(const f32x4*)(cw + jj * 1024 + c8), w1 = *(const f32x4*)(cw + jj * 1024 + c8 + 4);
                acc[0] += bflo(xr.x) * w0[0]; acc[1] += bfhi(xr.x) * w0[1]; acc[2] += bflo(xr.y) * w0[2]; acc[3] += bfhi(xr.y) * w0[3];
                acc[4] += bflo(xr.z) * w1[0]; acc[5] += bfhi(xr.z) * w1[1]; acc[6] += bflo(xr.w) * w1[2]; acc[7] += bfhi(xr.w) * w1[3]; } }
        u32x4 o; o.x = cvt_pk_bf16(acc[0], acc[1]); o.y = cvt_pk_bf16(acc[2], acc[3]); o.z = cvt_pk_bf16(acc[4], acc[5]); o.w = cvt_pk_bf16(acc[6], acc[7]);
        *(u32x4*)(XC + (size_t)tok * 1024 + c8) = o;
    }
}
__device__ __forceinline__ void lru_scan1(KP p, LAS unsigned char* lds) {
    LAUNDER_IDS
    const bf16_t* LOGA = (const bf16_t*)(p->ws + WS_LOGA); const bf16_t* BT = (const bf16_t*)(p->ws + WS_BTERM);
    float* CP = (float*)(p->ws + WS_CP); float* CH = (float*)(p->ws + WS_CH);
    LAS float* XP = (LAS float*)lds; LAS float* XH = (LAS float*)(lds + 16384);
    for (int u = bidL; u < 1024; u += gridDim.x) {
        int tid = tidL; asm volatile("" : "+v"(tid));
        const int ts = tid >> 7, c8 = (tid & 127) * 8;
        const int chunk = u & 255, dir = (u >> 8) & 1, b = u >> 9;
        const size_t base = ((size_t)dir * T + b * SEQ + chunk * 32) * 1024 + c8;
        u32x4 lw[8], bw[8];
#pragma unroll
        for (int q = 0; q < 8; ++q) { const int t = dir ? 31 - (ts * 8 + q) : ts * 8 + q; lw[q] = *(const u32x4*)(LOGA + base + (size_t)t * 1024); bw[q] = *(const u32x4*)(BT + base + (size_t)t * 1024); }
        float h[8], sl[8];
#pragma unroll
        for (int i = 0; i < 8; ++i) { h[i] = 0.f; sl[i] = 0.f; }
#pragma unroll
        for (int q = 0; q < 8; ++q) {
#pragma unroll
            for (int w = 0; w < 4; ++w) { const float l0 = bflo(lw[q][w]), l1 = bfhi(lw[q][w]);
                h[2 * w] = fast_exp(l0) * h[2 * w] + bflo(bw[q][w]); h[2 * w + 1] = fast_exp(l1) * h[2 * w + 1] + bfhi(bw[q][w]); sl[2 * w] += l0; sl[2 * w + 1] += l1; } }
        *(LAS f32x4*)(XP + ts * 1024 + c8) = (f32x4){fast_exp(sl[0]), fast_exp(sl[1]), fast_exp(sl[2]), fast_exp(sl[3])};
        *(LAS f32x4*)(XP + ts * 1024 + c8 + 4) = (f32x4){fast_exp(sl[4]), fast_exp(sl[5]), fast_exp(sl[6]), fast_exp(sl[7])};
        *(LAS f32x4*)(XH + ts * 1024 + c8) = (f32x4){h[0], h[1], h[2], h[3]}; *(LAS f32x4*)(XH + ts * 1024 + c8 + 4) = (f32x4){h[4], h[5], h[6], h[7]};
        __syncthreads();
        { const int ch = 2 * tid; float P0 = 1.f, P1 = 1.f, H0 = 0.f, H1 = 0.f;
#pragma unroll
            for (int s2 = 0; s2 < 4; ++s2) { const f32x2 pp = *(const LAS f32x2*)(XP + s2 * 1024 + ch), hh = *(const LAS f32x2*)(XH + s2 * 1024 + ch);
                H0 = pp[0] * H0 + hh[0]; H1 = pp[1] * H1 + hh[1]; P0 *= pp[0]; P1 *= pp[1]; }
            const size_t o = ((size_t)(b * 2 + dir) * 256 + chunk) * 1024 + ch;
            *(f32x2*)(CP + o) = (f32x2){P0, P1}; *(f32x2*)(CH + o) = (f32x2){H0, H1}; }
        __syncthreads();
    }
}
__device__ __forceinline__ void lru_scan2(KP p) {
    LAUNDER_IDS
    const float* CP = (const float*)(p->ws + WS_CP); const float* CH = (const float*)(p->ws + WS_CH); float* HIN = (float*)(p->ws + WS_HIN);
    const int wave = tidL >> 6, lane = tidL & 63;
    for (int item = bidL * NWAVE + wave; item < 4096; item += gridDim.x * NWAVE) {
        const int ch = item & 1023, bd = item >> 10, dir = bd & 1;
        float pp[4], hh[4]; float Pl = 1.f, Hl = 0.f;
#pragma unroll
        for (int q = 0; q < 4; ++q) { const int ci = 4 * lane + q, chunk = dir ? 255 - ci : ci; const size_t o = ((size_t)bd * 256 + chunk) * 1024 + ch;
            pp[q] = CP[o]; hh[q] = CH[o]; Hl = pp[q] * Hl + hh[q]; Pl *= pp[q]; }
#pragma unroll
        for (int off = 1; off < 64; off <<= 1) { const float Pp = __shfl_up(Pl, off), Hp = __shfl_up(Hl, off);
            if (lane >= off) { Hl = Pl * Hp + Hl; Pl = Pl * Pp; } }
        float carry = __shfl_up(Hl, 1); if (lane == 0) carry = 0.f;
#pragma unroll
        for (int q = 0; q < 4; ++q) { const int ci = 4 * lane + q, chunk = dir ? 255 - ci : ci; const size_t o = ((size_t)bd * 256 + chunk) * 1024 + ch;
            HIN[o] = carry; carry = pp[q] * carry + hh[q]; }
    }
}
__device__ __forceinline__ void lru_scan3(KP p, LAS unsigned char* lds) {
    LAUNDER_IDS
    const bf16_t* LOGA = (const bf16_t*)(p->ws + WS_LOGA); const bf16_t* BT = (const bf16_t*)(p->ws + WS_BTERM); const bf16_t* YG = (const bf16_t*)(p->ws + WS_YG);
    const float* HIN = (const float*)(p->ws + WS_HIN); bf16_t* OB = (bf16_t*)(p->ws + WS_OB);
    LAS float* XP = (LAS float*)lds; LAS float* XH = (LAS float*)(lds + 16384);
    for (int u = bidL; u < 512; u += gridDim.x) {
        int tid = tidL; asm volatile("" : "+v"(tid));
        const int ts = tid >> 7, c8 = (tid & 127) * 8;
        const int chunk = u & 255, b = u >> 8;
        const size_t base = ((size_t)b * SEQ + chunk * 32 + ts * 8) * 1024 + c8;
        unsigned hsp[8][4];
#pragma unroll
        for (int dir = 0; dir < 2; ++dir) {
            u32x4 lw[8], bw[8];
#pragma unroll
            for (int q = 0; q < 8; ++q) { lw[q] = *(const u32x4*)(LOGA + (size_t)dir * T * 1024 + base + (size_t)q * 1024); bw[q] = *(const u32x4*)(BT + (size_t)dir * T * 1024 + base + (size_t)q * 1024); }
            const f32x4 hi0 = *(const f32x4*)(HIN + ((size_t)(b * 2 + dir) * 256 + chunk) * 1024 + c8), hi1 = *(const f32x4*)(HIN + ((size_t)(b * 2 + dir) * 256 + chunk) * 1024 + c8 + 4);
            float h[8], sl[8];
#pragma unroll
            for (int i = 0; i < 8; ++i) { h[i] = 0.f; sl[i] = 0.f; }
#pragma unroll
            for (int qq = 0; qq < 8; ++qq) { const int q = dir ? 7 - qq : qq;
#pragma unroll
                for (int w = 0; w < 4; ++w) { const float l0 = bflo(lw[q][w]), l1 = bfhi(lw[q][w]);
                    h[2 * w] = fast_exp(l0) * h[2 * w] + bflo(bw[q][w]); h[2 * w + 1] = fast_exp(l1) * h[2 * w + 1] + bfhi(bw[q][w]); sl[2 * w] += l0; sl[2 * w + 1] += l1; } }
            __syncthreads();
            *(LAS f32x4*)(XP + ts * 1024 + c8) = (f32x4){fast_exp(sl[0]), fast_exp(sl[1]), fast_exp(sl[2]), fast_exp(sl[3])};
            *(LAS f32x4*)(XP + ts * 1024 + c8 + 4) = (f32x4){fast_exp(sl[4]), fast_exp(sl[5]), fast_exp(sl[6]), fast_exp(sl[7])};
            *(LAS f32x4*)(XH + ts * 1024 + c8) = (f32x4){h[0], h[1], h[2], h[3]}; *(LAS f32x4*)(XH + ts * 1024 + c8 + 4) = (f32x4){h[4], h[5], h[6], h[7]};
            __syncthreads();
            h[0] = hi0[0]; h[1] = hi0[1]; h[2] = hi0[2]; h[3] = hi0[3]; h[4] = hi1[0]; h[5] = hi1[1]; h[6] = hi1[2]; h[7] = hi1[3];
#pragma unroll
            for (int s3 = 0; s3 < 3; ++s3) { const int sr = dir ? 3 - s3 : s3; const bool use = dir ? (sr > ts) : (sr < ts);
                const f32x4 p0 = *(const LAS f32x4*)(XP + sr * 1024 + c8), p1 = *(const LAS f32x4*)(XP + sr * 1024 + c8 + 4), q0 = *(const LAS f32x4*)(XH + sr * 1024 + c8), q1 = *(const LAS f32x4*)(XH + sr * 1024 + c8 + 4);
                if (use) { h[0] = p0[0] * h[0] + q0[0]; h[1] = p0[1] * h[1] + q0[1]; h[2] = p0[2] * h[2] + q0[2]; h[3] = p0[3] * h[3] + q0[3];
                    h[4] = p1[0] * h[4] + q1[0]; h[5] = p1[1] * h[5] + q1[1]; h[6] = p1[2] * h[6] + q1[2]; h[7] = p1[3] * h[7] + q1[3]; } }
#pragma unroll
            for (int qq = 0; qq < 8; ++qq) { const int q = dir ? 7 - qq : qq;
                u32x4 yw; if (dir) yw = *(const u32x4*)(YG + base + (size_t)q * 1024);
                unsigned ow[4];
#pragma unroll
                for (int w = 0; w < 4; ++w) { h[2 * w] = fast_exp(bflo(lw[q][w])) * h[2 * w] + bflo(bw[q][w]); h[2 * w + 1] = fast_exp(bfhi(lw[q][w])) * h[2 * w + 1] + bfhi(bw[q][w]);
                    if (dir == 0) hsp[q][w] = cvt_pk_bf16(h[2 * w], h[2 * w + 1]);
                    else ow[w] = cvt_pk_bf16((bflo(hsp[q][w]) + h[2 * w]) * bflo(yw[w]), (bfhi(hsp[q][w]) + h[2 * w + 1]) * bfhi(yw[w])); }
                if (dir) *(u32x4*)(OB + base + (size_t)q * 1024) = (u32x4){ow[0], ow[1], ow[2], ow[3]}; }
        }
        __syncthreads();
    }
}

__device__ const unsigned char STAIR[64] = {
    0x00, 0x01, 0x02, 0x03, 0x04, 0x05, 0x06, 0x07, 0x08, 0x09, 0x0a, 0x0b, 0x0c, 0x0d, 0x0e, 0x0f,
    0x10, 0x11, 0x12, 0x13, 0x14, 0x15, 0x16, 0x17, 0x20, 0x21, 0x22, 0x23, 0x24, 0x30, 0x31, 0x32,
    0x33, 0x40, 0x41, 0x42, 0x50, 0x51, 0x60, 0x61, 0x70, 0x71, 0x80, 0x90, 0xa0, 0xb0, 0xc0, 0xd0,
    0xe0, 0xf0, 0, 0, 0, 0, 0, 0, 0, 0, 0, 0, 0, 0, 0, 0};
__device__ __forceinline__ unsigned mono_key(float f) { const unsigned b = __float_as_uint(f); return b ^ ((b >> 31) ? 0xffffffffu : 0x80000000u); }

__device__ __forceinline__ float inv_mono(unsigned k) { return __uint_as_float(k ^ ((k >> 31) ? 0x80000000u : 0xffffffffu)); }
#define TK_INSERT(L, x) do { _Pragma("unroll") for (int q_ = 0; q_ < 16; ++q_) { const unsigned hi_ = max(L[q_], x); x = min(L[q_], x); L[q_] = hi_; } } while (0)
__device__ __forceinline__ void peer_topk(KP p, LAS unsigned char* lds) {
    LAUNDER_IDS
    (void)bidL;
    const int tid = tidL, wave = tid >> 6, lane = tid & 63;
    const float* SCT = (const float*)(p->ws + WS_SCORES);
    int* TOPI = (int*)(p->ws + WS_TOPI); float* TOPG = (float*)(p->ws + WS_TOPG);
    LAS unsigned char* IX = lds + wave * 2048 + lane * 32;
    for (int item = bidL * NWAVE + wave; item < 2048; item += gridDim.x * NWAVE) {
        const int tg = item >> 3, hd = item & 7, tok = tg * 64 + lane;
        float V[2][16];
#pragma unroll
        for (int half = 0; half < 2; ++half) {
            unsigned L[16];
#pragma unroll
            for (int q = 0; q < 16; ++q) L[q] = 0u;
            const float* sc = SCT + (size_t)(hd * 256 + half * 128) * T + tok;
            float cur[16], nxt[16];
#pragma unroll
            for (int i = 0; i < 16; ++i) cur[i] = sc[(size_t)i * T];
#pragma unroll 1
            for (int kb = 0; kb < 8; ++kb) {
                const int kn = kb < 7 ? kb + 1 : kb;
#pragma unroll
                for (int i = 0; i < 16; ++i) nxt[i] = sc[(size_t)(kn * 16 + i) * T];
#pragma unroll
                for (int i = 0; i < 16; ++i) { unsigned x = (mono_key(cur[i]) & ~0x7fu) | (unsigned)(kb * 16 + i); TK_INSERT(L, x); }
#pragma unroll
                for (int i = 0; i < 16; ++i) cur[i] = nxt[i];
            }
            u32x4 w0, w1;
            w0.x = (L[0] & 0x7f) | ((L[1] & 0x7f) << 8) | ((L[2] & 0x7f) << 16) | ((L[3] & 0x7f) << 24); w0.y = (L[4] & 0x7f) | ((L[5] & 0x7f) << 8) | ((L[6] & 0x7f) << 16) | ((L[7] & 0x7f) << 24);
            w0.z = (L[8] & 0x7f) | ((L[9] & 0x7f) << 8) | ((L[10] & 0x7f) << 16) | ((L[11] & 0x7f) << 24); w0.w = (L[12] & 0x7f) | ((L[13] & 0x7f) << 8) | ((L[14] & 0x7f) << 16) | ((L[15] & 0x7f) << 24);
            *(LAS u32x4*)(IX + half * 16) = w0;
#pragma unroll
            for (int q = 0; q < 16; ++q) V[half][q] = inv_mono(L[q]);
        }
        unsigned C[16];
#pragma unroll
        for (int q = 0; q < 16; ++q) C[q] = 0u;
#pragma unroll
        for (int i = 0; i < 16; ++i)
#pragma unroll
            for (int jj = 0; jj < 16; ++jj) if ((i + 1) * (jj + 1) <= 16) { unsigned x = (mono_key(V[0][i] + V[1][jj]) & ~0xffu) | (unsigned)(i * 16 + jj); TK_INSERT(C, x); }
        asm volatile("s_waitcnt lgkmcnt(0)" ::: "memory");
        const float s0 = inv_mono(C[0] & ~0xffu);
        float e[16]; float sum = 0.f; int ids[16];
#pragma unroll
        for (int q = 0; q < 16; ++q) { e[q] = fast_exp(inv_mono(C[q] & ~0xffu) - s0); sum += e[q];
            const unsigned code = C[q] & 0xffu; ids[q] = (int)IX[code >> 4] * 128 + (int)IX[16 + (code & 15u)]; }
        const float rs = fast_rcp(sum);
        int* ip = TOPI + (size_t)tok * 128 + hd * 16; float* gp = TOPG + (size_t)tok * 128 + hd * 16;
#pragma unroll
        for (int q = 0; q < 4; ++q) { *(u32x4*)(ip + 4 * q) = (u32x4){(unsigned)ids[4 * q], (unsigned)ids[4 * q + 1], (unsigned)ids[4 * q + 2], (unsigned)ids[4 * q + 3]};
            *(f32x4*)(gp + 4 * q) = (f32x4){e[4 * q] * rs, e[4 * q + 1] * rs, e[4 * q + 2] * rs, e[4 * q + 3] * rs}; }
        asm volatile("s_waitcnt lgkmcnt(0)" ::: "memory");
    }
}

__device__ __forceinline__ void peer_gather(KP p, int l, bool dry) {
    LAUNDER_IDS
    const int wave = tidL >> 6, lane = tidL & 63;
    const bf16_t* HB = (const bf16_t*)(p->ws + WS_HBUF); bf16_t* HBW = (bf16_t*)(p->ws + WS_HBUF);
    const int* TOPI = (const int*)(p->ws + WS_TOPI); const float* TOPG = (const float*)(p->ws + WS_TOPG);
    const unsigned char* U8 = p->ws + WS_UTAB + (size_t)l * 16384 * 1024 + 16 * lane; const unsigned char* V8 = p->ws + WS_VTAB + (size_t)l * 16384 * 1024 + 16 * lane;
    const float* USC = (const float*)(p->ws + WS_USC) + l * 16384; const float* VSC = (const float*)(p->ws + WS_VSC) + l * 16384;
    float* XRES = (float*)(p->ws + WS_XRES); const float* MOD = (const float*)(p->ws + WS_MOD);
    for (int tok = bidL * NWAVE + wave; tok < T; tok += gridDim.x * NWAVE) {
        const int b = tok >> 13;
        f32x2 hv2[8];
        { const u32x4 h0 = *(const u32x4*)(HB + (size_t)tok * 1024 + 16 * lane), h1 = *(const u32x4*)(HB + (size_t)tok * 1024 + 16 * lane + 8);
            hv2[0] = (f32x2){bflo(h0.x), bfhi(h0.x)}; hv2[1] = (f32x2){bflo(h0.y), bfhi(h0.y)}; hv2[2] = (f32x2){bflo(h0.z), bfhi(h0.z)}; hv2[3] = (f32x2){bflo(h0.w), bfhi(h0.w)};
            hv2[4] = (f32x2){bflo(h1.x), bfhi(h1.x)}; hv2[5] = (f32x2){bflo(h1.y), bfhi(h1.y)}; hv2[6] = (f32x2){bflo(h1.z), bfhi(h1.z)}; hv2[7] = (f32x2){bflo(h1.w), bfhi(h1.w)}; }
        const int id0 = TOPI[(size_t)tok * 128 + lane], id1 = TOPI[(size_t)tok * 128 + 64 + lane];
        const float g0 = TOPG[(size_t)tok * 128 + lane], g1 = TOPG[(size_t)tok * 128 + 64 + lane];
        f32x2 acc2[8];
#pragma unroll
        for (int i = 0; i < 8; ++i) acc2[i] = (f32x2){0.f, 0.f};
#pragma unroll 1
        for (int e0 = 0; e0 < 128; e0 += 8) {
            u32x4 uq[8], vq[8]; float gk[8], su[8], sv[8];
#pragma unroll
            for (int k = 0; k < 8; ++k) { const int e = e0 + k;
                int id = __builtin_amdgcn_readlane(e0 < 64 ? id0 : id1, e & 63);
                id &= 16383;
                gk[k] = __uint_as_float(__builtin_amdgcn_readlane(__float_as_uint(e0 < 64 ? g0 : g1), e & 63));
                uq[k] = *(const u32x4*)(U8 + (size_t)id * 1024); vq[k] = *(const u32x4*)(V8 + (size_t)id * 1024);
                su[k] = USC[id]; sv[k] = VSC[id]; }
            float d[8];
#pragma unroll
            for (int k = 0; k < 8; ++k) { f32x2 s2 = (f32x2){0.f, 0.f};
#pragma unroll
                for (int w = 0; w < 4; ++w) { const f32x2 lo = __builtin_amdgcn_cvt_pk_f32_fp8((int)uq[k][w], false), hi = __builtin_amdgcn_cvt_pk_f32_fp8((int)uq[k][w], true);
                    s2 = lo * hv2[2 * w] + s2; s2 = hi * hv2[2 * w + 1] + s2; }
                d[k] = s2[0] + s2[1]; }
            const bool b32 = lane & 32, b16 = lane & 16, b8 = lane & 8;
            float d4[4], d2[2], r;
#pragma unroll
            for (int k = 0; k < 4; ++k) { const float recv = __shfl_xor(b32 ? d[k] : d[k + 4], 32); d4[k] = (b32 ? d[k + 4] : d[k]) + recv; }
#pragma unroll
            for (int k = 0; k < 2; ++k) { const float recv = __shfl_xor(b16 ? d4[k] : d4[k + 2], 16); d2[k] = (b16 ? d4[k + 2] : d4[k]) + recv; }
            { const float recv = __shfl_xor(b8 ? d2[0] : d2[1], 8); r = (b8 ? d2[1] : d2[0]) + recv; }
            r += __shfl_xor(r, 4); r += __shfl_xor(r, 2); r += __shfl_xor(r, 1);
#pragma unroll
            for (int k = 0; k < 8; ++k) { const float dot = __uint_as_float(__builtin_amdgcn_readlane(__float_as_uint(r), ((k >> 2) & 1) * 32 + ((k >> 1) & 1) * 16 + (k & 1) * 8));
                const float cf = gk[k] * gelu_tanh(dot * su[k]) * sv[k]; const f32x2 cf2 = (f32x2){cf, cf};
#pragma unroll
                for (int w = 0; w < 4; ++w) { const f32x2 lo = __builtin_amdgcn_cvt_pk_f32_fp8((int)vq[k][w], false), hi = __builtin_amdgcn_cvt_pk_f32_fp8((int)vq[k][w], true);
                    acc2[2 * w] = lo * cf2 + acc2[2 * w]; acc2[2 * w + 1] = hi * cf2 + acc2[2 * w + 1]; } }
        }
        const float* g2 = MOD + ((size_t)l * 2 + b) * 6144 + 5 * 1024 + 16 * lane;
        float* xrow = XRES + (size_t)tok * 1024 + 16 * lane;
        float xn[16]; float ss = 0.f;
#pragma unroll
        for (int q = 0; q < 4; ++q) { const f32x4 xr = *(const f32x4*)(xrow + 4 * q), gg = *(const f32x4*)(g2 + 4 * q);
            const float a0 = acc2[2 * q][0], a1 = acc2[2 * q][1], a2 = acc2[2 * q + 1][0], a3 = acc2[2 * q + 1][1];
            xn[4 * q + 0] = xr[0] + gg[0] * a0; xn[4 * q + 1] = xr[1] + gg[1] * a1; xn[4 * q + 2] = xr[2] + gg[2] * a2; xn[4 * q + 3] = xr[3] + gg[3] * a3; }
#pragma unroll
        for (int i = 0; i < 16; ++i) ss += xn[i] * xn[i];
        const float inv = __builtin_amdgcn_rsqf(wave_sum(ss) * (1.f / 1024.f) + EPS);
        if (dry) { if (inv == 123.456f) p->out[tok] = inv; continue; }
        if (l < DEPTH - 1) {
            const float* gain = p->norm_g + (size_t)(l + 1) * 2 * 1024 + 16 * lane; const float* sh = MOD + ((size_t)(l + 1) * 2 + b) * 6144 + 16 * lane; const float* sc = sh + 1024;
            float y[16];
#pragma unroll
            for (int q = 0; q < 4; ++q) { const f32x4 gn = *(const f32x4*)(gain + 4 * q), s1 = *(const f32x4*)(sh + 4 * q), c1 = *(const f32x4*)(sc + 4 * q);
                *(f32x4*)(xrow + 4 * q) = (f32x4){xn[4 * q], xn[4 * q + 1], xn[4 * q + 2], xn[4 * q + 3]};
#pragma unroll
                for (int i = 0; i < 4; ++i) y[4 * q + i] = (xn[4 * q + i] * inv) * gn[i] * (1.f + c1[i]) + s1[i]; }
            u32x4 o0, o1; o0.x = cvt_pk_bf16(y[0], y[1]); o0.y = cvt_pk_bf16(y[2], y[3]); o0.z = cvt_pk_bf16(y[4], y[5]); o0.w = cvt_pk_bf16(y[6], y[7]);
            o1.x = cvt_pk_bf16(y[8], y[9]); o1.y = cvt_pk_bf16(y[10], y[11]); o1.z = cvt_pk_bf16(y[12], y[13]); o1.w = cvt_pk_bf16(y[14], y[15]);
            *(u32x4*)(HBW + (size_t)tok * 1024 + 16 * lane) = o0; *(u32x4*)(HBW + (size_t)tok * 1024 + 16 * lane + 8) = o1;
        } else {
            const float* fg = p->final_g + 16 * lane; float* orow = p->out + (size_t)tok * 1024 + 16 * lane;
#pragma unroll
            for (int q = 0; q < 4; ++q) { const f32x4 gn = *(const f32x4*)(fg + 4 * q); f32x4 o;
#pragma unroll
                for (int i = 0; i < 4; ++i) o[i] = (xn[4 * q + i] * inv) * gn[i];
                *(f32x4*)(orow + 4 * q) = o; }
        }
    }
}

#define XB_TMO      128
#define XB_XCNT(j)  (256  + 64 * (j))
#define XB_XSUB(j)  (1280 + 64 * (j))
#define XB_XGEN(j)  (2304 + 64 * (j))
#define XB_TOP      3328
#define XB_TOPGEN   3392
#define XCD_BAR_WORDS 3456
#define XB_SPIN_CAP (1u << 18)

__device__ __forceinline__ unsigned xb_ld(unsigned* p)              { return __hip_atomic_load(p, __ATOMIC_RELAXED, __HIP_MEMORY_SCOPE_AGENT); }
__device__ __forceinline__ unsigned xb_add(unsigned* p, unsigned v) { return __hip_atomic_fetch_add(p, v, __ATOMIC_RELAXED, __HIP_MEMORY_SCOPE_AGENT); }
__device__ __forceinline__ unsigned xb_xcc_id() { return (unsigned)__builtin_amdgcn_s_getreg((3 << 11) | 20) & 0xFu; }
#define XB_SPIN(cond, bar) do { unsigned _sp = 0; while (cond) { __builtin_amdgcn_s_sleep(1); \
    if ((++_sp & 255u) == 0u) { if (xb_ld(&(bar)[XB_TMO])) break; if (_sp > XB_SPIN_CAP) { atomicAdd(&(bar)[XB_TMO], 1u); break; } } } } while (0)

struct XcdBarrier {
    unsigned* bar; unsigned x;
    volatile LAS unsigned* st;
};

__device__ __forceinline__ XcdBarrier xcd_barrier_post(unsigned* bar, volatile LAS unsigned* st) {
    XcdBarrier b; b.bar = bar; b.x = xb_xcc_id(); b.st = st;
    if (threadIdx.x == 0) (void)xb_add(&bar[XB_XCNT(b.x)], 1u);
    return b;
}
__device__ __forceinline__ void xcd_barrier_complete(unsigned* bar, unsigned x, unsigned& nloc, unsigned& nx) {
    const unsigned G = gridDim.x * gridDim.y * gridDim.z;
    unsigned sum, cnt, mine, sp = 0u;
    for (;;) {
        sum = 0u; cnt = 0u; mine = 0u;
#pragma unroll
        for (unsigned j = 0; j < 16; ++j) { const unsigned c = xb_ld(&bar[XB_XCNT(j)]); sum += c; cnt += (c > 0u) ? 1u : 0u; mine = (j == x) ? c : mine; }
        if (sum == G) break;
        __builtin_amdgcn_s_sleep(1);
        if ((++sp & 255u) == 0u) { if (xb_ld(&bar[XB_TMO])) break; if (sp > XB_SPIN_CAP) { atomicAdd(&bar[XB_TMO], 1u); break; } }
    }
    nloc = mine > 0u ? mine : 1u; nx = cnt > 0u ? cnt : 1u;
}

__device__ __forceinline__ void xcd_barrier(const XcdBarrier& b) {
    asm volatile("s_waitcnt vmcnt(0)" ::: "memory");
    __syncthreads();
    if (threadIdx.x == 0) {
        unsigned* bar = b.bar;
        __builtin_amdgcn_s_waitcnt(0);
        unsigned nloc = b.st[0], nx = b.st[1];
        if (nloc == 0u) { xcd_barrier_complete(bar, b.x, nloc, nx); b.st[0] = nloc; b.st[1] = nx; }
        const unsigned old = xb_add(&bar[XB_XSUB(b.x)], 1u);
        const unsigned gen = old / nloc;
        if (old + 1u == (gen + 1u) * nloc) {
            __builtin_amdgcn_fence(__ATOMIC_RELEASE, "agent");
            asm volatile("s_waitcnt vmcnt(0)" ::: "memory");
            const unsigned og = xb_add(&bar[XB_TOP], 1u);
            const unsigned tg = og / nx;
            if (og + 1u == (tg + 1u) * nx) xb_add(&bar[XB_TOPGEN], 1u);
            else XB_SPIN(xb_ld(&bar[XB_TOPGEN]) == tg, bar);
            __builtin_amdgcn_fence(__ATOMIC_ACQUIRE, "agent");
            xb_add(&bar[XB_XGEN(b.x)], 1u);
            asm volatile("s_waitcnt vmcnt(0)" ::: "memory");
        } else {
            XB_SPIN(xb_ld(&bar[XB_XGEN(b.x)]) == gen, bar);
            __builtin_amdgcn_fence(__ATOMIC_ACQUIRE, "agent");
            asm volatile("s_waitcnt vmcnt(0)" ::: "memory");
        }
    }
    __syncthreads();
}

#ifndef OPMASK
#define OPMASK 0xFFFFFFFFu
#endif
#define EN(o) ((OPMASK >> (o)) & 1u)
enum { OP_P0 = 0, OP_RMS1, OP_HG_IN, OP_HG_A, OP_HG_B, OP_HG_C, OP_MIX_OUT, OP_LR_IN, OP_LR_CONV, OP_LR_G, OP_LR_S1, OP_LR_S2, OP_LR_S3, OP_RMS2, OP_QK, OP_TOPK, OP_GATHER };
constexpr int NPH = 42;
#define REP_MASK 0u
__device__ __forceinline__ void decode_phase(int ph, int& l, int& op) {
    if (ph == 0) { l = 0; op = OP_P0; return; }
    if (ph == 1) { l = 0; op = OP_RMS1; return; }
    int q = ph - 2;
    if (q < 9) { l = 0; } else if (q < 20) { l = 1; q -= 9; } else if (q < 29) { l = 2; q -= 20; } else { l = 3; q -= 29; }
    if ((l & 1) == 0) { op = q == 0 ? OP_HG_IN : q == 1 ? OP_HG_A : q == 2 ? OP_HG_B : q == 3 ? OP_HG_C : q == 4 ? OP_MIX_OUT : q == 5 ? OP_RMS2 : q == 6 ? OP_QK : q == 7 ? OP_TOPK : OP_GATHER; }
    else { op = q == 0 ? OP_LR_IN : q == 1 ? OP_LR_CONV : q == 2 ? OP_LR_G : q == 3 ? OP_LR_S1 : q == 4 ? OP_LR_S2 : q == 5 ? OP_LR_S3 : q == 6 ? OP_MIX_OUT : q == 7 ? OP_RMS2 : q == 8 ? OP_QK : q == 9 ? OP_TOPK : OP_GATHER; }
}

__global__ __launch_bounds__(512, 2) void mk_fwd(Params p_arg) {
    extern __shared__ __attribute__((aligned(16))) unsigned char shm[];
    LAS unsigned char* lds = (LAS unsigned char*)shm;
    cg::grid_group grid = cg::this_grid();
    unsigned long long kpv = (unsigned long long)__builtin_amdgcn_kernarg_segment_ptr();
    const int ph_lo = p_arg.ph_lo, ph_hi = p_arg.ph_hi;
    volatile LAS unsigned* xst = (volatile LAS unsigned*)(lds + LDS_BYTES - 16);
    if (threadIdx.x == 0) { xst[0] = 0u; xst[1] = 0u; }
    __syncthreads();
    const XcdBarrier xb = xcd_barrier_post((unsigned*)(p_arg.ws + WS_CTL) + 1024, xst);
    for (int ph = ph_lo; ph < ph_hi; ++ph) {
        if (ph > ph_lo) { if (ph == 1) grid.sync(); else xcd_barrier(xb); }
        asm volatile("" : "+s"(kpv));
        KP p = (KP)kpv;
        unsigned char* ws = p->ws;
        const float* MOD = (const float*)(ws + WS_MOD);
        int l, op; decode_phase(ph, l, op);
        const int j = l >> 1;
        const int nrep = ((p->rep_mask >> op) & 1u) ? 2 : 1;
        for (int rep = 0; rep < nrep; ++rep) {
        const bool dry = rep + 1 < nrep;
#ifdef ONLY
        switch (ONLY) {
#else
        switch (op) {
#endif
        case OP_P0: if (EN(OP_P0)) phase0(p, lds); break;
        case OP_RMS1: if (EN(OP_RMS1)) phase_rms(p->x, p->norm_g, MOD, MOD + 1024, (bf16_t*)(ws + WS_HBUF)); break;
        case OP_HG_IN: if (EN(OP_HG_IN)) { EpiBf16 E; E.O = (bf16_t*)(ws + WS_PROJ); E.ldc = 5120;
            run_gemm(lds, (const bf16_t*)(ws + WS_HBUF), (const bf16_t*)(ws + WS_HGWIN) + (size_t)j * 5120 * 1024, 5120, 1024, 1024, 1024, 0, 0, E); } break;
        case OP_HG_A: if (EN(OP_HG_A)) hg_pass_a(p, lds, j); break;
        case OP_HG_B: if (EN(OP_HG_B)) hg_pass_b(p); break;
        case OP_HG_C: if (EN(OP_HG_C)) hg_pass_c(p, lds, j); break;
        case OP_MIX_OUT: if (EN(OP_MIX_OUT)) { EpiResid E; E.xin = (l == 0) ? p->x : (const float*)(ws + WS_XRES); E.xout = (float*)(ws + WS_XRES); E.gate = MOD + (size_t)l * 2 * 6144 + 2 * 1024; E.dry = dry;
            const bf16_t* W = (l & 1) ? (const bf16_t*)(ws + WS_LRWOUT) + (size_t)j * 1024 * 1024 : (const bf16_t*)(ws + WS_HGWOUT) + (size_t)j * 1024 * 1024;
            run_gemm(lds, (const bf16_t*)(ws + WS_OB), W, 1024, 1024, 1024, 1024, 0, 0, E); } break;
        case OP_LR_IN: if (EN(OP_LR_IN)) { EpiLruIn E; E.XB = (bf16_t*)(ws + WS_XB); E.YG = (bf16_t*)(ws + WS_YG);
            run_gemm(lds, (const bf16_t*)(ws + WS_HBUF), (const bf16_t*)(ws + WS_LRWIN) + (size_t)j * 2048 * 1024, 2048, 1024, 1024, 1024, 0, 0, E); } break;
        case OP_LR_CONV: if (EN(OP_LR_CONV)) lru_conv(p, j); break;
        case OP_LR_G: if (EN(OP_LR_G)) { EpiGates E; E.LOGA = (bf16_t*)(ws + WS_LOGA); E.BTERM = (bf16_t*)(ws + WS_BTERM); E.XC = (const bf16_t*)(ws + WS_XC);
            E.b_a = p->lru_b_a + (size_t)j * 2048; E.b_x = p->lru_b_x + (size_t)j * 2048; E.lam = p->lru_lam + (size_t)j * 2048;
            run_gemm(lds, (const bf16_t*)(ws + WS_XC), (const bf16_t*)(ws + WS_LRWG) + (size_t)j * 4 * 1024 * 256, 4096, 256, 1024, 256, 2, 512, E); } break;
        case OP_LR_S1: if (EN(OP_LR_S1)) lru_scan1(p, lds); break;
        case OP_LR_S2: if (EN(OP_LR_S2)) lru_scan2(p); break;
        case OP_LR_S3: if (EN(OP_LR_S3)) lru_scan3(p, lds); break;
        case OP_RMS2: if (EN(OP_RMS2)) phase_rms((const float*)(ws + WS_XRES), p->norm_g + ((size_t)l * 2 + 1) * 1024, MOD + (size_t)l * 2 * 6144 + 3 * 1024, MOD + (size_t)l * 2 * 6144 + 4 * 1024, (bf16_t*)(ws + WS_HBUF)); break;
        case OP_QK: if (EN(OP_QK)) { EpiScoresT E; E.C = (float*)(ws + WS_SCORES);
            run_gemm(lds, (const bf16_t*)(ws + WS_HBUF), (const bf16_t*)(ws + WS_WQK) + (size_t)l * 2048 * 1024, 2048, 1024, 1024, 1024, 0, 0, E); } break;
        case OP_TOPK: if (EN(OP_TOPK)) peer_topk(p, lds); break;
        case OP_GATHER: if (EN(OP_GATHER)) peer_gather(p, l, dry); break;
        default: break;
        }
        }
    }
}

extern "C" void kernel_launch(void* const* d_in, const int* in_sizes, int n_in, void* d_out, int out_size, void* d_ws, size_t ws_size, hipStream_t stream) {
    static int grid = 0;
    if (grid == 0) {
        if (n_in != 23 || ws_size < WS_END) { fprintf(stderr, "kernel_launch: unexpected n_in %d / ws_size %zu (need %zu)\n", n_in, ws_size, (size_t)WS_END); grid = -1; return; }
        int dev = 0, cus = 0, per_cu = 0;
        hipGetDevice(&dev); hipDeviceGetAttribute(&cus, hipDeviceAttributeMultiprocessorCount, dev);
        if (hipFuncSetAttribute((const void*)mk_fwd, hipFuncAttributeMaxDynamicSharedMemorySize, LDS_BYTES) != hipSuccess) { fprintf(stderr, "kernel_launch: hipFuncSetAttribute failed\n"); grid = -1; return; }
        if (hipOccupancyMaxActiveBlocksPerMultiprocessor(&per_cu, (const void*)mk_fwd, NTHR, LDS_BYTES) != hipSuccess || per_cu < 1) { fprintf(stderr, "kernel_launch: occupancy query failed (%d)\n", per_cu); (void)hipGetLastError(); per_cu = 1; }
        grid = cus * 1;
        fprintf(stderr, "kernel_launch: cus %d per_cu %d grid %d\n", cus, per_cu, grid);
    }
    if (grid < 0) return;
    if (hipMemsetAsync((char*)d_ws + WS_CTL, 0, 65536, stream) != hipSuccess) { fprintf(stderr, "kernel_launch: memset failed\n"); return; }
    Params p{};
    const float** pp = (const float**)&p;
    for (int i = 0; i < 23; ++i) pp[i] = (const float*)d_in[i];
    p.out = (float*)d_out; p.ws = (unsigned char*)d_ws; p.ph_lo = 0; p.ph_hi = NPH; p.rep_mask = REP_MASK;
    void* args[] = {&p};
    hipError_t e = hipLaunchCooperativeKernel((const void*)mk_fwd, dim3(grid), dim3(NTHR), args, LDS_BYTES, stream);
    if (e != hipSuccess) fprintf(stderr, "kernel_launch: cooperative launch failed: %s (grid %d)\n", hipGetErrorString(e), grid);
}
```

```cpp
#include <hip/hip_runtime.h>
#include <hip/hip_cooperative_groups.h>
#include <cstdio>
#include <cstdint>
namespace cg = cooperative_groups;

#define LAS __attribute__((address_space(3)))
#define PG8_LAS __attribute__((address_space(3)))
typedef unsigned short bf16_t;
typedef short bf16x8 __attribute__((ext_vector_type(8)));
typedef float f32x4 __attribute__((ext_vector_type(4)));
typedef float f32x2 __attribute__((ext_vector_type(2)));
typedef unsigned u32x4 __attribute__((ext_vector_type(4)));
typedef unsigned u32x2 __attribute__((ext_vector_type(2)));

constexpr int T = 16384, D = 1024, SEQ = 8192, DEPTH = 4;
constexpr float EPS = 1e-6f;
constexpr int NBLK = 256, NTHR = 512, NWAVE = 8, NGW = NBLK * NWAVE;

constexpr size_t MiB = 1u << 20;
constexpr size_t WS_CTL = 0;
constexpr size_t WS_MOD = 1 * MiB;
constexpr size_t WS_HGWIN = 2 * MiB;
constexpr size_t WS_HGWOUT = 22 * MiB;
constexpr size_t WS_LRWIN = 26 * MiB;
constexpr size_t WS_LRWG = 34 * MiB;
constexpr size_t WS_LRWOUT = 38 * MiB;
constexpr size_t WS_WQK = 42 * MiB;
constexpr size_t WS_TOPI = 58 * MiB;
constexpr size_t WS_TOPG = 66 * MiB;
constexpr size_t WS_DEC = 74 * MiB;
constexpr size_t WS_CP = 75 * MiB;
constexpr size_t WS_CH = 79 * MiB;
constexpr size_t WS_HIN = 83 * MiB;
constexpr size_t WS_USC = 87 * MiB;
constexpr size_t WS_VSC = 87 * MiB + 262144;
constexpr size_t WS_XRES = 88 * MiB;
constexpr size_t WS_HBUF = 152 * MiB;
constexpr size_t WS_OB = 184 * MiB;
constexpr size_t WS_PROJ = 216 * MiB;
constexpr size_t WS_XB = WS_PROJ, WS_YG = WS_PROJ + 32 * MiB, WS_XC = WS_PROJ + 64 * MiB, WS_LOGA = WS_PROJ + 96 * MiB;
constexpr size_t WS_SCORES = WS_PROJ;
constexpr size_t WS_KV = 376 * MiB;
constexpr size_t WS_BTERM = WS_KV;
constexpr size_t WS_SIN = 504 * MiB;
constexpr size_t WS_UTAB = 568 * MiB;
constexpr size_t WS_VTAB = 696 * MiB;
constexpr size_t WS_END = 824 * MiB;

constexpr int LDS_BYTES = 155648;

#define LAUNDER_IDS int tidL = threadIdx.x, bidL = blockIdx.x; asm volatile("" : "+v"(tidL)); asm volatile("" : "+s"(bidL));
__device__ __forceinline__ float bf2f(bf16_t b) { return __uint_as_float(((unsigned)b) << 16); }
__device__ __forceinline__ float bflo(unsigned u) { return __uint_as_float(u << 16); }
__device__ __forceinline__ float bfhi(unsigned u) { return __uint_as_float(u & 0xffff0000u); }
__device__ __forceinline__ unsigned cvt_pk_bf16(float lo, float hi) { unsigned r; asm volatile("v_cvt_pk_bf16_f32 %0, %1, %2" : "=v"(r) : "v"(lo), "v"(hi)); return r; }
__device__ __forceinline__ bf16_t f2bf(float f) { return (bf16_t)(cvt_pk_bf16(f, 0.f) & 0xffffu); }
__device__ __forceinline__ float fast_exp(float x) { return __builtin_amdgcn_exp2f(x * 1.4426950408889634f); }
__device__ __forceinline__ float fast_log(float x) { return __builtin_amdgcn_logf(x) * 0.6931471805599453f; }
__device__ __forceinline__ float fast_rcp(float x) { return __builtin_amdgcn_rcpf(x); }
__device__ __forceinline__ float sigmoidf_(float x) { return fast_rcp(1.f + fast_exp(-x)); }
__device__ __forceinline__ float gelu_tanh(float x) { const float u = 1.5957691216057308f * (x + 0.044715f * x * x * x); return x * fast_rcp(1.f + fast_exp(-u)); }
__device__ __forceinline__ float silu_(float x) { return x * sigmoidf_(x); }
__device__ __forceinline__ float wave_sum(float v) {
#pragma unroll
    for (int o = 1; o < 64; o <<= 1) v += __shfl_xor(v, o);
    return v;
}
__device__ __forceinline__ float wave_max(float v) {
#pragma unroll
    for (int o = 1; o < 64; o <<= 1) v = fmaxf(v, __shfl_xor(v, o));
    return v;
}

namespace pg8 {
constexpr int BM = 256, BK = 64, HALF = 128, HTB = HALF * BK * 2, STAGE_BYTES = 8 * HTB, NXCD = 8, WGM = 8;
__host__ __device__ __forceinline__ int lds_byte(int r, int c) { const int st = (r >> 4) * 2 + (c >> 5), rr = r & 15, cc = c & 31, ob = rr * 64 + cc * 2; return st * 1024 + (ob ^ (((ob >> 9) & 1) << 5)); }
__host__ __device__ __forceinline__ void stage_rc(int b, int& R, int& C) { const int st = b / 1024, sb = b % 1024, swz = sb ^ (((sb >> 9) & 1) << 5); R = (st >> 1) * 16 + swz / 64; C = (st & 1) * 32 + (swz % 64) / 2; }
__host__ __device__ __forceinline__ int perm32(int rho) { const int n = rho >> 4, i = rho & 15; return 8 * (i >> 2) + 4 * n + (i & 3); }
struct Unit { int pm, pn; };
struct Gemm { const bf16_t* A; const bf16_t* Bt; int M, N, K, lda, ldb, a_pn_shift, a_pn_stride; };
struct StaticOrder {
    int nM, nN, nwg, G, c;
    __host__ __device__ void init(int M, int N, int G_, int c_) { nM = M / BM; nN = N / BM; nwg = nM * nN; G = G_; c = c_; }
    __host__ __device__ bool next(int i, Unit& u) const {
        const long L = (long)i * G + c; if (L >= nwg) return false;
        int wgid = (int)L; { const int q = nwg / NXCD, r = nwg % NXCD, xcd = wgid % NXCD, off = wgid / NXCD; wgid = (xcd < r ? xcd * (q + 1) : r * (q + 1) + (xcd - r) * q) + off; }
        const int nig = WGM * nN, gid = wgid / nig, fm = gid * WGM, gsz = (nM - fm) < WGM ? (nM - fm) : WGM;
        u.pm = fm + ((wgid % nig) % gsz); u.pn = (wgid % nig) / gsz; return true;
    }
    __device__ __forceinline__ void a_ready(const Unit&) const {}
    __device__ __forceinline__ void done(const Unit&) const {}
};
template <class Epi, class Sched, bool STAMP = false>
__device__ __forceinline__ void gemm_phase(PG8_LAS unsigned char* lds, const Gemm g, const Sched& S, const Epi& E, unsigned long long* stamps) {
    int tid = threadIdx.x; asm volatile("" : "+v"(tid)); const int wid = __builtin_amdgcn_readfirstlane(tid >> 6), lane = tid & 63, wr = wid >> 2, wc = wid & 3, fr = lane & 15, fq = lane >> 4;
    const int K = g.K, nt = K / BK;
    int ts_lo = 0, ts_hi = 0, nts = 0; const unsigned long long rt_entry = STAMP ? (unsigned long long)wall_clock64() : 0ull;
#define PG8_STAMP() do { if (STAMP && wid == 0 && nts < 64) { const unsigned long long _c = (unsigned long long)clock64(); \
        ts_lo = (lane == nts) ? (int)(unsigned)_c : ts_lo; ts_hi = (lane == nts) ? (int)(unsigned)(_c >> 32) : ts_hi; ++nts; } } while (0)
    PG8_STAMP();
    unsigned voffA[2], voffB[2];
#pragma unroll
    for (int i = 0; i < 2; ++i) { int R, C; stage_rc(tid * 16 + i * 8192, R, C); const int Rb = Epi::PERM ? ((R & ~31) + perm32(R & 31)) : R;
        voffA[i] = (unsigned)(R * g.lda + C) * 2u; voffB[i] = (unsigned)(Rb * g.ldb + C) * 2u; }
    const size_t kstep = (size_t)(BK * 2);
    const size_t hstepA = (size_t)HALF * g.lda * 2, hstepB = (size_t)HALF * g.ldb * 2;
    const size_t tstepA = 2 * hstepA, tstepB = 2 * hstepB;
    const unsigned ldsw = (unsigned)wid * 1024u;
    const int aoff = lds_byte(wr * 64 + fr, fq * 8), boff = lds_byte(wc * 32 + fr, fq * 8);
#define PG8_SA(b, h) (((b) * 2 + (h)) * HTB)
#define PG8_SB(b, h) ((4 + (b) * 2 + (h)) * HTB)
#define PG8_STAGE(bufoff, gbase, voff) do { _Pragma("unroll") for (int _i = 0; _i < 2; ++_i) \
        __builtin_amdgcn_global_load_lds((const unsigned*)((const char*)(gbase) + (voff)[_i]), (PG8_LAS unsigned*)(lds + (bufoff) + ldsw + _i * 8192), 16, 0, 0); } while (0)
#define PG8_LDA(dst, b, h) do { _Pragma("unroll") for (int m = 0; m < 4; ++m) _Pragma("unroll") for (int k = 0; k < 2; ++k) dst[m][k] = *(const PG8_LAS bf16x8*)(lds + PG8_SA(b, h) + aoff + m * 2048 + k * 1024); } while (0)
#define PG8_LDB(dst, b, h) do { _Pragma("unroll") for (int n = 0; n < 2; ++n) _Pragma("unroll") for (int k = 0; k < 2; ++k) dst[n][k] = *(const PG8_LAS bf16x8*)(lds + PG8_SB(b, h) + boff + n * 2048 + k * 1024); } while (0)
#define PG8_MMA(ai, bj, At, Bt) do { __builtin_amdgcn_s_setprio(1); _Pragma("unroll") for (int m = 0; m < 4; ++m) _Pragma("unroll") for (int n = 0; n < 2; ++n) _Pragma("unroll") for (int k = 0; k < 2; ++k) \
        acc[ai][bj][m][n] = Epi::SWAP ? __builtin_amdgcn_mfma_f32_16x16x32_bf16(At[m][k], Bt[n][k], acc[ai][bj][m][n], 0, 0, 0) : __builtin_amdgcn_mfma_f32_16x16x32_bf16(Bt[n][k], At[m][k], acc[ai][bj][m][n], 0, 0, 0); __builtin_amdgcn_s_setprio(0); } while (0)
#define PG8_WAIT_V(n) asm volatile("s_waitcnt vmcnt(" #n ")" ::: "memory")
#define PG8_WAIT_L(n) asm volatile("s_waitcnt lgkmcnt(" #n ")" ::: "memory")
#define PG8_BAR __builtin_amdgcn_s_barrier()
#define PG8_SCHED __builtin_amdgcn_sched_barrier(0)
    Unit cur, nxt; int ui = 0;
    if (!S.next(0, cur)) return;
    f32x4 acc[2][2][4][2];
#pragma unroll
    for (int a = 0; a < 2; ++a)
#pragma unroll
        for (int b = 0; b < 2; ++b)
#pragma unroll
            for (int m = 0; m < 4; ++m)
#pragma unroll
                for (int n = 0; n < 2; ++n) acc[a][b][m][n] = (f32x4){0.f, 0.f, 0.f, 0.f};
    bf16x8 At[4][2], B0[2][2], B1[2][2];
    const char* cA = (const char*)g.A + (size_t)cur.pm * tstepA + (size_t)(cur.pn >> g.a_pn_shift) * g.a_pn_stride; const char* cB = (const char*)g.Bt + (size_t)cur.pn * tstepB;
    S.a_ready(cur);
    PG8_STAGE(PG8_SB(0, 0), cB, voffB); PG8_STAGE(PG8_SA(0, 0), cA, voffA); PG8_STAGE(PG8_SB(0, 1), cB + hstepB, voffB); PG8_STAGE(PG8_SA(0, 1), cA + hstepA, voffA);
    if (wr == 1) PG8_BAR;
    PG8_WAIT_V(4); PG8_BAR;
    PG8_STAGE(PG8_SB(1, 0), cB + kstep, voffB); PG8_STAGE(PG8_SA(1, 0), cA + kstep, voffA); PG8_STAGE(PG8_SB(1, 1), cB + hstepB + kstep, voffB);
    PG8_WAIT_V(6); PG8_BAR;
    PG8_STAMP();
    for (;;) {
        const bool has_next = S.next(ui + 1, nxt);
        const char* nA = has_next ? (const char*)g.A + (size_t)nxt.pm * tstepA + (size_t)(nxt.pn >> g.a_pn_shift) * g.a_pn_stride : cA; const char* nB = has_next ? (const char*)g.Bt + (size_t)nxt.pn * tstepB : cB;
#pragma unroll 1
        for (int t = 0; t < nt; t += 2) {
            const bool last = (t == nt - 2);
            const char* a1 = cA + (size_t)(t + 1) * kstep;
            const char* a2 = last ? nA : cA + (size_t)(t + 2) * kstep; const char* b2 = last ? nB : cB + (size_t)(t + 2) * kstep;
            const char* a3 = a2 + kstep; const char* b3 = b2 + kstep;
            if (last && has_next) S.a_ready(nxt);
            PG8_LDB(B0, 0, 0); PG8_SCHED; PG8_LDA(At, 0, 0); PG8_STAGE(PG8_SA(1, 1), a1 + hstepA, voffA);
            PG8_WAIT_L(8); PG8_BAR; PG8_WAIT_L(0); PG8_MMA(0, 0, At, B0); PG8_BAR; PG8_SCHED;
            PG8_LDB(B1, 0, 1); PG8_STAGE(PG8_SB(0, 0), b2, voffB);
            PG8_BAR; PG8_WAIT_L(0); PG8_MMA(0, 1, At, B1); PG8_BAR;
            PG8_LDA(At, 0, 1); PG8_STAGE(PG8_SA(0, 0), a2, voffA);
            PG8_BAR; PG8_WAIT_L(0); PG8_MMA(1, 0, At, B0); PG8_BAR; PG8_SCHED;
            PG8_STAGE(PG8_SB(0, 1), b2 + hstepB, voffB);
            PG8_WAIT_V(6); PG8_BAR; PG8_MMA(1, 1, At, B1); PG8_BAR;
            PG8_LDB(B0, 1, 0); PG8_SCHED; PG8_LDA(At, 1, 0); PG8_STAGE(PG8_SA(0, 1), a2 + hstepA, voffA);
            PG8_WAIT_L(8); PG8_BAR; PG8_WAIT_L(0); PG8_MMA(0, 0, At, B0); PG8_BAR; PG8_SCHED;
            PG8_LDB(B1, 1, 1); PG8_STAGE(PG8_SB(1, 0), b3, voffB);
            PG8_BAR; PG8_WAIT_L(0); PG8_MMA(0, 1, At, B1); PG8_BAR;
            PG8_LDA(At, 1, 1); PG8_STAGE(PG8_SA(1, 0), a3, voffA);
            PG8_BAR; PG8_WAIT_L(0); PG8_MMA(1, 0, At, B0); PG8_BAR; PG8_SCHED;
            PG8_STAGE(PG8_SB(1, 1), b3 + hstepB, voffB);
            PG8_WAIT_V(6); PG8_BAR; PG8_MMA(1, 1, At, B1); PG8_BAR;
        }
        PG8_STAMP();
        if constexpr (!Epi::AFTER_DRAIN) { E(acc, cur, wr, wc, fr, fq); S.done(cur); }
        PG8_STAMP();
        if (!has_next) break;
#pragma unroll
        for (int a = 0; a < 2; ++a)
#pragma unroll
            for (int b = 0; b < 2; ++b)
#pragma unroll
                for (int m = 0; m < 4; ++m)
#pragma unroll
                    for (int n = 0; n < 2; ++n) acc[a][b][m][n] = (f32x4){0.f, 0.f, 0.f, 0.f};
        cur = nxt; cA = nA; cB = nB; ++ui;
    }
    PG8_WAIT_V(0);
    if (wr == 0) PG8_BAR;
    PG8_BAR;
    if constexpr (Epi::AFTER_DRAIN) { E.fused(acc, cur, wr, wc, fr, fq, lds, wid, lane); S.done(cur); }
    PG8_STAMP();
    if (STAMP && wid == 0) { stamps[lane] = lane < nts ? (((unsigned long long)(unsigned)ts_hi << 32) | (unsigned)ts_lo) : 0ull;
        if (lane == 62) stamps[62] = rt_entry; if (lane == 63) stamps[63] = (unsigned long long)wall_clock64(); }
#undef PG8_STAMP
#undef PG8_SA
#undef PG8_SB
#undef PG8_STAGE
#undef PG8_LDA
#undef PG8_LDB
#undef PG8_MMA
#undef PG8_WAIT_V
#undef PG8_WAIT_L
#undef PG8_BAR
#undef PG8_SCHED
}
}
using pg8::Unit;

struct EpiBf16 {
    static constexpr bool PERM = true, AFTER_DRAIN = false, SWAP = false;
    bf16_t* O; int ldc;
    __device__ __forceinline__ void operator()(const f32x4 (&acc)[2][2][4][2], const Unit& u, int wr, int wc, int fr, int fq) const {
        const int row0 = u.pm * 256 + wr * 64 + fr, col0 = u.pn * 256 + wc * 32 + 8 * fq;
#pragma unroll
        for (int ai = 0; ai < 2; ++ai)
#pragma unroll
            for (int m = 0; m < 4; ++m) { bf16_t* rowp = O + (size_t)(row0 + ai * 128 + m * 16) * ldc + col0;
#pragma unroll
                for (int bj = 0; bj < 2; ++bj) { const f32x4 v0 = acc[ai][bj][m][0], v1 = acc[ai][bj][m][1];
                    u32x4 o; o.x = cvt_pk_bf16(v0[0], v0[1]); o.y = cvt_pk_bf16(v0[2], v0[3]); o.z = cvt_pk_bf16(v1[0], v1[1]); o.w = cvt_pk_bf16(v1[2], v1[3]);
                    *(u32x4*)(rowp + bj * 128) = o; } }
    }
};
struct EpiLruIn {
    static constexpr bool PERM = true, AFTER_DRAIN = false, SWAP = false;
    bf16_t* XB; bf16_t* YG;
    __device__ __forceinline__ void operator()(const f32x4 (&acc)[2][2][4][2], const Unit& u, int wr, int wc, int fr, int fq) const {
        const bool isy = u.pn >= 4;
        bf16_t* O = isy ? YG : XB;
        const int row0 = u.pm * 256 + wr * 64 + fr, col0 = (u.pn & 3) * 256 + wc * 32 + 8 * fq;
#pragma unroll
        for (int ai = 0; ai < 2; ++ai)
#pragma unroll
            for (int m = 0; m < 4; ++m) { bf16_t* rowp = O + (size_t)(row0 + ai * 128 + m * 16) * 1024 + col0;
#pragma unroll
                for (int bj = 0; bj < 2; ++bj) { f32x4 v0 = acc[ai][bj][m][0], v1 = acc[ai][bj][m][1];
                    if (isy) {
#pragma unroll
                        for (int i = 0; i < 4; ++i) { v0[i] = gelu_tanh(v0[i]); v1[i] = gelu_tanh(v1[i]); } }
                    u32x4 o; o.x = cvt_pk_bf16(v0[0], v0[1]); o.y = cvt_pk_bf16(v0[2], v0[3]); o.z = cvt_pk_bf16(v1[0], v1[1]); o.w = cvt_pk_bf16(v1[2], v1[3]);
                    *(u32x4*)(rowp + bj * 128) = o; } }
    }
};
struct EpiGates {
    static constexpr bool PERM = true, AFTER_DRAIN = false, SWAP = false;
    bf16_t* LOGA; bf16_t* BTERM; const bf16_t* XC; const float* b_a; const float* b_x; const float* lam;
    __device__ __forceinline__ void operator()(const f32x4 (&acc)[2][2][4][2], const Unit& u, int wr, int wc, int fr_, int fq) const {
        int fr = fr_; asm volatile("" : "+v"(fr));
        const int nblk = u.pn >> 2, uu = u.pn & 3, d = uu >> 1, jh = uu & 1;
        const int colbase = nblk * 256 + jh * 128 + wc * 32 + 8 * fq;
        const unsigned off0 = (unsigned)(u.pm * 256 + wr * 64 + fr) * 1024u + (unsigned)colbase;
        const bf16_t* xcp = XC; bf16_t* lap = LOGA + (size_t)d * T * 1024; bf16_t* btp = BTERM + (size_t)d * T * 1024;
        const float* bap = b_a + d * 1024; const float* bxp = b_x + d * 1024; const float* lmp = lam + d * 1024;
#pragma unroll
        for (int ai = 0; ai < 2; ++ai)
#pragma unroll
            for (int m = 0; m < 4; ++m) { const unsigned off = off0 + (unsigned)(ai * 128 + m * 16) * 1024u;
                asm volatile("" ::: "memory"); __builtin_amdgcn_sched_barrier(0);
                const u32x4 xr = *(const u32x4*)(xcp + off);
                const float xv[8] = {bflo(xr.x), bfhi(xr.x), bflo(xr.y), bfhi(xr.y), bflo(xr.z), bfhi(xr.z), bflo(xr.w), bfhi(xr.w)};
                unsigned o1[4], o2[4];
#pragma unroll
                for (int n = 0; n < 2; ++n) { const f32x4 ba = *(const f32x4*)(bap + (unsigned)(colbase + 4 * n)), bx = *(const f32x4*)(bxp + (unsigned)(colbase + 4 * n)), lm = *(const f32x4*)(lmp + (unsigned)(colbase + 4 * n));
                    float la[4], bt[4];
#pragma unroll
                    for (int i = 0; i < 4; ++i) { const float r = sigmoidf_(acc[ai][0][m][n][i] + ba[i]), ig = sigmoidf_(acc[ai][1][m][n][i] + bx[i]);
                        const float l = -8.f * fast_log(1.f + fast_exp(-lm[i])) * r; const float mult = __builtin_sqrtf(fmaxf(1.f - fast_exp(2.f * l), 0.f));
                        la[i] = l; bt[i] = mult * ig * xv[n * 4 + i]; }
                    o1[n * 2] = cvt_pk_bf16(la[0], la[1]); o1[n * 2 + 1] = cvt_pk_bf16(la[2], la[3]); o2[n * 2] = cvt_pk_bf16(bt[0], bt[1]); o2[n * 2 + 1] = cvt_pk_bf16(bt[2], bt[3]); }
                *(u32x4*)(lap + off) = (u32x4){o1[0], o1[1], o1[2], o1[3]}; *(u32x4*)(btp + off) = (u32x4){o2[0], o2[1], o2[2], o2[3]}; }
    }
};
struct EpiResid {
    static constexpr bool PERM = false, AFTER_DRAIN = false, SWAP = false;
    const float* xin; float* xout; const float* gate; bool dry;
    __device__ __forceinline__ void operator()(const f32x4 (&acc)[2][2][4][2], const Unit& u, int wr, int wc, int fr, int fq) const {
        const int row0 = u.pm * 256 + wr * 64 + fr, col0 = u.pn * 256 + wc * 32 + 4 * fq;
        const float* gp = gate + ((u.pm * 256) >> 13) * 6144 + col0;
        f32x4 gv[2][2];
#pragma unroll
        for (int bj = 0; bj < 2; ++bj)
#pragma unroll
            for (int n = 0; n < 2; ++n) gv[bj][n] = *(const f32x4*)(gp + bj * 128 + n * 16);
#pragma unroll
        for (int ai = 0; ai < 2; ++ai)
#pragma unroll
            for (int m = 0; m < 4; ++m) { const size_t off = (size_t)(row0 + ai * 128 + m * 16) * 1024 + col0;
#pragma unroll
                for (int bj = 0; bj < 2; ++bj)
#pragma unroll
                    for (int n = 0; n < 2; ++n) { const f32x4 xv = *(const f32x4*)(xin + off + bj * 128 + n * 16);
                        if (!dry) *(f32x4*)(xout + off + bj * 128 + n * 16) = xv + gv[bj][n] * acc[ai][bj][m][n]; } }
    }
};
struct EpiScoresT {
    static constexpr bool PERM = false, AFTER_DRAIN = false, SWAP = true;
    float* C;
    __device__ __forceinline__ void operator()(const f32x4 (&acc)[2][2][4][2], const Unit& u, int wr, int wc, int fr_, int fq) const {
        int fr = fr_; asm volatile("" : "+v"(fr));
        const unsigned off0 = (unsigned)(u.pn * 256 + wc * 32 + fr) * (unsigned)T + (unsigned)(u.pm * 256 + wr * 64 + 4 * fq);
#pragma unroll
        for (int ai = 0; ai < 2; ++ai)
#pragma unroll
            for (int m = 0; m < 4; ++m)
#pragma unroll
                for (int bj = 0; bj < 2; ++bj)
#pragma unroll
                    for (int n = 0; n < 2; ++n) *(f32x4*)(C + (off0 + (unsigned)(bj * 128 + n * 16) * (unsigned)T + (unsigned)(ai * 128 + m * 16))) = acc[ai][bj][m][n];
    }
};

struct Params {
    const float *x, *c, *w_ada, *b_ada, *norm_g, *hg_w_in, *hg_lb, *hg_norm_g, *hg_w_out, *lru_w_in, *lru_conv_w, *lru_conv_b,
        *lru_w_a, *lru_b_a, *lru_w_x, *lru_b_x, *lru_lam, *lru_w_out, *peer_w_q, *peer_keys, *peer_u, *peer_v, *final_g;
    float* out; unsigned char* ws; int ph_lo, ph_hi; unsigned rep_mask; int pad_;
};

typedef const __attribute__((address_space(4))) Params* KP;

template <class Epi>
__device__ __forceinline__ void run_gemm(LAS unsigned char* lds, const bf16_t* A, const bf16_t* Bt, int N, int K, int lda, int ldb, int a_pn_shift, int a_pn_stride, const Epi& E) {
    pg8::Gemm g; g.A = A; g.Bt = Bt; g.M = T; g.N = N; g.K = K; g.lda = lda; g.ldb = ldb; g.a_pn_shift = a_pn_shift; g.a_pn_stride = a_pn_stride;
    LAUNDER_IDS
    pg8::StaticOrder S; S.init(T, N, (int)gridDim.x, bidL); (void)tidL;
    pg8::gemm_phase<Epi, pg8::StaticOrder, false>(lds, g, S, E, nullptr);
    __syncthreads();
}

__device__ __forceinline__ void transpose_tile(const float* __restrict__ src, int ld_src, bf16_t* dst, int ld_dst, LAS float* tile, int tid) {
#pragma unroll
    for (int it = 0; it < 2; ++it) { const int r = (tid >> 4) + 32 * it, c4 = (tid & 15) * 4;
        const f32x4 v = *(const f32x4*)(src + (size_t)r * ld_src + c4);
        tile[r * 65 + c4 + 0] = v[0]; tile[r * 65 + c4 + 1] = v[1]; tile[r * 65 + c4 + 2] = v[2]; tile[r * 65 + c4 + 3] = v[3]; }
    __syncthreads();
    { const int n = tid >> 3, kc = tid & 7; const LAS float* s = tile + (kc * 8) * 65 + n;
        u32x4 o; o.x = cvt_pk_bf16(s[0], s[65]); o.y = cvt_pk_bf16(s[2 * 65], s[3 * 65]); o.z = cvt_pk_bf16(s[4 * 65], s[5 * 65]); o.w = cvt_pk_bf16(s[6 * 65], s[7 * 65]);
        *(u32x4*)(dst + (size_t)n * ld_dst + kc * 8) = o; }
    __syncthreads();
}

__device__ __forceinline__ void phase0(KP p, LAS unsigned char* lds) {
    LAUNDER_IDS
    const int tid = tidL, wave = tid >> 6, lane = tid & 63;
    unsigned char* ws = p->ws;
    LAS float* tile = (LAS float*)lds;
    constexpr int I_HGIN = 16 * 80, I_SQ = 16 * 16, I_LRIN = 16 * 32, I_G = 16;
    constexpr int N_A = 2 * I_HGIN + 2 * I_SQ + 2 * I_LRIN + 2 * I_SQ + 32 * I_G;
    for (int it = bidL; it < N_A; it += gridDim.x) {
        int r = it;
        if (r < 2 * I_HGIN) { const int j = r / I_HGIN, q = r % I_HGIN, kb = q / 80, nb = q % 80;
            transpose_tile(p->hg_w_in + (size_t)j * 1024 * 5120 + (size_t)kb * 64 * 5120 + nb * 64, 5120, (bf16_t*)(ws + WS_HGWIN) + (size_t)j * 5120 * 1024 + (size_t)nb * 64 * 1024 + kb * 64, 1024, tile, tid); continue; }
        r -= 2 * I_HGIN;
        if (r < 2 * I_SQ) { const int j = r / I_SQ, q = r % I_SQ, kb = q / 16, nb = q % 16;
            transpose_tile(p->hg_w_out + (size_t)j * 1024 * 1024 + (size_t)kb * 64 * 1024 + nb * 64, 1024, (bf16_t*)(ws + WS_HGWOUT) + (size_t)j * 1024 * 1024 + (size_t)nb * 64 * 1024 + kb * 64, 1024, tile, tid); continue; }
        r -= 2 * I_SQ;
        if (r < 2 * I_LRIN) { const int j = r / I_LRIN, q = r % I_LRIN, kb = q / 32, nb = q % 32;
            transpose_tile(p->lru_w_in + (size_t)j * 1024 * 2048 + (size_t)kb * 64 * 2048 + nb * 64, 2048, (bf16_t*)(ws + WS_LRWIN) + (size_t)j * 2048 * 1024 + (size_t)nb * 64 * 1024 + kb * 64, 1024, tile, tid); continue; }
        r -= 2 * I_LRIN;
        if (r < 2 * I_SQ) { const int j = r / I_SQ, q = r % I_SQ, kb = q / 16, nb = q % 16;
            transpose_tile(p->lru_w_out + (size_t)j * 1024 * 1024 + (size_t)kb * 64 * 1024 + nb * 64, 1024, (bf16_t*)(ws + WS_LRWOUT) + (size_t)j * 1024 * 1024 + (size_t)nb * 64 * 1024 + kb * 64, 1024, tile, tid); continue; }
        r -= 2 * I_SQ;
        { const int mat = r / I_G, q = r % I_G, kb = q / 4, nb = q % 4;
            const int nblk = mat & 3, gate = (mat >> 2) & 1, d = (mat >> 3) & 1, l = mat >> 4;
            const float* src = (gate ? p->lru_w_x : p->lru_w_a) + (size_t)((l * 2 + d) * 4 + nblk) * 65536 + (size_t)kb * 64 * 256 + nb * 64;
            const int n0 = nb * 64, jh = n0 >> 7;
            bf16_t* dst = (bf16_t*)(ws + WS_LRWG) + (size_t)l * 4 * 1024 * 256 + (size_t)nblk * 1024 * 256 + (size_t)((d * 2 + jh) * 256 + gate * 128 + (n0 & 127)) * 256 + kb * 64;
            transpose_tile(src, 256, dst, 256, tile, tid); }
    }
    {
        LAS float* keysL = (LAS float*)lds;
        LAS float* wqL = (LAS float*)(lds + 128 * 132 * 4);
        for (int it = bidL; it < 1024; it += gridDim.x) {
            const int l = it >> 8, hp = (it >> 4) & 15, dt = it & 15;
            const float* kp = p->peer_keys + ((size_t)l * 16 + hp) * 16384;
#pragma unroll
            for (int q = 0; q < 8; ++q) { const int e = (tid + 512 * q) * 4; const f32x4 v = *(const f32x4*)(kp + e); *(LAS f32x4*)(keysL + (e >> 7) * 132 + (e & 127)) = v; }
            const float* wp = p->peer_w_q + (size_t)l * 1024 * 2048 + (size_t)(dt * 64) * 2048 + hp * 128;
#pragma unroll
            for (int q = 0; q < 4; ++q) { const int e = (tid + 512 * q) * 4; const f32x4 v = *(const f32x4*)(wp + (size_t)(e >> 7) * 2048 + (e & 127)); *(LAS f32x4*)(wqL + e) = v; }
            __syncthreads();
            const int key = tid & 127, g = tid >> 7;
            float acc[16];
#pragma unroll
            for (int i = 0; i < 16; ++i) acc[i] = 0.f;
            for (int d4 = 0; d4 < 128; d4 += 4) {
                const f32x4 kv = *(const LAS f32x4*)(keysL + key * 132 + d4);
#pragma unroll
                for (int i = 0; i < 16; ++i) { const f32x4 wv = *(const LAS f32x4*)(wqL + (g * 16 + i) * 128 + d4);
                    acc[i] += kv[0] * wv[0] + kv[1] * wv[1] + kv[2] * wv[2] + kv[3] * wv[3]; }
            }
            bf16_t* op = (bf16_t*)(ws + WS_WQK) + (size_t)l * 2048 * 1024 + (size_t)(hp * 128 + key) * 1024 + dt * 64 + g * 16;
            u32x4 o1, o2; o1.x = cvt_pk_bf16(acc[0], acc[1]); o1.y = cvt_pk_bf16(acc[2], acc[3]); o1.z = cvt_pk_bf16(acc[4], acc[5]); o1.w = cvt_pk_bf16(acc[6], acc[7]);
            o2.x = cvt_pk_bf16(acc[8], acc[9]); o2.y = cvt_pk_bf16(acc[10], acc[11]); o2.z = cvt_pk_bf16(acc[12], acc[13]); o2.w = cvt_pk_bf16(acc[14], acc[15]);
            *(u32x4*)op = o1; *(u32x4*)(op + 8) = o2;
            __syncthreads();
        }
    }
    {
        LAS float* condL = (LAS float*)lds;
        LAS float* red = (LAS float*)(lds + 8192);
        for (int i = tid; i < 2048; i += NTHR) condL[i] = silu_(p->c[i]);
        __syncthreads();
        for (int it = bidL; it < 4 * 48; it += gridDim.x) {
            const int l = it / 48, col0 = (it % 48) * 128;
            const float* wp = p->w_ada + (size_t)l * 1024 * 6144 + col0 + 2 * lane;
            float a00 = 0.f, a01 = 0.f, a10 = 0.f, a11 = 0.f;
#pragma unroll 8
            for (int kk = 0; kk < 128; ++kk) { const int k = wave * 128 + kk; const f32x2 w = *(const f32x2*)(wp + (size_t)k * 6144);
                const float c0 = condL[k], c1 = condL[1024 + k];
                a00 += c0 * w[0]; a01 += c0 * w[1]; a10 += c1 * w[0]; a11 += c1 * w[1]; }
            red[(wave * 2 + 0) * 128 + 2 * lane] = a00; red[(wave * 2 + 0) * 128 + 2 * lane + 1] = a01;
            red[(wave * 2 + 1) * 128 + 2 * lane] = a10; red[(wave * 2 + 1) * 128 + 2 * lane + 1] = a11;
            __syncthreads();
            if (tid < 256) { const int b = tid >> 7, cc = tid & 127; float s = 0.f;
#pragma unroll
                for (int w = 0; w < 8; ++w) s += red[(w * 2 + b) * 128 + cc];
                ((float*)(ws + WS_MOD))[((size_t)l * 2 + b) * 6144 + col0 + cc] = s + p->b_ada[(size_t)l * 6144 + col0 + cc]; }
            __syncthreads();
        }
    }
    {
        const int nw = gridDim.x * NWAVE;
        for (int row0 = bidL * NWAVE + wave; row0 < 2 * 65536; row0 += 4 * nw) {
            f32x4 v[4][4];
#pragma unroll
            for (int rr = 0; rr < 4; ++rr) { const int row = row0 + rr * nw; const int tb = row >> 16, r = row & 65535;
                const float* src = (tb ? p->peer_v : p->peer_u) + (size_t)r * 1024 + 4 * lane;
#pragma unroll
                for (int jx = 0; jx < 4; ++jx) v[rr][jx] = __builtin_nontemporal_load((const f32x4*)(src + 256 * jx)); }
#pragma unroll
            for (int rr = 0; rr < 4; ++rr) { const int row = row0 + rr * nw; const int tb = row >> 16, r = row & 65535;
                float am = 0.f;
#pragma unroll
                for (int jx = 0; jx < 4; ++jx) am = fmaxf(am, fmaxf(fmaxf(fabsf(v[rr][jx][0]), fabsf(v[rr][jx][1])), fmaxf(fabsf(v[rr][jx][2]), fabsf(v[rr][jx][3]))));
                am = wave_max(am);
                const float sc = am > 0.f ? am * (1.f / 448.f) : 1.f, inv = am > 0.f ? 448.f / am : 1.f;
                unsigned char* dst = ws + (tb ? WS_VTAB : WS_UTAB) + (size_t)r * 1024 + 4 * lane;
#pragma unroll
                for (int jx = 0; jx < 4; ++jx) { int w = __builtin_amdgcn_cvt_pk_fp8_f32(v[rr][jx][0] * inv, v[rr][jx][1] * inv, 0, false);
                    w = __builtin_amdgcn_cvt_pk_fp8_f32(v[rr][jx][2] * inv, v[rr][jx][3] * inv, w, true);
                    *(int*)(dst + 256 * jx) = w; }
                if (lane == 0) ((float*)(ws + (tb ? WS_VSC : WS_USC)))[r] = sc; }
        }
    }
}

__device__ __forceinline__ void phase_rms(const float* xin, const float* gain, const float* shift, const float* scale, bf16_t* hout) {
    LAUNDER_IDS
    const int tid = tidL, wave = tid >> 6, lane = tid & 63;
    for (int row = bidL * NWAVE + wave; row < T; row += gridDim.x * NWAVE) {
        const int b = row >> 13;
        const float* xr = xin + (size_t)row * 1024 + lane * 4;
        f32x4 v[4]; float ss = 0.f;
#pragma unroll
        for (int j = 0; j < 4; ++j) { v[j] = *(const f32x4*)(xr + j * 256); ss += v[j][0] * v[j][0] + v[j][1] * v[j][1] + v[j][2] * v[j][2] + v[j][3] * v[j][3]; }
        const float inv = __builtin_amdgcn_rsqf(wave_sum(ss) * (1.f / 1024.f) + EPS);
#pragma unroll
        for (int j = 0; j < 4; ++j) { const int col = j * 256 + lane * 4;
            const f32x4 g = *(const f32x4*)(gain + col), sh = *(const f32x4*)(shift + b * 6144 + col), sc = *(const f32x4*)(scale + b * 6144 + col);
            const f32x4 y = (v[j] * inv) * g * (1.f + sc) + sh;
            u32x2 o; o.x = cvt_pk_bf16(y[0], y[1]); o.y = cvt_pk_bf16(y[2], y[3]);
            *(u32x2*)(hout + (size_t)row * 1024 + col) = o; }
    }
}

constexpr int LROW = 136;
__device__ __forceinline__ float hg_lower_bound(const float* hg_lb, int j, int col) {
    if (j == 0) return 0.f;
    const float l0 = hg_lb[col], l1 = hg_lb[1024 + col];
    return fast_rcp(1.f + fast_exp(l0 - l1));
}
__device__ __forceinline__ f32x4 mfma16(bf16x8 a, bf16x8 b, f32x4 c) { return __builtin_amdgcn_mfma_f32_16x16x32_bf16(a, b, c, 0, 0, 0); }

__device__ __forceinline__ void load_v_regs(const bf16_t* proj, u32x4 (&vr)[4], int t0, int dir, int h, int tid) {
#pragma unroll
    for (int it = 0; it < 4; ++it) { const int idx = tid + 512 * it, tau = idx & 127, cv = idx >> 7;
        const int tok = dir ? t0 + 127 - tau : t0 + tau;
        vr[it] = *(const u32x4*)(proj + (size_t)tok * 5120 + 3072 + h * 128 + cv * 8); }
}
__device__ __forceinline__ void store_vt(LAS bf16_t* VT, const u32x4 (&vr)[4], int tid) {
#pragma unroll
    for (int it = 0; it < 4; ++it) { const int idx = tid + 512 * it, tau = idx & 127, cv = idx >> 7; const u32x4 v = vr[it];
        LAS bf16_t* d = VT + (cv * 8) * LROW + tau;
        d[0 * LROW] = (bf16_t)(v.x & 0xffff); d[1 * LROW] = (bf16_t)(v.x >> 16); d[2 * LROW] = (bf16_t)(v.y & 0xffff); d[3 * LROW] = (bf16_t)(v.y >> 16);
        d[4 * LROW] = (bf16_t)(v.z & 0xffff); d[5 * LROW] = (bf16_t)(v.z >> 16); d[6 * LROW] = (bf16_t)(v.w & 0xffff); d[7 * LROW] = (bf16_t)(v.w >> 16); }
}
__device__ __forceinline__ void load_tile_regs(const bf16_t* proj, u32x4 (&r)[4], int t0, int dir, int col0, int tid) {
#pragma unroll
    for (int it = 0; it < 4; ++it) { const int idx = tid + 512 * it, tau = idx >> 4, c16 = idx & 15;
        const int tok = dir ? t0 + 127 - tau : t0 + tau;
        r[it] = *(const u32x4*)(proj + (size_t)tok * 5120 + col0 + c16 * 8); }
}
__device__ __forceinline__ void store_tile(LAS bf16_t* TL, const u32x4 (&r)[4], int tid) {
#pragma unroll
    for (int it = 0; it < 4; ++it) { const int idx = tid + 512 * it, tau = idx >> 4, c16 = idx & 15; *(LAS u32x4*)(TL + tau * LROW + c16 * 8) = r[it]; }
}

__device__ __forceinline__ void hg_pass_a(KP p, LAS unsigned char* lds, int j) {
    LAUNDER_IDS
    const bf16_t* proj = (const bf16_t*)(p->ws + WS_PROJ);
    float* KV = (float*)(p->ws + WS_KV); float* DEC = (float*)(p->ws + WS_DEC);
    LAS bf16_t* VT = (LAS bf16_t*)lds; LAS bf16_t* KT = (LAS bf16_t*)(lds + 34816); LAS float* TOT = (LAS float*)(lds + 69632); LAS bf16_t* ZT = (LAS bf16_t*)(lds + 71680);
    for (int u = bidL; u < 2048; u += gridDim.x) {
        int tid = tidL; asm volatile("" : "+v"(tid));
        const int wave = tid >> 6, lane = tid & 63;
        const int seq = u >> 6, c = u & 63, dir = seq & 1, h = (seq >> 1) & 7, b = seq >> 4;
        const int t0 = b * SEQ + c * 128;
        const int dk = tid & 127, g = tid >> 7;
        const float lb = hg_lower_bound(p->hg_lb, j, h * 128 + dk);
        float lcs[32], kks[32]; float lc = 0.f;
        { u32x4 zr[4], vr[4];
            load_tile_regs(proj, zr, t0, dir, 1024 * (1 + dir) + h * 128, tid); load_v_regs(proj, vr, t0, dir, h, tid);
            store_tile(ZT, zr, tid); store_vt(VT, vr, tid); }
        __syncthreads();
#pragma unroll
        for (int q = 0; q < 32; ++q) { const int tau = 32 * g + q;
            const float z = bf2f(ZT[tau * LROW + dk]);
            const float f = lb + (1.f - lb) * sigmoidf_(z);
            lc += fast_log(f); lcs[q] = lc; kks[q] = 1.f - f; }
        TOT[g * 128 + dk] = lc;
        __syncthreads();
        float rg = 0.f, total = 0.f;
#pragma unroll
        for (int gg = 0; gg < 4; ++gg) { const float tv = TOT[gg * 128 + dk]; total += tv; if (gg < g) rg += tv; }
        const float base = total - rg;
#pragma unroll
        for (int q8 = 0; q8 < 4; ++q8) { unsigned w[4];
#pragma unroll
            for (int e = 0; e < 4; ++e) { const int q = q8 * 8 + e * 2;
                w[e] = cvt_pk_bf16(kks[q] * fast_exp(base - lcs[q]), kks[q + 1] * fast_exp(base - lcs[q + 1])); }
            u32x4 o; o.x = w[0]; o.y = w[1]; o.z = w[2]; o.w = w[3];
            *(LAS u32x4*)(KT + dk * LROW + 32 * g + q8 * 8) = o; }
        if (g == 0) DEC[(size_t)u * 128 + dk] = fast_exp(total);
        __syncthreads();
        f32x4 acc[2][4];
#pragma unroll
        for (int a = 0; a < 2; ++a)
#pragma unroll
            for (int bb = 0; bb < 4; ++bb) acc[a][bb] = (f32x4){0.f, 0.f, 0.f, 0.f};
        const int l15 = lane & 15, lq = lane >> 4;
#pragma unroll
        for (int ks = 0; ks < 4; ++ks) {
            bf16x8 af[2], bfr[4];
#pragma unroll
            for (int a = 0; a < 2; ++a) af[a] = *(const LAS bf16x8*)(VT + (((wave & 3) * 2 + a) * 16 + l15) * LROW + ks * 32 + lq * 8);
#pragma unroll
            for (int bb = 0; bb < 4; ++bb) bfr[bb] = *(const LAS bf16x8*)(KT + (((wave >> 2) * 4 + bb) * 16 + l15) * LROW + ks * 32 + lq * 8);
#pragma unroll
            for (int a = 0; a < 2; ++a)
#pragma unroll
                for (int bb = 0; bb < 4; ++bb) acc[a][bb] = mfma16(af[a], bfr[bb], acc[a][bb]);
        }
        float* kvp = KV + (size_t)u * 16384;
#pragma unroll
        for (int a = 0; a < 2; ++a)
#pragma unroll
            for (int bb = 0; bb < 4; ++bb)
#pragma unroll
                for (int r = 0; r < 4; ++r) kvp[(((wave & 3) * 2 + a) * 16 + lq * 4 + r) * 128 + ((wave >> 2) * 4 + bb) * 16 + l15] = acc[a][bb][r];
        __syncthreads();
    }
}

__device__ __forceinline__ void hg_pass_b(KP p) {
    LAUNDER_IDS
    const float* KV = (const float*)(p->ws + WS_KV); const float* DEC = (const float*)(p->ws + WS_DEC);
    bf16_t* SIN = (bf16_t*)(p->ws + WS_SIN);
    for (int e = bidL * NTHR + tidL; e < 131072; e += gridDim.x * NTHR) {
    const int seq = e >> 12, i4 = e & 4095, dir = seq & 1, dk = (i4 * 4) & 127;
    f32x4 S = {0.f, 0.f, 0.f, 0.f};
#pragma unroll 8
    for (int step = 0; step < 64; ++step) {
        const int c = dir ? 63 - step : step; const size_t u = (size_t)seq * 64 + c;
        const f32x4 kv = *(const f32x4*)(KV + u * 16384 + i4 * 4); const f32x4 dc = *(const f32x4*)(DEC + u * 128 + dk);
        u32x2 o; o.x = cvt_pk_bf16(S[0], S[1]); o.y = cvt_pk_bf16(S[2], S[3]);
        *(u32x2*)(SIN + u * 16384 + i4 * 4) = o;
        S = dc * S + kv;
    }
    }
}

__device__ __forceinline__ void hg_pass_c(KP p, LAS unsigned char* lds, int j) {
    LAUNDER_IDS
    const bf16_t* proj = (const bf16_t*)(p->ws + WS_PROJ);
    const bf16_t* SIN = (const bf16_t*)(p->ws + WS_SIN);
    bf16_t* OB = (bf16_t*)(p->ws + WS_OB);
    LAS bf16_t* QT = (LAS bf16_t*)lds; LAS bf16_t* QI = (LAS bf16_t*)(lds + 34816); LAS bf16_t* KT = (LAS bf16_t*)(lds + 69632);
    LAS bf16_t* VT = (LAS bf16_t*)(lds + 104448); LAS bf16_t* PI = (LAS bf16_t*)(lds + 139264); LAS float* TOT = (LAS float*)(lds + 147968);
    LAS float* OSUM = (LAS float*)(lds + 69632);
    for (int u = bidL; u < 1024; u += gridDim.x) {
        int tid = tidL; asm volatile("" : "+v"(tid));
        const int wave = tid >> 6, lane = tid & 63, l15 = lane & 15, lq = lane >> 4;
        const int c = u & 63, h = (u >> 6) & 7, b = u >> 9;
        const int t0 = b * SEQ + c * 128;
        const int dk = tid & 127, g = tid >> 7;
        const float lb = hg_lower_bound(p->hg_lb, j, h * 128 + dk);
        const int tt = wave & 1, dvt0 = (wave >> 1) * 2;
        f32x4 oacc[2][4][2];
#pragma unroll
        for (int dir = 0; dir < 2; ++dir) {
            const size_t su = ((size_t)((b * 8 + h) * 2 + dir) * 64 + c);
            unsigned k0p[16]; float lc = 0.f; float kprev = 0.f;
            u32x4 vr[4];
            { u32x4 zr[4], qr[4];
                load_tile_regs(proj, zr, t0, dir, 1024 * (1 + dir) + h * 128, tid); load_tile_regs(proj, qr, t0, dir, h * 128, tid); load_v_regs(proj, vr, t0, dir, h, tid);
                __syncthreads();
                store_tile(KT, zr, tid); store_tile(VT, qr, tid); }
            __syncthreads();
#pragma unroll
            for (int q = 0; q < 32; ++q) { const int tau = 32 * g + q;
                const float z = bf2f(KT[tau * LROW + dk]), qv = bf2f(VT[tau * LROW + dk]);
                const float f = lb + (1.f - lb) * sigmoidf_(z);
                lc += fast_log(f);
                const float el = fast_exp(fmaxf(lc, -80.f));
                QT[tau * LROW + dk] = f2bf(qv * el);
                const float kcur = (1.f - f) * fast_rcp(el);
                if (q & 1) k0p[q >> 1] = cvt_pk_bf16(kprev, kcur); else kprev = kcur; }
            TOT[g * 128 + dk] = lc;
            __syncthreads();
            float r[4]; { float run = 0.f;
#pragma unroll
                for (int gg = 0; gg < 4; ++gg) { r[gg] = run; run += TOT[gg * 128 + dk]; } }
            float rg = 0.f;
#pragma unroll
            for (int gg = 0; gg < 4; ++gg) if (gg == g) rg = r[gg];
            { const float eg = fast_exp(rg);
#pragma unroll
                for (int q = 0; q < 32; ++q) QI[(32 * g + q) * LROW + dk] = f2bf(bf2f(QT[(32 * g + q) * LROW + dk]) * eg); }
            store_vt(VT, vr, tid);
            bf16x8 sfr[2][4];
#pragma unroll
            for (int n = 0; n < 2; ++n)
#pragma unroll
                for (int ks = 0; ks < 4; ++ks) sfr[n][ks] = *(const bf16x8*)(SIN + su * 16384 + (size_t)((dvt0 + n) * 16 + l15) * 128 + ks * 32 + lq * 8);
#pragma unroll
            for (int i = 0; i < 4; ++i) {
                if (g <= i) { const float e = fast_exp(r[i] - rg);
#pragma unroll
                    for (int q = 0; q < 32; ++q) KT[(32 * g + q) * LROW + dk] = f2bf(((q & 1) ? bfhi(k0p[q >> 1]) : bflo(k0p[q >> 1])) * e); }
                __syncthreads();
                for (int tl = wave; tl < 4 * (i + 1); tl += 8) { const int sm = tl >> 1, tn = tl & 1;
                    f32x4 a4 = {0.f, 0.f, 0.f, 0.f};
#pragma unroll
                    for (int ks = 0; ks < 4; ++ks) { const bf16x8 af = *(const LAS bf16x8*)(KT + (sm * 16 + l15) * LROW + ks * 32 + lq * 8);
                        const bf16x8 bq = *(const LAS bf16x8*)(QT + (32 * i + tn * 16 + l15) * LROW + ks * 32 + lq * 8);
                        a4 = mfma16(af, bq, a4); }
                    const int tloc = tn * 16 + l15, s0 = sm * 16 + lq * 4, tg = 32 * i + tloc;
                    u32x2 o; o.x = cvt_pk_bf16(s0 + 0 <= tg ? a4[0] : 0.f, s0 + 1 <= tg ? a4[1] : 0.f); o.y = cvt_pk_bf16(s0 + 2 <= tg ? a4[2] : 0.f, s0 + 3 <= tg ? a4[3] : 0.f);
                    *(LAS u32x2*)(PI + tloc * LROW + s0) = o; }
                __syncthreads();
                f32x4 a0 = {0.f, 0.f, 0.f, 0.f}, a1 = {0.f, 0.f, 0.f, 0.f};
                for (int ks = 0; ks <= i; ++ks) { const bf16x8 af = *(const LAS bf16x8*)(PI + (tt * 16 + l15) * LROW + ks * 32 + lq * 8);
                    const bf16x8 b0 = *(const LAS bf16x8*)(VT + ((dvt0 + 0) * 16 + l15) * LROW + ks * 32 + lq * 8);
                    const bf16x8 b1 = *(const LAS bf16x8*)(VT + ((dvt0 + 1) * 16 + l15) * LROW + ks * 32 + lq * 8);
                    a0 = mfma16(af, b0, a0); a1 = mfma16(af, b1, a1); }
#pragma unroll
                for (int ks = 0; ks < 4; ++ks) { const bf16x8 af = *(const LAS bf16x8*)(QI + (32 * i + tt * 16 + l15) * LROW + ks * 32 + lq * 8);
                    a0 = mfma16(af, sfr[0][ks], a0); a1 = mfma16(af, sfr[1][ks], a1); }
                oacc[dir][i][0] = a0; oacc[dir][i][1] = a1;
            }
        }
        __syncthreads();
#pragma unroll
        for (int i = 0; i < 4; ++i)
#pragma unroll
            for (int n = 0; n < 2; ++n)
#pragma unroll
                for (int rr = 0; rr < 4; ++rr) OSUM[(32 * i + tt * 16 + lq * 4 + rr) * 132 + (dvt0 + n) * 16 + l15] = oacc[0][i][n][rr];
        __syncthreads();
#pragma unroll
        for (int i = 0; i < 4; ++i)
#pragma unroll
            for (int n = 0; n < 2; ++n)
#pragma unroll
                for (int rr = 0; rr < 4; ++rr) OSUM[(127 - (32 * i + tt * 16 + lq * 4 + rr)) * 132 + (dvt0 + n) * 16 + l15] += oacc[1][i][n][rr];
        __syncthreads();
        { const int row = tid >> 2, part = tid & 3; const int tok = t0 + row;
            float ov[32]; float ss = 0.f;
#pragma unroll
            for (int q = 0; q < 8; ++q) { const f32x4 v = *(const LAS f32x4*)(OSUM + row * 132 + part * 32 + q * 4);
                ov[q * 4 + 0] = v[0]; ov[q * 4 + 1] = v[1]; ov[q * 4 + 2] = v[2]; ov[q * 4 + 3] = v[3]; ss += v[0] * v[0] + v[1] * v[1] + v[2] * v[2] + v[3] * v[3]; }
            ss += __shfl_xor(ss, 1); ss += __shfl_xor(ss, 2);
            const float inv = __builtin_amdgcn_rsqf(ss * (1.f / 128.f) + EPS);
            const int col = h * 128 + part * 32;
            const bf16_t* gp = proj + (size_t)tok * 5120 + 4096 + col; const float* ng = p->hg_norm_g + j * 1024 + col;
#pragma unroll
            for (int q = 0; q < 4; ++q) { const u32x4 gr = *(const u32x4*)(gp + q * 8);
                const float gv[8] = {bflo(gr.x), bfhi(gr.x), bflo(gr.y), bfhi(gr.y), bflo(gr.z), bfhi(gr.z), bflo(gr.w), bfhi(gr.w)};
                float y[8];
#pragma unroll
                for (int e = 0; e < 8; ++e) y[e] = ov[q * 8 + e] * inv * ng[q * 8 + e] * silu_(gv[e]);
                u32x4 o; o.x = cvt_pk_bf16(y[0], y[1]); o.y = cvt_pk_bf16(y[2], y[3]); o.z = cvt_pk_bf16(y[4], y[5]); o.w = cvt_pk_bf16(y[6], y[7]);
                *(u32x4*)(OB + (size_t)tok * 1024 + col + q * 8) = o; }
        }
        __syncthreads();
    }
}

__device__ __forceinline__ void lru_conv(KP p, int l) {
    LAUNDER_IDS
    const bf16_t* XB = (const bf16_t*)(p->ws + WS_XB); bf16_t* XC = (bf16_t*)(p->ws + WS_XC);
    const float* cw = p->lru_conv_w + (size_t)l * 4 * 1024; const float* cb = p->lru_conv_b + (size_t)l * 1024;
    const int gs = gridDim.x * NTHR;
    for (int it = bidL * NTHR + tidL; it < T * 128; it += gs) {
        const int tok = it >> 7, c8 = (it & 127) * 8, s = tok & (SEQ - 1);
        float acc[8];
        { const f32x4 b0 = *(const f32x4*)(cb + c8), b1 = *(const f32x4*)(cb + c8 + 4);
            acc[0] = b0[0]; acc[1] = b0[1]; acc[2] = b0[2]; acc[3] = b0[3]; acc[4] = b1[0]; acc[5] = b1[1]; acc[6] = b1[2]; acc[7] = b1[3]; }
#pragma unroll
        for (int jj = 0; jj < 4; ++jj) { const int ts = s + jj - 2;
            if (ts >= 0 && ts < SEQ) { const u32x4 xr = *(const u32x4*)(XB + (size_t)(tok + jj - 2) * 1024 + c8);
                const f32x4 w0 = *(const f32x4*)(cw + jj * 1024 + c8), w1 = *(const f32x4*)(cw + jj * 1024 + c8 + 4);
                acc[0] += bflo(xr.x) * w0[0]; acc[1] += bfhi(xr.x) * w0[1]; acc[2] += bflo(xr.y) * w0[2]; acc[3] += bfhi(xr.y) * w0[3];
                acc[4] += bflo(xr.z) * w1[0]; acc[5] += bfhi(xr.z) * w1[1]; acc[6] += bflo(xr.w) * w1[2]; acc[7] += bfhi(xr.w) * w1[3]; } }
        u32x4 o; o.x = cvt_pk_bf16(acc[0], acc[1]); o.y = cvt_pk_bf16(acc[2], acc[3]); o.z = cvt_pk_bf16(acc[4], acc[5]); o.w = cvt_pk_bf16(acc[6], acc[7]);
        *(u32x4*)(XC + (size_t)tok * 1024 + c8) = o;
    }
}
__device__ __forceinline__ void lru_scan1(KP p, LAS unsigned char* lds) {
    LAUNDER_IDS
    const bf16_t* LOGA = (const bf16_t*)(p->ws + WS_LOGA); const bf16_t* BT = (const bf16_t*)(p->ws + WS_BTERM);
    float* CP = (float*)(p->ws + WS_CP); float* CH = (float*)(p->ws + WS_CH);
    LAS float* XP = (LAS float*)lds; LAS float* XH = (LAS float*)(lds + 16384);
    for (int u = bidL; u < 1024; u += gridDim.x) {
        int tid = tidL; asm volatile("" : "+v"(tid));
        const int ts = tid >> 7, c8 = (tid & 127) * 8;
        const int chunk = u & 255, dir = (u >> 8) & 1, b = u >> 9;
        const size_t base = ((size_t)dir * T + b * SEQ + chunk * 32) * 1024 + c8;
        u32x4 lw[8], bw[8];
#pragma unroll
        for (int q = 0; q < 8; ++q) { const int t = dir ? 31 - (ts * 8 + q) : ts * 8 + q; lw[q] = *(const u32x4*)(LOGA + base + (size_t)t * 1024); bw[q] = *(const u32x4*)(BT + base + (size_t)t * 1024); }
        float h[8], sl[8];
#pragma unroll
        for (int i = 0; i < 8; ++i) { h[i] = 0.f; sl[i] = 0.f; }
#pragma unroll
        for (int q = 0; q < 8; ++q) {
#pragma unroll
            for (int w = 0; w < 4; ++w) { const float l0 = bflo(lw[q][w]), l1 = bfhi(lw[q][w]);
                h[2 * w] = fast_exp(l0) * h[2 * w] + bflo(bw[q][w]); h[2 * w + 1] = fast_exp(l1) * h[2 * w + 1] + bfhi(bw[q][w]); sl[2 * w] += l0; sl[2 * w + 1] += l1; } }
        *(LAS f32x4*)(XP + ts * 1024 + c8) = (f32x4){fast_exp(sl[0]), fast_exp(sl[1]), fast_exp(sl[2]), fast_exp(sl[3])};
        *(LAS f32x4*)(XP + ts * 1024 + c8 + 4) = (f32x4){fast_exp(sl[4]), fast_exp(sl[5]), fast_exp(sl[6]), fast_exp(sl[7])};
        *(LAS f32x4*)(XH + ts * 1024 + c8) = (f32x4){h[0], h[1], h[2], h[3]}; *(LAS f32x4*)(XH + ts * 1024 + c8 + 4) = (f32x4){h[4], h[5], h[6], h[7]};
        __syncthreads();
        { const int ch = 2 * tid; float P0 = 1.f, P1 = 1.f, H0 = 0.f, H1 = 0.f;
#pragma unroll
            for (int s2 = 0; s2 < 4; ++s2) { const f32x2 pp = *(const LAS f32x2*)(XP + s2 * 1024 + ch), hh = *(const LAS f32x2*)(XH + s2 * 1024 + ch);
                H0 = pp[0] * H0 + hh[0]; H1 = pp[1] * H1 + hh[1]; P0 *= pp[0]; P1 *= pp[1]; }
            const size_t o = ((size_t)(b * 2 + dir) * 256 + chunk) * 1024 + ch;
            *(f32x2*)(CP + o) = (f32x2){P0, P1}; *(f32x2*)(CH + o) = (f32x2){H0, H1}; }
        __syncthreads();
    }
}
__device__ __forceinline__ void lru_scan2(KP p) {
    LAUNDER_IDS
    const float* CP = (const float*)(p->ws + WS_CP); const float* CH = (const float*)(p->ws + WS_CH); float* HIN = (float*)(p->ws + WS_HIN);
    const int wave = tidL >> 6, lane = tidL & 63;
    for (int item = bidL * NWAVE + wave; item < 4096; item += gridDim.x * NWAVE) {
        const int ch = item & 1023, bd = item >> 10, dir = bd & 1;
        float pp[4], hh[4]; float Pl = 1.f, Hl = 0.f;
#pragma unroll
        for (int q = 0; q < 4; ++q) { const int ci = 4 * lane + q, chunk = dir ? 255 - ci : ci; const size_t o = ((size_t)bd * 256 + chunk) * 1024 + ch;
            pp[q] = CP[o]; hh[q] = CH[o]; Hl = pp[q] * Hl + hh[q]; Pl *= pp[q]; }
#pragma unroll
        for (int off = 1; off < 64; off <<= 1) { const float Pp = __shfl_up(Pl, off), Hp = __shfl_up(Hl, off);
            if (lane >= off) { Hl = Pl * Hp + Hl; Pl = Pl * Pp; } }
        float carry = __shfl_up(Hl, 1); if (lane == 0) carry = 0.f;
#pragma unroll
        for (int q = 0; q < 4; ++q) { const int ci = 4 * lane + q, chunk = dir ? 255 - ci : ci; const size_t o = ((size_t)bd * 256 + chunk) * 1024 + ch;
            HIN[o] = carry; carry = pp[q] * carry + hh[q]; }
    }
}
__device__ __forceinline__ void lru_scan3(KP p, LAS unsigned char* lds) {
    LAUNDER_IDS
    const bf16_t* LOGA = (const bf16_t*)(p->ws + WS_LOGA); const bf16_t* BT = (const bf16_t*)(p->ws + WS_BTERM); const bf16_t* YG = (const bf16_t*)(p->ws + WS_YG);
    const float* HIN = (const float*)(p->ws + WS_HIN); bf16_t* OB = (bf16_t*)(p->ws + WS_OB);
    LAS float* XP = (LAS float*)lds; LAS float* XH = (LAS float*)(lds + 16384);
    for (int u = bidL; u < 512; u += gridDim.x) {
        int tid = tidL; asm volatile("" : "+v"(tid));
        const int ts = tid >> 7, c8 = (tid & 127) * 8;
        const int chunk = u & 255, b = u >> 8;
        const size_t base = ((size_t)b * SEQ + chunk * 32 + ts * 8) * 1024 + c8;
        unsigned hsp[8][4];
#pragma unroll
        for (int dir = 0; dir < 2; ++dir) {
            u32x4 lw[8], bw[8];
#pragma unroll
            for (int q = 0; q < 8; ++q) { lw[q] = *(const u32x4*)(LOGA + (size_t)dir * T * 1024 + base + (size_t)q * 1024); bw[q] = *(const u32x4*)(BT + (size_t)dir * T * 1024 + base + (size_t)q * 1024); }
            const f32x4 hi0 = *(const f32x4*)(HIN + ((size_t)(b * 2 + dir) * 256 + chunk) * 1024 + c8), hi1 = *(const f32x4*)(HIN + ((size_t)(b * 2 + dir) * 256 + chunk) * 1024 + c8 + 4);
            float h[8], sl[8];
#pragma unroll
            for (int i = 0; i < 8; ++i) { h[i] = 0.f; sl[i] = 0.f; }
#pragma unroll
            for (int qq = 0; qq < 8; ++qq) { const int q = dir ? 7 - qq : qq;
#pragma unroll
                for (int w = 0; w < 4; ++w) { const float l0 = bflo(lw[q][w]), l1 = bfhi(lw[q][w]);
                    h[2 * w] = fast_exp(l0) * h[2 * w] + bflo(bw[q][w]); h[2 * w + 1] = fast_exp(l1) * h[2 * w + 1] + bfhi(bw[q][w]); sl[2 * w] += l0; sl[2 * w + 1] += l1; } }
            __syncthreads();
            *(LAS f32x4*)(XP + ts * 1024 + c8) = (f32x4){fast_exp(sl[0]), fast_exp(sl[1]), fast_exp(sl[2]), fast_exp(sl[3])};
            *(LAS f32x4*)(XP + ts * 1024 + c8 + 4) = (f32x4){fast_exp(sl[4]), fast_exp(sl[5]), fast_exp(sl[6]), fast_exp(sl[7])};
            *(LAS f32x4*)(XH + ts * 1024 + c8) = (f32x4){h[0], h[1], h[2], h[3]}; *(LAS f32x4*)(XH + ts * 1024 + c8 + 4) = (f32x4){h[4], h[5], h[6], h[7]};
            __syncthreads();
            h[0] = hi0[0]; h[1] = hi0[1]; h[2] = hi0[2]; h[3] = hi0[3]; h[4] = hi1[0]; h[5] = hi1[1]; h[6] = hi1[2]; h[7] = hi1[3];
#pragma unroll
            for (int s3 = 0; s3 < 3; ++s3) { const int sr = dir ? 3 - s3 : s3; const bool use = dir ? (sr > ts) : (sr < ts);
                const f32x4 p0 = *(const LAS f32x4*)(XP + sr * 1024 + c8), p1 = *(const LAS f32x4*)(XP + sr * 1024 + c8 + 4), q0 = *(const LAS f32x4*)(XH + sr * 1024 + c8), q1 = *(const LAS f32x4*)(XH + sr * 1024 + c8 + 4);
                if (use) { h[0] = p0[0] * h[0] + q0[0]; h[1] = p0[1] * h[1] + q0[1]; h[2] = p0[2] * h[2] + q0[2]; h[3] = p0[3] * h[3] + q0[3];
                    h[4] = p1[0] * h[4] + q1[0]; h[5] = p1[1] * h[5] + q1[1]; h[6] = p1[2] * h[6] + q1[2]; h[7] = p1[3] * h[7] + q1[3]; } }
#pragma unroll
            for (int qq = 0; qq < 8; ++qq) { const int q = dir ? 7 - qq : qq;
                u32x4 yw; if (dir) yw = *(const u32x4*)(YG + base + (size_t)q * 1024);
                unsigned ow[4];
#pragma unroll
                for (int w = 0; w < 4; ++w) { h[2 * w] = fast_exp(bflo(lw[q][w])) * h[2 * w] + bflo(bw[q][w]); h[2 * w + 1] = fast_exp(bfhi(lw[q][w])) * h[2 * w + 1] + bfhi(bw[q][w]);
                    if (dir == 0) hsp[q][w] = cvt_pk_bf16(h[2 * w], h[2 * w + 1]);
                    else ow[w] = cvt_pk_bf16((bflo(hsp[q][w]) + h[2 * w]) * bflo(yw[w]), (bfhi(hsp[q][w]) + h[2 * w + 1]) * bfhi(yw[w])); }
                if (dir) *(u32x4*)(OB + base + (size_t)q * 1024) = (u32x4){ow[0], ow[1], ow[2], ow[3]}; }
        }
        __syncthreads();
    }
}

__device__ const unsigned char STAIR[64] = {
    0x00, 0x01, 0x02, 0x03, 0x04, 0x05, 0x06, 0x07, 0x08, 0x09, 0x0a, 0x0b, 0x0c, 0x0d, 0x0e, 0x0f,
    0x10, 0x11, 0x12, 0x13, 0x14, 0x15, 0x16, 0x17, 0x20, 0x21, 0x22, 0x23, 0x24, 0x30, 0x31, 0x32,
    0x33, 0x40, 0x41, 0x42, 0x50, 0x51, 0x60, 0x61, 0x70, 0x71, 0x80, 0x90, 0xa0, 0xb0, 0xc0, 0xd0,
    0xe0, 0xf0, 0, 0, 0, 0, 0, 0, 0, 0, 0, 0, 0, 0, 0, 0};
__device__ __forceinline__ unsigned mono_key(float f) { const unsigned b = __float_as_uint(f); return b ^ ((b >> 31) ? 0xffffffffu : 0x80000000u); }

__device__ __forceinline__ float inv_mono(unsigned k) { return __uint_as_float(k ^ ((k >> 31) ? 0x80000000u : 0xffffffffu)); }
#define TK_CE(A, B) do { const unsigned hi_ = max(A, B), lo_ = min(A, B); A = hi_; B = lo_; } while (0)
#define TK_SORT16(N) do { _Pragma("unroll") for (int k_ = 2; k_ <= 16; k_ <<= 1) { _Pragma("unroll") for (int j_ = k_ >> 1; j_ > 0; j_ >>= 1) { _Pragma("unroll") for (int i_ = 0; i_ < 16; ++i_) { \
    const int l_ = i_ ^ j_; if (l_ > i_) { if ((i_ & k_) == 0) TK_CE(N[i_], N[l_]); else TK_CE(N[l_], N[i_]); } } } } } while (0)
#define TK_MERGE16(L, N) do { _Pragma("unroll") for (int i_ = 0; i_ < 16; ++i_) L[i_] = max(L[i_], N[15 - i_]); \
    _Pragma("unroll") for (int j_ = 8; j_ > 0; j_ >>= 1) { _Pragma("unroll") for (int i_ = 0; i_ < 16; ++i_) { const int l_ = i_ ^ j_; if (l_ > i_) TK_CE(L[i_], L[l_]); } } } while (0)
#define TK_INSERT(L, x) do { _Pragma("unroll") for (int q_ = 0; q_ < 16; ++q_) { const unsigned hi_ = max(L[q_], x); x = min(L[q_], x); L[q_] = hi_; } } while (0)
__device__ __forceinline__ void peer_topk(KP p, LAS unsigned char* lds) {
    LAUNDER_IDS
    (void)bidL;
    const int tid = tidL, wave = tid >> 6, lane = tid & 63;
    const float* SCT = (const float*)(p->ws + WS_SCORES);
    int* TOPI = (int*)(p->ws + WS_TOPI); float* TOPG = (float*)(p->ws + WS_TOPG);
    LAS unsigned char* IX = lds + wave * 2048 + lane * 32;
    for (int item = bidL * NWAVE + wave; item < 2048; item += gridDim.x * NWAVE) {
        const int tg = item >> 3, hd = item & 7, tok = tg * 64 + lane;
        float V[2][16];
#pragma unroll
        for (int half = 0; half < 2; ++half) {
            unsigned L[16];
#pragma unroll
            for (int q = 0; q < 16; ++q) L[q] = 0u;
            const float* sc = SCT + (size_t)(hd * 256 + half * 128) * T + tok;
            float cur[16], nxt[16];
#pragma unroll
            for (int i = 0; i < 16; ++i) cur[i] = sc[(size_t)i * T];
#pragma unroll 1
            for (int kb = 0; kb < 8; ++kb) {
                const int kn = kb < 7 ? kb + 1 : kb;
#pragma unroll
                for (int i = 0; i < 16; ++i) nxt[i] = sc[(size_t)(kn * 16 + i) * T];
                unsigned NK[16];
#pragma unroll
                for (int i = 0; i < 16; ++i) NK[i] = (mono_key(cur[i]) & ~0x7fu) | (unsigned)(kb * 16 + i);
                TK_SORT16(NK); TK_MERGE16(L, NK);
#pragma unroll
                for (int i = 0; i < 16; ++i) cur[i] = nxt[i];
            }
            u32x4 w0, w1;
            w0.x = (L[0] & 0x7f) | ((L[1] & 0x7f) << 8) | ((L[2] & 0x7f) << 16) | ((L[3] & 0x7f) << 24); w0.y = (L[4] & 0x7f) | ((L[5] & 0x7f) << 8) | ((L[6] & 0x7f) << 16) | ((L[7] & 0x7f) << 24);
            w0.z = (L[8] & 0x7f) | ((L[9] & 0x7f) << 8) | ((L[10] & 0x7f) << 16) | ((L[11] & 0x7f) << 24); w0.w = (L[12] & 0x7f) | ((L[13] & 0x7f) << 8) | ((L[14] & 0x7f) << 16) | ((L[15] & 0x7f) << 24);
            *(LAS u32x4*)(IX + half * 16) = w0;
#pragma unroll
            for (int q = 0; q < 16; ++q) V[half][q] = inv_mono(L[q]);
        }
        unsigned C[16];
#pragma unroll
        for (int q = 0; q < 16; ++q) C[q] = 0u;
#pragma unroll
        for (int i = 0; i < 16; ++i)
#pragma unroll
            for (int jj = 0; jj < 16; ++jj) if ((i + 1) * (jj + 1) <= 16) { unsigned x = (mono_key(V[0][i] + V[1][jj]) & ~0xffu) | (unsigned)(i * 16 + jj); TK_INSERT(C, x); }
        asm volatile("s_waitcnt lgkmcnt(0)" ::: "memory");
        const float s0 = inv_mono(C[0] & ~0xffu);
        float e[16]; float sum = 0.f; int ids[16];
#pragma unroll
        for (int q = 0; q < 16; ++q) { e[q] = fast_exp(inv_mono(C[q] & ~0xffu) - s0); sum += e[q];
            const unsigned code = C[q] & 0xffu; ids[q] = (int)IX[code >> 4] * 128 + (int)IX[16 + (code & 15u)]; }
        const float rs = fast_rcp(sum);
        int* ip = TOPI + (size_t)tok * 128 + hd * 16; float* gp = TOPG + (size_t)tok * 128 + hd * 16;
#pragma unroll
        for (int q = 0; q < 4; ++q) { *(u32x4*)(ip + 4 * q) = (u32x4){(unsigned)ids[4 * q], (unsigned)ids[4 * q + 1], (unsigned)ids[4 * q + 2], (unsigned)ids[4 * q + 3]};
            *(f32x4*)(gp + 4 * q) = (f32x4){e[4 * q] * rs, e[4 * q + 1] * rs, e[4 * q + 2] * rs, e[4 * q + 3] * rs}; }
        asm volatile("s_waitcnt lgkmcnt(0)" ::: "memory");
    }
}

__device__ __forceinline__ void peer_gather(KP p, int l, bool dry) {
    LAUNDER_IDS
    const int wave = tidL >> 6, lane = tidL & 63;
    const bf16_t* HB = (const bf16_t*)(p->ws + WS_HBUF); bf16_t* HBW = (bf16_t*)(p->ws + WS_HBUF);
    const int* TOPI = (const int*)(p->ws + WS_TOPI); const float* TOPG = (const float*)(p->ws + WS_TOPG);
    const unsigned char* U8 = p->ws + WS_UTAB + (size_t)l * 16384 * 1024 + 16 * lane; const unsigned char* V8 = p->ws + WS_VTAB + (size_t)l * 16384 * 1024 + 16 * lane;
    const float* USC = (const float*)(p->ws + WS_USC) + l * 16384; const float* VSC = (const float*)(p->ws + WS_VSC) + l * 16384;
    float* XRES = (float*)(p->ws + WS_XRES); const float* MOD = (const float*)(p->ws + WS_MOD);
    for (int tok = bidL * NWAVE + wave; tok < T; tok += gridDim.x * NWAVE) {
        const int b = tok >> 13;
        f32x2 hv2[8];
        { const u32x4 h0 = *(const u32x4*)(HB + (size_t)tok * 1024 + 16 * lane), h1 = *(const u32x4*)(HB + (size_t)tok * 1024 + 16 * lane + 8);
            hv2[0] = (f32x2){bflo(h0.x), bfhi(h0.x)}; hv2[1] = (f32x2){bflo(h0.y), bfhi(h0.y)}; hv2[2] = (f32x2){bflo(h0.z), bfhi(h0.z)}; hv2[3] = (f32x2){bflo(h0.w), bfhi(h0.w)};
            hv2[4] = (f32x2){bflo(h1.x), bfhi(h1.x)}; hv2[5] = (f32x2){bflo(h1.y), bfhi(h1.y)}; hv2[6] = (f32x2){bflo(h1.z), bfhi(h1.z)}; hv2[7] = (f32x2){bflo(h1.w), bfhi(h1.w)}; }
        const int id0 = TOPI[(size_t)tok * 128 + lane], id1 = TOPI[(size_t)tok * 128 + 64 + lane];
        const float g0 = TOPG[(size_t)tok * 128 + lane], g1 = TOPG[(size_t)tok * 128 + 64 + lane];
        f32x2 acc2[8];
#pragma unroll
        for (int i = 0; i < 8; ++i) acc2[i] = (f32x2){0.f, 0.f};
#pragma unroll 1
        for (int e0 = 0; e0 < 128; e0 += 8) {
            u32x4 uq[8], vq[8]; float gk[8], su[8], sv[8];
#pragma unroll
            for (int k = 0; k < 8; ++k) { const int e = e0 + k;
                int id = __builtin_amdgcn_readlane(e0 < 64 ? id0 : id1, e & 63);
                id &= 16383;
                gk[k] = __uint_as_float(__builtin_amdgcn_readlane(__float_as_uint(e0 < 64 ? g0 : g1), e & 63));
                uq[k] = *(const u32x4*)(U8 + (size_t)id * 1024); vq[k] = *(const u32x4*)(V8 + (size_t)id * 1024);
                su[k] = USC[id]; sv[k] = VSC[id]; }
            float d[8];
#pragma unroll
            for (int k = 0; k < 8; ++k) { f32x2 s2 = (f32x2){0.f, 0.f};
#pragma unroll
                for (int w = 0; w < 4; ++w) { const f32x2 lo = __builtin_amdgcn_cvt_pk_f32_fp8((int)uq[k][w], false), hi = __builtin_amdgcn_cvt_pk_f32_fp8((int)uq[k][w], true);
                    s2 = lo * hv2[2 * w] + s2; s2 = hi * hv2[2 * w + 1] + s2; }
                d[k] = s2[0] + s2[1]; }
            const bool b32 = lane & 32, b16 = lane & 16, b8 = lane & 8;
            float d4[4], d2[2], r;
#pragma unroll
            for (int k = 0; k < 4; ++k) { const float recv = __shfl_xor(b32 ? d[k] : d[k + 4], 32); d4[k] = (b32 ? d[k + 4] : d[k]) + recv; }
#pragma unroll
            for (int k = 0; k < 2; ++k) { const float recv = __shfl_xor(b16 ? d4[k] : d4[k + 2], 16); d2[k] = (b16 ? d4[k + 2] : d4[k]) + recv; }
            { const float recv = __shfl_xor(b8 ? d2[0] : d2[1], 8); r = (b8 ? d2[1] : d2[0]) + recv; }
            r += __shfl_xor(r, 4); r += __shfl_xor(r, 2); r += __shfl_xor(r, 1);
#pragma unroll
            for (int k = 0; k < 8; ++k) { const float dot = __uint_as_float(__builtin_amdgcn_readlane(__float_as_uint(r), ((k >> 2) & 1) * 32 + ((k >> 1) & 1) * 16 + (k & 1) * 8));
                const float cf = gk[k] * gelu_tanh(dot * su[k]) * sv[k]; const f32x2 cf2 = (f32x2){cf, cf};
#pragma unroll
                for (int w = 0; w < 4; ++w) { const f32x2 lo = __builtin_amdgcn_cvt_pk_f32_fp8((int)vq[k][w], false), hi = __builtin_amdgcn_cvt_pk_f32_fp8((int)vq[k][w], true);
                    acc2[2 * w] = lo * cf2 + acc2[2 * w]; acc2[2 * w + 1] = hi * cf2 + acc2[2 * w + 1]; } }
        }
        const float* g2 = MOD + ((size_t)l * 2 + b) * 6144 + 5 * 1024 + 16 * lane;
        float* xrow = XRES + (size_t)tok * 1024 + 16 * lane;
        float xn[16]; float ss = 0.f;
#pragma unroll
        for (int q = 0; q < 4; ++q) { const f32x4 xr = *(const f32x4*)(xrow + 4 * q), gg = *(const f32x4*)(g2 + 4 * q);
            const float a0 = acc2[2 * q][0], a1 = acc2[2 * q][1], a2 = acc2[2 * q + 1][0], a3 = acc2[2 * q + 1][1];
            xn[4 * q + 0] = xr[0] + gg[0] * a0; xn[4 * q + 1] = xr[1] + gg[1] * a1; xn[4 * q + 2] = xr[2] + gg[2] * a2; xn[4 * q + 3] = xr[3] + gg[3] * a3; }
#pragma unroll
        for (int i = 0; i < 16; ++i) ss += xn[i] * xn[i];
        const float inv = __builtin_amdgcn_rsqf(wave_sum(ss) * (1.f / 1024.f) + EPS);
        if (dry) { if (inv == 123.456f) p->out[tok] = inv; continue; }
        if (l < DEPTH - 1) {
            const float* gain = p->norm_g + (size_t)(l + 1) * 2 * 1024 + 16 * lane; const float* sh = MOD + ((size_t)(l + 1) * 2 + b) * 6144 + 16 * lane; const float* sc = sh + 1024;
            float y[16];
#pragma unroll
            for (int q = 0; q < 4; ++q) { const f32x4 gn = *(const f32x4*)(gain + 4 * q), s1 = *(const f32x4*)(sh + 4 * q), c1 = *(const f32x4*)(sc + 4 * q);
                *(f32x4*)(xrow + 4 * q) = (f32x4){xn[4 * q], xn[4 * q + 1], xn[4 * q + 2], xn[4 * q + 3]};
#pragma unroll
                for (int i = 0; i < 4; ++i) y[4 * q + i] = (xn[4 * q + i] * inv) * gn[i] * (1.f + c1[i]) + s1[i]; }
            u32x4 o0, o1; o0.x = cvt_pk_bf16(y[0], y[1]); o0.y = cvt_pk_bf16(y[2], y[3]); o0.z = cvt_pk_bf16(y[4], y[5]); o0.w = cvt_pk_bf16(y[6], y[7]);
            o1.x = cvt_pk_bf16(y[8], y[9]); o1.y = cvt_pk_bf16(y[10], y[11]); o1.z = cvt_pk_bf16(y[12], y[13]); o1.w = cvt_pk_bf16(y[14], y[15]);
            *(u32x4*)(HBW + (size_t)tok * 1024 + 16 * lane) = o0; *(u32x4*)(HBW + (size_t)tok * 1024 + 16 * lane + 8) = o1;
        } else {
            const float* fg = p->final_g + 16 * lane; float* orow = p->out + (size_t)tok * 1024 + 16 * lane;
#pragma unroll
            for (int q = 0; q < 4; ++q) { const f32x4 gn = *(const f32x4*)(fg + 4 * q); f32x4 o;
#pragma unroll
                for (int i = 0; i < 4; ++i) o[i] = (xn[4 * q + i] * inv) * gn[i];
                *(f32x4*)(orow + 4 * q) = o; }
        }
    }
}

#define XB_TMO      128
#define XB_XCNT(j)  (256  + 64 * (j))
#define XB_XSUB(j)  (1280 + 64 * (j))
#define XB_XGEN(j)  (2304 + 64 * (j))
#define XB_TOP      3328
#define XB_TOPGEN   3392
#define XCD_BAR_WORDS 3456
#define XB_SPIN_CAP (1u << 18)

__device__ __forceinline__ unsigned xb_ld(unsigned* p)              { return __hip_atomic_load(p, __ATOMIC_RELAXED, __HIP_MEMORY_SCOPE_AGENT); }
__device__ __forceinline__ unsigned xb_add(unsigned* p, unsigned v) { return __hip_atomic_fetch_add(p, v, __ATOMIC_RELAXED, __HIP_MEMORY_SCOPE_AGENT); }
__device__ __forceinline__ unsigned xb_xcc_id() { return (unsigned)__builtin_amdgcn_s_getreg((3 << 11) | 20) & 0xFu; }
#define XB_SPIN(cond, bar) do { unsigned _sp = 0; while (cond) { __builtin_amdgcn_s_sleep(1); \
    if ((++_sp & 255u) == 0u) { if (xb_ld(&(bar)[XB_TMO])) break; if (_sp > XB_SPIN_CAP) { atomicAdd(&(bar)[XB_TMO], 1u); break; } } } } while (0)

struct XcdBarrier {
    unsigned* bar; unsigned x;
    volatile LAS unsigned* st;
};

__device__ __forceinline__ XcdBarrier xcd_barrier_post(unsigned* bar, volatile LAS unsigned* st) {
    XcdBarrier b; b.bar = bar; b.x = xb_xcc_id(); b.st = st;
    if (threadIdx.x == 0) (void)xb_add(&bar[XB_XCNT(b.x)], 1u);
    return b;
}
__device__ __forceinline__ void xcd_barrier_complete(unsigned* bar, unsigned x, unsigned& nloc, unsigned& nx) {
    const unsigned G = gridDim.x * gridDim.y * gridDim.z;
    unsigned sum, cnt, mine, sp = 0u;
    for (;;) {
        sum = 0u; cnt = 0u; mine = 0u;
#pragma unroll
        for (unsigned j = 0; j < 16; ++j) { const unsigned c = xb_ld(&bar[XB_XCNT(j)]); sum += c; cnt += (c > 0u) ? 1u : 0u; mine = (j == x) ? c : mine; }
        if (sum == G) break;
        __builtin_amdgcn_s_sleep(1);
        if ((++sp & 255u) == 0u) { if (xb_ld(&bar[XB_TMO])) break; if (sp > XB_SPIN_CAP) { atomicAdd(&bar[XB_TMO], 1u); break; } }
    }
    nloc = mine > 0u ? mine : 1u; nx = cnt > 0u ? cnt : 1u;
}

__device__ __forceinline__ void xcd_barrier(const XcdBarrier& b) {
    asm volatile("s_waitcnt vmcnt(0)" ::: "memory");
    __syncthreads();
    if (threadIdx.x == 0) {
        unsigned* bar = b.bar;
        __builtin_amdgcn_s_waitcnt(0);
        unsigned nloc = b.st[0], nx = b.st[1];
        if (nloc == 0u) { xcd_barrier_complete(bar, b.x, nloc, nx); b.st[0] = nloc; b.st[1] = nx; }
        const unsigned old = xb_add(&bar[XB_XSUB(b.x)], 1u);
        const unsigned gen = old / nloc;
        if (old + 1u == (gen + 1u) * nloc) {
            __builtin_amdgcn_fence(__ATOMIC_RELEASE, "agent");
            asm volatile("s_waitcnt vmcnt(0)" ::: "memory");
            const unsigned og = xb_add(&bar[XB_TOP], 1u);
            const unsigned tg = og / nx;
            if (og + 1u == (tg + 1u) * nx) xb_add(&bar[XB_TOPGEN], 1u);
            else XB_SPIN(xb_ld(&bar[XB_TOPGEN]) == tg, bar);
            __builtin_amdgcn_fence(__ATOMIC_ACQUIRE, "agent");
            xb_add(&bar[XB_XGEN(b.x)], 1u);
            asm volatile("s_waitcnt vmcnt(0)" ::: "memory");
        } else {
            XB_SPIN(xb_ld(&bar[XB_XGEN(b.x)]) == gen, bar);
            __builtin_amdgcn_fence(__ATOMIC_ACQUIRE, "agent");
            asm volatile("s_waitcnt vmcnt(0)" ::: "memory");
        }
    }
    __syncthreads();
}

#ifndef OPMASK
#define OPMASK 0xFFFFFFFFu
#endif
#define EN(o) ((OPMASK >> (o)) & 1u)
enum { OP_P0 = 0, OP_RMS1, OP_HG_IN, OP_HG_A, OP_HG_B, OP_HG_C, OP_MIX_OUT, OP_LR_IN, OP_LR_CONV, OP_LR_G, OP_LR_S1, OP_LR_S2, OP_LR_S3, OP_RMS2, OP_QK, OP_TOPK, OP_GATHER };
constexpr int NPH = 42;
#define REP_MASK 0u
__device__ __forceinline__ void decode_phase(int ph, int& l, int& op) {
    if (ph == 0) { l = 0; op = OP_P0; return; }
    if (ph == 1) { l = 0; op = OP_RMS1; return; }
    int q = ph - 2;
    if (q < 9) { l = 0; } else if (q < 20) { l = 1; q -= 9; } else if (q < 29) { l = 2; q -= 20; } else { l = 3; q -= 29; }
    if ((l & 1) == 0) { op = q == 0 ? OP_HG_IN : q == 1 ? OP_HG_A : q == 2 ? OP_HG_B : q == 3 ? OP_HG_C : q == 4 ? OP_MIX_OUT : q == 5 ? OP_RMS2 : q == 6 ? OP_QK : q == 7 ? OP_TOPK : OP_GATHER; }
    else { op = q == 0 ? OP_LR_IN : q == 1 ? OP_LR_CONV : q == 2 ? OP_LR_G : q == 3 ? OP_LR_S1 : q == 4 ? OP_LR_S2 : q == 5 ? OP_LR_S3 : q == 6 ? OP_MIX_OUT : q == 7 ? OP_RMS2 : q == 8 ? OP_QK : q == 9 ? OP_TOPK : OP_GATHER; }
}

__global__ __launch_bounds__(512, 2) void mk_fwd(Params p_arg) {
    extern __shared__ __attribute__((aligned(16))) unsigned char shm[];
    LAS unsigned char* lds = (LAS unsigned char*)shm;
    cg::grid_group grid = cg::this_grid();
    unsigned long long kpv = (unsigned long long)__builtin_amdgcn_kernarg_segment_ptr();
    const int ph_lo = p_arg.ph_lo, ph_hi = p_arg.ph_hi;
    volatile LAS unsigned* xst = (volatile LAS unsigned*)(lds + LDS_BYTES - 16);
    if (threadIdx.x == 0) { xst[0] = 0u; xst[1] = 0u; }
    __syncthreads();
    const XcdBarrier xb = xcd_barrier_post((unsigned*)(p_arg.ws + WS_CTL) + 1024, xst);
    for (int ph = ph_lo; ph < ph_hi; ++ph) {
        if (ph > ph_lo) { if (ph == 1) grid.sync(); else xcd_barrier(xb); }
        asm volatile("" : "+s"(kpv));
        KP p = (KP)kpv;
        unsigned char* ws = p->ws;
        const float* MOD = (const float*)(ws + WS_MOD);
        int l, op; decode_phase(ph, l, op);
        const int j = l >> 1;
        const int nrep = ((p->rep_mask >> op) & 1u) ? 2 : 1;
        for (int rep = 0; rep < nrep; ++rep) {
        const bool dry = rep + 1 < nrep;
#ifdef ONLY
        switch (ONLY) {
#else
        switch (op) {
#endif
        case OP_P0: if (EN(OP_P0)) phase0(p, lds); break;
        case OP_RMS1: if (EN(OP_RMS1)) phase_rms(p->x, p->norm_g, MOD, MOD + 1024, (bf16_t*)(ws + WS_HBUF)); break;
        case OP_HG_IN: if (EN(OP_HG_IN)) { EpiBf16 E; E.O = (bf16_t*)(ws + WS_PROJ); E.ldc = 5120;
            run_gemm(lds, (const bf16_t*)(ws + WS_HBUF), (const bf16_t*)(ws + WS_HGWIN) + (size_t)j * 5120 * 1024, 5120, 1024, 1024, 1024, 0, 0, E); } break;
        case OP_HG_A: if (EN(OP_HG_A)) hg_pass_a(p, lds, j); break;
        case OP_HG_B: if (EN(OP_HG_B)) hg_pass_b(p); break;
        case OP_HG_C: if (EN(OP_HG_C)) hg_pass_c(p, lds, j); break;
        case OP_MIX_OUT: if (EN(OP_MIX_OUT)) { EpiResid E; E.xin = (l == 0) ? p->x : (const float*)(ws + WS_XRES); E.xout = (float*)(ws + WS_XRES); E.gate = MOD + (size_t)l * 2 * 6144 + 2 * 1024; E.dry = dry;
            const bf16_t* W = (l & 1) ? (const bf16_t*)(ws + WS_LRWOUT) + (size_t)j * 1024 * 1024 : (const bf16_t*)(ws + WS_HGWOUT) + (size_t)j * 1024 * 1024;
            run_gemm(lds, (const bf16_t*)(ws + WS_OB), W, 1024, 1024, 1024, 1024, 0, 0, E); } break;
        case OP_LR_IN: if (EN(OP_LR_IN)) { EpiLruIn E; E.XB = (bf16_t*)(ws + WS_XB); E.YG = (bf16_t*)(ws + WS_YG);
            run_gemm(lds, (const bf16_t*)(ws + WS_HBUF), (const bf16_t*)(ws + WS_LRWIN) + (size_t)j * 2048 * 1024, 2048, 1024, 1024, 1024, 0, 0, E); } break;
        case OP_LR_CONV: if (EN(OP_LR_CONV)) lru_conv(p, j); break;
        case OP_LR_G: if (EN(OP_LR_G)) { EpiGates E; E.LOGA = (bf16_t*)(ws + WS_LOGA); E.BTERM = (bf16_t*)(ws + WS_BTERM); E.XC = (const bf16_t*)(ws + WS_XC);
            E.b_a = p->lru_b_a + (size_t)j * 2048; E.b_x = p->lru_b_x + (size_t)j * 2048; E.lam = p->lru_lam + (size_t)j * 2048;
            run_gemm(lds, (const bf16_t*)(ws + WS_XC), (const bf16_t*)(ws + WS_LRWG) + (size_t)j * 4 * 1024 * 256, 4096, 256, 1024, 256, 2, 512, E); } break;
        case OP_LR_S1: if (EN(OP_LR_S1)) lru_scan1(p, lds); break;
        case OP_LR_S2: if (EN(OP_LR_S2)) lru_scan2(p); break;
        case OP_LR_S3: if (EN(OP_LR_S3)) lru_scan3(p, lds); break;
        case OP_RMS2: if (EN(OP_RMS2)) phase_rms((const float*)(ws + WS_XRES), p->norm_g + ((size_t)l * 2 + 1) * 1024, MOD + (size_t)l * 2 * 6144 + 3 * 1024, MOD + (size_t)l * 2 * 6144 + 4 * 1024, (bf16_t*)(ws + WS_HBUF)); break;
        case OP_QK: if (EN(OP_QK)) { EpiScoresT E; E.C = (float*)(ws + WS_SCORES);
            run_gemm(lds, (const bf16_t*)(ws + WS_HBUF), (const bf16_t*)(ws + WS_WQK) + (size_t)l * 2048 * 1024, 2048, 1024, 1024, 1024, 0, 0, E); } break;
        case OP_TOPK: if (EN(OP_TOPK)) peer_topk(p, lds); break;
        case OP_GATHER: if (EN(OP_GATHER)) peer_gather(p, l, dry); break;
        default: break;
        }
        }
    }
}

extern "C" void kernel_launch(void* const* d_in, const int* in_sizes, int n_in, void* d_out, int out_size, void* d_ws, size_t ws_size, hipStream_t stream) {
    static int grid = 0;
    if (grid == 0) {
        if (n_in != 23 || ws_size < WS_END) { fprintf(stderr, "kernel_launch: unexpected n_in %d / ws_size %zu (need %zu)\n", n_in, ws_size, (size_t)WS_END); grid = -1; return; }
        int dev = 0, cus = 0, per_cu = 0;
        hipGetDevice(&dev); hipDeviceGetAttribute(&cus, hipDeviceAttributeMultiprocessorCount, dev);
        if (hipFuncSetAttribute((const void*)mk_fwd, hipFuncAttributeMaxDynamicSharedMemorySize, LDS_BYTES) != hipSuccess) { fprintf(stderr, "kernel_launch: hipFuncSetAttribute failed\n"); grid = -1; return; }
        if (hipOccupancyMaxActiveBlocksPerMultiprocessor(&per_cu, (const void*)mk_fwd, NTHR, LDS_BYTES) != hipSuccess || per_cu < 1) { fprintf(stderr, "kernel_launch: occupancy query failed (%d)\n", per_cu); (void)hipGetLastError(); per_cu = 1; }
        grid = cus * 1;
        fprintf(stderr, "kernel_launch: cus %d per_cu %d grid %d\n", cus, per_cu, grid);
    }
    if (grid < 0) return;
    if (hipMemsetAsync((char*)d_ws + WS_CTL, 0, 65536, stream) != hipSuccess) { fprintf(stderr, "kernel_launch: memset failed\n"); return; }
    Params p{};
    const float** pp = (const float**)&p;
    for (int i = 0; i < 23; ++i) pp[i] = (const float*)d_in[i];
    p.out = (float*)d_out; p.ws = (unsigned char*)d_ws; p.ph_lo = 0; p.ph_hi = NPH; p.rep_mask = REP_MASK;
    void* args[] = {&p};
    hipError_t e = hipLaunchCooperativeKernel((const void*)mk_fwd, dim3(grid), dim3(NTHR), args, LDS_BYTES, stream);
    if (e != hipSuccess) fprintf(stderr, "kernel_launch: cooperative launch failed: %s (grid %d)\n", hipGetErrorString(e), grid);
}
```

```cpp
#include <hip/hip_runtime.h>
#include <hip/hip_cooperative_groups.h>
#include <cstdio>
#include <cstdint>
namespace cg = cooperative_groups;

#define LAS __attribute__((address_space(3)))
#define PG8_LAS __attribute__((address_space(3)))
typedef unsigned short bf16_t;
typedef short bf16x8 __attribute__((ext_vector_type(8)));
typedef float f32x4 __attribute__((ext_vector_type(4)));
typedef float f32x2 __attribute__((ext_vector_type(2)));
typedef unsigned u32x4 __attribute__((ext_vector_type(4)));
typedef unsigned u32x2 __attribute__((ext_vector_type(2)));

constexpr int T = 16384, D = 1024, SEQ = 8192, DEPTH = 4;
constexpr float EPS = 1e-6f;
constexpr int NBLK = 256, NTHR = 512, NWAVE = 8, NGW = NBLK * NWAVE;

constexpr size_t MiB = 1u << 20;
constexpr size_t WS_CTL = 0;
constexpr size_t WS_MOD = 1 * MiB;
constexpr size_t WS_HGWIN = 2 * MiB;
constexpr size_t WS_HGWOUT = 22 * MiB;
constexpr size_t WS_LRWIN = 26 * MiB;
constexpr size_t WS_LRWG = 34 * MiB;
constexpr size_t WS_LRWOUT = 38 * MiB;
constexpr size_t WS_WQK = 42 * MiB;
constexpr size_t WS_TOPI = 58 * MiB;
constexpr size_t WS_TOPG = 66 * MiB;
constexpr size_t WS_DEC = 74 * MiB;
constexpr size_t WS_CP = 75 * MiB;
constexpr size_t WS_CH = 79 * MiB;
constexpr size_t WS_HIN = 83 * MiB;
constexpr size_t WS_USC = 87 * MiB;
constexpr size_t WS_VSC = 87 * MiB + 262144;
constexpr size_t WS_XRES = 88 * MiB;
constexpr size_t WS_HBUF = 152 * MiB;
constexpr size_t WS_OB = 184 * MiB;
constexpr size_t WS_PROJ = 216 * MiB;
constexpr size_t WS_XB = WS_PROJ, WS_YG = WS_PROJ + 32 * MiB, WS_XC = WS_PROJ + 64 * MiB, WS_LOGA = WS_PROJ + 96 * MiB;
constexpr size_t WS_SCORES = WS_PROJ;
constexpr size_t WS_KV = 376 * MiB;
constexpr size_t WS_BTERM = WS_KV;
constexpr size_t WS_SIN = 504 * MiB;
constexpr size_t WS_UTAB = 568 * MiB;
constexpr size_t WS_VTAB = 696 * MiB;
constexpr size_t WS_END = 824 * MiB;

constexpr int LDS_BYTES = 155648;

#define LAUNDER_IDS int tidL = threadIdx.x, bidL = blockIdx.x; asm volatile("" : "+v"(tidL)); asm volatile("" : "+s"(bidL));
__device__ __forceinline__ float bf2f(bf16_t b) { return __uint_as_float(((unsigned)b) << 16); }
__device__ __forceinline__ float bflo(unsigned u) { return __uint_as_float(u << 16); }
__device__ __forceinline__ float bfhi(unsigned u) { return __uint_as_float(u & 0xffff0000u); }
__device__ __forceinline__ unsigned cvt_pk_bf16(float lo, float hi) { unsigned r; asm volatile("v_cvt_pk_bf16_f32 %0, %1, %2" : "=v"(r) : "v"(lo), "v"(hi)); return r; }
__device__ __forceinline__ bf16_t f2bf(float f) { return (bf16_t)(cvt_pk_bf16(f, 0.f) & 0xffffu); }
__device__ __forceinline__ float fast_exp(float x) { return __builtin_amdgcn_exp2f(x * 1.4426950408889634f); }
__device__ __forceinline__ float fast_log(float x) { return __builtin_amdgcn_logf(x) * 0.6931471805599453f; }
__device__ __forceinline__ float fast_rcp(float x) { return __builtin_amdgcn_rcpf(x); }
__device__ __forceinline__ float sigmoidf_(float x) { return fast_rcp(1.f + fast_exp(-x)); }
__device__ __forceinline__ float gelu_tanh(float x) { const float u = 1.5957691216057308f * (x + 0.044715f * x * x * x); return x * fast_rcp(1.f + fast_exp(-u)); }
__device__ __forceinline__ float silu_(float x) { return x * sigmoidf_(x); }
__device__ __forceinline__ float wave_sum(float v) {
#pragma unroll
    for (int o = 1; o < 64; o <<= 1) v += __shfl_xor(v, o);
    return v;
}
__device__ __forceinline__ float wave_max(float v) {
#pragma unroll
    for (int o = 1; o < 64; o <<= 1) v = fmaxf(v, __shfl_xor(v, o));
    return v;
}

namespace pg8 {
constexpr int BM = 256, BK = 64, HALF = 128, HTB = HALF * BK * 2, STAGE_BYTES = 8 * HTB, NXCD = 8, WGM = 8;
__host__ __device__ __forceinline__ int lds_byte(int r, int c) { const int st = (r >> 4) * 2 + (c >> 5), rr = r & 15, cc = c & 31, ob = rr * 64 + cc * 2; return st * 1024 + (ob ^ (((ob >> 9) & 1) << 5)); }
__host__ __device__ __forceinline__ void stage_rc(int b, int& R, int& C) { const int st = b / 1024, sb = b % 1024, swz = sb ^ (((sb >> 9) & 1) << 5); R = (st >> 1) * 16 + swz / 64; C = (st & 1) * 32 + (swz % 64) / 2; }
__host__ __device__ __forceinline__ int perm32(int rho) { const int n = rho >> 4, i = rho & 15; return 8 * (i >> 2) + 4 * n + (i & 3); }
struct Unit { int pm, pn; };
struct Gemm { const bf16_t* A; const bf16_t* Bt; int M, N, K, lda, ldb, a_pn_shift, a_pn_stride; };
struct StaticOrder {
    int nM, nN, nwg, G, c;
    __host__ __device__ void init(int M, int N, int G_, int c_) { nM = M / BM; nN = N / BM; nwg = nM * nN; G = G_; c = c_; }
    __host__ __device__ bool next(int i, Unit& u) const {
        const long L = (long)i * G + c; if (L >= nwg) return false;
        int wgid = (int)L; { const int q = nwg / NXCD, r = nwg % NXCD, xcd = wgid % NXCD, off = wgid / NXCD; wgid = (xcd < r ? xcd * (q + 1) : r * (q + 1) + (xcd - r) * q) + off; }
        const int nig = WGM * nN, gid = wgid / nig, fm = gid * WGM, gsz = (nM - fm) < WGM ? (nM - fm) : WGM;
        u.pm = fm + ((wgid % nig) % gsz); u.pn = (wgid % nig) / gsz; return true;
    }
    __device__ __forceinline__ void a_ready(const Unit&) const {}
    __device__ __forceinline__ void done(const Unit&) const {}
};
template <class Epi, class Sched, bool STAMP = false>
__device__ __forceinline__ void gemm_phase(PG8_LAS unsigned char* lds, const Gemm g, const Sched& S, const Epi& E, unsigned long long* stamps) {
    int tid = threadIdx.x; asm volatile("" : "+v"(tid)); const int wid = __builtin_amdgcn_readfirstlane(tid >> 6), lane = tid & 63, wr = wid >> 2, wc = wid & 3, fr = lane & 15, fq = lane >> 4;
    const int K = g.K, nt = K / BK;
    int ts_lo = 0, ts_hi = 0, nts = 0; const unsigned long long rt_entry = STAMP ? (unsigned long long)wall_clock64() : 0ull;
#define PG8_STAMP() do { if (STAMP && wid == 0 && nts < 64) { const unsigned long long _c = (unsigned long long)clock64(); \
        ts_lo = (lane == nts) ? (int)(unsigned)_c : ts_lo; ts_hi = (lane == nts) ? (int)(unsigned)(_c >> 32) : ts_hi; ++nts; } } while (0)
    PG8_STAMP();
    unsigned voffA[2], voffB[2];
#pragma unroll
    for (int i = 0; i < 2; ++i) { int R, C; stage_rc(tid * 16 + i * 8192, R, C); const int Rb = Epi::PERM ? ((R & ~31) + perm32(R & 31)) : R;
        voffA[i] = (unsigned)(R * g.lda + C) * 2u; voffB[i] = (unsigned)(Rb * g.ldb + C) * 2u; }
    const size_t kstep = (size_t)(BK * 2);
    const size_t hstepA = (size_t)HALF * g.lda * 2, hstepB = (size_t)HALF * g.ldb * 2;
    const size_t tstepA = 2 * hstepA, tstepB = 2 * hstepB;
    const unsigned ldsw = (unsigned)wid * 1024u;
    const int aoff = lds_byte(wr * 64 + fr, fq * 8), boff = lds_byte(wc * 32 + fr, fq * 8);
#define PG8_SA(b, h) (((b) * 2 + (h)) * HTB)
#define PG8_SB(b, h) ((4 + (b) * 2 + (h)) * HTB)
#define PG8_STAGE(bufoff, gbase, voff) do { _Pragma("unroll") for (int _i = 0; _i < 2; ++_i) \
        __builtin_amdgcn_global_load_lds((const unsigned*)((const char*)(gbase) + (voff)[_i]), (PG8_LAS unsigned*)(lds + (bufoff) + ldsw + _i * 8192), 16, 0, 0); } while (0)
#define PG8_LDA(dst, b, h) do { _Pragma("unroll") for (int m = 0; m < 4; ++m) _Pragma("unroll") for (int k = 0; k < 2; ++k) dst[m][k] = *(const PG8_LAS bf16x8*)(lds + PG8_SA(b, h) + aoff + m * 2048 + k * 1024); } while (0)
#define PG8_LDB(dst, b, h) do { _Pragma("unroll") for (int n = 0; n < 2; ++n) _Pragma("unroll") for (int k = 0; k < 2; ++k) dst[n][k] = *(const PG8_LAS bf16x8*)(lds + PG8_SB(b, h) + boff + n * 2048 + k * 1024); } while (0)
#define PG8_MMA(ai, bj, At, Bt) do { __builtin_amdgcn_s_setprio(1); _Pragma("unroll") for (int m = 0; m < 4; ++m) _Pragma("unroll") for (int n = 0; n < 2; ++n) _Pragma("unroll") for (int k = 0; k < 2; ++k) \
        acc[ai][bj][m][n] = Epi::SWAP ? __builtin_amdgcn_mfma_f32_16x16x32_bf16(At[m][k], Bt[n][k], acc[ai][bj][m][n], 0, 0, 0) : __builtin_amdgcn_mfma_f32_16x16x32_bf16(Bt[n][k], At[m][k], acc[ai][bj][m][n], 0, 0, 0); __builtin_amdgcn_s_setprio(0); } while (0)
#define PG8_WAIT_V(n) asm volatile("s_waitcnt vmcnt(" #n ")" ::: "memory")
#define PG8_WAIT_L(n) asm volatile("s_waitcnt lgkmcnt(" #n ")" ::: "memory")
#define PG8_BAR __builtin_amdgcn_s_barrier()
#define PG8_SCHED __builtin_amdgcn_sched_barrier(0)
    Unit cur, nxt; int ui = 0;
    if (!S.next(0, cur)) return;
    f32x4 acc[2][2][4][2];
#pragma unroll
    for (int a = 0; a < 2; ++a)
#pragma unroll
        for (int b = 0; b < 2; ++b)
#pragma unroll
            for (int m = 0; m < 4; ++m)
#pragma unroll
                for (int n = 0; n < 2; ++n) acc[a][b][m][n] = (f32x4){0.f, 0.f, 0.f, 0.f};
    bf16x8 At[4][2], B0[2][2], B1[2][2];
    const char* cA = (const char*)g.A + (size_t)cur.pm * tstepA + (size_t)(cur.pn >> g.a_pn_shift) * g.a_pn_stride; const char* cB = (const char*)g.Bt + (size_t)cur.pn * tstepB;
    S.a_ready(cur);
    PG8_STAGE(PG8_SB(0, 0), cB, voffB); PG8_STAGE(PG8_SA(0, 0), cA, voffA); PG8_STAGE(PG8_SB(0, 1), cB + hstepB, voffB); PG8_STAGE(PG8_SA(0, 1), cA + hstepA, voffA);
    if (wr == 1) PG8_BAR;
    PG8_WAIT_V(4); PG8_BAR;
    PG8_STAGE(PG8_SB(1, 0), cB + kstep, voffB); PG8_STAGE(PG8_SA(1, 0), cA + kstep, voffA); PG8_STAGE(PG8_SB(1, 1), cB + hstepB + kstep, voffB);
    PG8_WAIT_V(6); PG8_BAR;
    PG8_STAMP();
    for (;;) {
        const bool has_next = S.next(ui + 1, nxt);
        const char* nA = has_next ? (const char*)g.A + (size_t)nxt.pm * tstepA + (size_t)(nxt.pn >> g.a_pn_shift) * g.a_pn_stride : cA; const char* nB = has_next ? (const char*)g.Bt + (size_t)nxt.pn * tstepB : cB;
#pragma unroll 1
        for (int t = 0; t < nt; t += 2) {
            const bool last = (t == nt - 2);
            const char* a1 = cA + (size_t)(t + 1) * kstep;
            const char* a2 = last ? nA : cA + (size_t)(t + 2) * kstep; const char* b2 = last ? nB : cB + (size_t)(t + 2) * kstep;
            const char* a3 = a2 + kstep; const char* b3 = b2 + kstep;
            if (last && has_next) S.a_ready(nxt);
            PG8_LDB(B0, 0, 0); PG8_SCHED; PG8_LDA(At, 0, 0); PG8_STAGE(PG8_SA(1, 1), a1 + hstepA, voffA);
            PG8_WAIT_L(8); PG8_BAR; PG8_WAIT_L(0); PG8_MMA(0, 0, At, B0); PG8_BAR; PG8_SCHED;
            PG8_LDB(B1, 0, 1); PG8_STAGE(PG8_SB(0, 0), b2, voffB);
            PG8_BAR; PG8_WAIT_L(0); PG8_MMA(0, 1, At, B1); PG8_BAR;
            PG8_LDA(At, 0, 1); PG8_STAGE(PG8_SA(0, 0), a2, voffA);
            PG8_BAR; PG8_WAIT_L(0); PG8_MMA(1, 0, At, B0); PG8_BAR; PG8_SCHED;
            PG8_STAGE(PG8_SB(0, 1), b2 + hstepB, voffB);
            PG8_WAIT_V(6); PG8_BAR; PG8_MMA(1, 1, At, B1); PG8_BAR;
            PG8_LDB(B0, 1, 0); PG8_SCHED; PG8_LDA(At, 1, 0); PG8_STAGE(PG8_SA(0, 1), a2 + hstepA, voffA);
            PG8_WAIT_L(8); PG8_BAR; PG8_WAIT_L(0); PG8_MMA(0, 0, At, B0); PG8_BAR; PG8_SCHED;
            PG8_LDB(B1, 1, 1); PG8_STAGE(PG8_SB(1, 0), b3, voffB);
            PG8_BAR; PG8_WAIT_L(0); PG8_MMA(0, 1, At, B1); PG8_BAR;
            PG8_LDA(At, 1, 1); PG8_STAGE(PG8_SA(1, 0), a3, voffA);
            PG8_BAR; PG8_WAIT_L(0); PG8_MMA(1, 0, At, B0); PG8_BAR; PG8_SCHED;
            PG8_STAGE(PG8_SB(1, 1), b3 + hstepB, voffB);
            PG8_WAIT_V(6); PG8_BAR; PG8_MMA(1, 1, At, B1); PG8_BAR;
        }
        PG8_STAMP();
        if constexpr (!Epi::AFTER_DRAIN) { E(acc, cur, wr, wc, fr, fq); S.done(cur); }
        PG8_STAMP();
        if (!has_next) break;
#pragma unroll
        for (int a = 0; a < 2; ++a)
#pragma unroll
            for (int b = 0; b < 2; ++b)
#pragma unroll
                for (int m = 0; m < 4; ++m)
#pragma unroll
                    for (int n = 0; n < 2; ++n) acc[a][b][m][n] = (f32x4){0.f, 0.f, 0.f, 0.f};
        cur = nxt; cA = nA; cB = nB; ++ui;
    }
    PG8_WAIT_V(0);
    if (wr == 0) PG8_BAR;
    PG8_BAR;
    if constexpr (Epi::AFTER_DRAIN) { E.fused(acc, cur, wr, wc, fr, fq, lds, wid, lane); S.done(cur); }
    PG8_STAMP();
    if (STAMP && wid == 0) { stamps[lane] = lane < nts ? (((unsigned long long)(unsigned)ts_hi << 32) | (unsigned)ts_lo) : 0ull;
        if (lane == 62) stamps[62] = rt_entry; if (lane == 63) stamps[63] = (unsigned long long)wall_clock64(); }
#undef PG8_STAMP
#undef PG8_SA
#undef PG8_SB
#undef PG8_STAGE
#undef PG8_LDA
#undef PG8_LDB
#undef PG8_MMA
#undef PG8_WAIT_V
#undef PG8_WAIT_L
#undef PG8_BAR
#undef PG8_SCHED
}
}
using pg8::Unit;

struct EpiBf16 {
    static constexpr bool PERM = true, AFTER_DRAIN = false, SWAP = false;
    bf16_t* O; int ldc;
    __device__ __forceinline__ void operator()(const f32x4 (&acc)[2][2][4][2], const Unit& u, int wr, int wc, int fr, int fq) const {
        const int row0 = u.pm * 256 + wr * 64 + fr, col0 = u.pn * 256 + wc * 32 + 8 * fq;
#pragma unroll
        for (int ai = 0; ai < 2; ++ai)
#pragma unroll
            for (int m = 0; m < 4; ++m) { bf16_t* rowp = O + (size_t)(row0 + ai * 128 + m * 16) * ldc + col0;
#pragma unroll
                for (int bj = 0; bj < 2; ++bj) { const f32x4 v0 = acc[ai][bj][m][0], v1 = acc[ai][bj][m][1];
                    u32x4 o; o.x = cvt_pk_bf16(v0[0], v0[1]); o.y = cvt_pk_bf16(v0[2], v0[3]); o.z = cvt_pk_bf16(v1[0], v1[1]); o.w = cvt_pk_bf16(v1[2], v1[3]);
                    *(u32x4*)(rowp + bj * 128) = o; } }
    }
};
struct EpiLruIn {
    static constexpr bool PERM = true, AFTER_DRAIN = false, SWAP = false;
    bf16_t* XB; bf16_t* YG;
    __device__ __forceinline__ void operator()(const f32x4 (&acc)[2][2][4][2], const Unit& u, int wr, int wc, int fr, int fq) const {
        const bool isy = u.pn >= 4;
        bf16_t* O = isy ? YG : XB;
        const int row0 = u.pm * 256 + wr * 64 + fr, col0 = (u.pn & 3) * 256 + wc * 32 + 8 * fq;
#pragma unroll
        for (int ai = 0; ai < 2; ++ai)
#pragma unroll
            for (int m = 0; m < 4; ++m) { bf16_t* rowp = O + (size_t)(row0 + ai * 128 + m * 16) * 1024 + col0;
#pragma unroll
                for (int bj = 0; bj < 2; ++bj) { f32x4 v0 = acc[ai][bj][m][0], v1 = acc[ai][bj][m][1];
                    if (isy) {
#pragma unroll
                        for (int i = 0; i < 4; ++i) { v0[i] = gelu_tanh(v0[i]); v1[i] = gelu_tanh(v1[i]); } }
                    u32x4 o; o.x = cvt_pk_bf16(v0[0], v0[1]); o.y = cvt_pk_bf16(v0[2], v0[3]); o.z = cvt_pk_bf16(v1[0], v1[1]); o.w = cvt_pk_bf16(v1[2], v1[3]);
                    *(u32x4*)(rowp + bj * 128) = o; } }
    }
};
struct EpiGates {
    static constexpr bool PERM = true, AFTER_DRAIN = false, SWAP = false;
    bf16_t* LOGA; bf16_t* BTERM; const bf16_t* XC; const float* b_a; const float* b_x; const float* lam;
    __device__ __forceinline__ void operator()(const f32x4 (&acc)[2][2][4][2], const Unit& u, int wr, int wc, int fr_, int fq) const {
        int fr = fr_; asm volatile("" : "+v"(fr));
        const int nblk = u.pn >> 2, uu = u.pn & 3, d = uu >> 1, jh = uu & 1;
        const int colbase = nblk * 256 + jh * 128 + wc * 32 + 8 * fq;
        const unsigned off0 = (unsigned)(u.pm * 256 + wr * 64 + fr) * 1024u + (unsigned)colbase;
        const bf16_t* xcp = XC; bf16_t* lap = LOGA + (size_t)d * T * 1024; bf16_t* btp = BTERM + (size_t)d * T * 1024;
        const float* bap = b_a + d * 1024; const float* bxp = b_x + d * 1024; const float* lmp = lam + d * 1024;
#pragma unroll
        for (int ai = 0; ai < 2; ++ai)
#pragma unroll
            for (int m = 0; m < 4; ++m) { const unsigned off = off0 + (unsigned)(ai * 128 + m * 16) * 1024u;
                asm volatile("" ::: "memory"); __builtin_amdgcn_sched_barrier(0);
                const u32x4 xr = *(const u32x4*)(xcp + off);
                const float xv[8] = {bflo(xr.x), bfhi(xr.x), bflo(xr.y), bfhi(xr.y), bflo(xr.z), bfhi(xr.z), bflo(xr.w), bfhi(xr.w)};
                unsigned o1[4], o2[4];
#pragma unroll
                for (int n = 0; n < 2; ++n) { const f32x4 ba = *(const f32x4*)(bap + (unsigned)(colbase + 4 * n)), bx = *(const f32x4*)(bxp + (unsigned)(colbase + 4 * n)), lm = *(const f32x4*)(lmp + (unsigned)(colbase + 4 * n));
                    float la[4], bt[4];
#pragma unroll
                    for (int i = 0; i < 4; ++i) { const float r = sigmoidf_(acc[ai][0][m][n][i] + ba[i]), ig = sigmoidf_(acc[ai][1][m][n][i] + bx[i]);
                        const float l = -8.f * fast_log(1.f + fast_exp(-lm[i])) * r; const float mult = __builtin_sqrtf(fmaxf(1.f - fast_exp(2.f * l), 0.f));
                        la[i] = l; bt[i] = mult * ig * xv[n * 4 + i]; }
                    o1[n * 2] = cvt_pk_bf16(la[0], la[1]); o1[n * 2 + 1] = cvt_pk_bf16(la[2], la[3]); o2[n * 2] = cvt_pk_bf16(bt[0], bt[1]); o2[n * 2 + 1] = cvt_pk_bf16(bt[2], bt[3]); }
                *(u32x4*)(lap + off) = (u32x4){o1[0], o1[1], o1[2], o1[3]}; *(u32x4*)(btp + off) = (u32x4){o2[0], o2[1], o2[2], o2[3]}; }
    }
};
struct EpiResid {
    static constexpr bool PERM = false, AFTER_DRAIN = false, SWAP = false;
    const float* xin; float* xout; const float* gate; bool dry;
    __device__ __forceinline__ void operator()(const f32x4 (&acc)[2][2][4][2], const Unit& u, int wr, int wc, int fr, int fq) const {
        const int row0 = u.pm * 256 + wr * 64 + fr, col0 = u.pn * 256 + wc * 32 + 4 * fq;
        const float* gp = gate + ((u.pm * 256) >> 13) * 6144 + col0;
        f32x4 gv[2][2];
#pragma unroll
        for (int bj = 0; bj < 2; ++bj)
#pragma unroll
            for (int n = 0; n < 2; ++n) gv[bj][n] = *(const f32x4*)(gp + bj * 128 + n * 16);
#pragma unroll
        for (int ai = 0; ai < 2; ++ai)
#pragma unroll
            for (int m = 0; m < 4; ++m) { const size_t off = (size_t)(row0 + ai * 128 + m * 16) * 1024 + col0;
#pragma unroll
                for (int bj = 0; bj < 2; ++bj)
#pragma unroll
                    for (int n = 0; n < 2; ++n) { const f32x4 xv = *(const f32x4*)(xin + off + bj * 128 + n * 16);
                        if (!dry) *(f32x4*)(xout + off + bj * 128 + n * 16) = xv + gv[bj][n] * acc[ai][bj][m][n]; } }
    }
};
struct EpiScoresT {
    static constexpr bool PERM = false, AFTER_DRAIN = false, SWAP = true;
    float* C;
    __device__ __forceinline__ void operator()(const f32x4 (&acc)[2][2][4][2], const Unit& u, int wr, int wc, int fr_, int fq) const {
        int fr = fr_; asm volatile("" : "+v"(fr));
        const unsigned off0 = (unsigned)(u.pn * 256 + wc * 32 + fr) * (unsigned)T + (unsigned)(u.pm * 256 + wr * 64 + 4 * fq);
#pragma unroll
        for (int ai = 0; ai < 2; ++ai)
#pragma unroll
            for (int m = 0; m < 4; ++m)
#pragma unroll
                for (int bj = 0; bj < 2; ++bj)
#pragma unroll
                    for (int n = 0; n < 2; ++n) *(f32x4*)(C + (off0 + (unsigned)(bj * 128 + n * 16) * (unsigned)T + (unsigned)(ai * 128 + m * 16))) = acc[ai][bj][m][n];
    }
};

struct Params {
    const float *x, *c, *w_ada, *b_ada, *norm_g, *hg_w_in, *hg_lb, *hg_norm_g, *hg_w_out, *lru_w_in, *lru_conv_w, *lru_conv_b,
        *lru_w_a, *lru_b_a, *lru_w_x, *lru_b_x, *lru_lam, *lru_w_out, *peer_w_q, *peer_keys, *peer_u, *peer_v, *final_g;
    float* out; unsigned char* ws; int ph_lo, ph_hi; unsigned rep_mask; int pad_;
};

typedef const __attribute__((address_space(4))) Params* KP;

template <class Epi>
__device__ __forceinline__ void run_gemm(LAS unsigned char* lds, const bf16_t* A, const bf16_t* Bt, int N, int K, int lda, int ldb, int a_pn_shift, int a_pn_stride, const Epi& E) {
    pg8::Gemm g; g.A = A; g.Bt = Bt; g.M = T; g.N = N; g.K = K; g.lda = lda; g.ldb = ldb; g.a_pn_shift = a_pn_shift; g.a_pn_stride = a_pn_stride;
    LAUNDER_IDS
    pg8::StaticOrder S; S.init(T, N, (int)gridDim.x, bidL); (void)tidL;
    pg8::gemm_phase<Epi, pg8::StaticOrder, false>(lds, g, S, E, nullptr);
    __syncthreads();
}

__device__ __forceinline__ void transpose_tile(const float* __restrict__ src, int ld_src, bf16_t* dst, int ld_dst, LAS float* tile, int tid) {
#pragma unroll
    for (int it = 0; it < 2; ++it) { const int r = (tid >> 4) + 32 * it, c4 = (tid & 15) * 4;
        const f32x4 v = *(const f32x4*)(src + (size_t)r * ld_src + c4);
        tile[r * 65 + c4 + 0] = v[0]; tile[r * 65 + c4 + 1] = v[1]; tile[r * 65 + c4 + 2] = v[2]; tile[r * 65 + c4 + 3] = v[3]; }
    __syncthreads();
    { const int n = tid >> 3, kc = tid & 7; const LAS float* s = tile + (kc * 8) * 65 + n;
        u32x4 o; o.x = cvt_pk_bf16(s[0], s[65]); o.y = cvt_pk_bf16(s[2 * 65], s[3 * 65]); o.z = cvt_pk_bf16(s[4 * 65], s[5 * 65]); o.w = cvt_pk_bf16(s[6 * 65], s[7 * 65]);
        *(u32x4*)(dst + (size_t)n * ld_dst + kc * 8) = o; }
    __syncthreads();
}

__device__ __forceinline__ void phase0(KP p, LAS unsigned char* lds) {
    LAUNDER_IDS
    const int tid = tidL, wave = tid >> 6, lane = tid & 63;
    unsigned char* ws = p->ws;
    LAS float* tile = (LAS float*)lds;
    constexpr int I_HGIN = 16 * 80, I_SQ = 16 * 16, I_LRIN = 16 * 32, I_G = 16;
    constexpr int N_A = 2 * I_HGIN + 2 * I_SQ + 2 * I_LRIN + 2 * I_SQ + 32 * I_G;
    for (int it = bidL; it < N_A; it += gridDim.x) {
        int r = it;
        if (r < 2 * I_HGIN) { const int j = r / I_HGIN, q = r % I_HGIN, kb = q / 80, nb = q % 80;
            transpose_tile(p->hg_w_in + (size_t)j * 1024 * 5120 + (size_t)kb * 64 * 5120 + nb * 64, 5120, (bf16_t*)(ws + WS_HGWIN) + (size_t)j * 5120 * 1024 + (size_t)nb * 64 * 1024 + kb * 64, 1024, tile, tid); continue; }
        r -= 2 * I_HGIN;
        if (r < 2 * I_SQ) { const int j = r / I_SQ, q = r % I_SQ, kb = q / 16, nb = q % 16;
            transpose_tile(p->hg_w_out + (size_t)j * 1024 * 1024 + (size_t)kb * 64 * 1024 + nb * 64, 1024, (bf16_t*)(ws + WS_HGWOUT) + (size_t)j * 1024 * 1024 + (size_t)nb * 64 * 1024 + kb * 64, 1024, tile, tid); continue; }
        r -= 2 * I_SQ;
        if (r < 2 * I_LRIN) { const int j = r / I_LRIN, q = r % I_LRIN, kb = q / 32, nb = q % 32;
            transpose_tile(p->lru_w_in + (size_t)j * 1024 * 2048 + (size_t)kb * 64 * 2048 + nb * 64, 2048, (bf16_t*)(ws + WS_LRWIN) + (size_t)j * 2048 * 1024 + (size_t)nb * 64 * 1024 + kb * 64, 1024, tile, tid); continue; }
        r -= 2 * I_LRIN;
        if (r < 2 * I_SQ) { const int j = r / I_SQ, q = r % I_SQ, kb = q / 16, nb = q % 16;
            transpose_tile(p->lru_w_out + (size_t)j * 1024 * 1024 + (size_t)kb * 64 * 1024 + nb * 64, 1024, (bf16_t*)(ws + WS_LRWOUT) + (size_t)j * 1024 * 1024 + (size_t)nb * 64 * 1024 + kb * 64, 1024, tile, tid); continue; }
        r -= 2 * I_SQ;
        { const int mat = r / I_G, q = r % I_G, kb = q / 4, nb = q % 4;
            const int nblk = mat & 3, gate = (mat >> 2) & 1, d = (mat >> 3) & 1, l = mat >> 4;
            const float* src = (gate ? p->lru_w_x : p->lru_w_a) + (size_t)((l * 2 + d) * 4 + nblk) * 65536 + (size_t)kb * 64 * 256 + nb * 64;
            const int n0 = nb * 64, jh = n0 >> 7;
            bf16_t* dst = (bf16_t*)(ws + WS_LRWG) + (size_t)l * 4 * 1024 * 256 + (size_t)nblk * 1024 * 256 + (size_t)((d * 2 + jh) * 256 + gate * 128 + (n0 & 127)) * 256 + kb * 64;
            transpose_tile(src, 256, dst, 256, tile, tid); }
    }
    {
        LAS float* keysL = (LAS float*)lds;
        LAS float* wqL = (LAS float*)(lds + 128 * 132 * 4);
        for (int it = bidL; it < 1024; it += gridDim.x) {
            const int l = it >> 8, hp = (it >> 4) & 15, dt = it & 15;
            const float* kp = p->peer_keys + ((size_t)l * 16 + hp) * 16384;
#pragma unroll
            for (int q = 0; q < 8; ++q) { const int e = (tid + 512 * q) * 4; const f32x4 v = *(const f32x4*)(kp + e); *(LAS f32x4*)(keysL + (e >> 7) * 132 + (e & 127)) = v; }
            const float* wp = p->peer_w_q + (size_t)l * 1024 * 2048 + (size_t)(dt * 64) * 2048 + hp * 128;
#pragma unroll
            for (int q = 0; q < 4; ++q) { const int e = (tid + 512 * q) * 4; const f32x4 v = *(const f32x4*)(wp + (size_t)(e >> 7) * 2048 + (e & 127)); *(LAS f32x4*)(wqL + e) = v; }
            __syncthreads();
            const int key = tid & 127, g = tid >> 7;
            float acc[16];
#pragma unroll
            for (int i = 0; i < 16; ++i) acc[i] = 0.f;
            for (int d4 = 0; d4 < 128; d4 += 4) {
                const f32x4 kv = *(const LAS f32x4*)(keysL + key * 132 + d4);
#pragma unroll
                for (int i = 0; i < 16; ++i) { const f32x4 wv = *(const LAS f32x4*)(wqL + (g * 16 + i) * 128 + d4);
                    acc[i] += kv[0] * wv[0] + kv[1] * wv[1] + kv[2] * wv[2] + kv[3] * wv[3]; }
            }
            bf16_t* op = (bf16_t*)(ws + WS_WQK) + (size_t)l * 2048 * 1024 + (size_t)(hp * 128 + key) * 1024 + dt * 64 + g * 16;
            u32x4 o1, o2; o1.x = cvt_pk_bf16(acc[0], acc[1]); o1.y = cvt_pk_bf16(acc[2], acc[3]); o1.z = cvt_pk_bf16(acc[4], acc[5]); o1.w = cvt_pk_bf16(acc[6], acc[7]);
            o2.x = cvt_pk_bf16(acc[8], acc[9]); o2.y = cvt_pk_bf16(acc[10], acc[11]); o2.z = cvt_pk_bf16(acc[12], acc[13]); o2.w = cvt_pk_bf16(acc[14], acc[15]);
            *(u32x4*)op = o1; *(u32x4*)(op + 8) = o2;
            __syncthreads();
        }
    }
    {
        LAS float* condL = (LAS float*)lds;
        LAS float* red = (LAS float*)(lds + 8192);
        for (int i = tid; i < 2048; i += NTHR) condL[i] = silu_(p->c[i]);
        __syncthreads();
        for (int it = bidL; it < 4 * 48; it += gridDim.x) {
            const int l = it / 48, col0 = (it % 48) * 128;
            const float* wp = p->w_ada + (size_t)l * 1024 * 6144 + col0 + 2 * lane;
            float a00 = 0.f, a01 = 0.f, a10 = 0.f, a11 = 0.f;
#pragma unroll 8
            for (int kk = 0; kk < 128; ++kk) { const int k = wave * 128 + kk; const f32x2 w = *(const f32x2*)(wp + (size_t)k * 6144);
                const float c0 = condL[k], c1 = condL[1024 + k];
                a00 += c0 * w[0]; a01 += c0 * w[1]; a10 += c1 * w[0]; a11 += c1 * w[1]; }
            red[(wave * 2 + 0) * 128 + 2 * lane] = a00; red[(wave * 2 + 0) * 128 + 2 * lane + 1] = a01;
            red[(wave * 2 + 1) * 128 + 2 * lane] = a10; red[(wave * 2 + 1) * 128 + 2 * lane + 1] = a11;
            __syncthreads();
            if (tid < 256) { const int b = tid >> 7, cc = tid & 127; float s = 0.f;
#pragma unroll
                for (int w = 0; w < 8; ++w) s += red[(w * 2 + b) * 128 + cc];
                ((float*)(ws + WS_MOD))[((size_t)l * 2 + b) * 6144 + col0 + cc] = s + p->b_ada[(size_t)l * 6144 + col0 + cc]; }
            __syncthreads();
        }
    }
    {
        const int nw = gridDim.x * NWAVE;
        for (int row0 = bidL * NWAVE + wave; row0 < 2 * 65536; row0 += 4 * nw) {
            f32x4 v[4][4];
#pragma unroll
            for (int rr = 0; rr < 4; ++rr) { const int row = row0 + rr * nw; const int tb = row >> 16, r = row & 65535;
                const float* src = (tb ? p->peer_v : p->peer_u) + (size_t)r * 1024 + 4 * lane;
#pragma unroll
                for (int jx = 0; jx < 4; ++jx) v[rr][jx] = __builtin_nontemporal_load((const f32x4*)(src + 256 * jx)); }
#pragma unroll
            for (int rr = 0; rr < 4; ++rr) { const int row = row0 + rr * nw; const int tb = row >> 16, r = row & 65535;
                float am = 0.f;
#pragma unroll
                for (int jx = 0; jx < 4; ++jx) am = fmaxf(am, fmaxf(fmaxf(fabsf(v[rr][jx][0]), fabsf(v[rr][jx][1])), fmaxf(fabsf(v[rr][jx][2]), fabsf(v[rr][jx][3]))));
                am = wave_max(am);
                const float sc = am > 0.f ? am * (1.f / 448.f) : 1.f, inv = am > 0.f ? 448.f / am : 1.f;
                unsigned char* dst = ws + (tb ? WS_VTAB : WS_UTAB) + (size_t)r * 1024 + 4 * lane;
#pragma unroll
                for (int jx = 0; jx < 4; ++jx) { int w = __builtin_amdgcn_cvt_pk_fp8_f32(v[rr][jx][0] * inv, v[rr][jx][1] * inv, 0, false);
                    w = __builtin_amdgcn_cvt_pk_fp8_f32(v[rr][jx][2] * inv, v[rr][jx][3] * inv, w, true);
                    *(int*)(dst + 256 * jx) = w; }
                if (lane == 0) ((float*)(ws + (tb ? WS_VSC : WS_USC)))[r] = sc; }
        }
    }
}

__device__ __forceinline__ void phase_rms(const float* xin, const float* gain, const float* shift, const float* scale, bf16_t* hout) {
    LAUNDER_IDS
    const int tid = tidL, wave = tid >> 6, lane = tid & 63;
    const int nw = gridDim.x * NWAVE;
    for (int row0 = bidL * NWAVE + wave; row0 < T; row0 += 2 * nw) {
        f32x4 v[2][4]; float ss[2];
#pragma unroll
        for (int rr = 0; rr < 2; ++rr) { const int row = min(row0 + rr * nw, T - 1); const float* xr = xin + (size_t)row * 1024 + lane * 4;
#pragma unroll
            for (int j = 0; j < 4; ++j) v[rr][j] = *(const f32x4*)(xr + j * 256); }
#pragma unroll
        for (int rr = 0; rr < 2; ++rr) { float a = 0.f;
#pragma unroll
            for (int j = 0; j < 4; ++j) a += v[rr][j][0] * v[rr][j][0] + v[rr][j][1] * v[rr][j][1] + v[rr][j][2] * v[rr][j][2] + v[rr][j][3] * v[rr][j][3];
            ss[rr] = a; }
#pragma unroll
        for (int o = 1; o < 64; o <<= 1) { ss[0] += __shfl_xor(ss[0], o); ss[1] += __shfl_xor(ss[1], o); }
#pragma unroll
        for (int rr = 0; rr < 2; ++rr) { const int row = row0 + rr * nw; if (row >= T) continue; const int b = row >> 13;
            const float inv = __builtin_amdgcn_rsqf(ss[rr] * (1.f / 1024.f) + EPS);
#pragma unroll
            for (int j = 0; j < 4; ++j) { const int col = j * 256 + lane * 4;
                const f32x4 g = *(const f32x4*)(gain + col), sh = *(const f32x4*)(shift + b * 6144 + col), sc = *(const f32x4*)(scale + b * 6144 + col);
                const f32x4 y = (v[rr][j] * inv) * g * (1.f + sc) + sh;
                u32x2 o; o.x = cvt_pk_bf16(y[0], y[1]); o.y = cvt_pk_bf16(y[2], y[3]);
                *(u32x2*)(hout + (size_t)row * 1024 + col) = o; } }
    }
}

constexpr int LROW = 136;
__device__ __forceinline__ float hg_lower_bound(const float* hg_lb, int j, int col) {
    if (j == 0) return 0.f;
    const float l0 = hg_lb[col], l1 = hg_lb[1024 + col];
    return fast_rcp(1.f + fast_exp(l0 - l1));
}
__device__ __forceinline__ f32x4 mfma16(bf16x8 a, bf16x8 b, f32x4 c) { return __builtin_amdgcn_mfma_f32_16x16x32_bf16(a, b, c, 0, 0, 0); }

__device__ __forceinline__ void load_v_regs(const bf16_t* proj, u32x4 (&vr)[4], int t0, int dir, int h, int tid) {
#pragma unroll
    for (int it = 0; it < 4; ++it) { const int idx = tid + 512 * it, tau = idx & 127, cv = idx >> 7;
        const int tok = dir ? t0 + 127 - tau : t0 + tau;
        vr[it] = *(const u32x4*)(proj + (size_t)tok * 5120 + 3072 + h * 128 + cv * 8); }
}
__device__ __forceinline__ void store_vt(LAS bf16_t* VT, const u32x4 (&vr)[4], int tid) {
#pragma unroll
    for (int it = 0; it < 4; ++it) { const int idx = tid + 512 * it, tau = idx & 127, cv = idx >> 7; const u32x4 v = vr[it];
        LAS bf16_t* d = VT + (cv * 8) * LROW + tau;
        d[0 * LROW] = (bf16_t)(v.x & 0xffff); d[1 * LROW] = (bf16_t)(v.x >> 16); d[2 * LROW] = (bf16_t)(v.y & 0xffff); d[3 * LROW] = (bf16_t)(v.y >> 16);
        d[4 * LROW] = (bf16_t)(v.z & 0xffff); d[5 * LROW] = (bf16_t)(v.z >> 16); d[6 * LROW] = (bf16_t)(v.w & 0xffff); d[7 * LROW] = (bf16_t)(v.w >> 16); }
}
__device__ __forceinline__ void load_tile_regs(const bf16_t* proj, u32x4 (&r)[4], int t0, int dir, int col0, int tid) {
#pragma unroll
    for (int it = 0; it < 4; ++it) { const int idx = tid + 512 * it, tau = idx >> 4, c16 = idx & 15;
        const int tok = dir ? t0 + 127 - tau : t0 + tau;
        r[it] = *(const u32x4*)(proj + (size_t)tok * 5120 + col0 + c16 * 8); }
}
__device__ __forceinline__ void store_tile(LAS bf16_t* TL, const u32x4 (&r)[4], int tid) {
#pragma unroll
    for (int it = 0; it < 4; ++it) { const int idx = tid + 512 * it, tau = idx >> 4, c16 = idx & 15; *(LAS u32x4*)(TL + tau * LROW + c16 * 8) = r[it]; }
}

__device__ __forceinline__ void hg_pass_a(KP p, LAS unsigned char* lds, int j) {
    LAUNDER_IDS
    const bf16_t* proj = (const bf16_t*)(p->ws + WS_PROJ);
    float* KV = (float*)(p->ws + WS_KV); float* DEC = (float*)(p->ws + WS_DEC);
    LAS bf16_t* VT = (LAS bf16_t*)lds; LAS bf16_t* KT = (LAS bf16_t*)(lds + 34816); LAS float* TOT = (LAS float*)(lds + 69632); LAS bf16_t* ZT = (LAS bf16_t*)(lds + 71680);
    for (int u = bidL; u < 2048; u += gridDim.x) {
        int tid = tidL; asm volatile("" : "+v"(tid));
        const int wave = tid >> 6, lane = tid & 63;
        const int seq = u >> 6, c = u & 63, dir = seq & 1, h = (seq >> 1) & 7, b = seq >> 4;
        const int t0 = b * SEQ + c * 128;
        const int dk = tid & 127, g = tid >> 7;
        const float lb = hg_lower_bound(p->hg_lb, j, h * 128 + dk);
        float lcs[32], kks[32]; float lc = 0.f;
        { u32x4 zr[4], vr[4];
            load_tile_regs(proj, zr, t0, dir, 1024 * (1 + dir) + h * 128, tid); load_v_regs(proj, vr, t0, dir, h, tid);
            store_tile(ZT, zr, tid); store_vt(VT, vr, tid); }
        __syncthreads();
#pragma unroll
        for (int q = 0; q < 32; ++q) { const int tau = 32 * g + q;
            const float z = bf2f(ZT[tau * LROW + dk]);
            const float f = lb + (1.f - lb) * sigmoidf_(z);
            lc += fast_log(f); lcs[q] = lc; kks[q] = 1.f - f; }
        TOT[g * 128 + dk] = lc;
        __syncthreads();
        float rg = 0.f, total = 0.f;
#pragma unroll
        for (int gg = 0; gg < 4; ++gg) { const float tv = TOT[gg * 128 + dk]; total += tv; if (gg < g) rg += tv; }
        const float base = total - rg;
#pragma unroll
        for (int q8 = 0; q8 < 4; ++q8) { unsigned w[4];
#pragma unroll
            for (int e = 0; e < 4; ++e) { const int q = q8 * 8 + e * 2;
                w[e] = cvt_pk_bf16(kks[q] * fast_exp(base - lcs[q]), kks[q + 1] * fast_exp(base - lcs[q + 1])); }
            u32x4 o; o.x = w[0]; o.y = w[1]; o.z = w[2]; o.w = w[3];
            *(LAS u32x4*)(KT + dk * LROW + 32 * g + q8 * 8) = o; }
        if (g == 0) DEC[(size_t)u * 128 + dk] = fast_exp(total);
        __syncthreads();
        f32x4 acc[2][4];
#pragma unroll
        for (int a = 0; a < 2; ++a)
#pragma unroll
            for (int bb = 0; bb < 4; ++bb) acc[a][bb] = (f32x4){0.f, 0.f, 0.f, 0.f};
        const int l15 = lane & 15, lq = lane >> 4;
#pragma unroll
        for (int ks = 0; ks < 4; ++ks) {
            bf16x8 af[2], bfr[4];
#pragma unroll
            for (int a = 0; a < 2; ++a) af[a] = *(const LAS bf16x8*)(VT + (((wave & 3) * 2 + a) * 16 + l15) * LROW + ks * 32 + lq * 8);
#pragma unroll
            for (int bb = 0; bb < 4; ++bb) bfr[bb] = *(const LAS bf16x8*)(KT + (((wave >> 2) * 4 + bb) * 16 + l15) * LROW + ks * 32 + lq * 8);
#pragma unroll
            for (int a = 0; a < 2; ++a)
#pragma unroll
                for (int bb = 0; bb < 4; ++bb) acc[a][bb] = mfma16(af[a], bfr[bb], acc[a][bb]);
        }
        float* kvp = KV + (size_t)u * 16384;
#pragma unroll
        for (int a = 0; a < 2; ++a)
#pragma unroll
            for (int bb = 0; bb < 4; ++bb)
#pragma unroll
                for (int r = 0; r < 4; ++r) kvp[(((wave & 3) * 2 + a) * 16 + lq * 4 + r) * 128 + ((wave >> 2) * 4 + bb) * 16 + l15] = acc[a][bb][r];
        __syncthreads();
    }
}

__device__ __forceinline__ void hg_pass_b(KP p) {
    LAUNDER_IDS
    const float* KV = (const float*)(p->ws + WS_KV); const float* DEC = (const float*)(p->ws + WS_DEC);
    bf16_t* SIN = (bf16_t*)(p->ws + WS_SIN);
    for (int e = bidL * NTHR + tidL; e < 131072; e += gridDim.x * NTHR) {
    const int seq = e >> 12, i4 = e & 4095, dir = seq & 1, dk = (i4 * 4) & 127;
    f32x4 S = {0.f, 0.f, 0.f, 0.f};
#pragma unroll 16
    for (int step = 0; step < 64; ++step) {
        const int c = dir ? 63 - step : step; const size_t u = (size_t)seq * 64 + c;
        const f32x4 kv = *(const f32x4*)(KV + u * 16384 + i4 * 4); const f32x4 dc = *(const f32x4*)(DEC + u * 128 + dk);
        u32x2 o; o.x = cvt_pk_bf16(S[0], S[1]); o.y = cvt_pk_bf16(S[2], S[3]);
        *(u32x2*)(SIN + u * 16384 + i4 * 4) = o;
        S = dc * S + kv;
    }
    }
}

__device__ __forceinline__ void hg_pass_c(KP p, LAS unsigned char* lds, int j) {
    LAUNDER_IDS
    const bf16_t* proj = (const bf16_t*)(p->ws + WS_PROJ);
    const bf16_t* SIN = (const bf16_t*)(p->ws + WS_SIN);
    bf16_t* OB = (bf16_t*)(p->ws + WS_OB);
    LAS bf16_t* QT = (LAS bf16_t*)lds; LAS bf16_t* QI = (LAS bf16_t*)(lds + 34816); LAS bf16_t* KT = (LAS bf16_t*)(lds + 69632);
    LAS bf16_t* VT = (LAS bf16_t*)(lds + 104448); LAS bf16_t* PI = (LAS bf16_t*)(lds + 139264); LAS float* TOT = (LAS float*)(lds + 147968);
    LAS float* OSUM = (LAS float*)(lds + 69632);
    for (int u = bidL; u < 1024; u += gridDim.x) {
        int tid = tidL; asm volatile("" : "+v"(tid));
        const int wave = tid >> 6, lane = tid & 63, l15 = lane & 15, lq = lane >> 4;
        const int c = u & 63, h = (u >> 6) & 7, b = u >> 9;
        const int t0 = b * SEQ + c * 128;
        const int dk = tid & 127, g = tid >> 7;
        const float lb = hg_lower_bound(p->hg_lb, j, h * 128 + dk);
        const int tt = wave & 1, dvt0 = (wave >> 1) * 2;
        f32x4 oacc[2][4][2];
#pragma unroll
        for (int dir = 0; dir < 2; ++dir) {
            const size_t su = ((size_t)((b * 8 + h) * 2 + dir) * 64 + c);
            unsigned k0p[16]; float lc = 0.f; float kprev = 0.f;
            u32x4 vr[4];
            { u32x4 zr[4], qr[4];
                load_tile_regs(proj, zr, t0, dir, 1024 * (1 + dir) + h * 128, tid); load_tile_regs(proj, qr, t0, dir, h * 128, tid); load_v_regs(proj, vr, t0, dir, h, tid);
                __syncthreads();
                store_tile(KT, zr, tid); store_tile(VT, qr, tid); }
            __syncthreads();
#pragma unroll
            for (int q = 0; q < 32; ++q) { const int tau = 32 * g + q;
                const float z = bf2f(KT[tau * LROW + dk]), qv = bf2f(VT[tau * LROW + dk]);
                const float f = lb + (1.f - lb) * sigmoidf_(z);
                lc += fast_log(f);
                const float el = fast_exp(fmaxf(lc, -80.f));
                QT[tau * LROW + dk] = f2bf(qv * el);
                const float kcur = (1.f - f) * fast_rcp(el);
                if (q & 1) k0p[q >> 1] = cvt_pk_bf16(kprev, kcur); else kprev = kcur; }
            TOT[g * 128 + dk] = lc;
            __syncthreads();
            float r[4]; { float run = 0.f;
#pragma unroll
                for (int gg = 0; gg < 4; ++gg) { r[gg] = run; run += TOT[gg * 128 + dk]; } }
            float rg = 0.f;
#pragma unroll
            for (int gg = 0; gg < 4; ++gg) if (gg == g) rg = r[gg];
            { const float eg = fast_exp(rg);
#pragma unroll
                for (int q = 0; q < 32; ++q) QI[(32 * g + q) * LROW + dk] = f2bf(bf2f(QT[(32 * g + q) * LROW + dk]) * eg); }
            store_vt(VT, vr, tid);
            bf16x8 sfr[2][4];
#pragma unroll
            for (int n = 0; n < 2; ++n)
#pragma unroll
                for (int ks = 0; ks < 4; ++ks) sfr[n][ks] = *(const bf16x8*)(SIN + su * 16384 + (size_t)((dvt0 + n) * 16 + l15) * 128 + ks * 32 + lq * 8);
#pragma unroll
            for (int i = 0; i < 4; ++i) {
                if (g <= i) { const float e = fast_exp(r[i] - rg);
#pragma unroll
                    for (int q = 0; q < 32; ++q) KT[(32 * g + q) * LROW + dk] = f2bf(((q & 1) ? bfhi(k0p[q >> 1]) : bflo(k0p[q >> 1])) * e); }
                __syncthreads();
                for (int tl = wave; tl < 4 * (i + 1); tl += 8) { const int sm = tl >> 1, tn = tl & 1;
                    f32x4 a4 = {0.f, 0.f, 0.f, 0.f};
#pragma unroll
                    for (int ks = 0; ks < 4; ++ks) { const bf16x8 af = *(const LAS bf16x8*)(KT + (sm * 16 + l15) * LROW + ks * 32 + lq * 8);
                        const bf16x8 bq = *(const LAS bf16x8*)(QT + (32 * i + tn * 16 + l15) * LROW + ks * 32 + lq * 8);
                        a4 = mfma16(af, bq, a4); }
                    const int tloc = tn * 16 + l15, s0 = sm * 16 + lq * 4, tg = 32 * i + tloc;
                    u32x2 o; o.x = cvt_pk_bf16(s0 + 0 <= tg ? a4[0] : 0.f, s0 + 1 <= tg ? a4[1] : 0.f); o.y = cvt_pk_bf16(s0 + 2 <= tg ? a4[2] : 0.f, s0 + 3 <= tg ? a4[3] : 0.f);
                    *(LAS u32x2*)(PI + tloc * LROW + s0) = o; }
                __syncthreads();
                f32x4 a0 = {0.f, 0.f, 0.f, 0.f}, a1 = {0.f, 0.f, 0.f, 0.f};
                for (int ks = 0; ks <= i; ++ks) { const bf16x8 af = *(const LAS bf16x8*)(PI + (tt * 16 + l15) * LROW + ks * 32 + lq * 8);
                    const bf16x8 b0 = *(const LAS bf16x8*)(VT + ((dvt0 + 0) * 16 + l15) * LROW + ks * 32 + lq * 8);
                    const bf16x8 b1 = *(const LAS bf16x8*)(VT + ((dvt0 + 1) * 16 + l15) * LROW + ks * 32 + lq * 8);
                    a0 = mfma16(af, b0, a0); a1 = mfma16(af, b1, a1); }
#pragma unroll
                for (int ks = 0; ks < 4; ++ks) { const bf16x8 af = *(const LAS bf16x8*)(QI + (32 * i + tt * 16 + l15) * LROW + ks * 32 + lq * 8);
                    a0 = mfma16(af, sfr[0][ks], a0); a1 = mfma16(af, sfr[1][ks], a1); }
                oacc[dir][i][0] = a0; oacc[dir][i][1] = a1;
            }
        }
        __syncthreads();
#pragma unroll
        for (int i = 0; i < 4; ++i)
#pragma unroll
            for (int n = 0; n < 2; ++n)
#pragma unroll
                for (int rr = 0; rr < 4; ++rr) OSUM[(32 * i + tt * 16 + lq * 4 + rr) * 132 + (dvt0 + n) * 16 + l15] = oacc[0][i][n][rr];
        __syncthreads();
#pragma unroll
        for (int i = 0; i < 4; ++i)
#pragma unroll
            for (int n = 0; n < 2; ++n)
#pragma unroll
                for (int rr = 0; rr < 4; ++rr) OSUM[(127 - (32 * i + tt * 16 + lq * 4 + rr)) * 132 + (dvt0 + n) * 16 + l15] += oacc[1][i][n][rr];
        __syncthreads();
        { const int row = tid >> 2, part = tid & 3; const int tok = t0 + row;
            float ov[32]; float ss = 0.f;
#pragma unroll
            for (int q = 0; q < 8; ++q) { const f32x4 v = *(const LAS f32x4*)(OSUM + row * 132 + part * 32 + q * 4);
                ov[q * 4 + 0] = v[0]; ov[q * 4 + 1] = v[1]; ov[q * 4 + 2] = v[2]; ov[q * 4 + 3] = v[3]; ss += v[0] * v[0] + v[1] * v[1] + v[2] * v[2] + v[3] * v[3]; }
            ss += __shfl_xor(ss, 1); ss += __shfl_xor(ss, 2);
            const float inv = __builtin_amdgcn_rsqf(ss * (1.f / 128.f) + EPS);
            const int col = h * 128 + part * 32;
            const bf16_t* gp = proj + (size_t)tok * 5120 + 4096 + col; const float* ng = p->hg_norm_g + j * 1024 + col;
#pragma unroll
            for (int q = 0; q < 4; ++q) { const u32x4 gr = *(const u32x4*)(gp + q * 8);
                const float gv[8] = {bflo(gr.x), bfhi(gr.x), bflo(gr.y), bfhi(gr.y), bflo(gr.z), bfhi(gr.z), bflo(gr.w), bfhi(gr.w)};
                float y[8];
#pragma unroll
                for (int e = 0; e < 8; ++e) y[e] = ov[q * 8 + e] * inv * ng[q * 8 + e] * silu_(gv[e]);
                u32x4 o; o.x = cvt_pk_bf16(y[0], y[1]); o.y = cvt_pk_bf16(y[2], y[3]); o.z = cvt_pk_bf16(y[4], y[5]); o.w = cvt_pk_bf16(y[6], y[7]);
                *(u32x4*)(OB + (size_t)tok * 1024 + col + q * 8) = o; }
        }
        __syncthreads();
    }
}

__device__ __forceinline__ void lru_conv(KP p, int l) {
    LAUNDER_IDS
    const bf16_t* XB = (const bf16_t*)(p->ws + WS_XB); bf16_t* XC = (bf16_t*)(p->ws + WS_XC);
    const float* cw = p->lru_conv_w + (size_t)l * 4 * 1024; const float* cb = p->lru_conv_b + (size_t)l * 1024;
    const int gs = gridDim.x * NTHR;
    for (int it = bidL * NTHR + tidL; it < T * 128; it += gs) {
        const int tok = it >> 7, c8 = (it & 127) * 8, s = tok & (SEQ - 1);
        float acc[8];
        { const f32x4 b0 = *(const f32x4*)(cb + c8), b1 = *(const f32x4*)(cb + c8 + 4);
            acc[0] = b0[0]; acc[1] = b0[1]; acc[2] = b0[2]; acc[3] = b0[3]; acc[4] = b1[0]; acc[5] = b1[1]; acc[6] = b1[2]; acc[7] = b1[3]; }
#pragma unroll
        for (int jj = 0; jj < 4; ++jj) { const int ts = s + jj - 2;
            if (ts >= 0 && ts < SEQ) { const u32x4 xr = *(const u32x4*)(XB + (size_t)(tok + jj - 2) * 1024 + c8);
                const f32x4 w0 = *(const f32x4*)(cw + jj * 1024 + c8), w1 = *(const f32x4*)(cw + jj * 1024 + c8 + 4);
                acc[0] += bflo(xr.x) * w0[0]; acc[1] += bfhi(xr.x) * w0[1]; acc[2] += bflo(xr.y) * w0[2]; acc[3] += bfhi(xr.y) * w0[3];
                acc[4] += bflo(xr.z) * w1[0]; acc[5] += bfhi(xr.z) * w1[1]; acc[6] += bflo(xr.w) * w1[2]; acc[7] += bfhi(xr.w) * w1[3]; } }
        u32x4 o; o.x = cvt_pk_bf16(acc[0], acc[1]); o.y = cvt_pk_bf16(acc[2], acc[3]); o.z = cvt_pk_bf16(acc[4], acc[5]); o.w = cvt_pk_bf16(acc[6], acc[7]);
        *(u32x4*)(XC + (size_t)tok * 1024 + c8) = o;
    }
}
__device__ __forceinline__ void lru_scan1(KP p, LAS unsigned char* lds) {
    LAUNDER_IDS
    const bf16_t* LOGA = (const bf16_t*)(p->ws + WS_LOGA); const bf16_t* BT = (const bf16_t*)(p->ws + WS_BTERM);
    float* CP = (float*)(p->ws + WS_CP); float* CH = (float*)(p->ws + WS_CH);
    LAS float* XP = (LAS float*)lds; LAS float* XH = (LAS float*)(lds + 16384);
    for (int u = bidL; u < 1024; u += gridDim.x) {
        int tid = tidL; asm volatile("" : "+v"(tid));
        const int ts = tid >> 7, c8 = (tid & 127) * 8;
        const int chunk = u & 255, dir = (u >> 8) & 1, b = u >> 9;
        const size_t base = ((size_t)dir * T + b * SEQ + chunk * 32) * 1024 + c8;
        u32x4 lw[8], bw[8];
#pragma unroll
        for (int q = 0; q < 8; ++q) { const int t = dir ? 31 - (ts * 8 + q) : ts * 8 + q; lw[q] = *(const u32x4*)(LOGA + base + (size_t)t * 1024); bw[q] = *(const u32x4*)(BT + base + (size_t)t * 1024); }
        float h[8], sl[8];
#pragma unroll
        for (int i = 0; i < 8; ++i) { h[i] = 0.f; sl[i] = 0.f; }
#pragma unroll
        for (int q = 0; q < 8; ++q) {
#pragma unroll
            for (int w = 0; w < 4; ++w) { const float l0 = bflo(lw[q][w]), l1 = bfhi(lw[q][w]);
                h[2 * w] = fast_exp(l0) * h[2 * w] + bflo(bw[q][w]); h[2 * w + 1] = fast_exp(l1) * h[2 * w + 1] + bfhi(bw[q][w]); sl[2 * w] += l0; sl[2 * w + 1] += l1; } }
        *(LAS f32x4*)(XP + ts * 1024 + c8) = (f32x4){fast_exp(sl[0]), fast_exp(sl[1]), fast_exp(sl[2]), fast_exp(sl[3])};
        *(LAS f32x4*)(XP + ts * 1024 + c8 + 4) = (f32x4){fast_exp(sl[4]), fast_exp(sl[5]), fast_exp(sl[6]), fast_exp(sl[7])};
        *(LAS f32x4*)(XH + ts * 1024 + c8) = (f32x4){h[0], h[1], h[2], h[3]}; *(LAS f32x4*)(XH + ts * 1024 + c8 + 4) = (f32x4){h[4], h[5], h[6], h[7]};
        __syncthreads();
        { const int ch = 2 * tid; float P0 = 1.f, P1 = 1.f, H0 = 0.f, H1 = 0.f;
#pragma unroll
            for (int s2 = 0; s2 < 4; ++s2) { const f32x2 pp = *(const LAS f32x2*)(XP + s2 * 1024 + ch), hh = *(const LAS f32x2*)(XH + s2 * 1024 + ch);
                H0 = pp[0] * H0 + hh[0]; H1 = pp[1] * H1 + hh[1]; P0 *= pp[0]; P1 *= pp[1]; }
            const size_t o = ((size_t)(b * 2 + dir) * 256 + chunk) * 1024 + ch;
            *(f32x2*)(CP + o) = (f32x2){P0, P1}; *(f32x2*)(CH + o) = (f32x2){H0, H1}; }
        __syncthreads();
    }
}
__device__ __forceinline__ void lru_scan2(KP p) {
    LAUNDER_IDS
    const float* CP = (const float*)(p->ws + WS_CP); const float* CH = (const float*)(p->ws + WS_CH); float* HIN = (float*)(p->ws + WS_HIN);
    const int wave = tidL >> 6, lane = tidL & 63;
    for (int item = bidL * NWAVE + wave; item < 4096; item += gridDim.x * NWAVE) {
        const int ch = item & 1023, bd = item >> 10, dir = bd & 1;
        float pp[4], hh[4]; float Pl = 1.f, Hl = 0.f;
#pragma unroll
        for (int q = 0; q < 4; ++q) { const int ci = 4 * lane + q, chunk = dir ? 255 - ci : ci; const size_t o = ((size_t)bd * 256 + chunk) * 1024 + ch;
            pp[q] = CP[o]; hh[q] = CH[o]; Hl = pp[q] * Hl + hh[q]; Pl *= pp[q]; }
#pragma unroll
        for (int off = 1; off < 64; off <<= 1) { const float Pp = __shfl_up(Pl, off), Hp = __shfl_up(Hl, off);
            if (lane >= off) { Hl = Pl * Hp + Hl; Pl = Pl * Pp; } }
        float carry = __shfl_up(Hl, 1); if (lane == 0) carry = 0.f;
#pragma unroll
        for (int q = 0; q < 4; ++q) { const int ci = 4 * lane + q, chunk = dir ? 255 - ci : ci; const size_t o = ((size_t)bd * 256 + chunk) * 1024 + ch;
            HIN[o] = carry; carry = pp[q] * carry + hh[q]; }
    }
}
__device__ __forceinline__ void lru_scan3(KP p, LAS unsigned char* lds) {
    LAUNDER_IDS
    const bf16_t* LOGA = (const bf16_t*)(p->ws + WS_LOGA); const bf16_t* BT = (const bf16_t*)(p->ws + WS_BTERM); const bf16_t* YG = (const bf16_t*)(p->ws + WS_YG);
    const float* HIN = (const float*)(p->ws + WS_HIN); bf16_t* OB = (bf16_t*)(p->ws + WS_OB);
    LAS float* XP = (LAS float*)lds; LAS float* XH = (LAS float*)(lds + 16384);
    for (int u = bidL; u < 512; u += gridDim.x) {
        int tid = tidL; asm volatile("" : "+v"(tid));
        const int ts = tid >> 7, c8 = (tid & 127) * 8;
        const int chunk = u & 255, b = u >> 8;
        const size_t base = ((size_t)b * SEQ + chunk * 32 + ts * 8) * 1024 + c8;
        unsigned hsp[8][4];
#pragma unroll
        for (int dir = 0; dir < 2; ++dir) {
            u32x4 lw[8], bw[8];
#pragma unroll
            for (int q = 0; q < 8; ++q) { lw[q] = *(const u32x4*)(LOGA + (size_t)dir * T * 1024 + base + (size_t)q * 1024); bw[q] = *(const u32x4*)(BT + (size_t)dir * T * 1024 + base + (size_t)q * 1024); }
            const f32x4 hi0 = *(const f32x4*)(HIN + ((size_t)(b * 2 + dir) * 256 + chunk) * 1024 + c8), hi1 = *(const f32x4*)(HIN + ((size_t)(b * 2 + dir) * 256 + chunk) * 1024 + c8 + 4);
            float h[8], sl[8];
#pragma unroll
            for (int i = 0; i < 8; ++i) { h[i] = 0.f; sl[i] = 0.f; }
#pragma unroll
            for (int qq = 0; qq < 8; ++qq) { const int q = dir ? 7 - qq : qq;
#pragma unroll
                for (int w = 0; w < 4; ++w) { const float l0 = bflo(lw[q][w]), l1 = bfhi(lw[q][w]);
                    h[2 * w] = fast_exp(l0) * h[2 * w] + bflo(bw[q][w]); h[2 * w + 1] = fast_exp(l1) * h[2 * w + 1] + bfhi(bw[q][w]); sl[2 * w] += l0; sl[2 * w + 1] += l1; } }
            __syncthreads();
            *(LAS f32x4*)(XP + ts * 1024 + c8) = (f32x4){fast_exp(sl[0]), fast_exp(sl[1]), fast_exp(sl[2]), fast_exp(sl[3])};
            *(LAS f32x4*)(XP + ts * 1024 + c8 + 4) = (f32x4){fast_exp(sl[4]), fast_exp(sl[5]), fast_exp(sl[6]), fast_exp(sl[7])};
            *(LAS f32x4*)(XH + ts * 1024 + c8) = (f32x4){h[0], h[1], h[2], h[3]}; *(LAS f32x4*)(XH + ts * 1024 + c8 + 4) = (f32x4){h[4], h[5], h[6], h[7]};
            __syncthreads();
            h[0] = hi0[0]; h[1] = hi0[1]; h[2] = hi0[2]; h[3] = hi0[3]; h[4] = hi1[0]; h[5] = hi1[1]; h[6] = hi1[2]; h[7] = hi1[3];
#pragma unroll
            for (int s3 = 0; s3 < 3; ++s3) { const int sr = dir ? 3 - s3 : s3; const bool use = dir ? (sr > ts) : (sr < ts);
                const f32x4 p0 = *(const LAS f32x4*)(XP + sr * 1024 + c8), p1 = *(const LAS f32x4*)(XP + sr * 1024 + c8 + 4), q0 = *(const LAS f32x4*)(XH + sr * 1024 + c8), q1 = *(const LAS f32x4*)(XH + sr * 1024 + c8 + 4);
                if (use) { h[0] = p0[0] * h[0] + q0[0]; h[1] = p0[1] * h[1] + q0[1]; h[2] = p0[2] * h[2] + q0[2]; h[3] = p0[3] * h[3] + q0[3];
                    h[4] = p1[0] * h[4] + q1[0]; h[5] = p1[1] * h[5] + q1[1]; h[6] = p1[2] * h[6] + q1[2]; h[7] = p1[3] * h[7] + q1[3]; } }
#pragma unroll
            for (int qq = 0; qq < 8; ++qq) { const int q = dir ? 7 - qq : qq;
                u32x4 yw; if (dir) yw = *(const u32x4*)(YG + base + (size_t)q * 1024);
                unsigned ow[4];
#pragma unroll
                for (int w = 0; w < 4; ++w) { h[2 * w] = fast_exp(bflo(lw[q][w])) * h[2 * w] + bflo(bw[q][w]); h[2 * w + 1] = fast_exp(bfhi(lw[q][w])) * h[2 * w + 1] + bfhi(bw[q][w]);
                    if (dir == 0) hsp[q][w] = cvt_pk_bf16(h[2 * w], h[2 * w + 1]);
                    else ow[w] = cvt_pk_bf16((bflo(hsp[q][w]) + h[2 * w]) * bflo(yw[w]), (bfhi(hsp[q][w]) + h[2 * w + 1]) * bfhi(yw[w])); }
                if (dir) *(u32x4*)(OB + base + (size_t)q * 1024) = (u32x4){ow[0], ow[1], ow[2], ow[3]}; }
        }
        __syncthreads();
    }
}

__device__ const unsigned char STAIR[64] = {
    0x00, 0x01, 0x02, 0x03, 0x04, 0x05, 0x06, 0x07, 0x08, 0x09, 0x0a, 0x0b, 0x0c, 0x0d, 0x0e, 0x0f,
    0x10, 0x11, 0x12, 0x13, 0x14, 0x15, 0x16, 0x17, 0x20, 0x21, 0x22, 0x23, 0x24, 0x30, 0x31, 0x32,
    0x33, 0x40, 0x41, 0x42, 0x50, 0x51, 0x60, 0x61, 0x70, 0x71, 0x80, 0x90, 0xa0, 0xb0, 0xc0, 0xd0,
    0xe0, 0xf0, 0, 0, 0, 0, 0, 0, 0, 0, 0, 0, 0, 0, 0, 0};
__device__ __forceinline__ unsigned mono_key(float f) { const unsigned b = __float_as_uint(f); return b ^ ((b >> 31) ? 0xffffffffu : 0x80000000u); }

__device__ __forceinline__ float inv_mono(unsigned k) { return __uint_as_float(k ^ ((k >> 31) ? 0x80000000u : 0xffffffffu)); }
#define TK_CE(A, B) do { const unsigned hi_ = max(A, B), lo_ = min(A, B); A = hi_; B = lo_; } while (0)
#define TK_SORT16(N) do { _Pragma("unroll") for (int k_ = 2; k_ <= 16; k_ <<= 1) { _Pragma("unroll") for (int j_ = k_ >> 1; j_ > 0; j_ >>= 1) { _Pragma("unroll") for (int i_ = 0; i_ < 16; ++i_) { \
    const int l_ = i_ ^ j_; if (l_ > i_) { if ((i_ & k_) == 0) TK_CE(N[i_], N[l_]); else TK_CE(N[l_], N[i_]); } } } } } while (0)
#define TK_MERGE16(L, N) do { _Pragma("unroll") for (int i_ = 0; i_ < 16; ++i_) L[i_] = max(L[i_], N[15 - i_]); \
    _Pragma("unroll") for (int j_ = 8; j_ > 0; j_ >>= 1) { _Pragma("unroll") for (int i_ = 0; i_ < 16; ++i_) { const int l_ = i_ ^ j_; if (l_ > i_) TK_CE(L[i_], L[l_]); } } } while (0)
#define TK_INSERT(L, x) do { _Pragma("unroll") for (int q_ = 0; q_ < 16; ++q_) { const unsigned hi_ = max(L[q_], x); x = min(L[q_], x); L[q_] = hi_; } } while (0)
__device__ __forceinline__ void peer_topk(KP p, LAS unsigned char* lds) {
    LAUNDER_IDS
    (void)bidL;
    const int tid = tidL, wave = tid >> 6, lane = tid & 63;
    const float* SCT = (const float*)(p->ws + WS_SCORES);
    int* TOPI = (int*)(p->ws + WS_TOPI); float* TOPG = (float*)(p->ws + WS_TOPG);
    LAS unsigned char* IX = lds + wave * 2048 + lane * 32;
    for (int item = bidL * NWAVE + wave; item < 2048; item += gridDim.x * NWAVE) {
        const int tg = item >> 3, hd = item & 7, tok = tg * 64 + lane;
        float V[2][16];
#pragma unroll
        for (int half = 0; half < 2; ++half) {
            unsigned L[16];
#pragma unroll
            for (int q = 0; q < 16; ++q) L[q] = 0u;
            const float* sc = SCT + (size_t)(hd * 256 + half * 128) * T + tok;
            float cur[16], nxt[16];
#pragma unroll
            for (int i = 0; i < 16; ++i) cur[i] = sc[(size_t)i * T];
#pragma unroll 1
            for (int kb = 0; kb < 8; ++kb) {
                const int kn = kb < 7 ? kb + 1 : kb;
#pragma unroll
                for (int i = 0; i < 16; ++i) nxt[i] = sc[(size_t)(kn * 16 + i) * T];
                unsigned NK[16];
#pragma unroll
                for (int i = 0; i < 16; ++i) NK[i] = (mono_key(cur[i]) & ~0x7fu) | (unsigned)(kb * 16 + i);
                TK_SORT16(NK); TK_MERGE16(L, NK);
#pragma unroll
                for (int i = 0; i < 16; ++i) cur[i] = nxt[i];
            }
            u32x4 w0, w1;
            w0.x = (L[0] & 0x7f) | ((L[1] & 0x7f) << 8) | ((L[2] & 0x7f) << 16) | ((L[3] & 0x7f) << 24); w0.y = (L[4] & 0x7f) | ((L[5] & 0x7f) << 8) | ((L[6] & 0x7f) << 16) | ((L[7] & 0x7f) << 24);
            w0.z = (L[8] & 0x7f) | ((L[9] & 0x7f) << 8) | ((L[10] & 0x7f) << 16) | ((L[11] & 0x7f) << 24); w0.w = (L[12] & 0x7f) | ((L[13] & 0x7f) << 8) | ((L[14] & 0x7f) << 16) | ((L[15] & 0x7f) << 24);
            *(LAS u32x4*)(IX + half * 16) = w0;
#pragma unroll
            for (int q = 0; q < 16; ++q) V[half][q] = inv_mono(L[q]);
        }
        unsigned C[16];
#pragma unroll
        for (int q = 0; q < 16; ++q) C[q] = 0u;
#pragma unroll
        for (int i = 0; i < 16; ++i)
#pragma unroll
            for (int jj = 0; jj < 16; ++jj) if ((i + 1) * (jj + 1) <= 16) { unsigned x = (mono_key(V[0][i] + V[1][jj]) & ~0xffu) | (unsigned)(i * 16 + jj); TK_INSERT(C, x); }
        asm volatile("s_waitcnt lgkmcnt(0)" ::: "memory");
        const float s0 = inv_mono(C[0] & ~0xffu);
        float e[16]; float sum = 0.f; int ids[16];
#pragma unroll
        for (int q = 0; q < 16; ++q) { e[q] = fast_exp(inv_mono(C[q] & ~0xffu) - s0); sum += e[q];
            const unsigned code = C[q] & 0xffu; ids[q] = (int)IX[code >> 4] * 128 + (int)IX[16 + (code & 15u)]; }
        const float rs = fast_rcp(sum);
        int* ip = TOPI + (size_t)tok * 128 + hd * 16; float* gp = TOPG + (size_t)tok * 128 + hd * 16;
#pragma unroll
        for (int q = 0; q < 4; ++q) { *(u32x4*)(ip + 4 * q) = (u32x4){(unsigned)ids[4 * q], (unsigned)ids[4 * q + 1], (unsigned)ids[4 * q + 2], (unsigned)ids[4 * q + 3]};
            *(f32x4*)(gp + 4 * q) = (f32x4){e[4 * q] * rs, e[4 * q + 1] * rs, e[4 * q + 2] * rs, e[4 * q + 3] * rs}; }
        asm volatile("s_waitcnt lgkmcnt(0)" ::: "memory");
    }
}

__device__ __forceinline__ void peer_gather(KP p, int l, bool dry) {
    LAUNDER_IDS
    const int wave = tidL >> 6, lane = tidL & 63;
    const bf16_t* HB = (const bf16_t*)(p->ws + WS_HBUF); bf16_t* HBW = (bf16_t*)(p->ws + WS_HBUF);
    const int* TOPI = (const int*)(p->ws + WS_TOPI); const float* TOPG = (const float*)(p->ws + WS_TOPG);
    const unsigned char* U8 = p->ws + WS_UTAB + (size_t)l * 16384 * 1024 + 16 * lane; const unsigned char* V8 = p->ws + WS_VTAB + (size_t)l * 16384 * 1024 + 16 * lane;
    const float* USC = (const float*)(p->ws + WS_USC) + l * 16384; const float* VSC = (const float*)(p->ws + WS_VSC) + l * 16384;
    float* XRES = (float*)(p->ws + WS_XRES); const float* MOD = (const float*)(p->ws + WS_MOD);
    for (int tok = bidL * NWAVE + wave; tok < T; tok += gridDim.x * NWAVE) {
        const int b = tok >> 13;
        f32x2 hv2[8];
        { const u32x4 h0 = *(const u32x4*)(HB + (size_t)tok * 1024 + 16 * lane), h1 = *(const u32x4*)(HB + (size_t)tok * 1024 + 16 * lane + 8);
            hv2[0] = (f32x2){bflo(h0.x), bfhi(h0.x)}; hv2[1] = (f32x2){bflo(h0.y), bfhi(h0.y)}; hv2[2] = (f32x2){bflo(h0.z), bfhi(h0.z)}; hv2[3] = (f32x2){bflo(h0.w), bfhi(h0.w)};
            hv2[4] = (f32x2){bflo(h1.x), bfhi(h1.x)}; hv2[5] = (f32x2){bflo(h1.y), bfhi(h1.y)}; hv2[6] = (f32x2){bflo(h1.z), bfhi(h1.z)}; hv2[7] = (f32x2){bflo(h1.w), bfhi(h1.w)}; }
        const int id0 = TOPI[(size_t)tok * 128 + lane], id1 = TOPI[(size_t)tok * 128 + 64 + lane];
        const float g0 = TOPG[(size_t)tok * 128 + lane], g1 = TOPG[(size_t)tok * 128 + 64 + lane];
        f32x2 acc2[8];
#pragma unroll
        for (int i = 0; i < 8; ++i) acc2[i] = (f32x2){0.f, 0.f};
#pragma unroll 1
        for (int e0 = 0; e0 < 128; e0 += 8) {
            u32x4 uq[8], vq[8]; float gk[8], su[8], sv[8];
#pragma unroll
            for (int k = 0; k < 8; ++k) { const int e = e0 + k;
                int id = __builtin_amdgcn_readlane(e0 < 64 ? id0 : id1, e & 63);
                id &= 16383;
                gk[k] = __uint_as_float(__builtin_amdgcn_readlane(__float_as_uint(e0 < 64 ? g0 : g1), e & 63));
                uq[k] = *(const u32x4*)(U8 + (size_t)id * 1024); vq[k] = *(const u32x4*)(V8 + (size_t)id * 1024);
                su[k] = USC[id]; sv[k] = VSC[id]; }
            float d[8];
#pragma unroll
            for (int k = 0; k < 8; ++k) { f32x2 s2 = (f32x2){0.f, 0.f};
#pragma unroll
                for (int w = 0; w < 4; ++w) { const f32x2 lo = __builtin_amdgcn_cvt_pk_f32_fp8((int)uq[k][w], false), hi = __builtin_amdgcn_cvt_pk_f32_fp8((int)uq[k][w], true);
                    s2 = lo * hv2[2 * w] + s2; s2 = hi * hv2[2 * w + 1] + s2; }
                d[k] = s2[0] + s2[1]; }
            const bool b32 = lane & 32, b16 = lane & 16, b8 = lane & 8;
            float d4[4], d2[2], r;
#pragma unroll
            for (int k = 0; k < 4; ++k) { const float recv = __shfl_xor(b32 ? d[k] : d[k + 4], 32); d4[k] = (b32 ? d[k + 4] : d[k]) + recv; }
#pragma unroll
            for (int k = 0; k < 2; ++k) { const float recv = __shfl_xor(b16 ? d4[k] : d4[k + 2], 16); d2[k] = (b16 ? d4[k + 2] : d4[k]) + recv; }
            { const float recv = __shfl_xor(b8 ? d2[0] : d2[1], 8); r = (b8 ? d2[1] : d2[0]) + recv; }
            r += __shfl_xor(r, 4); r += __shfl_xor(r, 2); r += __shfl_xor(r, 1);
#pragma unroll
            for (int k = 0; k < 8; ++k) { const float dot = __uint_as_float(__builtin_amdgcn_readlane(__float_as_uint(r), ((k >> 2) & 1) * 32 + ((k >> 1) & 1) * 16 + (k & 1) * 8));
                const float cf = gk[k] * gelu_tanh(dot * su[k]) * sv[k]; const f32x2 cf2 = (f32x2){cf, cf};
#pragma unroll
                for (int w = 0; w < 4; ++w) { const f32x2 lo = __builtin_amdgcn_cvt_pk_f32_fp8((int)vq[k][w], false), hi = __builtin_amdgcn_cvt_pk_f32_fp8((int)vq[k][w], true);
                    acc2[2 * w] = lo * cf2 + acc2[2 * w]; acc2[2 * w + 1] = hi * cf2 + acc2[2 * w + 1]; } }
        }
        const float* g2 = MOD + ((size_t)l * 2 + b) * 6144 + 5 * 1024 + 16 * lane;
        float* xrow = XRES + (size_t)tok * 1024 + 16 * lane;
        float xn[16]; float ss = 0.f;
#pragma unroll
        for (int q = 0; q < 4; ++q) { const f32x4 xr = *(const f32x4*)(xrow + 4 * q), gg = *(const f32x4*)(g2 + 4 * q);
            const float a0 = acc2[2 * q][0], a1 = acc2[2 * q][1], a2 = acc2[2 * q + 1][0], a3 = acc2[2 * q + 1][1];
            xn[4 * q + 0] = xr[0] + gg[0] * a0; xn[4 * q + 1] = xr[1] + gg[1] * a1; xn[4 * q + 2] = xr[2] + gg[2] * a2; xn[4 * q + 3] = xr[3] + gg[3] * a3; }
#pragma unroll
        for (int i = 0; i < 16; ++i) ss += xn[i] * xn[i];
        const float inv = __builtin_amdgcn_rsqf(wave_sum(ss) * (1.f / 1024.f) + EPS);
        if (dry) { if (inv == 123.456f) p->out[tok] = inv; continue; }
        if (l < DEPTH - 1) {
            const float* gain = p->norm_g + (size_t)(l + 1) * 2 * 1024 + 16 * lane; const float* sh = MOD + ((size_t)(l + 1) * 2 + b) * 6144 + 16 * lane; const float* sc = sh + 1024;
            float y[16];
#pragma unroll
            for (int q = 0; q < 4; ++q) { const f32x4 gn = *(const f32x4*)(gain + 4 * q), s1 = *(const f32x4*)(sh + 4 * q), c1 = *(const f32x4*)(sc + 4 * q);
                *(f32x4*)(xrow + 4 * q) = (f32x4){xn[4 * q], xn[4 * q + 1], xn[4 * q + 2], xn[4 * q + 3]};
#pragma unroll
                for (int i = 0; i < 4; ++i) y[4 * q + i] = (xn[4 * q + i] * inv) * gn[i] * (1.f + c1[i]) + s1[i]; }
            u32x4 o0, o1; o0.x = cvt_pk_bf16(y[0], y[1]); o0.y = cvt_pk_bf16(y[2], y[3]); o0.z = cvt_pk_bf16(y[4], y[5]); o0.w = cvt_pk_bf16(y[6], y[7]);
            o1.x = cvt_pk_bf16(y[8], y[9]); o1.y = cvt_pk_bf16(y[10], y[11]); o1.z = cvt_pk_bf16(y[12], y[13]); o1.w = cvt_pk_bf16(y[14], y[15]);
            *(u32x4*)(HBW + (size_t)tok * 1024 + 16 * lane) = o0; *(u32x4*)(HBW + (size_t)tok * 1024 + 16 * lane + 8) = o1;
        } else {
            const float* fg = p->final_g + 16 * lane; float* orow = p->out + (size_t)tok * 1024 + 16 * lane;
#pragma unroll
            for (int q = 0; q < 4; ++q) { const f32x4 gn = *(const f32x4*)(fg + 4 * q); f32x4 o;
#pragma unroll
                for (int i = 0; i < 4; ++i) o[i] = (xn[4 * q + i] * inv) * gn[i];
                *(f32x4*)(orow + 4 * q) = o; }
        }
    }
}

#define XB_TMO      128
#define XB_XCNT(j)  (256  + 64 * (j))
#define XB_XSUB(j)  (1280 + 64 * (j))
#define XB_XGEN(j)  (2304 + 64 * (j))
#define XB_TOP      3328
#define XB_TOPGEN   3392
#define XCD_BAR_WORDS 3456
#define XB_SPIN_CAP (1u << 18)

__device__ __forceinline__ unsigned xb_ld(unsigned* p)              { return __hip_atomic_load(p, __ATOMIC_RELAXED, __HIP_MEMORY_SCOPE_AGENT); }
__device__ __forceinline__ unsigned xb_add(unsigned* p, unsigned v) { return __hip_atomic_fetch_add(p, v, __ATOMIC_RELAXED, __HIP_MEMORY_SCOPE_AGENT); }
__device__ __forceinline__ unsigned xb_xcc_id() { return (unsigned)__builtin_amdgcn_s_getreg((3 << 11) | 20) & 0xFu; }
#define XB_SPIN(cond, bar) do { unsigned _sp = 0; while (cond) { __builtin_amdgcn_s_sleep(1); \
    if ((++_sp & 255u) == 0u) { if (xb_ld(&(bar)[XB_TMO])) break; if (_sp > XB_SPIN_CAP) { atomicAdd(&(bar)[XB_TMO], 1u); break; } } } } while (0)

struct XcdBarrier {
    unsigned* bar; unsigned x;
    volatile LAS unsigned* st;
};

__device__ __forceinline__ XcdBarrier xcd_barrier_post(unsigned* bar, volatile LAS unsigned* st) {
    XcdBarrier b; b.bar = bar; b.x = xb_xcc_id(); b.st = st;
    if (threadIdx.x == 0) (void)xb_add(&bar[XB_XCNT(b.x)], 1u);
    return b;
}
__device__ __forceinline__ void xcd_barrier_complete(unsigned* bar, unsigned x, unsigned& nloc, unsigned& nx) {
    const unsigned G = gridDim.x * gridDim.y * gridDim.z;
    unsigned sum, cnt, mine, sp = 0u;
    for (;;) {
        sum = 0u; cnt = 0u; mine = 0u;
#pragma unroll
        for (unsigned j = 0; j < 16; ++j) { const unsigned c = xb_ld(&bar[XB_XCNT(j)]); sum += c; cnt += (c > 0u) ? 1u : 0u; mine = (j == x) ? c : mine; }
        if (sum == G) break;
        __builtin_amdgcn_s_sleep(1);
        if ((++sp & 255u) == 0u) { if (xb_ld(&bar[XB_TMO])) break; if (sp > XB_SPIN_CAP) { atomicAdd(&bar[XB_TMO], 1u); break; } }
    }
    nloc = mine > 0u ? mine : 1u; nx = cnt > 0u ? cnt : 1u;
}

__device__ __forceinline__ void xcd_barrier(const XcdBarrier& b) {
    asm volatile("s_waitcnt vmcnt(0)" ::: "memory");
    __syncthreads();
    if (threadIdx.x == 0) {
        unsigned* bar = b.bar;
        __builtin_amdgcn_s_waitcnt(0);
        unsigned nloc = b.st[0], nx = b.st[1];
        if (nloc == 0u) { xcd_barrier_complete(bar, b.x, nloc, nx); b.st[0] = nloc; b.st[1] = nx; }
        const unsigned old = xb_add(&bar[XB_XSUB(b.x)], 1u);
        const unsigned gen = old / nloc;
        if (old + 1u == (gen + 1u) * nloc) {
            __builtin_amdgcn_fence(__ATOMIC_RELEASE, "agent");
            asm volatile("s_waitcnt vmcnt(0)" ::: "memory");
            const unsigned og = xb_add(&bar[XB_TOP], 1u);
            const unsigned tg = og / nx;
            if (og + 1u == (tg + 1u) * nx) xb_add(&bar[XB_TOPGEN], 1u);
            else XB_SPIN(xb_ld(&bar[XB_TOPGEN]) == tg, bar);
            __builtin_amdgcn_fence(__ATOMIC_ACQUIRE, "agent");
            xb_add(&bar[XB_XGEN(b.x)], 1u);
            asm volatile("s_waitcnt vmcnt(0)" ::: "memory");
        } else {
            XB_SPIN(xb_ld(&bar[XB_XGEN(b.x)]) == gen, bar);
            __builtin_amdgcn_fence(__ATOMIC_ACQUIRE, "agent");
            asm volatile("s_waitcnt vmcnt(0)" ::: "memory");
        }
    }
    __syncthreads();
}

#ifndef OPMASK
#define OPMASK 0xFFFFFFFFu
#endif
#define EN(o) ((OPMASK >> (o)) & 1u)
enum { OP_P0 = 0, OP_RMS1, OP_HG_IN, OP_HG_A, OP_HG_B, OP_HG_C, OP_MIX_OUT, OP_LR_IN, OP_LR_CONV, OP_LR_G, OP_LR_S1, OP_LR_S2, OP_LR_S3, OP_RMS2, OP_QK, OP_TOPK, OP_GATHER };
constexpr int NPH = 42;
#define REP_MASK 0u
__device__ __forceinline__ void decode_phase(int ph, int& l, int& op) {
    if (ph == 0) { l = 0; op = OP_P0; return; }
    if (ph == 1) { l = 0; op = OP_RMS1; return; }
    int q = ph - 2;
    if (q < 9) { l = 0; } else if (q < 20) { l = 1; q -= 9; } else if (q < 29) { l = 2; q -= 20; } else { l = 3; q -= 29; }
    if ((l & 1) == 0) { op = q == 0 ? OP_HG_IN : q == 1 ? OP_HG_A : q == 2 ? OP_HG_B : q == 3 ? OP_HG_C : q == 4 ? OP_MIX_OUT : q == 5 ? OP_RMS2 : q == 6 ? OP_QK : q == 7 ? OP_TOPK : OP_GATHER; }
    else { op = q == 0 ? OP_LR_IN : q == 1 ? OP_LR_CONV : q == 2 ? OP_LR_G : q == 3 ? OP_LR_S1 : q == 4 ? OP_LR_S2 : q == 5 ? OP_LR_S3 : q == 6 ? OP_MIX_OUT : q == 7 ? OP_RMS2 : q == 8 ? OP_QK : q == 9 ? OP_TOPK : OP_GATHER; }
}

__global__ __launch_bounds__(512, 2) void mk_fwd(Params p_arg) {
    extern __shared__ __attribute__((aligned(16))) unsigned char shm[];
    LAS unsigned char* lds = (LAS unsigned char*)shm;
    cg::grid_group grid = cg::this_grid();
    unsigned long long kpv = (unsigned long long)__builtin_amdgcn_kernarg_segment_ptr();
    const int ph_lo = p_arg.ph_lo, ph_hi = p_arg.ph_hi;
    volatile LAS unsigned* xst = (volatile LAS unsigned*)(lds + LDS_BYTES - 16);
    if (threadIdx.x == 0) { xst[0] = 0u; xst[1] = 0u; }
    __syncthreads();
    const XcdBarrier xb = xcd_barrier_post((unsigned*)(p_arg.ws + WS_CTL) + 1024, xst);
    for (int ph = ph_lo; ph < ph_hi; ++ph) {
        if (ph > ph_lo) { if (ph_hi > 4096) grid.sync(); else xcd_barrier(xb); }
        asm volatile("" : "+s"(kpv));
        KP p = (KP)kpv;
        unsigned char* ws = p->ws;
        const float* MOD = (const float*)(ws + WS_MOD);
        int l, op; decode_phase(ph, l, op);
        const int j = l >> 1;
        const int nrep = ((p->rep_mask >> op) & 1u) ? 2 : 1;
        for (int rep = 0; rep < nrep; ++rep) {
        const bool dry = rep + 1 < nrep;
#ifdef ONLY
        switch (ONLY) {
#else
        switch (op) {
#endif
        case OP_P0: if (EN(OP_P0)) phase0(p, lds); break;
        case OP_RMS1: if (EN(OP_RMS1)) phase_rms(p->x, p->norm_g, MOD, MOD + 1024, (bf16_t*)(ws + WS_HBUF)); break;
        case OP_HG_IN: if (EN(OP_HG_IN)) { EpiBf16 E; E.O = (bf16_t*)(ws + WS_PROJ); E.ldc = 5120;
            run_gemm(lds, (const bf16_t*)(ws + WS_HBUF), (const bf16_t*)(ws + WS_HGWIN) + (size_t)j * 5120 * 1024, 5120, 1024, 1024, 1024, 0, 0, E); } break;
        case OP_HG_A: if (EN(OP_HG_A)) hg_pass_a(p, lds, j); break;
        case OP_HG_B: if (EN(OP_HG_B)) hg_pass_b(p); break;
        case OP_HG_C: if (EN(OP_HG_C)) hg_pass_c(p, lds, j); break;
        case OP_MIX_OUT: if (EN(OP_MIX_OUT)) { EpiResid E; E.xin = (l == 0) ? p->x : (const float*)(ws + WS_XRES); E.xout = (float*)(ws + WS_XRES); E.gate = MOD + (size_t)l * 2 * 6144 + 2 * 1024; E.dry = dry;
            const bf16_t* W = (l & 1) ? (const bf16_t*)(ws + WS_LRWOUT) + (size_t)j * 1024 * 1024 : (const bf16_t*)(ws + WS_HGWOUT) + (size_t)j * 1024 * 1024;
            run_gemm(lds, (const bf16_t*)(ws + WS_OB), W, 1024, 1024, 1024, 1024, 0, 0, E); } break;
        case OP_LR_IN: if (EN(OP_LR_IN)) { EpiLruIn E; E.XB = (bf16_t*)(ws + WS_XB); E.YG = (bf16_t*)(ws + WS_YG);
            run_gemm(lds, (const bf16_t*)(ws + WS_HBUF), (const bf16_t*)(ws + WS_LRWIN) + (size_t)j * 2048 * 1024, 2048, 1024, 1024, 1024, 0, 0, E); } break;
        case OP_LR_CONV: if (EN(OP_LR_CONV)) lru_conv(p, j); break;
        case OP_LR_G: if (EN(OP_LR_G)) { EpiGates E; E.LOGA = (bf16_t*)(ws + WS_LOGA); E.BTERM = (bf16_t*)(ws + WS_BTERM); E.XC = (const bf16_t*)(ws + WS_XC);
            E.b_a = p->lru_b_a + (size_t)j * 2048; E.b_x = p->lru_b_x + (size_t)j * 2048; E.lam = p->lru_lam + (size_t)j * 2048;
            run_gemm(lds, (const bf16_t*)(ws + WS_XC), (const bf16_t*)(ws + WS_LRWG) + (size_t)j * 4 * 1024 * 256, 4096, 256, 1024, 256, 2, 512, E); } break;
        case OP_LR_S1: if (EN(OP_LR_S1)) lru_scan1(p, lds); break;
        case OP_LR_S2: if (EN(OP_LR_S2)) lru_scan2(p); break;
        case OP_LR_S3: if (EN(OP_LR_S3)) lru_scan3(p, lds); break;
        case OP_RMS2: if (EN(OP_RMS2)) phase_rms((const float*)(ws + WS_XRES), p->norm_g + ((size_t)l * 2 + 1) * 1024, MOD + (size_t)l * 2 * 6144 + 3 * 1024, MOD + (size_t)l * 2 * 6144 + 4 * 1024, (bf16_t*)(ws + WS_HBUF)); break;
        case OP_QK: if (EN(OP_QK)) { EpiScoresT E; E.C = (float*)(ws + WS_SCORES);
            run_gemm(lds, (const bf16_t*)(ws + WS_HBUF), (const bf16_t*)(ws + WS_WQK) + (size_t)l * 2048 * 1024, 2048, 1024, 1024, 1024, 0, 0, E); } break;
        case OP_TOPK: if (EN(OP_TOPK)) peer_topk(p, lds); break;
        case OP_GATHER: if (EN(OP_GATHER)) peer_gather(p, l, dry); break;
        default: break;
        }
        }
    }
}

extern "C" void kernel_launch(void* const* d_in, const int* in_sizes, int n_in, void* d_out, int out_size, void* d_ws, size_t ws_size, hipStream_t stream) {
    static int grid = 0;
    if (grid == 0) {
        if (n_in != 23 || ws_size < WS_END) { fprintf(stderr, "kernel_launch: unexpected n_in %d / ws_size %zu (need %zu)\n", n_in, ws_size, (size_t)WS_END); grid = -1; return; }
        int dev = 0, cus = 0, per_cu = 0;
        hipGetDevice(&dev); hipDeviceGetAttribute(&cus, hipDeviceAttributeMultiprocessorCount, dev);
        if (hipFuncSetAttribute((const void*)mk_fwd, hipFuncAttributeMaxDynamicSharedMemorySize, LDS_BYTES) != hipSuccess) { fprintf(stderr, "kernel_launch: hipFuncSetAttribute failed\n"); grid = -1; return; }
        if (hipOccupancyMaxActiveBlocksPerMultiprocessor(&per_cu, (const void*)mk_fwd, NTHR, LDS_BYTES) != hipSuccess || per_cu < 1) { fprintf(stderr, "kernel_launch: occupancy query failed (%d)\n", per_cu); (void)hipGetLastError(); per_cu = 1; }
        grid = cus * 1;
        fprintf(stderr, "kernel_launch: cus %d per_cu %d grid %d\n", cus, per_cu, grid);
    }
    if (grid < 0) return;
    if (hipMemsetAsync((char*)d_ws + WS_CTL, 0, 65536, stream) != hipSuccess) { fprintf(stderr, "kernel_launch: memset failed\n"); return; }
    Params p{};
    const float** pp = (const float**)&p;
    for (int i = 0; i < 23; ++i) pp[i] = (const float*)d_in[i];
    p.out = (float*)d_out; p.ws = (unsigned char*)d_ws; p.ph_lo = 0; p.ph_hi = NPH; p.rep_mask = REP_MASK;
    void* args[] = {&p};
    hipError_t e = hipLaunchCooperativeKernel((const void*)mk_fwd, dim3(grid), dim3(NTHR), args, LDS_BYTES, stream);
    if (e != hipSuccess) fprintf(stderr, "kernel_launch: cooperative launch failed: %s (grid %d)\n", hipGetErrorString(e), grid);
}
```

```cpp
#include <hip/hip_runtime.h>
#include <hip/hip_cooperative_groups.h>
#include <cstdio>
#include <cstdint>
namespace cg = cooperative_groups;

#define LAS __attribute__((address_space(3)))
#define PG8_LAS __attribute__((address_space(3)))
typedef unsigned short bf16_t;
typedef short bf16x8 __attribute__((ext_vector_type(8)));
typedef float f32x4 __attribute__((ext_vector_type(4)));
typedef float f32x2 __attribute__((ext_vector_type(2)));
typedef unsigned u32x4 __attribute__((ext_vector_type(4)));
typedef unsigned u32x2 __attribute__((ext_vector_type(2)));

constexpr int T = 16384, D = 1024, SEQ = 8192, DEPTH = 4;
constexpr float EPS = 1e-6f;
constexpr int NBLK = 256, NTHR = 512, NWAVE = 8, NGW = NBLK * NWAVE;

constexpr size_t MiB = 1u << 20;
constexpr size_t WS_CTL = 0;
constexpr size_t WS_MOD = 1 * MiB;
constexpr size_t WS_HGWIN = 2 * MiB;
constexpr size_t WS_HGWOUT = 22 * MiB;
constexpr size_t WS_LRWIN = 26 * MiB;
constexpr size_t WS_LRWG = 34 * MiB;
constexpr size_t WS_LRWOUT = 38 * MiB;
constexpr size_t WS_WQK = 42 * MiB;
constexpr size_t WS_TOPI = 58 * MiB;
constexpr size_t WS_TOPG = 66 * MiB;
constexpr size_t WS_DEC = 74 * MiB;
constexpr size_t WS_CP = 75 * MiB;
constexpr size_t WS_CH = 79 * MiB;
constexpr size_t WS_HIN = 83 * MiB;
constexpr size_t WS_USC = 87 * MiB;
constexpr size_t WS_VSC = 87 * MiB + 262144;
constexpr size_t WS_XRES = 88 * MiB;
constexpr size_t WS_HBUF = 152 * MiB;
constexpr size_t WS_OB = 184 * MiB;
constexpr size_t WS_PROJ = 216 * MiB;
constexpr size_t WS_XB = WS_PROJ, WS_YG = WS_PROJ + 32 * MiB, WS_XC = WS_PROJ + 64 * MiB, WS_LOGA = WS_PROJ + 96 * MiB;
constexpr size_t WS_SCORES = WS_PROJ;
constexpr size_t WS_KV = 376 * MiB;
constexpr size_t WS_BTERM = WS_KV;
constexpr size_t WS_SIN = 504 * MiB;
constexpr size_t WS_UTAB = 568 * MiB;
constexpr size_t WS_VTAB = 696 * MiB;
constexpr size_t WS_END = 824 * MiB;

constexpr int LDS_BYTES = 155648;

#define LAUNDER_IDS int tidL = threadIdx.x, bidL = blockIdx.x; asm volatile("" : "+v"(tidL)); asm volatile("" : "+s"(bidL));
__device__ __forceinline__ float bf2f(bf16_t b) { return __uint_as_float(((unsigned)b) << 16); }
__device__ __forceinline__ float bflo(unsigned u) { return __uint_as_float(u << 16); }
__device__ __forceinline__ float bfhi(unsigned u) { return __uint_as_float(u & 0xffff0000u); }
__device__ __forceinline__ unsigned cvt_pk_bf16(float lo, float hi) { unsigned r; asm volatile("v_cvt_pk_bf16_f32 %0, %1, %2" : "=v"(r) : "v"(lo), "v"(hi)); return r; }
__device__ __forceinline__ bf16_t f2bf(float f) { return (bf16_t)(cvt_pk_bf16(f, 0.f) & 0xffffu); }
__device__ __forceinline__ float fast_exp(float x) { return __builtin_amdgcn_exp2f(x * 1.4426950408889634f); }
__device__ __forceinline__ float fast_log(float x) { return __builtin_amdgcn_logf(x) * 0.6931471805599453f; }
__device__ __forceinline__ float fast_rcp(float x) { return __builtin_amdgcn_rcpf(x); }
__device__ __forceinline__ float sigmoidf_(float x) { return fast_rcp(1.f + fast_exp(-x)); }
__device__ __forceinline__ float gelu_tanh(float x) { const float u = 1.5957691216057308f * (x + 0.044715f * x * x * x); return x * fast_rcp(1.f + fast_exp(-u)); }
__device__ __forceinline__ float silu_(float x) { return x * sigmoidf_(x); }
__device__ __forceinline__ float wave_sum(float v) {
#pragma unroll
    for (int o = 1; o < 64; o <<= 1) v += __shfl_xor(v, o);
    return v;
}
__device__ __forceinline__ float wave_max(float v) {
#pragma unroll
    for (int o = 1; o < 64; o <<= 1) v = fmaxf(v, __shfl_xor(v, o));
    return v;
}

namespace pg8 {
constexpr int BM = 256, BK = 64, HALF = 128, HTB = HALF * BK * 2, STAGE_BYTES = 8 * HTB, NXCD = 8, WGM = 8;
__host__ __device__ __forceinline__ int lds_byte(int r, int c) { const int st = (r >> 4) * 2 + (c >> 5), rr = r & 15, cc = c & 31, ob = rr * 64 + cc * 2; return st * 1024 + (ob ^ (((ob >> 9) & 1) << 5)); }
__host__ __device__ __forceinline__ void stage_rc(int b, int& R, int& C) { const int st = b / 1024, sb = b % 1024, swz = sb ^ (((sb >> 9) & 1) << 5); R = (st >> 1) * 16 + swz / 64; C = (st & 1) * 32 + (swz % 64) / 2; }
__host__ __device__ __forceinline__ int perm32(int rho) { const int n = rho >> 4, i = rho & 15; return 8 * (i >> 2) + 4 * n + (i & 3); }
struct Unit { int pm, pn; };
struct Gemm { const bf16_t* A; const bf16_t* Bt; int M, N, K, lda, ldb, a_pn_shift, a_pn_stride; };
struct StaticOrder {
    int nM, nN, nwg, G, c;
    __host__ __device__ void init(int M, int N, int G_, int c_) { nM = M / BM; nN = N / BM; nwg = nM * nN; G = G_; c = c_; }
    __host__ __device__ bool next(int i, Unit& u) const {
        const long L = (long)i * G + c; if (L >= nwg) return false;
        int wgid = (int)L; { const int q = nwg / NXCD, r = nwg % NXCD, xcd = wgid % NXCD, off = wgid / NXCD; wgid = (xcd < r ? xcd * (q + 1) : r * (q + 1) + (xcd - r) * q) + off; }
        const int nig = WGM * nN, gid = wgid / nig, fm = gid * WGM, gsz = (nM - fm) < WGM ? (nM - fm) : WGM;
        u.pm = fm + ((wgid % nig) % gsz); u.pn = (wgid % nig) / gsz; return true;
    }
    __device__ __forceinline__ void a_ready(const Unit&) const {}
    __device__ __forceinline__ void done(const Unit&) const {}
};
template <class Epi, class Sched, bool STAMP = false>
__device__ __forceinline__ void gemm_phase(PG8_LAS unsigned char* lds, const Gemm g, const Sched& S, const Epi& E, unsigned long long* stamps) {
    int tid = threadIdx.x; asm volatile("" : "+v"(tid)); const int wid = __builtin_amdgcn_readfirstlane(tid >> 6), lane = tid & 63, wr = wid >> 2, wc = wid & 3, fr = lane & 15, fq = lane >> 4;
    const int K = g.K, nt = K / BK;
    int ts_lo = 0, ts_hi = 0, nts = 0; const unsigned long long rt_entry = STAMP ? (unsigned long long)wall_clock64() : 0ull;
#define PG8_STAMP() do { if (STAMP && wid == 0 && nts < 64) { const unsigned long long _c = (unsigned long long)clock64(); \
        ts_lo = (lane == nts) ? (int)(unsigned)_c : ts_lo; ts_hi = (lane == nts) ? (int)(unsigned)(_c >> 32) : ts_hi; ++nts; } } while (0)
    PG8_STAMP();
    unsigned voffA[2], voffB[2];
#pragma unroll
    for (int i = 0; i < 2; ++i) { int R, C; stage_rc(tid * 16 + i * 8192, R, C); const int Rb = Epi::PERM ? ((R & ~31) + perm32(R & 31)) : R;
        voffA[i] = (unsigned)(R * g.lda + C) * 2u; voffB[i] = (unsigned)(Rb * g.ldb + C) * 2u; }
    const size_t kstep = (size_t)(BK * 2);
    const size_t hstepA = (size_t)HALF * g.lda * 2, hstepB = (size_t)HALF * g.ldb * 2;
    const size_t tstepA = 2 * hstepA, tstepB = 2 * hstepB;
    const unsigned ldsw = (unsigned)wid * 1024u;
    const int aoff = lds_byte(wr * 64 + fr, fq * 8), boff = lds_byte(wc * 32 + fr, fq * 8);
#define PG8_SA(b, h) (((b) * 2 + (h)) * HTB)
#define PG8_SB(b, h) ((4 + (b) * 2 + (h)) * HTB)
#define PG8_STAGE(bufoff, gbase, voff) do { _Pragma("unroll") for (int _i = 0; _i < 2; ++_i) \
        __builtin_amdgcn_global_load_lds((const unsigned*)((const char*)(gbase) + (voff)[_i]), (PG8_LAS unsigned*)(lds + (bufoff) + ldsw + _i * 8192), 16, 0, 0); } while (0)
#define PG8_LDA(dst, b, h) do { _Pragma("unroll") for (int m = 0; m < 4; ++m) _Pragma("unroll") for (int k = 0; k < 2; ++k) dst[m][k] = *(const PG8_LAS bf16x8*)(lds + PG8_SA(b, h) + aoff + m * 2048 + k * 1024); } while (0)
#define PG8_LDB(dst, b, h) do { _Pragma("unroll") for (int n = 0; n < 2; ++n) _Pragma("unroll") for (int k = 0; k < 2; ++k) dst[n][k] = *(const PG8_LAS bf16x8*)(lds + PG8_SB(b, h) + boff + n * 2048 + k * 1024); } while (0)
#define PG8_MMA(ai, bj, At, Bt) do { __builtin_amdgcn_s_setprio(1); _Pragma("unroll") for (int m = 0; m < 4; ++m) _Pragma("unroll") for (int n = 0; n < 2; ++n) _Pragma("unroll") for (int k = 0; k < 2; ++k) \
        acc[ai][bj][m][n] = Epi::SWAP ? __builtin_amdgcn_mfma_f32_16x16x32_bf16(At[m][k], Bt[n][k], acc[ai][bj][m][n], 0, 0, 0) : __builtin_amdgcn_mfma_f32_16x16x32_bf16(Bt[n][k], At[m][k], acc[ai][bj][m][n], 0, 0, 0); __builtin_amdgcn_s_setprio(0); } while (0)
#define PG8_WAIT_V(n) asm volatile("s_waitcnt vmcnt(" #n ")" ::: "memory")
#define PG8_WAIT_L(n) asm volatile("s_waitcnt lgkmcnt(" #n ")" ::: "memory")
#define PG8_BAR __builtin_amdgcn_s_barrier()
#define PG8_SCHED __builtin_amdgcn_sched_barrier(0)
    Unit cur, nxt; int ui = 0;
    if (!S.next(0, cur)) return;
    f32x4 acc[2][2][4][2];
#pragma unroll
    for (int a = 0; a < 2; ++a)
#pragma unroll
        for (int b = 0; b < 2; ++b)
#pragma unroll
            for (int m = 0; m < 4; ++m)
#pragma unroll
                for (int n = 0; n < 2; ++n) acc[a][b][m][n] = (f32x4){0.f, 0.f, 0.f, 0.f};
    bf16x8 At[4][2], B0[2][2], B1[2][2];
    const char* cA = (const char*)g.A + (size_t)cur.pm * tstepA + (size_t)(cur.pn >> g.a_pn_shift) * g.a_pn_stride; const char* cB = (const char*)g.Bt + (size_t)cur.pn * tstepB;
    S.a_ready(cur);
    PG8_STAGE(PG8_SB(0, 0), cB, voffB); PG8_STAGE(PG8_SA(0, 0), cA, voffA); PG8_STAGE(PG8_SB(0, 1), cB + hstepB, voffB); PG8_STAGE(PG8_SA(0, 1), cA + hstepA, voffA);
    if (wr == 1) PG8_BAR;
    PG8_WAIT_V(4); PG8_BAR;
    PG8_STAGE(PG8_SB(1, 0), cB + kstep, voffB); PG8_STAGE(PG8_SA(1, 0), cA + kstep, voffA); PG8_STAGE(PG8_SB(1, 1), cB + hstepB + kstep, voffB);
    PG8_WAIT_V(6); PG8_BAR;
    PG8_STAMP();
    for (;;) {
        const bool has_next = S.next(ui + 1, nxt);
        const char* nA = has_next ? (const char*)g.A + (size_t)nxt.pm * tstepA + (size_t)(nxt.pn >> g.a_pn_shift) * g.a_pn_stride : cA; const char* nB = has_next ? (const char*)g.Bt + (size_t)nxt.pn * tstepB : cB;
#pragma unroll 1
        for (int t = 0; t < nt; t += 2) {
            const bool last = (t == nt - 2);
            const char* a1 = cA + (size_t)(t + 1) * kstep;
            const char* a2 = last ? nA : cA + (size_t)(t + 2) * kstep; const char* b2 = last ? nB : cB + (size_t)(t + 2) * kstep;
            const char* a3 = a2 + kstep; const char* b3 = b2 + kstep;
            if (last && has_next) S.a_ready(nxt);
            PG8_LDB(B0, 0, 0); PG8_SCHED; PG8_LDA(At, 0, 0); PG8_STAGE(PG8_SA(1, 1), a1 + hstepA, voffA);
            PG8_WAIT_L(8); PG8_BAR; PG8_WAIT_L(0); PG8_MMA(0, 0, At, B0); PG8_BAR; PG8_SCHED;
            PG8_LDB(B1, 0, 1); PG8_STAGE(PG8_SB(0, 0), b2, voffB);
            PG8_BAR; PG8_WAIT_L(0); PG8_MMA(0, 1, At, B1); PG8_BAR;
            PG8_LDA(At, 0, 1); PG8_STAGE(PG8_SA(0, 0), a2, voffA);
            PG8_BAR; PG8_WAIT_L(0); PG8_MMA(1, 0, At, B0); PG8_BAR; PG8_SCHED;
            PG8_STAGE(PG8_SB(0, 1), b2 + hstepB, voffB);
            PG8_WAIT_V(6); PG8_BAR; PG8_MMA(1, 1, At, B1); PG8_BAR;
            PG8_LDB(B0, 1, 0); PG8_SCHED; PG8_LDA(At, 1, 0); PG8_STAGE(PG8_SA(0, 1), a2 + hstepA, voffA);
            PG8_WAIT_L(8); PG8_BAR; PG8_WAIT_L(0); PG8_MMA(0, 0, At, B0); PG8_BAR; PG8_SCHED;
            PG8_LDB(B1, 1, 1); PG8_STAGE(PG8_SB(1, 0), b3, voffB);
            PG8_BAR; PG8_WAIT_L(0); PG8_MMA(0, 1, At, B1); PG8_BAR;
            PG8_LDA(At, 1, 1); PG8_STAGE(PG8_SA(1, 0), a3, voffA);
            PG8_BAR; PG8_WAIT_L(0); PG8_MMA(1, 0, At, B0); PG8_BAR; PG8_SCHED;
            PG8_STAGE(PG8_SB(1, 1), b3 + hstepB, voffB);
            PG8_WAIT_V(6); PG8_BAR; PG8_MMA(1, 1, At, B1); PG8_BAR;
        }
        PG8_STAMP();
        if constexpr (!Epi::AFTER_DRAIN) { E(acc, cur, wr, wc, fr, fq); S.done(cur); }
        PG8_STAMP();
        if (!has_next) break;
#pragma unroll
        for (int a = 0; a < 2; ++a)
#pragma unroll
            for (int b = 0; b < 2; ++b)
#pragma unroll
                for (int m = 0; m < 4; ++m)
#pragma unroll
                    for (int n = 0; n < 2; ++n) acc[a][b][m][n] = (f32x4){0.f, 0.f, 0.f, 0.f};
        cur = nxt; cA = nA; cB = nB; ++ui;
    }
    PG8_WAIT_V(0);
    if (wr == 0) PG8_BAR;
    PG8_BAR;
    if constexpr (Epi::AFTER_DRAIN) { E.fused(acc, cur, wr, wc, fr, fq, lds, wid, lane); S.done(cur); }
    PG8_STAMP();
    if (STAMP && wid == 0) { stamps[lane] = lane < nts ? (((unsigned long long)(unsigned)ts_hi << 32) | (unsigned)ts_lo) : 0ull;
        if (lane == 62) stamps[62] = rt_entry; if (lane == 63) stamps[63] = (unsigned long long)wall_clock64(); }
#undef PG8_STAMP
#undef PG8_SA
#undef PG8_SB
#undef PG8_STAGE
#undef PG8_LDA
#undef PG8_LDB
#undef PG8_MMA
#undef PG8_WAIT_V
#undef PG8_WAIT_L
#undef PG8_BAR
#undef PG8_SCHED
}
}
using pg8::Unit;

struct EpiBf16 {
    static constexpr bool PERM = true, AFTER_DRAIN = false, SWAP = false;
    bf16_t* O; int ldc;
    __device__ __forceinline__ void operator()(const f32x4 (&acc)[2][2][4][2], const Unit& u, int wr, int wc, int fr, int fq) const {
        const int row0 = u.pm * 256 + wr * 64 + fr, col0 = u.pn * 256 + wc * 32 + 8 * fq;
#pragma unroll
        for (int ai = 0; ai < 2; ++ai)
#pragma unroll
            for (int m = 0; m < 4; ++m) { bf16_t* rowp = O + (size_t)(row0 + ai * 128 + m * 16) * ldc + col0;
#pragma unroll
                for (int bj = 0; bj < 2; ++bj) { const f32x4 v0 = acc[ai][bj][m][0], v1 = acc[ai][bj][m][1];
                    u32x4 o; o.x = cvt_pk_bf16(v0[0], v0[1]); o.y = cvt_pk_bf16(v0[2], v0[3]); o.z = cvt_pk_bf16(v1[0], v1[1]); o.w = cvt_pk_bf16(v1[2], v1[3]);
                    *(u32x4*)(rowp + bj * 128) = o; } }
    }
};
struct EpiLruIn {
    static constexpr bool PERM = true, AFTER_DRAIN = false, SWAP = false;
    bf16_t* XB; bf16_t* YG;
    __device__ __forceinline__ void operator()(const f32x4 (&acc)[2][2][4][2], const Unit& u, int wr, int wc, int fr, int fq) const {
        const bool isy = u.pn >= 4;
        bf16_t* O = isy ? YG : XB;
        const int row0 = u.pm * 256 + wr * 64 + fr, col0 = (u.pn & 3) * 256 + wc * 32 + 8 * fq;
#pragma unroll
        for (int ai = 0; ai < 2; ++ai)
#pragma unroll
            for (int m = 0; m < 4; ++m) { bf16_t* rowp = O + (size_t)(row0 + ai * 128 + m * 16) * 1024 + col0;
#pragma unroll
                for (int bj = 0; bj < 2; ++bj) { f32x4 v0 = acc[ai][bj][m][0], v1 = acc[ai][bj][m][1];
                    if (isy) {
#pragma unroll
                        for (int i = 0; i < 4; ++i) { v0[i] = gelu_tanh(v0[i]); v1[i] = gelu_tanh(v1[i]); } }
                    u32x4 o; o.x = cvt_pk_bf16(v0[0], v0[1]); o.y = cvt_pk_bf16(v0[2], v0[3]); o.z = cvt_pk_bf16(v1[0], v1[1]); o.w = cvt_pk_bf16(v1[2], v1[3]);
                    *(u32x4*)(rowp + bj * 128) = o; } }
    }
};
struct EpiGates {
    static constexpr bool PERM = true, AFTER_DRAIN = false, SWAP = false;
    bf16_t* LOGA; bf16_t* BTERM; const bf16_t* XC; const float* b_a; const float* b_x; const float* lam;
    __device__ __forceinline__ void operator()(const f32x4 (&acc)[2][2][4][2], const Unit& u, int wr, int wc, int fr_, int fq) const {
        int fr = fr_; asm volatile("" : "+v"(fr));
        const int nblk = u.pn >> 2, uu = u.pn & 3, d = uu >> 1, jh = uu & 1;
        const int colbase = nblk * 256 + jh * 128 + wc * 32 + 8 * fq;
        const unsigned off0 = (unsigned)(u.pm * 256 + wr * 64 + fr) * 1024u + (unsigned)colbase;
        const bf16_t* xcp = XC; bf16_t* lap = LOGA + (size_t)d * T * 1024; bf16_t* btp = BTERM + (size_t)d * T * 1024;
        const float* bap = b_a + d * 1024; const float* bxp = b_x + d * 1024; const float* lmp = lam + d * 1024;
#pragma unroll
        for (int ai = 0; ai < 2; ++ai)
#pragma unroll
            for (int m = 0; m < 4; ++m) { const unsigned off = off0 + (unsigned)(ai * 128 + m * 16) * 1024u;
                asm volatile("" ::: "memory"); __builtin_amdgcn_sched_barrier(0);
                const u32x4 xr = *(const u32x4*)(xcp + off);
                const float xv[8] = {bflo(xr.x), bfhi(xr.x), bflo(xr.y), bfhi(xr.y), bflo(xr.z), bfhi(xr.z), bflo(xr.w), bfhi(xr.w)};
                unsigned o1[4], o2[4];
#pragma unroll
                for (int n = 0; n < 2; ++n) { const f32x4 ba = *(const f32x4*)(bap + (unsigned)(colbase + 4 * n)), bx = *(const f32x4*)(bxp + (unsigned)(colbase + 4 * n)), lm = *(const f32x4*)(lmp + (unsigned)(colbase + 4 * n));
                    float la[4], bt[4];
#pragma unroll
                    for (int i = 0; i < 4; ++i) { const float r = sigmoidf_(acc[ai][0][m][n][i] + ba[i]), ig = sigmoidf_(acc[ai][1][m][n][i] + bx[i]);
                        const float l = -8.f * fast_log(1.f + fast_exp(-lm[i])) * r; const float mult = __builtin_sqrtf(fmaxf(1.f - fast_exp(2.f * l), 0.f));
                        la[i] = l; bt[i] = mult * ig * xv[n * 4 + i]; }
                    o1[n * 2] = cvt_pk_bf16(la[0], la[1]); o1[n * 2 + 1] = cvt_pk_bf16(la[2], la[3]); o2[n * 2] = cvt_pk_bf16(bt[0], bt[1]); o2[n * 2 + 1] = cvt_pk_bf16(bt[2], bt[3]); }
                *(u32x4*)(lap + off) = (u32x4){o1[0], o1[1], o1[2], o1[3]}; *(u32x4*)(btp + off) = (u32x4){o2[0], o2[1], o2[2], o2[3]}; }
    }
};
struct EpiResid {
    static constexpr bool PERM = false, AFTER_DRAIN = false, SWAP = false;
    const float* xin; float* xout; const float* gate; bool dry;
    __device__ __forceinline__ void operator()(const f32x4 (&acc)[2][2][4][2], const Unit& u, int wr, int wc, int fr, int fq) const {
        const int row0 = u.pm * 256 + wr * 64 + fr, col0 = u.pn * 256 + wc * 32 + 4 * fq;
        const float* gp = gate + ((u.pm * 256) >> 13) * 6144 + col0;
        f32x4 gv[2][2];
#pragma unroll
        for (int bj = 0; bj < 2; ++bj)
#pragma unroll
            for (int n = 0; n < 2; ++n) gv[bj][n] = *(const f32x4*)(gp + bj * 128 + n * 16);
#pragma unroll
        for (int ai = 0; ai < 2; ++ai)
#pragma unroll
            for (int m = 0; m < 4; ++m) { const size_t off = (size_t)(row0 + ai * 128 + m * 16) * 1024 + col0;
#pragma unroll
                for (int bj = 0; bj < 2; ++bj)
#pragma unroll
                    for (int n = 0; n < 2; ++n) { const f32x4 xv = *(const f32x4*)(xin + off + bj * 128 + n * 16);
                        if (!dry) *(f32x4*)(xout + off + bj * 128 + n * 16) = xv + gv[bj][n] * acc[ai][bj][m][n]; } }
    }
};
struct EpiScoresT {
    static constexpr bool PERM = false, AFTER_DRAIN = false, SWAP = true;
    float* C;
    __device__ __forceinline__ void operator()(const f32x4 (&acc)[2][2][4][2], const Unit& u, int wr, int wc, int fr_, int fq) const {
        int fr = fr_; asm volatile("" : "+v"(fr));
        const unsigned off0 = (unsigned)(u.pn * 256 + wc * 32 + fr) * (unsigned)T + (unsigned)(u.pm * 256 + wr * 64 + 4 * fq);
#pragma unroll
        for (int ai = 0; ai < 2; ++ai)
#pragma unroll
            for (int m = 0; m < 4; ++m)
#pragma unroll
                for (int bj = 0; bj < 2; ++bj)
#pragma unroll
                    for (int n = 0; n < 2; ++n) *(f32x4*)(C + (off0 + (unsigned)(bj * 128 + n * 16) * (unsigned)T + (unsigned)(ai * 128 + m * 16))) = acc[ai][bj][m][n];
    }
};

struct Params {
    const float *x, *c, *w_ada, *b_ada, *norm_g, *hg_w_in, *hg_lb, *hg_norm_g, *hg_w_out, *lru_w_in, *lru_conv_w, *lru_conv_b,
        *lru_w_a, *lru_b_a, *lru_w_x, *lru_b_x, *lru_lam, *lru_w_out, *peer_w_q, *peer_keys, *peer_u, *peer_v, *final_g;
    float* out; unsigned char* ws; int ph_lo, ph_hi; unsigned rep_mask; int pad_;
};

typedef const __attribute__((address_space(4))) Params* KP;

template <class Epi>
__device__ __forceinline__ void run_gemm(LAS unsigned char* lds, const bf16_t* A, const bf16_t* Bt, int N, int K, int lda, int ldb, int a_pn_shift, int a_pn_stride, const Epi& E) {
    pg8::Gemm g; g.A = A; g.Bt = Bt; g.M = T; g.N = N; g.K = K; g.lda = lda; g.ldb = ldb; g.a_pn_shift = a_pn_shift; g.a_pn_stride = a_pn_stride;
    LAUNDER_IDS
    pg8::StaticOrder S; S.init(T, N, (int)gridDim.x, bidL); (void)tidL;
    pg8::gemm_phase<Epi, pg8::StaticOrder, false>(lds, g, S, E, nullptr);
    __syncthreads();
}

__device__ __forceinline__ void transpose_tile(const float* __restrict__ src, int ld_src, bf16_t* dst, int ld_dst, LAS float* tile, int tid) {
#pragma unroll
    for (int it = 0; it < 2; ++it) { const int r = (tid >> 4) + 32 * it, c4 = (tid & 15) * 4;
        const f32x4 v = *(const f32x4*)(src + (size_t)r * ld_src + c4);
        tile[r * 65 + c4 + 0] = v[0]; tile[r * 65 + c4 + 1] = v[1]; tile[r * 65 + c4 + 2] = v[2]; tile[r * 65 + c4 + 3] = v[3]; }
    __syncthreads();
    { const int n = tid >> 3, kc = tid & 7; const LAS float* s = tile + (kc * 8) * 65 + n;
        u32x4 o; o.x = cvt_pk_bf16(s[0], s[65]); o.y = cvt_pk_bf16(s[2 * 65], s[3 * 65]); o.z = cvt_pk_bf16(s[4 * 65], s[5 * 65]); o.w = cvt_pk_bf16(s[6 * 65], s[7 * 65]);
        *(u32x4*)(dst + (size_t)n * ld_dst + kc * 8) = o; }
    __syncthreads();
}

__device__ __forceinline__ void phase0(KP p, LAS unsigned char* lds) {
    LAUNDER_IDS
    const int tid = tidL, wave = tid >> 6, lane = tid & 63;
    unsigned char* ws = p->ws;
    LAS float* tile = (LAS float*)lds;
    constexpr int I_HGIN = 16 * 80, I_SQ = 16 * 16, I_LRIN = 16 * 32, I_G = 16;
    constexpr int N_A = 2 * I_HGIN + 2 * I_SQ + 2 * I_LRIN + 2 * I_SQ + 32 * I_G;
    for (int it = bidL; it < N_A; it += gridDim.x) {
        int r = it;
        if (r < 2 * I_HGIN) { const int j = r / I_HGIN, q = r % I_HGIN, kb = q / 80, nb = q % 80;
            transpose_tile(p->hg_w_in + (size_t)j * 1024 * 5120 + (size_t)kb * 64 * 5120 + nb * 64, 5120, (bf16_t*)(ws + WS_HGWIN) + (size_t)j * 5120 * 1024 + (size_t)nb * 64 * 1024 + kb * 64, 1024, tile, tid); continue; }
        r -= 2 * I_HGIN;
        if (r < 2 * I_SQ) { const int j = r / I_SQ, q = r % I_SQ, kb = q / 16, nb = q % 16;
            transpose_tile(p->hg_w_out + (size_t)j * 1024 * 1024 + (size_t)kb * 64 * 1024 + nb * 64, 1024, (bf16_t*)(ws + WS_HGWOUT) + (size_t)j * 1024 * 1024 + (size_t)nb * 64 * 1024 + kb * 64, 1024, tile, tid); continue; }
        r -= 2 * I_SQ;
        if (r < 2 * I_LRIN) { const int j = r / I_LRIN, q = r % I_LRIN, kb = q / 32, nb = q % 32;
            transpose_tile(p->lru_w_in + (size_t)j * 1024 * 2048 + (size_t)kb * 64 * 2048 + nb * 64, 2048, (bf16_t*)(ws + WS_LRWIN) + (size_t)j * 2048 * 1024 + (size_t)nb * 64 * 1024 + kb * 64, 1024, tile, tid); continue; }
        r -= 2 * I_LRIN;
        if (r < 2 * I_SQ) { const int j = r / I_SQ, q = r % I_SQ, kb = q / 16, nb = q % 16;
            transpose_tile(p->lru_w_out + (size_t)j * 1024 * 1024 + (size_t)kb * 64 * 1024 + nb * 64, 1024, (bf16_t*)(ws + WS_LRWOUT) + (size_t)j * 1024 * 1024 + (size_t)nb * 64 * 1024 + kb * 64, 1024, tile, tid); continue; }
        r -= 2 * I_SQ;
        { const int mat = r / I_G, q = r % I_G, kb = q / 4, nb = q % 4;
            const int nblk = mat & 3, gate = (mat >> 2) & 1, d = (mat >> 3) & 1, l = mat >> 4;
            const float* src = (gate ? p->lru_w_x : p->lru_w_a) + (size_t)((l * 2 + d) * 4 + nblk) * 65536 + (size_t)kb * 64 * 256 + nb * 64;
            const int n0 = nb * 64, jh = n0 >> 7;
            bf16_t* dst = (bf16_t*)(ws + WS_LRWG) + (size_t)l * 4 * 1024 * 256 + (size_t)nblk * 1024 * 256 + (size_t)((d * 2 + jh) * 256 + gate * 128 + (n0 & 127)) * 256 + kb * 64;
            transpose_tile(src, 256, dst, 256, tile, tid); }
    }
    {
        LAS float* keysL = (LAS float*)lds;
        LAS float* wqL = (LAS float*)(lds + 128 * 132 * 4);
        for (int it = bidL; it < 1024; it += gridDim.x) {
            const int l = it >> 8, hp = (it >> 4) & 15, dt = it & 15;
            const float* kp = p->peer_keys + ((size_t)l * 16 + hp) * 16384;
#pragma unroll
            for (int q = 0; q < 8; ++q) { const int e = (tid + 512 * q) * 4; const f32x4 v = *(const f32x4*)(kp + e); *(LAS f32x4*)(keysL + (e >> 7) * 132 + (e & 127)) = v; }
            const float* wp = p->peer_w_q + (size_t)l * 1024 * 2048 + (size_t)(dt * 64) * 2048 + hp * 128;
#pragma unroll
            for (int q = 0; q < 4; ++q) { const int e = (tid + 512 * q) * 4; const f32x4 v = *(const f32x4*)(wp + (size_t)(e >> 7) * 2048 + (e & 127)); *(LAS f32x4*)(wqL + e) = v; }
            __syncthreads();
            const int key = tid & 127, g = tid >> 7;
            float acc[16];
#pragma unroll
            for (int i = 0; i < 16; ++i) acc[i] = 0.f;
            for (int d4 = 0; d4 < 128; d4 += 4) {
                const f32x4 kv = *(const LAS f32x4*)(keysL + key * 132 + d4);
#pragma unroll
                for (int i = 0; i < 16; ++i) { const f32x4 wv = *(const LAS f32x4*)(wqL + (g * 16 + i) * 128 + d4);
                    acc[i] += kv[0] * wv[0] + kv[1] * wv[1] + kv[2] * wv[2] + kv[3] * wv[3]; }
            }
            bf16_t* op = (bf16_t*)(ws + WS_WQK) + (size_t)l * 2048 * 1024 + (size_t)(hp * 128 + key) * 1024 + dt * 64 + g * 16;
            u32x4 o1, o2; o1.x = cvt_pk_bf16(acc[0], acc[1]); o1.y = cvt_pk_bf16(acc[2], acc[3]); o1.z = cvt_pk_bf16(acc[4], acc[5]); o1.w = cvt_pk_bf16(acc[6], acc[7]);
            o2.x = cvt_pk_bf16(acc[8], acc[9]); o2.y = cvt_pk_bf16(acc[10], acc[11]); o2.z = cvt_pk_bf16(acc[12], acc[13]); o2.w = cvt_pk_bf16(acc[14], acc[15]);
            *(u32x4*)op = o1; *(u32x4*)(op + 8) = o2;
            __syncthreads();
        }
    }
    {
        LAS float* condL = (LAS float*)lds;
        LAS float* red = (LAS float*)(lds + 8192);
        for (int i = tid; i < 2048; i += NTHR) condL[i] = silu_(p->c[i]);
        __syncthreads();
        for (int it = bidL; it < 4 * 48; it += gridDim.x) {
            const int l = it / 48, col0 = (it % 48) * 128;
            const float* wp = p->w_ada + (size_t)l * 1024 * 6144 + col0 + 2 * lane;
            float a00 = 0.f, a01 = 0.f, a10 = 0.f, a11 = 0.f;
#pragma unroll 8
            for (int kk = 0; kk < 128; ++kk) { const int k = wave * 128 + kk; const f32x2 w = *(const f32x2*)(wp + (size_t)k * 6144);
                const float c0 = condL[k], c1 = condL[1024 + k];
                a00 += c0 * w[0]; a01 += c0 * w[1]; a10 += c1 * w[0]; a11 += c1 * w[1]; }
            red[(wave * 2 + 0) * 128 + 2 * lane] = a00; red[(wave * 2 + 0) * 128 + 2 * lane + 1] = a01;
            red[(wave * 2 + 1) * 128 + 2 * lane] = a10; red[(wave * 2 + 1) * 128 + 2 * lane + 1] = a11;
            __syncthreads();
            if (tid < 256) { const int b = tid >> 7, cc = tid & 127; float s = 0.f;
#pragma unroll
                for (int w = 0; w < 8; ++w) s += red[(w * 2 + b) * 128 + cc];
                ((float*)(ws + WS_MOD))[((size_t)l * 2 + b) * 6144 + col0 + cc] = s + p->b_ada[(size_t)l * 6144 + col0 + cc]; }
            __syncthreads();
        }
    }
    {
        const int nw = gridDim.x * NWAVE;
        for (int row0 = bidL * NWAVE + wave; row0 < 2 * 65536; row0 += 4 * nw) {
            f32x4 v[4][4];
#pragma unroll
            for (int rr = 0; rr < 4; ++rr) { const int row = row0 + rr * nw; const int tb = row >> 16, r = row & 65535;
                const float* src = (tb ? p->peer_v : p->peer_u) + (size_t)r * 1024 + 4 * lane;
#pragma unroll
                for (int jx = 0; jx < 4; ++jx) v[rr][jx] = __builtin_nontemporal_load((const f32x4*)(src + 256 * jx)); }
#pragma unroll
            for (int rr = 0; rr < 4; ++rr) { const int row = row0 + rr * nw; const int tb = row >> 16, r = row & 65535;
                float am = 0.f;
#pragma unroll
                for (int jx = 0; jx < 4; ++jx) am = fmaxf(am, fmaxf(fmaxf(fabsf(v[rr][jx][0]), fabsf(v[rr][jx][1])), fmaxf(fabsf(v[rr][jx][2]), fabsf(v[rr][jx][3]))));
                am = wave_max(am);
                const float sc = am > 0.f ? am * (1.f / 6.f) : 1.f, inv = am > 0.f ? 6.f / am : 1.f;
                unsigned char* dst = ws + (tb ? WS_VTAB : WS_UTAB) + (size_t)r * 512 + 2 * lane;
#pragma unroll
                for (int jx = 0; jx < 4; ++jx) { unsigned w = __builtin_amdgcn_cvt_scalef32_pk_fp4_f32(0u, v[rr][jx][0] * inv, v[rr][jx][1] * inv, 1.0f, 0);
                    w = __builtin_amdgcn_cvt_scalef32_pk_fp4_f32(w, v[rr][jx][2] * inv, v[rr][jx][3] * inv, 1.0f, 1);
                    *(unsigned short*)(dst + 128 * jx) = (unsigned short)(w & 0xffffu); }
                if (lane == 0) ((float*)(ws + (tb ? WS_VSC : WS_USC)))[r] = sc; }
        }
    }
}

__device__ __forceinline__ void phase_rms(const float* xin, const float* gain, const float* shift, const float* scale, bf16_t* hout) {
    LAUNDER_IDS
    const int tid = tidL, wave = tid >> 6, lane = tid & 63;
    const int nw = gridDim.x * NWAVE;
    for (int row0 = bidL * NWAVE + wave; row0 < T; row0 += 2 * nw) {
        f32x4 v[2][4]; float ss[2];
#pragma unroll
        for (int rr = 0; rr < 2; ++rr) { const int row = min(row0 + rr * nw, T - 1); const float* xr = xin + (size_t)row * 1024 + lane * 4;
#pragma unroll
            for (int j = 0; j < 4; ++j) v[rr][j] = *(const f32x4*)(xr + j * 256); }
#pragma unroll
        for (int rr = 0; rr < 2; ++rr) { float a = 0.f;
#pragma unroll
            for (int j = 0; j < 4; ++j) a += v[rr][j][0] * v[rr][j][0] + v[rr][j][1] * v[rr][j][1] + v[rr][j][2] * v[rr][j][2] + v[rr][j][3] * v[rr][j][3];
            ss[rr] = a; }
#pragma unroll
        for (int o = 1; o < 64; o <<= 1) { ss[0] += __shfl_xor(ss[0], o); ss[1] += __shfl_xor(ss[1], o); }
#pragma unroll
        for (int rr = 0; rr < 2; ++rr) { const int row = row0 + rr * nw; if (row >= T) continue; const int b = row >> 13;
            const float inv = __builtin_amdgcn_rsqf(ss[rr] * (1.f / 1024.f) + EPS);
#pragma unroll
            for (int j = 0; j < 4; ++j) { const int col = j * 256 + lane * 4;
                const f32x4 g = *(const f32x4*)(gain + col), sh = *(const f32x4*)(shift + b * 6144 + col), sc = *(const f32x4*)(scale + b * 6144 + col);
                const f32x4 y = (v[rr][j] * inv) * g * (1.f + sc) + sh;
                u32x2 o; o.x = cvt_pk_bf16(y[0], y[1]); o.y = cvt_pk_bf16(y[2], y[3]);
                *(u32x2*)(hout + (size_t)row * 1024 + col) = o; } }
    }
}

constexpr int LROW = 136;
__device__ __forceinline__ float hg_lower_bound(const float* hg_lb, int j, int col) {
    if (j == 0) return 0.f;
    const float l0 = hg_lb[col], l1 = hg_lb[1024 + col];
    return fast_rcp(1.f + fast_exp(l0 - l1));
}
__device__ __forceinline__ f32x4 mfma16(bf16x8 a, bf16x8 b, f32x4 c) { return __builtin_amdgcn_mfma_f32_16x16x32_bf16(a, b, c, 0, 0, 0); }

__device__ __forceinline__ void load_v_regs(const bf16_t* proj, u32x4 (&vr)[4], int t0, int dir, int h, int tid) {
#pragma unroll
    for (int it = 0; it < 4; ++it) { const int idx = tid + 512 * it, tau = idx & 127, cv = idx >> 7;
        const int tok = dir ? t0 + 127 - tau : t0 + tau;
        vr[it] = *(const u32x4*)(proj + (size_t)tok * 5120 + 3072 + h * 128 + cv * 8); }
}
__device__ __forceinline__ void store_vt(LAS bf16_t* VT, const u32x4 (&vr)[4], int tid) {
#pragma unroll
    for (int it = 0; it < 4; ++it) { const int idx = tid + 512 * it, tau = idx & 127, cv = idx >> 7; const u32x4 v = vr[it];
        LAS bf16_t* d = VT + (cv * 8) * LROW + tau;
        d[0 * LROW] = (bf16_t)(v.x & 0xffff); d[1 * LROW] = (bf16_t)(v.x >> 16); d[2 * LROW] = (bf16_t)(v.y & 0xffff); d[3 * LROW] = (bf16_t)(v.y >> 16);
        d[4 * LROW] = (bf16_t)(v.z & 0xffff); d[5 * LROW] = (bf16_t)(v.z >> 16); d[6 * LROW] = (bf16_t)(v.w & 0xffff); d[7 * LROW] = (bf16_t)(v.w >> 16); }
}
__device__ __forceinline__ void load_tile_regs(const bf16_t* proj, u32x4 (&r)[4], int t0, int dir, int col0, int tid) {
#pragma unroll
    for (int it = 0; it < 4; ++it) { const int idx = tid + 512 * it, tau = idx >> 4, c16 = idx & 15;
        const int tok = dir ? t0 + 127 - tau : t0 + tau;
        r[it] = *(const u32x4*)(proj + (size_t)tok * 5120 + col0 + c16 * 8); }
}
__device__ __forceinline__ void store_tile(LAS bf16_t* TL, const u32x4 (&r)[4], int tid) {
#pragma unroll
    for (int it = 0; it < 4; ++it) { const int idx = tid + 512 * it, tau = idx >> 4, c16 = idx & 15; *(LAS u32x4*)(TL + tau * LROW + c16 * 8) = r[it]; }
}

__device__ __forceinline__ void hg_pass_a(KP p, LAS unsigned char* lds, int j) {
    LAUNDER_IDS
    const bf16_t* proj = (const bf16_t*)(p->ws + WS_PROJ);
    float* KV = (float*)(p->ws + WS_KV); float* DEC = (float*)(p->ws + WS_DEC);
    LAS bf16_t* VT = (LAS bf16_t*)lds; LAS bf16_t* KT = (LAS bf16_t*)(lds + 34816); LAS float* TOT = (LAS float*)(lds + 69632); LAS bf16_t* ZT = (LAS bf16_t*)(lds + 71680);
    for (int u = bidL; u < 2048; u += gridDim.x) {
        int tid = tidL; asm volatile("" : "+v"(tid));
        const int wave = tid >> 6, lane = tid & 63;
        const int seq = u >> 6, c = u & 63, dir = seq & 1, h = (seq >> 1) & 7, b = seq >> 4;
        const int t0 = b * SEQ + c * 128;
        const int dk = tid & 127, g = tid >> 7;
        const float lb = hg_lower_bound(p->hg_lb, j, h * 128 + dk);
        float lcs[32], kks[32]; float lc = 0.f;
        { u32x4 zr[4], vr[4];
            load_tile_regs(proj, zr, t0, dir, 1024 * (1 + dir) + h * 128, tid); load_v_regs(proj, vr, t0, dir, h, tid);
            store_tile(ZT, zr, tid); store_vt(VT, vr, tid); }
        __syncthreads();
#pragma unroll
        for (int q = 0; q < 32; ++q) { const int tau = 32 * g + q;
            const float z = bf2f(ZT[tau * LROW + dk]);
            const float f = lb + (1.f - lb) * sigmoidf_(z);
            lc += fast_log(f); lcs[q] = lc; kks[q] = 1.f - f; }
        TOT[g * 128 + dk] = lc;
        __syncthreads();
        float rg = 0.f, total = 0.f;
#pragma unroll
        for (int gg = 0; gg < 4; ++gg) { const float tv = TOT[gg * 128 + dk]; total += tv; if (gg < g) rg += tv; }
        const float base = total - rg;
#pragma unroll
        for (int q8 = 0; q8 < 4; ++q8) { unsigned w[4];
#pragma unroll
            for (int e = 0; e < 4; ++e) { const int q = q8 * 8 + e * 2;
                w[e] = cvt_pk_bf16(kks[q] * fast_exp(base - lcs[q]), kks[q + 1] * fast_exp(base - lcs[q + 1])); }
            u32x4 o; o.x = w[0]; o.y = w[1]; o.z = w[2]; o.w = w[3];
            *(LAS u32x4*)(KT + dk * LROW + 32 * g + q8 * 8) = o; }
        if (g == 0) DEC[(size_t)u * 128 + dk] = fast_exp(total);
        __syncthreads();
        f32x4 acc[2][4];
#pragma unroll
        for (int a = 0; a < 2; ++a)
#pragma unroll
            for (int bb = 0; bb < 4; ++bb) acc[a][bb] = (f32x4){0.f, 0.f, 0.f, 0.f};
        const int l15 = lane & 15, lq = lane >> 4;
#pragma unroll
        for (int ks = 0; ks < 4; ++ks) {
            bf16x8 af[2], bfr[4];
#pragma unroll
            for (int a = 0; a < 2; ++a) af[a] = *(const LAS bf16x8*)(VT + (((wave & 3) * 2 + a) * 16 + l15) * LROW + ks * 32 + lq * 8);
#pragma unroll
            for (int bb = 0; bb < 4; ++bb) bfr[bb] = *(const LAS bf16x8*)(KT + (((wave >> 2) * 4 + bb) * 16 + l15) * LROW + ks * 32 + lq * 8);
#pragma unroll
            for (int a = 0; a < 2; ++a)
#pragma unroll
                for (int bb = 0; bb < 4; ++bb) acc[a][bb] = mfma16(af[a], bfr[bb], acc[a][bb]);
        }
        float* kvp = KV + (size_t)u * 16384;
#pragma unroll
        for (int a = 0; a < 2; ++a)
#pragma unroll
            for (int bb = 0; bb < 4; ++bb)
#pragma unroll
                for (int r = 0; r < 4; ++r) kvp[(((wave & 3) * 2 + a) * 16 + lq * 4 + r) * 128 + ((wave >> 2) * 4 + bb) * 16 + l15] = acc[a][bb][r];
        __syncthreads();
    }
}

__device__ __forceinline__ void hg_pass_b(KP p) {
    LAUNDER_IDS
    const float* KV = (const float*)(p->ws + WS_KV); const float* DEC = (const float*)(p->ws + WS_DEC);
    bf16_t* SIN = (bf16_t*)(p->ws + WS_SIN);
    for (int e = bidL * NTHR + tidL; e < 131072; e += gridDim.x * NTHR) {
    const int seq = e >> 12, i4 = e & 4095, dir = seq & 1, dk = (i4 * 4) & 127;
    f32x4 S = {0.f, 0.f, 0.f, 0.f};
#pragma unroll 16
    for (int step = 0; step < 64; ++step) {
        const int c = dir ? 63 - step : step; const size_t u = (size_t)seq * 64 + c;
        const f32x4 kv = *(const f32x4*)(KV + u * 16384 + i4 * 4); const f32x4 dc = *(const f32x4*)(DEC + u * 128 + dk);
        u32x2 o; o.x = cvt_pk_bf16(S[0], S[1]); o.y = cvt_pk_bf16(S[2], S[3]);
        *(u32x2*)(SIN + u * 16384 + i4 * 4) = o;
        S = dc * S + kv;
    }
    }
}

__device__ __forceinline__ void hg_pass_c(KP p, LAS unsigned char* lds, int j) {
    LAUNDER_IDS
    const bf16_t* proj = (const bf16_t*)(p->ws + WS_PROJ);
    const bf16_t* SIN = (const bf16_t*)(p->ws + WS_SIN);
    bf16_t* OB = (bf16_t*)(p->ws + WS_OB);
    LAS bf16_t* QT = (LAS bf16_t*)lds; LAS bf16_t* QI = (LAS bf16_t*)(lds + 34816); LAS bf16_t* KT = (LAS bf16_t*)(lds + 69632);
    LAS bf16_t* VT = (LAS bf16_t*)(lds + 104448); LAS bf16_t* PI = (LAS bf16_t*)(lds + 139264); LAS float* TOT = (LAS float*)(lds + 147968);
    LAS float* OSUM = (LAS float*)(lds + 69632);
    for (int u = bidL; u < 1024; u += gridDim.x) {
        int tid = tidL; asm volatile("" : "+v"(tid));
        const int wave = tid >> 6, lane = tid & 63, l15 = lane & 15, lq = lane >> 4;
        const int c = u & 63, h = (u >> 6) & 7, b = u >> 9;
        const int t0 = b * SEQ + c * 128;
        const int dk = tid & 127, g = tid >> 7;
        const float lb = hg_lower_bound(p->hg_lb, j, h * 128 + dk);
        const int tt = wave & 1, dvt0 = (wave >> 1) * 2;
        f32x4 oacc[2][4][2];
#pragma unroll
        for (int dir = 0; dir < 2; ++dir) {
            const size_t su = ((size_t)((b * 8 + h) * 2 + dir) * 64 + c);
            unsigned k0p[16]; float lc = 0.f; float kprev = 0.f;
            u32x4 vr[4];
            { u32x4 zr[4], qr[4];
                load_tile_regs(proj, zr, t0, dir, 1024 * (1 + dir) + h * 128, tid); load_tile_regs(proj, qr, t0, dir, h * 128, tid); load_v_regs(proj, vr, t0, dir, h, tid);
                __syncthreads();
                store_tile(KT, zr, tid); store_tile(VT, qr, tid); }
            __syncthreads();
#pragma unroll
            for (int q = 0; q < 32; ++q) { const int tau = 32 * g + q;
                const float z = bf2f(KT[tau * LROW + dk]), qv = bf2f(VT[tau * LROW + dk]);
                const float f = lb + (1.f - lb) * sigmoidf_(z);
                lc += fast_log(f);
                const float el = fast_exp(fmaxf(lc, -80.f));
                QT[tau * LROW + dk] = f2bf(qv * el);
                const float kcur = (1.f - f) * fast_rcp(el);
                if (q & 1) k0p[q >> 1] = cvt_pk_bf16(kprev, kcur); else kprev = kcur; }
            TOT[g * 128 + dk] = lc;
            __syncthreads();
            float r[4]; { float run = 0.f;
#pragma unroll
                for (int gg = 0; gg < 4; ++gg) { r[gg] = run; run += TOT[gg * 128 + dk]; } }
            float rg = 0.f;
#pragma unroll
            for (int gg = 0; gg < 4; ++gg) if (gg == g) rg = r[gg];
            { const float eg = fast_exp(rg);
#pragma unroll
                for (int q = 0; q < 32; ++q) QI[(32 * g + q) * LROW + dk] = f2bf(bf2f(QT[(32 * g + q) * LROW + dk]) * eg); }
            store_vt(VT, vr, tid);
            bf16x8 sfr[2][4];
#pragma unroll
            for (int n = 0; n < 2; ++n)
#pragma unroll
                for (int ks = 0; ks < 4; ++ks) sfr[n][ks] = *(const bf16x8*)(SIN + su * 16384 + (size_t)((dvt0 + n) * 16 + l15) * 128 + ks * 32 + lq * 8);
#pragma unroll
            for (int i = 0; i < 4; ++i) {
                if (g <= i) { const float e = fast_exp(r[i] - rg);
#pragma unroll
                    for (int q = 0; q < 32; ++q) KT[(32 * g + q) * LROW + dk] = f2bf(((q & 1) ? bfhi(k0p[q >> 1]) : bflo(k0p[q >> 1])) * e); }
                __syncthreads();
                for (int tl = wave; tl < 4 * (i + 1); tl += 8) { const int sm = tl >> 1, tn = tl & 1;
                    f32x4 a4 = {0.f, 0.f, 0.f, 0.f};
#pragma unroll
                    for (int ks = 0; ks < 4; ++ks) { const bf16x8 af = *(const LAS bf16x8*)(KT + (sm * 16 + l15) * LROW + ks * 32 + lq * 8);
                        const bf16x8 bq = *(const LAS bf16x8*)(QT + (32 * i + tn * 16 + l15) * LROW + ks * 32 + lq * 8);
                        a4 = mfma16(af, bq, a4); }
                    const int tloc = tn * 16 + l15, s0 = sm * 16 + lq * 4, tg = 32 * i + tloc;
                    u32x2 o; o.x = cvt_pk_bf16(s0 + 0 <= tg ? a4[0] : 0.f, s0 + 1 <= tg ? a4[1] : 0.f); o.y = cvt_pk_bf16(s0 + 2 <= tg ? a4[2] : 0.f, s0 + 3 <= tg ? a4[3] : 0.f);
                    *(LAS u32x2*)(PI + tloc * LROW + s0) = o; }
                __syncthreads();
                f32x4 a0 = {0.f, 0.f, 0.f, 0.f}, a1 = {0.f, 0.f, 0.f, 0.f};
                for (int ks = 0; ks <= i; ++ks) { const bf16x8 af = *(const LAS bf16x8*)(PI + (tt * 16 + l15) * LROW + ks * 32 + lq * 8);
                    const bf16x8 b0 = *(const LAS bf16x8*)(VT + ((dvt0 + 0) * 16 + l15) * LROW + ks * 32 + lq * 8);
                    const bf16x8 b1 = *(const LAS bf16x8*)(VT + ((dvt0 + 1) * 16 + l15) * LROW + ks * 32 + lq * 8);
                    a0 = mfma16(af, b0, a0); a1 = mfma16(af, b1, a1); }
#pragma unroll
                for (int ks = 0; ks < 4; ++ks) { const bf16x8 af = *(const LAS bf16x8*)(QI + (32 * i + tt * 16 + l15) * LROW + ks * 32 + lq * 8);
                    a0 = mfma16(af, sfr[0][ks], a0); a1 = mfma16(af, sfr[1][ks], a1); }
                oacc[dir][i][0] = a0; oacc[dir][i][1] = a1;
            }
        }
        __syncthreads();
#pragma unroll
        for (int i = 0; i < 4; ++i)
#pragma unroll
            for (int n = 0; n < 2; ++n)
#pragma unroll
                for (int rr = 0; rr < 4; ++rr) OSUM[(32 * i + tt * 16 + lq * 4 + rr) * 132 + (dvt0 + n) * 16 + l15] = oacc[0][i][n][rr];
        __syncthreads();
#pragma unroll
        for (int i = 0; i < 4; ++i)
#pragma unroll
            for (int n = 0; n < 2; ++n)
#pragma unroll
                for (int rr = 0; rr < 4; ++rr) OSUM[(127 - (32 * i + tt * 16 + lq * 4 + rr)) * 132 + (dvt0 + n) * 16 + l15] += oacc[1][i][n][rr];
        __syncthreads();
        { const int row = tid >> 2, part = tid & 3; const int tok = t0 + row;
            float ov[32]; float ss = 0.f;
#pragma unroll
            for (int q = 0; q < 8; ++q) { const f32x4 v = *(const LAS f32x4*)(OSUM + row * 132 + part * 32 + q * 4);
                ov[q * 4 + 0] = v[0]; ov[q * 4 + 1] = v[1]; ov[q * 4 + 2] = v[2]; ov[q * 4 + 3] = v[3]; ss += v[0] * v[0] + v[1] * v[1] + v[2] * v[2] + v[3] * v[3]; }
            ss += __shfl_xor(ss, 1); ss += __shfl_xor(ss, 2);
            const float inv = __builtin_amdgcn_rsqf(ss * (1.f / 128.f) + EPS);
            const int col = h * 128 + part * 32;
            const bf16_t* gp = proj + (size_t)tok * 5120 + 4096 + col; const float* ng = p->hg_norm_g + j * 1024 + col;
#pragma unroll
            for (int q = 0; q < 4; ++q) { const u32x4 gr = *(const u32x4*)(gp + q * 8);
                const float gv[8] = {bflo(gr.x), bfhi(gr.x), bflo(gr.y), bfhi(gr.y), bflo(gr.z), bfhi(gr.z), bflo(gr.w), bfhi(gr.w)};
                float y[8];
#pragma unroll
                for (int e = 0; e < 8; ++e) y[e] = ov[q * 8 + e] * inv * ng[q * 8 + e] * silu_(gv[e]);
                u32x4 o; o.x = cvt_pk_bf16(y[0], y[1]); o.y = cvt_pk_bf16(y[2], y[3]); o.z = cvt_pk_bf16(y[4], y[5]); o.w = cvt_pk_bf16(y[6], y[7]);
                *(u32x4*)(OB + (size_t)tok * 1024 + col + q * 8) = o; }
        }
        __syncthreads();
    }
}

__device__ __forceinline__ void lru_conv(KP p, int l) {
    LAUNDER_IDS
    const bf16_t* XB = (const bf16_t*)(p->ws + WS_XB); bf16_t* XC = (bf16_t*)(p->ws + WS_XC);
    const float* cw = p->lru_conv_w + (size_t)l * 4 * 1024; const float* cb = p->lru_conv_b + (size_t)l * 1024;
    const int gs = gridDim.x * NTHR;
    for (int it = bidL * NTHR + tidL; it < T * 128; it += gs) {
        const int tok = it >> 7, c8 = (it & 127) * 8, s = tok & (SEQ - 1);
        float acc[8];
        { const f32x4 b0 = *(const f32x4*)(cb + c8), b1 = *(const f32x4*)(cb + c8 + 4);
            acc[0] = b0[0]; acc[1] = b0[1]; acc[2] = b0[2]; acc[3] = b0[3]; acc[4] = b1[0]; acc[5] = b1[1]; acc[6] = b1[2]; acc[7] = b1[3]; }
#pragma unroll
        for (int jj = 0; jj < 4; ++jj) { const int ts = s + jj - 2;
            if (ts >= 0 && ts < SEQ) { const u32x4 xr = *(const u32x4*)(XB + (size_t)(tok + jj - 2) * 1024 + c8);
                const f32x4 w0 = *(const f32x4*)(cw + jj * 1024 + c8), w1 = *(const f32x4*)(cw + jj * 1024 + c8 + 4);
                acc[0] += bflo(xr.x) * w0[0]; acc[1] += bfhi(xr.x) * w0[1]; acc[2] += bflo(xr.y) * w0[2]; acc[3] += bfhi(xr.y) * w0[3];
                acc[4] += bflo(xr.z) * w1[0]; acc[5] += bfhi(xr.z) * w1[1]; acc[6] += bflo(xr.w) * w1[2]; acc[7] += bfhi(xr.w) * w1[3]; } }
        u32x4 o; o.x = cvt_pk_bf16(acc[0], acc[1]); o.y = cvt_pk_bf16(acc[2], acc[3]); o.z = cvt_pk_bf16(acc[4], acc[5]); o.w = cvt_pk_bf16(acc[6], acc[7]);
        *(u32x4*)(XC + (size_t)tok * 1024 + c8) = o;
    }
}
__device__ __forceinline__ void lru_scan1(KP p, LAS unsigned char* lds) {
    LAUNDER_IDS
    const bf16_t* LOGA = (const bf16_t*)(p->ws + WS_LOGA); const bf16_t* BT = (const bf16_t*)(p->ws + WS_BTERM);
    float* CP = (float*)(p->ws + WS_CP); float* CH = (float*)(p->ws + WS_CH);
    LAS float* XP = (LAS float*)lds; LAS float* XH = (LAS float*)(lds + 16384);
    for (int u = bidL; u < 1024; u += gridDim.x) {
        int tid = tidL; asm volatile("" : "+v"(tid));
        const int ts = tid >> 7, c8 = (tid & 127) * 8;
        const int chunk = u & 255, dir = (u >> 8) & 1, b = u >> 9;
        const size_t base = ((size_t)dir * T + b * SEQ + chunk * 32) * 1024 + c8;
        u32x4 lw[8], bw[8];
#pragma unroll
        for (int q = 0; q < 8; ++q) { const int t = dir ? 31 - (ts * 8 + q) : ts * 8 + q; lw[q] = *(const u32x4*)(LOGA + base + (size_t)t * 1024); bw[q] = *(const u32x4*)(BT + base + (size_t)t * 1024); }
        float h[8], sl[8];
#pragma unroll
        for (int i = 0; i < 8; ++i) { h[i] = 0.f; sl[i] = 0.f; }
#pragma unroll
        for (int q = 0; q < 8; ++q) {
#pragma unroll
            for (int w = 0; w < 4; ++w) { const float l0 = bflo(lw[q][w]), l1 = bfhi(lw[q][w]);
                h[2 * w] = fast_exp(l0) * h[2 * w] + bflo(bw[q][w]); h[2 * w + 1] = fast_exp(l1) * h[2 * w + 1] + bfhi(bw[q][w]); sl[2 * w] += l0; sl[2 * w + 1] += l1; } }
        *(LAS f32x4*)(XP + ts * 1024 + c8) = (f32x4){fast_exp(sl[0]), fast_exp(sl[1]), fast_exp(sl[2]), fast_exp(sl[3])};
        *(LAS f32x4*)(XP + ts * 1024 + c8 + 4) = (f32x4){fast_exp(sl[4]), fast_exp(sl[5]), fast_exp(sl[6]), fast_exp(sl[7])};
        *(LAS f32x4*)(XH + ts * 1024 + c8) = (f32x4){h[0], h[1], h[2], h[3]}; *(LAS f32x4*)(XH + ts * 1024 + c8 + 4) = (f32x4){h[4], h[5], h[6], h[7]};
        __syncthreads();
        { const int ch = 2 * tid; float P0 = 1.f, P1 = 1.f, H0 = 0.f, H1 = 0.f;
#pragma unroll
            for (int s2 = 0; s2 < 4; ++s2) { const f32x2 pp = *(const LAS f32x2*)(XP + s2 * 1024 + ch), hh = *(const LAS f32x2*)(XH + s2 * 1024 + ch);
                H0 = pp[0] * H0 + hh[0]; H1 = pp[1] * H1 + hh[1]; P0 *= pp[0]; P1 *= pp[1]; }
            const size_t o = ((size_t)(b * 2 + dir) * 256 + chunk) * 1024 + ch;
            *(f32x2*)(CP + o) = (f32x2){P0, P1}; *(f32x2*)(CH + o) = (f32x2){H0, H1}; }
        __syncthreads();
    }
}
__device__ __forceinline__ void lru_scan2(KP p) {
    LAUNDER_IDS
    const float* CP = (const float*)(p->ws + WS_CP); const float* CH = (const float*)(p->ws + WS_CH); float* HIN = (float*)(p->ws + WS_HIN);
    const int wave = tidL >> 6, lane = tidL & 63;
    for (int item = bidL * NWAVE + wave; item < 4096; item += gridDim.x * NWAVE) {
        const int ch = item & 1023, bd = item >> 10, dir = bd & 1;
        float pp[4], hh[4]; float Pl = 1.f, Hl = 0.f;
#pragma unroll
        for (int q = 0; q < 4; ++q) { const int ci = 4 * lane + q, chunk = dir ? 255 - ci : ci; const size_t o = ((size_t)bd * 256 + chunk) * 1024 + ch;
            pp[q] = CP[o]; hh[q] = CH[o]; Hl = pp[q] * Hl + hh[q]; Pl *= pp[q]; }
#pragma unroll
        for (int off = 1; off < 64; off <<= 1) { const float Pp = __shfl_up(Pl, off), Hp = __shfl_up(Hl, off);
            if (lane >= off) { Hl = Pl * Hp + Hl; Pl = Pl * Pp; } }
        float carry = __shfl_up(Hl, 1); if (lane == 0) carry = 0.f;
#pragma unroll
        for (int q = 0; q < 4; ++q) { const int ci = 4 * lane + q, chunk = dir ? 255 - ci : ci; const size_t o = ((size_t)bd * 256 + chunk) * 1024 + ch;
            HIN[o] = carry; carry = pp[q] * carry + hh[q]; }
    }
}
__device__ __forceinline__ void lru_scan3(KP p, LAS unsigned char* lds) {
    LAUNDER_IDS
    const bf16_t* LOGA = (const bf16_t*)(p->ws + WS_LOGA); const bf16_t* BT = (const bf16_t*)(p->ws + WS_BTERM); const bf16_t* YG = (const bf16_t*)(p->ws + WS_YG);
    const float* HIN = (const float*)(p->ws + WS_HIN); bf16_t* OB = (bf16_t*)(p->ws + WS_OB);
    LAS float* XP = (LAS float*)lds; LAS float* XH = (LAS float*)(lds + 16384);
    for (int u = bidL; u < 512; u += gridDim.x) {
        int tid = tidL; asm volatile("" : "+v"(tid));
        const int ts = tid >> 7, c8 = (tid & 127) * 8;
        const int chunk = u & 255, b = u >> 8;
        const size_t base = ((size_t)b * SEQ + chunk * 32 + ts * 8) * 1024 + c8;
        unsigned hsp[8][4];
#pragma unroll
        for (int dir = 0; dir < 2; ++dir) {
            u32x4 lw[8], bw[8];
#pragma unroll
            for (int q = 0; q < 8; ++q) { lw[q] = *(const u32x4*)(LOGA + (size_t)dir * T * 1024 + base + (size_t)q * 1024); bw[q] = *(const u32x4*)(BT + (size_t)dir * T * 1024 + base + (size_t)q * 1024); }
            const f32x4 hi0 = *(const f32x4*)(HIN + ((size_t)(b * 2 + dir) * 256 + chunk) * 1024 + c8), hi1 = *(const f32x4*)(HIN + ((size_t)(b * 2 + dir) * 256 + chunk) * 1024 + c8 + 4);
            float h[8], sl[8];
#pragma unroll
            for (int i = 0; i < 8; ++i) { h[i] = 0.f; sl[i] = 0.f; }
#pragma unroll
            for (int qq = 0; qq < 8; ++qq) { const int q = dir ? 7 - qq : qq;
#pragma unroll
                for (int w = 0; w < 4; ++w) { const float l0 = bflo(lw[q][w]), l1 = bfhi(lw[q][w]);
                    h[2 * w] = fast_exp(l0) * h[2 * w] + bflo(bw[q][w]); h[2 * w + 1] = fast_exp(l1) * h[2 * w + 1] + bfhi(bw[q][w]); sl[2 * w] += l0; sl[2 * w + 1] += l1; } }
            __syncthreads();
            *(LAS f32x4*)(XP + ts * 1024 + c8) = (f32x4){fast_exp(sl[0]), fast_exp(sl[1]), fast_exp(sl[2]), fast_exp(sl[3])};
            *(LAS f32x4*)(XP + ts * 1024 + c8 + 4) = (f32x4){fast_exp(sl[4]), fast_exp(sl[5]), fast_exp(sl[6]), fast_exp(sl[7])};
            *(LAS f32x4*)(XH + ts * 1024 + c8) = (f32x4){h[0], h[1], h[2], h[3]}; *(LAS f32x4*)(XH + ts * 1024 + c8 + 4) = (f32x4){h[4], h[5], h[6], h[7]};
            __syncthreads();
            h[0] = hi0[0]; h[1] = hi0[1]; h[2] = hi0[2]; h[3] = hi0[3]; h[4] = hi1[0]; h[5] = hi1[1]; h[6] = hi1[2]; h[7] = hi1[3];
#pragma unroll
            for (int s3 = 0; s3 < 3; ++s3) { const int sr = dir ? 3 - s3 : s3; const bool use = dir ? (sr > ts) : (sr < ts);
                const f32x4 p0 = *(const LAS f32x4*)(XP + sr * 1024 + c8), p1 = *(const LAS f32x4*)(XP + sr * 1024 + c8 + 4), q0 = *(const LAS f32x4*)(XH + sr * 1024 + c8), q1 = *(const LAS f32x4*)(XH + sr * 1024 + c8 + 4);
                if (use) { h[0] = p0[0] * h[0] + q0[0]; h[1] = p0[1] * h[1] + q0[1]; h[2] = p0[2] * h[2] + q0[2]; h[3] = p0[3] * h[3] + q0[3];
                    h[4] = p1[0] * h[4] + q1[0]; h[5] = p1[1] * h[5] + q1[1]; h[6] = p1[2] * h[6] + q1[2]; h[7] = p1[3] * h[7] + q1[3]; } }
#pragma unroll
            for (int qq = 0; qq < 8; ++qq) { const int q = dir ? 7 - qq : qq;
                u32x4 yw; if (dir) yw = *(const u32x4*)(YG + base + (size_t)q * 1024);
                unsigned ow[4];
#pragma unroll
                for (int w = 0; w < 4; ++w) { h[2 * w] = fast_exp(bflo(lw[q][w])) * h[2 * w] + bflo(bw[q][w]); h[2 * w + 1] = fast_exp(bfhi(lw[q][w])) * h[2 * w + 1] + bfhi(bw[q][w]);
                    if (dir == 0) hsp[q][w] = cvt_pk_bf16(h[2 * w], h[2 * w + 1]);
                    else ow[w] = cvt_pk_bf16((bflo(hsp[q][w]) + h[2 * w]) * bflo(yw[w]), (bfhi(hsp[q][w]) + h[2 * w + 1]) * bfhi(yw[w])); }
                if (dir) *(u32x4*)(OB + base + (size_t)q * 1024) = (u32x4){ow[0], ow[1], ow[2], ow[3]}; }
        }
        __syncthreads();
    }
}

__device__ const unsigned char STAIR[64] = {
    0x00, 0x01, 0x02, 0x03, 0x04, 0x05, 0x06, 0x07, 0x08, 0x09, 0x0a, 0x0b, 0x0c, 0x0d, 0x0e, 0x0f,
    0x10, 0x11, 0x12, 0x13, 0x14, 0x15, 0x16, 0x17, 0x20, 0x21, 0x22, 0x23, 0x24, 0x30, 0x31, 0x32,
    0x33, 0x40, 0x41, 0x42, 0x50, 0x51, 0x60, 0x61, 0x70, 0x71, 0x80, 0x90, 0xa0, 0xb0, 0xc0, 0xd0,
    0xe0, 0xf0, 0, 0, 0, 0, 0, 0, 0, 0, 0, 0, 0, 0, 0, 0};
__device__ __forceinline__ unsigned mono_key(float f) { const unsigned b = __float_as_uint(f); return b ^ ((b >> 31) ? 0xffffffffu : 0x80000000u); }

__device__ __forceinline__ float inv_mono(unsigned k) { return __uint_as_float(k ^ ((k >> 31) ? 0x80000000u : 0xffffffffu)); }
#define TK_CE(A, B) do { const unsigned hi_ = max(A, B), lo_ = min(A, B); A = hi_; B = lo_; } while (0)
#define TK_SORT16(N) do { _Pragma("unroll") for (int k_ = 2; k_ <= 16; k_ <<= 1) { _Pragma("unroll") for (int j_ = k_ >> 1; j_ > 0; j_ >>= 1) { _Pragma("unroll") for (int i_ = 0; i_ < 16; ++i_) { \
    const int l_ = i_ ^ j_; if (l_ > i_) { if ((i_ & k_) == 0) TK_CE(N[i_], N[l_]); else TK_CE(N[l_], N[i_]); } } } } } while (0)
#define TK_MERGE16(L, N) do { _Pragma("unroll") for (int i_ = 0; i_ < 16; ++i_) L[i_] = max(L[i_], N[15 - i_]); \
    _Pragma("unroll") for (int j_ = 8; j_ > 0; j_ >>= 1) { _Pragma("unroll") for (int i_ = 0; i_ < 16; ++i_) { const int l_ = i_ ^ j_; if (l_ > i_) TK_CE(L[i_], L[l_]); } } } while (0)
#define TK_INSERT(L, x) do { _Pragma("unroll") for (int q_ = 0; q_ < 16; ++q_) { const unsigned hi_ = max(L[q_], x); x = min(L[q_], x); L[q_] = hi_; } } while (0)
__device__ __forceinline__ void peer_topk(KP p, LAS unsigned char* lds) {
    LAUNDER_IDS
    (void)bidL;
    const int tid = tidL, wave = tid >> 6, lane = tid & 63;
    const float* SCT = (const float*)(p->ws + WS_SCORES);
    int* TOPI = (int*)(p->ws + WS_TOPI); float* TOPG = (float*)(p->ws + WS_TOPG);
    LAS unsigned char* IX = lds + wave * 2048 + lane * 32;
    for (int item = bidL * NWAVE + wave; item < 2048; item += gridDim.x * NWAVE) {
        const int tg = item >> 3, hd = item & 7, tok = tg * 64 + lane;
        float V[2][16];
#pragma unroll
        for (int half = 0; half < 2; ++half) {
            unsigned L[16];
#pragma unroll
            for (int q = 0; q < 16; ++q) L[q] = 0u;
            const float* sc = SCT + (size_t)(hd * 256 + half * 128) * T + tok;
            float cur[16], nxt[16];
#pragma unroll
            for (int i = 0; i < 16; ++i) cur[i] = sc[(size_t)i * T];
#pragma unroll 1
            for (int kb = 0; kb < 8; ++kb) {
                const int kn = kb < 7 ? kb + 1 : kb;
#pragma unroll
                for (int i = 0; i < 16; ++i) nxt[i] = sc[(size_t)(kn * 16 + i) * T];
                unsigned NK[16];
#pragma unroll
                for (int i = 0; i < 16; ++i) NK[i] = (mono_key(cur[i]) & ~0x7fu) | (unsigned)(kb * 16 + i);
                TK_SORT16(NK); TK_MERGE16(L, NK);
#pragma unroll
                for (int i = 0; i < 16; ++i) cur[i] = nxt[i];
            }
            u32x4 w0, w1;
            w0.x = (L[0] & 0x7f) | ((L[1] & 0x7f) << 8) | ((L[2] & 0x7f) << 16) | ((L[3] & 0x7f) << 24); w0.y = (L[4] & 0x7f) | ((L[5] & 0x7f) << 8) | ((L[6] & 0x7f) << 16) | ((L[7] & 0x7f) << 24);
            w0.z = (L[8] & 0x7f) | ((L[9] & 0x7f) << 8) | ((L[10] & 0x7f) << 16) | ((L[11] & 0x7f) << 24); w0.w = (L[12] & 0x7f) | ((L[13] & 0x7f) << 8) | ((L[14] & 0x7f) << 16) | ((L[15] & 0x7f) << 24);
            *(LAS u32x4*)(IX + half * 16) = w0;
#pragma unroll
            for (int q = 0; q < 16; ++q) V[half][q] = inv_mono(L[q]);
        }
        unsigned C[16];
#pragma unroll
        for (int q = 0; q < 16; ++q) C[q] = 0u;
#pragma unroll
        for (int i = 0; i < 16; ++i)
#pragma unroll
            for (int jj = 0; jj < 16; ++jj) if ((i + 1) * (jj + 1) <= 16) { unsigned x = (mono_key(V[0][i] + V[1][jj]) & ~0xffu) | (unsigned)(i * 16 + jj); TK_INSERT(C, x); }
        asm volatile("s_waitcnt lgkmcnt(0)" ::: "memory");
        const float s0 = inv_mono(C[0] & ~0xffu);
        float e[16]; float sum = 0.f; int ids[16];
#pragma unroll
        for (int q = 0; q < 16; ++q) { e[q] = fast_exp(inv_mono(C[q] & ~0xffu) - s0); sum += e[q];
            const unsigned code = C[q] & 0xffu; ids[q] = (int)IX[code >> 4] * 128 + (int)IX[16 + (code & 15u)]; }
        const float rs = fast_rcp(sum);
        int* ip = TOPI + (size_t)tok * 128 + hd * 16; float* gp = TOPG + (size_t)tok * 128 + hd * 16;
#pragma unroll
        for (int q = 0; q < 4; ++q) { *(u32x4*)(ip + 4 * q) = (u32x4){(unsigned)ids[4 * q], (unsigned)ids[4 * q + 1], (unsigned)ids[4 * q + 2], (unsigned)ids[4 * q + 3]};
            *(f32x4*)(gp + 4 * q) = (f32x4){e[4 * q] * rs, e[4 * q + 1] * rs, e[4 * q + 2] * rs, e[4 * q + 3] * rs}; }
        asm volatile("s_waitcnt lgkmcnt(0)" ::: "memory");
    }
}

__device__ __forceinline__ void peer_gather(KP p, int l, bool dry) {
    LAUNDER_IDS
    const int wave = tidL >> 6, lane = tidL & 63;
    const bf16_t* HB = (const bf16_t*)(p->ws + WS_HBUF); bf16_t* HBW = (bf16_t*)(p->ws + WS_HBUF);
    const int* TOPI = (const int*)(p->ws + WS_TOPI); const float* TOPG = (const float*)(p->ws + WS_TOPG);
    const unsigned char* U8 = p->ws + WS_UTAB + (size_t)l * 16384 * 512 + 8 * lane; const unsigned char* V8 = p->ws + WS_VTAB + (size_t)l * 16384 * 512 + 8 * lane;
    const float* USC = (const float*)(p->ws + WS_USC) + l * 16384; const float* VSC = (const float*)(p->ws + WS_VSC) + l * 16384;
    float* XRES = (float*)(p->ws + WS_XRES); const float* MOD = (const float*)(p->ws + WS_MOD);
    for (int tok = bidL * NWAVE + wave; tok < T; tok += gridDim.x * NWAVE) {
        const int b = tok >> 13;
        f32x2 hv2[8];
        { const u32x4 h0 = *(const u32x4*)(HB + (size_t)tok * 1024 + 16 * lane), h1 = *(const u32x4*)(HB + (size_t)tok * 1024 + 16 * lane + 8);
            hv2[0] = (f32x2){bflo(h0.x), bfhi(h0.x)}; hv2[1] = (f32x2){bflo(h0.y), bfhi(h0.y)}; hv2[2] = (f32x2){bflo(h0.z), bfhi(h0.z)}; hv2[3] = (f32x2){bflo(h0.w), bfhi(h0.w)};
            hv2[4] = (f32x2){bflo(h1.x), bfhi(h1.x)}; hv2[5] = (f32x2){bflo(h1.y), bfhi(h1.y)}; hv2[6] = (f32x2){bflo(h1.z), bfhi(h1.z)}; hv2[7] = (f32x2){bflo(h1.w), bfhi(h1.w)}; }
        const int id0 = TOPI[(size_t)tok * 128 + lane], id1 = TOPI[(size_t)tok * 128 + 64 + lane];
        const float g0 = TOPG[(size_t)tok * 128 + lane], g1 = TOPG[(size_t)tok * 128 + 64 + lane];
        f32x2 acc2[8];
#pragma unroll
        for (int i = 0; i < 8; ++i) acc2[i] = (f32x2){0.f, 0.f};
#pragma unroll 1
        for (int e0 = 0; e0 < 128; e0 += 16) {
            u32x2 uq[16], vq[16]; float gk[16], su[16], sv[16];
#pragma unroll
            for (int k = 0; k < 16; ++k) { const int e = e0 + k;
                int id = __builtin_amdgcn_readlane(e0 < 64 ? id0 : id1, e & 63);
                id &= 16383;
                gk[k] = __uint_as_float(__builtin_amdgcn_readlane(__float_as_uint(e0 < 64 ? g0 : g1), e & 63));
                uq[k] = *(const u32x2*)(U8 + (size_t)id * 512); vq[k] = *(const u32x2*)(V8 + (size_t)id * 512);
                su[k] = USC[id]; sv[k] = VSC[id]; }
            float d[16];
#pragma unroll
            for (int k = 0; k < 16; ++k) { f32x2 s2 = (f32x2){0.f, 0.f};
#pragma unroll
                for (int w = 0; w < 2; ++w) {
                    s2 = __builtin_amdgcn_cvt_scalef32_pk_f32_fp4(uq[k][w], 1.0f, 0) * hv2[4 * w + 0] + s2; s2 = __builtin_amdgcn_cvt_scalef32_pk_f32_fp4(uq[k][w], 1.0f, 1) * hv2[4 * w + 1] + s2;
                    s2 = __builtin_amdgcn_cvt_scalef32_pk_f32_fp4(uq[k][w], 1.0f, 2) * hv2[4 * w + 2] + s2; s2 = __builtin_amdgcn_cvt_scalef32_pk_f32_fp4(uq[k][w], 1.0f, 3) * hv2[4 * w + 3] + s2; }
                d[k] = s2[0] + s2[1]; }
            const bool b32 = lane & 32, b16 = lane & 16, b8 = lane & 8, b4 = lane & 4;
            float d8[8], d4[4], d2[2], r;
#pragma unroll
            for (int k = 0; k < 8; ++k) { const float recv = __shfl_xor(b32 ? d[k] : d[k + 8], 32); d8[k] = (b32 ? d[k + 8] : d[k]) + recv; }
#pragma unroll
            for (int k = 0; k < 4; ++k) { const float recv = __shfl_xor(b16 ? d8[k] : d8[k + 4], 16); d4[k] = (b16 ? d8[k + 4] : d8[k]) + recv; }
#pragma unroll
            for (int k = 0; k < 2; ++k) { const float recv = __shfl_xor(b8 ? d4[k] : d4[k + 2], 8); d2[k] = (b8 ? d4[k + 2] : d4[k]) + recv; }
            { const float recv = __shfl_xor(b4 ? d2[0] : d2[1], 4); r = (b4 ? d2[1] : d2[0]) + recv; }
            r += __shfl_xor(r, 2); r += __shfl_xor(r, 1);
#pragma unroll
            for (int k = 0; k < 16; ++k) { const float dot = __uint_as_float(__builtin_amdgcn_readlane(__float_as_uint(r), ((k >> 3) & 1) * 32 + ((k >> 2) & 1) * 16 + ((k >> 1) & 1) * 8 + (k & 1) * 4));
                const float cf = gk[k] * gelu_tanh(dot * su[k]) * sv[k]; const f32x2 cf2 = (f32x2){cf, cf};
#pragma unroll
                for (int w = 0; w < 2; ++w) {
                    acc2[4 * w + 0] = __builtin_amdgcn_cvt_scalef32_pk_f32_fp4(vq[k][w], 1.0f, 0) * cf2 + acc2[4 * w + 0]; acc2[4 * w + 1] = __builtin_amdgcn_cvt_scalef32_pk_f32_fp4(vq[k][w], 1.0f, 1) * cf2 + acc2[4 * w + 1];
                    acc2[4 * w + 2] = __builtin_amdgcn_cvt_scalef32_pk_f32_fp4(vq[k][w], 1.0f, 2) * cf2 + acc2[4 * w + 2]; acc2[4 * w + 3] = __builtin_amdgcn_cvt_scalef32_pk_f32_fp4(vq[k][w], 1.0f, 3) * cf2 + acc2[4 * w + 3]; } }
        }
        const float* g2 = MOD + ((size_t)l * 2 + b) * 6144 + 5 * 1024 + 16 * lane;
        float* xrow = XRES + (size_t)tok * 1024 + 16 * lane;
        float xn[16]; float ss = 0.f;
#pragma unroll
        for (int q = 0; q < 4; ++q) { const f32x4 xr = *(const f32x4*)(xrow + 4 * q), gg = *(const f32x4*)(g2 + 4 * q);
            const float a0 = acc2[2 * q][0], a1 = acc2[2 * q][1], a2 = acc2[2 * q + 1][0], a3 = acc2[2 * q + 1][1];
            xn[4 * q + 0] = xr[0] + gg[0] * a0; xn[4 * q + 1] = xr[1] + gg[1] * a1; xn[4 * q + 2] = xr[2] + gg[2] * a2; xn[4 * q + 3] = xr[3] + gg[3] * a3; }
#pragma unroll
        for (int i = 0; i < 16; ++i) ss += xn[i] * xn[i];
        const float inv = __builtin_amdgcn_rsqf(wave_sum(ss) * (1.f / 1024.f) + EPS);
        if (dry) { if (inv == 123.456f) p->out[tok] = inv; continue; }
        if (l < DEPTH - 1) {
            const float* gain = p->norm_g + (size_t)(l + 1) * 2 * 1024 + 16 * lane; const float* sh = MOD + ((size_t)(l + 1) * 2 + b) * 6144 + 16 * lane; const float* sc = sh + 1024;
            float y[16];
#pragma unroll
            for (int q = 0; q < 4; ++q) { const f32x4 gn = *(const f32x4*)(gain + 4 * q), s1 = *(const f32x4*)(sh + 4 * q), c1 = *(const f32x4*)(sc + 4 * q);
                *(f32x4*)(xrow + 4 * q) = (f32x4){xn[4 * q], xn[4 * q + 1], xn[4 * q + 2], xn[4 * q + 3]};
#pragma unroll
                for (int i = 0; i < 4; ++i) y[4 * q + i] = (xn[4 * q + i] * inv) * gn[i] * (1.f + c1[i]) + s1[i]; }
            u32x4 o0, o1; o0.x = cvt_pk_bf16(y[0], y[1]); o0.y = cvt_pk_bf16(y[2], y[3]); o0.z = cvt_pk_bf16(y[4], y[5]); o0.w = cvt_pk_bf16(y[6], y[7]);
            o1.x = cvt_pk_bf16(y[8], y[9]); o1.y = cvt_pk_bf16(y[10], y[11]); o1.z = cvt_pk_bf16(y[12], y[13]); o1.w = cvt_pk_bf16(y[14], y[15]);
            *(u32x4*)(HBW + (size_t)tok * 1024 + 16 * lane) = o0; *(u32x4*)(HBW + (size_t)tok * 1024 + 16 * lane + 8) = o1;
        } else {
            const float* fg = p->final_g + 16 * lane; float* orow = p->out + (size_t)tok * 1024 + 16 * lane;
#pragma unroll
            for (int q = 0; q < 4; ++q) { const f32x4 gn = *(const f32x4*)(fg + 4 * q); f32x4 o;
#pragma unroll
                for (int i = 0; i < 4; ++i) o[i] = (xn[4 * q + i] * inv) * gn[i];
                *(f32x4*)(orow + 4 * q) = o; }
        }
    }
}

#define XB_TMO      128
#define XB_XCNT(j)  (256  + 64 * (j))
#define XB_XSUB(j)  (1280 + 64 * (j))
#define XB_XGEN(j)  (2304 + 64 * (j))
#define XB_TOP      3328
#define XB_TOPGEN   3392
#define XCD_BAR_WORDS 3456
#define XB_SPIN_CAP (1u << 18)

__device__ __forceinline__ unsigned xb_ld(unsigned* p)              { return __hip_atomic_load(p, __ATOMIC_RELAXED, __HIP_MEMORY_SCOPE_AGENT); }
__device__ __forceinline__ unsigned xb_add(unsigned* p, unsigned v) { return __hip_atomic_fetch_add(p, v, __ATOMIC_RELAXED, __HIP_MEMORY_SCOPE_AGENT); }
__device__ __forceinline__ unsigned xb_xcc_id() { return (unsigned)__builtin_amdgcn_s_getreg((3 << 11) | 20) & 0xFu; }
#define XB_SPIN(cond, bar) do { unsigned _sp = 0; while (cond) { __builtin_amdgcn_s_sleep(1); \
    if ((++_sp & 255u) == 0u) { if (xb_ld(&(bar)[XB_TMO])) break; if (_sp > XB_SPIN_CAP) { atomicAdd(&(bar)[XB_TMO], 1u); break; } } } } while (0)

struct XcdBarrier {
    unsigned* bar; unsigned x;
    volatile LAS unsigned* st;
};

__device__ __forceinline__ XcdBarrier xcd_barrier_post(unsigned* bar, volatile LAS unsigned* st) {
    XcdBarrier b; b.bar = bar; b.x = xb_xcc_id(); b.st = st;
    if (threadIdx.x == 0) (void)xb_add(&bar[XB_XCNT(b.x)], 1u);
    return b;
}
__device__ __forceinline__ void xcd_barrier_complete(unsigned* bar, unsigned x, unsigned& nloc, unsigned& nx) {
    const unsigned G = gridDim.x * gridDim.y * gridDim.z;
    unsigned sum, cnt, mine, sp = 0u;
    for (;;) {
        sum = 0u; cnt = 0u; mine = 0u;
#pragma unroll
        for (unsigned j = 0; j < 16; ++j) { const unsigned c = xb_ld(&bar[XB_XCNT(j)]); sum += c; cnt += (c > 0u) ? 1u : 0u; mine = (j == x) ? c : mine; }
        if (sum == G) break;
        __builtin_amdgcn_s_sleep(1);
        if ((++sp & 255u) == 0u) { if (xb_ld(&bar[XB_TMO])) break; if (sp > XB_SPIN_CAP) { atomicAdd(&bar[XB_TMO], 1u); break; } }
    }
    nloc = mine > 0u ? mine : 1u; nx = cnt > 0u ? cnt : 1u;
}

__device__ __forceinline__ void xcd_barrier(const XcdBarrier& b) {
    asm volatile("s_waitcnt vmcnt(0)" ::: "memory");
    __syncthreads();
    if (threadIdx.x == 0) {
        unsigned* bar = b.bar;
        __builtin_amdgcn_s_waitcnt(0);
        unsigned nloc = b.st[0], nx = b.st[1];
        if (nloc == 0u) { xcd_barrier_complete(bar, b.x, nloc, nx); b.st[0] = nloc; b.st[1] = nx; }
        const unsigned old = xb_add(&bar[XB_XSUB(b.x)], 1u);
        const unsigned gen = old / nloc;
        if (old + 1u == (gen + 1u) * nloc) {
            __builtin_amdgcn_fence(__ATOMIC_RELEASE, "agent");
            asm volatile("s_waitcnt vmcnt(0)" ::: "memory");
            const unsigned og = xb_add(&bar[XB_TOP], 1u);
            const unsigned tg = og / nx;
            if (og + 1u == (tg + 1u) * nx) xb_add(&bar[XB_TOPGEN], 1u);
            else XB_SPIN(xb_ld(&bar[XB_TOPGEN]) == tg, bar);
            __builtin_amdgcn_fence(__ATOMIC_ACQUIRE, "agent");
            xb_add(&bar[XB_XGEN(b.x)], 1u);
            asm volatile("s_waitcnt vmcnt(0)" ::: "memory");
        } else {
            XB_SPIN(xb_ld(&bar[XB_XGEN(b.x)]) == gen, bar);
            __builtin_amdgcn_fence(__ATOMIC_ACQUIRE, "agent");
            asm volatile("s_waitcnt vmcnt(0)" ::: "memory");
        }
    }
    __syncthreads();
}

#ifndef OPMASK
#define OPMASK 0xFFFFFFFFu
#endif
#define EN(o) ((OPMASK >> (o)) & 1u)
enum { OP_P0 = 0, OP_RMS1, OP_HG_IN, OP_HG_A, OP_HG_B, OP_HG_C, OP_MIX_OUT, OP_LR_IN, OP_LR_CONV, OP_LR_G, OP_LR_S1, OP_LR_S2, OP_LR_S3, OP_RMS2, OP_QK, OP_TOPK, OP_GATHER };
constexpr int NPH = 42;
#define REP_MASK 0u
__device__ __forceinline__ void decode_phase(int ph, int& l, int& op) {
    if (ph == 0) { l = 0; op = OP_P0; return; }
    if (ph == 1) { l = 0; op = OP_RMS1; return; }
    int q = ph - 2;
    if (q < 9) { l = 0; } else if (q < 20) { l = 1; q -= 9; } else if (q < 29) { l = 2; q -= 20; } else { l = 3; q -= 29; }
    if ((l & 1) == 0) { op = q == 0 ? OP_HG_IN : q == 1 ? OP_HG_A : q == 2 ? OP_HG_B : q == 3 ? OP_HG_C : q == 4 ? OP_MIX_OUT : q == 5 ? OP_RMS2 : q == 6 ? OP_QK : q == 7 ? OP_TOPK : OP_GATHER; }
    else { op = q == 0 ? OP_LR_IN : q == 1 ? OP_LR_CONV : q == 2 ? OP_LR_G : q == 3 ? OP_LR_S1 : q == 4 ? OP_LR_S2 : q == 5 ? OP_LR_S3 : q == 6 ? OP_MIX_OUT : q == 7 ? OP_RMS2 : q == 8 ? OP_QK : q == 9 ? OP_TOPK : OP_GATHER; }
}

__global__ __launch_bounds__(512, 2) void mk_fwd(Params p_arg) {
    extern __shared__ __attribute__((aligned(16))) unsigned char shm[];
    LAS unsigned char* lds = (LAS unsigned char*)shm;
    cg::grid_group grid = cg::this_grid();
    unsigned long long kpv = (unsigned long long)__builtin_amdgcn_kernarg_segment_ptr();
    const int ph_lo = p_arg.ph_lo, ph_hi = p_arg.ph_hi;
    volatile LAS unsigned* xst = (volatile LAS unsigned*)(lds + LDS_BYTES - 16);
    if (threadIdx.x == 0) { xst[0] = 0u; xst[1] = 0u; }
    __syncthreads();
    const XcdBarrier xb = xcd_barrier_post((unsigned*)(p_arg.ws + WS_CTL) + 1024, xst);
    for (int ph = ph_lo; ph < ph_hi; ++ph) {
        if (ph > ph_lo) { if (ph_hi > 4096) grid.sync(); else xcd_barrier(xb); }
        asm volatile("" : "+s"(kpv));
        KP p = (KP)kpv;
        unsigned char* ws = p->ws;
        const float* MOD = (const float*)(ws + WS_MOD);
        int l, op; decode_phase(ph, l, op);
        const int j = l >> 1;
        const int nrep = ((p->rep_mask >> op) & 1u) ? 2 : 1;
        for (int rep = 0; rep < nrep; ++rep) {
        const bool dry = rep + 1 < nrep;
#ifdef ONLY
        switch (ONLY) {
#else
        switch (op) {
#endif
        case OP_P0: if (EN(OP_P0)) phase0(p, lds); break;
        case OP_RMS1: if (EN(OP_RMS1)) phase_rms(p->x, p->norm_g, MOD, MOD + 1024, (bf16_t*)(ws + WS_HBUF)); break;
        case OP_HG_IN: if (EN(OP_HG_IN)) { EpiBf16 E; E.O = (bf16_t*)(ws + WS_PROJ); E.ldc = 5120;
            run_gemm(lds, (const bf16_t*)(ws + WS_HBUF), (const bf16_t*)(ws + WS_HGWIN) + (size_t)j * 5120 * 1024, 5120, 1024, 1024, 1024, 0, 0, E); } break;
        case OP_HG_A: if (EN(OP_HG_A)) hg_pass_a(p, lds, j); break;
        case OP_HG_B: if (EN(OP_HG_B)) hg_pass_b(p); break;
        case OP_HG_C: if (EN(OP_HG_C)) hg_pass_c(p, lds, j); break;
        case OP_MIX_OUT: if (EN(OP_MIX_OUT)) { EpiResid E; E.xin = (l == 0) ? p->x : (const float*)(ws + WS_XRES); E.xout = (float*)(ws + WS_XRES); E.gate = MOD + (size_t)l * 2 * 6144 + 2 * 1024; E.dry = dry;
            const bf16_t* W = (l & 1) ? (const bf16_t*)(ws + WS_LRWOUT) + (size_t)j * 1024 * 1024 : (const bf16_t*)(ws + WS_HGWOUT) + (size_t)j * 1024 * 1024;
            run_gemm(lds, (const bf16_t*)(ws + WS_OB), W, 1024, 1024, 1024, 1024, 0, 0, E); } break;
        case OP_LR_IN: if (EN(OP_LR_IN)) { EpiLruIn E; E.XB = (bf16_t*)(ws + WS_XB); E.YG = (bf16_t*)(ws + WS_YG);
            run_gemm(lds, (const bf16_t*)(ws + WS_HBUF), (const bf16_t*)(ws + WS_LRWIN) + (size_t)j * 2048 * 1024, 2048, 1024, 1024, 1024, 0, 0, E); } break;
        case OP_LR_CONV: if (EN(OP_LR_CONV)) lru_conv(p, j); break;
        case OP_LR_G: if (EN(OP_LR_G)) { EpiGates E; E.LOGA = (bf16_t*)(ws + WS_LOGA); E.BTERM = (bf16_t*)(ws + WS_BTERM); E.XC = (const bf16_t*)(ws + WS_XC);
            E.b_a = p->lru_b_a + (size_t)j * 2048; E.b_x = p->lru_b_x + (size_t)j * 2048; E.lam = p->lru_lam + (size_t)j * 2048;
            run_gemm(lds, (const bf16_t*)(ws + WS_XC), (const bf16_t*)(ws + WS_LRWG) + (size_t)j * 4 * 1024 * 256, 4096, 256, 1024, 256, 2, 512, E); } break;
        case OP_LR_S1: if (EN(OP_LR_S1)) lru_scan1(p, lds); break;
        case OP_LR_S2: if (EN(OP_LR_S2)) lru_scan2(p); break;
        case OP_LR_S3: if (EN(OP_LR_S3)) lru_scan3(p, lds); break;
        case OP_RMS2: if (EN(OP_RMS2)) phase_rms((const float*)(ws + WS_XRES), p->norm_g + ((size_t)l * 2 + 1) * 1024, MOD + (size_t)l * 2 * 6144 + 3 * 1024, MOD + (size_t)l * 2 * 6144 + 4 * 1024, (bf16_t*)(ws + WS_HBUF)); break;
        case OP_QK: if (EN(OP_QK)) { EpiScoresT E; E.C = (float*)(ws + WS_SCORES);
            run_gemm(lds, (const bf16_t*)(ws + WS_HBUF), (const bf16_t*)(ws + WS_WQK) + (size_t)l * 2048 * 1024, 2048, 1024, 1024, 1024, 0, 0, E); } break;
        case OP_TOPK: if (EN(OP_TOPK)) peer_topk(p, lds); break;
        case OP_GATHER: if (EN(OP_GATHER)) peer_gather(p, l, dry); break;
        default: break;
        }
        }
    }
}

extern "C" void kernel_launch(void* const* d_in, const int* in_sizes, int n_in, void* d_out, int out_size, void* d_ws, size_t ws_size, hipStream_t stream) {
    static int grid = 0;
    if (grid == 0) {
        if (n_in != 23 || ws_size < WS_END) { fprintf(stderr, "kernel_launch: unexpected n_in %d / ws_size %zu (need %zu)\n", n_in, ws_size, (size_t)WS_END); grid = -1; return; }
        int dev = 0, cus = 0, per_cu = 0;
        hipGetDevice(&dev); hipDeviceGetAttribute(&cus, hipDeviceAttributeMultiprocessorCount, dev);
        if (hipFuncSetAttribute((const void*)mk_fwd, hipFuncAttributeMaxDynamicSharedMemorySize, LDS_BYTES) != hipSuccess) { fprintf(stderr, "kernel_launch: hipFuncSetAttribute failed\n"); grid = -1; return; }
        if (hipOccupancyMaxActiveBlocksPerMultiprocessor(&per_cu, (const void*)mk_fwd, NTHR, LDS_BYTES) != hipSuccess || per_cu < 1) { fprintf(stderr, "kernel_launch: occupancy query failed (%d)\n", per_cu); (void)hipGetLastError(); per_cu = 1; }
        grid = cus * 1;
        fprintf(stderr, "kernel_launch: cus %d per_cu %d grid %d\n", cus, per_cu, grid);
    }
    if (grid < 0) return;
    if (hipMemsetAsync((char*)d_ws + WS_CTL, 0, 65536, stream) != hipSuccess) { fprintf(stderr, "kernel_launch: memset failed\n"); return; }
    Params p{};
    const float** pp = (const float**)&p;
    for (int i = 0; i < 23; ++i) pp[i] = (const float*)d_in[i];
    p.out = (float*)d_out; p.ws = (unsigned char*)d_ws; p.ph_lo = 0; p.ph_hi = NPH; p.rep_mask = REP_MASK;
    void* args[] = {&p};
    hipError_t e = hipLaunchCooperativeKernel((const void*)mk_fwd, dim3(grid), dim3(NTHR), args, LDS_BYTES, stream);
    if (e != hipSuccess) fprintf(stderr, "kernel_launch: cooperative launch failed: %s (grid %d)\n", hipGetErrorString(e), grid);
}
```

```cpp
#include <hip/hip_runtime.h>
#include <hip/hip_cooperative_groups.h>
#include <cstdio>
#include <cstdint>
namespace cg = cooperative_groups;

#define LAS __attribute__((address_space(3)))
#define PG8_LAS __attribute__((address_space(3)))
typedef unsigned short bf16_t;
typedef short bf16x8 __attribute__((ext_vector_type(8)));
typedef float f32x4 __attribute__((ext_vector_type(4)));
typedef float f32x2 __attribute__((ext_vector_type(2)));
typedef unsigned u32x4 __attribute__((ext_vector_type(4)));
typedef unsigned u32x2 __attribute__((ext_vector_type(2)));

constexpr int T = 16384, D = 1024, SEQ = 8192, DEPTH = 4;
constexpr float EPS = 1e-6f;
constexpr int NBLK = 256, NTHR = 512, NWAVE = 8, NGW = NBLK * NWAVE;

constexpr size_t MiB = 1u << 20;
constexpr size_t WS_CTL = 0;
constexpr size_t WS_MOD = 1 * MiB;
constexpr size_t WS_HGWIN = 2 * MiB;
constexpr size_t WS_HGWOUT = 22 * MiB;
constexpr size_t WS_LRWIN = 26 * MiB;
constexpr size_t WS_LRWG = 34 * MiB;
constexpr size_t WS_LRWOUT = 38 * MiB;
constexpr size_t WS_WQK = 42 * MiB;
constexpr size_t WS_TOPI = 58 * MiB;
constexpr size_t WS_TOPG = 66 * MiB;
constexpr size_t WS_DEC = 74 * MiB;
constexpr size_t WS_CP = 75 * MiB;
constexpr size_t WS_CH = 79 * MiB;
constexpr size_t WS_HIN = 83 * MiB;
constexpr size_t WS_USC = 87 * MiB;
constexpr size_t WS_VSC = 87 * MiB + 262144;
constexpr size_t WS_XRES = 88 * MiB;
constexpr size_t WS_HBUF = 152 * MiB;
constexpr size_t WS_OB = 184 * MiB;
constexpr size_t WS_PROJ = 216 * MiB;
constexpr size_t WS_XB = WS_PROJ, WS_YG = WS_PROJ + 32 * MiB, WS_XC = WS_PROJ + 64 * MiB, WS_LOGA = WS_PROJ + 96 * MiB;
constexpr size_t WS_SCORES = WS_PROJ;
constexpr size_t WS_KV = 376 * MiB;
constexpr size_t WS_BTERM = WS_KV;
constexpr size_t WS_SIN = 504 * MiB;
constexpr size_t WS_UTAB = 568 * MiB;
constexpr size_t WS_VTAB = 696 * MiB;
constexpr size_t WS_END = 824 * MiB;

constexpr int LDS_BYTES = 155648;

#define LAUNDER_IDS int tidL = threadIdx.x, bidL = blockIdx.x; asm volatile("" : "+v"(tidL)); asm volatile("" : "+s"(bidL));
__device__ __forceinline__ float bf2f(bf16_t b) { return __uint_as_float(((unsigned)b) << 16); }
__device__ __forceinline__ float bflo(unsigned u) { return __uint_as_float(u << 16); }
__device__ __forceinline__ float bfhi(unsigned u) { return __uint_as_float(u & 0xffff0000u); }
__device__ __forceinline__ unsigned cvt_pk_bf16(float lo, float hi) { unsigned r; asm volatile("v_cvt_pk_bf16_f32 %0, %1, %2" : "=v"(r) : "v"(lo), "v"(hi)); return r; }
__device__ __forceinline__ bf16_t f2bf(float f) { return (bf16_t)(cvt_pk_bf16(f, 0.f) & 0xffffu); }
__device__ __forceinline__ float fast_exp(float x) { return __builtin_amdgcn_exp2f(x * 1.4426950408889634f); }
__device__ __forceinline__ float fast_log(float x) { return __builtin_amdgcn_logf(x) * 0.6931471805599453f; }
__device__ __forceinline__ float fast_rcp(float x) { return __builtin_amdgcn_rcpf(x); }
__device__ __forceinline__ float sigmoidf_(float x) { return fast_rcp(1.f + fast_exp(-x)); }
__device__ __forceinline__ float gelu_tanh(float x) { const float u = 1.5957691216057308f * (x + 0.044715f * x * x * x); return x * fast_rcp(1.f + fast_exp(-u)); }
__device__ __forceinline__ float silu_(float x) { return x * sigmoidf_(x); }
__device__ __forceinline__ float wave_sum(float v) {
#pragma unroll
    for (int o = 1; o < 64; o <<= 1) v += __shfl_xor(v, o);
    return v;
}
__device__ __forceinline__ float wave_max(float v) {
#pragma unroll
    for (int o = 1; o < 64; o <<= 1) v = fmaxf(v, __shfl_xor(v, o));
    return v;
}

namespace pg8 {
constexpr int BM = 256, BK = 64, HALF = 128, HTB = HALF * BK * 2, STAGE_BYTES = 8 * HTB, NXCD = 8, WGM = 8;
__host__ __device__ __forceinline__ int lds_byte(int r, int c) { const int st = (r >> 4) * 2 + (c >> 5), rr = r & 15, cc = c & 31, ob = rr * 64 + cc * 2; return st * 1024 + (ob ^ (((ob >> 9) & 1) << 5)); }
__host__ __device__ __forceinline__ void stage_rc(int b, int& R, int& C) { const int st = b / 1024, sb = b % 1024, swz = sb ^ (((sb >> 9) & 1) << 5); R = (st >> 1) * 16 + swz / 64; C = (st & 1) * 32 + (swz % 64) / 2; }
__host__ __device__ __forceinline__ int perm32(int rho) { const int n = rho >> 4, i = rho & 15; return 8 * (i >> 2) + 4 * n + (i & 3); }
struct Unit { int pm, pn; };
struct Gemm { const bf16_t* A; const bf16_t* Bt; int M, N, K, lda, ldb, a_pn_shift, a_pn_stride; };
struct StaticOrder {
    int nM, nN, nwg, G, c;
    __host__ __device__ void init(int M, int N, int G_, int c_) { nM = M / BM; nN = N / BM; nwg = nM * nN; G = G_; c = c_; }
    __host__ __device__ bool next(int i, Unit& u) const {
        const long L = (long)i * G + c; if (L >= nwg) return false;
        int wgid = (int)L; { const int q = nwg / NXCD, r = nwg % NXCD, xcd = wgid % NXCD, off = wgid / NXCD; wgid = (xcd < r ? xcd * (q + 1) : r * (q + 1) + (xcd - r) * q) + off; }
        const int nig = WGM * nN, gid = wgid / nig, fm = gid * WGM, gsz = (nM - fm) < WGM ? (nM - fm) : WGM;
        u.pm = fm + ((wgid % nig) % gsz); u.pn = (wgid % nig) / gsz; return true;
    }
    __device__ __forceinline__ void a_ready(const Unit&) const {}
    __device__ __forceinline__ void done(const Unit&) const {}
};
template <class Epi, class Sched, bool STAMP = false>
__device__ __forceinline__ void gemm_phase(PG8_LAS unsigned char* lds, const Gemm g, const Sched& S, const Epi& E, unsigned long long* stamps) {
    int tid = threadIdx.x; asm volatile("" : "+v"(tid)); const int wid = __builtin_amdgcn_readfirstlane(tid >> 6), lane = tid & 63, wr = wid >> 2, wc = wid & 3, fr = lane & 15, fq = lane >> 4;
    const int K = g.K, nt = K / BK;
    int ts_lo = 0, ts_hi = 0, nts = 0; const unsigned long long rt_entry = STAMP ? (unsigned long long)wall_clock64() : 0ull;
#define PG8_STAMP() do { if (STAMP && wid == 0 && nts < 64) { const unsigned long long _c = (unsigned long long)clock64(); \
        ts_lo = (lane == nts) ? (int)(unsigned)_c : ts_lo; ts_hi = (lane == nts) ? (int)(unsigned)(_c >> 32) : ts_hi; ++nts; } } while (0)
    PG8_STAMP();
    unsigned voffA[2], voffB[2];
#pragma unroll
    for (int i = 0; i < 2; ++i) { int R, C; stage_rc(tid * 16 + i * 8192, R, C); const int Rb = Epi::PERM ? ((R & ~31) + perm32(R & 31)) : R;
        voffA[i] = (unsigned)(R * g.lda + C) * 2u; voffB[i] = (unsigned)(Rb * g.ldb + C) * 2u; }
    const size_t kstep = (size_t)(BK * 2);
    const size_t hstepA = (size_t)HALF * g.lda * 2, hstepB = (size_t)HALF * g.ldb * 2;
    const size_t tstepA = 2 * hstepA, tstepB = 2 * hstepB;
    const unsigned ldsw = (unsigned)wid * 1024u;
    const int aoff = lds_byte(wr * 64 + fr, fq * 8), boff = lds_byte(wc * 32 + fr, fq * 8);
#define PG8_SA(b, h) (((b) * 2 + (h)) * HTB)
#define PG8_SB(b, h) ((4 + (b) * 2 + (h)) * HTB)
#define PG8_STAGE(bufoff, gbase, voff) do { _Pragma("unroll") for (int _i = 0; _i < 2; ++_i) \
        __builtin_amdgcn_global_load_lds((const unsigned*)((const char*)(gbase) + (voff)[_i]), (PG8_LAS unsigned*)(lds + (bufoff) + ldsw + _i * 8192), 16, 0, 0); } while (0)
#define PG8_LDA(dst, b, h) do { _Pragma("unroll") for (int m = 0; m < 4; ++m) _Pragma("unroll") for (int k = 0; k < 2; ++k) dst[m][k] = *(const PG8_LAS bf16x8*)(lds + PG8_SA(b, h) + aoff + m * 2048 + k * 1024); } while (0)
#define PG8_LDB(dst, b, h) do { _Pragma("unroll") for (int n = 0; n < 2; ++n) _Pragma("unroll") for (int k = 0; k < 2; ++k) dst[n][k] = *(const PG8_LAS bf16x8*)(lds + PG8_SB(b, h) + boff + n * 2048 + k * 1024); } while (0)
#define PG8_MMA(ai, bj, At, Bt) do { __builtin_amdgcn_s_setprio(1); _Pragma("unroll") for (int m = 0; m < 4; ++m) _Pragma("unroll") for (int n = 0; n < 2; ++n) _Pragma("unroll") for (int k = 0; k < 2; ++k) \
        acc[ai][bj][m][n] = Epi::SWAP ? __builtin_amdgcn_mfma_f32_16x16x32_bf16(At[m][k], Bt[n][k], acc[ai][bj][m][n], 0, 0, 0) : __builtin_amdgcn_mfma_f32_16x16x32_bf16(Bt[n][k], At[m][k], acc[ai][bj][m][n], 0, 0, 0); __builtin_amdgcn_s_setprio(0); } while (0)
#define PG8_WAIT_V(n) asm volatile("s_waitcnt vmcnt(" #n ")" ::: "memory")
#define PG8_WAIT_L(n) asm volatile("s_waitcnt lgkmcnt(" #n ")" ::: "memory")
#define PG8_BAR __builtin_amdgcn_s_barrier()
#define PG8_SCHED __builtin_amdgcn_sched_barrier(0)
    Unit cur, nxt; int ui = 0;
    if (!S.next(0, cur)) return;
    f32x4 acc[2][2][4][2];
#pragma unroll
    for (int a = 0; a < 2; ++a)
#pragma unroll
        for (int b = 0; b < 2; ++b)
#pragma unroll
            for (int m = 0; m < 4; ++m)
#pragma unroll
                for (int n = 0; n < 2; ++n) acc[a][b][m][n] = (f32x4){0.f, 0.f, 0.f, 0.f};
    bf16x8 At[4][2], B0[2][2], B1[2][2];
    const char* cA = (const char*)g.A + (size_t)cur.pm * tstepA + (size_t)(cur.pn >> g.a_pn_shift) * g.a_pn_stride; const char* cB = (const char*)g.Bt + (size_t)cur.pn * tstepB;
    S.a_ready(cur);
    PG8_STAGE(PG8_SB(0, 0), cB, voffB); PG8_STAGE(PG8_SA(0, 0), cA, voffA); PG8_STAGE(PG8_SB(0, 1), cB + hstepB, voffB); PG8_STAGE(PG8_SA(0, 1), cA + hstepA, voffA);
    if (wr == 1) PG8_BAR;
    PG8_WAIT_V(4); PG8_BAR;
    PG8_STAGE(PG8_SB(1, 0), cB + kstep, voffB); PG8_STAGE(PG8_SA(1, 0), cA + kstep, voffA); PG8_STAGE(PG8_SB(1, 1), cB + hstepB + kstep, voffB);
    PG8_WAIT_V(6); PG8_BAR;
    PG8_STAMP();
    for (;;) {
        const bool has_next = S.next(ui + 1, nxt);
        const char* nA = has_next ? (const char*)g.A + (size_t)nxt.pm * tstepA + (size_t)(nxt.pn >> g.a_pn_shift) * g.a_pn_stride : cA; const char* nB = has_next ? (const char*)g.Bt + (size_t)nxt.pn * tstepB : cB;
#pragma unroll 1
        for (int t = 0; t < nt; t += 2) {
            const bool last = (t == nt - 2);
            const char* a1 = cA + (size_t)(t + 1) * kstep;
            const char* a2 = last ? nA : cA + (size_t)(t + 2) * kstep; const char* b2 = last ? nB : cB + (size_t)(t + 2) * kstep;
            const char* a3 = a2 + kstep; const char* b3 = b2 + kstep;
            if (last && has_next) S.a_ready(nxt);
            PG8_LDB(B0, 0, 0); PG8_SCHED; PG8_LDA(At, 0, 0); PG8_STAGE(PG8_SA(1, 1), a1 + hstepA, voffA);
            PG8_WAIT_L(8); PG8_BAR; PG8_WAIT_L(0); PG8_MMA(0, 0, At, B0); PG8_BAR; PG8_SCHED;
            PG8_LDB(B1, 0, 1); PG8_STAGE(PG8_SB(0, 0), b2, voffB);
            PG8_BAR; PG8_WAIT_L(0); PG8_MMA(0, 1, At, B1); PG8_BAR;
            PG8_LDA(At, 0, 1); PG8_STAGE(PG8_SA(0, 0), a2, voffA);
            PG8_BAR; PG8_WAIT_L(0); PG8_MMA(1, 0, At, B0); PG8_BAR; PG8_SCHED;
            PG8_STAGE(PG8_SB(0, 1), b2 + hstepB, voffB);
            PG8_WAIT_V(6); PG8_BAR; PG8_MMA(1, 1, At, B1); PG8_BAR;
            PG8_LDB(B0, 1, 0); PG8_SCHED; PG8_LDA(At, 1, 0); PG8_STAGE(PG8_SA(0, 1), a2 + hstepA, voffA);
            PG8_WAIT_L(8); PG8_BAR; PG8_WAIT_L(0); PG8_MMA(0, 0, At, B0); PG8_BAR; PG8_SCHED;
            PG8_LDB(B1, 1, 1); PG8_STAGE(PG8_SB(1, 0), b3, voffB);
            PG8_BAR; PG8_WAIT_L(0); PG8_MMA(0, 1, At, B1); PG8_BAR;
            PG8_LDA(At, 1, 1); PG8_STAGE(PG8_SA(1, 0), a3, voffA);
            PG8_BAR; PG8_WAIT_L(0); PG8_MMA(1, 0, At, B0); PG8_BAR; PG8_SCHED;
            PG8_STAGE(PG8_SB(1, 1), b3 + hstepB, voffB);
            PG8_WAIT_V(6); PG8_BAR; PG8_MMA(1, 1, At, B1); PG8_BAR;
        }
        PG8_STAMP();
        if constexpr (!Epi::AFTER_DRAIN) { E(acc, cur, wr, wc, fr, fq); S.done(cur); }
        PG8_STAMP();
        if (!has_next) break;
#pragma unroll
        for (int a = 0; a < 2; ++a)
#pragma unroll
            for (int b = 0; b < 2; ++b)
#pragma unroll
                for (int m = 0; m < 4; ++m)
#pragma unroll
                    for (int n = 0; n < 2; ++n) acc[a][b][m][n] = (f32x4){0.f, 0.f, 0.f, 0.f};
        cur = nxt; cA = nA; cB = nB; ++ui;
    }
    PG8_WAIT_V(0);
    if (wr == 0) PG8_BAR;
    PG8_BAR;
    if constexpr (Epi::AFTER_DRAIN) { E.fused(acc, cur, wr, wc, fr, fq, lds, wid, lane); S.done(cur); }
    PG8_STAMP();
    if (STAMP && wid == 0) { stamps[lane] = lane < nts ? (((unsigned long long)(unsigned)ts_hi << 32) | (unsigned)ts_lo) : 0ull;
        if (lane == 62) stamps[62] = rt_entry; if (lane == 63) stamps[63] = (unsigned long long)wall_clock64(); }
#undef PG8_STAMP
#undef PG8_SA
#undef PG8_SB
#undef PG8_STAGE
#undef PG8_LDA
#undef PG8_LDB
#undef PG8_MMA
#undef PG8_WAIT_V
#undef PG8_WAIT_L
#undef PG8_BAR
#undef PG8_SCHED
}
}
using pg8::Unit;

struct EpiBf16 {
    static constexpr bool PERM = true, AFTER_DRAIN = false, SWAP = false;
    bf16_t* O; int ldc;
    __device__ __forceinline__ void operator()(const f32x4 (&acc)[2][2][4][2], const Unit& u, int wr, int wc, int fr, int fq) const {
        const int row0 = u.pm * 256 + wr * 64 + fr, col0 = u.pn * 256 + wc * 32 + 8 * fq;
#pragma unroll
        for (int ai = 0; ai < 2; ++ai)
#pragma unroll
            for (int m = 0; m < 4; ++m) { bf16_t* rowp = O + (size_t)(row0 + ai * 128 + m * 16) * ldc + col0;
#pragma unroll
                for (int bj = 0; bj < 2; ++bj) { const f32x4 v0 = acc[ai][bj][m][0], v1 = acc[ai][bj][m][1];
                    u32x4 o; o.x = cvt_pk_bf16(v0[0], v0[1]); o.y = cvt_pk_bf16(v0[2], v0[3]); o.z = cvt_pk_bf16(v1[0], v1[1]); o.w = cvt_pk_bf16(v1[2], v1[3]);
                    *(u32x4*)(rowp + bj * 128) = o; } }
    }
};
struct EpiLruIn {
    static constexpr bool PERM = true, AFTER_DRAIN = false, SWAP = false;
    bf16_t* XB; bf16_t* YG;
    __device__ __forceinline__ void operator()(const f32x4 (&acc)[2][2][4][2], const Unit& u, int wr, int wc, int fr, int fq) const {
        const bool isy = u.pn >= 4;
        bf16_t* O = isy ? YG : XB;
        const int row0 = u.pm * 256 + wr * 64 + fr, col0 = (u.pn & 3) * 256 + wc * 32 + 8 * fq;
#pragma unroll
        for (int ai = 0; ai < 2; ++ai)
#pragma unroll
            for (int m = 0; m < 4; ++m) { bf16_t* rowp = O + (size_t)(row0 + ai * 128 + m * 16) * 1024 + col0;
#pragma unroll
                for (int bj = 0; bj < 2; ++bj) { f32x4 v0 = acc[ai][bj][m][0], v1 = acc[ai][bj][m][1];
                    if (isy) {
#pragma unroll
                        for (int i = 0; i < 4; ++i) { v0[i] = gelu_tanh(v0[i]); v1[i] = gelu_tanh(v1[i]); } }
                    u32x4 o; o.x = cvt_pk_bf16(v0[0], v0[1]); o.y = cvt_pk_bf16(v0[2], v0[3]); o.z = cvt_pk_bf16(v1[0], v1[1]); o.w = cvt_pk_bf16(v1[2], v1[3]);
                    *(u32x4*)(rowp + bj * 128) = o; } }
    }
};
struct EpiGates {
    static constexpr bool PERM = true, AFTER_DRAIN = false, SWAP = false;
    bf16_t* LOGA; bf16_t* BTERM; const bf16_t* XC; const float* b_a; const float* b_x; const float* lam;
    __device__ __forceinline__ void operator()(const f32x4 (&acc)[2][2][4][2], const Unit& u, int wr, int wc, int fr_, int fq) const {
        int fr = fr_; asm volatile("" : "+v"(fr));
        const int nblk = u.pn >> 2, uu = u.pn & 3, d = uu >> 1, jh = uu & 1;
        const int colbase = nblk * 256 + jh * 128 + wc * 32 + 8 * fq;
        const unsigned off0 = (unsigned)(u.pm * 256 + wr * 64 + fr) * 1024u + (unsigned)colbase;
        const bf16_t* xcp = XC; bf16_t* lap = LOGA + (size_t)d * T * 1024; bf16_t* btp = BTERM + (size_t)d * T * 1024;
        const float* bap = b_a + d * 1024; const float* bxp = b_x + d * 1024; const float* lmp = lam + d * 1024;
#pragma unroll
        for (int ai = 0; ai < 2; ++ai)
#pragma unroll
            for (int m = 0; m < 4; ++m) { const unsigned off = off0 + (unsigned)(ai * 128 + m * 16) * 1024u;
                asm volatile("" ::: "memory"); __builtin_amdgcn_sched_barrier(0);
                const u32x4 xr = *(const u32x4*)(xcp + off);
                const float xv[8] = {bflo(xr.x), bfhi(xr.x), bflo(xr.y), bfhi(xr.y), bflo(xr.z), bfhi(xr.z), bflo(xr.w), bfhi(xr.w)};
                unsigned o1[4], o2[4];
#pragma unroll
                for (int n = 0; n < 2; ++n) { const f32x4 ba = *(const f32x4*)(bap + (unsigned)(colbase + 4 * n)), bx = *(const f32x4*)(bxp + (unsigned)(colbase + 4 * n)), lm = *(const f32x4*)(lmp + (unsigned)(colbase + 4 * n));
                    float la[4], bt[4];
#pragma unroll
                    for (int i = 0; i < 4; ++i) { const float r = sigmoidf_(acc[ai][0][m][n][i] + ba[i]), ig = sigmoidf_(acc[ai][1][m][n][i] + bx[i]);
                        const float l = -8.f * fast_log(1.f + fast_exp(-lm[i])) * r; const float mult = __builtin_sqrtf(fmaxf(1.f - fast_exp(2.f * l), 0.f));
                        la[i] = l; bt[i] = mult * ig * xv[n * 4 + i]; }
                    o1[n * 2] = cvt_pk_bf16(la[0], la[1]); o1[n * 2 + 1] = cvt_pk_bf16(la[2], la[3]); o2[n * 2] = cvt_pk_bf16(bt[0], bt[1]); o2[n * 2 + 1] = cvt_pk_bf16(bt[2], bt[3]); }
                *(u32x4*)(lap + off) = (u32x4){o1[0], o1[1], o1[2], o1[3]}; *(u32x4*)(btp + off) = (u32x4){o2[0], o2[1], o2[2], o2[3]}; }
    }
};
struct EpiResid {
    static constexpr bool PERM = false, AFTER_DRAIN = false, SWAP = false;
    const float* xin; float* xout; const float* gate; bool dry;
    __device__ __forceinline__ void operator()(const f32x4 (&acc)[2][2][4][2], const Unit& u, int wr, int wc, int fr, int fq) const {
        const int row0 = u.pm * 256 + wr * 64 + fr, col0 = u.pn * 256 + wc * 32 + 4 * fq;
        const float* gp = gate + ((u.pm * 256) >> 13) * 6144 + col0;
        f32x4 gv[2][2];
#pragma unroll
        for (int bj = 0; bj < 2; ++bj)
#pragma unroll
            for (int n = 0; n < 2; ++n) gv[bj][n] = *(const f32x4*)(gp + bj * 128 + n * 16);
#pragma unroll
        for (int ai = 0; ai < 2; ++ai)
#pragma unroll
            for (int m = 0; m < 4; ++m) { const size_t off = (size_t)(row0 + ai * 128 + m * 16) * 1024 + col0;
#pragma unroll
                for (int bj = 0; bj < 2; ++bj)
#pragma unroll
                    for (int n = 0; n < 2; ++n) { const f32x4 xv = *(const f32x4*)(xin + off + bj * 128 + n * 16);
                        if (!dry) *(f32x4*)(xout + off + bj * 128 + n * 16) = xv + gv[bj][n] * acc[ai][bj][m][n]; } }
    }
};
struct EpiScoresT {
    static constexpr bool PERM = false, AFTER_DRAIN = false, SWAP = true;
    float* C;
    __device__ __forceinline__ void operator()(const f32x4 (&acc)[2][2][4][2], const Unit& u, int wr, int wc, int fr_, int fq) const {
        int fr = fr_; asm volatile("" : "+v"(fr));
        const unsigned off0 = (unsigned)(u.pn * 256 + wc * 32 + fr) * (unsigned)T + (unsigned)(u.pm * 256 + wr * 64 + 4 * fq);
#pragma unroll
        for (int ai = 0; ai < 2; ++ai)
#pragma unroll
            for (int m = 0; m < 4; ++m)
#pragma unroll
                for (int bj = 0; bj < 2; ++bj)
#pragma unroll
                    for (int n = 0; n < 2; ++n) *(f32x4*)(C + (off0 + (unsigned)(bj * 128 + n * 16) * (unsigned)T + (unsigned)(ai * 128 + m * 16))) = acc[ai][bj][m][n];
    }
};

struct Params {
    const float *x, *c, *w_ada, *b_ada, *norm_g, *hg_w_in, *hg_lb, *hg_norm_g, *hg_w_out, *lru_w_in, *lru_conv_w, *lru_conv_b,
        *lru_w_a, *lru_b_a, *lru_w_x, *lru_b_x, *lru_lam, *lru_w_out, *peer_w_q, *peer_keys, *peer_u, *peer_v, *final_g;
    float* out; unsigned char* ws; int ph_lo, ph_hi; unsigned rep_mask; int pad_;
};

typedef const __attribute__((address_space(4))) Params* KP;

template <class Epi>
__device__ __forceinline__ void run_gemm(LAS unsigned char* lds, const bf16_t* A, const bf16_t* Bt, int N, int K, int lda, int ldb, int a_pn_shift, int a_pn_stride, const Epi& E) {
    pg8::Gemm g; g.A = A; g.Bt = Bt; g.M = T; g.N = N; g.K = K; g.lda = lda; g.ldb = ldb; g.a_pn_shift = a_pn_shift; g.a_pn_stride = a_pn_stride;
    LAUNDER_IDS
    pg8::StaticOrder S; S.init(T, N, (int)gridDim.x, bidL); (void)tidL;
    pg8::gemm_phase<Epi, pg8::StaticOrder, false>(lds, g, S, E, nullptr);
    __syncthreads();
}

__device__ __forceinline__ void transpose_tile(const float* __restrict__ src, int ld_src, bf16_t* dst, int ld_dst, LAS float* tile, int tid) {
#pragma unroll
    for (int it = 0; it < 2; ++it) { const int r = (tid >> 4) + 32 * it, c4 = (tid & 15) * 4;
        const f32x4 v = *(const f32x4*)(src + (size_t)r * ld_src + c4);
        tile[r * 65 + c4 + 0] = v[0]; tile[r * 65 + c4 + 1] = v[1]; tile[r * 65 + c4 + 2] = v[2]; tile[r * 65 + c4 + 3] = v[3]; }
    __syncthreads();
    { const int n = tid >> 3, kc = tid & 7; const LAS float* s = tile + (kc * 8) * 65 + n;
        u32x4 o; o.x = cvt_pk_bf16(s[0], s[65]); o.y = cvt_pk_bf16(s[2 * 65], s[3 * 65]); o.z = cvt_pk_bf16(s[4 * 65], s[5 * 65]); o.w = cvt_pk_bf16(s[6 * 65], s[7 * 65]);
        *(u32x4*)(dst + (size_t)n * ld_dst + kc * 8) = o; }
    __syncthreads();
}

__device__ __forceinline__ void phase0(KP p, LAS unsigned char* lds) {
    LAUNDER_IDS
    const int tid = tidL, wave = tid >> 6, lane = tid & 63;
    unsigned char* ws = p->ws;
    LAS float* tile = (LAS float*)lds;
    constexpr int I_HGIN = 16 * 80, I_SQ = 16 * 16, I_LRIN = 16 * 32, I_G = 16;
    constexpr int N_A = 2 * I_HGIN + 2 * I_SQ + 2 * I_LRIN + 2 * I_SQ + 32 * I_G;
    for (int it = bidL; it < N_A; it += gridDim.x) {
        int r = it;
        if (r < 2 * I_HGIN) { const int j = r / I_HGIN, q = r % I_HGIN, kb = q / 80, nb = q % 80;
            transpose_tile(p->hg_w_in + (size_t)j * 1024 * 5120 + (size_t)kb * 64 * 5120 + nb * 64, 5120, (bf16_t*)(ws + WS_HGWIN) + (size_t)j * 5120 * 1024 + (size_t)nb * 64 * 1024 + kb * 64, 1024, tile, tid); continue; }
        r -= 2 * I_HGIN;
        if (r < 2 * I_SQ) { const int j = r / I_SQ, q = r % I_SQ, kb = q / 16, nb = q % 16;
            transpose_tile(p->hg_w_out + (size_t)j * 1024 * 1024 + (size_t)kb * 64 * 1024 + nb * 64, 1024, (bf16_t*)(ws + WS_HGWOUT) + (size_t)j * 1024 * 1024 + (size_t)nb * 64 * 1024 + kb * 64, 1024, tile, tid); continue; }
        r -= 2 * I_SQ;
        if (r < 2 * I_LRIN) { const int j = r / I_LRIN, q = r % I_LRIN, kb = q / 32, nb = q % 32;
            transpose_tile(p->lru_w_in + (size_t)j * 1024 * 2048 + (size_t)kb * 64 * 2048 + nb * 64, 2048, (bf16_t*)(ws + WS_LRWIN) + (size_t)j * 2048 * 1024 + (size_t)nb * 64 * 1024 + kb * 64, 1024, tile, tid); continue; }
        r -= 2 * I_LRIN;
        if (r < 2 * I_SQ) { const int j = r / I_SQ, q = r % I_SQ, kb = q / 16, nb = q % 16;
            transpose_tile(p->lru_w_out + (size_t)j * 1024 * 1024 + (size_t)kb * 64 * 1024 + nb * 64, 1024, (bf16_t*)(ws + WS_LRWOUT) + (size_t)j * 1024 * 1024 + (size_t)nb * 64 * 1024 + kb * 64, 1024, tile, tid); continue; }
        r -= 2 * I_SQ;
        { const int mat = r / I_G, q = r % I_G, kb = q / 4, nb = q % 4;
            const int nblk = mat & 3, gate = (mat >> 2) & 1, d = (mat >> 3) & 1, l = mat >> 4;
            const float* src = (gate ? p->lru_w_x : p->lru_w_a) + (size_t)((l * 2 + d) * 4 + nblk) * 65536 + (size_t)kb * 64 * 256 + nb * 64;
            const int n0 = nb * 64, jh = n0 >> 7;
            bf16_t* dst = (bf16_t*)(ws + WS_LRWG) + (size_t)l * 4 * 1024 * 256 + (size_t)nblk * 1024 * 256 + (size_t)((d * 2 + jh) * 256 + gate * 128 + (n0 & 127)) * 256 + kb * 64;
            transpose_tile(src, 256, dst, 256, tile, tid); }
    }
    {
        LAS float* keysL = (LAS float*)lds;
        LAS float* wqL = (LAS float*)(lds + 128 * 132 * 4);
        for (int it = bidL; it < 1024; it += gridDim.x) {
            const int l = it >> 8, hp = (it >> 4) & 15, dt = it & 15;
            const float* kp = p->peer_keys + ((size_t)l * 16 + hp) * 16384;
#pragma unroll
            for (int q = 0; q < 8; ++q) { const int e = (tid + 512 * q) * 4; const f32x4 v = *(const f32x4*)(kp + e); *(LAS f32x4*)(keysL + (e >> 7) * 132 + (e & 127)) = v; }
            const float* wp = p->peer_w_q + (size_t)l * 1024 * 2048 + (size_t)(dt * 64) * 2048 + hp * 128;
#pragma unroll
            for (int q = 0; q < 4; ++q) { const int e = (tid + 512 * q) * 4; const f32x4 v = *(const f32x4*)(wp + (size_t)(e >> 7) * 2048 + (e & 127)); *(LAS f32x4*)(wqL + e) = v; }
            __syncthreads();
            const int key = tid & 127, g = tid >> 7;
            float acc[16];
#pragma unroll
            for (int i = 0; i < 16; ++i) acc[i] = 0.f;
            for (int d4 = 0; d4 < 128; d4 += 4) {
                const f32x4 kv = *(const LAS f32x4*)(keysL + key * 132 + d4);
#pragma unroll
                for (int i = 0; i < 16; ++i) { const f32x4 wv = *(const LAS f32x4*)(wqL + (g * 16 + i) * 128 + d4);
                    acc[i] += kv[0] * wv[0] + kv[1] * wv[1] + kv[2] * wv[2] + kv[3] * wv[3]; }
            }
            bf16_t* op = (bf16_t*)(ws + WS_WQK) + (size_t)l * 2048 * 1024 + (size_t)(hp * 128 + key) * 1024 + dt * 64 + g * 16;
            u32x4 o1, o2; o1.x = cvt_pk_bf16(acc[0], acc[1]); o1.y = cvt_pk_bf16(acc[2], acc[3]); o1.z = cvt_pk_bf16(acc[4], acc[5]); o1.w = cvt_pk_bf16(acc[6], acc[7]);
            o2.x = cvt_pk_bf16(acc[8], acc[9]); o2.y = cvt_pk_bf16(acc[10], acc[11]); o2.z = cvt_pk_bf16(acc[12], acc[13]); o2.w = cvt_pk_bf16(acc[14], acc[15]);
            *(u32x4*)op = o1; *(u32x4*)(op + 8) = o2;
            __syncthreads();
        }
    }
    {
        LAS float* condL = (LAS float*)lds;
        LAS float* red = (LAS float*)(lds + 8192);
        for (int i = tid; i < 2048; i += NTHR) condL[i] = silu_(p->c[i]);
        __syncthreads();
        for (int it = bidL; it < 4 * 48; it += gridDim.x) {
            const int l = it / 48, col0 = (it % 48) * 128;
            const float* wp = p->w_ada + (size_t)l * 1024 * 6144 + col0 + 2 * lane;
            float a00 = 0.f, a01 = 0.f, a10 = 0.f, a11 = 0.f;
#pragma unroll 8
            for (int kk = 0; kk < 128; ++kk) { const int k = wave * 128 + kk; const f32x2 w = *(const f32x2*)(wp + (size_t)k * 6144);
                const float c0 = condL[k], c1 = condL[1024 + k];
                a00 += c0 * w[0]; a01 += c0 * w[1]; a10 += c1 * w[0]; a11 += c1 * w[1]; }
            red[(wave * 2 + 0) * 128 + 2 * lane] = a00; red[(wave * 2 + 0) * 128 + 2 * lane + 1] = a01;
            red[(wave * 2 + 1) * 128 + 2 * lane] = a10; red[(wave * 2 + 1) * 128 + 2 * lane + 1] = a11;
            __syncthreads();
            if (tid < 256) { const int b = tid >> 7, cc = tid & 127; float s = 0.f;
#pragma unroll
                for (int w = 0; w < 8; ++w) s += red[(w * 2 + b) * 128 + cc];
                ((float*)(ws + WS_MOD))[((size_t)l * 2 + b) * 6144 + col0 + cc] = s + p->b_ada[(size_t)l * 6144 + col0 + cc]; }
            __syncthreads();
        }
    }
    {
        const int nw = gridDim.x * NWAVE;
        for (int row0 = bidL * NWAVE + wave; row0 < 2 * 65536; row0 += 4 * nw) {
            f32x4 v[4][4];
#pragma unroll
            for (int rr = 0; rr < 4; ++rr) { const int row = row0 + rr * nw; const int tb = row >> 16, r = row & 65535;
                const float* src = (tb ? p->peer_v : p->peer_u) + (size_t)r * 1024 + 4 * lane;
#pragma unroll
                for (int jx = 0; jx < 4; ++jx) v[rr][jx] = __builtin_nontemporal_load((const f32x4*)(src + 256 * jx)); }
#pragma unroll
            for (int rr = 0; rr < 4; ++rr) { const int row = row0 + rr * nw; const int tb = row >> 16, r = row & 65535;
                float am = 0.f;
#pragma unroll
                for (int jx = 0; jx < 4; ++jx) am = fmaxf(am, fmaxf(fmaxf(fabsf(v[rr][jx][0]), fabsf(v[rr][jx][1])), fmaxf(fabsf(v[rr][jx][2]), fabsf(v[rr][jx][3]))));
                am = wave_max(am);
                const float sc = am > 0.f ? am * (1.f / 6.f) : 1.f, inv = am > 0.f ? 6.f / am : 1.f;
                unsigned char* dst = ws + (tb ? WS_VTAB : WS_UTAB) + (size_t)r * 512 + 2 * lane;
#pragma unroll
                for (int jx = 0; jx < 4; ++jx) { unsigned w = __builtin_amdgcn_cvt_scalef32_pk_fp4_f32(0u, v[rr][jx][0] * inv, v[rr][jx][1] * inv, 1.0f, 0);
                    w = __builtin_amdgcn_cvt_scalef32_pk_fp4_f32(w, v[rr][jx][2] * inv, v[rr][jx][3] * inv, 1.0f, 1);
                    *(unsigned short*)(dst + 128 * jx) = (unsigned short)(w & 0xffffu); }
                if (lane == 0) ((float*)(ws + (tb ? WS_VSC : WS_USC)))[r] = sc; }
        }
    }
}

__device__ __forceinline__ void phase_rms(const float* xin, const float* gain, const float* shift, const float* scale, bf16_t* hout) {
    LAUNDER_IDS
    const int tid = tidL, wave = tid >> 6, lane = tid & 63;
    const int nw = gridDim.x * NWAVE;
    for (int row0 = bidL * NWAVE + wave; row0 < T; row0 += 2 * nw) {
        f32x4 v[2][4]; float ss[2];
#pragma unroll
        for (int rr = 0; rr < 2; ++rr) { const int row = min(row0 + rr * nw, T - 1); const float* xr = xin + (size_t)row * 1024 + lane * 4;
#pragma unroll
            for (int j = 0; j < 4; ++j) v[rr][j] = *(const f32x4*)(xr + j * 256); }
#pragma unroll
        for (int rr = 0; rr < 2; ++rr) { float a = 0.f;
#pragma unroll
            for (int j = 0; j < 4; ++j) a += v[rr][j][0] * v[rr][j][0] + v[rr][j][1] * v[rr][j][1] + v[rr][j][2] * v[rr][j][2] + v[rr][j][3] * v[rr][j][3];
            ss[rr] = a; }
#pragma unroll
        for (int o = 1; o < 64; o <<= 1) { ss[0] += __shfl_xor(ss[0], o); ss[1] += __shfl_xor(ss[1], o); }
#pragma unroll
        for (int rr = 0; rr < 2; ++rr) { const int row = row0 + rr * nw; if (row >= T) continue; const int b = row >> 13;
            const float inv = __builtin_amdgcn_rsqf(ss[rr] * (1.f / 1024.f) + EPS);
#pragma unroll
            for (int j = 0; j < 4; ++j) { const int col = j * 256 + lane * 4;
                const f32x4 g = *(const f32x4*)(gain + col), sh = *(const f32x4*)(shift + b * 6144 + col), sc = *(const f32x4*)(scale + b * 6144 + col);
                const f32x4 y = (v[rr][j] * inv) * g * (1.f + sc) + sh;
                u32x2 o; o.x = cvt_pk_bf16(y[0], y[1]); o.y = cvt_pk_bf16(y[2], y[3]);
                *(u32x2*)(hout + (size_t)row * 1024 + col) = o; } }
    }
}

constexpr int LROW = 136;
__device__ __forceinline__ float hg_lower_bound(const float* hg_lb, int j, int col) {
    if (j == 0) return 0.f;
    const float l0 = hg_lb[col], l1 = hg_lb[1024 + col];
    return fast_rcp(1.f + fast_exp(l0 - l1));
}
__device__ __forceinline__ f32x4 mfma16(bf16x8 a, bf16x8 b, f32x4 c) { return __builtin_amdgcn_mfma_f32_16x16x32_bf16(a, b, c, 0, 0, 0); }

__device__ __forceinline__ void load_v_regs(const bf16_t* proj, u32x4 (&vr)[4], int t0, int dir, int h, int tid) {
#pragma unroll
    for (int it = 0; it < 4; ++it) { const int idx = tid + 512 * it, tau = idx & 127, cv = idx >> 7;
        const int tok = dir ? t0 + 127 - tau : t0 + tau;
        vr[it] = *(const u32x4*)(proj + (size_t)tok * 5120 + 3072 + h * 128 + cv * 8); }
}
__device__ __forceinline__ void store_vt(LAS bf16_t* VT, const u32x4 (&vr)[4], int tid) {
#pragma unroll
    for (int it = 0; it < 4; ++it) { const int idx = tid + 512 * it, tau = idx & 127, cv = idx >> 7; const u32x4 v = vr[it];
        LAS bf16_t* d = VT + (cv * 8) * LROW + tau;
        d[0 * LROW] = (bf16_t)(v.x & 0xffff); d[1 * LROW] = (bf16_t)(v.x >> 16); d[2 * LROW] = (bf16_t)(v.y & 0xffff); d[3 * LROW] = (bf16_t)(v.y >> 16);
        d[4 * LROW] = (bf16_t)(v.z & 0xffff); d[5 * LROW] = (bf16_t)(v.z >> 16); d[6 * LROW] = (bf16_t)(v.w & 0xffff); d[7 * LROW] = (bf16_t)(v.w >> 16); }
}
__device__ __forceinline__ void load_tile_regs(const bf16_t* proj, u32x4 (&r)[4], int t0, int dir, int col0, int tid) {
#pragma unroll
    for (int it = 0; it < 4; ++it) { const int idx = tid + 512 * it, tau = idx >> 4, c16 = idx & 15;
        const int tok = dir ? t0 + 127 - tau : t0 + tau;
        r[it] = *(const u32x4*)(proj + (size_t)tok * 5120 + col0 + c16 * 8); }
}
__device__ __forceinline__ void store_tile(LAS bf16_t* TL, const u32x4 (&r)[4], int tid) {
#pragma unroll
    for (int it = 0; it < 4; ++it) { const int idx = tid + 512 * it, tau = idx >> 4, c16 = idx & 15; *(LAS u32x4*)(TL + tau * LROW + c16 * 8) = r[it]; }
}

__device__ __forceinline__ void hg_pass_a(KP p, LAS unsigned char* lds, int j) {
    LAUNDER_IDS
    const bf16_t* proj = (const bf16_t*)(p->ws + WS_PROJ);
    float* KV = (float*)(p->ws + WS_KV); float* DEC = (float*)(p->ws + WS_DEC);
    LAS bf16_t* VT = (LAS bf16_t*)lds; LAS bf16_t* KT = (LAS bf16_t*)(lds + 34816); LAS float* TOT = (LAS float*)(lds + 69632); LAS bf16_t* ZT = (LAS bf16_t*)(lds + 71680);
    for (int u = bidL; u < 2048; u += gridDim.x) {
        int tid = tidL; asm volatile("" : "+v"(tid));
        const int wave = tid >> 6, lane = tid & 63;
        const int seq = u >> 6, c = u & 63, dir = seq & 1, h = (seq >> 1) & 7, b = seq >> 4;
        const int t0 = b * SEQ + c * 128;
        const int dk = tid & 127, g = tid >> 7;
        const float lb = hg_lower_bound(p->hg_lb, j, h * 128 + dk);
        float lcs[32], kks[32]; float lc = 0.f;
        { u32x4 zr[4], vr[4];
            load_tile_regs(proj, zr, t0, dir, 1024 * (1 + dir) + h * 128, tid); load_v_regs(proj, vr, t0, dir, h, tid);
            store_tile(ZT, zr, tid); store_vt(VT, vr, tid); }
        __syncthreads();
#pragma unroll
        for (int q = 0; q < 32; ++q) { const int tau = 32 * g + q;
            const float z = bf2f(ZT[tau * LROW + dk]);
            const float f = lb + (1.f - lb) * sigmoidf_(z);
            lc += fast_log(f); lcs[q] = lc; kks[q] = 1.f - f; }
        TOT[g * 128 + dk] = lc;
        __syncthreads();
        float rg = 0.f, total = 0.f;
#pragma unroll
        for (int gg = 0; gg < 4; ++gg) { const float tv = TOT[gg * 128 + dk]; total += tv; if (gg < g) rg += tv; }
        const float base = total - rg;
#pragma unroll
        for (int q8 = 0; q8 < 4; ++q8) { unsigned w[4];
#pragma unroll
            for (int e = 0; e < 4; ++e) { const int q = q8 * 8 + e * 2;
                w[e] = cvt_pk_bf16(kks[q] * fast_exp(base - lcs[q]), kks[q + 1] * fast_exp(base - lcs[q + 1])); }
            u32x4 o; o.x = w[0]; o.y = w[1]; o.z = w[2]; o.w = w[3];
            *(LAS u32x4*)(KT + dk * LROW + 32 * g + q8 * 8) = o; }
        if (g == 0) DEC[(size_t)u * 128 + dk] = fast_exp(total);
        __syncthreads();
        f32x4 acc[2][4];
#pragma unroll
        for (int a = 0; a < 2; ++a)
#pragma unroll
            for (int bb = 0; bb < 4; ++bb) acc[a][bb] = (f32x4){0.f, 0.f, 0.f, 0.f};
        const int l15 = lane & 15, lq = lane >> 4;
#pragma unroll
        for (int ks = 0; ks < 4; ++ks) {
            bf16x8 af[2], bfr[4];
#pragma unroll
            for (int a = 0; a < 2; ++a) af[a] = *(const LAS bf16x8*)(VT + (((wave & 3) * 2 + a) * 16 + l15) * LROW + ks * 32 + lq * 8);
#pragma unroll
            for (int bb = 0; bb < 4; ++bb) bfr[bb] = *(const LAS bf16x8*)(KT + (((wave >> 2) * 4 + bb) * 16 + l15) * LROW + ks * 32 + lq * 8);
#pragma unroll
            for (int a = 0; a < 2; ++a)
#pragma unroll
                for (int bb = 0; bb < 4; ++bb) acc[a][bb] = mfma16(af[a], bfr[bb], acc[a][bb]);
        }
        float* kvp = KV + (size_t)u * 16384;
#pragma unroll
        for (int a = 0; a < 2; ++a)
#pragma unroll
            for (int bb = 0; bb < 4; ++bb)
#pragma unroll
                for (int r = 0; r < 4; ++r) kvp[(((wave & 3) * 2 + a) * 16 + lq * 4 + r) * 128 + ((wave >> 2) * 4 + bb) * 16 + l15] = acc[a][bb][r];
        __syncthreads();
    }
}

__device__ __forceinline__ void hg_pass_b(KP p) {
    LAUNDER_IDS
    const float* KV = (const float*)(p->ws + WS_KV); const float* DEC = (const float*)(p->ws + WS_DEC);
    bf16_t* SIN = (bf16_t*)(p->ws + WS_SIN);
    for (int e = bidL * NTHR + tidL; e < 131072; e += gridDim.x * NTHR) {
    const int seq = e >> 12, i4 = e & 4095, dir = seq & 1, dk = (i4 * 4) & 127;
    f32x4 S = {0.f, 0.f, 0.f, 0.f};
#pragma unroll 16
    for (int step = 0; step < 64; ++step) {
        const int c = dir ? 63 - step : step; const size_t u = (size_t)seq * 64 + c;
        const f32x4 kv = *(const f32x4*)(KV + u * 16384 + i4 * 4); const f32x4 dc = *(const f32x4*)(DEC + u * 128 + dk);
        u32x2 o; o.x = cvt_pk_bf16(S[0], S[1]); o.y = cvt_pk_bf16(S[2], S[3]);
        *(u32x2*)(SIN + u * 16384 + i4 * 4) = o;
        S = dc * S + kv;
    }
    }
}

__device__ __forceinline__ void hg_pass_c(KP p, LAS unsigned char* lds, int j) {
    LAUNDER_IDS
    const bf16_t* proj = (const bf16_t*)(p->ws + WS_PROJ);
    const bf16_t* SIN = (const bf16_t*)(p->ws + WS_SIN);
    bf16_t* OB = (bf16_t*)(p->ws + WS_OB);
    LAS bf16_t* QT = (LAS bf16_t*)lds; LAS bf16_t* QI = (LAS bf16_t*)(lds + 34816); LAS bf16_t* KT = (LAS bf16_t*)(lds + 69632);
    LAS bf16_t* VT = (LAS bf16_t*)(lds + 104448); LAS bf16_t* PI = (LAS bf16_t*)(lds + 139264); LAS float* TOT = (LAS float*)(lds + 147968);
    LAS float* OSUM = (LAS float*)(lds + 69632);
    for (int u = bidL; u < 1024; u += gridDim.x) {
        int tid = tidL; asm volatile("" : "+v"(tid));
        const int wave = tid >> 6, lane = tid & 63, l15 = lane & 15, lq = lane >> 4;
        const int c = u & 63, h = (u >> 6) & 7, b = u >> 9;
        const int t0 = b * SEQ + c * 128;
        const int dk = tid & 127, g = tid >> 7;
        const float lb = hg_lower_bound(p->hg_lb, j, h * 128 + dk);
        const int tt = wave & 1, dvt0 = (wave >> 1) * 2;
        f32x4 oacc[2][4][2];
#pragma unroll
        for (int dir = 0; dir < 2; ++dir) {
            const size_t su = ((size_t)((b * 8 + h) * 2 + dir) * 64 + c);
            unsigned k0p[16]; float lc = 0.f; float kprev = 0.f;
            u32x4 vr[4];
            { u32x4 zr[4], qr[4];
                load_tile_regs(proj, zr, t0, dir, 1024 * (1 + dir) + h * 128, tid); load_tile_regs(proj, qr, t0, dir, h * 128, tid); load_v_regs(proj, vr, t0, dir, h, tid);
                __syncthreads();
                store_tile(KT, zr, tid); store_tile(VT, qr, tid); }
            __syncthreads();
#pragma unroll
            for (int q = 0; q < 32; ++q) { const int tau = 32 * g + q;
                const float z = bf2f(KT[tau * LROW + dk]), qv = bf2f(VT[tau * LROW + dk]);
                const float f = lb + (1.f - lb) * sigmoidf_(z);
                lc += fast_log(f);
                const float el = fast_exp(fmaxf(lc, -80.f));
                QT[tau * LROW + dk] = f2bf(qv * el);
                const float kcur = (1.f - f) * fast_rcp(el);
                if (q & 1) k0p[q >> 1] = cvt_pk_bf16(kprev, kcur); else kprev = kcur; }
            TOT[g * 128 + dk] = lc;
            __syncthreads();
            float r[4]; { float run = 0.f;
#pragma unroll
                for (int gg = 0; gg < 4; ++gg) { r[gg] = run; run += TOT[gg * 128 + dk]; } }
            float rg = 0.f;
#pragma unroll
            for (int gg = 0; gg < 4; ++gg) if (gg == g) rg = r[gg];
            { const float eg = fast_exp(rg);
#pragma unroll
                for (int q = 0; q < 32; ++q) QI[(32 * g + q) * LROW + dk] = f2bf(bf2f(QT[(32 * g + q) * LROW + dk]) * eg); }
            store_vt(VT, vr, tid);
            bf16x8 sfr[2][4];
#pragma unroll
            for (int n = 0; n < 2; ++n)
#pragma unroll
                for (int ks = 0; ks < 4; ++ks) sfr[n][ks] = *(const bf16x8*)(SIN + su * 16384 + (size_t)((dvt0 + n) * 16 + l15) * 128 + ks * 32 + lq * 8);
#pragma unroll
            for (int i = 0; i < 4; ++i) {
                if (g <= i) { const float e = fast_exp(r[i] - rg);
#pragma unroll
                    for (int q = 0; q < 32; ++q) KT[(32 * g + q) * LROW + dk] = f2bf(((q & 1) ? bfhi(k0p[q >> 1]) : bflo(k0p[q >> 1])) * e); }
                __syncthreads();
                for (int tl = wave; tl < 4 * (i + 1); tl += 8) { const int sm = tl >> 1, tn = tl & 1;
                    f32x4 a4 = {0.f, 0.f, 0.f, 0.f};
#pragma unroll
                    for (int ks = 0; ks < 4; ++ks) { const bf16x8 af = *(const LAS bf16x8*)(KT + (sm * 16 + l15) * LROW + ks * 32 + lq * 8);
                        const bf16x8 bq = *(const LAS bf16x8*)(QT + (32 * i + tn * 16 + l15) * LROW + ks * 32 + lq * 8);
                        a4 = mfma16(af, bq, a4); }
                    const int tloc = tn * 16 + l15, s0 = sm * 16 + lq * 4, tg = 32 * i + tloc;
                    u32x2 o; o.x = cvt_pk_bf16(s0 + 0 <= tg ? a4[0] : 0.f, s0 + 1 <= tg ? a4[1] : 0.f); o.y = cvt_pk_bf16(s0 + 2 <= tg ? a4[2] : 0.f, s0 + 3 <= tg ? a4[3] : 0.f);
                    *(LAS u32x2*)(PI + tloc * LROW + s0) = o; }
                __syncthreads();
                f32x4 a0 = {0.f, 0.f, 0.f, 0.f}, a1 = {0.f, 0.f, 0.f, 0.f};
                for (int ks = 0; ks <= i; ++ks) { const bf16x8 af = *(const LAS bf16x8*)(PI + (tt * 16 + l15) * LROW + ks * 32 + lq * 8);
                    const bf16x8 b0 = *(const LAS bf16x8*)(VT + ((dvt0 + 0) * 16 + l15) * LROW + ks * 32 + lq * 8);
                    const bf16x8 b1 = *(const LAS bf16x8*)(VT + ((dvt0 + 1) * 16 + l15) * LROW + ks * 32 + lq * 8);
                    a0 = mfma16(af, b0, a0); a1 = mfma16(af, b1, a1); }
#pragma unroll
                for (int ks = 0; ks < 4; ++ks) { const bf16x8 af = *(const LAS bf16x8*)(QI + (32 * i + tt * 16 + l15) * LROW + ks * 32 + lq * 8);
                    a0 = mfma16(af, sfr[0][ks], a0); a1 = mfma16(af, sfr[1][ks], a1); }
                oacc[dir][i][0] = a0; oacc[dir][i][1] = a1;
            }
        }
        __syncthreads();
#pragma unroll
        for (int i = 0; i < 4; ++i)
#pragma unroll
            for (int n = 0; n < 2; ++n)
#pragma unroll
                for (int rr = 0; rr < 4; ++rr) OSUM[(32 * i + tt * 16 + lq * 4 + rr) * 132 + (dvt0 + n) * 16 + l15] = oacc[0][i][n][rr];
        __syncthreads();
#pragma unroll
        for (int i = 0; i < 4; ++i)
#pragma unroll
            for (int n = 0; n < 2; ++n)
#pragma unroll
                for (int rr = 0; rr < 4; ++rr) OSUM[(127 - (32 * i + tt * 16 + lq * 4 + rr)) * 132 + (dvt0 + n) * 16 + l15] += oacc[1][i][n][rr];
        __syncthreads();
        { const int row = tid >> 2, part = tid & 3; const int tok = t0 + row;
            float ov[32]; float ss = 0.f;
#pragma unroll
            for (int q = 0; q < 8; ++q) { const f32x4 v = *(const LAS f32x4*)(OSUM + row * 132 + part * 32 + q * 4);
                ov[q * 4 + 0] = v[0]; ov[q * 4 + 1] = v[1]; ov[q * 4 + 2] = v[2]; ov[q * 4 + 3] = v[3]; ss += v[0] * v[0] + v[1] * v[1] + v[2] * v[2] + v[3] * v[3]; }
            ss += __shfl_xor(ss, 1); ss += __shfl_xor(ss, 2);
            const float inv = __builtin_amdgcn_rsqf(ss * (1.f / 128.f) + EPS);
            const int col = h * 128 + part * 32;
            const bf16_t* gp = proj + (size_t)tok * 5120 + 4096 + col; const float* ng = p->hg_norm_g + j * 1024 + col;
#pragma unroll
            for (int q = 0; q < 4; ++q) { const u32x4 gr = *(const u32x4*)(gp + q * 8);
                const float gv[8] = {bflo(gr.x), bfhi(gr.x), bflo(gr.y), bfhi(gr.y), bflo(gr.z), bfhi(gr.z), bflo(gr.w), bfhi(gr.w)};
                float y[8];
#pragma unroll
                for (int e = 0; e < 8; ++e) y[e] = ov[q * 8 + e] * inv * ng[q * 8 + e] * silu_(gv[e]);
                u32x4 o; o.x = cvt_pk_bf16(y[0], y[1]); o.y = cvt_pk_bf16(y[2], y[3]); o.z = cvt_pk_bf16(y[4], y[5]); o.w = cvt_pk_bf16(y[6], y[7]);
                *(u32x4*)(OB + (size_t)tok * 1024 + col + q * 8) = o; }
        }
        __syncthreads();
    }
}

__device__ __forceinline__ void lru_conv(KP p, int l) {
    LAUNDER_IDS
    const bf16_t* XB = (const bf16_t*)(p->ws + WS_XB); bf16_t* XC = (bf16_t*)(p->ws + WS_XC);
    const float* cw = p->lru_conv_w + (size_t)l * 4 * 1024; const float* cb = p->lru_conv_b + (size_t)l * 1024;
    const int gs = gridDim.x * NTHR;
    for (int it = bidL * NTHR + tidL; it < T * 128; it += gs) {
        const int tok = it >> 7, c8 = (it & 127) * 8, s = tok & (SEQ - 1);
        float acc[8];
        { const f32x4 b0 = *(const f32x4*)(cb + c8), b1 = *(const f32x4*)(cb + c8 + 4);
            acc[0] = b0[0]; acc[1] = b0[1]; acc[2] = b0[2]; acc[3] = b0[3]; acc[4] = b1[0]; acc[5] = b1[1]; acc[6] = b1[2]; acc[7] = b1[3]; }
#pragma unroll
        for (int jj = 0; jj < 4; ++jj) { const int ts = s + jj - 2;
            if (ts >= 0 && ts < SEQ) { const u32x4 xr = *(const u32x4*)(XB + (size_t)(tok + jj - 2) * 1024 + c8);
                const f32x4 w0 = *(const f32x4*)(cw + jj * 1024 + c8), w1 = *(const f32x4*)(cw + jj * 1024 + c8 + 4);
                acc[0] += bflo(xr.x) * w0[0]; acc[1] += bfhi(xr.x) * w0[1]; acc[2] += bflo(xr.y) * w0[2]; acc[3] += bfhi(xr.y) * w0[3];
                acc[4] += bflo(xr.z) * w1[0]; acc[5] += bfhi(xr.z) * w1[1]; acc[6] += bflo(xr.w) * w1[2]; acc[7] += bfhi(xr.w) * w1[3]; } }
        u32x4 o; o.x = cvt_pk_bf16(acc[0], acc[1]); o.y = cvt_pk_bf16(acc[2], acc[3]); o.z = cvt_pk_bf16(acc[4], acc[5]); o.w = cvt_pk_bf16(acc[6], acc[7]);
        *(u32x4*)(XC + (size_t)tok * 1024 + c8) = o;
    }
}
__device__ __forceinline__ void lru_scan1(KP p, LAS unsigned char* lds) {
    LAUNDER_IDS
    const bf16_t* LOGA = (const bf16_t*)(p->ws + WS_LOGA); const bf16_t* BT = (const bf16_t*)(p->ws + WS_BTERM);
    float* CP = (float*)(p->ws + WS_CP); float* CH = (float*)(p->ws + WS_CH);
    LAS float* XP = (LAS float*)lds; LAS float* XH = (LAS float*)(lds + 16384);
    for (int u = bidL; u < 1024; u += gridDim.x) {
        int tid = tidL; asm volatile("" : "+v"(tid));
        const int ts = tid >> 7, c8 = (tid & 127) * 8;
        const int chunk = u & 255, dir = (u >> 8) & 1, b = u >> 9;
        const size_t base = ((size_t)dir * T + b * SEQ + chunk * 32) * 1024 + c8;
        u32x4 lw[8], bw[8];
#pragma unroll
        for (int q = 0; q < 8; ++q) { const int t = dir ? 31 - (ts * 8 + q) : ts * 8 + q; lw[q] = *(const u32x4*)(LOGA + base + (size_t)t * 1024); bw[q] = *(const u32x4*)(BT + base + (size_t)t * 1024); }
        float h[8], sl[8];
#pragma unroll
        for (int i = 0; i < 8; ++i) { h[i] = 0.f; sl[i] = 0.f; }
#pragma unroll
        for (int q = 0; q < 8; ++q) {
#pragma unroll
            for (int w = 0; w < 4; ++w) { const float l0 = bflo(lw[q][w]), l1 = bfhi(lw[q][w]);
                h[2 * w] = fast_exp(l0) * h[2 * w] + bflo(bw[q][w]); h[2 * w + 1] = fast_exp(l1) * h[2 * w + 1] + bfhi(bw[q][w]); sl[2 * w] += l0; sl[2 * w + 1] += l1; } }
        *(LAS f32x4*)(XP + ts * 1024 + c8) = (f32x4){fast_exp(sl[0]), fast_exp(sl[1]), fast_exp(sl[2]), fast_exp(sl[3])};
        *(LAS f32x4*)(XP + ts * 1024 + c8 + 4) = (f32x4){fast_exp(sl[4]), fast_exp(sl[5]), fast_exp(sl[6]), fast_exp(sl[7])};
        *(LAS f32x4*)(XH + ts * 1024 + c8) = (f32x4){h[0], h[1], h[2], h[3]}; *(LAS f32x4*)(XH + ts * 1024 + c8 + 4) = (f32x4){h[4], h[5], h[6], h[7]};
        __syncthreads();
        { const int ch = 2 * tid; float P0 = 1.f, P1 = 1.f, H0 = 0.f, H1 = 0.f;
#pragma unroll
            for (int s2 = 0; s2 < 4; ++s2) { const f32x2 pp = *(const LAS f32x2*)(XP + s2 * 1024 + ch), hh = *(const LAS f32x2*)(XH + s2 * 1024 + ch);
                H0 = pp[0] * H0 + hh[0]; H1 = pp[1] * H1 + hh[1]; P0 *= pp[0]; P1 *= pp[1]; }
            const size_t o = ((size_t)(b * 2 + dir) * 256 + chunk) * 1024 + ch;
            *(f32x2*)(CP + o) = (f32x2){P0, P1}; *(f32x2*)(CH + o) = (f32x2){H0, H1}; }
        __syncthreads();
    }
}
__device__ __forceinline__ void lru_scan2(KP p) {
    LAUNDER_IDS
    const float* CP = (const float*)(p->ws + WS_CP); const float* CH = (const float*)(p->ws + WS_CH); float* HIN = (float*)(p->ws + WS_HIN);
    const int wave = tidL >> 6, lane = tidL & 63;
    for (int item = bidL * NWAVE + wave; item < 4096; item += gridDim.x * NWAVE) {
        const int ch = item & 1023, bd = item >> 10, dir = bd & 1;
        float pp[4], hh[4]; float Pl = 1.f, Hl = 0.f;
#pragma unroll
        for (int q = 0; q < 4; ++q) { const int ci = 4 * lane + q, chunk = dir ? 255 - ci : ci; const size_t o = ((size_t)bd * 256 + chunk) * 1024 + ch;
            pp[q] = CP[o]; hh[q] = CH[o]; Hl = pp[q] * Hl + hh[q]; Pl *= pp[q]; }
#pragma unroll
        for (int off = 1; off < 64; off <<= 1) { const float Pp = __shfl_up(Pl, off), Hp = __shfl_up(Hl, off);
            if (lane >= off) { Hl = Pl * Hp + Hl; Pl = Pl * Pp; } }
        float carry = __shfl_up(Hl, 1); if (lane == 0) carry = 0.f;
#pragma unroll
        for (int q = 0; q < 4; ++q) { const int ci = 4 * lane + q, chunk = dir ? 255 - ci : ci; const size_t o = ((size_t)bd * 256 + chunk) * 1024 + ch;
            HIN[o] = carry; carry = pp[q] * carry + hh[q]; }
    }
}
__device__ __forceinline__ void lru_scan3(KP p, LAS unsigned char* lds) {
    LAUNDER_IDS
    const bf16_t* LOGA = (const bf16_t*)(p->ws + WS_LOGA); const bf16_t* BT = (const bf16_t*)(p->ws + WS_BTERM); const bf16_t* YG = (const bf16_t*)(p->ws + WS_YG);
    const float* HIN = (const float*)(p->ws + WS_HIN); bf16_t* OB = (bf16_t*)(p->ws + WS_OB);
    LAS float* XP = (LAS float*)lds; LAS float* XH = (LAS float*)(lds + 16384);
    for (int u = bidL; u < 512; u += gridDim.x) {
        int tid = tidL; asm volatile("" : "+v"(tid));
        const int ts = tid >> 7, c8 = (tid & 127) * 8;
        const int chunk = u & 255, b = u >> 8;
        const size_t base = ((size_t)b * SEQ + chunk * 32 + ts * 8) * 1024 + c8;
        unsigned hsp[8][4];
#pragma unroll
        for (int dir = 0; dir < 2; ++dir) {
            u32x4 lw[8], bw[8];
#pragma unroll
            for (int q = 0; q < 8; ++q) { lw[q] = *(const u32x4*)(LOGA + (size_t)dir * T * 1024 + base + (size_t)q * 1024); bw[q] = *(const u32x4*)(BT + (size_t)dir * T * 1024 + base + (size_t)q * 1024); }
            const f32x4 hi0 = *(const f32x4*)(HIN + ((size_t)(b * 2 + dir) * 256 + chunk) * 1024 + c8), hi1 = *(const f32x4*)(HIN + ((size_t)(b * 2 + dir) * 256 + chunk) * 1024 + c8 + 4);
            float h[8], sl[8];
#pragma unroll
            for (int i = 0; i < 8; ++i) { h[i] = 0.f; sl[i] = 0.f; }
#pragma unroll
            for (int qq = 0; qq < 8; ++qq) { const int q = dir ? 7 - qq : qq;
#pragma unroll
                for (int w = 0; w < 4; ++w) { const float l0 = bflo(lw[q][w]), l1 = bfhi(lw[q][w]);
                    h[2 * w] = fast_exp(l0) * h[2 * w] + bflo(bw[q][w]); h[2 * w + 1] = fast_exp(l1) * h[2 * w + 1] + bfhi(bw[q][w]); sl[2 * w] += l0; sl[2 * w + 1] += l1; } }
            __syncthreads();
            *(LAS f32x4*)(XP + ts * 1024 + c8) = (f32x4){fast_exp(sl[0]), fast_exp(sl[1]), fast_exp(sl[2]), fast_exp(sl[3])};
            *(LAS f32x4*)(XP + ts * 1024 + c8 + 4) = (f32x4){fast_exp(sl[4]), fast_exp(sl[5]), fast_exp(sl[6]), fast_exp(sl[7])};
            *(LAS f32x4*)(XH + ts * 1024 + c8) = (f32x4){h[0], h[1], h[2], h[3]}; *(LAS f32x4*)(XH + ts * 1024 + c8 + 4) = (f32x4){h[4], h[5], h[6], h[7]};
            __syncthreads();
            h[0] = hi0[0]; h[1] = hi0[1]; h[2] = hi0[2]; h[3] = hi0[3]; h[4] = hi1[0]; h[5] = hi1[1]; h[6] = hi1[2]; h[7] = hi1[3];
#pragma unroll
            for (int s3 = 0; s3 < 3; ++s3) { const int sr = dir ? 3 - s3 : s3; const bool use = dir ? (sr > ts) : (sr < ts);
                const f32x4 p0 = *(const LAS f32x4*)(XP + sr * 1024 + c8), p1 = *(const LAS f32x4*)(XP + sr * 1024 + c8 + 4), q0 = *(const LAS f32x4*)(XH + sr * 1024 + c8), q1 = *(const LAS f32x4*)(XH + sr * 1024 + c8 + 4);
                if (use) { h[0] = p0[0] * h[0] + q0[0]; h[1] = p0[1] * h[1] + q0[1]; h[2] = p0[2] * h[2] + q0[2]; h[3] = p0[3] * h[3] + q0[3];
                    h[4] = p1[0] * h[4] + q1[0]; h[5] = p1[1] * h[5] + q1[1]; h[6] = p1[2] * h[6] + q1[2]; h[7] = p1[3] * h[7] + q1[3]; } }
#pragma unroll
            for (int qq = 0; qq < 8; ++qq) { const int q = dir ? 7 - qq : qq;
                u32x4 yw; if (dir) yw = *(const u32x4*)(YG + base + (size_t)q * 1024);
                unsigned ow[4];
#pragma unroll
                for (int w = 0; w < 4; ++w) { h[2 * w] = fast_exp(bflo(lw[q][w])) * h[2 * w] + bflo(bw[q][w]); h[2 * w + 1] = fast_exp(bfhi(lw[q][w])) * h[2 * w + 1] + bfhi(bw[q][w]);
                    if (dir == 0) hsp[q][w] = cvt_pk_bf16(h[2 * w], h[2 * w + 1]);
                    else ow[w] = cvt_pk_bf16((bflo(hsp[q][w]) + h[2 * w]) * bflo(yw[w]), (bfhi(hsp[q][w]) + h[2 * w + 1]) * bfhi(yw[w])); }
                if (dir) *(u32x4*)(OB + base + (size_t)q * 1024) = (u32x4){ow[0], ow[1], ow[2], ow[3]}; }
        }
        __syncthreads();
    }
}

__device__ const unsigned char STAIR[64] = {
    0x00, 0x01, 0x02, 0x03, 0x04, 0x05, 0x06, 0x07, 0x08, 0x09, 0x0a, 0x0b, 0x0c, 0x0d, 0x0e, 0x0f,
    0x10, 0x11, 0x12, 0x13, 0x14, 0x15, 0x16, 0x17, 0x20, 0x21, 0x22, 0x23, 0x24, 0x30, 0x31, 0x32,
    0x33, 0x40, 0x41, 0x42, 0x50, 0x51, 0x60, 0x61, 0x70, 0x71, 0x80, 0x90, 0xa0, 0xb0, 0xc0, 0xd0,
    0xe0, 0xf0, 0, 0, 0, 0, 0, 0, 0, 0, 0, 0, 0, 0, 0, 0};
__device__ __forceinline__ unsigned mono_key(float f) { const unsigned b = __float_as_uint(f); return b ^ ((b >> 31) ? 0xffffffffu : 0x80000000u); }

__device__ __forceinline__ float inv_mono(unsigned k) { return __uint_as_float(k ^ ((k >> 31) ? 0x80000000u : 0xffffffffu)); }
#define TK_CE(A, B) do { const unsigned hi_ = max(A, B), lo_ = min(A, B); A = hi_; B = lo_; } while (0)
#define TK_SORT16(N) do { _Pragma("unroll") for (int k_ = 2; k_ <= 16; k_ <<= 1) { _Pragma("unroll") for (int j_ = k_ >> 1; j_ > 0; j_ >>= 1) { _Pragma("unroll") for (int i_ = 0; i_ < 16; ++i_) { \
    const int l_ = i_ ^ j_; if (l_ > i_) { if ((i_ & k_) == 0) TK_CE(N[i_], N[l_]); else TK_CE(N[l_], N[i_]); } } } } } while (0)
#define TK_MERGE16(L, N) do { _Pragma("unroll") for (int i_ = 0; i_ < 16; ++i_) L[i_] = max(L[i_], N[15 - i_]); \
    _Pragma("unroll") for (int j_ = 8; j_ > 0; j_ >>= 1) { _Pragma("unroll") for (int i_ = 0; i_ < 16; ++i_) { const int l_ = i_ ^ j_; if (l_ > i_) TK_CE(L[i_], L[l_]); } } } while (0)
#define TK_INSERT(L, x) do { _Pragma("unroll") for (int q_ = 0; q_ < 16; ++q_) { const unsigned hi_ = max(L[q_], x); x = min(L[q_], x); L[q_] = hi_; } } while (0)
__device__ __forceinline__ void peer_topk(KP p, LAS unsigned char* lds) {
    LAUNDER_IDS
    (void)bidL;
    const int tid = tidL, wave = tid >> 6, lane = tid & 63;
    const float* SCT = (const float*)(p->ws + WS_SCORES);
    int* TOPI = (int*)(p->ws + WS_TOPI); float* TOPG = (float*)(p->ws + WS_TOPG);
    LAS unsigned char* IX = lds + wave * 2048 + lane * 32;
    for (int item = bidL * NWAVE + wave; item < 2048; item += gridDim.x * NWAVE) {
        const int tg = item >> 3, hd = item & 7, tok = tg * 64 + lane;
        float V[2][16];
#pragma unroll
        for (int half = 0; half < 2; ++half) {
            unsigned L[16];
#pragma unroll
            for (int q = 0; q < 16; ++q) L[q] = 0u;
            const float* sc = SCT + (size_t)(hd * 256 + half * 128) * T + tok;
            float cur[16], nxt[16];
#pragma unroll
            for (int i = 0; i < 16; ++i) cur[i] = sc[(size_t)i * T];
#pragma unroll 1
            for (int kb = 0; kb < 8; ++kb) {
                const int kn = kb < 7 ? kb + 1 : kb;
#pragma unroll
                for (int i = 0; i < 16; ++i) nxt[i] = sc[(size_t)(kn * 16 + i) * T];
                unsigned NK[16];
#pragma unroll
                for (int i = 0; i < 16; ++i) NK[i] = (mono_key(cur[i]) & ~0x7fu) | (unsigned)(kb * 16 + i);
                TK_SORT16(NK); TK_MERGE16(L, NK);
#pragma unroll
                for (int i = 0; i < 16; ++i) cur[i] = nxt[i];
            }
            u32x4 w0, w1;
            w0.x = (L[0] & 0x7f) | ((L[1] & 0x7f) << 8) | ((L[2] & 0x7f) << 16) | ((L[3] & 0x7f) << 24); w0.y = (L[4] & 0x7f) | ((L[5] & 0x7f) << 8) | ((L[6] & 0x7f) << 16) | ((L[7] & 0x7f) << 24);
            w0.z = (L[8] & 0x7f) | ((L[9] & 0x7f) << 8) | ((L[10] & 0x7f) << 16) | ((L[11] & 0x7f) << 24); w0.w = (L[12] & 0x7f) | ((L[13] & 0x7f) << 8) | ((L[14] & 0x7f) << 16) | ((L[15] & 0x7f) << 24);
            *(LAS u32x4*)(IX + half * 16) = w0;
#pragma unroll
            for (int q = 0; q < 16; ++q) V[half][q] = inv_mono(L[q]);
        }
        unsigned C[16];
#pragma unroll
        for (int q = 0; q < 16; ++q) C[q] = 0u;
#pragma unroll
        for (int i = 0; i < 16; ++i)
#pragma unroll
            for (int jj = 0; jj < 16; ++jj) if ((i + 1) * (jj + 1) <= 16) { unsigned x = (mono_key(V[0][i] + V[1][jj]) & ~0xffu) | (unsigned)(i * 16 + jj); TK_INSERT(C, x); }
        asm volatile("s_waitcnt lgkmcnt(0)" ::: "memory");
        const float s0 = inv_mono(C[0] & ~0xffu);
        float e[16]; float sum = 0.f; int ids[16];
#pragma unroll
        for (int q = 0; q < 16; ++q) { e[q] = fast_exp(inv_mono(C[q] & ~0xffu) - s0); sum += e[q];
            const unsigned code = C[q] & 0xffu; ids[q] = (int)IX[code >> 4] * 128 + (int)IX[16 + (code & 15u)]; }
        const float rs = fast_rcp(sum);
        int* ip = TOPI + (size_t)tok * 128 + hd * 16; float* gp = TOPG + (size_t)tok * 128 + hd * 16;
#pragma unroll
        for (int q = 0; q < 4; ++q) { *(u32x4*)(ip + 4 * q) = (u32x4){(unsigned)ids[4 * q], (unsigned)ids[4 * q + 1], (unsigned)ids[4 * q + 2], (unsigned)ids[4 * q + 3]};
            *(f32x4*)(gp + 4 * q) = (f32x4){e[4 * q] * rs, e[4 * q + 1] * rs, e[4 * q + 2] * rs, e[4 * q + 3] * rs}; }
        asm volatile("s_waitcnt lgkmcnt(0)" ::: "memory");
    }
}

__device__ __forceinline__ void peer_gather(KP p, int l, bool dry) {
    LAUNDER_IDS
    const int wave = tidL >> 6, lane = tidL & 63;
    const bf16_t* HB = (const bf16_t*)(p->ws + WS_HBUF); bf16_t* HBW = (bf16_t*)(p->ws + WS_HBUF);
    const int* TOPI = (const int*)(p->ws + WS_TOPI); const float* TOPG = (const float*)(p->ws + WS_TOPG);
    const unsigned char* U8 = p->ws + WS_UTAB + (size_t)l * 16384 * 512 + 8 * lane; const unsigned char* V8 = p->ws + WS_VTAB + (size_t)l * 16384 * 512 + 8 * lane;
    const float* USC = (const float*)(p->ws + WS_USC) + l * 16384; const float* VSC = (const float*)(p->ws + WS_VSC) + l * 16384;
    float* XRES = (float*)(p->ws + WS_XRES); const float* MOD = (const float*)(p->ws + WS_MOD);
    for (int tok = bidL * NWAVE + wave; tok < T; tok += gridDim.x * NWAVE) {
        const int b = tok >> 13;
        f32x2 hv2[8];
        { const u32x4 h0 = *(const u32x4*)(HB + (size_t)tok * 1024 + 16 * lane), h1 = *(const u32x4*)(HB + (size_t)tok * 1024 + 16 * lane + 8);
            hv2[0] = (f32x2){bflo(h0.x), bfhi(h0.x)}; hv2[1] = (f32x2){bflo(h0.y), bfhi(h0.y)}; hv2[2] = (f32x2){bflo(h0.z), bfhi(h0.z)}; hv2[3] = (f32x2){bflo(h0.w), bfhi(h0.w)};
            hv2[4] = (f32x2){bflo(h1.x), bfhi(h1.x)}; hv2[5] = (f32x2){bflo(h1.y), bfhi(h1.y)}; hv2[6] = (f32x2){bflo(h1.z), bfhi(h1.z)}; hv2[7] = (f32x2){bflo(h1.w), bfhi(h1.w)}; }
        const int id0 = TOPI[(size_t)tok * 128 + lane], id1 = TOPI[(size_t)tok * 128 + 64 + lane];
        const float g0 = TOPG[(size_t)tok * 128 + lane], g1 = TOPG[(size_t)tok * 128 + 64 + lane];
        f32x2 acc2[8];
#pragma unroll
        for (int i = 0; i < 8; ++i) acc2[i] = (f32x2){0.f, 0.f};
        const bool b32 = lane & 32, b16 = lane & 16, b8 = lane & 8;
        const int kl = (b32 ? 4 : 0) + (b16 ? 2 : 0) + (b8 ? 1 : 0);
#define G_ISSUE(UQ, VQ, GL, SUL, SVL, E0) do { \
            _Pragma("unroll") for (int k = 0; k < 8; ++k) { const int id = __builtin_amdgcn_readlane((E0) < 64 ? id0 : id1, ((E0) + k) & 63) & 16383; \
                UQ[k] = *(const u32x2*)(U8 + (size_t)id * 512); VQ[k] = *(const u32x2*)(V8 + (size_t)id * 512); } \
            { const int idl = __shfl((E0) < 64 ? id0 : id1, ((E0) + kl) & 63) & 16383; GL = __shfl((E0) < 64 ? g0 : g1, ((E0) + kl) & 63); SUL = USC[idl]; SVL = VSC[idl]; } } while (0)
#define G_COMPUTE(UQ, VQ, GL, SUL, SVL) do { \
            float d[8]; \
            _Pragma("unroll") for (int k = 0; k < 8; ++k) { f32x2 s2 = (f32x2){0.f, 0.f}; \
                _Pragma("unroll") for (int w = 0; w < 2; ++w) { \
                    s2 = __builtin_amdgcn_cvt_scalef32_pk_f32_fp4(UQ[k][w], 1.0f, 0) * hv2[4 * w + 0] + s2; s2 = __builtin_amdgcn_cvt_scalef32_pk_f32_fp4(UQ[k][w], 1.0f, 1) * hv2[4 * w + 1] + s2; \
                    s2 = __builtin_amdgcn_cvt_scalef32_pk_f32_fp4(UQ[k][w], 1.0f, 2) * hv2[4 * w + 2] + s2; s2 = __builtin_amdgcn_cvt_scalef32_pk_f32_fp4(UQ[k][w], 1.0f, 3) * hv2[4 * w + 3] + s2; } \
                d[k] = s2[0] + s2[1]; } \
            float d4[4], d2[2], r; \
            _Pragma("unroll") for (int k = 0; k < 4; ++k) { const float recv = __shfl_xor(b32 ? d[k] : d[k + 4], 32); d4[k] = (b32 ? d[k + 4] : d[k]) + recv; } \
            _Pragma("unroll") for (int k = 0; k < 2; ++k) { const float recv = __shfl_xor(b16 ? d4[k] : d4[k + 2], 16); d2[k] = (b16 ? d4[k + 2] : d4[k]) + recv; } \
            { const float recv = __shfl_xor(b8 ? d2[0] : d2[1], 8); r = (b8 ? d2[1] : d2[0]) + recv; } \
            r += __shfl_xor(r, 4); r += __shfl_xor(r, 2); r += __shfl_xor(r, 1); \
            const float cfl = GL * gelu_tanh(r * SUL) * SVL; \
            _Pragma("unroll") for (int k = 0; k < 8; ++k) { const float cf = __uint_as_float(__builtin_amdgcn_readlane(__float_as_uint(cfl), ((k >> 2) & 1) * 32 + ((k >> 1) & 1) * 16 + (k & 1) * 8)); \
                const f32x2 cf2 = (f32x2){cf, cf}; \
                _Pragma("unroll") for (int w = 0; w < 2; ++w) { \
                    acc2[4 * w + 0] = __builtin_amdgcn_cvt_scalef32_pk_f32_fp4(VQ[k][w], 1.0f, 0) * cf2 + acc2[4 * w + 0]; acc2[4 * w + 1] = __builtin_amdgcn_cvt_scalef32_pk_f32_fp4(VQ[k][w], 1.0f, 1) * cf2 + acc2[4 * w + 1]; \
                    acc2[4 * w + 2] = __builtin_amdgcn_cvt_scalef32_pk_f32_fp4(VQ[k][w], 1.0f, 2) * cf2 + acc2[4 * w + 2]; acc2[4 * w + 3] = __builtin_amdgcn_cvt_scalef32_pk_f32_fp4(VQ[k][w], 1.0f, 3) * cf2 + acc2[4 * w + 3]; } } } while (0)
        u32x2 uA[8], vA[8], uB[8], vB[8]; float glA, sulA, svlA, glB, sulB, svlB;
        G_ISSUE(uA, vA, glA, sulA, svlA, 0);
#pragma unroll 1
        for (int e0 = 0; e0 < 128; e0 += 16) {
            G_ISSUE(uB, vB, glB, sulB, svlB, e0 + 8);
            G_COMPUTE(uA, vA, glA, sulA, svlA);
            if (e0 + 16 < 128) { G_ISSUE(uA, vA, glA, sulA, svlA, e0 + 16); }
            G_COMPUTE(uB, vB, glB, sulB, svlB);
        }
#undef G_ISSUE
#undef G_COMPUTE
        const float* g2 = MOD + ((size_t)l * 2 + b) * 6144 + 5 * 1024 + 16 * lane;
        float* xrow = XRES + (size_t)tok * 1024 + 16 * lane;
        float xn[16]; float ss = 0.f;
#pragma unroll
        for (int q = 0; q < 4; ++q) { const f32x4 xr = *(const f32x4*)(xrow + 4 * q), gg = *(const f32x4*)(g2 + 4 * q);
            const float a0 = acc2[2 * q][0], a1 = acc2[2 * q][1], a2 = acc2[2 * q + 1][0], a3 = acc2[2 * q + 1][1];
            xn[4 * q + 0] = xr[0] + gg[0] * a0; xn[4 * q + 1] = xr[1] + gg[1] * a1; xn[4 * q + 2] = xr[2] + gg[2] * a2; xn[4 * q + 3] = xr[3] + gg[3] * a3; }
#pragma unroll
        for (int i = 0; i < 16; ++i) ss += xn[i] * xn[i];
        const float inv = __builtin_amdgcn_rsqf(wave_sum(ss) * (1.f / 1024.f) + EPS);
        if (dry) { if (inv == 123.456f) p->out[tok] = inv; continue; }
        if (l < DEPTH - 1) {
            const float* gain = p->norm_g + (size_t)(l + 1) * 2 * 1024 + 16 * lane; const float* sh = MOD + ((size_t)(l + 1) * 2 + b) * 6144 + 16 * lane; const float* sc = sh + 1024;
            float y[16];
#pragma unroll
            for (int q = 0; q < 4; ++q) { const f32x4 gn = *(const f32x4*)(gain + 4 * q), s1 = *(const f32x4*)(sh + 4 * q), c1 = *(const f32x4*)(sc + 4 * q);
                *(f32x4*)(xrow + 4 * q) = (f32x4){xn[4 * q], xn[4 * q + 1], xn[4 * q + 2], xn[4 * q + 3]};
#pragma unroll
                for (int i = 0; i < 4; ++i) y[4 * q + i] = (xn[4 * q + i] * inv) * gn[i] * (1.f + c1[i]) + s1[i]; }
            u32x4 o0, o1; o0.x = cvt_pk_bf16(y[0], y[1]); o0.y = cvt_pk_bf16(y[2], y[3]); o0.z = cvt_pk_bf16(y[4], y[5]); o0.w = cvt_pk_bf16(y[6], y[7]);
            o1.x = cvt_pk_bf16(y[8], y[9]); o1.y = cvt_pk_bf16(y[10], y[11]); o1.z = cvt_pk_bf16(y[12], y[13]); o1.w = cvt_pk_bf16(y[14], y[15]);
            *(u32x4*)(HBW + (size_t)tok * 1024 + 16 * lane) = o0; *(u32x4*)(HBW + (size_t)tok * 1024 + 16 * lane + 8) = o1;
        } else {
            const float* fg = p->final_g + 16 * lane; float* orow = p->out + (size_t)tok * 1024 + 16 * lane;
#pragma unroll
            for (int q = 0; q < 4; ++q) { const f32x4 gn = *(const f32x4*)(fg + 4 * q); f32x4 o;
#pragma unroll
                for (int i = 0; i < 4; ++i) o[i] = (xn[4 * q + i] * inv) * gn[i];
                *(f32x4*)(orow + 4 * q) = o; }
        }
    }
}

#define XB_TMO      128
#define XB_XCNT(j)  (256  + 64 * (j))
#define XB_XSUB(j)  (1280 + 64 * (j))
#define XB_XGEN(j)  (2304 + 64 * (j))
#define XB_TOP      3328
#define XB_TOPGEN   3392
#define XCD_BAR_WORDS 3456
#define XB_SPIN_CAP (1u << 18)

__device__ __forceinline__ unsigned xb_ld(unsigned* p)              { return __hip_atomic_load(p, __ATOMIC_RELAXED, __HIP_MEMORY_SCOPE_AGENT); }
__device__ __forceinline__ unsigned xb_add(unsigned* p, unsigned v) { return __hip_atomic_fetch_add(p, v, __ATOMIC_RELAXED, __HIP_MEMORY_SCOPE_AGENT); }
__device__ __forceinline__ unsigned xb_xcc_id() { return (unsigned)__builtin_amdgcn_s_getreg((3 << 11) | 20) & 0xFu; }
#define XB_SPIN(cond, bar) do { unsigned _sp = 0; while (cond) { __builtin_amdgcn_s_sleep(1); \
    if ((++_sp & 255u) == 0u) { if (xb_ld(&(bar)[XB_TMO])) break; if (_sp > XB_SPIN_CAP) { atomicAdd(&(bar)[XB_TMO], 1u); break; } } } } while (0)

struct XcdBarrier {
    unsigned* bar; unsigned x;
    volatile LAS unsigned* st;
};

__device__ __forceinline__ XcdBarrier xcd_barrier_post(unsigned* bar, volatile LAS unsigned* st) {
    XcdBarrier b; b.bar = bar; b.x = xb_xcc_id(); b.st = st;
    if (threadIdx.x == 0) (void)xb_add(&bar[XB_XCNT(b.x)], 1u);
    return b;
}
__device__ __forceinline__ void xcd_barrier_complete(unsigned* bar, unsigned x, unsigned& nloc, unsigned& nx) {
    const unsigned G = gridDim.x * gridDim.y * gridDim.z;
    unsigned sum, cnt, mine, sp = 0u;
    for (;;) {
        sum = 0u; cnt = 0u; mine = 0u;
#pragma unroll
        for (unsigned j = 0; j < 16; ++j) { const unsigned c = xb_ld(&bar[XB_XCNT(j)]); sum += c; cnt += (c > 0u) ? 1u : 0u; mine = (j == x) ? c : mine; }
        if (sum == G) break;
        __builtin_amdgcn_s_sleep(1);
        if ((++sp & 255u) == 0u) { if (xb_ld(&bar[XB_TMO])) break; if (sp > XB_SPIN_CAP) { atomicAdd(&bar[XB_TMO], 1u); break; } }
    }
    nloc = mine > 0u ? mine : 1u; nx = cnt > 0u ? cnt : 1u;
}

__device__ __forceinline__ void xcd_barrier(const XcdBarrier& b) {
    asm volatile("s_waitcnt vmcnt(0)" ::: "memory");
    __syncthreads();
    if (threadIdx.x == 0) {
        unsigned* bar = b.bar;
        __builtin_amdgcn_s_waitcnt(0);
        unsigned nloc = b.st[0], nx = b.st[1];
        if (nloc == 0u) { xcd_barrier_complete(bar, b.x, nloc, nx); b.st[0] = nloc; b.st[1] = nx; }
        const unsigned old = xb_add(&bar[XB_XSUB(b.x)], 1u);
        const unsigned gen = old / nloc;
        if (old + 1u == (gen + 1u) * nloc) {
            __builtin_amdgcn_fence(__ATOMIC_RELEASE, "agent");
            asm volatile("s_waitcnt vmcnt(0)" ::: "memory");
            const unsigned og = xb_add(&bar[XB_TOP], 1u);
            const unsigned tg = og / nx;
            if (og + 1u == (tg + 1u) * nx) xb_add(&bar[XB_TOPGEN], 1u);
            else XB_SPIN(xb_ld(&bar[XB_TOPGEN]) == tg, bar);
            __builtin_amdgcn_fence(__ATOMIC_ACQUIRE, "agent");
            xb_add(&bar[XB_XGEN(b.x)], 1u);
            asm volatile("s_waitcnt vmcnt(0)" ::: "memory");
        } else {
            XB_SPIN(xb_ld(&bar[XB_XGEN(b.x)]) == gen, bar);
            __builtin_amdgcn_fence(__ATOMIC_ACQUIRE, "agent");
            asm volatile("s_waitcnt vmcnt(0)" ::: "memory");
        }
    }
    __syncthreads();
}

#ifndef OPMASK
#define OPMASK 0xFFFFFFFFu
#endif
#define EN(o) ((OPMASK >> (o)) & 1u)
enum { OP_P0 = 0, OP_RMS1, OP_HG_IN, OP_HG_A, OP_HG_B, OP_HG_C, OP_MIX_OUT, OP_LR_IN, OP_LR_CONV, OP_LR_G, OP_LR_S1, OP_LR_S2, OP_LR_S3, OP_RMS2, OP_QK, OP_TOPK, OP_GATHER };
constexpr int NPH = 42;
#define REP_MASK 0u
__device__ __forceinline__ void decode_phase(int ph, int& l, int& op) {
    if (ph == 0) { l = 0; op = OP_P0; return; }
    if (ph == 1) { l = 0; op = OP_RMS1; return; }
    int q = ph - 2;
    if (q < 9) { l = 0; } else if (q < 20) { l = 1; q -= 9; } else if (q < 29) { l = 2; q -= 20; } else { l = 3; q -= 29; }
    if ((l & 1) == 0) { op = q == 0 ? OP_HG_IN : q == 1 ? OP_HG_A : q == 2 ? OP_HG_B : q == 3 ? OP_HG_C : q == 4 ? OP_MIX_OUT : q == 5 ? OP_RMS2 : q == 6 ? OP_QK : q == 7 ? OP_TOPK : OP_GATHER; }
    else { op = q == 0 ? OP_LR_IN : q == 1 ? OP_LR_CONV : q == 2 ? OP_LR_G : q == 3 ? OP_LR_S1 : q == 4 ? OP_LR_S2 : q == 5 ? OP_LR_S3 : q == 6 ? OP_MIX_OUT : q == 7 ? OP_RMS2 : q == 8 ? OP_QK : q == 9 ? OP_TOPK : OP_GATHER; }
}

__global__ __launch_bounds__(512, 2) void mk_fwd(Params p_arg) {
    extern __shared__ __attribute__((aligned(16))) unsigned char shm[];
    LAS unsigned char* lds = (LAS unsigned char*)shm;
    cg::grid_group grid = cg::this_grid();
    unsigned long long kpv = (unsigned long long)__builtin_amdgcn_kernarg_segment_ptr();
    const int ph_lo = p_arg.ph_lo, ph_hi = p_arg.ph_hi;
    volatile LAS unsigned* xst = (volatile LAS unsigned*)(lds + LDS_BYTES - 16);
    if (threadIdx.x == 0) { xst[0] = 0u; xst[1] = 0u; }
    __syncthreads();
    const XcdBarrier xb = xcd_barrier_post((unsigned*)(p_arg.ws + WS_CTL) + 1024, xst);
    for (int ph = ph_lo; ph < ph_hi; ++ph) {
        if (ph > ph_lo) { if (ph_hi > 4096) grid.sync(); else xcd_barrier(xb); }
        asm volatile("" : "+s"(kpv));
        KP p = (KP)kpv;
        unsigned char* ws = p->ws;
        const float* MOD = (const float*)(ws + WS_MOD);
        int l, op; decode_phase(ph, l, op);
        const int j = l >> 1;
        const int nrep = ((p->rep_mask >> op) & 1u) ? 2 : 1;
        for (int rep = 0; rep < nrep; ++rep) {
        const bool dry = rep + 1 < nrep;
#ifdef ONLY
        switch (ONLY) {
#else
        switch (op) {
#endif
        case OP_P0: if (EN(OP_P0)) phase0(p, lds); break;
        case OP_RMS1: if (EN(OP_RMS1)) phase_rms(p->x, p->norm_g, MOD, MOD + 1024, (bf16_t*)(ws + WS_HBUF)); break;
        case OP_HG_IN: if (EN(OP_HG_IN)) { EpiBf16 E; E.O = (bf16_t*)(ws + WS_PROJ); E.ldc = 5120;
            run_gemm(lds, (const bf16_t*)(ws + WS_HBUF), (const bf16_t*)(ws + WS_HGWIN) + (size_t)j * 5120 * 1024, 5120, 1024, 1024, 1024, 0, 0, E); } break;
        case OP_HG_A: if (EN(OP_HG_A)) hg_pass_a(p, lds, j); break;
        case OP_HG_B: if (EN(OP_HG_B)) hg_pass_b(p); break;
        case OP_HG_C: if (EN(OP_HG_C)) hg_pass_c(p, lds, j); break;
        case OP_MIX_OUT: if (EN(OP_MIX_OUT)) { EpiResid E; E.xin = (l == 0) ? p->x : (const float*)(ws + WS_XRES); E.xout = (float*)(ws + WS_XRES); E.gate = MOD + (size_t)l * 2 * 6144 + 2 * 1024; E.dry = dry;
            const bf16_t* W = (l & 1) ? (const bf16_t*)(ws + WS_LRWOUT) + (size_t)j * 1024 * 1024 : (const bf16_t*)(ws + WS_HGWOUT) + (size_t)j * 1024 * 1024;
            run_gemm(lds, (const bf16_t*)(ws + WS_OB), W, 1024, 1024, 1024, 1024, 0, 0, E); } break;
        case OP_LR_IN: if (EN(OP_LR_IN)) { EpiLruIn E; E.XB = (bf16_t*)(ws + WS_XB); E.YG = (bf16_t*)(ws + WS_YG);
            run_gemm(lds, (const bf16_t*)(ws + WS_HBUF), (const bf16_t*)(ws + WS_LRWIN) + (size_t)j * 2048 * 1024, 2048, 1024, 1024, 1024, 0, 0, E); } break;
        case OP_LR_CONV: if (EN(OP_LR_CONV)) lru_conv(p, j); break;
        case OP_LR_G: if (EN(OP_LR_G)) { EpiGates E; E.LOGA = (bf16_t*)(ws + WS_LOGA); E.BTERM = (bf16_t*)(ws + WS_BTERM); E.XC = (const bf16_t*)(ws + WS_XC);
            E.b_a = p->lru_b_a + (size_t)j * 2048; E.b_x = p->lru_b_x + (size_t)j * 2048; E.lam = p->lru_lam + (size_t)j * 2048;
            run_gemm(lds, (const bf16_t*)(ws + WS_XC), (const bf16_t*)(ws + WS_LRWG) + (size_t)j * 4 * 1024 * 256, 4096, 256, 1024, 256, 2, 512, E); } break;
        case OP_LR_S1: if (EN(OP_LR_S1)) lru_scan1(p, lds); break;
        case OP_LR_S2: if (EN(OP_LR_S2)) lru_scan2(p); break;
        case OP_LR_S3: if (EN(OP_LR_S3)) lru_scan3(p, lds); break;
        case OP_RMS2: if (EN(OP_RMS2)) phase_rms((const float*)(ws + WS_XRES), p->norm_g + ((size_t)l * 2 + 1) * 1024, MOD + (size_t)l * 2 * 6144 + 3 * 1024, MOD + (size_t)l * 2 * 6144 + 4 * 1024, (bf16_t*)(ws + WS_HBUF)); break;
        case OP_QK: if (EN(OP_QK)) { EpiScoresT E; E.C = (float*)(ws + WS_SCORES);
            run_gemm(lds, (const bf16_t*)(ws + WS_HBUF), (const bf16_t*)(ws + WS_WQK) + (size_t)l * 2048 * 1024, 2048, 1024, 1024, 1024, 0, 0, E); } break;
        case OP_TOPK: if (EN(OP_TOPK)) peer_topk(p, lds); break;
        case OP_GATHER: if (EN(OP_GATHER)) peer_gather(p, l, dry); break;
        default: break;
        }
        }
    }
}

extern "C" void kernel_launch(void* const* d_in, const int* in_sizes, int n_in, void* d_out, int out_size, void* d_ws, size_t ws_size, hipStream_t stream) {
    static int grid = 0;
    if (grid == 0) {
        if (n_in != 23 || ws_size < WS_END) { fprintf(stderr, "kernel_launch: unexpected n_in %d / ws_size %zu (need %zu)\n", n_in, ws_size, (size_t)WS_END); grid = -1; return; }
        int dev = 0, cus = 0, per_cu = 0;
        hipGetDevice(&dev); hipDeviceGetAttribute(&cus, hipDeviceAttributeMultiprocessorCount, dev);
        if (hipFuncSetAttribute((const void*)mk_fwd, hipFuncAttributeMaxDynamicSharedMemorySize, LDS_BYTES) != hipSuccess) { fprintf(stderr, "kernel_launch: hipFuncSetAttribute failed\n"); grid = -1; return; }
        if (hipOccupancyMaxActiveBlocksPerMultiprocessor(&per_cu, (const void*)mk_fwd, NTHR, LDS_BYTES) != hipSuccess || per_cu < 1) { fprintf(stderr, "kernel_launch: occupancy query failed (%d)\n", per_cu); (void)hipGetLastError(); per_cu = 1; }
        grid = cus * 1;
        fprintf(stderr, "kernel_launch: cus %d per_cu %d grid %d\n", cus, per_cu, grid);
    }
    if (grid < 0) return;
    if (hipMemsetAsync((char*)d_ws + WS_CTL, 0, 65536, stream) != hipSuccess) { fprintf(stderr, "kernel_launch: memset failed\n"); return; }
    Params p{};
    const float** pp = (const float**)&p;
    for (int i = 0; i < 23; ++i) pp[i] = (const float*)d_in[i];
    p.out = (float*)d_out; p.ws = (unsigned char*)d_ws; p.ph_lo = 0; p.ph_hi = NPH; p.rep_mask = REP_MASK;
    void* args[] = {&p};
    hipError_t e = hipLaunchCooperativeKernel((const void*)mk_fwd, dim3(grid), dim3(NTHR), args, LDS_BYTES, stream);
    if (e != hipSuccess) fprintf(stderr, "kernel_launch: cooperative launch failed: %s (grid %d)\n", hipGetErrorString(e), grid);
}
```

```cpp
#include <hip/hip_runtime.h>
#include <hip/hip_cooperative_groups.h>
#include <cstdio>
#include <cstdint>
namespace cg = cooperative_groups;

#define LAS __attribute__((address_space(3)))
#define PG8_LAS __attribute__((address_space(3)))
typedef unsigned short bf16_t;
typedef short bf16x8 __attribute__((ext_vector_type(8)));
typedef float f32x4 __attribute__((ext_vector_type(4)));
typedef float f32x2 __attribute__((ext_vector_type(2)));
typedef unsigned u32x4 __attribute__((ext_vector_type(4)));
typedef unsigned u32x2 __attribute__((ext_vector_type(2)));
typedef int v8i __attribute__((ext_vector_type(8)));

constexpr int T = 16384, D = 1024, SEQ = 8192, DEPTH = 4;
constexpr float EPS = 1e-6f;
constexpr int NBLK = 256, NTHR = 512, NWAVE = 8, NGW = NBLK * NWAVE;

constexpr size_t MiB = 1u << 20;
constexpr size_t WS_CTL = 0;
constexpr size_t WS_MOD = 1 * MiB;
constexpr size_t WS_HGWIN = 2 * MiB;
constexpr size_t WS_HGWOUT = 22 * MiB;
constexpr size_t WS_LRWIN = 26 * MiB;
constexpr size_t WS_LRWG = 34 * MiB;
constexpr size_t WS_LRWOUT = 38 * MiB;
constexpr size_t WS_WQK = 42 * MiB;
constexpr size_t WS_TOPI = 58 * MiB;
constexpr size_t WS_TOPG = 66 * MiB;
constexpr size_t WS_DEC = 74 * MiB;
constexpr size_t WS_CP = 75 * MiB;
constexpr size_t WS_CH = 79 * MiB;
constexpr size_t WS_HIN = 83 * MiB;
constexpr size_t WS_USC = 87 * MiB;
constexpr size_t WS_VSC = 87 * MiB + 262144;
constexpr size_t WS_XRES = 88 * MiB;
constexpr size_t WS_HBUF = 152 * MiB;
constexpr size_t WS_OB = 184 * MiB;
constexpr size_t WS_PROJ = 216 * MiB;
constexpr size_t WS_XB = WS_PROJ, WS_YG = WS_PROJ + 32 * MiB, WS_XC = WS_PROJ + 64 * MiB, WS_LOGA = WS_PROJ + 96 * MiB;
constexpr size_t WS_SCORES = WS_PROJ;
constexpr size_t WS_KV = 376 * MiB;
constexpr size_t WS_BTERM = WS_KV;
constexpr size_t WS_SIN = 504 * MiB;
constexpr size_t WS_UTAB = 568 * MiB;
constexpr size_t WS_VTAB = 696 * MiB;
constexpr size_t WS_HB8 = 824 * MiB;
constexpr size_t WS_END = 840 * MiB;

constexpr int LDS_BYTES = 155648;

#define LAUNDER_IDS int tidL = threadIdx.x, bidL = blockIdx.x; asm volatile("" : "+v"(tidL)); asm volatile("" : "+s"(bidL));
__device__ __forceinline__ float bf2f(bf16_t b) { return __uint_as_float(((unsigned)b) << 16); }
__device__ __forceinline__ float bflo(unsigned u) { return __uint_as_float(u << 16); }
__device__ __forceinline__ float bfhi(unsigned u) { return __uint_as_float(u & 0xffff0000u); }
__device__ __forceinline__ unsigned cvt_pk_bf16(float lo, float hi) { unsigned r; asm volatile("v_cvt_pk_bf16_f32 %0, %1, %2" : "=v"(r) : "v"(lo), "v"(hi)); return r; }
__device__ __forceinline__ bf16_t f2bf(float f) { return (bf16_t)(cvt_pk_bf16(f, 0.f) & 0xffffu); }
__device__ __forceinline__ float fast_exp(float x) { return __builtin_amdgcn_exp2f(x * 1.4426950408889634f); }
__device__ __forceinline__ float fast_log(float x) { return __builtin_amdgcn_logf(x) * 0.6931471805599453f; }
__device__ __forceinline__ float fast_rcp(float x) { return __builtin_amdgcn_rcpf(x); }
__device__ __forceinline__ float sigmoidf_(float x) { return fast_rcp(1.f + fast_exp(-x)); }
__device__ __forceinline__ float gelu_tanh(float x) { const float u = 1.5957691216057308f * (x + 0.044715f * x * x * x); return x * fast_rcp(1.f + fast_exp(-u)); }
__device__ __forceinline__ float silu_(float x) { return x * sigmoidf_(x); }
__device__ __forceinline__ float wave_sum(float v) {
#pragma unroll
    for (int o = 1; o < 64; o <<= 1) v += __shfl_xor(v, o);
    return v;
}
__device__ __forceinline__ float wave_max(float v) {
#pragma unroll
    for (int o = 1; o < 64; o <<= 1) v = fmaxf(v, __shfl_xor(v, o));
    return v;
}

namespace pg8 {
constexpr int BM = 256, BK = 64, HALF = 128, HTB = HALF * BK * 2, STAGE_BYTES = 8 * HTB, NXCD = 8, WGM = 8;
__host__ __device__ __forceinline__ int lds_byte(int r, int c) { const int st = (r >> 4) * 2 + (c >> 5), rr = r & 15, cc = c & 31, ob = rr * 64 + cc * 2; return st * 1024 + (ob ^ (((ob >> 9) & 1) << 5)); }
__host__ __device__ __forceinline__ void stage_rc(int b, int& R, int& C) { const int st = b / 1024, sb = b % 1024, swz = sb ^ (((sb >> 9) & 1) << 5); R = (st >> 1) * 16 + swz / 64; C = (st & 1) * 32 + (swz % 64) / 2; }
__host__ __device__ __forceinline__ int perm32(int rho) { const int n = rho >> 4, i = rho & 15; return 8 * (i >> 2) + 4 * n + (i & 3); }
struct Unit { int pm, pn; };
struct Gemm { const bf16_t* A; const bf16_t* Bt; int M, N, K, lda, ldb, a_pn_shift, a_pn_stride; };
struct StaticOrder {
    int nM, nN, nwg, G, c;
    __host__ __device__ void init(int M, int N, int G_, int c_) { nM = M / BM; nN = N / BM; nwg = nM * nN; G = G_; c = c_; }
    __host__ __device__ bool next(int i, Unit& u) const {
        const long L = (long)i * G + c; if (L >= nwg) return false;
        int wgid = (int)L; { const int q = nwg / NXCD, r = nwg % NXCD, xcd = wgid % NXCD, off = wgid / NXCD; wgid = (xcd < r ? xcd * (q + 1) : r * (q + 1) + (xcd - r) * q) + off; }
        const int nig = WGM * nN, gid = wgid / nig, fm = gid * WGM, gsz = (nM - fm) < WGM ? (nM - fm) : WGM;
        u.pm = fm + ((wgid % nig) % gsz); u.pn = (wgid % nig) / gsz; return true;
    }
    __device__ __forceinline__ void a_ready(const Unit&) const {}
    __device__ __forceinline__ void done(const Unit&) const {}
};
template <class Epi, class Sched, bool STAMP = false>
__device__ __forceinline__ void gemm_phase(PG8_LAS unsigned char* lds, const Gemm g, const Sched& S, const Epi& E, unsigned long long* stamps) {
    int tid = threadIdx.x; asm volatile("" : "+v"(tid)); const int wid = __builtin_amdgcn_readfirstlane(tid >> 6), lane = tid & 63, wr = wid >> 2, wc = wid & 3, fr = lane & 15, fq = lane >> 4;
    const int K = g.K, nt = K / BK;
    int ts_lo = 0, ts_hi = 0, nts = 0; const unsigned long long rt_entry = STAMP ? (unsigned long long)wall_clock64() : 0ull;
#define PG8_STAMP() do { if (STAMP && wid == 0 && nts < 64) { const unsigned long long _c = (unsigned long long)clock64(); \
        ts_lo = (lane == nts) ? (int)(unsigned)_c : ts_lo; ts_hi = (lane == nts) ? (int)(unsigned)(_c >> 32) : ts_hi; ++nts; } } while (0)
    PG8_STAMP();
    unsigned voffA[2], voffB[2];
#pragma unroll
    for (int i = 0; i < 2; ++i) { int R, C; stage_rc(tid * 16 + i * 8192, R, C); const int Rb = Epi::PERM ? ((R & ~31) + perm32(R & 31)) : R;
        voffA[i] = (unsigned)(R * g.lda + C) * 2u; voffB[i] = (unsigned)(Rb * g.ldb + C) * 2u; }
    const size_t kstep = (size_t)(BK * 2);
    const size_t hstepA = (size_t)HALF * g.lda * 2, hstepB = (size_t)HALF * g.ldb * 2;
    const size_t tstepA = 2 * hstepA, tstepB = 2 * hstepB;
    const unsigned ldsw = (unsigned)wid * 1024u;
    const int aoff = lds_byte(wr * 64 + fr, fq * 8), boff = lds_byte(wc * 32 + fr, fq * 8);
#define PG8_SA(b, h) (((b) * 2 + (h)) * HTB)
#define PG8_SB(b, h) ((4 + (b) * 2 + (h)) * HTB)
#define PG8_STAGE(bufoff, gbase, voff) do { _Pragma("unroll") for (int _i = 0; _i < 2; ++_i) \
        __builtin_amdgcn_global_load_lds((const unsigned*)((const char*)(gbase) + (voff)[_i]), (PG8_LAS unsigned*)(lds + (bufoff) + ldsw + _i * 8192), 16, 0, 0); } while (0)
#define PG8_LDA(dst, b, h) do { _Pragma("unroll") for (int m = 0; m < 4; ++m) _Pragma("unroll") for (int k = 0; k < 2; ++k) dst[m][k] = *(const PG8_LAS bf16x8*)(lds + PG8_SA(b, h) + aoff + m * 2048 + k * 1024); } while (0)
#define PG8_LDB(dst, b, h) do { _Pragma("unroll") for (int n = 0; n < 2; ++n) _Pragma("unroll") for (int k = 0; k < 2; ++k) dst[n][k] = *(const PG8_LAS bf16x8*)(lds + PG8_SB(b, h) + boff + n * 2048 + k * 1024); } while (0)
#define PG8_MMA(ai, bj, At, Bt) do { __builtin_amdgcn_s_setprio(1); _Pragma("unroll") for (int m = 0; m < 4; ++m) _Pragma("unroll") for (int n = 0; n < 2; ++n) _Pragma("unroll") for (int k = 0; k < 2; ++k) \
        acc[ai][bj][m][n] = Epi::SWAP ? __builtin_amdgcn_mfma_f32_16x16x32_bf16(At[m][k], Bt[n][k], acc[ai][bj][m][n], 0, 0, 0) : __builtin_amdgcn_mfma_f32_16x16x32_bf16(Bt[n][k], At[m][k], acc[ai][bj][m][n], 0, 0, 0); __builtin_amdgcn_s_setprio(0); } while (0)
#define PG8_WAIT_V(n) asm volatile("s_waitcnt vmcnt(" #n ")" ::: "memory")
#define PG8_WAIT_L(n) asm volatile("s_waitcnt lgkmcnt(" #n ")" ::: "memory")
#define PG8_BAR __builtin_amdgcn_s_barrier()
#define PG8_SCHED __builtin_amdgcn_sched_barrier(0)
    Unit cur, nxt; int ui = 0;
    if (!S.next(0, cur)) return;
    f32x4 acc[2][2][4][2];
#pragma unroll
    for (int a = 0; a < 2; ++a)
#pragma unroll
        for (int b = 0; b < 2; ++b)
#pragma unroll
            for (int m = 0; m < 4; ++m)
#pragma unroll
                for (int n = 0; n < 2; ++n) acc[a][b][m][n] = (f32x4){0.f, 0.f, 0.f, 0.f};
    bf16x8 At[4][2], B0[2][2], B1[2][2];
    const char* cA = (const char*)g.A + (size_t)cur.pm * tstepA + (size_t)(cur.pn >> g.a_pn_shift) * g.a_pn_stride; const char* cB = (const char*)g.Bt + (size_t)cur.pn * tstepB;
    S.a_ready(cur);
    PG8_STAGE(PG8_SB(0, 0), cB, voffB); PG8_STAGE(PG8_SA(0, 0), cA, voffA); PG8_STAGE(PG8_SB(0, 1), cB + hstepB, voffB); PG8_STAGE(PG8_SA(0, 1), cA + hstepA, voffA);
    if (wr == 1) PG8_BAR;
    PG8_WAIT_V(4); PG8_BAR;
    PG8_STAGE(PG8_SB(1, 0), cB + kstep, voffB); PG8_STAGE(PG8_SA(1, 0), cA + kstep, voffA); PG8_STAGE(PG8_SB(1, 1), cB + hstepB + kstep, voffB);
    PG8_WAIT_V(6); PG8_BAR;
    PG8_STAMP();
    for (;;) {
        const bool has_next = S.next(ui + 1, nxt);
        const char* nA = has_next ? (const char*)g.A + (size_t)nxt.pm * tstepA + (size_t)(nxt.pn >> g.a_pn_shift) * g.a_pn_stride : cA; const char* nB = has_next ? (const char*)g.Bt + (size_t)nxt.pn * tstepB : cB;
#pragma unroll 1
        for (int t = 0; t < nt; t += 2) {
            const bool last = (t == nt - 2);
            const char* a1 = cA + (size_t)(t + 1) * kstep;
            const char* a2 = last ? nA : cA + (size_t)(t + 2) * kstep; const char* b2 = last ? nB : cB + (size_t)(t + 2) * kstep;
            const char* a3 = a2 + kstep; const char* b3 = b2 + kstep;
            if (last && has_next) S.a_ready(nxt);
            PG8_LDB(B0, 0, 0); PG8_SCHED; PG8_LDA(At, 0, 0); PG8_STAGE(PG8_SA(1, 1), a1 + hstepA, voffA);
            PG8_WAIT_L(8); PG8_BAR; PG8_WAIT_L(0); PG8_MMA(0, 0, At, B0); PG8_BAR; PG8_SCHED;
            PG8_LDB(B1, 0, 1); PG8_STAGE(PG8_SB(0, 0), b2, voffB);
            PG8_BAR; PG8_WAIT_L(0); PG8_MMA(0, 1, At, B1); PG8_BAR;
            PG8_LDA(At, 0, 1); PG8_STAGE(PG8_SA(0, 0), a2, voffA);
            PG8_BAR; PG8_WAIT_L(0); PG8_MMA(1, 0, At, B0); PG8_BAR; PG8_SCHED;
            PG8_STAGE(PG8_SB(0, 1), b2 + hstepB, voffB);
            PG8_WAIT_V(6); PG8_BAR; PG8_MMA(1, 1, At, B1); PG8_BAR;
            PG8_LDB(B0, 1, 0); PG8_SCHED; PG8_LDA(At, 1, 0); PG8_STAGE(PG8_SA(0, 1), a2 + hstepA, voffA);
            PG8_WAIT_L(8); PG8_BAR; PG8_WAIT_L(0); PG8_MMA(0, 0, At, B0); PG8_BAR; PG8_SCHED;
            PG8_LDB(B1, 1, 1); PG8_STAGE(PG8_SB(1, 0), b3, voffB);
            PG8_BAR; PG8_WAIT_L(0); PG8_MMA(0, 1, At, B1); PG8_BAR;
            PG8_LDA(At, 1, 1); PG8_STAGE(PG8_SA(1, 0), a3, voffA);
            PG8_BAR; PG8_WAIT_L(0); PG8_MMA(1, 0, At, B0); PG8_BAR; PG8_SCHED;
            PG8_STAGE(PG8_SB(1, 1), b3 + hstepB, voffB);
            PG8_WAIT_V(6); PG8_BAR; PG8_MMA(1, 1, At, B1); PG8_BAR;
        }
        PG8_STAMP();
        if constexpr (!Epi::AFTER_DRAIN) { E(acc, cur, wr, wc, fr, fq); S.done(cur); }
        PG8_STAMP();
        if (!has_next) break;
#pragma unroll
        for (int a = 0; a < 2; ++a)
#pragma unroll
            for (int b = 0; b < 2; ++b)
#pragma unroll
                for (int m = 0; m < 4; ++m)
#pragma unroll
                    for (int n = 0; n < 2; ++n) acc[a][b][m][n] = (f32x4){0.f, 0.f, 0.f, 0.f};
        cur = nxt; cA = nA; cB = nB; ++ui;
    }
    PG8_WAIT_V(0);
    if (wr == 0) PG8_BAR;
    PG8_BAR;
    if constexpr (Epi::AFTER_DRAIN) { E.fused(acc, cur, wr, wc, fr, fq, lds, wid, lane); S.done(cur); }
    PG8_STAMP();
    if (STAMP && wid == 0) { stamps[lane] = lane < nts ? (((unsigned long long)(unsigned)ts_hi << 32) | (unsigned)ts_lo) : 0ull;
        if (lane == 62) stamps[62] = rt_entry; if (lane == 63) stamps[63] = (unsigned long long)wall_clock64(); }
#undef PG8_STAMP
#undef PG8_SA
#undef PG8_SB
#undef PG8_STAGE
#undef PG8_LDA
#undef PG8_LDB
#undef PG8_MMA
#undef PG8_WAIT_V
#undef PG8_WAIT_L
#undef PG8_BAR
#undef PG8_SCHED
}
}
using pg8::Unit;

struct EpiBf16 {
    static constexpr bool PERM = true, AFTER_DRAIN = false, SWAP = false;
    bf16_t* O; int ldc;
    __device__ __forceinline__ void operator()(const f32x4 (&acc)[2][2][4][2], const Unit& u, int wr, int wc, int fr, int fq) const {
        const int row0 = u.pm * 256 + wr * 64 + fr, col0 = u.pn * 256 + wc * 32 + 8 * fq;
#pragma unroll
        for (int ai = 0; ai < 2; ++ai)
#pragma unroll
            for (int m = 0; m < 4; ++m) { bf16_t* rowp = O + (size_t)(row0 + ai * 128 + m * 16) * ldc + col0;
#pragma unroll
                for (int bj = 0; bj < 2; ++bj) { const f32x4 v0 = acc[ai][bj][m][0], v1 = acc[ai][bj][m][1];
                    u32x4 o; o.x = cvt_pk_bf16(v0[0], v0[1]); o.y = cvt_pk_bf16(v0[2], v0[3]); o.z = cvt_pk_bf16(v1[0], v1[1]); o.w = cvt_pk_bf16(v1[2], v1[3]);
                    *(u32x4*)(rowp + bj * 128) = o; } }
    }
};
struct EpiLruIn {
    static constexpr bool PERM = true, AFTER_DRAIN = false, SWAP = false;
    bf16_t* XB; bf16_t* YG;
    __device__ __forceinline__ void operator()(const f32x4 (&acc)[2][2][4][2], const Unit& u, int wr, int wc, int fr, int fq) const {
        const bool isy = u.pn >= 4;
        bf16_t* O = isy ? YG : XB;
        const int row0 = u.pm * 256 + wr * 64 + fr, col0 = (u.pn & 3) * 256 + wc * 32 + 8 * fq;
#pragma unroll
        for (int ai = 0; ai < 2; ++ai)
#pragma unroll
            for (int m = 0; m < 4; ++m) { bf16_t* rowp = O + (size_t)(row0 + ai * 128 + m * 16) * 1024 + col0;
#pragma unroll
                for (int bj = 0; bj < 2; ++bj) { f32x4 v0 = acc[ai][bj][m][0], v1 = acc[ai][bj][m][1];
                    if (isy) {
#pragma unroll
                        for (int i = 0; i < 4; ++i) { v0[i] = gelu_tanh(v0[i]); v1[i] = gelu_tanh(v1[i]); } }
                    u32x4 o; o.x = cvt_pk_bf16(v0[0], v0[1]); o.y = cvt_pk_bf16(v0[2], v0[3]); o.z = cvt_pk_bf16(v1[0], v1[1]); o.w = cvt_pk_bf16(v1[2], v1[3]);
                    *(u32x4*)(rowp + bj * 128) = o; } }
    }
};
struct EpiGates {
    static constexpr bool PERM = true, AFTER_DRAIN = false, SWAP = false;
    bf16_t* LOGA; bf16_t* BTERM; const bf16_t* XC; const float* b_a; const float* b_x; const float* lam;
    __device__ __forceinline__ void operator()(const f32x4 (&acc)[2][2][4][2], const Unit& u, int wr, int wc, int fr_, int fq) const {
        int fr = fr_; asm volatile("" : "+v"(fr));
        const int nblk = u.pn >> 2, uu = u.pn & 3, d = uu >> 1, jh = uu & 1;
        const int colbase = nblk * 256 + jh * 128 + wc * 32 + 8 * fq;
        const unsigned off0 = (unsigned)(u.pm * 256 + wr * 64 + fr) * 1024u + (unsigned)colbase;
        const bf16_t* xcp = XC; bf16_t* lap = LOGA + (size_t)d * T * 1024; bf16_t* btp = BTERM + (size_t)d * T * 1024;
        const float* bap = b_a + d * 1024; const float* bxp = b_x + d * 1024; const float* lmp = lam + d * 1024;
#pragma unroll
        for (int ai = 0; ai < 2; ++ai)
#pragma unroll
            for (int m = 0; m < 4; ++m) { const unsigned off = off0 + (unsigned)(ai * 128 + m * 16) * 1024u;
                asm volatile("" ::: "memory"); __builtin_amdgcn_sched_barrier(0);
                const u32x4 xr = *(const u32x4*)(xcp + off);
                const float xv[8] = {bflo(xr.x), bfhi(xr.x), bflo(xr.y), bfhi(xr.y), bflo(xr.z), bfhi(xr.z), bflo(xr.w), bfhi(xr.w)};
                unsigned o1[4], o2[4];
#pragma unroll
                for (int n = 0; n < 2; ++n) { const f32x4 ba = *(const f32x4*)(bap + (unsigned)(colbase + 4 * n)), bx = *(const f32x4*)(bxp + (unsigned)(colbase + 4 * n)), lm = *(const f32x4*)(lmp + (unsigned)(colbase + 4 * n));
                    float la[4], bt[4];
#pragma unroll
                    for (int i = 0; i < 4; ++i) { const float r = sigmoidf_(acc[ai][0][m][n][i] + ba[i]), ig = sigmoidf_(acc[ai][1][m][n][i] + bx[i]);
                        const float l = -8.f * fast_log(1.f + fast_exp(-lm[i])) * r; const float mult = __builtin_sqrtf(fmaxf(1.f - fast_exp(2.f * l), 0.f));
                        la[i] = l; bt[i] = mult * ig * xv[n * 4 + i]; }
                    o1[n * 2] = cvt_pk_bf16(la[0], la[1]); o1[n * 2 + 1] = cvt_pk_bf16(la[2], la[3]); o2[n * 2] = cvt_pk_bf16(bt[0], bt[1]); o2[n * 2 + 1] = cvt_pk_bf16(bt[2], bt[3]); }
                *(u32x4*)(lap + off) = (u32x4){o1[0], o1[1], o1[2], o1[3]}; *(u32x4*)(btp + off) = (u32x4){o2[0], o2[1], o2[2], o2[3]}; }
    }
};
struct EpiResid {
    static constexpr bool PERM = false, AFTER_DRAIN = false, SWAP = false;
    const float* xin; float* xout; const float* gate; bool dry;
    __device__ __forceinline__ void operator()(const f32x4 (&acc)[2][2][4][2], const Unit& u, int wr, int wc, int fr, int fq) const {
        const int row0 = u.pm * 256 + wr * 64 + fr, col0 = u.pn * 256 + wc * 32 + 4 * fq;
        const float* gp = gate + ((u.pm * 256) >> 13) * 6144 + col0;
        f32x4 gv[2][2];
#pragma unroll
        for (int bj = 0; bj < 2; ++bj)
#pragma unroll
            for (int n = 0; n < 2; ++n) gv[bj][n] = *(const f32x4*)(gp + bj * 128 + n * 16);
#pragma unroll
        for (int ai = 0; ai < 2; ++ai)
#pragma unroll
            for (int m = 0; m < 4; ++m) { const size_t off = (size_t)(row0 + ai * 128 + m * 16) * 1024 + col0;
#pragma unroll
                for (int bj = 0; bj < 2; ++bj)
#pragma unroll
                    for (int n = 0; n < 2; ++n) { const f32x4 xv = *(const f32x4*)(xin + off + bj * 128 + n * 16);
                        if (!dry) *(f32x4*)(xout + off + bj * 128 + n * 16) = xv + gv[bj][n] * acc[ai][bj][m][n]; } }
    }
};
struct EpiScoresT {
    static constexpr bool PERM = false, AFTER_DRAIN = false, SWAP = true;
    float* C;
    __device__ __forceinline__ void operator()(const f32x4 (&acc)[2][2][4][2], const Unit& u, int wr, int wc, int fr_, int fq) const {
        int fr = fr_; asm volatile("" : "+v"(fr));
        const unsigned off0 = (unsigned)(u.pn * 256 + wc * 32 + fr) * (unsigned)T + (unsigned)(u.pm * 256 + wr * 64 + 4 * fq);
#pragma unroll
        for (int ai = 0; ai < 2; ++ai)
#pragma unroll
            for (int m = 0; m < 4; ++m)
#pragma unroll
                for (int bj = 0; bj < 2; ++bj)
#pragma unroll
                    for (int n = 0; n < 2; ++n) *(f32x4*)(C + (off0 + (unsigned)(bj * 128 + n * 16) * (unsigned)T + (unsigned)(ai * 128 + m * 16))) = acc[ai][bj][m][n];
    }
};

struct Params {
    const float *x, *c, *w_ada, *b_ada, *norm_g, *hg_w_in, *hg_lb, *hg_norm_g, *hg_w_out, *lru_w_in, *lru_conv_w, *lru_conv_b,
        *lru_w_a, *lru_b_a, *lru_w_x, *lru_b_x, *lru_lam, *lru_w_out, *peer_w_q, *peer_keys, *peer_u, *peer_v, *final_g;
    float* out; unsigned char* ws; int ph_lo, ph_hi; unsigned rep_mask; int pad_;
};

typedef const __attribute__((address_space(4))) Params* KP;

template <class Epi>
__device__ __forceinline__ void run_gemm(LAS unsigned char* lds, const bf16_t* A, const bf16_t* Bt, int N, int K, int lda, int ldb, int a_pn_shift, int a_pn_stride, const Epi& E) {
    pg8::Gemm g; g.A = A; g.Bt = Bt; g.M = T; g.N = N; g.K = K; g.lda = lda; g.ldb = ldb; g.a_pn_shift = a_pn_shift; g.a_pn_stride = a_pn_stride;
    LAUNDER_IDS
    pg8::StaticOrder S; S.init(T, N, (int)gridDim.x, bidL); (void)tidL;
    pg8::gemm_phase<Epi, pg8::StaticOrder, false>(lds, g, S, E, nullptr);
    __syncthreads();
}

__device__ __forceinline__ void transpose_tile(const float* __restrict__ src, int ld_src, bf16_t* dst, int ld_dst, LAS float* tile, int tid) {
#pragma unroll
    for (int it = 0; it < 2; ++it) { const int r = (tid >> 4) + 32 * it, c4 = (tid & 15) * 4;
        const f32x4 v = *(const f32x4*)(src + (size_t)r * ld_src + c4);
        tile[r * 65 + c4 + 0] = v[0]; tile[r * 65 + c4 + 1] = v[1]; tile[r * 65 + c4 + 2] = v[2]; tile[r * 65 + c4 + 3] = v[3]; }
    __syncthreads();
    { const int n = tid >> 3, kc = tid & 7; const LAS float* s = tile + (kc * 8) * 65 + n;
        u32x4 o; o.x = cvt_pk_bf16(s[0], s[65]); o.y = cvt_pk_bf16(s[2 * 65], s[3 * 65]); o.z = cvt_pk_bf16(s[4 * 65], s[5 * 65]); o.w = cvt_pk_bf16(s[6 * 65], s[7 * 65]);
        *(u32x4*)(dst + (size_t)n * ld_dst + kc * 8) = o; }
    __syncthreads();
}

__device__ __forceinline__ void phase0(KP p, LAS unsigned char* lds) {
    LAUNDER_IDS
    const int tid = tidL, wave = tid >> 6, lane = tid & 63;
    unsigned char* ws = p->ws;
    LAS float* tile = (LAS float*)lds;
    constexpr int I_HGIN = 16 * 80, I_SQ = 16 * 16, I_LRIN = 16 * 32, I_G = 16;
    constexpr int N_A = 2 * I_HGIN + 2 * I_SQ + 2 * I_LRIN + 2 * I_SQ + 32 * I_G;
    for (int it = bidL; it < N_A; it += gridDim.x) {
        int r = it;
        if (r < 2 * I_HGIN) { const int j = r / I_HGIN, q = r % I_HGIN, kb = q / 80, nb = q % 80;
            transpose_tile(p->hg_w_in + (size_t)j * 1024 * 5120 + (size_t)kb * 64 * 5120 + nb * 64, 5120, (bf16_t*)(ws + WS_HGWIN) + (size_t)j * 5120 * 1024 + (size_t)nb * 64 * 1024 + kb * 64, 1024, tile, tid); continue; }
        r -= 2 * I_HGIN;
        if (r < 2 * I_SQ) { const int j = r / I_SQ, q = r % I_SQ, kb = q / 16, nb = q % 16;
            transpose_tile(p->hg_w_out + (size_t)j * 1024 * 1024 + (size_t)kb * 64 * 1024 + nb * 64, 1024, (bf16_t*)(ws + WS_HGWOUT) + (size_t)j * 1024 * 1024 + (size_t)nb * 64 * 1024 + kb * 64, 1024, tile, tid); continue; }
        r -= 2 * I_SQ;
        if (r < 2 * I_LRIN) { const int j = r / I_LRIN, q = r % I_LRIN, kb = q / 32, nb = q % 32;
            transpose_tile(p->lru_w_in + (size_t)j * 1024 * 2048 + (size_t)kb * 64 * 2048 + nb * 64, 2048, (bf16_t*)(ws + WS_LRWIN) + (size_t)j * 2048 * 1024 + (size_t)nb * 64 * 1024 + kb * 64, 1024, tile, tid); continue; }
        r -= 2 * I_LRIN;
        if (r < 2 * I_SQ) { const int j = r / I_SQ, q = r % I_SQ, kb = q / 16, nb = q % 16;
            transpose_tile(p->lru_w_out + (size_t)j * 1024 * 1024 + (size_t)kb * 64 * 1024 + nb * 64, 1024, (bf16_t*)(ws + WS_LRWOUT) + (size_t)j * 1024 * 1024 + (size_t)nb * 64 * 1024 + kb * 64, 1024, tile, tid); continue; }
        r -= 2 * I_SQ;
        { const int mat = r / I_G, q = r % I_G, kb = q / 4, nb = q % 4;
            const int nblk = mat & 3, gate = (mat >> 2) & 1, d = (mat >> 3) & 1, l = mat >> 4;
            const float* src = (gate ? p->lru_w_x : p->lru_w_a) + (size_t)((l * 2 + d) * 4 + nblk) * 65536 + (size_t)kb * 64 * 256 + nb * 64;
            const int n0 = nb * 64, jh = n0 >> 7;
            bf16_t* dst = (bf16_t*)(ws + WS_LRWG) + (size_t)l * 4 * 1024 * 256 + (size_t)nblk * 1024 * 256 + (size_t)((d * 2 + jh) * 256 + gate * 128 + (n0 & 127)) * 256 + kb * 64;
            transpose_tile(src, 256, dst, 256, tile, tid); }
    }
    {
        LAS float* keysL = (LAS float*)lds;
        LAS float* wqL = (LAS float*)(lds + 128 * 132 * 4);
        for (int it = bidL; it < 1024; it += gridDim.x) {
            const int l = it >> 8, hp = (it >> 4) & 15, dt = it & 15;
            const float* kp = p->peer_keys + ((size_t)l * 16 + hp) * 16384;
#pragma unroll
            for (int q = 0; q < 8; ++q) { const int e = (tid + 512 * q) * 4; const f32x4 v = *(const f32x4*)(kp + e); *(LAS f32x4*)(keysL + (e >> 7) * 132 + (e & 127)) = v; }
            const float* wp = p->peer_w_q + (size_t)l * 1024 * 2048 + (size_t)(dt * 64) * 2048 + hp * 128;
#pragma unroll
            for (int q = 0; q < 4; ++q) { const int e = (tid + 512 * q) * 4; const f32x4 v = *(const f32x4*)(wp + (size_t)(e >> 7) * 2048 + (e & 127)); *(LAS f32x4*)(wqL + e) = v; }
            __syncthreads();
            const int key = tid & 127, g = tid >> 7;
            float acc[16];
#pragma unroll
            for (int i = 0; i < 16; ++i) acc[i] = 0.f;
            for (int d4 = 0; d4 < 128; d4 += 4) {
                const f32x4 kv = *(const LAS f32x4*)(keysL + key * 132 + d4);
#pragma unroll
                for (int i = 0; i < 16; ++i) { const f32x4 wv = *(const LAS f32x4*)(wqL + (g * 16 + i) * 128 + d4);
                    acc[i] += kv[0] * wv[0] + kv[1] * wv[1] + kv[2] * wv[2] + kv[3] * wv[3]; }
            }
            bf16_t* op = (bf16_t*)(ws + WS_WQK) + (size_t)l * 2048 * 1024 + (size_t)(hp * 128 + key) * 1024 + dt * 64 + g * 16;
            u32x4 o1, o2; o1.x = cvt_pk_bf16(acc[0], acc[1]); o1.y = cvt_pk_bf16(acc[2], acc[3]); o1.z = cvt_pk_bf16(acc[4], acc[5]); o1.w = cvt_pk_bf16(acc[6], acc[7]);
            o2.x = cvt_pk_bf16(acc[8], acc[9]); o2.y = cvt_pk_bf16(acc[10], acc[11]); o2.z = cvt_pk_bf16(acc[12], acc[13]); o2.w = cvt_pk_bf16(acc[14], acc[15]);
            *(u32x4*)op = o1; *(u32x4*)(op + 8) = o2;
            __syncthreads();
        }
    }
    {
        LAS float* condL = (LAS float*)lds;
        LAS float* red = (LAS float*)(lds + 8192);
        for (int i = tid; i < 2048; i += NTHR) condL[i] = silu_(p->c[i]);
        __syncthreads();
        for (int it = bidL; it < 4 * 48; it += gridDim.x) {
            const int l = it / 48, col0 = (it % 48) * 128;
            const float* wp = p->w_ada + (size_t)l * 1024 * 6144 + col0 + 2 * lane;
            float a00 = 0.f, a01 = 0.f, a10 = 0.f, a11 = 0.f;
#pragma unroll 8
            for (int kk = 0; kk < 128; ++kk) { const int k = wave * 128 + kk; const f32x2 w = *(const f32x2*)(wp + (size_t)k * 6144);
                const float c0 = condL[k], c1 = condL[1024 + k];
                a00 += c0 * w[0]; a01 += c0 * w[1]; a10 += c1 * w[0]; a11 += c1 * w[1]; }
            red[(wave * 2 + 0) * 128 + 2 * lane] = a00; red[(wave * 2 + 0) * 128 + 2 * lane + 1] = a01;
            red[(wave * 2 + 1) * 128 + 2 * lane] = a10; red[(wave * 2 + 1) * 128 + 2 * lane + 1] = a11;
            __syncthreads();
            if (tid < 256) { const int b = tid >> 7, cc = tid & 127; float s = 0.f;
#pragma unroll
                for (int w = 0; w < 8; ++w) s += red[(w * 2 + b) * 128 + cc];
                ((float*)(ws + WS_MOD))[((size_t)l * 2 + b) * 6144 + col0 + cc] = s + p->b_ada[(size_t)l * 6144 + col0 + cc]; }
            __syncthreads();
        }
    }
    {
        const int nw = gridDim.x * NWAVE;
        for (int row0 = bidL * NWAVE + wave; row0 < 2 * 65536; row0 += 4 * nw) {
            f32x4 v[4][4];
#pragma unroll
            for (int rr = 0; rr < 4; ++rr) { const int row = row0 + rr * nw; const int tb = row >> 16, r = row & 65535;
                const float* src = (tb ? p->peer_v : p->peer_u) + (size_t)r * 1024 + 4 * lane;
#pragma unroll
                for (int jx = 0; jx < 4; ++jx) v[rr][jx] = __builtin_nontemporal_load((const f32x4*)(src + 256 * jx)); }
#pragma unroll
            for (int rr = 0; rr < 4; ++rr) { const int row = row0 + rr * nw; const int tb = row >> 16, r = row & 65535;
                float am = 0.f;
#pragma unroll
                for (int jx = 0; jx < 4; ++jx) am = fmaxf(am, fmaxf(fmaxf(fabsf(v[rr][jx][0]), fabsf(v[rr][jx][1])), fmaxf(fabsf(v[rr][jx][2]), fabsf(v[rr][jx][3]))));
                am = wave_max(am);
                const float sc = am > 0.f ? am * (1.f / 6.f) : 1.f, inv = am > 0.f ? 6.f / am : 1.f;
                unsigned char* dst = ws + (tb ? WS_VTAB : WS_UTAB) + (size_t)r * 512 + 2 * lane;
#pragma unroll
                for (int jx = 0; jx < 4; ++jx) { unsigned w = __builtin_amdgcn_cvt_scalef32_pk_fp4_f32(0u, v[rr][jx][0] * inv, v[rr][jx][1] * inv, 1.0f, 0);
                    w = __builtin_amdgcn_cvt_scalef32_pk_fp4_f32(w, v[rr][jx][2] * inv, v[rr][jx][3] * inv, 1.0f, 1);
                    *(unsigned short*)(dst + 128 * jx) = (unsigned short)(w & 0xffffu); }
                if (lane == 0) ((float*)(ws + (tb ? WS_VSC : WS_USC)))[r] = sc; }
        }
    }
}

__device__ __forceinline__ void phase_rms(const float* xin, const float* gain, const float* shift, const float* scale, bf16_t* hout, unsigned char* h8out) {
    LAUNDER_IDS
    const int tid = tidL, wave = tid >> 6, lane = tid & 63;
    const int nw = gridDim.x * NWAVE;
    for (int row0 = bidL * NWAVE + wave; row0 < T; row0 += 2 * nw) {
        f32x4 v[2][4]; float ss[2];
#pragma unroll
        for (int rr = 0; rr < 2; ++rr) { const int row = min(row0 + rr * nw, T - 1); const float* xr = xin + (size_t)row * 1024 + lane * 4;
#pragma unroll
            for (int j = 0; j < 4; ++j) v[rr][j] = *(const f32x4*)(xr + j * 256); }
#pragma unroll
        for (int rr = 0; rr < 2; ++rr) { float a = 0.f;
#pragma unroll
            for (int j = 0; j < 4; ++j) a += v[rr][j][0] * v[rr][j][0] + v[rr][j][1] * v[rr][j][1] + v[rr][j][2] * v[rr][j][2] + v[rr][j][3] * v[rr][j][3];
            ss[rr] = a; }
#pragma unroll
        for (int o = 1; o < 64; o <<= 1) { ss[0] += __shfl_xor(ss[0], o); ss[1] += __shfl_xor(ss[1], o); }
#pragma unroll
        for (int rr = 0; rr < 2; ++rr) { const int row = row0 + rr * nw; if (row >= T) continue; const int b = row >> 13;
            const float inv = __builtin_amdgcn_rsqf(ss[rr] * (1.f / 1024.f) + EPS);
#pragma unroll
            for (int j = 0; j < 4; ++j) { const int col = j * 256 + lane * 4;
                const f32x4 g = *(const f32x4*)(gain + col), sh = *(const f32x4*)(shift + b * 6144 + col), sc = *(const f32x4*)(scale + b * 6144 + col);
                const f32x4 y = (v[rr][j] * inv) * g * (1.f + sc) + sh;
                u32x2 o; o.x = cvt_pk_bf16(y[0], y[1]); o.y = cvt_pk_bf16(y[2], y[3]);
                *(u32x2*)(hout + (size_t)row * 1024 + col) = o;
                if (h8out) { int w8 = __builtin_amdgcn_cvt_pk_fp8_f32(y[0], y[1], 0, false); w8 = __builtin_amdgcn_cvt_pk_fp8_f32(y[2], y[3], w8, true); *(int*)(h8out + (size_t)row * 1024 + col) = w8; } } }
    }
}

constexpr int LROW = 136;
__device__ __forceinline__ float hg_lower_bound(const float* hg_lb, int j, int col) {
    if (j == 0) return 0.f;
    const float l0 = hg_lb[col], l1 = hg_lb[1024 + col];
    return fast_rcp(1.f + fast_exp(l0 - l1));
}
__device__ __forceinline__ f32x4 mfma16(bf16x8 a, bf16x8 b, f32x4 c) { return __builtin_amdgcn_mfma_f32_16x16x32_bf16(a, b, c, 0, 0, 0); }

__device__ __forceinline__ void load_v_regs(const bf16_t* proj, u32x4 (&vr)[4], int t0, int dir, int h, int tid) {
#pragma unroll
    for (int it = 0; it < 4; ++it) { const int idx = tid + 512 * it, tau = idx & 127, cv = idx >> 7;
        const int tok = dir ? t0 + 127 - tau : t0 + tau;
        vr[it] = *(const u32x4*)(proj + (size_t)tok * 5120 + 3072 + h * 128 + cv * 8); }
}
__device__ __forceinline__ void store_vt(LAS bf16_t* VT, const u32x4 (&vr)[4], int tid) {
#pragma unroll
    for (int it = 0; it < 4; ++it) { const int idx = tid + 512 * it, tau = idx & 127, cv = idx >> 7; const u32x4 v = vr[it];
        LAS bf16_t* d = VT + (cv * 8) * LROW + tau;
        d[0 * LROW] = (bf16_t)(v.x & 0xffff); d[1 * LROW] = (bf16_t)(v.x >> 16); d[2 * LROW] = (bf16_t)(v.y & 0xffff); d[3 * LROW] = (bf16_t)(v.y >> 16);
        d[4 * LROW] = (bf16_t)(v.z & 0xffff); d[5 * LROW] = (bf16_t)(v.z >> 16); d[6 * LROW] = (bf16_t)(v.w & 0xffff); d[7 * LROW] = (bf16_t)(v.w >> 16); }
}
__device__ __forceinline__ void load_tile_regs(const bf16_t* proj, u32x4 (&r)[4], int t0, int dir, int col0, int tid) {
#pragma unroll
    for (int it = 0; it < 4; ++it) { const int idx = tid + 512 * it, tau = idx >> 4, c16 = idx & 15;
        const int tok = dir ? t0 + 127 - tau : t0 + tau;
        r[it] = *(const u32x4*)(proj + (size_t)tok * 5120 + col0 + c16 * 8); }
}
__device__ __forceinline__ void store_tile(LAS bf16_t* TL, const u32x4 (&r)[4], int tid) {
#pragma unroll
    for (int it = 0; it < 4; ++it) { const int idx = tid + 512 * it, tau = idx >> 4, c16 = idx & 15; *(LAS u32x4*)(TL + tau * LROW + c16 * 8) = r[it]; }
}

__device__ __forceinline__ void hg_pass_a(KP p, LAS unsigned char* lds, int j) {
    LAUNDER_IDS
    const bf16_t* proj = (const bf16_t*)(p->ws + WS_PROJ);
    float* KV = (float*)(p->ws + WS_KV); float* DEC = (float*)(p->ws + WS_DEC);
    LAS bf16_t* VT = (LAS bf16_t*)lds; LAS bf16_t* KT = (LAS bf16_t*)(lds + 34816); LAS float* TOT = (LAS float*)(lds + 69632); LAS bf16_t* ZT = (LAS bf16_t*)(lds + 71680);
    for (int u = bidL; u < 2048; u += gridDim.x) {
        int tid = tidL; asm volatile("" : "+v"(tid));
        const int wave = tid >> 6, lane = tid & 63;
        const int seq = u >> 6, c = u & 63, dir = seq & 1, h = (seq >> 1) & 7, b = seq >> 4;
        const int t0 = b * SEQ + c * 128;
        const int dk = tid & 127, g = tid >> 7;
        const float lb = hg_lower_bound(p->hg_lb, j, h * 128 + dk);
        float lcs[32], kks[32]; float lc = 0.f;
        { u32x4 zr[4], vr[4];
            load_tile_regs(proj, zr, t0, dir, 1024 * (1 + dir) + h * 128, tid); load_v_regs(proj, vr, t0, dir, h, tid);
            store_tile(ZT, zr, tid); store_vt(VT, vr, tid); }
        __syncthreads();
#pragma unroll
        for (int q = 0; q < 32; ++q) { const int tau = 32 * g + q;
            const float z = bf2f(ZT[tau * LROW + dk]);
            const float f = lb + (1.f - lb) * sigmoidf_(z);
            lc += fast_log(f); lcs[q] = lc; kks[q] = 1.f - f; }
        TOT[g * 128 + dk] = lc;
        __syncthreads();
        float rg = 0.f, total = 0.f;
#pragma unroll
        for (int gg = 0; gg < 4; ++gg) { const float tv = TOT[gg * 128 + dk]; total += tv; if (gg < g) rg += tv; }
        const float base = total - rg;
#pragma unroll
        for (int q8 = 0; q8 < 4; ++q8) { unsigned w[4];
#pragma unroll
            for (int e = 0; e < 4; ++e) { const int q = q8 * 8 + e * 2;
                w[e] = cvt_pk_bf16(kks[q] * fast_exp(base - lcs[q]), kks[q + 1] * fast_exp(base - lcs[q + 1])); }
            u32x4 o; o.x = w[0]; o.y = w[1]; o.z = w[2]; o.w = w[3];
            *(LAS u32x4*)(KT + dk * LROW + 32 * g + q8 * 8) = o; }
        if (g == 0) DEC[(size_t)u * 128 + dk] = fast_exp(total);
        __syncthreads();
        f32x4 acc[2][4];
#pragma unroll
        for (int a = 0; a < 2; ++a)
#pragma unroll
            for (int bb = 0; bb < 4; ++bb) acc[a][bb] = (f32x4){0.f, 0.f, 0.f, 0.f};
        const int l15 = lane & 15, lq = lane >> 4;
#pragma unroll
        for (int ks = 0; ks < 4; ++ks) {
            bf16x8 af[2], bfr[4];
#pragma unroll
            for (int a = 0; a < 2; ++a) af[a] = *(const LAS bf16x8*)(VT + (((wave & 3) * 2 + a) * 16 + l15) * LROW + ks * 32 + lq * 8);
#pragma unroll
            for (int bb = 0; bb < 4; ++bb) bfr[bb] = *(const LAS bf16x8*)(KT + (((wave >> 2) * 4 + bb) * 16 + l15) * LROW + ks * 32 + lq * 8);
#pragma unroll
            for (int a = 0; a < 2; ++a)
#pragma unroll
                for (int bb = 0; bb < 4; ++bb) acc[a][bb] = mfma16(af[a], bfr[bb], acc[a][bb]);
        }
        float* kvp = KV + (size_t)u * 16384;
#pragma unroll
        for (int a = 0; a < 2; ++a)
#pragma unroll
            for (int bb = 0; bb < 4; ++bb)
#pragma unroll
                for (int r = 0; r < 4; ++r) kvp[(((wave & 3) * 2 + a) * 16 + lq * 4 + r) * 128 + ((wave >> 2) * 4 + bb) * 16 + l15] = acc[a][bb][r];
        __syncthreads();
    }
}

__device__ __forceinline__ void hg_pass_b(KP p) {
    LAUNDER_IDS
    const float* KV = (const float*)(p->ws + WS_KV); const float* DEC = (const float*)(p->ws + WS_DEC);
    bf16_t* SIN = (bf16_t*)(p->ws + WS_SIN);
    for (int e = bidL * NTHR + tidL; e < 131072; e += gridDim.x * NTHR) {
    const int seq = e >> 12, i4 = e & 4095, dir = seq & 1, dk = (i4 * 4) & 127;
    f32x4 S = {0.f, 0.f, 0.f, 0.f};
#pragma unroll 16
    for (int step = 0; step < 64; ++step) {
        const int c = dir ? 63 - step : step; const size_t u = (size_t)seq * 64 + c;
        const f32x4 kv = *(const f32x4*)(KV + u * 16384 + i4 * 4); const f32x4 dc = *(const f32x4*)(DEC + u * 128 + dk);
        u32x2 o; o.x = cvt_pk_bf16(S[0], S[1]); o.y = cvt_pk_bf16(S[2], S[3]);
        *(u32x2*)(SIN + u * 16384 + i4 * 4) = o;
        S = dc * S + kv;
    }
    }
}

__device__ __forceinline__ void hg_pass_c(KP p, LAS unsigned char* lds, int j) {
    LAUNDER_IDS
    const bf16_t* proj = (const bf16_t*)(p->ws + WS_PROJ);
    const bf16_t* SIN = (const bf16_t*)(p->ws + WS_SIN);
    bf16_t* OB = (bf16_t*)(p->ws + WS_OB);
    LAS bf16_t* QT = (LAS bf16_t*)lds; LAS bf16_t* QI = (LAS bf16_t*)(lds + 34816); LAS bf16_t* KT = (LAS bf16_t*)(lds + 69632);
    LAS bf16_t* VT = (LAS bf16_t*)(lds + 104448); LAS bf16_t* PI = (LAS bf16_t*)(lds + 139264); LAS float* TOT = (LAS float*)(lds + 147968);
    LAS float* OSUM = (LAS float*)(lds + 69632);
    for (int u = bidL; u < 1024; u += gridDim.x) {
        int tid = tidL; asm volatile("" : "+v"(tid));
        const int wave = tid >> 6, lane = tid & 63, l15 = lane & 15, lq = lane >> 4;
        const int c = u & 63, h = (u >> 6) & 7, b = u >> 9;
        const int t0 = b * SEQ + c * 128;
        const int dk = tid & 127, g = tid >> 7;
        const float lb = hg_lower_bound(p->hg_lb, j, h * 128 + dk);
        const int tt = wave & 1, dvt0 = (wave >> 1) * 2;
        f32x4 oacc[2][4][2];
#pragma unroll
        for (int dir = 0; dir < 2; ++dir) {
            const size_t su = ((size_t)((b * 8 + h) * 2 + dir) * 64 + c);
            unsigned k0p[16]; float lc = 0.f; float kprev = 0.f;
            u32x4 vr[4];
            { u32x4 zr[4], qr[4];
                load_tile_regs(proj, zr, t0, dir, 1024 * (1 + dir) + h * 128, tid); load_tile_regs(proj, qr, t0, dir, h * 128, tid); load_v_regs(proj, vr, t0, dir, h, tid);
                __syncthreads();
                store_tile(KT, zr, tid); store_tile(VT, qr, tid); }
            __syncthreads();
#pragma unroll
            for (int q = 0; q < 32; ++q) { const int tau = 32 * g + q;
                const float z = bf2f(KT[tau * LROW + dk]), qv = bf2f(VT[tau * LROW + dk]);
                const float f = lb + (1.f - lb) * sigmoidf_(z);
                lc += fast_log(f);
                const float el = fast_exp(fmaxf(lc, -80.f));
                QT[tau * LROW + dk] = f2bf(qv * el);
                const float kcur = (1.f - f) * fast_rcp(el);
                if (q & 1) k0p[q >> 1] = cvt_pk_bf16(kprev, kcur); else kprev = kcur; }
            TOT[g * 128 + dk] = lc;
            __syncthreads();
            float r[4]; { float run = 0.f;
#pragma unroll
                for (int gg = 0; gg < 4; ++gg) { r[gg] = run; run += TOT[gg * 128 + dk]; } }
            float rg = 0.f;
#pragma unroll
            for (int gg = 0; gg < 4; ++gg) if (gg == g) rg = r[gg];
            { const float eg = fast_exp(rg);
#pragma unroll
                for (int q = 0; q < 32; ++q) QI[(32 * g + q) * LROW + dk] = f2bf(bf2f(QT[(32 * g + q) * LROW + dk]) * eg); }
            store_vt(VT, vr, tid);
            bf16x8 sfr[2][4];
#pragma unroll
            for (int n = 0; n < 2; ++n)
#pragma unroll
                for (int ks = 0; ks < 4; ++ks) sfr[n][ks] = *(const bf16x8*)(SIN + su * 16384 + (size_t)((dvt0 + n) * 16 + l15) * 128 + ks * 32 + lq * 8);
#pragma unroll
            for (int i = 0; i < 4; ++i) {
                if (g <= i) { const float e = fast_exp(r[i] - rg);
#pragma unroll
                    for (int q = 0; q < 32; ++q) KT[(32 * g + q) * LROW + dk] = f2bf(((q & 1) ? bfhi(k0p[q >> 1]) : bflo(k0p[q >> 1])) * e); }
                __syncthreads();
                for (int tl = wave; tl < 4 * (i + 1); tl += 8) { const int sm = tl >> 1, tn = tl & 1;
                    f32x4 a4 = {0.f, 0.f, 0.f, 0.f};
#pragma unroll
                    for (int ks = 0; ks < 4; ++ks) { const bf16x8 af = *(const LAS bf16x8*)(KT + (sm * 16 + l15) * LROW + ks * 32 + lq * 8);
                        const bf16x8 bq = *(const LAS bf16x8*)(QT + (32 * i + tn * 16 + l15) * LROW + ks * 32 + lq * 8);
                        a4 = mfma16(af, bq, a4); }
                    const int tloc = tn * 16 + l15, s0 = sm * 16 + lq * 4, tg = 32 * i + tloc;
                    u32x2 o; o.x = cvt_pk_bf16(s0 + 0 <= tg ? a4[0] : 0.f, s0 + 1 <= tg ? a4[1] : 0.f); o.y = cvt_pk_bf16(s0 + 2 <= tg ? a4[2] : 0.f, s0 + 3 <= tg ? a4[3] : 0.f);
                    *(LAS u32x2*)(PI + tloc * LROW + s0) = o; }
                __syncthreads();
                f32x4 a0 = {0.f, 0.f, 0.f, 0.f}, a1 = {0.f, 0.f, 0.f, 0.f};
                for (int ks = 0; ks <= i; ++ks) { const bf16x8 af = *(const LAS bf16x8*)(PI + (tt * 16 + l15) * LROW + ks * 32 + lq * 8);
                    const bf16x8 b0 = *(const LAS bf16x8*)(VT + ((dvt0 + 0) * 16 + l15) * LROW + ks * 32 + lq * 8);
                    const bf16x8 b1 = *(const LAS bf16x8*)(VT + ((dvt0 + 1) * 16 + l15) * LROW + ks * 32 + lq * 8);
                    a0 = mfma16(af, b0, a0); a1 = mfma16(af, b1, a1); }
#pragma unroll
                for (int ks = 0; ks < 4; ++ks) { const bf16x8 af = *(const LAS bf16x8*)(QI + (32 * i + tt * 16 + l15) * LROW + ks * 32 + lq * 8);
                    a0 = mfma16(af, sfr[0][ks], a0); a1 = mfma16(af, sfr[1][ks], a1); }
                oacc[dir][i][0] = a0; oacc[dir][i][1] = a1;
            }
        }
        __syncthreads();
#pragma unroll
        for (int i = 0; i < 4; ++i)
#pragma unroll
            for (int n = 0; n < 2; ++n)
#pragma unroll
                for (int rr = 0; rr < 4; ++rr) OSUM[(32 * i + tt * 16 + lq * 4 + rr) * 132 + (dvt0 + n) * 16 + l15] = oacc[0][i][n][rr];
        __syncthreads();
#pragma unroll
        for (int i = 0; i < 4; ++i)
#pragma unroll
            for (int n = 0; n < 2; ++n)
#pragma unroll
                for (int rr = 0; rr < 4; ++rr) OSUM[(127 - (32 * i + tt * 16 + lq * 4 + rr)) * 132 + (dvt0 + n) * 16 + l15] += oacc[1][i][n][rr];
        __syncthreads();
        { const int row = tid >> 2, part = tid & 3; const int tok = t0 + row;
            float ov[32]; float ss = 0.f;
#pragma unroll
            for (int q = 0; q < 8; ++q) { const f32x4 v = *(const LAS f32x4*)(OSUM + row * 132 + part * 32 + q * 4);
                ov[q * 4 + 0] = v[0]; ov[q * 4 + 1] = v[1]; ov[q * 4 + 2] = v[2]; ov[q * 4 + 3] = v[3]; ss += v[0] * v[0] + v[1] * v[1] + v[2] * v[2] + v[3] * v[3]; }
            ss += __shfl_xor(ss, 1); ss += __shfl_xor(ss, 2);
            const float inv = __builtin_amdgcn_rsqf(ss * (1.f / 128.f) + EPS);
            const int col = h * 128 + part * 32;
            const bf16_t* gp = proj + (size_t)tok * 5120 + 4096 + col; const float* ng = p->hg_norm_g + j * 1024 + col;
#pragma unroll
            for (int q = 0; q < 4; ++q) { const u32x4 gr = *(const u32x4*)(gp + q * 8);
                const float gv[8] = {bflo(gr.x), bfhi(gr.x), bflo(gr.y), bfhi(gr.y), bflo(gr.z), bfhi(gr.z), bflo(gr.w), bfhi(gr.w)};
                float y[8];
#pragma unroll
                for (int e = 0; e < 8; ++e) y[e] = ov[q * 8 + e] * inv * ng[q * 8 + e] * silu_(gv[e]);
                u32x4 o; o.x = cvt_pk_bf16(y[0], y[1]); o.y = cvt_pk_bf16(y[2], y[3]); o.z = cvt_pk_bf16(y[4], y[5]); o.w = cvt_pk_bf16(y[6], y[7]);
                *(u32x4*)(OB + (size_t)tok * 1024 + col + q * 8) = o; }
        }
        __syncthreads();
    }
}

__device__ __forceinline__ void lru_conv(KP p, int l) {
    LAUNDER_IDS
    const bf16_t* XB = (const bf16_t*)(p->ws + WS_XB); bf16_t* XC = (bf16_t*)(p->ws + WS_XC);
    const float* cw = p->lru_conv_w + (size_t)l * 4 * 1024; const float* cb = p->lru_conv_b + (size_t)l * 1024;
    const int gs = gridDim.x * NTHR;
    for (int it = bidL * NTHR + tidL; it < T * 128; it += gs) {
        const int tok = it >> 7, c8 = (it & 127) * 8, s = tok & (SEQ - 1);
        float acc[8];
        { const f32x4 b0 = *(const f32x4*)(cb + c8), b1 = *(const f32x4*)(cb + c8 + 4);
            acc[0] = b0[0]; acc[1] = b0[1]; acc[2] = b0[2]; acc[3] = b0[3]; acc[4] = b1[0]; acc[5] = b1[1]; acc[6] = b1[2]; acc[7] = b1[3]; }
#pragma unroll
        for (int jj = 0; jj < 4; ++jj) { const int ts = s + jj - 2;
            if (ts >= 0 && ts < SEQ) { const u32x4 xr = *(const u32x4*)(XB + (size_t)(tok + jj - 2) * 1024 + c8);
                const f32x4 w0 = *(const f32x4*)(cw + jj * 1024 + c8), w1 = *(const f32x4*)(cw + jj * 1024 + c8 + 4);
                acc[0] += bflo(xr.x) * w0[0]; acc[1] += bfhi(xr.x) * w0[1]; acc[2] += bflo(xr.y) * w0[2]; acc[3] += bfhi(xr.y) * w0[3];
                acc[4] += bflo(xr.z) * w1[0]; acc[5] += bfhi(xr.z) * w1[1]; acc[6] += bflo(xr.w) * w1[2]; acc[7] += bfhi(xr.w) * w1[3]; } }
        u32x4 o; o.x = cvt_pk_bf16(acc[0], acc[1]); o.y = cvt_pk_bf16(acc[2], acc[3]); o.z = cvt_pk_bf16(acc[4], acc[5]); o.w = cvt_pk_bf16(acc[6], acc[7]);
        *(u32x4*)(XC + (size_t)tok * 1024 + c8) = o;
    }
}
__device__ __forceinline__ void lru_scan1(KP p, LAS unsigned char* lds) {
    LAUNDER_IDS
    const bf16_t* LOGA = (const bf16_t*)(p->ws + WS_LOGA); const bf16_t* BT = (const bf16_t*)(p->ws + WS_BTERM);
    float* CP = (float*)(p->ws + WS_CP); float* CH = (float*)(p->ws + WS_CH);
    LAS float* XP = (LAS float*)lds; LAS float* XH = (LAS float*)(lds + 16384);
    for (int u = bidL; u < 1024; u += gridDim.x) {
        int tid = tidL; asm volatile("" : "+v"(tid));
        const int ts = tid >> 7, c8 = (tid & 127) * 8;
        const int chunk = u & 255, dir = (u >> 8) & 1, b = u >> 9;
        const size_t base = ((size_t)dir * T + b * SEQ + chunk * 32) * 1024 + c8;
        u32x4 lw[8], bw[8];
#pragma unroll
        for (int q = 0; q < 8; ++q) { const int t = dir ? 31 - (ts * 8 + q) : ts * 8 + q; lw[q] = *(const u32x4*)(LOGA + base + (size_t)t * 1024); bw[q] = *(const u32x4*)(BT + base + (size_t)t * 1024); }
        float h[8], sl[8];
#pragma unroll
        for (int i = 0; i < 8; ++i) { h[i] = 0.f; sl[i] = 0.f; }
#pragma unroll
        for (int q = 0; q < 8; ++q) {
#pragma unroll
            for (int w = 0; w < 4; ++w) { const float l0 = bflo(lw[q][w]), l1 = bfhi(lw[q][w]);
                h[2 * w] = fast_exp(l0) * h[2 * w] + bflo(bw[q][w]); h[2 * w + 1] = fast_exp(l1) * h[2 * w + 1] + bfhi(bw[q][w]); sl[2 * w] += l0; sl[2 * w + 1] += l1; } }
        *(LAS f32x4*)(XP + ts * 1024 + c8) = (f32x4){fast_exp(sl[0]), fast_exp(sl[1]), fast_exp(sl[2]), fast_exp(sl[3])};
        *(LAS f32x4*)(XP + ts * 1024 + c8 + 4) = (f32x4){fast_exp(sl[4]), fast_exp(sl[5]), fast_exp(sl[6]), fast_exp(sl[7])};
        *(LAS f32x4*)(XH + ts * 1024 + c8) = (f32x4){h[0], h[1], h[2], h[3]}; *(LAS f32x4*)(XH + ts * 1024 + c8 + 4) = (f32x4){h[4], h[5], h[6], h[7]};
        __syncthreads();
        { const int ch = 2 * tid; float P0 = 1.f, P1 = 1.f, H0 = 0.f, H1 = 0.f;
#pragma unroll
            for (int s2 = 0; s2 < 4; ++s2) { const f32x2 pp = *(const LAS f32x2*)(XP + s2 * 1024 + ch), hh = *(const LAS f32x2*)(XH + s2 * 1024 + ch);
                H0 = pp[0] * H0 + hh[0]; H1 = pp[1] * H1 + hh[1]; P0 *= pp[0]; P1 *= pp[1]; }
            const size_t o = ((size_t)(b * 2 + dir) * 256 + chunk) * 1024 + ch;
            *(f32x2*)(CP + o) = (f32x2){P0, P1}; *(f32x2*)(CH + o) = (f32x2){H0, H1}; }
        __syncthreads();
    }
}
__device__ __forceinline__ void lru_scan2(KP p) {
    LAUNDER_IDS
    const float* CP = (const float*)(p->ws + WS_CP); const float* CH = (const float*)(p->ws + WS_CH); float* HIN = (float*)(p->ws + WS_HIN);
    const int wave = tidL >> 6, lane = tidL & 63;
    for (int item = bidL * NWAVE + wave; item < 4096; item += gridDim.x * NWAVE) {
        const int ch = item & 1023, bd = item >> 10, dir = bd & 1;
        float pp[4], hh[4]; float Pl = 1.f, Hl = 0.f;
#pragma unroll
        for (int q = 0; q < 4; ++q) { const int ci = 4 * lane + q, chunk = dir ? 255 - ci : ci; const size_t o = ((size_t)bd * 256 + chunk) * 1024 + ch;
            pp[q] = CP[o]; hh[q] = CH[o]; Hl = pp[q] * Hl + hh[q]; Pl *= pp[q]; }
#pragma unroll
        for (int off = 1; off < 64; off <<= 1) { const float Pp = __shfl_up(Pl, off), Hp = __shfl_up(Hl, off);
            if (lane >= off) { Hl = Pl * Hp + Hl; Pl = Pl * Pp; } }
        float carry = __shfl_up(Hl, 1); if (lane == 0) carry = 0.f;
#pragma unroll
        for (int q = 0; q < 4; ++q) { const int ci = 4 * lane + q, chunk = dir ? 255 - ci : ci; const size_t o = ((size_t)bd * 256 + chunk) * 1024 + ch;
            HIN[o] = carry; carry = pp[q] * carry + hh[q]; }
    }
}
__device__ __forceinline__ void lru_scan3(KP p, LAS unsigned char* lds) {
    LAUNDER_IDS
    const bf16_t* LOGA = (const bf16_t*)(p->ws + WS_LOGA); const bf16_t* BT = (const bf16_t*)(p->ws + WS_BTERM); const bf16_t* YG = (const bf16_t*)(p->ws + WS_YG);
    const float* HIN = (const float*)(p->ws + WS_HIN); bf16_t* OB = (bf16_t*)(p->ws + WS_OB);
    LAS float* XP = (LAS float*)lds; LAS float* XH = (LAS float*)(lds + 16384);
    for (int u = bidL; u < 512; u += gridDim.x) {
        int tid = tidL; asm volatile("" : "+v"(tid));
        const int ts = tid >> 7, c8 = (tid & 127) * 8;
        const int chunk = u & 255, b = u >> 8;
        const size_t base = ((size_t)b * SEQ + chunk * 32 + ts * 8) * 1024 + c8;
        unsigned hsp[8][4];
#pragma unroll
        for (int dir = 0; dir < 2; ++dir) {
            u32x4 lw[8], bw[8];
#pragma unroll
            for (int q = 0; q < 8; ++q) { lw[q] = *(const u32x4*)(LOGA + (size_t)dir * T * 1024 + base + (size_t)q * 1024); bw[q] = *(const u32x4*)(BT + (size_t)dir * T * 1024 + base + (size_t)q * 1024); }
            const f32x4 hi0 = *(const f32x4*)(HIN + ((size_t)(b * 2 + dir) * 256 + chunk) * 1024 + c8), hi1 = *(const f32x4*)(HIN + ((size_t)(b * 2 + dir) * 256 + chunk) * 1024 + c8 + 4);
            float h[8], sl[8];
#pragma unroll
            for (int i = 0; i < 8; ++i) { h[i] = 0.f; sl[i] = 0.f; }
#pragma unroll
            for (int qq = 0; qq < 8; ++qq) { const int q = dir ? 7 - qq : qq;
#pragma unroll
                for (int w = 0; w < 4; ++w) { const float l0 = bflo(lw[q][w]), l1 = bfhi(lw[q][w]);
                    h[2 * w] = fast_exp(l0) * h[2 * w] + bflo(bw[q][w]); h[2 * w + 1] = fast_exp(l1) * h[2 * w + 1] + bfhi(bw[q][w]); sl[2 * w] += l0; sl[2 * w + 1] += l1; } }
            __syncthreads();
            *(LAS f32x4*)(XP + ts * 1024 + c8) = (f32x4){fast_exp(sl[0]), fast_exp(sl[1]), fast_exp(sl[2]), fast_exp(sl[3])};
            *(LAS f32x4*)(XP + ts * 1024 + c8 + 4) = (f32x4){fast_exp(sl[4]), fast_exp(sl[5]), fast_exp(sl[6]), fast_exp(sl[7])};
            *(LAS f32x4*)(XH + ts * 1024 + c8) = (f32x4){h[0], h[1], h[2], h[3]}; *(LAS f32x4*)(XH + ts * 1024 + c8 + 4) = (f32x4){h[4], h[5], h[6], h[7]};
            __syncthreads();
            h[0] = hi0[0]; h[1] = hi0[1]; h[2] = hi0[2]; h[3] = hi0[3]; h[4] = hi1[0]; h[5] = hi1[1]; h[6] = hi1[2]; h[7] = hi1[3];
#pragma unroll
            for (int s3 = 0; s3 < 3; ++s3) { const int sr = dir ? 3 - s3 : s3; const bool use = dir ? (sr > ts) : (sr < ts);
                const f32x4 p0 = *(const LAS f32x4*)(XP + sr * 1024 + c8), p1 = *(const LAS f32x4*)(XP + sr * 1024 + c8 + 4), q0 = *(const LAS f32x4*)(XH + sr * 1024 + c8), q1 = *(const LAS f32x4*)(XH + sr * 1024 + c8 + 4);
                if (use) { h[0] = p0[0] * h[0] + q0[0]; h[1] = p0[1] * h[1] + q0[1]; h[2] = p0[2] * h[2] + q0[2]; h[3] = p0[3] * h[3] + q0[3];
                    h[4] = p1[0] * h[4] + q1[0]; h[5] = p1[1] * h[5] + q1[1]; h[6] = p1[2] * h[6] + q1[2]; h[7] = p1[3] * h[7] + q1[3]; } }
#pragma unroll
            for (int qq = 0; qq < 8; ++qq) { const int q = dir ? 7 - qq : qq;
                u32x4 yw; if (dir) yw = *(const u32x4*)(YG + base + (size_t)q * 1024);
                unsigned ow[4];
#pragma unroll
                for (int w = 0; w < 4; ++w) { h[2 * w] = fast_exp(bflo(lw[q][w])) * h[2 * w] + bflo(bw[q][w]); h[2 * w + 1] = fast_exp(bfhi(lw[q][w])) * h[2 * w + 1] + bfhi(bw[q][w]);
                    if (dir == 0) hsp[q][w] = cvt_pk_bf16(h[2 * w], h[2 * w + 1]);
                    else ow[w] = cvt_pk_bf16((bflo(hsp[q][w]) + h[2 * w]) * bflo(yw[w]), (bfhi(hsp[q][w]) + h[2 * w + 1]) * bfhi(yw[w])); }
                if (dir) *(u32x4*)(OB + base + (size_t)q * 1024) = (u32x4){ow[0], ow[1], ow[2], ow[3]}; }
        }
        __syncthreads();
    }
}

__device__ const unsigned char STAIR[64] = {
    0x00, 0x01, 0x02, 0x03, 0x04, 0x05, 0x06, 0x07, 0x08, 0x09, 0x0a, 0x0b, 0x0c, 0x0d, 0x0e, 0x0f,
    0x10, 0x11, 0x12, 0x13, 0x14, 0x15, 0x16, 0x17, 0x20, 0x21, 0x22, 0x23, 0x24, 0x30, 0x31, 0x32,
    0x33, 0x40, 0x41, 0x42, 0x50, 0x51, 0x60, 0x61, 0x70, 0x71, 0x80, 0x90, 0xa0, 0xb0, 0xc0, 0xd0,
    0xe0, 0xf0, 0, 0, 0, 0, 0, 0, 0, 0, 0, 0, 0, 0, 0, 0};
__device__ __forceinline__ unsigned mono_key(float f) { const unsigned b = __float_as_uint(f); return b ^ ((b >> 31) ? 0xffffffffu : 0x80000000u); }

__device__ __forceinline__ float inv_mono(unsigned k) { return __uint_as_float(k ^ ((k >> 31) ? 0x80000000u : 0xffffffffu)); }
#define TK_CE(A, B) do { const unsigned hi_ = max(A, B), lo_ = min(A, B); A = hi_; B = lo_; } while (0)
#define TK_SORT16(N) do { _Pragma("unroll") for (int k_ = 2; k_ <= 16; k_ <<= 1) { _Pragma("unroll") for (int j_ = k_ >> 1; j_ > 0; j_ >>= 1) { _Pragma("unroll") for (int i_ = 0; i_ < 16; ++i_) { \
    const int l_ = i_ ^ j_; if (l_ > i_) { if ((i_ & k_) == 0) TK_CE(N[i_], N[l_]); else TK_CE(N[l_], N[i_]); } } } } } while (0)
#define TK_MERGE16(L, N) do { _Pragma("unroll") for (int i_ = 0; i_ < 16; ++i_) L[i_] = max(L[i_], N[15 - i_]); \
    _Pragma("unroll") for (int j_ = 8; j_ > 0; j_ >>= 1) { _Pragma("unroll") for (int i_ = 0; i_ < 16; ++i_) { const int l_ = i_ ^ j_; if (l_ > i_) TK_CE(L[i_], L[l_]); } } } while (0)
#define TK_INSERT(L, x) do { _Pragma("unroll") for (int q_ = 0; q_ < 16; ++q_) { const unsigned hi_ = max(L[q_], x); x = min(L[q_], x); L[q_] = hi_; } } while (0)
__device__ __forceinline__ void peer_topk(KP p, LAS unsigned char* lds) {
    LAUNDER_IDS
    (void)bidL;
    const int tid = tidL, wave = tid >> 6, lane = tid & 63;
    const float* SCT = (const float*)(p->ws + WS_SCORES);
    int* TOPI = (int*)(p->ws + WS_TOPI); float* TOPG = (float*)(p->ws + WS_TOPG);
    LAS unsigned char* IX = lds + wave * 2048 + lane * 32;
    for (int item = bidL * NWAVE + wave; item < 2048; item += gridDim.x * NWAVE) {
        const int tg = item >> 3, hd = item & 7, tok = tg * 64 + lane;
        float V[2][16];
#pragma unroll
        for (int half = 0; half < 2; ++half) {
            unsigned L[16];
#pragma unroll
            for (int q = 0; q < 16; ++q) L[q] = 0u;
            const float* sc = SCT + (size_t)(hd * 256 + half * 128) * T + tok;
            float cur[16], nxt[16];
#pragma unroll
            for (int i = 0; i < 16; ++i) cur[i] = sc[(size_t)i * T];
#pragma unroll 1
            for (int kb = 0; kb < 8; ++kb) {
                const int kn = kb < 7 ? kb + 1 : kb;
#pragma unroll
                for (int i = 0; i < 16; ++i) nxt[i] = sc[(size_t)(kn * 16 + i) * T];
                unsigned NK[16];
#pragma unroll
                for (int i = 0; i < 16; ++i) NK[i] = (mono_key(cur[i]) & ~0x7fu) | (unsigned)(kb * 16 + i);
                TK_SORT16(NK); TK_MERGE16(L, NK);
#pragma unroll
                for (int i = 0; i < 16; ++i) cur[i] = nxt[i];
            }
            u32x4 w0, w1;
            w0.x = (L[0] & 0x7f) | ((L[1] & 0x7f) << 8) | ((L[2] & 0x7f) << 16) | ((L[3] & 0x7f) << 24); w0.y = (L[4] & 0x7f) | ((L[5] & 0x7f) << 8) | ((L[6] & 0x7f) << 16) | ((L[7] & 0x7f) << 24);
            w0.z = (L[8] & 0x7f) | ((L[9] & 0x7f) << 8) | ((L[10] & 0x7f) << 16) | ((L[11] & 0x7f) << 24); w0.w = (L[12] & 0x7f) | ((L[13] & 0x7f) << 8) | ((L[14] & 0x7f) << 16) | ((L[15] & 0x7f) << 24);
            *(LAS u32x4*)(IX + half * 16) = w0;
#pragma unroll
            for (int q = 0; q < 16; ++q) V[half][q] = inv_mono(L[q]);
        }
        unsigned C[16];
#pragma unroll
        for (int q = 0; q < 16; ++q) C[q] = 0u;
#pragma unroll
        for (int i = 0; i < 16; ++i)
#pragma unroll
            for (int jj = 0; jj < 16; ++jj) if ((i + 1) * (jj + 1) <= 16) { unsigned x = (mono_key(V[0][i] + V[1][jj]) & ~0xffu) | (unsigned)(i * 16 + jj); TK_INSERT(C, x); }
        asm volatile("s_waitcnt lgkmcnt(0)" ::: "memory");
        const float s0 = inv_mono(C[0] & ~0xffu);
        float e[16]; float sum = 0.f; int ids[16];
#pragma unroll
        for (int q = 0; q < 16; ++q) { e[q] = fast_exp(inv_mono(C[q] & ~0xffu) - s0); sum += e[q];
            const unsigned code = C[q] & 0xffu; ids[q] = (int)IX[code >> 4] * 128 + (int)IX[16 + (code & 15u)]; }
        const float rs = fast_rcp(sum);
        int* ip = TOPI + (size_t)tok * 128 + hd * 16; float* gp = TOPG + (size_t)tok * 128 + hd * 16;
#pragma unroll
        for (int q = 0; q < 4; ++q) { *(u32x4*)(ip + 4 * q) = (u32x4){(unsigned)ids[4 * q], (unsigned)ids[4 * q + 1], (unsigned)ids[4 * q + 2], (unsigned)ids[4 * q + 3]};
            *(f32x4*)(gp + 4 * q) = (f32x4){e[4 * q] * rs, e[4 * q + 1] * rs, e[4 * q + 2] * rs, e[4 * q + 3] * rs}; }
        asm volatile("s_waitcnt lgkmcnt(0)" ::: "memory");
    }
}

__device__ __forceinline__ void peer_gather(KP p, int l, bool dry) {
    LAUNDER_IDS
    const int wave = tidL >> 6, lane = tidL & 63;
    const bf16_t* HB = (const bf16_t*)(p->ws + WS_HBUF); bf16_t* HBW = (bf16_t*)(p->ws + WS_HBUF);
    const int* TOPI = (const int*)(p->ws + WS_TOPI); const float* TOPG = (const float*)(p->ws + WS_TOPG);
    const unsigned char* UA = p->ws + WS_UTAB + (size_t)l * 16384 * 512; const unsigned char* V8 = p->ws + WS_VTAB + (size_t)l * 16384 * 512 + 8 * lane; const unsigned char* H8 = p->ws + WS_HB8;
    const float* USC = (const float*)(p->ws + WS_USC) + l * 16384; const float* VSC = (const float*)(p->ws + WS_VSC) + l * 16384;
    float* XRES = (float*)(p->ws + WS_XRES); const float* MOD = (const float*)(p->ws + WS_MOD);
    for (int tok = bidL * NWAVE + wave; tok < T; tok += gridDim.x * NWAVE) {
        const int b = tok >> 13;
        const int gq = lane >> 4, jq = lane & 15;
        v8i hb[8];
#pragma unroll
        for (int sidx = 0; sidx < 8; ++sidx) { const u32x4 lo = *(const u32x4*)(H8 + (size_t)tok * 1024 + 128 * sidx + 16 * gq), hi = *(const u32x4*)(H8 + (size_t)tok * 1024 + 128 * sidx + 64 + 16 * gq);
            hb[sidx] = (v8i){(int)lo.x, (int)lo.y, (int)lo.z, (int)lo.w, (int)hi.x, (int)hi.y, (int)hi.z, (int)hi.w}; }
        const int id0 = TOPI[(size_t)tok * 128 + lane], id1 = TOPI[(size_t)tok * 128 + 64 + lane];
        const float g0 = TOPG[(size_t)tok * 128 + lane], g1 = TOPG[(size_t)tok * 128 + 64 + lane];
        f32x2 acc2[8];
#pragma unroll
        for (int i = 0; i < 8; ++i) acc2[i] = (f32x2){0.f, 0.f};
        const int ke = 4 * gq + (jq & 3);
#pragma unroll 1
        for (int e0 = 0; e0 < 128; e0 += 16) {
            const int ida = __shfl(e0 < 64 ? id0 : id1, (e0 + jq) & 63) & 16383;
            const unsigned char* ua_p = UA + (size_t)ida * 512 + 16 * gq;
            u32x4 ua[8];
#pragma unroll
            for (int sidx = 0; sidx < 8; ++sidx) ua[sidx] = *(const u32x4*)(ua_p + 64 * sidx);
            u32x2 vq[16];
#pragma unroll
            for (int k = 0; k < 16; ++k) { const int id = __builtin_amdgcn_readlane(e0 < 64 ? id0 : id1, (e0 + k) & 63) & 16383; vq[k] = *(const u32x2*)(V8 + (size_t)id * 512); }
            const int idk = __shfl(e0 < 64 ? id0 : id1, (e0 + ke) & 63) & 16383; const float gl = __shfl(e0 < 64 ? g0 : g1, (e0 + ke) & 63);
            const float sul = USC[idk], svl = VSC[idk];
            f32x4 dacc = {0.f, 0.f, 0.f, 0.f};
#pragma unroll
            for (int sidx = 0; sidx < 8; ++sidx) { const v8i av = (v8i){(int)ua[sidx].x, (int)ua[sidx].y, (int)ua[sidx].z, (int)ua[sidx].w, 0, 0, 0, 0};
                dacc = __builtin_amdgcn_mfma_scale_f32_16x16x128_f8f6f4(av, hb[sidx], dacc, 4, 0, 0, 0x7f7f7f7f, 0, 0x7f7f7f7f); }
            const int jr = jq & 3;
            const float r = jr == 0 ? dacc[0] : jr == 1 ? dacc[1] : jr == 2 ? dacc[2] : dacc[3];
            const float cfl = gl * gelu_tanh(r * sul) * svl;
#pragma unroll
            for (int k = 0; k < 16; ++k) { const float cf = __uint_as_float(__builtin_amdgcn_readlane(__float_as_uint(cfl), 16 * (k >> 2) + (k & 3)));
                const f32x2 cf2 = (f32x2){cf, cf};
#pragma unroll
                for (int w = 0; w < 2; ++w) {
                    acc2[4 * w + 0] = __builtin_amdgcn_cvt_scalef32_pk_f32_fp4(vq[k][w], 1.0f, 0) * cf2 + acc2[4 * w + 0]; acc2[4 * w + 1] = __builtin_amdgcn_cvt_scalef32_pk_f32_fp4(vq[k][w], 1.0f, 1) * cf2 + acc2[4 * w + 1];
                    acc2[4 * w + 2] = __builtin_amdgcn_cvt_scalef32_pk_f32_fp4(vq[k][w], 1.0f, 2) * cf2 + acc2[4 * w + 2]; acc2[4 * w + 3] = __builtin_amdgcn_cvt_scalef32_pk_f32_fp4(vq[k][w], 1.0f, 3) * cf2 + acc2[4 * w + 3]; } }
        }
        const float* g2 = MOD + ((size_t)l * 2 + b) * 6144 + 5 * 1024 + 16 * lane;
        float* xrow = XRES + (size_t)tok * 1024 + 16 * lane;
        float xn[16]; float ss = 0.f;
#pragma unroll
        for (int q = 0; q < 4; ++q) { const f32x4 xr = *(const f32x4*)(xrow + 4 * q), gg = *(const f32x4*)(g2 + 4 * q);
            const float a0 = acc2[2 * q][0], a1 = acc2[2 * q][1], a2 = acc2[2 * q + 1][0], a3 = acc2[2 * q + 1][1];
            xn[4 * q + 0] = xr[0] + gg[0] * a0; xn[4 * q + 1] = xr[1] + gg[1] * a1; xn[4 * q + 2] = xr[2] + gg[2] * a2; xn[4 * q + 3] = xr[3] + gg[3] * a3; }
#pragma unroll
        for (int i = 0; i < 16; ++i) ss += xn[i] * xn[i];
        const float inv = __builtin_amdgcn_rsqf(wave_sum(ss) * (1.f / 1024.f) + EPS);
        if (dry) { if (inv == 123.456f) p->out[tok] = inv; continue; }
        if (l < DEPTH - 1) {
            const float* gain = p->norm_g + (size_t)(l + 1) * 2 * 1024 + 16 * lane; const float* sh = MOD + ((size_t)(l + 1) * 2 + b) * 6144 + 16 * lane; const float* sc = sh + 1024;
            float y[16];
#pragma unroll
            for (int q = 0; q < 4; ++q) { const f32x4 gn = *(const f32x4*)(gain + 4 * q), s1 = *(const f32x4*)(sh + 4 * q), c1 = *(const f32x4*)(sc + 4 * q);
                *(f32x4*)(xrow + 4 * q) = (f32x4){xn[4 * q], xn[4 * q + 1], xn[4 * q + 2], xn[4 * q + 3]};
#pragma unroll
                for (int i = 0; i < 4; ++i) y[4 * q + i] = (xn[4 * q + i] * inv) * gn[i] * (1.f + c1[i]) + s1[i]; }
            u32x4 o0, o1; o0.x = cvt_pk_bf16(y[0], y[1]); o0.y = cvt_pk_bf16(y[2], y[3]); o0.z = cvt_pk_bf16(y[4], y[5]); o0.w = cvt_pk_bf16(y[6], y[7]);
            o1.x = cvt_pk_bf16(y[8], y[9]); o1.y = cvt_pk_bf16(y[10], y[11]); o1.z = cvt_pk_bf16(y[12], y[13]); o1.w = cvt_pk_bf16(y[14], y[15]);
            *(u32x4*)(HBW + (size_t)tok * 1024 + 16 * lane) = o0; *(u32x4*)(HBW + (size_t)tok * 1024 + 16 * lane + 8) = o1;
        } else {
            const float* fg = p->final_g + 16 * lane; float* orow = p->out + (size_t)tok * 1024 + 16 * lane;
#pragma unroll
            for (int q = 0; q < 4; ++q) { const f32x4 gn = *(const f32x4*)(fg + 4 * q); f32x4 o;
#pragma unroll
                for (int i = 0; i < 4; ++i) o[i] = (xn[4 * q + i] * inv) * gn[i];
                *(f32x4*)(orow + 4 * q) = o; }
        }
    }
}

#define XB_TMO      128
#define XB_XCNT(j)  (256  + 64 * (j))
#define XB_XSUB(j)  (1280 + 64 * (j))
#define XB_XGEN(j)  (2304 + 64 * (j))
#define XB_TOP      3328
#define XB_TOPGEN   3392
#define XCD_BAR_WORDS 3456
#define XB_SPIN_CAP (1u << 18)

__device__ __forceinline__ unsigned xb_ld(unsigned* p)              { return __hip_atomic_load(p, __ATOMIC_RELAXED, __HIP_MEMORY_SCOPE_AGENT); }
__device__ __forceinline__ unsigned xb_add(unsigned* p, unsigned v) { return __hip_atomic_fetch_add(p, v, __ATOMIC_RELAXED, __HIP_MEMORY_SCOPE_AGENT); }
__device__ __forceinline__ unsigned xb_xcc_id() { return (unsigned)__builtin_amdgcn_s_getreg((3 << 11) | 20) & 0xFu; }
#define XB_SPIN(cond, bar) do { unsigned _sp = 0; while (cond) { __builtin_amdgcn_s_sleep(1); \
    if ((++_sp & 255u) == 0u) { if (xb_ld(&(bar)[XB_TMO])) break; if (_sp > XB_SPIN_CAP) { atomicAdd(&(bar)[XB_TMO], 1u); break; } } } } while (0)

struct XcdBarrier {
    unsigned* bar; unsigned x;
    volatile LAS unsigned* st;
};

__device__ __forceinline__ XcdBarrier xcd_barrier_post(unsigned* bar, volatile LAS unsigned* st) {
    XcdBarrier b; b.bar = bar; b.x = xb_xcc_id(); b.st = st;
    if (threadIdx.x == 0) (void)xb_add(&bar[XB_XCNT(b.x)], 1u);
    return b;
}
__device__ __forceinline__ void xcd_barrier_complete(unsigned* bar, unsigned x, unsigned& nloc, unsigned& nx) {
    const unsigned G = gridDim.x * gridDim.y * gridDim.z;
    unsigned sum, cnt, mine, sp = 0u;
    for (;;) {
        sum = 0u; cnt = 0u; mine = 0u;
#pragma unroll
        for (unsigned j = 0; j < 16; ++j) { const unsigned c = xb_ld(&bar[XB_XCNT(j)]); sum += c; cnt += (c > 0u) ? 1u : 0u; mine = (j == x) ? c : mine; }
        if (sum == G) break;
        __builtin_amdgcn_s_sleep(1);
        if ((++sp & 255u) == 0u) { if (xb_ld(&bar[XB_TMO])) break; if (sp > XB_SPIN_CAP) { atomicAdd(&bar[XB_TMO], 1u); break; } }
    }
    nloc = mine > 0u ? mine : 1u; nx = cnt > 0u ? cnt : 1u;
}

__device__ __forceinline__ void xcd_barrier(const XcdBarrier& b) {
    asm volatile("s_waitcnt vmcnt(0)" ::: "memory");
    __syncthreads();
    if (threadIdx.x == 0) {
        unsigned* bar = b.bar;
        __builtin_amdgcn_s_waitcnt(0);
        unsigned nloc = b.st[0], nx = b.st[1];
        if (nloc == 0u) { xcd_barrier_complete(bar, b.x, nloc, nx); b.st[0] = nloc; b.st[1] = nx; }
        const unsigned old = xb_add(&bar[XB_XSUB(b.x)], 1u);
        const unsigned gen = old / nloc;
        if (old + 1u == (gen + 1u) * nloc) {
            __builtin_amdgcn_fence(__ATOMIC_RELEASE, "agent");
            asm volatile("s_waitcnt vmcnt(0)" ::: "memory");
            const unsigned og = xb_add(&bar[XB_TOP], 1u);
            const unsigned tg = og / nx;
            if (og + 1u == (tg + 1u) * nx) xb_add(&bar[XB_TOPGEN], 1u);
            else XB_SPIN(xb_ld(&bar[XB_TOPGEN]) == tg, bar);
            __builtin_amdgcn_fence(__ATOMIC_ACQUIRE, "agent");
            xb_add(&bar[XB_XGEN(b.x)], 1u);
            asm volatile("s_waitcnt vmcnt(0)" ::: "memory");
        } else {
            XB_SPIN(xb_ld(&bar[XB_XGEN(b.x)]) == gen, bar);
            __builtin_amdgcn_fence(__ATOMIC_ACQUIRE, "agent");
            asm volatile("s_waitcnt vmcnt(0)" ::: "memory");
        }
    }
    __syncthreads();
}

#ifndef OPMASK
#define OPMASK 0xFFFFFFFFu
#endif
#define EN(o) ((OPMASK >> (o)) & 1u)
enum { OP_P0 = 0, OP_RMS1, OP_HG_IN, OP_HG_A, OP_HG_B, OP_HG_C, OP_MIX_OUT, OP_LR_IN, OP_LR_CONV, OP_LR_G, OP_LR_S1, OP_LR_S2, OP_LR_S3, OP_RMS2, OP_QK, OP_TOPK, OP_GATHER };
constexpr int NPH = 42;
#define REP_MASK 0u
__device__ __forceinline__ void decode_phase(int ph, int& l, int& op) {
    if (ph == 0) { l = 0; op = OP_P0; return; }
    if (ph == 1) { l = 0; op = OP_RMS1; return; }
    int q = ph - 2;
    if (q < 9) { l = 0; } else if (q < 20) { l = 1; q -= 9; } else if (q < 29) { l = 2; q -= 20; } else { l = 3; q -= 29; }
    if ((l & 1) == 0) { op = q == 0 ? OP_HG_IN : q == 1 ? OP_HG_A : q == 2 ? OP_HG_B : q == 3 ? OP_HG_C : q == 4 ? OP_MIX_OUT : q == 5 ? OP_RMS2 : q == 6 ? OP_QK : q == 7 ? OP_TOPK : OP_GATHER; }
    else { op = q == 0 ? OP_LR_IN : q == 1 ? OP_LR_CONV : q == 2 ? OP_LR_G : q == 3 ? OP_LR_S1 : q == 4 ? OP_LR_S2 : q == 5 ? OP_LR_S3 : q == 6 ? OP_MIX_OUT : q == 7 ? OP_RMS2 : q == 8 ? OP_QK : q == 9 ? OP_TOPK : OP_GATHER; }
}

__global__ __launch_bounds__(512, 2) void mk_fwd(Params p_arg) {
    extern __shared__ __attribute__((aligned(16))) unsigned char shm[];
    LAS unsigned char* lds = (LAS unsigned char*)shm;
    cg::grid_group grid = cg::this_grid();
    unsigned long long kpv = (unsigned long long)__builtin_amdgcn_kernarg_segment_ptr();
    const int ph_lo = p_arg.ph_lo, ph_hi = p_arg.ph_hi;
    volatile LAS unsigned* xst = (volatile LAS unsigned*)(lds + LDS_BYTES - 16);
    if (threadIdx.x == 0) { xst[0] = 0u; xst[1] = 0u; }
    __syncthreads();
    const XcdBarrier xb = xcd_barrier_post((unsigned*)(p_arg.ws + WS_CTL) + 1024, xst);
    for (int ph = ph_lo; ph < ph_hi; ++ph) {
        if (ph > ph_lo) { if (ph_hi > 4096) grid.sync(); else xcd_barrier(xb); }
        asm volatile("" : "+s"(kpv));
        KP p = (KP)kpv;
        unsigned char* ws = p->ws;
        const float* MOD = (const float*)(ws + WS_MOD);
        int l, op; decode_phase(ph, l, op);
        const int j = l >> 1;
        const int nrep = ((p->rep_mask >> op) & 1u) ? 2 : 1;
        for (int rep = 0; rep < nrep; ++rep) {
        const bool dry = rep + 1 < nrep;
#ifdef ONLY
        switch (ONLY) {
#else
        switch (op) {
#endif
        case OP_P0: if (EN(OP_P0)) phase0(p, lds); break;
        case OP_RMS1: if (EN(OP_RMS1)) phase_rms(p->x, p->norm_g, MOD, MOD + 1024, (bf16_t*)(ws + WS_HBUF), nullptr); break;
        case OP_HG_IN: if (EN(OP_HG_IN)) { EpiBf16 E; E.O = (bf16_t*)(ws + WS_PROJ); E.ldc = 5120;
            run_gemm(lds, (const bf16_t*)(ws + WS_HBUF), (const bf16_t*)(ws + WS_HGWIN) + (size_t)j * 5120 * 1024, 5120, 1024, 1024, 1024, 0, 0, E); } break;
        case OP_HG_A: if (EN(OP_HG_A)) hg_pass_a(p, lds, j); break;
        case OP_HG_B: if (EN(OP_HG_B)) hg_pass_b(p); break;
        case OP_HG_C: if (EN(OP_HG_C)) hg_pass_c(p, lds, j); break;
        case OP_MIX_OUT: if (EN(OP_MIX_OUT)) { EpiResid E; E.xin = (l == 0) ? p->x : (const float*)(ws + WS_XRES); E.xout = (float*)(ws + WS_XRES); E.gate = MOD + (size_t)l * 2 * 6144 + 2 * 1024; E.dry = dry;
            const bf16_t* W = (l & 1) ? (const bf16_t*)(ws + WS_LRWOUT) + (size_t)j * 1024 * 1024 : (const bf16_t*)(ws + WS_HGWOUT) + (size_t)j * 1024 * 1024;
            run_gemm(lds, (const bf16_t*)(ws + WS_OB), W, 1024, 1024, 1024, 1024, 0, 0, E); } break;
        case OP_LR_IN: if (EN(OP_LR_IN)) { EpiLruIn E; E.XB = (bf16_t*)(ws + WS_XB); E.YG = (bf16_t*)(ws + WS_YG);
            run_gemm(lds, (const bf16_t*)(ws + WS_HBUF), (const bf16_t*)(ws + WS_LRWIN) + (size_t)j * 2048 * 1024, 2048, 1024, 1024, 1024, 0, 0, E); } break;
        case OP_LR_CONV: if (EN(OP_LR_CONV)) lru_conv(p, j); break;
        case OP_LR_G: if (EN(OP_LR_G)) { EpiGates E; E.LOGA = (bf16_t*)(ws + WS_LOGA); E.BTERM = (bf16_t*)(ws + WS_BTERM); E.XC = (const bf16_t*)(ws + WS_XC);
            E.b_a = p->lru_b_a + (size_t)j * 2048; E.b_x = p->lru_b_x + (size_t)j * 2048; E.lam = p->lru_lam + (size_t)j * 2048;
            run_gemm(lds, (const bf16_t*)(ws + WS_XC), (const bf16_t*)(ws + WS_LRWG) + (size_t)j * 4 * 1024 * 256, 4096, 256, 1024, 256, 2, 512, E); } break;
        case OP_LR_S1: if (EN(OP_LR_S1)) lru_scan1(p, lds); break;
        case OP_LR_S2: if (EN(OP_LR_S2)) lru_scan2(p); break;
        case OP_LR_S3: if (EN(OP_LR_S3)) lru_scan3(p, lds); break;
        case OP_RMS2: if (EN(OP_RMS2)) phase_rms((const float*)(ws + WS_XRES), p->norm_g + ((size_t)l * 2 + 1) * 1024, MOD + (size_t)l * 2 * 6144 + 3 * 1024, MOD + (size_t)l * 2 * 6144 + 4 * 1024, (bf16_t*)(ws + WS_HBUF), ws + WS_HB8); break;
        case OP_QK: if (EN(OP_QK)) { EpiScoresT E; E.C = (float*)(ws + WS_SCORES);
            run_gemm(lds, (const bf16_t*)(ws + WS_HBUF), (const bf16_t*)(ws + WS_WQK) + (size_t)l * 2048 * 1024, 2048, 1024, 1024, 1024, 0, 0, E); } break;
        case OP_TOPK: if (EN(OP_TOPK)) peer_topk(p, lds); break;
        case OP_GATHER: if (EN(OP_GATHER)) peer_gather(p, l, dry); break;
        default: break;
        }
        }
    }
}

extern "C" void kernel_launch(void* const* d_in, const int* in_sizes, int n_in, void* d_out, int out_size, void* d_ws, size_t ws_size, hipStream_t stream) {
    static int grid = 0;
    if (grid == 0) {
        if (n_in != 23 || ws_size < WS_END) { fprintf(stderr, "kernel_launch: unexpected n_in %d / ws_size %zu (need %zu)\n", n_in, ws_size, (size_t)WS_END); grid = -1; return; }
        int dev = 0, cus = 0, per_cu = 0;
        hipGetDevice(&dev); hipDeviceGetAttribute(&cus, hipDeviceAttributeMultiprocessorCount, dev);
        if (hipFuncSetAttribute((const void*)mk_fwd, hipFuncAttributeMaxDynamicSharedMemorySize, LDS_BYTES) != hipSuccess) { fprintf(stderr, "kernel_launch: hipFuncSetAttribute failed\n"); grid = -1; return; }
        if (hipOccupancyMaxActiveBlocksPerMultiprocessor(&per_cu, (const void*)mk_fwd, NTHR, LDS_BYTES) != hipSuccess || per_cu < 1) { fprintf(stderr, "kernel_launch: occupancy query failed (%d)\n", per_cu); (void)hipGetLastError(); per_cu = 1; }
        grid = cus * 1;
        fprintf(stderr, "kernel_launch: cus %d per_cu %d grid %d\n", cus, per_cu, grid);
    }
    if (grid < 0) return;
    if (hipMemsetAsync((char*)d_ws + WS_CTL, 0, 65536, stream) != hipSuccess) { fprintf(stderr, "kernel_launch: memset failed\n"); return; }
    Params p{};
    const float** pp = (const float**)&p;
    for (int i = 0; i < 23; ++i) pp[i] = (const float*)d_in[i];
    p.out = (float*)d_out; p.ws = (unsigned char*)d_ws; p.ph_lo = 0; p.ph_hi = NPH; p.rep_mask = REP_MASK;
    void* args[] = {&p};
    hipError_t e = hipLaunchCooperativeKernel((const void*)mk_fwd, dim3(grid), dim3(NTHR), args, LDS_BYTES, stream);
    if (e != hipSuccess) fprintf(stderr, "kernel_launch: cooperative launch failed: %s (grid %d)\n", hipGetErrorString(e), grid);
}
```

```cpp
#include <hip/hip_runtime.h>
#include <hip/hip_cooperative_groups.h>
#include <cstdio>
#include <cstdint>
namespace cg = cooperative_groups;

#define LAS __attribute__((address_space(3)))
#define PG8_LAS __attribute__((address_space(3)))
typedef unsigned short bf16_t;
typedef short bf16x8 __attribute__((ext_vector_type(8)));
typedef float f32x4 __attribute__((ext_vector_type(4)));
typedef float f32x2 __attribute__((ext_vector_type(2)));
typedef unsigned u32x4 __attribute__((ext_vector_type(4)));
typedef unsigned u32x2 __attribute__((ext_vector_type(2)));
typedef int v8i __attribute__((ext_vector_type(8)));

constexpr int T = 16384, D = 1024, SEQ = 8192, DEPTH = 4;
constexpr float EPS = 1e-6f;
constexpr int NBLK = 256, NTHR = 512, NWAVE = 8, NGW = NBLK * NWAVE;

constexpr size_t MiB = 1u << 20;
constexpr size_t WS_CTL = 0;
constexpr size_t WS_MOD = 1 * MiB;
constexpr size_t WS_HGWIN = 2 * MiB;
constexpr size_t WS_HGWOUT = 22 * MiB;
constexpr size_t WS_LRWIN = 26 * MiB;
constexpr size_t WS_LRWG = 34 * MiB;
constexpr size_t WS_LRWOUT = 38 * MiB;
constexpr size_t WS_WQK = 42 * MiB;
constexpr size_t WS_TOPI = 58 * MiB;
constexpr size_t WS_TOPG = 66 * MiB;
constexpr size_t WS_DEC = 74 * MiB;
constexpr size_t WS_CP = 75 * MiB;
constexpr size_t WS_CH = 79 * MiB;
constexpr size_t WS_HIN = 83 * MiB;
constexpr size_t WS_USC = 87 * MiB;
constexpr size_t WS_VSC = 87 * MiB + 262144;
constexpr size_t WS_XRES = 88 * MiB;
constexpr size_t WS_HBUF = 152 * MiB;
constexpr size_t WS_OB = 184 * MiB;
constexpr size_t WS_PROJ = 216 * MiB;
constexpr size_t WS_XB = WS_PROJ, WS_YG = WS_PROJ + 32 * MiB, WS_XC = WS_PROJ + 64 * MiB, WS_LOGA = WS_PROJ + 96 * MiB;
constexpr size_t WS_SCORES = WS_PROJ;
constexpr size_t WS_KV = 376 * MiB;
constexpr size_t WS_BTERM = WS_KV;
constexpr size_t WS_SIN = 504 * MiB;
constexpr size_t WS_UTAB = 568 * MiB;
constexpr size_t WS_VTAB = 696 * MiB;
constexpr size_t WS_HB8 = 824 * MiB;
constexpr size_t WS_END = 840 * MiB;

constexpr int LDS_BYTES = 155648;

#define LAUNDER_IDS int tidL = threadIdx.x, bidL = blockIdx.x; asm volatile("" : "+v"(tidL)); asm volatile("" : "+s"(bidL));
__device__ __forceinline__ float bf2f(bf16_t b) { return __uint_as_float(((unsigned)b) << 16); }
__device__ __forceinline__ float bflo(unsigned u) { return __uint_as_float(u << 16); }
__device__ __forceinline__ float bfhi(unsigned u) { return __uint_as_float(u & 0xffff0000u); }
__device__ __forceinline__ unsigned cvt_pk_bf16(float lo, float hi) { unsigned r; asm volatile("v_cvt_pk_bf16_f32 %0, %1, %2" : "=v"(r) : "v"(lo), "v"(hi)); return r; }
__device__ __forceinline__ bf16_t f2bf(float f) { return (bf16_t)(cvt_pk_bf16(f, 0.f) & 0xffffu); }
__device__ __forceinline__ float fast_exp(float x) { return __builtin_amdgcn_exp2f(x * 1.4426950408889634f); }
__device__ __forceinline__ float fast_log(float x) { return __builtin_amdgcn_logf(x) * 0.6931471805599453f; }
__device__ __forceinline__ float fast_rcp(float x) { return __builtin_amdgcn_rcpf(x); }
__device__ __forceinline__ float sigmoidf_(float x) { return fast_rcp(1.f + fast_exp(-x)); }
__device__ __forceinline__ float gelu_tanh(float x) { const float u = 1.5957691216057308f * (x + 0.044715f * x * x * x); return x * fast_rcp(1.f + fast_exp(-u)); }
__device__ __forceinline__ float silu_(float x) { return x * sigmoidf_(x); }
__device__ __forceinline__ float wave_sum(float v) {
#pragma unroll
    for (int o = 1; o < 64; o <<= 1) v += __shfl_xor(v, o);
    return v;
}
__device__ __forceinline__ float wave_max(float v) {
#pragma unroll
    for (int o = 1; o < 64; o <<= 1) v = fmaxf(v, __shfl_xor(v, o));
    return v;
}

namespace pg8 {
constexpr int BM = 256, BK = 64, HALF = 128, HTB = HALF * BK * 2, STAGE_BYTES = 8 * HTB, NXCD = 8, WGM = 8;
__host__ __device__ __forceinline__ int lds_byte(int r, int c) { const int st = (r >> 4) * 2 + (c >> 5), rr = r & 15, cc = c & 31, ob = rr * 64 + cc * 2; return st * 1024 + (ob ^ (((ob >> 9) & 1) << 5)); }
__host__ __device__ __forceinline__ void stage_rc(int b, int& R, int& C) { const int st = b / 1024, sb = b % 1024, swz = sb ^ (((sb >> 9) & 1) << 5); R = (st >> 1) * 16 + swz / 64; C = (st & 1) * 32 + (swz % 64) / 2; }
__host__ __device__ __forceinline__ int perm32(int rho) { const int n = rho >> 4, i = rho & 15; return 8 * (i >> 2) + 4 * n + (i & 3); }
struct Unit { int pm, pn; };
struct Gemm { const bf16_t* A; const bf16_t* Bt; int M, N, K, lda, ldb, a_pn_shift, a_pn_stride; };
struct StaticOrder {
    int nM, nN, nwg, G, c;
    __host__ __device__ void init(int M, int N, int G_, int c_) { nM = M / BM; nN = N / BM; nwg = nM * nN; G = G_; c = c_; }
    __host__ __device__ bool next(int i, Unit& u) const {
        const long L = (long)i * G + c; if (L >= nwg) return false;
        int wgid = (int)L; { const int q = nwg / NXCD, r = nwg % NXCD, xcd = wgid % NXCD, off = wgid / NXCD; wgid = (xcd < r ? xcd * (q + 1) : r * (q + 1) + (xcd - r) * q) + off; }
        const int nig = WGM * nN, gid = wgid / nig, fm = gid * WGM, gsz = (nM - fm) < WGM ? (nM - fm) : WGM;
        u.pm = fm + ((wgid % nig) % gsz); u.pn = (wgid % nig) / gsz; return true;
    }
    __device__ __forceinline__ void a_ready(const Unit&) const {}
    __device__ __forceinline__ void done(const Unit&) const {}
};
template <class Epi, class Sched, bool STAMP = false>
__device__ __forceinline__ void gemm_phase(PG8_LAS unsigned char* lds, const Gemm g, const Sched& S, const Epi& E, unsigned long long* stamps) {
    int tid = threadIdx.x; asm volatile("" : "+v"(tid)); const int wid = __builtin_amdgcn_readfirstlane(tid >> 6), lane = tid & 63, wr = wid >> 2, wc = wid & 3, fr = lane & 15, fq = lane >> 4;
    const int K = g.K, nt = K / BK;
    int ts_lo = 0, ts_hi = 0, nts = 0; const unsigned long long rt_entry = STAMP ? (unsigned long long)wall_clock64() : 0ull;
#define PG8_STAMP() do { if (STAMP && wid == 0 && nts < 64) { const unsigned long long _c = (unsigned long long)clock64(); \
        ts_lo = (lane == nts) ? (int)(unsigned)_c : ts_lo; ts_hi = (lane == nts) ? (int)(unsigned)(_c >> 32) : ts_hi; ++nts; } } while (0)
    PG8_STAMP();
    unsigned voffA[2], voffB[2];
#pragma unroll
    for (int i = 0; i < 2; ++i) { int R, C; stage_rc(tid * 16 + i * 8192, R, C); const int Rb = Epi::PERM ? ((R & ~31) + perm32(R & 31)) : R;
        voffA[i] = (unsigned)(R * g.lda + C) * 2u; voffB[i] = (unsigned)(Rb * g.ldb + C) * 2u; }
    const size_t kstep = (size_t)(BK * 2);
    const size_t hstepA = (size_t)HALF * g.lda * 2, hstepB = (size_t)HALF * g.ldb * 2;
    const size_t tstepA = 2 * hstepA, tstepB = 2 * hstepB;
    const unsigned ldsw = (unsigned)wid * 1024u;
    const int aoff = lds_byte(wr * 64 + fr, fq * 8), boff = lds_byte(wc * 32 + fr, fq * 8);
#define PG8_SA(b, h) (((b) * 2 + (h)) * HTB)
#define PG8_SB(b, h) ((4 + (b) * 2 + (h)) * HTB)
#define PG8_STAGE(bufoff, gbase, voff) do { _Pragma("unroll") for (int _i = 0; _i < 2; ++_i) \
        __builtin_amdgcn_global_load_lds((const unsigned*)((const char*)(gbase) + (voff)[_i]), (PG8_LAS unsigned*)(lds + (bufoff) + ldsw + _i * 8192), 16, 0, 0); } while (0)
#define PG8_LDA(dst, b, h) do { _Pragma("unroll") for (int m = 0; m < 4; ++m) _Pragma("unroll") for (int k = 0; k < 2; ++k) dst[m][k] = *(const PG8_LAS bf16x8*)(lds + PG8_SA(b, h) + aoff + m * 2048 + k * 1024); } while (0)
#define PG8_LDB(dst, b, h) do { _Pragma("unroll") for (int n = 0; n < 2; ++n) _Pragma("unroll") for (int k = 0; k < 2; ++k) dst[n][k] = *(const PG8_LAS bf16x8*)(lds + PG8_SB(b, h) + boff + n * 2048 + k * 1024); } while (0)
#define PG8_MMA(ai, bj, At, Bt) do { __builtin_amdgcn_s_setprio(1); _Pragma("unroll") for (int m = 0; m < 4; ++m) _Pragma("unroll") for (int n = 0; n < 2; ++n) _Pragma("unroll") for (int k = 0; k < 2; ++k) \
        acc[ai][bj][m][n] = Epi::SWAP ? __builtin_amdgcn_mfma_f32_16x16x32_bf16(At[m][k], Bt[n][k], acc[ai][bj][m][n], 0, 0, 0) : __builtin_amdgcn_mfma_f32_16x16x32_bf16(Bt[n][k], At[m][k], acc[ai][bj][m][n], 0, 0, 0); __builtin_amdgcn_s_setprio(0); } while (0)
#define PG8_WAIT_V(n) asm volatile("s_waitcnt vmcnt(" #n ")" ::: "memory")
#define PG8_WAIT_L(n) asm volatile("s_waitcnt lgkmcnt(" #n ")" ::: "memory")
#define PG8_BAR __builtin_amdgcn_s_barrier()
#define PG8_SCHED __builtin_amdgcn_sched_barrier(0)
    Unit cur, nxt; int ui = 0;
    if (!S.next(0, cur)) return;
    f32x4 acc[2][2][4][2];
#pragma unroll
    for (int a = 0; a < 2; ++a)
#pragma unroll
        for (int b = 0; b < 2; ++b)
#pragma unroll
            for (int m = 0; m < 4; ++m)
#pragma unroll
                for (int n = 0; n < 2; ++n) acc[a][b][m][n] = (f32x4){0.f, 0.f, 0.f, 0.f};
    bf16x8 At[4][2], B0[2][2], B1[2][2];
    const char* cA = (const char*)g.A + (size_t)cur.pm * tstepA + (size_t)(cur.pn >> g.a_pn_shift) * g.a_pn_stride; const char* cB = (const char*)g.Bt + (size_t)cur.pn * tstepB;
    S.a_ready(cur);
    PG8_STAGE(PG8_SB(0, 0), cB, voffB); PG8_STAGE(PG8_SA(0, 0), cA, voffA); PG8_STAGE(PG8_SB(0, 1), cB + hstepB, voffB); PG8_STAGE(PG8_SA(0, 1), cA + hstepA, voffA);
    if (wr == 1) PG8_BAR;
    PG8_WAIT_V(4); PG8_BAR;
    PG8_STAGE(PG8_SB(1, 0), cB + kstep, voffB); PG8_STAGE(PG8_SA(1, 0), cA + kstep, voffA); PG8_STAGE(PG8_SB(1, 1), cB + hstepB + kstep, voffB);
    PG8_WAIT_V(6); PG8_BAR;
    PG8_STAMP();
    for (;;) {
        const bool has_next = S.next(ui + 1, nxt);
        const char* nA = has_next ? (const char*)g.A + (size_t)nxt.pm * tstepA + (size_t)(nxt.pn >> g.a_pn_shift) * g.a_pn_stride : cA; const char* nB = has_next ? (const char*)g.Bt + (size_t)nxt.pn * tstepB : cB;
#pragma unroll 1
        for (int t = 0; t < nt; t += 2) {
            const bool last = (t == nt - 2);
            const char* a1 = cA + (size_t)(t + 1) * kstep;
            const char* a2 = last ? nA : cA + (size_t)(t + 2) * kstep; const char* b2 = last ? nB : cB + (size_t)(t + 2) * kstep;
            const char* a3 = a2 + kstep; const char* b3 = b2 + kstep;
            if (last && has_next) S.a_ready(nxt);
            PG8_LDB(B0, 0, 0); PG8_SCHED; PG8_LDA(At, 0, 0); PG8_STAGE(PG8_SA(1, 1), a1 + hstepA, voffA);
            PG8_WAIT_L(8); PG8_BAR; PG8_WAIT_L(0); PG8_MMA(0, 0, At, B0); PG8_BAR; PG8_SCHED;
            PG8_LDB(B1, 0, 1); PG8_STAGE(PG8_SB(0, 0), b2, voffB);
            PG8_BAR; PG8_WAIT_L(0); PG8_MMA(0, 1, At, B1); PG8_BAR;
            PG8_LDA(At, 0, 1); PG8_STAGE(PG8_SA(0, 0), a2, voffA);
            PG8_BAR; PG8_WAIT_L(0); PG8_MMA(1, 0, At, B0); PG8_BAR; PG8_SCHED;
            PG8_STAGE(PG8_SB(0, 1), b2 + hstepB, voffB);
            PG8_WAIT_V(6); PG8_BAR; PG8_MMA(1, 1, At, B1); PG8_BAR;
            PG8_LDB(B0, 1, 0); PG8_SCHED; PG8_LDA(At, 1, 0); PG8_STAGE(PG8_SA(0, 1), a2 + hstepA, voffA);
            PG8_WAIT_L(8); PG8_BAR; PG8_WAIT_L(0); PG8_MMA(0, 0, At, B0); PG8_BAR; PG8_SCHED;
            PG8_LDB(B1, 1, 1); PG8_STAGE(PG8_SB(1, 0), b3, voffB);
            PG8_BAR; PG8_WAIT_L(0); PG8_MMA(0, 1, At, B1); PG8_BAR;
            PG8_LDA(At, 1, 1); PG8_STAGE(PG8_SA(1, 0), a3, voffA);
            PG8_BAR; PG8_WAIT_L(0); PG8_MMA(1, 0, At, B0); PG8_BAR; PG8_SCHED;
            PG8_STAGE(PG8_SB(1, 1), b3 + hstepB, voffB);
            PG8_WAIT_V(6); PG8_BAR; PG8_MMA(1, 1, At, B1); PG8_BAR;
        }
        PG8_STAMP();
        if constexpr (!Epi::AFTER_DRAIN) { E(acc, cur, wr, wc, fr, fq); S.done(cur); }
        PG8_STAMP();
        if (!has_next) break;
#pragma unroll
        for (int a = 0; a < 2; ++a)
#pragma unroll
            for (int b = 0; b < 2; ++b)
#pragma unroll
                for (int m = 0; m < 4; ++m)
#pragma unroll
                    for (int n = 0; n < 2; ++n) acc[a][b][m][n] = (f32x4){0.f, 0.f, 0.f, 0.f};
        cur = nxt; cA = nA; cB = nB; ++ui;
    }
    PG8_WAIT_V(0);
    if (wr == 0) PG8_BAR;
    PG8_BAR;
    if constexpr (Epi::AFTER_DRAIN) { E.fused(acc, cur, wr, wc, fr, fq, lds, wid, lane); S.done(cur); }
    PG8_STAMP();
    if (STAMP && wid == 0) { stamps[lane] = lane < nts ? (((unsigned long long)(unsigned)ts_hi << 32) | (unsigned)ts_lo) : 0ull;
        if (lane == 62) stamps[62] = rt_entry; if (lane == 63) stamps[63] = (unsigned long long)wall_clock64(); }
#undef PG8_STAMP
#undef PG8_SA
#undef PG8_SB
#undef PG8_STAGE
#undef PG8_LDA
#undef PG8_LDB
#undef PG8_MMA
#undef PG8_WAIT_V
#undef PG8_WAIT_L
#undef PG8_BAR
#undef PG8_SCHED
}
}
using pg8::Unit;

struct EpiBf16 {
    static constexpr bool PERM = true, AFTER_DRAIN = false, SWAP = false;
    bf16_t* O; int ldc;
    __device__ __forceinline__ void operator()(const f32x4 (&acc)[2][2][4][2], const Unit& u, int wr, int wc, int fr, int fq) const {
        const int row0 = u.pm * 256 + wr * 64 + fr, col0 = u.pn * 256 + wc * 32 + 8 * fq;
#pragma unroll
        for (int ai = 0; ai < 2; ++ai)
#pragma unroll
            for (int m = 0; m < 4; ++m) { bf16_t* rowp = O + (size_t)(row0 + ai * 128 + m * 16) * ldc + col0;
#pragma unroll
                for (int bj = 0; bj < 2; ++bj) { const f32x4 v0 = acc[ai][bj][m][0], v1 = acc[ai][bj][m][1];
                    u32x4 o; o.x = cvt_pk_bf16(v0[0], v0[1]); o.y = cvt_pk_bf16(v0[2], v0[3]); o.z = cvt_pk_bf16(v1[0], v1[1]); o.w = cvt_pk_bf16(v1[2], v1[3]);
                    *(u32x4*)(rowp + bj * 128) = o; } }
    }
};
struct EpiLruIn {
    static constexpr bool PERM = true, AFTER_DRAIN = false, SWAP = false;
    bf16_t* XB; bf16_t* YG;
    __device__ __forceinline__ void operator()(const f32x4 (&acc)[2][2][4][2], const Unit& u, int wr, int wc, int fr, int fq) const {
        const bool isy = u.pn >= 4;
        bf16_t* O = isy ? YG : XB;
        const int row0 = u.pm * 256 + wr * 64 + fr, col0 = (u.pn & 3) * 256 + wc * 32 + 8 * fq;
#pragma unroll
        for (int ai = 0; ai < 2; ++ai)
#pragma unroll
            for (int m = 0; m < 4; ++m) { bf16_t* rowp = O + (size_t)(row0 + ai * 128 + m * 16) * 1024 + col0;
#pragma unroll
                for (int bj = 0; bj < 2; ++bj) { f32x4 v0 = acc[ai][bj][m][0], v1 = acc[ai][bj][m][1];
                    if (isy) {
#pragma unroll
                        for (int i = 0; i < 4; ++i) { v0[i] = gelu_tanh(v0[i]); v1[i] = gelu_tanh(v1[i]); } }
                    u32x4 o; o.x = cvt_pk_bf16(v0[0], v0[1]); o.y = cvt_pk_bf16(v0[2], v0[3]); o.z = cvt_pk_bf16(v1[0], v1[1]); o.w = cvt_pk_bf16(v1[2], v1[3]);
                    *(u32x4*)(rowp + bj * 128) = o; } }
    }
};
struct EpiGates {
    static constexpr bool PERM = true, AFTER_DRAIN = false, SWAP = false;
    bf16_t* LOGA; bf16_t* BTERM; const bf16_t* XC; const float* b_a; const float* b_x; const float* lam;
    __device__ __forceinline__ void operator()(const f32x4 (&acc)[2][2][4][2], const Unit& u, int wr, int wc, int fr_, int fq) const {
        int fr = fr_; asm volatile("" : "+v"(fr));
        const int nblk = u.pn >> 2, uu = u.pn & 3, d = uu >> 1, jh = uu & 1;
        const int colbase = nblk * 256 + jh * 128 + wc * 32 + 8 * fq;
        const unsigned off0 = (unsigned)(u.pm * 256 + wr * 64 + fr) * 1024u + (unsigned)colbase;
        const bf16_t* xcp = XC; bf16_t* lap = LOGA + (size_t)d * T * 1024; bf16_t* btp = BTERM + (size_t)d * T * 1024;
        const float* bap = b_a + d * 1024; const float* bxp = b_x + d * 1024; const float* lmp = lam + d * 1024;
#pragma unroll
        for (int ai = 0; ai < 2; ++ai)
#pragma unroll
            for (int m = 0; m < 4; ++m) { const unsigned off = off0 + (unsigned)(ai * 128 + m * 16) * 1024u;
                asm volatile("" ::: "memory"); __builtin_amdgcn_sched_barrier(0);
                const u32x4 xr = *(const u32x4*)(xcp + off);
                const float xv[8] = {bflo(xr.x), bfhi(xr.x), bflo(xr.y), bfhi(xr.y), bflo(xr.z), bfhi(xr.z), bflo(xr.w), bfhi(xr.w)};
                unsigned o1[4], o2[4];
#pragma unroll
                for (int n = 0; n < 2; ++n) { const f32x4 ba = *(const f32x4*)(bap + (unsigned)(colbase + 4 * n)), bx = *(const f32x4*)(bxp + (unsigned)(colbase + 4 * n)), lm = *(const f32x4*)(lmp + (unsigned)(colbase + 4 * n));
                    float la[4], bt[4];
#pragma unroll
                    for (int i = 0; i < 4; ++i) { const float r = sigmoidf_(acc[ai][0][m][n][i] + ba[i]), ig = sigmoidf_(acc[ai][1][m][n][i] + bx[i]);
                        const float l = -8.f * fast_log(1.f + fast_exp(-lm[i])) * r; const float mult = __builtin_sqrtf(fmaxf(1.f - fast_exp(2.f * l), 0.f));
                        la[i] = l; bt[i] = mult * ig * xv[n * 4 + i]; }
                    o1[n * 2] = cvt_pk_bf16(la[0], la[1]); o1[n * 2 + 1] = cvt_pk_bf16(la[2], la[3]); o2[n * 2] = cvt_pk_bf16(bt[0], bt[1]); o2[n * 2 + 1] = cvt_pk_bf16(bt[2], bt[3]); }
                *(u32x4*)(lap + off) = (u32x4){o1[0], o1[1], o1[2], o1[3]}; *(u32x4*)(btp + off) = (u32x4){o2[0], o2[1], o2[2], o2[3]}; }
    }
};
struct EpiResid {
    static constexpr bool PERM = false, AFTER_DRAIN = false, SWAP = false;
    const float* xin; float* xout; const float* gate; bool dry;
    __device__ __forceinline__ void operator()(const f32x4 (&acc)[2][2][4][2], const Unit& u, int wr, int wc, int fr, int fq) const {
        const int row0 = u.pm * 256 + wr * 64 + fr, col0 = u.pn * 256 + wc * 32 + 4 * fq;
        const float* gp = gate + ((u.pm * 256) >> 13) * 6144 + col0;
        f32x4 gv[2][2];
#pragma unroll
        for (int bj = 0; bj < 2; ++bj)
#pragma unroll
            for (int n = 0; n < 2; ++n) gv[bj][n] = *(const f32x4*)(gp + bj * 128 + n * 16);
#pragma unroll
        for (int ai = 0; ai < 2; ++ai)
#pragma unroll
            for (int m = 0; m < 4; ++m) { const size_t off = (size_t)(row0 + ai * 128 + m * 16) * 1024 + col0;
#pragma unroll
                for (int bj = 0; bj < 2; ++bj)
#pragma unroll
                    for (int n = 0; n < 2; ++n) { const f32x4 xv = *(const f32x4*)(xin + off + bj * 128 + n * 16);
                        if (!dry) *(f32x4*)(xout + off + bj * 128 + n * 16) = xv + gv[bj][n] * acc[ai][bj][m][n]; } }
    }
};
struct EpiF32 {
    static constexpr bool PERM = false, AFTER_DRAIN = false, SWAP = false;
    float* C; int ldc;
    __device__ __forceinline__ void operator()(const f32x4 (&acc)[2][2][4][2], const Unit& u, int wr, int wc, int fr_, int fq) const {
        int fr = fr_; asm volatile("" : "+v"(fr));
        const int row0 = u.pm * 256 + wr * 64 + fr, col0 = u.pn * 256 + wc * 32 + 4 * fq;
#pragma unroll
        for (int ai = 0; ai < 2; ++ai)
#pragma unroll
            for (int m = 0; m < 4; ++m) { float* rowp = C + (size_t)(row0 + ai * 128 + m * 16) * ldc + col0;
#pragma unroll
                for (int bj = 0; bj < 2; ++bj)
#pragma unroll
                    for (int n = 0; n < 2; ++n) *(f32x4*)(rowp + bj * 128 + n * 16) = acc[ai][bj][m][n]; }
    }
};

struct Params {
    const float *x, *c, *w_ada, *b_ada, *norm_g, *hg_w_in, *hg_lb, *hg_norm_g, *hg_w_out, *lru_w_in, *lru_conv_w, *lru_conv_b,
        *lru_w_a, *lru_b_a, *lru_w_x, *lru_b_x, *lru_lam, *lru_w_out, *peer_w_q, *peer_keys, *peer_u, *peer_v, *final_g;
    float* out; unsigned char* ws; int ph_lo, ph_hi; unsigned rep_mask; int pad_;
};

typedef const __attribute__((address_space(4))) Params* KP;

template <class Epi>
__device__ __forceinline__ void run_gemm(LAS unsigned char* lds, const bf16_t* A, const bf16_t* Bt, int N, int K, int lda, int ldb, int a_pn_shift, int a_pn_stride, const Epi& E) {
    pg8::Gemm g; g.A = A; g.Bt = Bt; g.M = T; g.N = N; g.K = K; g.lda = lda; g.ldb = ldb; g.a_pn_shift = a_pn_shift; g.a_pn_stride = a_pn_stride;
    LAUNDER_IDS
    pg8::StaticOrder S; S.init(T, N, (int)gridDim.x, bidL); (void)tidL;
    pg8::gemm_phase<Epi, pg8::StaticOrder, false>(lds, g, S, E, nullptr);
    __syncthreads();
}

__device__ __forceinline__ void transpose_tile(const float* __restrict__ src, int ld_src, bf16_t* dst, int ld_dst, LAS float* tile, int tid) {
#pragma unroll
    for (int it = 0; it < 2; ++it) { const int r = (tid >> 4) + 32 * it, c4 = (tid & 15) * 4;
        const f32x4 v = *(const f32x4*)(src + (size_t)r * ld_src + c4);
        tile[r * 65 + c4 + 0] = v[0]; tile[r * 65 + c4 + 1] = v[1]; tile[r * 65 + c4 + 2] = v[2]; tile[r * 65 + c4 + 3] = v[3]; }
    __syncthreads();
    { const int n = tid >> 3, kc = tid & 7; const LAS float* s = tile + (kc * 8) * 65 + n;
        u32x4 o; o.x = cvt_pk_bf16(s[0], s[65]); o.y = cvt_pk_bf16(s[2 * 65], s[3 * 65]); o.z = cvt_pk_bf16(s[4 * 65], s[5 * 65]); o.w = cvt_pk_bf16(s[6 * 65], s[7 * 65]);
        *(u32x4*)(dst + (size_t)n * ld_dst + kc * 8) = o; }
    __syncthreads();
}

__device__ __forceinline__ void phase0(KP p, LAS unsigned char* lds) {
    LAUNDER_IDS
    const int tid = tidL, wave = tid >> 6, lane = tid & 63;
    unsigned char* ws = p->ws;
    LAS float* tile = (LAS float*)lds;
    constexpr int I_HGIN = 16 * 80, I_SQ = 16 * 16, I_LRIN = 16 * 32, I_G = 16;
    constexpr int N_A = 2 * I_HGIN + 2 * I_SQ + 2 * I_LRIN + 2 * I_SQ + 32 * I_G;
    for (int it = bidL; it < N_A; it += gridDim.x) {
        int r = it;
        if (r < 2 * I_HGIN) { const int j = r / I_HGIN, q = r % I_HGIN, kb = q / 80, nb = q % 80;
            transpose_tile(p->hg_w_in + (size_t)j * 1024 * 5120 + (size_t)kb * 64 * 5120 + nb * 64, 5120, (bf16_t*)(ws + WS_HGWIN) + (size_t)j * 5120 * 1024 + (size_t)nb * 64 * 1024 + kb * 64, 1024, tile, tid); continue; }
        r -= 2 * I_HGIN;
        if (r < 2 * I_SQ) { const int j = r / I_SQ, q = r % I_SQ, kb = q / 16, nb = q % 16;
            transpose_tile(p->hg_w_out + (size_t)j * 1024 * 1024 + (size_t)kb * 64 * 1024 + nb * 64, 1024, (bf16_t*)(ws + WS_HGWOUT) + (size_t)j * 1024 * 1024 + (size_t)nb * 64 * 1024 + kb * 64, 1024, tile, tid); continue; }
        r -= 2 * I_SQ;
        if (r < 2 * I_LRIN) { const int j = r / I_LRIN, q = r % I_LRIN, kb = q / 32, nb = q % 32;
            transpose_tile(p->lru_w_in + (size_t)j * 1024 * 2048 + (size_t)kb * 64 * 2048 + nb * 64, 2048, (bf16_t*)(ws + WS_LRWIN) + (size_t)j * 2048 * 1024 + (size_t)nb * 64 * 1024 + kb * 64, 1024, tile, tid); continue; }
        r -= 2 * I_LRIN;
        if (r < 2 * I_SQ) { const int j = r / I_SQ, q = r % I_SQ, kb = q / 16, nb = q % 16;
            transpose_tile(p->lru_w_out + (size_t)j * 1024 * 1024 + (size_t)kb * 64 * 1024 + nb * 64, 1024, (bf16_t*)(ws + WS_LRWOUT) + (size_t)j * 1024 * 1024 + (size_t)nb * 64 * 1024 + kb * 64, 1024, tile, tid); continue; }
        r -= 2 * I_SQ;
        { const int mat = r / I_G, q = r % I_G, kb = q / 4, nb = q % 4;
            const int nblk = mat & 3, gate = (mat >> 2) & 1, d = (mat >> 3) & 1, l = mat >> 4;
            const float* src = (gate ? p->lru_w_x : p->lru_w_a) + (size_t)((l * 2 + d) * 4 + nblk) * 65536 + (size_t)kb * 64 * 256 + nb * 64;
            const int n0 = nb * 64, jh = n0 >> 7;
            bf16_t* dst = (bf16_t*)(ws + WS_LRWG) + (size_t)l * 4 * 1024 * 256 + (size_t)nblk * 1024 * 256 + (size_t)((d * 2 + jh) * 256 + gate * 128 + (n0 & 127)) * 256 + kb * 64;
            transpose_tile(src, 256, dst, 256, tile, tid); }
    }
    {
        LAS float* keysL = (LAS float*)lds;
        LAS float* wqL = (LAS float*)(lds + 128 * 132 * 4);
        for (int it = bidL; it < 1024; it += gridDim.x) {
            const int l = it >> 8, hp = (it >> 4) & 15, dt = it & 15;
            const float* kp = p->peer_keys + ((size_t)l * 16 + hp) * 16384;
#pragma unroll
            for (int q = 0; q < 8; ++q) { const int e = (tid + 512 * q) * 4; const f32x4 v = *(const f32x4*)(kp + e); *(LAS f32x4*)(keysL + (e >> 7) * 132 + (e & 127)) = v; }
            const float* wp = p->peer_w_q + (size_t)l * 1024 * 2048 + (size_t)(dt * 64) * 2048 + hp * 128;
#pragma unroll
            for (int q = 0; q < 4; ++q) { const int e = (tid + 512 * q) * 4; const f32x4 v = *(const f32x4*)(wp + (size_t)(e >> 7) * 2048 + (e & 127)); *(LAS f32x4*)(wqL + e) = v; }
            __syncthreads();
            const int key = tid & 127, g = tid >> 7;
            float acc[16];
#pragma unroll
            for (int i = 0; i < 16; ++i) acc[i] = 0.f;
            for (int d4 = 0; d4 < 128; d4 += 4) {
                const f32x4 kv = *(const LAS f32x4*)(keysL + key * 132 + d4);
#pragma unroll
                for (int i = 0; i < 16; ++i) { const f32x4 wv = *(const LAS f32x4*)(wqL + (g * 16 + i) * 128 + d4);
                    acc[i] += kv[0] * wv[0] + kv[1] * wv[1] + kv[2] * wv[2] + kv[3] * wv[3]; }
            }
            bf16_t* op = (bf16_t*)(ws + WS_WQK) + (size_t)l * 2048 * 1024 + (size_t)(hp * 128 + key) * 1024 + dt * 64 + g * 16;
            u32x4 o1, o2; o1.x = cvt_pk_bf16(acc[0], acc[1]); o1.y = cvt_pk_bf16(acc[2], acc[3]); o1.z = cvt_pk_bf16(acc[4], acc[5]); o1.w = cvt_pk_bf16(acc[6], acc[7]);
            o2.x = cvt_pk_bf16(acc[8], acc[9]); o2.y = cvt_pk_bf16(acc[10], acc[11]); o2.z = cvt_pk_bf16(acc[12], acc[13]); o2.w = cvt_pk_bf16(acc[14], acc[15]);
            *(u32x4*)op = o1; *(u32x4*)(op + 8) = o2;
            __syncthreads();
        }
    }
    {
        LAS float* condL = (LAS float*)lds;
        LAS float* red = (LAS float*)(lds + 8192);
        for (int i = tid; i < 2048; i += NTHR) condL[i] = silu_(p->c[i]);
        __syncthreads();
        for (int it = bidL; it < 4 * 48; it += gridDim.x) {
            const int l = it / 48, col0 = (it % 48) * 128;
            const float* wp = p->w_ada + (size_t)l * 1024 * 6144 + col0 + 2 * lane;
            float a00 = 0.f, a01 = 0.f, a10 = 0.f, a11 = 0.f;
#pragma unroll 8
            for (int kk = 0; kk < 128; ++kk) { const int k = wave * 128 + kk; const f32x2 w = *(const f32x2*)(wp + (size_t)k * 6144);
                const float c0 = condL[k], c1 = condL[1024 + k];
                a00 += c0 * w[0]; a01 += c0 * w[1]; a10 += c1 * w[0]; a11 += c1 * w[1]; }
            red[(wave * 2 + 0) * 128 + 2 * lane] = a00; red[(wave * 2 + 0) * 128 + 2 * lane + 1] = a01;
            red[(wave * 2 + 1) * 128 + 2 * lane] = a10; red[(wave * 2 + 1) * 128 + 2 * lane + 1] = a11;
            __syncthreads();
            if (tid < 256) { const int b = tid >> 7, cc = tid & 127; float s = 0.f;
#pragma unroll
                for (int w = 0; w < 8; ++w) s += red[(w * 2 + b) * 128 + cc];
                ((float*)(ws + WS_MOD))[((size_t)l * 2 + b) * 6144 + col0 + cc] = s + p->b_ada[(size_t)l * 6144 + col0 + cc]; }
            __syncthreads();
        }
    }
    {
        const int nw = gridDim.x * NWAVE;
        for (int row0 = bidL * NWAVE + wave; row0 < 2 * 65536; row0 += 4 * nw) {
            f32x4 v[4][4];
#pragma unroll
            for (int rr = 0; rr < 4; ++rr) { const int row = row0 + rr * nw; const int tb = row >> 16, r = row & 65535;
                const float* src = (tb ? p->peer_v : p->peer_u) + (size_t)r * 1024 + 4 * lane;
#pragma unroll
                for (int jx = 0; jx < 4; ++jx) v[rr][jx] = __builtin_nontemporal_load((const f32x4*)(src + 256 * jx)); }
#pragma unroll
            for (int rr = 0; rr < 4; ++rr) { const int row = row0 + rr * nw; const int tb = row >> 16, r = row & 65535;
                float am = 0.f;
#pragma unroll
                for (int jx = 0; jx < 4; ++jx) am = fmaxf(am, fmaxf(fmaxf(fabsf(v[rr][jx][0]), fabsf(v[rr][jx][1])), fmaxf(fabsf(v[rr][jx][2]), fabsf(v[rr][jx][3]))));
                am = wave_max(am);
                const float sc = am > 0.f ? am * (1.f / 6.f) : 1.f, inv = am > 0.f ? 6.f / am : 1.f;
                unsigned char* dst = ws + (tb ? WS_VTAB : WS_UTAB) + (size_t)r * 512 + 2 * lane;
#pragma unroll
                for (int jx = 0; jx < 4; ++jx) { unsigned w = __builtin_amdgcn_cvt_scalef32_pk_fp4_f32(0u, v[rr][jx][0] * inv, v[rr][jx][1] * inv, 1.0f, 0);
                    w = __builtin_amdgcn_cvt_scalef32_pk_fp4_f32(w, v[rr][jx][2] * inv, v[rr][jx][3] * inv, 1.0f, 1);
                    *(unsigned short*)(dst + 128 * jx) = (unsigned short)(w & 0xffffu); }
                if (lane == 0) ((float*)(ws + (tb ? WS_VSC : WS_USC)))[r] = sc; }
        }
    }
}

__device__ __forceinline__ void phase_rms(const float* xin, const float* gain, const float* shift, const float* scale, bf16_t* hout, unsigned char* h8out) {
    LAUNDER_IDS
    const int tid = tidL, wave = tid >> 6, lane = tid & 63;
    const int nw = gridDim.x * NWAVE;
    for (int row0 = bidL * NWAVE + wave; row0 < T; row0 += 2 * nw) {
        f32x4 v[2][4]; float ss[2];
#pragma unroll
        for (int rr = 0; rr < 2; ++rr) { const int row = min(row0 + rr * nw, T - 1); const float* xr = xin + (size_t)row * 1024 + lane * 4;
#pragma unroll
            for (int j = 0; j < 4; ++j) v[rr][j] = *(const f32x4*)(xr + j * 256); }
#pragma unroll
        for (int rr = 0; rr < 2; ++rr) { float a = 0.f;
#pragma unroll
            for (int j = 0; j < 4; ++j) a += v[rr][j][0] * v[rr][j][0] + v[rr][j][1] * v[rr][j][1] + v[rr][j][2] * v[rr][j][2] + v[rr][j][3] * v[rr][j][3];
            ss[rr] = a; }
#pragma unroll
        for (int o = 1; o < 64; o <<= 1) { ss[0] += __shfl_xor(ss[0], o); ss[1] += __shfl_xor(ss[1], o); }
#pragma unroll
        for (int rr = 0; rr < 2; ++rr) { const int row = row0 + rr * nw; if (row >= T) continue; const int b = row >> 13;
            const float inv = __builtin_amdgcn_rsqf(ss[rr] * (1.f / 1024.f) + EPS);
#pragma unroll
            for (int j = 0; j < 4; ++j) { const int col = j * 256 + lane * 4;
                const f32x4 g = *(const f32x4*)(gain + col), sh = *(const f32x4*)(shift + b * 6144 + col), sc = *(const f32x4*)(scale + b * 6144 + col);
                const f32x4 y = (v[rr][j] * inv) * g * (1.f + sc) + sh;
                u32x2 o; o.x = cvt_pk_bf16(y[0], y[1]); o.y = cvt_pk_bf16(y[2], y[3]);
                *(u32x2*)(hout + (size_t)row * 1024 + col) = o;
                if (h8out) { int w8 = __builtin_amdgcn_cvt_pk_fp8_f32(y[0], y[1], 0, false); w8 = __builtin_amdgcn_cvt_pk_fp8_f32(y[2], y[3], w8, true); *(int*)(h8out + (size_t)row * 1024 + col) = w8; } } }
    }
}

constexpr int LROW = 136;
__device__ __forceinline__ float hg_lower_bound(const float* hg_lb, int j, int col) {
    if (j == 0) return 0.f;
    const float l0 = hg_lb[col], l1 = hg_lb[1024 + col];
    return fast_rcp(1.f + fast_exp(l0 - l1));
}
__device__ __forceinline__ f32x4 mfma16(bf16x8 a, bf16x8 b, f32x4 c) { return __builtin_amdgcn_mfma_f32_16x16x32_bf16(a, b, c, 0, 0, 0); }

__device__ __forceinline__ void load_v_regs(const bf16_t* proj, u32x4 (&vr)[4], int t0, int dir, int h, int tid) {
#pragma unroll
    for (int it = 0; it < 4; ++it) { const int idx = tid + 512 * it, tau = idx & 127, cv = idx >> 7;
        const int tok = dir ? t0 + 127 - tau : t0 + tau;
        vr[it] = *(const u32x4*)(proj + (size_t)tok * 5120 + 3072 + h * 128 + cv * 8); }
}
__device__ __forceinline__ void store_vt(LAS bf16_t* VT, const u32x4 (&vr)[4], int tid) {
#pragma unroll
    for (int it = 0; it < 4; ++it) { const int idx = tid + 512 * it, tau = idx & 127, cv = idx >> 7; const u32x4 v = vr[it];
        LAS bf16_t* d = VT + (cv * 8) * LROW + tau;
        d[0 * LROW] = (bf16_t)(v.x & 0xffff); d[1 * LROW] = (bf16_t)(v.x >> 16); d[2 * LROW] = (bf16_t)(v.y & 0xffff); d[3 * LROW] = (bf16_t)(v.y >> 16);
        d[4 * LROW] = (bf16_t)(v.z & 0xffff); d[5 * LROW] = (bf16_t)(v.z >> 16); d[6 * LROW] = (bf16_t)(v.w & 0xffff); d[7 * LROW] = (bf16_t)(v.w >> 16); }
}
__device__ __forceinline__ void load_tile_regs(const bf16_t* proj, u32x4 (&r)[4], int t0, int dir, int col0, int tid) {
#pragma unroll
    for (int it = 0; it < 4; ++it) { const int idx = tid + 512 * it, tau = idx >> 4, c16 = idx & 15;
        const int tok = dir ? t0 + 127 - tau : t0 + tau;
        r[it] = *(const u32x4*)(proj + (size_t)tok * 5120 + col0 + c16 * 8); }
}
__device__ __forceinline__ void store_tile(LAS bf16_t* TL, const u32x4 (&r)[4], int tid) {
#pragma unroll
    for (int it = 0; it < 4; ++it) { const int idx = tid + 512 * it, tau = idx >> 4, c16 = idx & 15; *(LAS u32x4*)(TL + tau * LROW + c16 * 8) = r[it]; }
}

__device__ __forceinline__ void hg_pass_a(KP p, LAS unsigned char* lds, int j) {
    LAUNDER_IDS
    const bf16_t* proj = (const bf16_t*)(p->ws + WS_PROJ);
    float* KV = (float*)(p->ws + WS_KV); float* DEC = (float*)(p->ws + WS_DEC);
    LAS bf16_t* VT = (LAS bf16_t*)lds; LAS bf16_t* KT = (LAS bf16_t*)(lds + 34816); LAS float* TOT = (LAS float*)(lds + 69632); LAS bf16_t* ZT = (LAS bf16_t*)(lds + 71680);
    for (int u = bidL; u < 2048; u += gridDim.x) {
        int tid = tidL; asm volatile("" : "+v"(tid));
        const int wave = tid >> 6, lane = tid & 63;
        const int seq = u >> 6, c = u & 63, dir = seq & 1, h = (seq >> 1) & 7, b = seq >> 4;
        const int t0 = b * SEQ + c * 128;
        const int dk = tid & 127, g = tid >> 7;
        const float lb = hg_lower_bound(p->hg_lb, j, h * 128 + dk);
        float lcs[32], kks[32]; float lc = 0.f;
        { u32x4 zr[4], vr[4];
            load_tile_regs(proj, zr, t0, dir, 1024 * (1 + dir) + h * 128, tid); load_v_regs(proj, vr, t0, dir, h, tid);
            store_tile(ZT, zr, tid); store_vt(VT, vr, tid); }
        __syncthreads();
#pragma unroll
        for (int q = 0; q < 32; ++q) { const int tau = 32 * g + q;
            const float z = bf2f(ZT[tau * LROW + dk]);
            const float f = lb + (1.f - lb) * sigmoidf_(z);
            lc += fast_log(f); lcs[q] = lc; kks[q] = 1.f - f; }
        TOT[g * 128 + dk] = lc;
        __syncthreads();
        float rg = 0.f, total = 0.f;
#pragma unroll
        for (int gg = 0; gg < 4; ++gg) { const float tv = TOT[gg * 128 + dk]; total += tv; if (gg < g) rg += tv; }
        const float base = total - rg;
#pragma unroll
        for (int q8 = 0; q8 < 4; ++q8) { unsigned w[4];
#pragma unroll
            for (int e = 0; e < 4; ++e) { const int q = q8 * 8 + e * 2;
                w[e] = cvt_pk_bf16(kks[q] * fast_exp(base - lcs[q]), kks[q + 1] * fast_exp(base - lcs[q + 1])); }
            u32x4 o; o.x = w[0]; o.y = w[1]; o.z = w[2]; o.w = w[3];
            *(LAS u32x4*)(KT + dk * LROW + 32 * g + q8 * 8) = o; }
        if (g == 0) DEC[(size_t)u * 128 + dk] = fast_exp(total);
        __syncthreads();
        f32x4 acc[2][4];
#pragma unroll
        for (int a = 0; a < 2; ++a)
#pragma unroll
            for (int bb = 0; bb < 4; ++bb) acc[a][bb] = (f32x4){0.f, 0.f, 0.f, 0.f};
        const int l15 = lane & 15, lq = lane >> 4;
#pragma unroll
        for (int ks = 0; ks < 4; ++ks) {
            bf16x8 af[2], bfr[4];
#pragma unroll
            for (int a = 0; a < 2; ++a) af[a] = *(const LAS bf16x8*)(VT + (((wave & 3) * 2 + a) * 16 + l15) * LROW + ks * 32 + lq * 8);
#pragma unroll
            for (int bb = 0; bb < 4; ++bb) bfr[bb] = *(const LAS bf16x8*)(KT + (((wave >> 2) * 4 + bb) * 16 + l15) * LROW + ks * 32 + lq * 8);
#pragma unroll
            for (int a = 0; a < 2; ++a)
#pragma unroll
                for (int bb = 0; bb < 4; ++bb) acc[a][bb] = mfma16(af[a], bfr[bb], acc[a][bb]);
        }
        float* kvp = KV + (size_t)u * 16384;
#pragma unroll
        for (int a = 0; a < 2; ++a)
#pragma unroll
            for (int bb = 0; bb < 4; ++bb)
#pragma unroll
                for (int r = 0; r < 4; ++r) kvp[(((wave & 3) * 2 + a) * 16 + lq * 4 + r) * 128 + ((wave >> 2) * 4 + bb) * 16 + l15] = acc[a][bb][r];
        __syncthreads();
    }
}

__device__ __forceinline__ void hg_pass_b(KP p) {
    LAUNDER_IDS
    const float* KV = (const float*)(p->ws + WS_KV); const float* DEC = (const float*)(p->ws + WS_DEC);
    bf16_t* SIN = (bf16_t*)(p->ws + WS_SIN);
    for (int e = bidL * NTHR + tidL; e < 131072; e += gridDim.x * NTHR) {
    const int seq = e >> 12, i4 = e & 4095, dir = seq & 1, dk = (i4 * 4) & 127;
    f32x4 S = {0.f, 0.f, 0.f, 0.f};
#pragma unroll 16
    for (int step = 0; step < 64; ++step) {
        const int c = dir ? 63 - step : step; const size_t u = (size_t)seq * 64 + c;
        const f32x4 kv = *(const f32x4*)(KV + u * 16384 + i4 * 4); const f32x4 dc = *(const f32x4*)(DEC + u * 128 + dk);
        u32x2 o; o.x = cvt_pk_bf16(S[0], S[1]); o.y = cvt_pk_bf16(S[2], S[3]);
        *(u32x2*)(SIN + u * 16384 + i4 * 4) = o;
        S = dc * S + kv;
    }
    }
}

__device__ __forceinline__ void hg_pass_c(KP p, LAS unsigned char* lds, int j) {
    LAUNDER_IDS
    const bf16_t* proj = (const bf16_t*)(p->ws + WS_PROJ);
    const bf16_t* SIN = (const bf16_t*)(p->ws + WS_SIN);
    bf16_t* OB = (bf16_t*)(p->ws + WS_OB);
    LAS bf16_t* QT = (LAS bf16_t*)lds; LAS bf16_t* QI = (LAS bf16_t*)(lds + 34816); LAS bf16_t* KT = (LAS bf16_t*)(lds + 69632);
    LAS bf16_t* VT = (LAS bf16_t*)(lds + 104448); LAS bf16_t* PI = (LAS bf16_t*)(lds + 139264); LAS float* TOT = (LAS float*)(lds + 147968);
    LAS float* OSUM = (LAS float*)(lds + 69632);
    for (int u = bidL; u < 1024; u += gridDim.x) {
        int tid = tidL; asm volatile("" : "+v"(tid));
        const int wave = tid >> 6, lane = tid & 63, l15 = lane & 15, lq = lane >> 4;
        const int c = u & 63, h = (u >> 6) & 7, b = u >> 9;
        const int t0 = b * SEQ + c * 128;
        const int dk = tid & 127, g = tid >> 7;
        const float lb = hg_lower_bound(p->hg_lb, j, h * 128 + dk);
        const int tt = wave & 1, dvt0 = (wave >> 1) * 2;
        f32x4 oacc[2][4][2];
#pragma unroll
        for (int dir = 0; dir < 2; ++dir) {
            const size_t su = ((size_t)((b * 8 + h) * 2 + dir) * 64 + c);
            unsigned k0p[16]; float lc = 0.f; float kprev = 0.f;
            u32x4 vr[4];
            { u32x4 zr[4], qr[4];
                load_tile_regs(proj, zr, t0, dir, 1024 * (1 + dir) + h * 128, tid); load_tile_regs(proj, qr, t0, dir, h * 128, tid); load_v_regs(proj, vr, t0, dir, h, tid);
                __syncthreads();
                store_tile(KT, zr, tid); store_tile(VT, qr, tid); }
            __syncthreads();
#pragma unroll
            for (int q = 0; q < 32; ++q) { const int tau = 32 * g + q;
                const float z = bf2f(KT[tau * LROW + dk]), qv = bf2f(VT[tau * LROW + dk]);
                const float f = lb + (1.f - lb) * sigmoidf_(z);
                lc += fast_log(f);
                const float el = fast_exp(fmaxf(lc, -80.f));
                QT[tau * LROW + dk] = f2bf(qv * el);
                const float kcur = (1.f - f) * fast_rcp(el);
                if (q & 1) k0p[q >> 1] = cvt_pk_bf16(kprev, kcur); else kprev = kcur; }
            TOT[g * 128 + dk] = lc;
            __syncthreads();
            float r[4]; { float run = 0.f;
#pragma unroll
                for (int gg = 0; gg < 4; ++gg) { r[gg] = run; run += TOT[gg * 128 + dk]; } }
            float rg = 0.f;
#pragma unroll
            for (int gg = 0; gg < 4; ++gg) if (gg == g) rg = r[gg];
            { const float eg = fast_exp(rg);
#pragma unroll
                for (int q = 0; q < 32; ++q) QI[(32 * g + q) * LROW + dk] = f2bf(bf2f(QT[(32 * g + q) * LROW + dk]) * eg); }
            store_vt(VT, vr, tid);
            bf16x8 sfr[2][4];
#pragma unroll
            for (int n = 0; n < 2; ++n)
#pragma unroll
                for (int ks = 0; ks < 4; ++ks) sfr[n][ks] = *(const bf16x8*)(SIN + su * 16384 + (size_t)((dvt0 + n) * 16 + l15) * 128 + ks * 32 + lq * 8);
#pragma unroll
            for (int i = 0; i < 4; ++i) {
                if (g <= i) { const float e = fast_exp(r[i] - rg);
#pragma unroll
                    for (int q = 0; q < 32; ++q) KT[(32 * g + q) * LROW + dk] = f2bf(((q & 1) ? bfhi(k0p[q >> 1]) : bflo(k0p[q >> 1])) * e); }
                __syncthreads();
                for (int tl = wave; tl < 4 * (i + 1); tl += 8) { const int sm = tl >> 1, tn = tl & 1;
                    f32x4 a4 = {0.f, 0.f, 0.f, 0.f};
#pragma unroll
                    for (int ks = 0; ks < 4; ++ks) { const bf16x8 af = *(const LAS bf16x8*)(KT + (sm * 16 + l15) * LROW + ks * 32 + lq * 8);
                        const bf16x8 bq = *(const LAS bf16x8*)(QT + (32 * i + tn * 16 + l15) * LROW + ks * 32 + lq * 8);
                        a4 = mfma16(af, bq, a4); }
                    const int tloc = tn * 16 + l15, s0 = sm * 16 + lq * 4, tg = 32 * i + tloc;
                    u32x2 o; o.x = cvt_pk_bf16(s0 + 0 <= tg ? a4[0] : 0.f, s0 + 1 <= tg ? a4[1] : 0.f); o.y = cvt_pk_bf16(s0 + 2 <= tg ? a4[2] : 0.f, s0 + 3 <= tg ? a4[3] : 0.f);
                    *(LAS u32x2*)(PI + tloc * LROW + s0) = o; }
                __syncthreads();
                f32x4 a0 = {0.f, 0.f, 0.f, 0.f}, a1 = {0.f, 0.f, 0.f, 0.f};
                for (int ks = 0; ks <= i; ++ks) { const bf16x8 af = *(const LAS bf16x8*)(PI + (tt * 16 + l15) * LROW + ks * 32 + lq * 8);
                    const bf16x8 b0 = *(const LAS bf16x8*)(VT + ((dvt0 + 0) * 16 + l15) * LROW + ks * 32 + lq * 8);
                    const bf16x8 b1 = *(const LAS bf16x8*)(VT + ((dvt0 + 1) * 16 + l15) * LROW + ks * 32 + lq * 8);
                    a0 = mfma16(af, b0, a0); a1 = mfma16(af, b1, a1); }
#pragma unroll
                for (int ks = 0; ks < 4; ++ks) { const bf16x8 af = *(const LAS bf16x8*)(QI + (32 * i + tt * 16 + l15) * LROW + ks * 32 + lq * 8);
                    a0 = mfma16(af, sfr[0][ks], a0); a1 = mfma16(af, sfr[1][ks], a1); }
                oacc[dir][i][0] = a0; oacc[dir][i][1] = a1;
            }
        }
        __syncthreads();
#pragma unroll
        for (int i = 0; i < 4; ++i)
#pragma unroll
            for (int n = 0; n < 2; ++n)
#pragma unroll
                for (int rr = 0; rr < 4; ++rr) OSUM[(32 * i + tt * 16 + lq * 4 + rr) * 132 + (dvt0 + n) * 16 + l15] = oacc[0][i][n][rr];
        __syncthreads();
#pragma unroll
        for (int i = 0; i < 4; ++i)
#pragma unroll
            for (int n = 0; n < 2; ++n)
#pragma unroll
                for (int rr = 0; rr < 4; ++rr) OSUM[(127 - (32 * i + tt * 16 + lq * 4 + rr)) * 132 + (dvt0 + n) * 16 + l15] += oacc[1][i][n][rr];
        __syncthreads();
        { const int row = tid >> 2, part = tid & 3; const int tok = t0 + row;
            float ov[32]; float ss = 0.f;
#pragma unroll
            for (int q = 0; q < 8; ++q) { const f32x4 v = *(const LAS f32x4*)(OSUM + row * 132 + part * 32 + q * 4);
                ov[q * 4 + 0] = v[0]; ov[q * 4 + 1] = v[1]; ov[q * 4 + 2] = v[2]; ov[q * 4 + 3] = v[3]; ss += v[0] * v[0] + v[1] * v[1] + v[2] * v[2] + v[3] * v[3]; }
            ss += __shfl_xor(ss, 1); ss += __shfl_xor(ss, 2);
            const float inv = __builtin_amdgcn_rsqf(ss * (1.f / 128.f) + EPS);
            const int col = h * 128 + part * 32;
            const bf16_t* gp = proj + (size_t)tok * 5120 + 4096 + col; const float* ng = p->hg_norm_g + j * 1024 + col;
#pragma unroll
            for (int q = 0; q < 4; ++q) { const u32x4 gr = *(const u32x4*)(gp + q * 8);
                const float gv[8] = {bflo(gr.x), bfhi(gr.x), bflo(gr.y), bfhi(gr.y), bflo(gr.z), bfhi(gr.z), bflo(gr.w), bfhi(gr.w)};
                float y[8];
#pragma unroll
                for (int e = 0; e < 8; ++e) y[e] = ov[q * 8 + e] * inv * ng[q * 8 + e] * silu_(gv[e]);
                u32x4 o; o.x = cvt_pk_bf16(y[0], y[1]); o.y = cvt_pk_bf16(y[2], y[3]); o.z = cvt_pk_bf16(y[4], y[5]); o.w = cvt_pk_bf16(y[6], y[7]);
                *(u32x4*)(OB + (size_t)tok * 1024 + col + q * 8) = o; }
        }
        __syncthreads();
    }
}

__device__ __forceinline__ void lru_conv(KP p, int l) {
    LAUNDER_IDS
    const bf16_t* XB = (const bf16_t*)(p->ws + WS_XB); bf16_t* XC = (bf16_t*)(p->ws + WS_XC);
    const float* cw = p->lru_conv_w + (size_t)l * 4 * 1024; const float* cb = p->lru_conv_b + (size_t)l * 1024;
    const int gs = gridDim.x * NTHR;
    for (int it = bidL * NTHR + tidL; it < T * 128; it += gs) {
        const int tok = it >> 7, c8 = (it & 127) * 8, s = tok & (SEQ - 1);
        float acc[8];
        { const f32x4 b0 = *(const f32x4*)(cb + c8), b1 = *(const f32x4*)(cb + c8 + 4);
            acc[0] = b0[0]; acc[1] = b0[1]; acc[2] = b0[2]; acc[3] = b0[3]; acc[4] = b1[0]; acc[5] = b1[1]; acc[6] = b1[2]; acc[7] = b1[3]; }
#pragma unroll
        for (int jj = 0; jj < 4; ++jj) { const int ts = s + jj - 2;
            if (ts >= 0 && ts < SEQ) { const u32x4 xr = *(const u32x4*)(XB + (size_t)(tok + jj - 2) * 1024 + c8);
                const f32x4 w0 = *(const f32x4*)(cw + jj * 1024 + c8), w1 = *(const f32x4*)(cw + jj * 1024 + c8 + 4);
                acc[0] += bflo(xr.x) * w0[0]; acc[1] += bfhi(xr.x) * w0[1]; acc[2] += bflo(xr.y) * w0[2]; acc[3] += bfhi(xr.y) * w0[3];
                acc[4] += bflo(xr.z) * w1[0]; acc[5] += bfhi(xr.z) * w1[1]; acc[6] += bflo(xr.w) * w1[2]; acc[7] += bfhi(xr.w) * w1[3]; } }
        u32x4 o; o.x = cvt_pk_bf16(acc[0], acc[1]); o.y = cvt_pk_bf16(acc[2], acc[3]); o.z = cvt_pk_bf16(acc[4], acc[5]); o.w = cvt_pk_bf16(acc[6], acc[7]);
        *(u32x4*)(XC + (size_t)tok * 1024 + c8) = o;
    }
}
__device__ __forceinline__ void lru_scan1(KP p, LAS unsigned char* lds) {
    LAUNDER_IDS
    const bf16_t* LOGA = (const bf16_t*)(p->ws + WS_LOGA); const bf16_t* BT = (const bf16_t*)(p->ws + WS_BTERM);
    float* CP = (float*)(p->ws + WS_CP); float* CH = (float*)(p->ws + WS_CH);
    LAS float* XP = (LAS float*)lds; LAS float* XH = (LAS float*)(lds + 16384);
    for (int u = bidL; u < 1024; u += gridDim.x) {
        int tid = tidL; asm volatile("" : "+v"(tid));
        const int ts = tid >> 7, c8 = (tid & 127) * 8;
        const int chunk = u & 255, dir = (u >> 8) & 1, b = u >> 9;
        const size_t base = ((size_t)dir * T + b * SEQ + chunk * 32) * 1024 + c8;
        u32x4 lw[8], bw[8];
#pragma unroll
        for (int q = 0; q < 8; ++q) { const int t = dir ? 31 - (ts * 8 + q) : ts * 8 + q; lw[q] = *(const u32x4*)(LOGA + base + (size_t)t * 1024); bw[q] = *(const u32x4*)(BT + base + (size_t)t * 1024); }
        float h[8], sl[8];
#pragma unroll
        for (int i = 0; i < 8; ++i) { h[i] = 0.f; sl[i] = 0.f; }
#pragma unroll
        for (int q = 0; q < 8; ++q) {
#pragma unroll
            for (int w = 0; w < 4; ++w) { const float l0 = bflo(lw[q][w]), l1 = bfhi(lw[q][w]);
                h[2 * w] = fast_exp(l0) * h[2 * w] + bflo(bw[q][w]); h[2 * w + 1] = fast_exp(l1) * h[2 * w + 1] + bfhi(bw[q][w]); sl[2 * w] += l0; sl[2 * w + 1] += l1; } }
        *(LAS f32x4*)(XP + ts * 1024 + c8) = (f32x4){fast_exp(sl[0]), fast_exp(sl[1]), fast_exp(sl[2]), fast_exp(sl[3])};
        *(LAS f32x4*)(XP + ts * 1024 + c8 + 4) = (f32x4){fast_exp(sl[4]), fast_exp(sl[5]), fast_exp(sl[6]), fast_exp(sl[7])};
        *(LAS f32x4*)(XH + ts * 1024 + c8) = (f32x4){h[0], h[1], h[2], h[3]}; *(LAS f32x4*)(XH + ts * 1024 + c8 + 4) = (f32x4){h[4], h[5], h[6], h[7]};
        __syncthreads();
        { const int ch = 2 * tid; float P0 = 1.f, P1 = 1.f, H0 = 0.f, H1 = 0.f;
#pragma unroll
            for (int s2 = 0; s2 < 4; ++s2) { const f32x2 pp = *(const LAS f32x2*)(XP + s2 * 1024 + ch), hh = *(const LAS f32x2*)(XH + s2 * 1024 + ch);
                H0 = pp[0] * H0 + hh[0]; H1 = pp[1] * H1 + hh[1]; P0 *= pp[0]; P1 *= pp[1]; }
            const size_t o = ((size_t)(b * 2 + dir) * 256 + chunk) * 1024 + ch;
            *(f32x2*)(CP + o) = (f32x2){P0, P1}; *(f32x2*)(CH + o) = (f32x2){H0, H1}; }
        __syncthreads();
    }
}
__device__ __forceinline__ void lru_scan2(KP p) {
    LAUNDER_IDS
    const float* CP = (const float*)(p->ws + WS_CP); const float* CH = (const float*)(p->ws + WS_CH); float* HIN = (float*)(p->ws + WS_HIN);
    const int wave = tidL >> 6, lane = tidL & 63;
    for (int item = bidL * NWAVE + wave; item < 4096; item += gridDim.x * NWAVE) {
        const int ch = item & 1023, bd = item >> 10, dir = bd & 1;
        float pp[4], hh[4]; float Pl = 1.f, Hl = 0.f;
#pragma unroll
        for (int q = 0; q < 4; ++q) { const int ci = 4 * lane + q, chunk = dir ? 255 - ci : ci; const size_t o = ((size_t)bd * 256 + chunk) * 1024 + ch;
            pp[q] = CP[o]; hh[q] = CH[o]; Hl = pp[q] * Hl + hh[q]; Pl *= pp[q]; }
#pragma unroll
        for (int off = 1; off < 64; off <<= 1) { const float Pp = __shfl_up(Pl, off), Hp = __shfl_up(Hl, off);
            if (lane >= off) { Hl = Pl * Hp + Hl; Pl = Pl * Pp; } }
        float carry = __shfl_up(Hl, 1); if (lane == 0) carry = 0.f;
#pragma unroll
        for (int q = 0; q < 4; ++q) { const int ci = 4 * lane + q, chunk = dir ? 255 - ci : ci; const size_t o = ((size_t)bd * 256 + chunk) * 1024 + ch;
            HIN[o] = carry; carry = pp[q] * carry + hh[q]; }
    }
}
__device__ __forceinline__ void lru_scan3(KP p, LAS unsigned char* lds) {
    LAUNDER_IDS
    const bf16_t* LOGA = (const bf16_t*)(p->ws + WS_LOGA); const bf16_t* BT = (const bf16_t*)(p->ws + WS_BTERM); const bf16_t* YG = (const bf16_t*)(p->ws + WS_YG);
    const float* HIN = (const float*)(p->ws + WS_HIN); bf16_t* OB = (bf16_t*)(p->ws + WS_OB);
    LAS float* XP = (LAS float*)lds; LAS float* XH = (LAS float*)(lds + 16384);
    for (int u = bidL; u < 512; u += gridDim.x) {
        int tid = tidL; asm volatile("" : "+v"(tid));
        const int ts = tid >> 7, c8 = (tid & 127) * 8;
        const int chunk = u & 255, b = u >> 8;
        const size_t base = ((size_t)b * SEQ + chunk * 32 + ts * 8) * 1024 + c8;
        unsigned hsp[8][4];
#pragma unroll
        for (int dir = 0; dir < 2; ++dir) {
            u32x4 lw[8], bw[8];
#pragma unroll
            for (int q = 0; q < 8; ++q) { lw[q] = *(const u32x4*)(LOGA + (size_t)dir * T * 1024 + base + (size_t)q * 1024); bw[q] = *(const u32x4*)(BT + (size_t)dir * T * 1024 + base + (size_t)q * 1024); }
            const f32x4 hi0 = *(const f32x4*)(HIN + ((size_t)(b * 2 + dir) * 256 + chunk) * 1024 + c8), hi1 = *(const f32x4*)(HIN + ((size_t)(b * 2 + dir) * 256 + chunk) * 1024 + c8 + 4);
            float h[8], sl[8];
#pragma unroll
            for (int i = 0; i < 8; ++i) { h[i] = 0.f; sl[i] = 0.f; }
#pragma unroll
            for (int qq = 0; qq < 8; ++qq) { const int q = dir ? 7 - qq : qq;
#pragma unroll
                for (int w = 0; w < 4; ++w) { const float l0 = bflo(lw[q][w]), l1 = bfhi(lw[q][w]);
                    h[2 * w] = fast_exp(l0) * h[2 * w] + bflo(bw[q][w]); h[2 * w + 1] = fast_exp(l1) * h[2 * w + 1] + bfhi(bw[q][w]); sl[2 * w] += l0; sl[2 * w + 1] += l1; } }
            __syncthreads();
            *(LAS f32x4*)(XP + ts * 1024 + c8) = (f32x4){fast_exp(sl[0]), fast_exp(sl[1]), fast_exp(sl[2]), fast_exp(sl[3])};
            *(LAS f32x4*)(XP + ts * 1024 + c8 + 4) = (f32x4){fast_exp(sl[4]), fast_exp(sl[5]), fast_exp(sl[6]), fast_exp(sl[7])};
            *(LAS f32x4*)(XH + ts * 1024 + c8) = (f32x4){h[0], h[1], h[2], h[3]}; *(LAS f32x4*)(XH + ts * 1024 + c8 + 4) = (f32x4){h[4], h[5], h[6], h[7]};
            __syncthreads();
            h[0] = hi0[0]; h[1] = hi0[1]; h[2] = hi0[2]; h[3] = hi0[3]; h[4] = hi1[0]; h[5] = hi1[1]; h[6] = hi1[2]; h[7] = hi1[3];
#pragma unroll
            for (int s3 = 0; s3 < 3; ++s3) { const int sr = dir ? 3 - s3 : s3; const bool use = dir ? (sr > ts) : (sr < ts);
                const f32x4 p0 = *(const LAS f32x4*)(XP + sr * 1024 + c8), p1 = *(const LAS f32x4*)(XP + sr * 1024 + c8 + 4), q0 = *(const LAS f32x4*)(XH + sr * 1024 + c8), q1 = *(const LAS f32x4*)(XH + sr * 1024 + c8 + 4);
                if (use) { h[0] = p0[0] * h[0] + q0[0]; h[1] = p0[1] * h[1] + q0[1]; h[2] = p0[2] * h[2] + q0[2]; h[3] = p0[3] * h[3] + q0[3];
                    h[4] = p1[0] * h[4] + q1[0]; h[5] = p1[1] * h[5] + q1[1]; h[6] = p1[2] * h[6] + q1[2]; h[7] = p1[3] * h[7] + q1[3]; } }
#pragma unroll
            for (int qq = 0; qq < 8; ++qq) { const int q = dir ? 7 - qq : qq;
                u32x4 yw; if (dir) yw = *(const u32x4*)(YG + base + (size_t)q * 1024);
                unsigned ow[4];
#pragma unroll
                for (int w = 0; w < 4; ++w) { h[2 * w] = fast_exp(bflo(lw[q][w])) * h[2 * w] + bflo(bw[q][w]); h[2 * w + 1] = fast_exp(bfhi(lw[q][w])) * h[2 * w + 1] + bfhi(bw[q][w]);
                    if (dir == 0) hsp[q][w] = cvt_pk_bf16(h[2 * w], h[2 * w + 1]);
                    else ow[w] = cvt_pk_bf16((bflo(hsp[q][w]) + h[2 * w]) * bflo(yw[w]), (bfhi(hsp[q][w]) + h[2 * w + 1]) * bfhi(yw[w])); }
                if (dir) *(u32x4*)(OB + base + (size_t)q * 1024) = (u32x4){ow[0], ow[1], ow[2], ow[3]}; }
        }
        __syncthreads();
    }
}

__device__ const unsigned char STAIR[64] = {
    0x00, 0x01, 0x02, 0x03, 0x04, 0x05, 0x06, 0x07, 0x08, 0x09, 0x0a, 0x0b, 0x0c, 0x0d, 0x0e, 0x0f,
    0x10, 0x11, 0x12, 0x13, 0x14, 0x15, 0x16, 0x17, 0x20, 0x21, 0x22, 0x23, 0x24, 0x30, 0x31, 0x32,
    0x33, 0x40, 0x41, 0x42, 0x50, 0x51, 0x60, 0x61, 0x70, 0x71, 0x80, 0x90, 0xa0, 0xb0, 0xc0, 0xd0,
    0xe0, 0xf0, 0, 0, 0, 0, 0, 0, 0, 0, 0, 0, 0, 0, 0, 0};
__device__ __forceinline__ unsigned mono_key(float f) { const unsigned b = __float_as_uint(f); return b ^ ((b >> 31) ? 0xffffffffu : 0x80000000u); }

__device__ __forceinline__ float inv_mono(unsigned k) { return __uint_as_float(k ^ ((k >> 31) ? 0x80000000u : 0xffffffffu)); }
#define TK_CE(A, B) do { const unsigned hi_ = max(A, B), lo_ = min(A, B); A = hi_; B = lo_; } while (0)
#define TK_SORT16(N) do { _Pragma("unroll") for (int k_ = 2; k_ <= 16; k_ <<= 1) { _Pragma("unroll") for (int j_ = k_ >> 1; j_ > 0; j_ >>= 1) { _Pragma("unroll") for (int i_ = 0; i_ < 16; ++i_) { \
    const int l_ = i_ ^ j_; if (l_ > i_) { if ((i_ & k_) == 0) TK_CE(N[i_], N[l_]); else TK_CE(N[l_], N[i_]); } } } } } while (0)
#define TK_MERGE16(L, N) do { _Pragma("unroll") for (int i_ = 0; i_ < 16; ++i_) L[i_] = max(L[i_], N[15 - i_]); \
    _Pragma("unroll") for (int j_ = 8; j_ > 0; j_ >>= 1) { _Pragma("unroll") for (int i_ = 0; i_ < 16; ++i_) { const int l_ = i_ ^ j_; if (l_ > i_) TK_CE(L[i_], L[l_]); } } } while (0)
#define TK_INSERT(L, x) do { _Pragma("unroll") for (int q_ = 0; q_ < 16; ++q_) { const unsigned hi_ = max(L[q_], x); x = min(L[q_], x); L[q_] = hi_; } } while (0)
__device__ __forceinline__ void peer_topk(KP p, LAS unsigned char* lds) {
    LAUNDER_IDS
    (void)bidL;
    const int tid = tidL, wave = tid >> 6, lane = tid & 63;
    const float* SC = (const float*)(p->ws + WS_SCORES);
    LAS float* TB = (LAS float*)(lds + 32768 + wave * 4608);
    int* TOPI = (int*)(p->ws + WS_TOPI); float* TOPG = (float*)(p->ws + WS_TOPG);
    LAS unsigned char* IX = lds + wave * 2048 + lane * 32;
    for (int item = bidL * NWAVE + wave; item < 2048; item += gridDim.x * NWAVE) {
        const int tg = item >> 3, hd = item & 7, tok = tg * 64 + lane;
        float V[2][16];
#pragma unroll
        for (int half = 0; half < 2; ++half) {
            unsigned L[16];
#pragma unroll
            for (int q = 0; q < 16; ++q) L[q] = 0u;
            const float* scb = SC + (size_t)(tg * 64 + (lane >> 2)) * 2048 + hd * 256 + half * 128 + (lane & 3) * 4;
            f32x4 nx[4];
#pragma unroll
            for (int i = 0; i < 4; ++i) nx[i] = *(const f32x4*)(scb + (size_t)(16 * i) * 2048);
#pragma unroll 1
            for (int kb = 0; kb < 8; ++kb) {
#pragma unroll
                for (int i = 0; i < 4; ++i) { LAS float* d = TB + ((lane >> 2) + 16 * i) * 17 + (lane & 3) * 4; d[0] = nx[i][0]; d[1] = nx[i][1]; d[2] = nx[i][2]; d[3] = nx[i][3]; }
                asm volatile("s_waitcnt lgkmcnt(0)" ::: "memory");
                float cur[16];
#pragma unroll
                for (int i = 0; i < 16; ++i) cur[i] = TB[lane * 17 + i];
                asm volatile("s_waitcnt lgkmcnt(0)" ::: "memory");
                const int kn = kb < 7 ? kb + 1 : kb;
#pragma unroll
                for (int i = 0; i < 4; ++i) nx[i] = *(const f32x4*)(scb + (size_t)(16 * i) * 2048 + 16 * kn);
                unsigned NK[16];
#pragma unroll
                for (int i = 0; i < 16; ++i) NK[i] = (mono_key(cur[i]) & ~0x7fu) | (unsigned)(kb * 16 + i);
                TK_SORT16(NK); TK_MERGE16(L, NK);
            }
            u32x4 w0, w1;
            w0.x = (L[0] & 0x7f) | ((L[1] & 0x7f) << 8) | ((L[2] & 0x7f) << 16) | ((L[3] & 0x7f) << 24); w0.y = (L[4] & 0x7f) | ((L[5] & 0x7f) << 8) | ((L[6] & 0x7f) << 16) | ((L[7] & 0x7f) << 24);
            w0.z = (L[8] & 0x7f) | ((L[9] & 0x7f) << 8) | ((L[10] & 0x7f) << 16) | ((L[11] & 0x7f) << 24); w0.w = (L[12] & 0x7f) | ((L[13] & 0x7f) << 8) | ((L[14] & 0x7f) << 16) | ((L[15] & 0x7f) << 24);
            *(LAS u32x4*)(IX + half * 16) = w0;
#pragma unroll
            for (int q = 0; q < 16; ++q) V[half][q] = inv_mono(L[q]);
        }
        unsigned C[16];
#pragma unroll
        for (int q = 0; q < 16; ++q) C[q] = 0u;
#pragma unroll
        for (int i = 0; i < 16; ++i)
#pragma unroll
            for (int jj = 0; jj < 16; ++jj) if ((i + 1) * (jj + 1) <= 16) { unsigned x = (mono_key(V[0][i] + V[1][jj]) & ~0xffu) | (unsigned)(i * 16 + jj); TK_INSERT(C, x); }
        asm volatile("s_waitcnt lgkmcnt(0)" ::: "memory");
        const float s0 = inv_mono(C[0] & ~0xffu);
        float e[16]; float sum = 0.f; int ids[16];
#pragma unroll
        for (int q = 0; q < 16; ++q) { e[q] = fast_exp(inv_mono(C[q] & ~0xffu) - s0); sum += e[q];
            const unsigned code = C[q] & 0xffu; ids[q] = (int)IX[code >> 4] * 128 + (int)IX[16 + (code & 15u)]; }
        const float rs = fast_rcp(sum);
        int* ip = TOPI + (size_t)tok * 128 + hd * 16; float* gp = TOPG + (size_t)tok * 128 + hd * 16;
#pragma unroll
        for (int q = 0; q < 4; ++q) { *(u32x4*)(ip + 4 * q) = (u32x4){(unsigned)ids[4 * q], (unsigned)ids[4 * q + 1], (unsigned)ids[4 * q + 2], (unsigned)ids[4 * q + 3]};
            *(f32x4*)(gp + 4 * q) = (f32x4){e[4 * q] * rs, e[4 * q + 1] * rs, e[4 * q + 2] * rs, e[4 * q + 3] * rs}; }
        asm volatile("s_waitcnt lgkmcnt(0)" ::: "memory");
    }
}

__device__ __forceinline__ void peer_gather(KP p, int l, bool dry) {
    LAUNDER_IDS
    const int wave = tidL >> 6, lane = tidL & 63;
    const bf16_t* HB = (const bf16_t*)(p->ws + WS_HBUF); bf16_t* HBW = (bf16_t*)(p->ws + WS_HBUF);
    const int* TOPI = (const int*)(p->ws + WS_TOPI); const float* TOPG = (const float*)(p->ws + WS_TOPG);
    const unsigned char* UA = p->ws + WS_UTAB + (size_t)l * 16384 * 512; const unsigned char* V8 = p->ws + WS_VTAB + (size_t)l * 16384 * 512 + 8 * lane; const unsigned char* H8 = p->ws + WS_HB8;
    const float* USC = (const float*)(p->ws + WS_USC) + l * 16384; const float* VSC = (const float*)(p->ws + WS_VSC) + l * 16384;
    float* XRES = (float*)(p->ws + WS_XRES); const float* MOD = (const float*)(p->ws + WS_MOD);
    for (int tok = bidL * NWAVE + wave; tok < T; tok += gridDim.x * NWAVE) {
        const int b = tok >> 13;
        const int gq = lane >> 4, jq = lane & 15;
        v8i hb[8];
#pragma unroll
        for (int sidx = 0; sidx < 8; ++sidx) { const u32x4 lo = *(const u32x4*)(H8 + (size_t)tok * 1024 + 128 * sidx + 16 * gq), hi = *(const u32x4*)(H8 + (size_t)tok * 1024 + 128 * sidx + 64 + 16 * gq);
            hb[sidx] = (v8i){(int)lo.x, (int)lo.y, (int)lo.z, (int)lo.w, (int)hi.x, (int)hi.y, (int)hi.z, (int)hi.w}; }
        const int id0 = TOPI[(size_t)tok * 128 + lane], id1 = TOPI[(size_t)tok * 128 + 64 + lane];
        const float g0 = TOPG[(size_t)tok * 128 + lane], g1 = TOPG[(size_t)tok * 128 + 64 + lane];
        f32x2 acc2[8];
#pragma unroll
        for (int i = 0; i < 8; ++i) acc2[i] = (f32x2){0.f, 0.f};
        const int ke = 4 * gq + (jq & 3);
#pragma unroll 1
        for (int e0 = 0; e0 < 128; e0 += 16) {
            const int ida = __shfl(e0 < 64 ? id0 : id1, (e0 + jq) & 63) & 16383;
            const unsigned char* ua_p = UA + (size_t)ida * 512 + 16 * gq;
            u32x4 ua[8];
#pragma unroll
            for (int sidx = 0; sidx < 8; ++sidx) ua[sidx] = *(const u32x4*)(ua_p + 64 * sidx);
            u32x2 vq[16];
#pragma unroll
            for (int k = 0; k < 16; ++k) { const int id = __builtin_amdgcn_readlane(e0 < 64 ? id0 : id1, (e0 + k) & 63) & 16383; vq[k] = *(const u32x2*)(V8 + (size_t)id * 512); }
            const int idk = __shfl(e0 < 64 ? id0 : id1, (e0 + ke) & 63) & 16383; const float gl = __shfl(e0 < 64 ? g0 : g1, (e0 + ke) & 63);
            const float sul = USC[idk], svl = VSC[idk];
            f32x4 dacc = {0.f, 0.f, 0.f, 0.f};
#pragma unroll
            for (int sidx = 0; sidx < 8; ++sidx) { const v8i av = (v8i){(int)ua[sidx].x, (int)ua[sidx].y, (int)ua[sidx].z, (int)ua[sidx].w, 0, 0, 0, 0};
                dacc = __builtin_amdgcn_mfma_scale_f32_16x16x128_f8f6f4(av, hb[sidx], dacc, 4, 0, 0, 0x7f7f7f7f, 0, 0x7f7f7f7f); }
            const int jr = jq & 3;
            const float r = jr == 0 ? dacc[0] : jr == 1 ? dacc[1] : jr == 2 ? dacc[2] : dacc[3];
            const float cfl = gl * gelu_tanh(r * sul) * svl;
#pragma unroll
            for (int k = 0; k < 16; ++k) { const float cf = __uint_as_float(__builtin_amdgcn_readlane(__float_as_uint(cfl), 16 * (k >> 2) + (k & 3)));
                const f32x2 cf2 = (f32x2){cf, cf};
#pragma unroll
                for (int w = 0; w < 2; ++w) {
                    acc2[4 * w + 0] = __builtin_amdgcn_cvt_scalef32_pk_f32_fp4(vq[k][w], 1.0f, 0) * cf2 + acc2[4 * w + 0]; acc2[4 * w + 1] = __builtin_amdgcn_cvt_scalef32_pk_f32_fp4(vq[k][w], 1.0f, 1) * cf2 + acc2[4 * w + 1];
                    acc2[4 * w + 2] = __builtin_amdgcn_cvt_scalef32_pk_f32_fp4(vq[k][w], 1.0f, 2) * cf2 + acc2[4 * w + 2]; acc2[4 * w + 3] = __builtin_amdgcn_cvt_scalef32_pk_f32_fp4(vq[k][w], 1.0f, 3) * cf2 + acc2[4 * w + 3]; } }
        }
        const float* g2 = MOD + ((size_t)l * 2 + b) * 6144 + 5 * 1024 + 16 * lane;
        float* xrow = XRES + (size_t)tok * 1024 + 16 * lane;
        float xn[16]; float ss = 0.f;
#pragma unroll
        for (int q = 0; q < 4; ++q) { const f32x4 xr = *(const f32x4*)(xrow + 4 * q), gg = *(const f32x4*)(g2 + 4 * q);
            const float a0 = acc2[2 * q][0], a1 = acc2[2 * q][1], a2 = acc2[2 * q + 1][0], a3 = acc2[2 * q + 1][1];
            xn[4 * q + 0] = xr[0] + gg[0] * a0; xn[4 * q + 1] = xr[1] + gg[1] * a1; xn[4 * q + 2] = xr[2] + gg[2] * a2; xn[4 * q + 3] = xr[3] + gg[3] * a3; }
#pragma unroll
        for (int i = 0; i < 16; ++i) ss += xn[i] * xn[i];
        const float inv = __builtin_amdgcn_rsqf(wave_sum(ss) * (1.f / 1024.f) + EPS);
        if (dry) { if (inv == 123.456f) p->out[tok] = inv; continue; }
        if (l < DEPTH - 1) {
            const float* gain = p->norm_g + (size_t)(l + 1) * 2 * 1024 + 16 * lane; const float* sh = MOD + ((size_t)(l + 1) * 2 + b) * 6144 + 16 * lane; const float* sc = sh + 1024;
            float y[16];
#pragma unroll
            for (int q = 0; q < 4; ++q) { const f32x4 gn = *(const f32x4*)(gain + 4 * q), s1 = *(const f32x4*)(sh + 4 * q), c1 = *(const f32x4*)(sc + 4 * q);
                *(f32x4*)(xrow + 4 * q) = (f32x4){xn[4 * q], xn[4 * q + 1], xn[4 * q + 2], xn[4 * q + 3]};
#pragma unroll
                for (int i = 0; i < 4; ++i) y[4 * q + i] = (xn[4 * q + i] * inv) * gn[i] * (1.f + c1[i]) + s1[i]; }
            u32x4 o0, o1; o0.x = cvt_pk_bf16(y[0], y[1]); o0.y = cvt_pk_bf16(y[2], y[3]); o0.z = cvt_pk_bf16(y[4], y[5]); o0.w = cvt_pk_bf16(y[6], y[7]);
            o1.x = cvt_pk_bf16(y[8], y[9]); o1.y = cvt_pk_bf16(y[10], y[11]); o1.z = cvt_pk_bf16(y[12], y[13]); o1.w = cvt_pk_bf16(y[14], y[15]);
            *(u32x4*)(HBW + (size_t)tok * 1024 + 16 * lane) = o0; *(u32x4*)(HBW + (size_t)tok * 1024 + 16 * lane + 8) = o1;
        } else {
            const float* fg = p->final_g + 16 * lane; float* orow = p->out + (size_t)tok * 1024 + 16 * lane;
#pragma unroll
            for (int q = 0; q < 4; ++q) { const f32x4 gn = *(const f32x4*)(fg + 4 * q); f32x4 o;
#pragma unroll
                for (int i = 0; i < 4; ++i) o[i] = (xn[4 * q + i] * inv) * gn[i];
                *(f32x4*)(orow + 4 * q) = o; }
        }
    }
}

#define XB_TMO      128
#define XB_XCNT(j)  (256  + 64 * (j))
#define XB_XSUB(j)  (1280 + 64 * (j))
#define XB_XGEN(j)  (2304 + 64 * (j))
#define XB_TOP      3328
#define XB_TOPGEN   3392
#define XCD_BAR_WORDS 3456
#define XB_SPIN_CAP (1u << 18)

__device__ __forceinline__ unsigned xb_ld(unsigned* p)              { return __hip_atomic_load(p, __ATOMIC_RELAXED, __HIP_MEMORY_SCOPE_AGENT); }
__device__ __forceinline__ unsigned xb_add(unsigned* p, unsigned v) { return __hip_atomic_fetch_add(p, v, __ATOMIC_RELAXED, __HIP_MEMORY_SCOPE_AGENT); }
__device__ __forceinline__ unsigned xb_xcc_id() { return (unsigned)__builtin_amdgcn_s_getreg((3 << 11) | 20) & 0xFu; }
#define XB_SPIN(cond, bar) do { unsigned _sp = 0; while (cond) { __builtin_amdgcn_s_sleep(1); \
    if ((++_sp & 255u) == 0u) { if (xb_ld(&(bar)[XB_TMO])) break; if (_sp > XB_SPIN_CAP) { atomicAdd(&(bar)[XB_TMO], 1u); break; } } } } while (0)

struct XcdBarrier {
    unsigned* bar; unsigned x;
    volatile LAS unsigned* st;
};

__device__ __forceinline__ XcdBarrier xcd_barrier_post(unsigned* bar, volatile LAS unsigned* st) {
    XcdBarrier b; b.bar = bar; b.x = xb_xcc_id(); b.st = st;
    if (threadIdx.x == 0) (void)xb_add(&bar[XB_XCNT(b.x)], 1u);
    return b;
}
__device__ __forceinline__ void xcd_barrier_complete(unsigned* bar, unsigned x, unsigned& nloc, unsigned& nx) {
    const unsigned G = gridDim.x * gridDim.y * gridDim.z;
    unsigned sum, cnt, mine, sp = 0u;
    for (;;) {
        sum = 0u; cnt = 0u; mine = 0u;
#pragma unroll
        for (unsigned j = 0; j < 16; ++j) { const unsigned c = xb_ld(&bar[XB_XCNT(j)]); sum += c; cnt += (c > 0u) ? 1u : 0u; mine = (j == x) ? c : mine; }
        if (sum == G) break;
        __builtin_amdgcn_s_sleep(1);
        if ((++sp & 255u) == 0u) { if (xb_ld(&bar[XB_TMO])) break; if (sp > XB_SPIN_CAP) { atomicAdd(&bar[XB_TMO], 1u); break; } }
    }
    nloc = mine > 0u ? mine : 1u; nx = cnt > 0u ? cnt : 1u;
}

__device__ __forceinline__ void xcd_barrier(const XcdBarrier& b) {
    asm volatile("s_waitcnt vmcnt(0)" ::: "memory");
    __syncthreads();
    if (threadIdx.x == 0) {
        unsigned* bar = b.bar;
        __builtin_amdgcn_s_waitcnt(0);
        unsigned nloc = b.st[0], nx = b.st[1];
        if (nloc == 0u) { xcd_barrier_complete(bar, b.x, nloc, nx); b.st[0] = nloc; b.st[1] = nx; }
        const unsigned old = xb_add(&bar[XB_XSUB(b.x)], 1u);
        const unsigned gen = old / nloc;
        if (old + 1u == (gen + 1u) * nloc) {
            __builtin_amdgcn_fence(__ATOMIC_RELEASE, "agent");
            asm volatile("s_waitcnt vmcnt(0)" ::: "memory");
            const unsigned og = xb_add(&bar[XB_TOP], 1u);
            const unsigned tg = og / nx;
            if (og + 1u == (tg + 1u) * nx) xb_add(&bar[XB_TOPGEN], 1u);
            else XB_SPIN(xb_ld(&bar[XB_TOPGEN]) == tg, bar);
            __builtin_amdgcn_fence(__ATOMIC_ACQUIRE, "agent");
            xb_add(&bar[XB_XGEN(b.x)], 1u);
            asm volatile("s_waitcnt vmcnt(0)" ::: "memory");
        } else {
            XB_SPIN(xb_ld(&bar[XB_XGEN(b.x)]) == gen, bar);
            __builtin_amdgcn_fence(__ATOMIC_ACQUIRE, "agent");
            asm volatile("s_waitcnt vmcnt(0)" ::: "memory");
        }
    }
    __syncthreads();
}

#ifndef OPMASK
#define OPMASK 0xFFFFFFFFu
#endif
#define EN(o) ((OPMASK >> (o)) & 1u)
enum { OP_P0 = 0, OP_RMS1, OP_HG_IN, OP_HG_A, OP_HG_B, OP_HG_C, OP_MIX_OUT, OP_LR_IN, OP_LR_CONV, OP_LR_G, OP_LR_S1, OP_LR_S2, OP_LR_S3, OP_RMS2, OP_QK, OP_TOPK, OP_GATHER };
constexpr int NPH = 42;
#define REP_MASK 0u
__device__ __forceinline__ void decode_phase(int ph, int& l, int& op) {
    if (ph == 0) { l = 0; op = OP_P0; return; }
    if (ph == 1) { l = 0; op = OP_RMS1; return; }
    int q = ph - 2;
    if (q < 9) { l = 0; } else if (q < 20) { l = 1; q -= 9; } else if (q < 29) { l = 2; q -= 20; } else { l = 3; q -= 29; }
    if ((l & 1) == 0) { op = q == 0 ? OP_HG_IN : q == 1 ? OP_HG_A : q == 2 ? OP_HG_B : q == 3 ? OP_HG_C : q == 4 ? OP_MIX_OUT : q == 5 ? OP_RMS2 : q == 6 ? OP_QK : q == 7 ? OP_TOPK : OP_GATHER; }
    else { op = q == 0 ? OP_LR_IN : q == 1 ? OP_LR_CONV : q == 2 ? OP_LR_G : q == 3 ? OP_LR_S1 : q == 4 ? OP_LR_S2 : q == 5 ? OP_LR_S3 : q == 6 ? OP_MIX_OUT : q == 7 ? OP_RMS2 : q == 8 ? OP_QK : q == 9 ? OP_TOPK : OP_GATHER; }
}

__global__ __launch_bounds__(512, 2) void mk_fwd(Params p_arg) {
    extern __shared__ __attribute__((aligned(16))) unsigned char shm[];
    LAS unsigned char* lds = (LAS unsigned char*)shm;
    cg::grid_group grid = cg::this_grid();
    unsigned long long kpv = (unsigned long long)__builtin_amdgcn_kernarg_segment_ptr();
    const int ph_lo = p_arg.ph_lo, ph_hi = p_arg.ph_hi;
    volatile LAS unsigned* xst = (volatile LAS unsigned*)(lds + LDS_BYTES - 16);
    if (threadIdx.x == 0) { xst[0] = 0u; xst[1] = 0u; }
    __syncthreads();
    const XcdBarrier xb = xcd_barrier_post((unsigned*)(p_arg.ws + WS_CTL) + 1024, xst);
    for (int ph = ph_lo; ph < ph_hi; ++ph) {
        if (ph > ph_lo) { if (ph_hi > 4096) grid.sync(); else xcd_barrier(xb); }
        asm volatile("" : "+s"(kpv));
        KP p = (KP)kpv;
        unsigned char* ws = p->ws;
        const float* MOD = (const float*)(ws + WS_MOD);
        int l, op; decode_phase(ph, l, op);
        const int j = l >> 1;
        const int nrep = ((p->rep_mask >> op) & 1u) ? 2 : 1;
        for (int rep = 0; rep < nrep; ++rep) {
        const bool dry = rep + 1 < nrep;
#ifdef ONLY
        switch (ONLY) {
#else
        switch (op) {
#endif
        case OP_P0: if (EN(OP_P0)) phase0(p, lds); break;
        case OP_RMS1: if (EN(OP_RMS1)) phase_rms(p->x, p->norm_g, MOD, MOD + 1024, (bf16_t*)(ws + WS_HBUF), nullptr); break;
        case OP_HG_IN: if (EN(OP_HG_IN)) { EpiBf16 E; E.O = (bf16_t*)(ws + WS_PROJ); E.ldc = 5120;
            run_gemm(lds, (const bf16_t*)(ws + WS_HBUF), (const bf16_t*)(ws + WS_HGWIN) + (size_t)j * 5120 * 1024, 5120, 1024, 1024, 1024, 0, 0, E); } break;
        case OP_HG_A: if (EN(OP_HG_A)) hg_pass_a(p, lds, j); break;
        case OP_HG_B: if (EN(OP_HG_B)) hg_pass_b(p); break;
        case OP_HG_C: if (EN(OP_HG_C)) hg_pass_c(p, lds, j); break;
        case OP_MIX_OUT: if (EN(OP_MIX_OUT)) { EpiResid E; E.xin = (l == 0) ? p->x : (const float*)(ws + WS_XRES); E.xout = (float*)(ws + WS_XRES); E.gate = MOD + (size_t)l * 2 * 6144 + 2 * 1024; E.dry = dry;
            const bf16_t* W = (l & 1) ? (const bf16_t*)(ws + WS_LRWOUT) + (size_t)j * 1024 * 1024 : (const bf16_t*)(ws + WS_HGWOUT) + (size_t)j * 1024 * 1024;
            run_gemm(lds, (const bf16_t*)(ws + WS_OB), W, 1024, 1024, 1024, 1024, 0, 0, E); } break;
        case OP_LR_IN: if (EN(OP_LR_IN)) { EpiLruIn E; E.XB = (bf16_t*)(ws + WS_XB); E.YG = (bf16_t*)(ws + WS_YG);
            run_gemm(lds, (const bf16_t*)(ws + WS_HBUF), (const bf16_t*)(ws + WS_LRWIN) + (size_t)j * 2048 * 1024, 2048, 1024, 1024, 1024, 0, 0, E); } break;
        case OP_LR_CONV: if (EN(OP_LR_CONV)) lru_conv(p, j); break;
        case OP_LR_G: if (EN(OP_LR_G)) { EpiGates E; E.LOGA = (bf16_t*)(ws + WS_LOGA); E.BTERM = (bf16_t*)(ws + WS_BTERM); E.XC = (const bf16_t*)(ws + WS_XC);
            E.b_a = p->lru_b_a + (size_t)j * 2048; E.b_x = p->lru_b_x + (size_t)j * 2048; E.lam = p->lru_lam + (size_t)j * 2048;
            run_gemm(lds, (const bf16_t*)(ws + WS_XC), (const bf16_t*)(ws + WS_LRWG) + (size_t)j * 4 * 1024 * 256, 4096, 256, 1024, 256, 2, 512, E); } break;
        case OP_LR_S1: if (EN(OP_LR_S1)) lru_scan1(p, lds); break;
        case OP_LR_S2: if (EN(OP_LR_S2)) lru_scan2(p); break;
        case OP_LR_S3: if (EN(OP_LR_S3)) lru_scan3(p, lds); break;
        case OP_RMS2: if (EN(OP_RMS2)) phase_rms((const float*)(ws + WS_XRES), p->norm_g + ((size_t)l * 2 + 1) * 1024, MOD + (size_t)l * 2 * 6144 + 3 * 1024, MOD + (size_t)l * 2 * 6144 + 4 * 1024, (bf16_t*)(ws + WS_HBUF), ws + WS_HB8); break;
        case OP_QK: if (EN(OP_QK)) { EpiF32 E; E.C = (float*)(ws + WS_SCORES); E.ldc = 2048;
            run_gemm(lds, (const bf16_t*)(ws + WS_HBUF), (const bf16_t*)(ws + WS_WQK) + (size_t)l * 2048 * 1024, 2048, 1024, 1024, 1024, 0, 0, E); } break;
        case OP_TOPK: if (EN(OP_TOPK)) peer_topk(p, lds); break;
        case OP_GATHER: if (EN(OP_GATHER)) peer_gather(p, l, dry); break;
        default: break;
        }
        }
    }
}

extern "C" void kernel_launch(void* const* d_in, const int* in_sizes, int n_in, void* d_out, int out_size, void* d_ws, size_t ws_size, hipStream_t stream) {
    static int grid = 0;
    if (grid == 0) {
        if (n_in != 23 || ws_size < WS_END) { fprintf(stderr, "kernel_launch: unexpected n_in %d / ws_size %zu (need %zu)\n", n_in, ws_size, (size_t)WS_END); grid = -1; return; }
        int dev = 0, cus = 0, per_cu = 0;
        hipGetDevice(&dev); hipDeviceGetAttribute(&cus, hipDeviceAttributeMultiprocessorCount, dev);
        if (hipFuncSetAttribute((const void*)mk_fwd, hipFuncAttributeMaxDynamicSharedMemorySize, LDS_BYTES) != hipSuccess) { fprintf(stderr, "kernel_launch: hipFuncSetAttribute failed\n"); grid = -1; return; }
        if (hipOccupancyMaxActiveBlocksPerMultiprocessor(&per_cu, (const void*)mk_fwd, NTHR, LDS_BYTES) != hipSuccess || per_cu < 1) { fprintf(stderr, "kernel_launch: occupancy query failed (%d)\n", per_cu); (void)hipGetLastError(); per_cu = 1; }
        grid = cus * 1;
        fprintf(stderr, "kernel_launch: cus %d per_cu %d grid %d\n", cus, per_cu, grid);
    }
    if (grid < 0) return;
    if (hipMemsetAsync((char*)d_ws + WS_CTL, 0, 65536, stream) != hipSuccess) { fprintf(stderr, "kernel_launch: memset failed\n"); return; }
    Params p{};
    const float** pp = (const float**)&p;
    for (int i = 0; i < 23; ++i) pp[i] = (const float*)d_in[i];
    p.out = (float*)d_out; p.ws = (unsigned char*)d_ws; p.ph_lo = 0; p.ph_hi = NPH; p.rep_mask = REP_MASK;
    void* args[] = {&p};
    hipError_t e = hipLaunchCooperativeKernel((const void*)mk_fwd, dim3(grid), dim3(NTHR), args, LDS_BYTES, stream);
    if (e != hipSuccess) fprintf(stderr, "kernel_launch: cooperative launch failed: %s (grid %d)\n", hipGetErrorString(e), grid);
}
```

```cpp
#include <hip/hip_runtime.h>
#include <hip/hip_cooperative_groups.h>
#include <cstdio>
#include <cstdint>
namespace cg = cooperative_groups;

#define LAS __attribute__((address_space(3)))
#define PG8_LAS __attribute__((address_space(3)))
typedef unsigned short bf16_t;
typedef short bf16x8 __attribute__((ext_vector_type(8)));
typedef float f32x4 __attribute__((ext_vector_type(4)));
typedef float f32x2 __attribute__((ext_vector_type(2)));
typedef unsigned u32x4 __attribute__((ext_vector_type(4)));
typedef unsigned u32x2 __attribute__((ext_vector_type(2)));
typedef int v8i __attribute__((ext_vector_type(8)));

constexpr int T = 16384, D = 1024, SEQ = 8192, DEPTH = 4;
constexpr float EPS = 1e-6f;
constexpr int NBLK = 256, NTHR = 512, NWAVE = 8, NGW = NBLK * NWAVE;

constexpr size_t MiB = 1u << 20;
constexpr size_t WS_CTL = 0;
constexpr size_t WS_MOD = 1 * MiB;
constexpr size_t WS_HGWIN = 2 * MiB;
constexpr size_t WS_HGWOUT = 22 * MiB;
constexpr size_t WS_LRWIN = 26 * MiB;
constexpr size_t WS_LRWG = 34 * MiB;
constexpr size_t WS_LRWOUT = 38 * MiB;
constexpr size_t WS_WQK = 42 * MiB;
constexpr size_t WS_TOPI = 58 * MiB;
constexpr size_t WS_TOPG = 66 * MiB;
constexpr size_t WS_DEC = 74 * MiB;
constexpr size_t WS_CP = 75 * MiB;
constexpr size_t WS_CH = 79 * MiB;
constexpr size_t WS_HIN = 83 * MiB;
constexpr size_t WS_USC = 87 * MiB;
constexpr size_t WS_VSC = 87 * MiB + 262144;
constexpr size_t WS_XRES = 88 * MiB;
constexpr size_t WS_HBUF = 152 * MiB;
constexpr size_t WS_OB = 184 * MiB;
constexpr size_t WS_PROJ = 216 * MiB;
constexpr size_t WS_XB = WS_PROJ, WS_YG = WS_PROJ + 32 * MiB, WS_XC = WS_PROJ + 64 * MiB, WS_LOGA = WS_PROJ + 96 * MiB;
constexpr size_t WS_SCORES = WS_PROJ;
constexpr size_t WS_KV = 376 * MiB;
constexpr size_t WS_BTERM = WS_KV;
constexpr size_t WS_SIN = 504 * MiB;
constexpr size_t WS_UTAB = 568 * MiB;
constexpr size_t WS_VTAB = 696 * MiB;
constexpr size_t WS_HB8 = 824 * MiB;
constexpr size_t WS_END = 840 * MiB;

constexpr int LDS_BYTES = 155648;

#define LAUNDER_IDS int tidL = threadIdx.x, bidL = blockIdx.x; asm volatile("" : "+v"(tidL)); asm volatile("" : "+s"(bidL));
__device__ __forceinline__ float bf2f(bf16_t b) { return __uint_as_float(((unsigned)b) << 16); }
__device__ __forceinline__ float bflo(unsigned u) { return __uint_as_float(u << 16); }
__device__ __forceinline__ float bfhi(unsigned u) { return __uint_as_float(u & 0xffff0000u); }
__device__ __forceinline__ unsigned cvt_pk_bf16(float lo, float hi) { unsigned r; asm volatile("v_cvt_pk_bf16_f32 %0, %1, %2" : "=v"(r) : "v"(lo), "v"(hi)); return r; }
__device__ __forceinline__ unsigned pk_bf16_rne(float lo, float hi) { unsigned a = __float_as_uint(lo), b = __float_as_uint(hi); a += 0x7fffu + ((a >> 16) & 1u); b += 0x7fffu + ((b >> 16) & 1u); return (a >> 16) | (b & 0xffff0000u); }
__device__ __forceinline__ bf16_t f2bf(float f) { return (bf16_t)(cvt_pk_bf16(f, 0.f) & 0xffffu); }
__device__ __forceinline__ float fast_exp(float x) { return __builtin_amdgcn_exp2f(x * 1.4426950408889634f); }
__device__ __forceinline__ float fast_log(float x) { return __builtin_amdgcn_logf(x) * 0.6931471805599453f; }
__device__ __forceinline__ float fast_rcp(float x) { return __builtin_amdgcn_rcpf(x); }
__device__ __forceinline__ float sigmoidf_(float x) { return fast_rcp(1.f + fast_exp(-x)); }
__device__ __forceinline__ float gelu_tanh(float x) { const float u = 1.5957691216057308f * (x + 0.044715f * x * x * x); return x * fast_rcp(1.f + fast_exp(-u)); }
__device__ __forceinline__ float silu_(float x) { return x * sigmoidf_(x); }
__device__ __forceinline__ float wave_sum(float v) {
#pragma unroll
    for (int o = 1; o < 64; o <<= 1) v += __shfl_xor(v, o);
    return v;
}
__device__ __forceinline__ float wave_max(float v) {
#pragma unroll
    for (int o = 1; o < 64; o <<= 1) v = fmaxf(v, __shfl_xor(v, o));
    return v;
}

namespace pg8 {
constexpr int BM = 256, BK = 64, HALF = 128, HTB = HALF * BK * 2, STAGE_BYTES = 8 * HTB, NXCD = 8, WGM = 8;
__host__ __device__ __forceinline__ int lds_byte(int r, int c) { const int st = (r >> 4) * 2 + (c >> 5), rr = r & 15, cc = c & 31, ob = rr * 64 + cc * 2; return st * 1024 + (ob ^ (((ob >> 9) & 1) << 5)); }
__host__ __device__ __forceinline__ void stage_rc(int b, int& R, int& C) { const int st = b / 1024, sb = b % 1024, swz = sb ^ (((sb >> 9) & 1) << 5); R = (st >> 1) * 16 + swz / 64; C = (st & 1) * 32 + (swz % 64) / 2; }
__host__ __device__ __forceinline__ int perm32(int rho) { const int n = rho >> 4, i = rho & 15; return 8 * (i >> 2) + 4 * n + (i & 3); }
struct Unit { int pm, pn; };
struct Gemm { const bf16_t* A; const bf16_t* Bt; int M, N, K, lda, ldb, a_pn_shift, a_pn_stride; };
struct StaticOrder {
    int nM, nN, nwg, G, c;
    __host__ __device__ void init(int M, int N, int G_, int c_) { nM = M / BM; nN = N / BM; nwg = nM * nN; G = G_; c = c_; }
    __host__ __device__ bool next(int i, Unit& u) const {
        const long L = (long)i * G + c; if (L >= nwg) return false;
        int wgid = (int)L; { const int q = nwg / NXCD, r = nwg % NXCD, xcd = wgid % NXCD, off = wgid / NXCD; wgid = (xcd < r ? xcd * (q + 1) : r * (q + 1) + (xcd - r) * q) + off; }
        const int nig = WGM * nN, gid = wgid / nig, fm = gid * WGM, gsz = (nM - fm) < WGM ? (nM - fm) : WGM;
        u.pm = fm + ((wgid % nig) % gsz); u.pn = (wgid % nig) / gsz; return true;
    }
    __device__ __forceinline__ void a_ready(const Unit&) const {}
    __device__ __forceinline__ void done(const Unit&) const {}
};
template <class Epi, class Sched, bool STAMP = false>
__device__ __forceinline__ void gemm_phase(PG8_LAS unsigned char* lds, const Gemm g, const Sched& S, const Epi& E, unsigned long long* stamps) {
    int tid = threadIdx.x; asm volatile("" : "+v"(tid)); const int wid = __builtin_amdgcn_readfirstlane(tid >> 6), lane = tid & 63, wr = wid >> 2, wc = wid & 3, fr = lane & 15, fq = lane >> 4;
    const int K = g.K, nt = K / BK;
    int ts_lo = 0, ts_hi = 0, nts = 0; const unsigned long long rt_entry = STAMP ? (unsigned long long)wall_clock64() : 0ull;
#define PG8_STAMP() do { if (STAMP && wid == 0 && nts < 64) { const unsigned long long _c = (unsigned long long)clock64(); \
        ts_lo = (lane == nts) ? (int)(unsigned)_c : ts_lo; ts_hi = (lane == nts) ? (int)(unsigned)(_c >> 32) : ts_hi; ++nts; } } while (0)
    PG8_STAMP();
    unsigned voffA[2], voffB[2];
#pragma unroll
    for (int i = 0; i < 2; ++i) { int R, C; stage_rc(tid * 16 + i * 8192, R, C); const int Rb = Epi::PERM ? ((R & ~31) + perm32(R & 31)) : R;
        voffA[i] = (unsigned)(R * g.lda + C) * 2u; voffB[i] = (unsigned)(Rb * g.ldb + C) * 2u; }
    const size_t kstep = (size_t)(BK * 2);
    const size_t hstepA = (size_t)HALF * g.lda * 2, hstepB = (size_t)HALF * g.ldb * 2;
    const size_t tstepA = 2 * hstepA, tstepB = 2 * hstepB;
    const unsigned ldsw = (unsigned)wid * 1024u;
    const int aoff = lds_byte(wr * 64 + fr, fq * 8), boff = lds_byte(wc * 32 + fr, fq * 8);
#define PG8_SA(b, h) (((b) * 2 + (h)) * HTB)
#define PG8_SB(b, h) ((4 + (b) * 2 + (h)) * HTB)
#define PG8_STAGE(bufoff, gbase, voff) do { _Pragma("unroll") for (int _i = 0; _i < 2; ++_i) \
        __builtin_amdgcn_global_load_lds((const unsigned*)((const char*)(gbase) + (voff)[_i]), (PG8_LAS unsigned*)(lds + (bufoff) + ldsw + _i * 8192), 16, 0, 0); } while (0)
#define PG8_LDA(dst, b, h) do { _Pragma("unroll") for (int m = 0; m < 4; ++m) _Pragma("unroll") for (int k = 0; k < 2; ++k) dst[m][k] = *(const PG8_LAS bf16x8*)(lds + PG8_SA(b, h) + aoff + m * 2048 + k * 1024); } while (0)
#define PG8_LDB(dst, b, h) do { _Pragma("unroll") for (int n = 0; n < 2; ++n) _Pragma("unroll") for (int k = 0; k < 2; ++k) dst[n][k] = *(const PG8_LAS bf16x8*)(lds + PG8_SB(b, h) + boff + n * 2048 + k * 1024); } while (0)
#define PG8_MMA(ai, bj, At, Bt) do { __builtin_amdgcn_s_setprio(1); _Pragma("unroll") for (int m = 0; m < 4; ++m) _Pragma("unroll") for (int n = 0; n < 2; ++n) _Pragma("unroll") for (int k = 0; k < 2; ++k) \
        acc[ai][bj][m][n] = Epi::SWAP ? __builtin_amdgcn_mfma_f32_16x16x32_bf16(At[m][k], Bt[n][k], acc[ai][bj][m][n], 0, 0, 0) : __builtin_amdgcn_mfma_f32_16x16x32_bf16(Bt[n][k], At[m][k], acc[ai][bj][m][n], 0, 0, 0); __builtin_amdgcn_s_setprio(0); } while (0)
#define PG8_WAIT_V(n) asm volatile("s_waitcnt vmcnt(" #n ")" ::: "memory")
#define PG8_WAIT_L(n) asm volatile("s_waitcnt lgkmcnt(" #n ")" ::: "memory")
#define PG8_BAR __builtin_amdgcn_s_barrier()
#define PG8_SCHED __builtin_amdgcn_sched_barrier(0)
    Unit cur, nxt; int ui = 0;
    if (!S.next(0, cur)) return;
    f32x4 acc[2][2][4][2];
#pragma unroll
    for (int a = 0; a < 2; ++a)
#pragma unroll
        for (int b = 0; b < 2; ++b)
#pragma unroll
            for (int m = 0; m < 4; ++m)
#pragma unroll
                for (int n = 0; n < 2; ++n) acc[a][b][m][n] = (f32x4){0.f, 0.f, 0.f, 0.f};
    bf16x8 At[4][2], B0[2][2], B1[2][2];
    const char* cA = (const char*)g.A + (size_t)cur.pm * tstepA + (size_t)(cur.pn >> g.a_pn_shift) * g.a_pn_stride; const char* cB = (const char*)g.Bt + (size_t)cur.pn * tstepB;
    S.a_ready(cur);
    PG8_STAGE(PG8_SB(0, 0), cB, voffB); PG8_STAGE(PG8_SA(0, 0), cA, voffA); PG8_STAGE(PG8_SB(0, 1), cB + hstepB, voffB); PG8_STAGE(PG8_SA(0, 1), cA + hstepA, voffA);
    if (wr == 1) PG8_BAR;
    PG8_WAIT_V(4); PG8_BAR;
    PG8_STAGE(PG8_SB(1, 0), cB + kstep, voffB); PG8_STAGE(PG8_SA(1, 0), cA + kstep, voffA); PG8_STAGE(PG8_SB(1, 1), cB + hstepB + kstep, voffB);
    PG8_WAIT_V(6); PG8_BAR;
    PG8_STAMP();
    for (;;) {
        const bool has_next = S.next(ui + 1, nxt);
        const char* nA = has_next ? (const char*)g.A + (size_t)nxt.pm * tstepA + (size_t)(nxt.pn >> g.a_pn_shift) * g.a_pn_stride : cA; const char* nB = has_next ? (const char*)g.Bt + (size_t)nxt.pn * tstepB : cB;
#pragma unroll 1
        for (int t = 0; t < nt; t += 2) {
            const bool last = (t == nt - 2);
            const char* a1 = cA + (size_t)(t + 1) * kstep;
            const char* a2 = last ? nA : cA + (size_t)(t + 2) * kstep; const char* b2 = last ? nB : cB + (size_t)(t + 2) * kstep;
            const char* a3 = a2 + kstep; const char* b3 = b2 + kstep;
            if (last && has_next) S.a_ready(nxt);
            PG8_LDB(B0, 0, 0); PG8_SCHED; PG8_LDA(At, 0, 0); PG8_STAGE(PG8_SA(1, 1), a1 + hstepA, voffA);
            PG8_WAIT_L(8); PG8_BAR; PG8_WAIT_L(0); PG8_MMA(0, 0, At, B0); PG8_BAR; PG8_SCHED;
            PG8_LDB(B1, 0, 1); PG8_STAGE(PG8_SB(0, 0), b2, voffB);
            PG8_BAR; PG8_WAIT_L(0); PG8_MMA(0, 1, At, B1); PG8_BAR;
            PG8_LDA(At, 0, 1); PG8_STAGE(PG8_SA(0, 0), a2, voffA);
            PG8_BAR; PG8_WAIT_L(0); PG8_MMA(1, 0, At, B0); PG8_BAR; PG8_SCHED;
            PG8_STAGE(PG8_SB(0, 1), b2 + hstepB, voffB);
            PG8_WAIT_V(6); PG8_BAR; PG8_MMA(1, 1, At, B1); PG8_BAR;
            PG8_LDB(B0, 1, 0); PG8_SCHED; PG8_LDA(At, 1, 0); PG8_STAGE(PG8_SA(0, 1), a2 + hstepA, voffA);
            PG8_WAIT_L(8); PG8_BAR; PG8_WAIT_L(0); PG8_MMA(0, 0, At, B0); PG8_BAR; PG8_SCHED;
            PG8_LDB(B1, 1, 1); PG8_STAGE(PG8_SB(1, 0), b3, voffB);
            PG8_BAR; PG8_WAIT_L(0); PG8_MMA(0, 1, At, B1); PG8_BAR;
            PG8_LDA(At, 1, 1); PG8_STAGE(PG8_SA(1, 0), a3, voffA);
            PG8_BAR; PG8_WAIT_L(0); PG8_MMA(1, 0, At, B0); PG8_BAR; PG8_SCHED;
            PG8_STAGE(PG8_SB(1, 1), b3 + hstepB, voffB);
            PG8_WAIT_V(6); PG8_BAR; PG8_MMA(1, 1, At, B1); PG8_BAR;
        }
        PG8_STAMP();
        if constexpr (!Epi::AFTER_DRAIN) { E(acc, cur, wr, wc, fr, fq); S.done(cur); }
        PG8_STAMP();
        if (!has_next) break;
#pragma unroll
        for (int a = 0; a < 2; ++a)
#pragma unroll
            for (int b = 0; b < 2; ++b)
#pragma unroll
                for (int m = 0; m < 4; ++m)
#pragma unroll
                    for (int n = 0; n < 2; ++n) acc[a][b][m][n] = (f32x4){0.f, 0.f, 0.f, 0.f};
        cur = nxt; cA = nA; cB = nB; ++ui;
    }
    PG8_WAIT_V(0);
    if (wr == 0) PG8_BAR;
    PG8_BAR;
    if constexpr (Epi::AFTER_DRAIN) { E.fused(acc, cur, wr, wc, fr, fq, lds, wid, lane); S.done(cur); }
    PG8_STAMP();
    if (STAMP && wid == 0) { stamps[lane] = lane < nts ? (((unsigned long long)(unsigned)ts_hi << 32) | (unsigned)ts_lo) : 0ull;
        if (lane == 62) stamps[62] = rt_entry; if (lane == 63) stamps[63] = (unsigned long long)wall_clock64(); }
#undef PG8_STAMP
#undef PG8_SA
#undef PG8_SB
#undef PG8_STAGE
#undef PG8_LDA
#undef PG8_LDB
#undef PG8_MMA
#undef PG8_WAIT_V
#undef PG8_WAIT_L
#undef PG8_BAR
#undef PG8_SCHED
}
}
using pg8::Unit;

struct EpiBf16 {
    static constexpr bool PERM = true, AFTER_DRAIN = false, SWAP = false;
    bf16_t* O; int ldc;
    __device__ __forceinline__ void operator()(const f32x4 (&acc)[2][2][4][2], const Unit& u, int wr, int wc, int fr, int fq) const {
        const int row0 = u.pm * 256 + wr * 64 + fr, col0 = u.pn * 256 + wc * 32 + 8 * fq;
#pragma unroll
        for (int ai = 0; ai < 2; ++ai)
#pragma unroll
            for (int m = 0; m < 4; ++m) { bf16_t* rowp = O + (size_t)(row0 + ai * 128 + m * 16) * ldc + col0;
#pragma unroll
                for (int bj = 0; bj < 2; ++bj) { const f32x4 v0 = acc[ai][bj][m][0], v1 = acc[ai][bj][m][1];
                    u32x4 o; o.x = cvt_pk_bf16(v0[0], v0[1]); o.y = cvt_pk_bf16(v0[2], v0[3]); o.z = cvt_pk_bf16(v1[0], v1[1]); o.w = cvt_pk_bf16(v1[2], v1[3]);
                    *(u32x4*)(rowp + bj * 128) = o; } }
    }
};
struct EpiLruIn {
    static constexpr bool PERM = true, AFTER_DRAIN = false, SWAP = false;
    bf16_t* XB; bf16_t* YG;
    __device__ __forceinline__ void operator()(const f32x4 (&acc)[2][2][4][2], const Unit& u, int wr, int wc, int fr, int fq) const {
        const bool isy = u.pn >= 4;
        bf16_t* O = isy ? YG : XB;
        const int row0 = u.pm * 256 + wr * 64 + fr, col0 = (u.pn & 3) * 256 + wc * 32 + 8 * fq;
#pragma unroll
        for (int ai = 0; ai < 2; ++ai)
#pragma unroll
            for (int m = 0; m < 4; ++m) { bf16_t* rowp = O + (size_t)(row0 + ai * 128 + m * 16) * 1024 + col0;
#pragma unroll
                for (int bj = 0; bj < 2; ++bj) { f32x4 v0 = acc[ai][bj][m][0], v1 = acc[ai][bj][m][1];
                    if (isy) {
#pragma unroll
                        for (int i = 0; i < 4; ++i) { v0[i] = gelu_tanh(v0[i]); v1[i] = gelu_tanh(v1[i]); } }
                    u32x4 o; o.x = cvt_pk_bf16(v0[0], v0[1]); o.y = cvt_pk_bf16(v0[2], v0[3]); o.z = cvt_pk_bf16(v1[0], v1[1]); o.w = cvt_pk_bf16(v1[2], v1[3]);
                    *(u32x4*)(rowp + bj * 128) = o; } }
    }
};
struct EpiGates {
    static constexpr bool PERM = true, AFTER_DRAIN = false, SWAP = false;
    bf16_t* LOGA; bf16_t* BTERM; const bf16_t* XC; const float* b_a; const float* b_x; const float* lam;
    __device__ __forceinline__ void operator()(const f32x4 (&acc)[2][2][4][2], const Unit& u, int wr, int wc, int fr_, int fq) const {
        int fr = fr_; asm volatile("" : "+v"(fr));
        const int nblk = u.pn >> 2, uu = u.pn & 3, d = uu >> 1, jh = uu & 1;
        const int colbase = nblk * 256 + jh * 128 + wc * 32 + 8 * fq;
        const unsigned off0 = (unsigned)(u.pm * 256 + wr * 64 + fr) * 1024u + (unsigned)colbase;
        const bf16_t* xcp = XC; bf16_t* lap = LOGA + (size_t)d * T * 1024; bf16_t* btp = BTERM + (size_t)d * T * 1024;
        const float* bap = b_a + d * 1024; const float* bxp = b_x + d * 1024; const float* lmp = lam + d * 1024;
#pragma unroll
        for (int ai = 0; ai < 2; ++ai)
#pragma unroll
            for (int m = 0; m < 4; ++m) { const unsigned off = off0 + (unsigned)(ai * 128 + m * 16) * 1024u;
                asm volatile("" ::: "memory"); __builtin_amdgcn_sched_barrier(0);
                const u32x4 xr = *(const u32x4*)(xcp + off);
                const float xv[8] = {bflo(xr.x), bfhi(xr.x), bflo(xr.y), bfhi(xr.y), bflo(xr.z), bfhi(xr.z), bflo(xr.w), bfhi(xr.w)};
                unsigned o1[4], o2[4];
#pragma unroll
                for (int n = 0; n < 2; ++n) { const f32x4 ba = *(const f32x4*)(bap + (unsigned)(colbase + 4 * n)), bx = *(const f32x4*)(bxp + (unsigned)(colbase + 4 * n)), lm = *(const f32x4*)(lmp + (unsigned)(colbase + 4 * n));
                    float la[4], bt[4];
#pragma unroll
                    for (int i = 0; i < 4; ++i) { const float r = sigmoidf_(acc[ai][0][m][n][i] + ba[i]), ig = sigmoidf_(acc[ai][1][m][n][i] + bx[i]);
                        const float l = -8.f * fast_log(1.f + fast_exp(-lm[i])) * r; const float mult = __builtin_sqrtf(fmaxf(1.f - fast_exp(2.f * l), 0.f));
                        la[i] = l; bt[i] = mult * ig * xv[n * 4 + i]; }
                    o1[n * 2] = cvt_pk_bf16(la[0], la[1]); o1[n * 2 + 1] = cvt_pk_bf16(la[2], la[3]); o2[n * 2] = cvt_pk_bf16(bt[0], bt[1]); o2[n * 2 + 1] = cvt_pk_bf16(bt[2], bt[3]); }
                *(u32x4*)(lap + off) = (u32x4){o1[0], o1[1], o1[2], o1[3]}; *(u32x4*)(btp + off) = (u32x4){o2[0], o2[1], o2[2], o2[3]}; }
    }
};
struct EpiResid {
    static constexpr bool PERM = false, AFTER_DRAIN = false, SWAP = false;
    const float* xin; float* xout; const float* gate; bool dry;
    __device__ __forceinline__ void operator()(const f32x4 (&acc)[2][2][4][2], const Unit& u, int wr, int wc, int fr, int fq) const {
        const int row0 = u.pm * 256 + wr * 64 + fr, col0 = u.pn * 256 + wc * 32 + 4 * fq;
        const float* gp = gate + ((u.pm * 256) >> 13) * 6144 + col0;
        f32x4 gv[2][2];
#pragma unroll
        for (int bj = 0; bj < 2; ++bj)
#pragma unroll
            for (int n = 0; n < 2; ++n) gv[bj][n] = *(const f32x4*)(gp + bj * 128 + n * 16);
#pragma unroll
        for (int ai = 0; ai < 2; ++ai)
#pragma unroll
            for (int m = 0; m < 4; ++m) { const size_t off = (size_t)(row0 + ai * 128 + m * 16) * 1024 + col0;
#pragma unroll
                for (int bj = 0; bj < 2; ++bj)
#pragma unroll
                    for (int n = 0; n < 2; ++n) { const f32x4 xv = *(const f32x4*)(xin + off + bj * 128 + n * 16);
                        if (!dry) *(f32x4*)(xout + off + bj * 128 + n * 16) = xv + gv[bj][n] * acc[ai][bj][m][n]; } }
    }
};
struct EpiF32 {
    static constexpr bool PERM = false, AFTER_DRAIN = false, SWAP = false;
    float* C; int ldc;
    __device__ __forceinline__ void operator()(const f32x4 (&acc)[2][2][4][2], const Unit& u, int wr, int wc, int fr_, int fq) const {
        int fr = fr_; asm volatile("" : "+v"(fr));
        const int row0 = u.pm * 256 + wr * 64 + fr, col0 = u.pn * 256 + wc * 32 + 4 * fq;
#pragma unroll
        for (int ai = 0; ai < 2; ++ai)
#pragma unroll
            for (int m = 0; m < 4; ++m) { float* rowp = C + (size_t)(row0 + ai * 128 + m * 16) * ldc + col0;
#pragma unroll
                for (int bj = 0; bj < 2; ++bj)
#pragma unroll
                    for (int n = 0; n < 2; ++n) *(f32x4*)(rowp + bj * 128 + n * 16) = acc[ai][bj][m][n]; }
    }
};

struct Params {
    const float *x, *c, *w_ada, *b_ada, *norm_g, *hg_w_in, *hg_lb, *hg_norm_g, *hg_w_out, *lru_w_in, *lru_conv_w, *lru_conv_b,
        *lru_w_a, *lru_b_a, *lru_w_x, *lru_b_x, *lru_lam, *lru_w_out, *peer_w_q, *peer_keys, *peer_u, *peer_v, *final_g;
    float* out; unsigned char* ws; int ph_lo, ph_hi; unsigned rep_mask; int pad_;
};

typedef const __attribute__((address_space(4))) Params* KP;

template <class Epi>
__device__ __forceinline__ void run_gemm(LAS unsigned char* lds, const bf16_t* A, const bf16_t* Bt, int N, int K, int lda, int ldb, int a_pn_shift, int a_pn_stride, const Epi& E) {
    pg8::Gemm g; g.A = A; g.Bt = Bt; g.M = T; g.N = N; g.K = K; g.lda = lda; g.ldb = ldb; g.a_pn_shift = a_pn_shift; g.a_pn_stride = a_pn_stride;
    LAUNDER_IDS
    pg8::StaticOrder S; S.init(T, N, (int)gridDim.x, bidL); (void)tidL;
    pg8::gemm_phase<Epi, pg8::StaticOrder, false>(lds, g, S, E, nullptr);
    __syncthreads();
}

__device__ __forceinline__ void transpose_tile(const float* __restrict__ src, int ld_src, bf16_t* dst, int ld_dst, LAS float* tile, int tid) {
#pragma unroll
    for (int it = 0; it < 2; ++it) { const int r = (tid >> 4) + 32 * it, c4 = (tid & 15) * 4;
        const f32x4 v = *(const f32x4*)(src + (size_t)r * ld_src + c4);
        tile[r * 65 + c4 + 0] = v[0]; tile[r * 65 + c4 + 1] = v[1]; tile[r * 65 + c4 + 2] = v[2]; tile[r * 65 + c4 + 3] = v[3]; }
    __syncthreads();
    { const int n = tid >> 3, kc = tid & 7; const LAS float* s = tile + (kc * 8) * 65 + n;
        u32x4 o; o.x = cvt_pk_bf16(s[0], s[65]); o.y = cvt_pk_bf16(s[2 * 65], s[3 * 65]); o.z = cvt_pk_bf16(s[4 * 65], s[5 * 65]); o.w = cvt_pk_bf16(s[6 * 65], s[7 * 65]);
        *(u32x4*)(dst + (size_t)n * ld_dst + kc * 8) = o; }
    __syncthreads();
}

__device__ __forceinline__ void phase0(KP p, LAS unsigned char* lds) {
    LAUNDER_IDS
    const int tid = tidL, wave = tid >> 6, lane = tid & 63;
    unsigned char* ws = p->ws;
    LAS float* tile = (LAS float*)lds;
    constexpr int I_HGIN = 16 * 80, I_SQ = 16 * 16, I_LRIN = 16 * 32, I_G = 16;
    constexpr int N_A = 2 * I_HGIN + 2 * I_SQ + 2 * I_LRIN + 2 * I_SQ + 32 * I_G;
    for (int it = bidL; it < N_A; it += gridDim.x) {
        int r = it;
        if (r < 2 * I_HGIN) { const int j = r / I_HGIN, q = r % I_HGIN, kb = q / 80, nb = q % 80;
            transpose_tile(p->hg_w_in + (size_t)j * 1024 * 5120 + (size_t)kb * 64 * 5120 + nb * 64, 5120, (bf16_t*)(ws + WS_HGWIN) + (size_t)j * 5120 * 1024 + (size_t)nb * 64 * 1024 + kb * 64, 1024, tile, tid); continue; }
        r -= 2 * I_HGIN;
        if (r < 2 * I_SQ) { const int j = r / I_SQ, q = r % I_SQ, kb = q / 16, nb = q % 16;
            transpose_tile(p->hg_w_out + (size_t)j * 1024 * 1024 + (size_t)kb * 64 * 1024 + nb * 64, 1024, (bf16_t*)(ws + WS_HGWOUT) + (size_t)j * 1024 * 1024 + (size_t)nb * 64 * 1024 + kb * 64, 1024, tile, tid); continue; }
        r -= 2 * I_SQ;
        if (r < 2 * I_LRIN) { const int j = r / I_LRIN, q = r % I_LRIN, kb = q / 32, nb = q % 32;
            transpose_tile(p->lru_w_in + (size_t)j * 1024 * 2048 + (size_t)kb * 64 * 2048 + nb * 64, 2048, (bf16_t*)(ws + WS_LRWIN) + (size_t)j * 2048 * 1024 + (size_t)nb * 64 * 1024 + kb * 64, 1024, tile, tid); continue; }
        r -= 2 * I_LRIN;
        if (r < 2 * I_SQ) { const int j = r / I_SQ, q = r % I_SQ, kb = q / 16, nb = q % 16;
            transpose_tile(p->lru_w_out + (size_t)j * 1024 * 1024 + (size_t)kb * 64 * 1024 + nb * 64, 1024, (bf16_t*)(ws + WS_LRWOUT) + (size_t)j * 1024 * 1024 + (size_t)nb * 64 * 1024 + kb * 64, 1024, tile, tid); continue; }
        r -= 2 * I_SQ;
        { const int mat = r / I_G, q = r % I_G, kb = q / 4, nb = q % 4;
            const int nblk = mat & 3, gate = (mat >> 2) & 1, d = (mat >> 3) & 1, l = mat >> 4;
            const float* src = (gate ? p->lru_w_x : p->lru_w_a) + (size_t)((l * 2 + d) * 4 + nblk) * 65536 + (size_t)kb * 64 * 256 + nb * 64;
            const int n0 = nb * 64, jh = n0 >> 7;
            bf16_t* dst = (bf16_t*)(ws + WS_LRWG) + (size_t)l * 4 * 1024 * 256 + (size_t)nblk * 1024 * 256 + (size_t)((d * 2 + jh) * 256 + gate * 128 + (n0 & 127)) * 256 + kb * 64;
            transpose_tile(src, 256, dst, 256, tile, tid); }
    }
    {
        LAS bf16_t* KA = (LAS bf16_t*)lds;
        LAS bf16_t* WB = (LAS bf16_t*)(lds + 128 * 136 * 2);
        const int l15 = lane & 15, lq = lane >> 4;
        for (int it = bidL; it < 1024; it += gridDim.x) {
            const int l = it >> 8, hp = (it >> 4) & 15, dt = it & 15;
            const float* kp = p->peer_keys + ((size_t)l * 16 + hp) * 16384;
            const float* wp = p->peer_w_q + (size_t)l * 1024 * 2048 + (size_t)(dt * 64) * 2048 + hp * 128;
            f32x4 kv[8], wv[4];
#pragma unroll
            for (int q = 0; q < 8; ++q) kv[q] = *(const f32x4*)(kp + (tid + 512 * q) * 4);
#pragma unroll
            for (int q = 0; q < 4; ++q) { const int e = (tid + 512 * q) * 4; wv[q] = *(const f32x4*)(wp + (size_t)(e >> 7) * 2048 + (e & 127)); }
#pragma unroll
            for (int q = 0; q < 8; ++q) { const int e = (tid + 512 * q) * 4; *(LAS u32x2*)(KA + (e >> 7) * 136 + (e & 127)) = (u32x2){cvt_pk_bf16(kv[q][0], kv[q][1]), cvt_pk_bf16(kv[q][2], kv[q][3])}; }
#pragma unroll
            for (int q = 0; q < 4; ++q) { const int e = (tid + 512 * q) * 4; *(LAS u32x2*)(WB + (e >> 7) * 136 + (e & 127)) = (u32x2){cvt_pk_bf16(wv[q][0], wv[q][1]), cvt_pk_bf16(wv[q][2], wv[q][3])}; }
            __syncthreads();
            const int rt = wave & 3, ct0 = (wave >> 2) * 4;
            f32x4 acc[4];
#pragma unroll
            for (int c = 0; c < 4; ++c) acc[c] = (f32x4){0.f, 0.f, 0.f, 0.f};
#pragma unroll
            for (int ks = 0; ks < 4; ++ks) { const bf16x8 av = *(const LAS bf16x8*)(WB + (rt * 16 + l15) * 136 + ks * 32 + lq * 8);
#pragma unroll
                for (int c = 0; c < 4; ++c) { const bf16x8 bv = *(const LAS bf16x8*)(KA + ((ct0 + c) * 16 + l15) * 136 + ks * 32 + lq * 8);
                    acc[c] = __builtin_amdgcn_mfma_f32_16x16x32_bf16(av, bv, acc[c], 0, 0, 0); } }
#pragma unroll
            for (int c = 0; c < 4; ++c) { bf16_t* op = (bf16_t*)(ws + WS_WQK) + (size_t)l * 2048 * 1024 + (size_t)(hp * 128 + (ct0 + c) * 16 + l15) * 1024 + dt * 64 + rt * 16 + lq * 4;
                *(u32x2*)op = (u32x2){pk_bf16_rne(acc[c][0], acc[c][1]), pk_bf16_rne(acc[c][2], acc[c][3])}; }
            __syncthreads();
        }
    }
    {
        LAS float* condL = (LAS float*)lds;
        LAS float* red = (LAS float*)(lds + 8192);
        for (int i = tid; i < 2048; i += NTHR) condL[i] = silu_(p->c[i]);
        __syncthreads();
        for (int it = bidL; it < 4 * 48; it += gridDim.x) {
            const int l = it / 48, col0 = (it % 48) * 128;
            const float* wp = p->w_ada + (size_t)l * 1024 * 6144 + col0 + 2 * lane;
            float a00 = 0.f, a01 = 0.f, a10 = 0.f, a11 = 0.f;
#pragma unroll 8
            for (int kk = 0; kk < 128; ++kk) { const int k = wave * 128 + kk; const f32x2 w = *(const f32x2*)(wp + (size_t)k * 6144);
                const float c0 = condL[k], c1 = condL[1024 + k];
                a00 += c0 * w[0]; a01 += c0 * w[1]; a10 += c1 * w[0]; a11 += c1 * w[1]; }
            red[(wave * 2 + 0) * 128 + 2 * lane] = a00; red[(wave * 2 + 0) * 128 + 2 * lane + 1] = a01;
            red[(wave * 2 + 1) * 128 + 2 * lane] = a10; red[(wave * 2 + 1) * 128 + 2 * lane + 1] = a11;
            __syncthreads();
            if (tid < 256) { const int b = tid >> 7, cc = tid & 127; float s = 0.f;
#pragma unroll
                for (int w = 0; w < 8; ++w) s += red[(w * 2 + b) * 128 + cc];
                ((float*)(ws + WS_MOD))[((size_t)l * 2 + b) * 6144 + col0 + cc] = s + p->b_ada[(size_t)l * 6144 + col0 + cc]; }
            __syncthreads();
        }
    }
    {
        const int nw = gridDim.x * NWAVE;
        for (int row0 = bidL * NWAVE + wave; row0 < 2 * 65536; row0 += 4 * nw) {
            f32x4 v[4][4];
#pragma unroll
            for (int rr = 0; rr < 4; ++rr) { const int row = row0 + rr * nw; const int tb = row >> 16, r = row & 65535;
                const float* src = (tb ? p->peer_v : p->peer_u) + (size_t)r * 1024 + 4 * lane;
#pragma unroll
                for (int jx = 0; jx < 4; ++jx) v[rr][jx] = __builtin_nontemporal_load((const f32x4*)(src + 256 * jx)); }
#pragma unroll
            for (int rr = 0; rr < 4; ++rr) { const int row = row0 + rr * nw; const int tb = row >> 16, r = row & 65535;
                float am = 0.f;
#pragma unroll
                for (int jx = 0; jx < 4; ++jx) am = fmaxf(am, fmaxf(fmaxf(fabsf(v[rr][jx][0]), fabsf(v[rr][jx][1])), fmaxf(fabsf(v[rr][jx][2]), fabsf(v[rr][jx][3]))));
                am = wave_max(am);
                const float sc = am > 0.f ? am * (1.f / 6.f) : 1.f, inv = am > 0.f ? 6.f / am : 1.f;
                unsigned char* dst = ws + (tb ? WS_VTAB : WS_UTAB) + (size_t)r * 512 + 2 * lane;
#pragma unroll
                for (int jx = 0; jx < 4; ++jx) { unsigned w = __builtin_amdgcn_cvt_scalef32_pk_fp4_f32(0u, v[rr][jx][0] * inv, v[rr][jx][1] * inv, 1.0f, 0);
                    w = __builtin_amdgcn_cvt_scalef32_pk_fp4_f32(w, v[rr][jx][2] * inv, v[rr][jx][3] * inv, 1.0f, 1);
                    *(unsigned short*)(dst + 128 * jx) = (unsigned short)(w & 0xffffu); }
                if (lane == 0) ((float*)(ws + (tb ? WS_VSC : WS_USC)))[r] = sc; }
        }
    }
}

__device__ __forceinline__ void phase_rms(const float* xin, const float* gain, const float* shift, const float* scale, bf16_t* hout, unsigned char* h8out) {
    LAUNDER_IDS
    const int tid = tidL, wave = tid >> 6, lane = tid & 63;
    const int nw = gridDim.x * NWAVE;
    for (int row0 = bidL * NWAVE + wave; row0 < T; row0 += 2 * nw) {
        f32x4 v[2][4]; float ss[2];
#pragma unroll
        for (int rr = 0; rr < 2; ++rr) { const int row = min(row0 + rr * nw, T - 1); const float* xr = xin + (size_t)row * 1024 + lane * 4;
#pragma unroll
            for (int j = 0; j < 4; ++j) v[rr][j] = *(const f32x4*)(xr + j * 256); }
#pragma unroll
        for (int rr = 0; rr < 2; ++rr) { float a = 0.f;
#pragma unroll
            for (int j = 0; j < 4; ++j) a += v[rr][j][0] * v[rr][j][0] + v[rr][j][1] * v[rr][j][1] + v[rr][j][2] * v[rr][j][2] + v[rr][j][3] * v[rr][j][3];
            ss[rr] = a; }
#pragma unroll
        for (int o = 1; o < 64; o <<= 1) { ss[0] += __shfl_xor(ss[0], o); ss[1] += __shfl_xor(ss[1], o); }
#pragma unroll
        for (int rr = 0; rr < 2; ++rr) { const int row = row0 + rr * nw; if (row >= T) continue; const int b = row >> 13;
            const float inv = __builtin_amdgcn_rsqf(ss[rr] * (1.f / 1024.f) + EPS);
#pragma unroll
            for (int j = 0; j < 4; ++j) { const int col = j * 256 + lane * 4;
                const f32x4 g = *(const f32x4*)(gain + col), sh = *(const f32x4*)(shift + b * 6144 + col), sc = *(const f32x4*)(scale + b * 6144 + col);
                const f32x4 y = (v[rr][j] * inv) * g * (1.f + sc) + sh;
                u32x2 o; o.x = cvt_pk_bf16(y[0], y[1]); o.y = cvt_pk_bf16(y[2], y[3]);
                *(u32x2*)(hout + (size_t)row * 1024 + col) = o;
                if (h8out) { int w8 = __builtin_amdgcn_cvt_pk_fp8_f32(y[0], y[1], 0, false); w8 = __builtin_amdgcn_cvt_pk_fp8_f32(y[2], y[3], w8, true); *(int*)(h8out + (size_t)row * 1024 + col) = w8; } } }
    }
}

constexpr int LROW = 136;
__device__ __forceinline__ float hg_lower_bound(const float* hg_lb, int j, int col) {
    if (j == 0) return 0.f;
    const float l0 = hg_lb[col], l1 = hg_lb[1024 + col];
    return fast_rcp(1.f + fast_exp(l0 - l1));
}
__device__ __forceinline__ f32x4 mfma16(bf16x8 a, bf16x8 b, f32x4 c) { return __builtin_amdgcn_mfma_f32_16x16x32_bf16(a, b, c, 0, 0, 0); }

__device__ __forceinline__ void load_v_regs(const bf16_t* proj, u32x4 (&vr)[4], int t0, int dir, int h, int tid) {
#pragma unroll
    for (int it = 0; it < 4; ++it) { const int idx = tid + 512 * it, tau = idx & 127, cv = idx >> 7;
        const int tok = dir ? t0 + 127 - tau : t0 + tau;
        vr[it] = *(const u32x4*)(proj + (size_t)tok * 5120 + 3072 + h * 128 + cv * 8); }
}
__device__ __forceinline__ void store_vt(LAS bf16_t* VT, const u32x4 (&vr)[4], int tid) {
#pragma unroll
    for (int it = 0; it < 4; ++it) { const int idx = tid + 512 * it, tau = idx & 127, cv = idx >> 7; const u32x4 v = vr[it];
        LAS bf16_t* d = VT + (cv * 8) * LROW + tau;
        d[0 * LROW] = (bf16_t)(v.x & 0xffff); d[1 * LROW] = (bf16_t)(v.x >> 16); d[2 * LROW] = (bf16_t)(v.y & 0xffff); d[3 * LROW] = (bf16_t)(v.y >> 16);
        d[4 * LROW] = (bf16_t)(v.z & 0xffff); d[5 * LROW] = (bf16_t)(v.z >> 16); d[6 * LROW] = (bf16_t)(v.w & 0xffff); d[7 * LROW] = (bf16_t)(v.w >> 16); }
}
__device__ __forceinline__ void load_tile_regs(const bf16_t* proj, u32x4 (&r)[4], int t0, int dir, int col0, int tid) {
#pragma unroll
    for (int it = 0; it < 4; ++it) { const int idx = tid + 512 * it, tau = idx >> 4, c16 = idx & 15;
        const int tok = dir ? t0 + 127 - tau : t0 + tau;
        r[it] = *(const u32x4*)(proj + (size_t)tok * 5120 + col0 + c16 * 8); }
}
__device__ __forceinline__ void store_tile(LAS bf16_t* TL, const u32x4 (&r)[4], int tid) {
#pragma unroll
    for (int it = 0; it < 4; ++it) { const int idx = tid + 512 * it, tau = idx >> 4, c16 = idx & 15; *(LAS u32x4*)(TL + tau * LROW + c16 * 8) = r[it]; }
}

__device__ __forceinline__ void hg_pass_a(KP p, LAS unsigned char* lds, int j) {
    LAUNDER_IDS
    const bf16_t* proj = (const bf16_t*)(p->ws + WS_PROJ);
    bf16_t* KVh = (bf16_t*)(p->ws + WS_KV); float* DEC = (float*)(p->ws + WS_DEC);
    LAS bf16_t* VT = (LAS bf16_t*)lds; LAS bf16_t* KT = (LAS bf16_t*)(lds + 34816); LAS float* TOT = (LAS float*)(lds + 69632); LAS bf16_t* ZT = (LAS bf16_t*)(lds + 71680);
    for (int u = bidL; u < 2048; u += gridDim.x) {
        int tid = tidL; asm volatile("" : "+v"(tid));
        const int wave = tid >> 6, lane = tid & 63;
        const int seq = u >> 6, c = u & 63, dir = seq & 1, h = (seq >> 1) & 7, b = seq >> 4;
        const int t0 = b * SEQ + c * 128;
        const int dk = tid & 127, g = tid >> 7;
        const float lb = hg_lower_bound(p->hg_lb, j, h * 128 + dk);
        float lcs[32], kks[32]; float lc = 0.f;
        { u32x4 zr[4], vr[4];
            load_tile_regs(proj, zr, t0, dir, 1024 * (1 + dir) + h * 128, tid); load_v_regs(proj, vr, t0, dir, h, tid);
            store_tile(ZT, zr, tid); store_vt(VT, vr, tid); }
        __syncthreads();
#pragma unroll
        for (int q = 0; q < 32; ++q) { const int tau = 32 * g + q;
            const float z = bf2f(ZT[tau * LROW + dk]);
            const float f = lb + (1.f - lb) * sigmoidf_(z);
            lc += fast_log(f); lcs[q] = lc; kks[q] = 1.f - f; }
        TOT[g * 128 + dk] = lc;
        __syncthreads();
        float rg = 0.f, total = 0.f;
#pragma unroll
        for (int gg = 0; gg < 4; ++gg) { const float tv = TOT[gg * 128 + dk]; total += tv; if (gg < g) rg += tv; }
        const float base = total - rg;
#pragma unroll
        for (int q8 = 0; q8 < 4; ++q8) { unsigned w[4];
#pragma unroll
            for (int e = 0; e < 4; ++e) { const int q = q8 * 8 + e * 2;
                w[e] = cvt_pk_bf16(kks[q] * fast_exp(base - lcs[q]), kks[q + 1] * fast_exp(base - lcs[q + 1])); }
            u32x4 o; o.x = w[0]; o.y = w[1]; o.z = w[2]; o.w = w[3];
            *(LAS u32x4*)(KT + dk * LROW + 32 * g + q8 * 8) = o; }
        if (g == 0) DEC[(size_t)u * 128 + dk] = fast_exp(total);
        __syncthreads();
        f32x4 acc[2][4];
#pragma unroll
        for (int a = 0; a < 2; ++a)
#pragma unroll
            for (int bb = 0; bb < 4; ++bb) acc[a][bb] = (f32x4){0.f, 0.f, 0.f, 0.f};
        const int l15 = lane & 15, lq = lane >> 4;
#pragma unroll
        for (int ks = 0; ks < 4; ++ks) {
            bf16x8 af[2], bfr[4];
#pragma unroll
            for (int a = 0; a < 2; ++a) af[a] = *(const LAS bf16x8*)(VT + (((wave & 3) * 2 + a) * 16 + l15) * LROW + ks * 32 + lq * 8);
#pragma unroll
            for (int bb = 0; bb < 4; ++bb) bfr[bb] = *(const LAS bf16x8*)(KT + (((wave >> 2) * 4 + bb) * 16 + l15) * LROW + ks * 32 + lq * 8);
#pragma unroll
            for (int a = 0; a < 2; ++a)
#pragma unroll
                for (int bb = 0; bb < 4; ++bb) acc[a][bb] = mfma16(bfr[bb], af[a], acc[a][bb]);
        }
        bf16_t* kvp = KVh + (size_t)u * 16384;
#pragma unroll
        for (int a = 0; a < 2; ++a)
#pragma unroll
            for (int bb = 0; bb < 4; ++bb) *(u32x2*)(kvp + (((wave & 3) * 2 + a) * 16 + l15) * 128 + ((wave >> 2) * 4 + bb) * 16 + lq * 4) = (u32x2){pk_bf16_rne(acc[a][bb][0], acc[a][bb][1]), pk_bf16_rne(acc[a][bb][2], acc[a][bb][3])};
        __syncthreads();
    }
}

__device__ __forceinline__ void hg_pass_b(KP p) {
    LAUNDER_IDS
    const bf16_t* KVh = (const bf16_t*)(p->ws + WS_KV); const float* DEC = (const float*)(p->ws + WS_DEC);
    bf16_t* SIN = (bf16_t*)(p->ws + WS_SIN);
    for (int e = bidL * NTHR + tidL; e < 131072; e += gridDim.x * NTHR) {
    const int seq = e >> 12, i4 = e & 4095, dir = seq & 1, dk = (i4 * 4) & 127;
    f32x4 S = {0.f, 0.f, 0.f, 0.f};
#pragma unroll 16
    for (int step = 0; step < 64; ++step) {
        const int c = dir ? 63 - step : step; const size_t u = (size_t)seq * 64 + c;
        const u32x2 kvr = *(const u32x2*)(KVh + u * 16384 + i4 * 4); const f32x4 kv = (f32x4){bflo(kvr.x), bfhi(kvr.x), bflo(kvr.y), bfhi(kvr.y)}; const f32x4 dc = *(const f32x4*)(DEC + u * 128 + dk);
        u32x2 o; o.x = cvt_pk_bf16(S[0], S[1]); o.y = cvt_pk_bf16(S[2], S[3]);
        *(u32x2*)(SIN + u * 16384 + i4 * 4) = o;
        S = dc * S + kv;
    }
    }
}

__device__ __forceinline__ void hg_pass_c(KP p, LAS unsigned char* lds, int j) {
    LAUNDER_IDS
    const bf16_t* proj = (const bf16_t*)(p->ws + WS_PROJ);
    const bf16_t* SIN = (const bf16_t*)(p->ws + WS_SIN);
    bf16_t* OB = (bf16_t*)(p->ws + WS_OB);
    LAS bf16_t* QT = (LAS bf16_t*)lds; LAS bf16_t* QI = (LAS bf16_t*)(lds + 34816); LAS bf16_t* KT = (LAS bf16_t*)(lds + 69632);
    LAS bf16_t* VT = (LAS bf16_t*)(lds + 104448); LAS bf16_t* PI = (LAS bf16_t*)(lds + 139264); LAS float* TOT = (LAS float*)(lds + 147968);
    LAS float* OSUM = (LAS float*)(lds + 69632);
    for (int u = bidL; u < 1024; u += gridDim.x) {
        int tid = tidL; asm volatile("" : "+v"(tid));
        const int wave = tid >> 6, lane = tid & 63, l15 = lane & 15, lq = lane >> 4;
        const int c = u & 63, h = (u >> 6) & 7, b = u >> 9;
        const int t0 = b * SEQ + c * 128;
        const int dk = tid & 127, g = tid >> 7;
        const float lb = hg_lower_bound(p->hg_lb, j, h * 128 + dk);
        const int tt = wave & 1, dvt0 = (wave >> 1) * 2;
        f32x4 oacc[2][4][2];
#pragma unroll
        for (int dir = 0; dir < 2; ++dir) {
            const size_t su = ((size_t)((b * 8 + h) * 2 + dir) * 64 + c);
            unsigned k0p[16]; float lc = 0.f; float kprev = 0.f;
            u32x4 vr[4];
            { u32x4 zr[4], qr[4];
                load_tile_regs(proj, zr, t0, dir, 1024 * (1 + dir) + h * 128, tid); load_tile_regs(proj, qr, t0, dir, h * 128, tid); load_v_regs(proj, vr, t0, dir, h, tid);
                __syncthreads();
                store_tile(KT, zr, tid); store_tile(VT, qr, tid); }
            __syncthreads();
#pragma unroll
            for (int q = 0; q < 32; ++q) { const int tau = 32 * g + q;
                const float z = bf2f(KT[tau * LROW + dk]), qv = bf2f(VT[tau * LROW + dk]);
                const float f = lb + (1.f - lb) * sigmoidf_(z);
                lc += fast_log(f);
                const float el = fast_exp(fmaxf(lc, -80.f));
                QT[tau * LROW + dk] = f2bf(qv * el);
                const float kcur = (1.f - f) * fast_rcp(el);
                if (q & 1) k0p[q >> 1] = cvt_pk_bf16(kprev, kcur); else kprev = kcur; }
            TOT[g * 128 + dk] = lc;
            __syncthreads();
            float r[4]; { float run = 0.f;
#pragma unroll
                for (int gg = 0; gg < 4; ++gg) { r[gg] = run; run += TOT[gg * 128 + dk]; } }
            float rg = 0.f;
#pragma unroll
            for (int gg = 0; gg < 4; ++gg) if (gg == g) rg = r[gg];
            { const float eg = fast_exp(rg);
#pragma unroll
                for (int q = 0; q < 32; ++q) QI[(32 * g + q) * LROW + dk] = f2bf(bf2f(QT[(32 * g + q) * LROW + dk]) * eg); }
            store_vt(VT, vr, tid);
            bf16x8 sfr[2][4];
#pragma unroll
            for (int n = 0; n < 2; ++n)
#pragma unroll
                for (int ks = 0; ks < 4; ++ks) sfr[n][ks] = *(const bf16x8*)(SIN + su * 16384 + (size_t)((dvt0 + n) * 16 + l15) * 128 + ks * 32 + lq * 8);
#pragma unroll
            for (int i = 0; i < 4; ++i) {
                if (g <= i) { const float e = fast_exp(r[i] - rg);
#pragma unroll
                    for (int q = 0; q < 32; ++q) KT[(32 * g + q) * LROW + dk] = f2bf(((q & 1) ? bfhi(k0p[q >> 1]) : bflo(k0p[q >> 1])) * e); }
                __syncthreads();
                for (int tl = wave; tl < 4 * (i + 1); tl += 8) { const int sm = tl >> 1, tn = tl & 1;
                    f32x4 a4 = {0.f, 0.f, 0.f, 0.f};
#pragma unroll
                    for (int ks = 0; ks < 4; ++ks) { const bf16x8 af = *(const LAS bf16x8*)(KT + (sm * 16 + l15) * LROW + ks * 32 + lq * 8);
                        const bf16x8 bq = *(const LAS bf16x8*)(QT + (32 * i + tn * 16 + l15) * LROW + ks * 32 + lq * 8);
                        a4 = mfma16(af, bq, a4); }
                    const int tloc = tn * 16 + l15, s0 = sm * 16 + lq * 4, tg = 32 * i + tloc;
                    u32x2 o; o.x = cvt_pk_bf16(s0 + 0 <= tg ? a4[0] : 0.f, s0 + 1 <= tg ? a4[1] : 0.f); o.y = cvt_pk_bf16(s0 + 2 <= tg ? a4[2] : 0.f, s0 + 3 <= tg ? a4[3] : 0.f);
                    *(LAS u32x2*)(PI + tloc * LROW + s0) = o; }
                __syncthreads();
                f32x4 a0 = {0.f, 0.f, 0.f, 0.f}, a1 = {0.f, 0.f, 0.f, 0.f};
                for (int ks = 0; ks <= i; ++ks) { const bf16x8 af = *(const LAS bf16x8*)(PI + (tt * 16 + l15) * LROW + ks * 32 + lq * 8);
                    const bf16x8 b0 = *(const LAS bf16x8*)(VT + ((dvt0 + 0) * 16 + l15) * LROW + ks * 32 + lq * 8);
                    const bf16x8 b1 = *(const LAS bf16x8*)(VT + ((dvt0 + 1) * 16 + l15) * LROW + ks * 32 + lq * 8);
                    a0 = mfma16(af, b0, a0); a1 = mfma16(af, b1, a1); }
#pragma unroll
                for (int ks = 0; ks < 4; ++ks) { const bf16x8 af = *(const LAS bf16x8*)(QI + (32 * i + tt * 16 + l15) * LROW + ks * 32 + lq * 8);
                    a0 = mfma16(af, sfr[0][ks], a0); a1 = mfma16(af, sfr[1][ks], a1); }
                oacc[dir][i][0] = a0; oacc[dir][i][1] = a1;
            }
        }
        __syncthreads();
#pragma unroll
        for (int i = 0; i < 4; ++i)
#pragma unroll
            for (int n = 0; n < 2; ++n)
#pragma unroll
                for (int rr = 0; rr < 4; ++rr) OSUM[(32 * i + tt * 16 + lq * 4 + rr) * 132 + (dvt0 + n) * 16 + l15] = oacc[0][i][n][rr];
        __syncthreads();
#pragma unroll
        for (int i = 0; i < 4; ++i)
#pragma unroll
            for (int n = 0; n < 2; ++n)
#pragma unroll
                for (int rr = 0; rr < 4; ++rr) OSUM[(127 - (32 * i + tt * 16 + lq * 4 + rr)) * 132 + (dvt0 + n) * 16 + l15] += oacc[1][i][n][rr];
        __syncthreads();
        { const int row = tid >> 2, part = tid & 3; const int tok = t0 + row;
            float ov[32]; float ss = 0.f;
#pragma unroll
            for (int q = 0; q < 8; ++q) { const f32x4 v = *(const LAS f32x4*)(OSUM + row * 132 + part * 32 + q * 4);
                ov[q * 4 + 0] = v[0]; ov[q * 4 + 1] = v[1]; ov[q * 4 + 2] = v[2]; ov[q * 4 + 3] = v[3]; ss += v[0] * v[0] + v[1] * v[1] + v[2] * v[2] + v[3] * v[3]; }
            ss += __shfl_xor(ss, 1); ss += __shfl_xor(ss, 2);
            const float inv = __builtin_amdgcn_rsqf(ss * (1.f / 128.f) + EPS);
            const int col = h * 128 + part * 32;
            const bf16_t* gp = proj + (size_t)tok * 5120 + 4096 + col; const float* ng = p->hg_norm_g + j * 1024 + col;
#pragma unroll
            for (int q = 0; q < 4; ++q) { const u32x4 gr = *(const u32x4*)(gp + q * 8);
                const float gv[8] = {bflo(gr.x), bfhi(gr.x), bflo(gr.y), bfhi(gr.y), bflo(gr.z), bfhi(gr.z), bflo(gr.w), bfhi(gr.w)};
                float y[8];
#pragma unroll
                for (int e = 0; e < 8; ++e) y[e] = ov[q * 8 + e] * inv * ng[q * 8 + e] * silu_(gv[e]);
                u32x4 o; o.x = cvt_pk_bf16(y[0], y[1]); o.y = cvt_pk_bf16(y[2], y[3]); o.z = cvt_pk_bf16(y[4], y[5]); o.w = cvt_pk_bf16(y[6], y[7]);
                *(u32x4*)(OB + (size_t)tok * 1024 + col + q * 8) = o; }
        }
        __syncthreads();
    }
}

__device__ __forceinline__ void lru_conv(KP p, int l) {
    LAUNDER_IDS
    const bf16_t* XB = (const bf16_t*)(p->ws + WS_XB); bf16_t* XC = (bf16_t*)(p->ws + WS_XC);
    const float* cw = p->lru_conv_w + (size_t)l * 4 * 1024; const float* cb = p->lru_conv_b + (size_t)l * 1024;
    const int gs = gridDim.x * NTHR;
    for (int it = bidL * NTHR + tidL; it < T * 128; it += gs) {
        const int tok = it >> 7, c8 = (it & 127) * 8, s = tok & (SEQ - 1);
        float acc[8];
        { const f32x4 b0 = *(const f32x4*)(cb + c8), b1 = *(const f32x4*)(cb + c8 + 4);
            acc[0] = b0[0]; acc[1] = b0[1]; acc[2] = b0[2]; acc[3] = b0[3]; acc[4] = b1[0]; acc[5] = b1[1]; acc[6] = b1[2]; acc[7] = b1[3]; }
#pragma unroll
        for (int jj = 0; jj < 4; ++jj) { const int ts = s + jj - 2;
            if (ts >= 0 && ts < SEQ) { const u32x4 xr = *(const u32x4*)(XB + (size_t)(tok + jj - 2) * 1024 + c8);
                const f32x4 w0 = *(const f32x4*)(cw + jj * 1024 + c8), w1 = *(const f32x4*)(cw + jj * 1024 + c8 + 4);
                acc[0] += bflo(xr.x) * w0[0]; acc[1] += bfhi(xr.x) * w0[1]; acc[2] += bflo(xr.y) * w0[2]; acc[3] += bfhi(xr.y) * w0[3];
                acc[4] += bflo(xr.z) * w1[0]; acc[5] += bfhi(xr.z) * w1[1]; acc[6] += bflo(xr.w) * w1[2]; acc[7] += bfhi(xr.w) * w1[3]; } }
        u32x4 o; o.x = cvt_pk_bf16(acc[0], acc[1]); o.y = cvt_pk_bf16(acc[2], acc[3]); o.z = cvt_pk_bf16(acc[4], acc[5]); o.w = cvt_pk_bf16(acc[6], acc[7]);
        *(u32x4*)(XC + (size_t)tok * 1024 + c8) = o;
    }
}
__device__ __forceinline__ void lru_scan1(KP p, LAS unsigned char* lds) {
    LAUNDER_IDS
    const bf16_t* LOGA = (const bf16_t*)(p->ws + WS_LOGA); const bf16_t* BT = (const bf16_t*)(p->ws + WS_BTERM);
    float* CP = (float*)(p->ws + WS_CP); float* CH = (float*)(p->ws + WS_CH);
    LAS float* XP = (LAS float*)lds; LAS float* XH = (LAS float*)(lds + 16384);
    for (int u = bidL; u < 1024; u += gridDim.x) {
        int tid = tidL; asm volatile("" : "+v"(tid));
        const int ts = tid >> 7, c8 = (tid & 127) * 8;
        const int chunk = u & 255, dir = (u >> 8) & 1, b = u >> 9;
        const size_t base = ((size_t)dir * T + b * SEQ + chunk * 32) * 1024 + c8;
        u32x4 lw[8], bw[8];
#pragma unroll
        for (int q = 0; q < 8; ++q) { const int t = dir ? 31 - (ts * 8 + q) : ts * 8 + q; lw[q] = *(const u32x4*)(LOGA + base + (size_t)t * 1024); bw[q] = *(const u32x4*)(BT + base + (size_t)t * 1024); }
        float h[8], sl[8];
#pragma unroll
        for (int i = 0; i < 8; ++i) { h[i] = 0.f; sl[i] = 0.f; }
#pragma unroll
        for (int q = 0; q < 8; ++q) {
#pragma unroll
            for (int w = 0; w < 4; ++w) { const float l0 = bflo(lw[q][w]), l1 = bfhi(lw[q][w]);
                h[2 * w] = fast_exp(l0) * h[2 * w] + bflo(bw[q][w]); h[2 * w + 1] = fast_exp(l1) * h[2 * w + 1] + bfhi(bw[q][w]); sl[2 * w] += l0; sl[2 * w + 1] += l1; } }
        *(LAS f32x4*)(XP + ts * 1024 + c8) = (f32x4){fast_exp(sl[0]), fast_exp(sl[1]), fast_exp(sl[2]), fast_exp(sl[3])};
        *(LAS f32x4*)(XP + ts * 1024 + c8 + 4) = (f32x4){fast_exp(sl[4]), fast_exp(sl[5]), fast_exp(sl[6]), fast_exp(sl[7])};
        *(LAS f32x4*)(XH + ts * 1024 + c8) = (f32x4){h[0], h[1], h[2], h[3]}; *(LAS f32x4*)(XH + ts * 1024 + c8 + 4) = (f32x4){h[4], h[5], h[6], h[7]};
        __syncthreads();
        { const int ch = 2 * tid; float P0 = 1.f, P1 = 1.f, H0 = 0.f, H1 = 0.f;
#pragma unroll
            for (int s2 = 0; s2 < 4; ++s2) { const f32x2 pp = *(const LAS f32x2*)(XP + s2 * 1024 + ch), hh = *(const LAS f32x2*)(XH + s2 * 1024 + ch);
                H0 = pp[0] * H0 + hh[0]; H1 = pp[1] * H1 + hh[1]; P0 *= pp[0]; P1 *= pp[1]; }
            const size_t o = ((size_t)(b * 2 + dir) * 256 + chunk) * 1024 + ch;
            *(f32x2*)(CP + o) = (f32x2){P0, P1}; *(f32x2*)(CH + o) = (f32x2){H0, H1}; }
        __syncthreads();
    }
}
__device__ __forceinline__ void lru_scan2(KP p) {
    LAUNDER_IDS
    const float* CP = (const float*)(p->ws + WS_CP); const float* CH = (const float*)(p->ws + WS_CH); float* HIN = (float*)(p->ws + WS_HIN);
    const int wave = tidL >> 6, lane = tidL & 63;
    for (int item = bidL * NWAVE + wave; item < 4096; item += gridDim.x * NWAVE) {
        const int ch = item & 1023, bd = item >> 10, dir = bd & 1;
        float pp[4], hh[4]; float Pl = 1.f, Hl = 0.f;
#pragma unroll
        for (int q = 0; q < 4; ++q) { const int ci = 4 * lane + q, chunk = dir ? 255 - ci : ci; const size_t o = ((size_t)bd * 256 + chunk) * 1024 + ch;
            pp[q] = CP[o]; hh[q] = CH[o]; Hl = pp[q] * Hl + hh[q]; Pl *= pp[q]; }
#pragma unroll
        for (int off = 1; off < 64; off <<= 1) { const float Pp = __shfl_up(Pl, off), Hp = __shfl_up(Hl, off);
            if (lane >= off) { Hl = Pl * Hp + Hl; Pl = Pl * Pp; } }
        float carry = __shfl_up(Hl, 1); if (lane == 0) carry = 0.f;
#pragma unroll
        for (int q = 0; q < 4; ++q) { const int ci = 4 * lane + q, chunk = dir ? 255 - ci : ci; const size_t o = ((size_t)bd * 256 + chunk) * 1024 + ch;
            HIN[o] = carry; carry = pp[q] * carry + hh[q]; }
    }
}
__device__ __forceinline__ void lru_scan3(KP p, LAS unsigned char* lds) {
    LAUNDER_IDS
    const bf16_t* LOGA = (const bf16_t*)(p->ws + WS_LOGA); const bf16_t* BT = (const bf16_t*)(p->ws + WS_BTERM); const bf16_t* YG = (const bf16_t*)(p->ws + WS_YG);
    const float* HIN = (const float*)(p->ws + WS_HIN); bf16_t* OB = (bf16_t*)(p->ws + WS_OB);
    LAS float* XP = (LAS float*)lds; LAS float* XH = (LAS float*)(lds + 16384);
    for (int u = bidL; u < 512; u += gridDim.x) {
        int tid = tidL; asm volatile("" : "+v"(tid));
        const int ts = tid >> 7, c8 = (tid & 127) * 8;
        const int chunk = u & 255, b = u >> 8;
        const size_t base = ((size_t)b * SEQ + chunk * 32 + ts * 8) * 1024 + c8;
        unsigned hsp[8][4];
#pragma unroll
        for (int dir = 0; dir < 2; ++dir) {
            u32x4 lw[8], bw[8];
#pragma unroll
            for (int q = 0; q < 8; ++q) { lw[q] = *(const u32x4*)(LOGA + (size_t)dir * T * 1024 + base + (size_t)q * 1024); bw[q] = *(const u32x4*)(BT + (size_t)dir * T * 1024 + base + (size_t)q * 1024); }
            const f32x4 hi0 = *(const f32x4*)(HIN + ((size_t)(b * 2 + dir) * 256 + chunk) * 1024 + c8), hi1 = *(const f32x4*)(HIN + ((size_t)(b * 2 + dir) * 256 + chunk) * 1024 + c8 + 4);
            float h[8], sl[8];
#pragma unroll
            for (int i = 0; i < 8; ++i) { h[i] = 0.f; sl[i] = 0.f; }
#pragma unroll
            for (int qq = 0; qq < 8; ++qq) { const int q = dir ? 7 - qq : qq;
#pragma unroll
                for (int w = 0; w < 4; ++w) { const float l0 = bflo(lw[q][w]), l1 = bfhi(lw[q][w]);
                    h[2 * w] = fast_exp(l0) * h[2 * w] + bflo(bw[q][w]); h[2 * w + 1] = fast_exp(l1) * h[2 * w + 1] + bfhi(bw[q][w]); sl[2 * w] += l0; sl[2 * w + 1] += l1; } }
            __syncthreads();
            *(LAS f32x4*)(XP + ts * 1024 + c8) = (f32x4){fast_exp(sl[0]), fast_exp(sl[1]), fast_exp(sl[2]), fast_exp(sl[3])};
            *(LAS f32x4*)(XP + ts * 1024 + c8 + 4) = (f32x4){fast_exp(sl[4]), fast_exp(sl[5]), fast_exp(sl[6]), fast_exp(sl[7])};
            *(LAS f32x4*)(XH + ts * 1024 + c8) = (f32x4){h[0], h[1], h[2], h[3]}; *(LAS f32x4*)(XH + ts * 1024 + c8 + 4) = (f32x4){h[4], h[5], h[6], h[7]};
            __syncthreads();
            h[0] = hi0[0]; h[1] = hi0[1]; h[2] = hi0[2]; h[3] = hi0[3]; h[4] = hi1[0]; h[5] = hi1[1]; h[6] = hi1[2]; h[7] = hi1[3];
#pragma unroll
            for (int s3 = 0; s3 < 3; ++s3) { const int sr = dir ? 3 - s3 : s3; const bool use = dir ? (sr > ts) : (sr < ts);
                const f32x4 p0 = *(const LAS f32x4*)(XP + sr * 1024 + c8), p1 = *(const LAS f32x4*)(XP + sr * 1024 + c8 + 4), q0 = *(const LAS f32x4*)(XH + sr * 1024 + c8), q1 = *(const LAS f32x4*)(XH + sr * 1024 + c8 + 4);
                if (use) { h[0] = p0[0] * h[0] + q0[0]; h[1] = p0[1] * h[1] + q0[1]; h[2] = p0[2] * h[2] + q0[2]; h[3] = p0[3] * h[3] + q0[3];
                    h[4] = p1[0] * h[4] + q1[0]; h[5] = p1[1] * h[5] + q1[1]; h[6] = p1[2] * h[6] + q1[2]; h[7] = p1[3] * h[7] + q1[3]; } }
#pragma unroll
            for (int qq = 0; qq < 8; ++qq) { const int q = dir ? 7 - qq : qq;
                u32x4 yw; if (dir) yw = *(const u32x4*)(YG + base + (size_t)q * 1024);
                unsigned ow[4];
#pragma unroll
                for (int w = 0; w < 4; ++w) { h[2 * w] = fast_exp(bflo(lw[q][w])) * h[2 * w] + bflo(bw[q][w]); h[2 * w + 1] = fast_exp(bfhi(lw[q][w])) * h[2 * w + 1] + bfhi(bw[q][w]);
                    if (dir == 0) hsp[q][w] = cvt_pk_bf16(h[2 * w], h[2 * w + 1]);
                    else ow[w] = cvt_pk_bf16((bflo(hsp[q][w]) + h[2 * w]) * bflo(yw[w]), (bfhi(hsp[q][w]) + h[2 * w + 1]) * bfhi(yw[w])); }
                if (dir) *(u32x4*)(OB + base + (size_t)q * 1024) = (u32x4){ow[0], ow[1], ow[2], ow[3]}; }
        }
        __syncthreads();
    }
}

__device__ const unsigned char STAIR[64] = {
    0x00, 0x01, 0x02, 0x03, 0x04, 0x05, 0x06, 0x07, 0x08, 0x09, 0x0a, 0x0b, 0x0c, 0x0d, 0x0e, 0x0f,
    0x10, 0x11, 0x12, 0x13, 0x14, 0x15, 0x16, 0x17, 0x20, 0x21, 0x22, 0x23, 0x24, 0x30, 0x31, 0x32,
    0x33, 0x40, 0x41, 0x42, 0x50, 0x51, 0x60, 0x61, 0x70, 0x71, 0x80, 0x90, 0xa0, 0xb0, 0xc0, 0xd0,
    0xe0, 0xf0, 0, 0, 0, 0, 0, 0, 0, 0, 0, 0, 0, 0, 0, 0};
__device__ __forceinline__ unsigned mono_key(float f) { const unsigned b = __float_as_uint(f); return b ^ ((b >> 31) ? 0xffffffffu : 0x80000000u); }

__device__ __forceinline__ float inv_mono(unsigned k) { return __uint_as_float(k ^ ((k >> 31) ? 0x80000000u : 0xffffffffu)); }
#define TK_CE(A, B) do { const unsigned hi_ = max(A, B), lo_ = min(A, B); A = hi_; B = lo_; } while (0)
#define TK_SORT16(N) do { _Pragma("unroll") for (int k_ = 2; k_ <= 16; k_ <<= 1) { _Pragma("unroll") for (int j_ = k_ >> 1; j_ > 0; j_ >>= 1) { _Pragma("unroll") for (int i_ = 0; i_ < 16; ++i_) { \
    const int l_ = i_ ^ j_; if (l_ > i_) { if ((i_ & k_) == 0) TK_CE(N[i_], N[l_]); else TK_CE(N[l_], N[i_]); } } } } } while (0)
#define TK_MERGE16(L, N) do { _Pragma("unroll") for (int i_ = 0; i_ < 16; ++i_) L[i_] = max(L[i_], N[15 - i_]); \
    _Pragma("unroll") for (int j_ = 8; j_ > 0; j_ >>= 1) { _Pragma("unroll") for (int i_ = 0; i_ < 16; ++i_) { const int l_ = i_ ^ j_; if (l_ > i_) TK_CE(L[i_], L[l_]); } } } while (0)
#define TK_INSERT(L, x) do { _Pragma("unroll") for (int q_ = 0; q_ < 16; ++q_) { const unsigned hi_ = max(L[q_], x); x = min(L[q_], x); L[q_] = hi_; } } while (0)
__device__ __forceinline__ void peer_topk(KP p, LAS unsigned char* lds) {
    LAUNDER_IDS
    (void)bidL;
    const int tid = tidL, wave = tid >> 6, lane = tid & 63;
    const float* SC = (const float*)(p->ws + WS_SCORES);
    LAS float* TB = (LAS float*)(lds + 32768 + wave * 4608);
    int* TOPI = (int*)(p->ws + WS_TOPI); float* TOPG = (float*)(p->ws + WS_TOPG);
    LAS unsigned char* IX = lds + wave * 2048 + lane * 32;
    for (int item = bidL * NWAVE + wave; item < 2048; item += gridDim.x * NWAVE) {
        const int tg = item >> 3, hd = item & 7, tok = tg * 64 + lane;
        float V[2][16];
#pragma unroll
        for (int half = 0; half < 2; ++half) {
            unsigned L[16];
#pragma unroll
            for (int q = 0; q < 16; ++q) L[q] = 0u;
            const float* scb = SC + (size_t)(tg * 64 + (lane >> 2)) * 2048 + hd * 256 + half * 128 + (lane & 3) * 4;
            f32x4 nx[4];
#pragma unroll
            for (int i = 0; i < 4; ++i) nx[i] = *(const f32x4*)(scb + (size_t)(16 * i) * 2048);
#pragma unroll 1
            for (int kb = 0; kb < 8; ++kb) {
#pragma unroll
                for (int i = 0; i < 4; ++i) { LAS float* d = TB + ((lane >> 2) + 16 * i) * 17 + (lane & 3) * 4; d[0] = nx[i][0]; d[1] = nx[i][1]; d[2] = nx[i][2]; d[3] = nx[i][3]; }
                asm volatile("s_waitcnt lgkmcnt(0)" ::: "memory");
                float cur[16];
#pragma unroll
                for (int i = 0; i < 16; ++i) cur[i] = TB[lane * 17 + i];
                asm volatile("s_waitcnt lgkmcnt(0)" ::: "memory");
                const int kn = kb < 7 ? kb + 1 : kb;
#pragma unroll
                for (int i = 0; i < 4; ++i) nx[i] = *(const f32x4*)(scb + (size_t)(16 * i) * 2048 + 16 * kn);
                unsigned NK[16];
#pragma unroll
                for (int i = 0; i < 16; ++i) NK[i] = (mono_key(cur[i]) & ~0x7fu) | (unsigned)(kb * 16 + i);
                TK_SORT16(NK); TK_MERGE16(L, NK);
            }
            u32x4 w0, w1;
            w0.x = (L[0] & 0x7f) | ((L[1] & 0x7f) << 8) | ((L[2] & 0x7f) << 16) | ((L[3] & 0x7f) << 24); w0.y = (L[4] & 0x7f) | ((L[5] & 0x7f) << 8) | ((L[6] & 0x7f) << 16) | ((L[7] & 0x7f) << 24);
            w0.z = (L[8] & 0x7f) | ((L[9] & 0x7f) << 8) | ((L[10] & 0x7f) << 16) | ((L[11] & 0x7f) << 24); w0.w = (L[12] & 0x7f) | ((L[13] & 0x7f) << 8) | ((L[14] & 0x7f) << 16) | ((L[15] & 0x7f) << 24);
            *(LAS u32x4*)(IX + half * 16) = w0;
#pragma unroll
            for (int q = 0; q < 16; ++q) V[half][q] = inv_mono(L[q]);
        }
        unsigned C[16];
#pragma unroll
        for (int q = 0; q < 16; ++q) C[q] = 0u;
#pragma unroll
        for (int i = 0; i < 16; ++i)
#pragma unroll
            for (int jj = 0; jj < 16; ++jj) if ((i + 1) * (jj + 1) <= 16) { unsigned x = (mono_key(V[0][i] + V[1][jj]) & ~0xffu) | (unsigned)(i * 16 + jj); TK_INSERT(C, x); }
        asm volatile("s_waitcnt lgkmcnt(0)" ::: "memory");
        const float s0 = inv_mono(C[0] & ~0xffu);
        float e[16]; float sum = 0.f; int ids[16];
#pragma unroll
        for (int q = 0; q < 16; ++q) { e[q] = fast_exp(inv_mono(C[q] & ~0xffu) - s0); sum += e[q];
            const unsigned code = C[q] & 0xffu; ids[q] = (int)IX[code >> 4] * 128 + (int)IX[16 + (code & 15u)]; }
        const float rs = fast_rcp(sum);
        int* ip = TOPI + (size_t)tok * 128 + hd * 16; float* gp = TOPG + (size_t)tok * 128 + hd * 16;
#pragma unroll
        for (int q = 0; q < 4; ++q) { *(u32x4*)(ip + 4 * q) = (u32x4){(unsigned)ids[4 * q], (unsigned)ids[4 * q + 1], (unsigned)ids[4 * q + 2], (unsigned)ids[4 * q + 3]};
            *(f32x4*)(gp + 4 * q) = (f32x4){e[4 * q] * rs, e[4 * q + 1] * rs, e[4 * q + 2] * rs, e[4 * q + 3] * rs}; }
        asm volatile("s_waitcnt lgkmcnt(0)" ::: "memory");
    }
}

__device__ __forceinline__ void peer_gather(KP p, int l, bool dry) {
    LAUNDER_IDS
    const int wave = tidL >> 6, lane = tidL & 63;
    const bf16_t* HB = (const bf16_t*)(p->ws + WS_HBUF); bf16_t* HBW = (bf16_t*)(p->ws + WS_HBUF);
    const int* TOPI = (const int*)(p->ws + WS_TOPI); const float* TOPG = (const float*)(p->ws + WS_TOPG);
    const unsigned char* UA = p->ws + WS_UTAB + (size_t)l * 16384 * 512; const unsigned char* V8 = p->ws + WS_VTAB + (size_t)l * 16384 * 512 + 8 * lane; const unsigned char* H8 = p->ws + WS_HB8;
    const float* USC = (const float*)(p->ws + WS_USC) + l * 16384; const float* VSC = (const float*)(p->ws + WS_VSC) + l * 16384;
    float* XRES = (float*)(p->ws + WS_XRES); const float* MOD = (const float*)(p->ws + WS_MOD);
    for (int tok = bidL * NWAVE + wave; tok < T; tok += gridDim.x * NWAVE) {
        const int b = tok >> 13;
        const int gq = lane >> 4, jq = lane & 15;
        v8i hb[8];
#pragma unroll
        for (int sidx = 0; sidx < 8; ++sidx) { const u32x4 lo = *(const u32x4*)(H8 + (size_t)tok * 1024 + 128 * sidx + 16 * gq), hi = *(const u32x4*)(H8 + (size_t)tok * 1024 + 128 * sidx + 64 + 16 * gq);
            hb[sidx] = (v8i){(int)lo.x, (int)lo.y, (int)lo.z, (int)lo.w, (int)hi.x, (int)hi.y, (int)hi.z, (int)hi.w}; }
        const int id0 = TOPI[(size_t)tok * 128 + lane], id1 = TOPI[(size_t)tok * 128 + 64 + lane];
        const float g0 = TOPG[(size_t)tok * 128 + lane], g1 = TOPG[(size_t)tok * 128 + 64 + lane];
        f32x2 acc2[8];
#pragma unroll
        for (int i = 0; i < 8; ++i) acc2[i] = (f32x2){0.f, 0.f};
        const int ke = 4 * gq + (jq & 3);
#pragma unroll 1
        for (int e0 = 0; e0 < 128; e0 += 16) {
            const int ida = __shfl(e0 < 64 ? id0 : id1, (e0 + jq) & 63) & 16383;
            const unsigned char* ua_p = UA + (size_t)ida * 512 + 16 * gq;
            u32x4 ua[8];
#pragma unroll
            for (int sidx = 0; sidx < 8; ++sidx) ua[sidx] = *(const u32x4*)(ua_p + 64 * sidx);
            u32x2 vq[16];
#pragma unroll
            for (int k = 0; k < 16; ++k) { const int id = __builtin_amdgcn_readlane(e0 < 64 ? id0 : id1, (e0 + k) & 63) & 16383; vq[k] = *(const u32x2*)(V8 + (size_t)id * 512); }
            const int idk = __shfl(e0 < 64 ? id0 : id1, (e0 + ke) & 63) & 16383; const float gl = __shfl(e0 < 64 ? g0 : g1, (e0 + ke) & 63);
            const float sul = USC[idk], svl = VSC[idk];
            f32x4 dacc = {0.f, 0.f, 0.f, 0.f};
#pragma unroll
            for (int sidx = 0; sidx < 8; ++sidx) { const v8i av = (v8i){(int)ua[sidx].x, (int)ua[sidx].y, (int)ua[sidx].z, (int)ua[sidx].w, 0, 0, 0, 0};
                dacc = __builtin_amdgcn_mfma_scale_f32_16x16x128_f8f6f4(av, hb[sidx], dacc, 4, 0, 0, 0x7f7f7f7f, 0, 0x7f7f7f7f); }
            const int jr = jq & 3;
            const float r = jr == 0 ? dacc[0] : jr == 1 ? dacc[1] : jr == 2 ? dacc[2] : dacc[3];
            const float cfl = gl * gelu_tanh(r * sul) * svl;
#pragma unroll
            for (int k = 0; k < 16; ++k) { const float cf = __uint_as_float(__builtin_amdgcn_readlane(__float_as_uint(cfl), 16 * (k >> 2) + (k & 3)));
                const f32x2 cf2 = (f32x2){cf, cf};
#pragma unroll
                for (int w = 0; w < 2; ++w) {
                    acc2[4 * w + 0] = __builtin_amdgcn_cvt_scalef32_pk_f32_fp4(vq[k][w], 1.0f, 0) * cf2 + acc2[4 * w + 0]; acc2[4 * w + 1] = __builtin_amdgcn_cvt_scalef32_pk_f32_fp4(vq[k][w], 1.0f, 1) * cf2 + acc2[4 * w + 1];
                    acc2[4 * w + 2] = __builtin_amdgcn_cvt_scalef32_pk_f32_fp4(vq[k][w], 1.0f, 2) * cf2 + acc2[4 * w + 2]; acc2[4 * w + 3] = __builtin_amdgcn_cvt_scalef32_pk_f32_fp4(vq[k][w], 1.0f, 3) * cf2 + acc2[4 * w + 3]; } }
        }
        const float* g2 = MOD + ((size_t)l * 2 + b) * 6144 + 5 * 1024 + 16 * lane;
        float* xrow = XRES + (size_t)tok * 1024 + 16 * lane;
        float xn[16]; float ss = 0.f;
#pragma unroll
        for (int q = 0; q < 4; ++q) { const f32x4 xr = *(const f32x4*)(xrow + 4 * q), gg = *(const f32x4*)(g2 + 4 * q);
            const float a0 = acc2[2 * q][0], a1 = acc2[2 * q][1], a2 = acc2[2 * q + 1][0], a3 = acc2[2 * q + 1][1];
            xn[4 * q + 0] = xr[0] + gg[0] * a0; xn[4 * q + 1] = xr[1] + gg[1] * a1; xn[4 * q + 2] = xr[2] + gg[2] * a2; xn[4 * q + 3] = xr[3] + gg[3] * a3; }
#pragma unroll
        for (int i = 0; i < 16; ++i) ss += xn[i] * xn[i];
        const float inv = __builtin_amdgcn_rsqf(wave_sum(ss) * (1.f / 1024.f) + EPS);
        if (dry) { if (inv == 123.456f) p->out[tok] = inv; continue; }
        if (l < DEPTH - 1) {
            const float* gain = p->norm_g + (size_t)(l + 1) * 2 * 1024 + 16 * lane; const float* sh = MOD + ((size_t)(l + 1) * 2 + b) * 6144 + 16 * lane; const float* sc = sh + 1024;
            float y[16];
#pragma unroll
            for (int q = 0; q < 4; ++q) { const f32x4 gn = *(const f32x4*)(gain + 4 * q), s1 = *(const f32x4*)(sh + 4 * q), c1 = *(const f32x4*)(sc + 4 * q);
                *(f32x4*)(xrow + 4 * q) = (f32x4){xn[4 * q], xn[4 * q + 1], xn[4 * q + 2], xn[4 * q + 3]};
#pragma unroll
                for (int i = 0; i < 4; ++i) y[4 * q + i] = (xn[4 * q + i] * inv) * gn[i] * (1.f + c1[i]) + s1[i]; }
            u32x4 o0, o1; o0.x = cvt_pk_bf16(y[0], y[1]); o0.y = cvt_pk_bf16(y[2], y[3]); o0.z = cvt_pk_bf16(y[4], y[5]); o0.w = cvt_pk_bf16(y[6], y[7]);
            o1.x = cvt_pk_bf16(y[8], y[9]); o1.y = cvt_pk_bf16(y[10], y[11]); o1.z = cvt_pk_bf16(y[12], y[13]); o1.w = cvt_pk_bf16(y[14], y[15]);
            *(u32x4*)(HBW + (size_t)tok * 1024 + 16 * lane) = o0; *(u32x4*)(HBW + (size_t)tok * 1024 + 16 * lane + 8) = o1;
        } else {
            const float* fg = p->final_g + 16 * lane; float* orow = p->out + (size_t)tok * 1024 + 16 * lane;
#pragma unroll
            for (int q = 0; q < 4; ++q) { const f32x4 gn = *(const f32x4*)(fg + 4 * q); f32x4 o;
#pragma unroll
                for (int i = 0; i < 4; ++i) o[i] = (xn[4 * q + i] * inv) * gn[i];
                *(f32x4*)(orow + 4 * q) = o; }
        }
    }
}

#define XB_TMO      128
#define XB_XCNT(j)  (256  + 64 * (j))
#define XB_XSUB(j)  (1280 + 64 * (j))
#define XB_XGEN(j)  (2304 + 64 * (j))
#define XB_TOP      3328
#define XB_TOPGEN   3392
#define XCD_BAR_WORDS 3456
#define XB_SPIN_CAP (1u << 18)

__device__ __forceinline__ unsigned xb_ld(unsigned* p)              { return __hip_atomic_load(p, __ATOMIC_RELAXED, __HIP_MEMORY_SCOPE_AGENT); }
__device__ __forceinline__ unsigned xb_add(unsigned* p, unsigned v) { return __hip_atomic_fetch_add(p, v, __ATOMIC_RELAXED, __HIP_MEMORY_SCOPE_AGENT); }
__device__ __forceinline__ unsigned xb_xcc_id() { return (unsigned)__builtin_amdgcn_s_getreg((3 << 11) | 20) & 0xFu; }
#define XB_SPIN(cond, bar) do { unsigned _sp = 0; while (cond) { __builtin_amdgcn_s_sleep(1); \
    if ((++_sp & 255u) == 0u) { if (xb_ld(&(bar)[XB_TMO])) break; if (_sp > XB_SPIN_CAP) { atomicAdd(&(bar)[XB_TMO], 1u); break; } } } } while (0)

struct XcdBarrier {
    unsigned* bar; unsigned x;
    volatile LAS unsigned* st;
};

__device__ __forceinline__ XcdBarrier xcd_barrier_post(unsigned* bar, volatile LAS unsigned* st) {
    XcdBarrier b; b.bar = bar; b.x = xb_xcc_id(); b.st = st;
    if (threadIdx.x == 0) (void)xb_add(&bar[XB_XCNT(b.x)], 1u);
    return b;
}
__device__ __forceinline__ void xcd_barrier_complete(unsigned* bar, unsigned x, unsigned& nloc, unsigned& nx) {
    const unsigned G = gridDim.x * gridDim.y * gridDim.z;
    unsigned sum, cnt, mine, sp = 0u;
    for (;;) {
        sum = 0u; cnt = 0u; mine = 0u;
#pragma unroll
        for (unsigned j = 0; j < 16; ++j) { const unsigned c = xb_ld(&bar[XB_XCNT(j)]); sum += c; cnt += (c > 0u) ? 1u : 0u; mine = (j == x) ? c : mine; }
        if (sum == G) break;
        __builtin_amdgcn_s_sleep(1);
        if ((++sp & 255u) == 0u) { if (xb_ld(&bar[XB_TMO])) break; if (sp > XB_SPIN_CAP) { atomicAdd(&bar[XB_TMO], 1u); break; } }
    }
    nloc = mine > 0u ? mine : 1u; nx = cnt > 0u ? cnt : 1u;
}

__device__ __forceinline__ void xcd_barrier(const XcdBarrier& b) {
    asm volatile("s_waitcnt vmcnt(0)" ::: "memory");
    __syncthreads();
    if (threadIdx.x == 0) {
        unsigned* bar = b.bar;
        __builtin_amdgcn_s_waitcnt(0);
        unsigned nloc = b.st[0], nx = b.st[1];
        if (nloc == 0u) { xcd_barrier_complete(bar, b.x, nloc, nx); b.st[0] = nloc; b.st[1] = nx; }
        const unsigned old = xb_add(&bar[XB_XSUB(b.x)], 1u);
        const unsigned gen = old / nloc;
        if (old + 1u == (gen + 1u) * nloc) {
            __builtin_amdgcn_fence(__ATOMIC_RELEASE, "agent");
            asm volatile("s_waitcnt vmcnt(0)" ::: "memory");
            const unsigned og = xb_add(&bar[XB_TOP], 1u);
            const unsigned tg = og / nx;
            if (og + 1u == (tg + 1u) * nx) xb_add(&bar[XB_TOPGEN], 1u);
            else XB_SPIN(xb_ld(&bar[XB_TOPGEN]) == tg, bar);
            __builtin_amdgcn_fence(__ATOMIC_ACQUIRE, "agent");
            xb_add(&bar[XB_XGEN(b.x)], 1u);
            asm volatile("s_waitcnt vmcnt(0)" ::: "memory");
        } else {
            XB_SPIN(xb_ld(&bar[XB_XGEN(b.x)]) == gen, bar);
            __builtin_amdgcn_fence(__ATOMIC_ACQUIRE, "agent");
            asm volatile("s_waitcnt vmcnt(0)" ::: "memory");
        }
    }
    __syncthreads();
}

#ifndef OPMASK
#define OPMASK 0xFFFFFFFFu
#endif
#define EN(o) ((OPMASK >> (o)) & 1u)
enum { OP_P0 = 0, OP_RMS1, OP_HG_IN, OP_HG_A, OP_HG_B, OP_HG_C, OP_MIX_OUT, OP_LR_IN, OP_LR_CONV, OP_LR_G, OP_LR_S1, OP_LR_S2, OP_LR_S3, OP_RMS2, OP_QK, OP_TOPK, OP_GATHER };
constexpr int NPH = 42;
#define REP_MASK 0u
__device__ __forceinline__ void decode_phase(int ph, int& l, int& op) {
    if (ph == 0) { l = 0; op = OP_P0; return; }
    if (ph == 1) { l = 0; op = OP_RMS1; return; }
    int q = ph - 2;
    if (q < 9) { l = 0; } else if (q < 20) { l = 1; q -= 9; } else if (q < 29) { l = 2; q -= 20; } else { l = 3; q -= 29; }
    if ((l & 1) == 0) { op = q == 0 ? OP_HG_IN : q == 1 ? OP_HG_A : q == 2 ? OP_HG_B : q == 3 ? OP_HG_C : q == 4 ? OP_MIX_OUT : q == 5 ? OP_RMS2 : q == 6 ? OP_QK : q == 7 ? OP_TOPK : OP_GATHER; }
    else { op = q == 0 ? OP_LR_IN : q == 1 ? OP_LR_CONV : q == 2 ? OP_LR_G : q == 3 ? OP_LR_S1 : q == 4 ? OP_LR_S2 : q == 5 ? OP_LR_S3 : q == 6 ? OP_MIX_OUT : q == 7 ? OP_RMS2 : q == 8 ? OP_QK : q == 9 ? OP_TOPK : OP_GATHER; }
}

__global__ __launch_bounds__(512, 2) void mk_fwd(Params p_arg) {
    extern __shared__ __attribute__((aligned(16))) unsigned char shm[];
    LAS unsigned char* lds = (LAS unsigned char*)shm;
    cg::grid_group grid = cg::this_grid();
    unsigned long long kpv = (unsigned long long)__builtin_amdgcn_kernarg_segment_ptr();
    const int ph_lo = p_arg.ph_lo, ph_hi = p_arg.ph_hi;
    volatile LAS unsigned* xst = (volatile LAS unsigned*)(lds + LDS_BYTES - 16);
    if (threadIdx.x == 0) { xst[0] = 0u; xst[1] = 0u; }
    __syncthreads();
    const XcdBarrier xb = xcd_barrier_post((unsigned*)(p_arg.ws + WS_CTL) + 1024, xst);
    for (int ph = ph_lo; ph < ph_hi; ++ph) {
        if (ph > ph_lo) { if (ph_hi > 4096) grid.sync(); else xcd_barrier(xb); }
        asm volatile("" : "+s"(kpv));
        KP p = (KP)kpv;
        unsigned char* ws = p->ws;
        const float* MOD = (const float*)(ws + WS_MOD);
        int l, op; decode_phase(ph, l, op);
        const int j = l >> 1;
        const int nrep = ((p->rep_mask >> op) & 1u) ? 2 : 1;
        for (int rep = 0; rep < nrep; ++rep) {
        const bool dry = rep + 1 < nrep;
#ifdef ONLY
        switch (ONLY) {
#else
        switch (op) {
#endif
        case OP_P0: if (EN(OP_P0)) phase0(p, lds); break;
        case OP_RMS1: if (EN(OP_RMS1)) phase_rms(p->x, p->norm_g, MOD, MOD + 1024, (bf16_t*)(ws + WS_HBUF), nullptr); break;
        case OP_HG_IN: if (EN(OP_HG_IN)) { EpiBf16 E; E.O = (bf16_t*)(ws + WS_PROJ); E.ldc = 5120;
            run_gemm(lds, (const bf16_t*)(ws + WS_HBUF), (const bf16_t*)(ws + WS_HGWIN) + (size_t)j * 5120 * 1024, 5120, 1024, 1024, 1024, 0, 0, E); } break;
        case OP_HG_A: if (EN(OP_HG_A)) hg_pass_a(p, lds, j); break;
        case OP_HG_B: if (EN(OP_HG_B)) hg_pass_b(p); break;
        case OP_HG_C: if (EN(OP_HG_C)) hg_pass_c(p, lds, j); break;
        case OP_MIX_OUT: if (EN(OP_MIX_OUT)) { EpiResid E; E.xin = (l == 0) ? p->x : (const float*)(ws + WS_XRES); E.xout = (float*)(ws + WS_XRES); E.gate = MOD + (size_t)l * 2 * 6144 + 2 * 1024; E.dry = dry;
            const bf16_t* W = (l & 1) ? (const bf16_t*)(ws + WS_LRWOUT) + (size_t)j * 1024 * 1024 : (const bf16_t*)(ws + WS_HGWOUT) + (size_t)j * 1024 * 1024;
            run_gemm(lds, (const bf16_t*)(ws + WS_OB), W, 1024, 1024, 1024, 1024, 0, 0, E); } break;
        case OP_LR_IN: if (EN(OP_LR_IN)) { EpiLruIn E; E.XB = (bf16_t*)(ws + WS_XB); E.YG = (bf16_t*)(ws + WS_YG);
            run_gemm(lds, (const bf16_t*)(ws + WS_HBUF), (const bf16_t*)(ws + WS_LRWIN) + (size_t)j * 2048 * 1024, 2048, 1024, 1024, 1024, 0, 0, E); } break;
        case OP_LR_CONV: if (EN(OP_LR_CONV)) lru_conv(p, j); break;
        case OP_LR_G: if (EN(OP_LR_G)) { EpiGates E; E.LOGA = (bf16_t*)(ws + WS_LOGA); E.BTERM = (bf16_t*)(ws + WS_BTERM); E.XC = (const bf16_t*)(ws + WS_XC);
            E.b_a = p->lru_b_a + (size_t)j * 2048; E.b_x = p->lru_b_x + (size_t)j * 2048; E.lam = p->lru_lam + (size_t)j * 2048;
            run_gemm(lds, (const bf16_t*)(ws + WS_XC), (const bf16_t*)(ws + WS_LRWG) + (size_t)j * 4 * 1024 * 256, 4096, 256, 1024, 256, 2, 512, E); } break;
        case OP_LR_S1: if (EN(OP_LR_S1)) lru_scan1(p, lds); break;
        case OP_LR_S2: if (EN(OP_LR_S2)) lru_scan2(p); break;
        case OP_LR_S3: if (EN(OP_LR_S3)) lru_scan3(p, lds); break;
        case OP_RMS2: if (EN(OP_RMS2)) phase_rms((const float*)(ws + WS_XRES), p->norm_g + ((size_t)l * 2 + 1) * 1024, MOD + (size_t)l * 2 * 6144 + 3 * 1024, MOD + (size_t)l * 2 * 6144 + 4 * 1024, (bf16_t*)(ws + WS_HBUF), ws + WS_HB8); break;
        case OP_QK: if (EN(OP_QK)) { EpiF32 E; E.C = (float*)(ws + WS_SCORES); E.ldc = 2048;
            run_gemm(lds, (const bf16_t*)(ws + WS_HBUF), (const bf16_t*)(ws + WS_WQK) + (size_t)l * 2048 * 1024, 2048, 1024, 1024, 1024, 0, 0, E); } break;
        case OP_TOPK: if (EN(OP_TOPK)) peer_topk(p, lds); break;
        case OP_GATHER: if (EN(OP_GATHER)) peer_gather(p, l, dry); break;
        default: break;
        }
        }
    }
}

extern "C" void kernel_launch(void* const* d_in, const int* in_sizes, int n_in, void* d_out, int out_size, void* d_ws, size_t ws_size, hipStream_t stream) {
    static int grid = 0;
    if (grid == 0) {
        if (n_in != 23 || ws_size < WS_END) { fprintf(stderr, "kernel_launch: unexpected n_in %d / ws_size %zu (need %zu)\n", n_in, ws_size, (size_t)WS_END); grid = -1; return; }
        int dev = 0, cus = 0, per_cu = 0;
        hipGetDevice(&dev); hipDeviceGetAttribute(&cus, hipDeviceAttributeMultiprocessorCount, dev);
        if (hipFuncSetAttribute((const void*)mk_fwd, hipFuncAttributeMaxDynamicSharedMemorySize, LDS_BYTES) != hipSuccess) { fprintf(stderr, "kernel_launch: hipFuncSetAttribute failed\n"); grid = -1; return; }
        if (hipOccupancyMaxActiveBlocksPerMultiprocessor(&per_cu, (const void*)mk_fwd, NTHR, LDS_BYTES) != hipSuccess || per_cu < 1) { fprintf(stderr, "kernel_launch: occupancy query failed (%d)\n", per_cu); (void)hipGetLastError(); per_cu = 1; }
        grid = cus * 1;
        fprintf(stderr, "kernel_launch: cus %d per_cu %d grid %d\n", cus, per_cu, grid);
    }
    if (grid < 0) return;
    if (hipMemsetAsync((char*)d_ws + WS_CTL, 0, 65536, stream) != hipSuccess) { fprintf(stderr, "kernel_launch: memset failed\n"); return; }
    Params p{};
    const float** pp = (const float**)&p;
    for (int i = 0; i < 23; ++i) pp[i] = (const float*)d_in[i];
    p.out = (float*)d_out; p.ws = (unsigned char*)d_ws; p.ph_lo = 0; p.ph_hi = NPH; p.rep_mask = REP_MASK;
    void* args[] = {&p};
    hipError_t e = hipLaunchCooperativeKernel((const void*)mk_fwd, dim3(grid), dim3(NTHR), args, LDS_BYTES, stream);
    if (e != hipSuccess) fprintf(stderr, "kernel_launch: cooperative launch failed: %s (grid %d)\n", hipGetErrorString(e), grid);
}
```

```cpp
#include <hip/hip_runtime.h>
#include <hip/hip_cooperative_groups.h>
#include <cstdio>
#include <cstdint>
namespace cg = cooperative_groups;

#define LAS __attribute__((address_space(3)))
#define PG8_LAS __attribute__((address_space(3)))
typedef unsigned short bf16_t;
typedef short bf16x8 __attribute__((ext_vector_type(8)));
typedef float f32x4 __attribute__((ext_vector_type(4)));
typedef float f32x2 __attribute__((ext_vector_type(2)));
typedef unsigned u32x4 __attribute__((ext_vector_type(4)));
typedef unsigned u32x2 __attribute__((ext_vector_type(2)));
typedef int v8i __attribute__((ext_vector_type(8)));

constexpr int T = 16384, D = 1024, SEQ = 8192, DEPTH = 4;
constexpr float EPS = 1e-6f;
constexpr int NBLK = 256, NTHR = 512, NWAVE = 8, NGW = NBLK * NWAVE;

constexpr size_t MiB = 1u << 20;
constexpr size_t WS_CTL = 0;
constexpr size_t WS_MOD = 1 * MiB;
constexpr size_t WS_HGWIN = 2 * MiB;
constexpr size_t WS_HGWOUT = 22 * MiB;
constexpr size_t WS_LRWIN = 26 * MiB;
constexpr size_t WS_LRWG = 34 * MiB;
constexpr size_t WS_LRWOUT = 38 * MiB;
constexpr size_t WS_WQK = 42 * MiB;
constexpr size_t WS_TOPI = 58 * MiB;
constexpr size_t WS_TOPG = 66 * MiB;
constexpr size_t WS_DEC = 74 * MiB;
constexpr size_t WS_CP = 75 * MiB;
constexpr size_t WS_CH = 79 * MiB;
constexpr size_t WS_HIN = 83 * MiB;
constexpr size_t WS_USC = 87 * MiB;
constexpr size_t WS_VSC = 87 * MiB + 262144;
constexpr size_t WS_XRES = 88 * MiB;
constexpr size_t WS_HBUF = 152 * MiB;
constexpr size_t WS_OB = 184 * MiB;
constexpr size_t WS_PROJ = 216 * MiB;
constexpr size_t WS_XB = WS_PROJ, WS_YG = WS_PROJ + 32 * MiB, WS_XC = WS_PROJ + 64 * MiB, WS_LOGA = WS_PROJ + 96 * MiB;
constexpr size_t WS_SCORES = WS_PROJ;
constexpr size_t WS_KV = 376 * MiB;
constexpr size_t WS_BTERM = WS_KV;
constexpr size_t WS_SIN = 504 * MiB;
constexpr size_t WS_UTAB = 568 * MiB;
constexpr size_t WS_VTAB = 696 * MiB;
constexpr size_t WS_HB8 = 824 * MiB;
constexpr size_t WS_END = 840 * MiB;

constexpr int LDS_BYTES = 155648;

#define LAUNDER_IDS int tidL = threadIdx.x, bidL = blockIdx.x; asm volatile("" : "+v"(tidL)); asm volatile("" : "+s"(bidL));
__device__ __forceinline__ float bf2f(bf16_t b) { return __uint_as_float(((unsigned)b) << 16); }
__device__ __forceinline__ float bflo(unsigned u) { return __uint_as_float(u << 16); }
__device__ __forceinline__ float bfhi(unsigned u) { return __uint_as_float(u & 0xffff0000u); }
__device__ __forceinline__ unsigned cvt_pk_bf16(float lo, float hi) { unsigned r; asm volatile("v_cvt_pk_bf16_f32 %0, %1, %2" : "=v"(r) : "v"(lo), "v"(hi)); return r; }
__device__ __forceinline__ unsigned pk_bf16_rne(float lo, float hi) { unsigned a = __float_as_uint(lo), b = __float_as_uint(hi); a += 0x7fffu + ((a >> 16) & 1u); b += 0x7fffu + ((b >> 16) & 1u); return (a >> 16) | (b & 0xffff0000u); }
__device__ __forceinline__ bf16_t f2bf(float f) { return (bf16_t)(cvt_pk_bf16(f, 0.f) & 0xffffu); }
__device__ __forceinline__ float fast_exp(float x) { return __builtin_amdgcn_exp2f(x * 1.4426950408889634f); }
__device__ __forceinline__ float fast_log(float x) { return __builtin_amdgcn_logf(x) * 0.6931471805599453f; }
__device__ __forceinline__ float fast_rcp(float x) { return __builtin_amdgcn_rcpf(x); }
__device__ __forceinline__ float sigmoidf_(float x) { return fast_rcp(1.f + fast_exp(-x)); }
__device__ __forceinline__ float gelu_tanh(float x) { const float u = 1.5957691216057308f * (x + 0.044715f * x * x * x); return x * fast_rcp(1.f + fast_exp(-u)); }
__device__ __forceinline__ float silu_(float x) { return x * sigmoidf_(x); }
__device__ __forceinline__ float wave_sum(float v) {
#pragma unroll
    for (int o = 1; o < 64; o <<= 1) v += __shfl_xor(v, o);
    return v;
}
__device__ __forceinline__ float wave_max(float v) {
#pragma unroll
    for (int o = 1; o < 64; o <<= 1) v = fmaxf(v, __shfl_xor(v, o));
    return v;
}

namespace pg8 {
constexpr int BM = 256, BK = 64, HALF = 128, HTB = HALF * BK * 2, STAGE_BYTES = 8 * HTB, NXCD = 8, WGM = 8;
__host__ __device__ __forceinline__ int lds_byte(int r, int c) { const int st = (r >> 4) * 2 + (c >> 5), rr = r & 15, cc = c & 31, ob = rr * 64 + cc * 2; return st * 1024 + (ob ^ (((ob >> 9) & 1) << 5)); }
__host__ __device__ __forceinline__ void stage_rc(int b, int& R, int& C) { const int st = b / 1024, sb = b % 1024, swz = sb ^ (((sb >> 9) & 1) << 5); R = (st >> 1) * 16 + swz / 64; C = (st & 1) * 32 + (swz % 64) / 2; }
__host__ __device__ __forceinline__ int perm32(int rho) { const int n = rho >> 4, i = rho & 15; return 8 * (i >> 2) + 4 * n + (i & 3); }
struct Unit { int pm, pn; };
struct Gemm { const bf16_t* A; const bf16_t* Bt; int M, N, K, lda, ldb, a_pn_shift, a_pn_stride; };
struct StaticOrder {
    int nM, nN, nwg, G, c;
    __host__ __device__ void init(int M, int N, int G_, int c_) { nM = M / BM; nN = N / BM; nwg = nM * nN; G = G_; c = c_; }
    __host__ __device__ bool next(int i, Unit& u) const {
        const long L = (long)i * G + c; if (L >= nwg) return false;
        int wgid = (int)L; { const int q = nwg / NXCD, r = nwg % NXCD, xcd = wgid % NXCD, off = wgid / NXCD; wgid = (xcd < r ? xcd * (q + 1) : r * (q + 1) + (xcd - r) * q) + off; }
        const int nig = WGM * nN, gid = wgid / nig, fm = gid * WGM, gsz = (nM - fm) < WGM ? (nM - fm) : WGM;
        u.pm = fm + ((wgid % nig) % gsz); u.pn = (wgid % nig) / gsz; return true;
    }
    __device__ __forceinline__ void a_ready(const Unit&) const {}
    __device__ __forceinline__ void done(const Unit&) const {}
};
template <class Epi, class Sched, bool STAMP = false>
__device__ __forceinline__ void gemm_phase(PG8_LAS unsigned char* lds, const Gemm g, const Sched& S, const Epi& E, unsigned long long* stamps) {
    int tid = threadIdx.x; asm volatile("" : "+v"(tid)); const int wid = __builtin_amdgcn_readfirstlane(tid >> 6), lane = tid & 63, wr = wid >> 2, wc = wid & 3, fr = lane & 15, fq = lane >> 4;
    const int K = g.K, nt = K / BK;
    int ts_lo = 0, ts_hi = 0, nts = 0; const unsigned long long rt_entry = STAMP ? (unsigned long long)wall_clock64() : 0ull;
#define PG8_STAMP() do { if (STAMP && wid == 0 && nts < 64) { const unsigned long long _c = (unsigned long long)clock64(); \
        ts_lo = (lane == nts) ? (int)(unsigned)_c : ts_lo; ts_hi = (lane == nts) ? (int)(unsigned)(_c >> 32) : ts_hi; ++nts; } } while (0)
    PG8_STAMP();
    unsigned voffA[2], voffB[2];
#pragma unroll
    for (int i = 0; i < 2; ++i) { int R, C; stage_rc(tid * 16 + i * 8192, R, C); const int Rb = Epi::PERM ? ((R & ~31) + perm32(R & 31)) : R;
        voffA[i] = (unsigned)(R * g.lda + C) * 2u; voffB[i] = (unsigned)(Rb * g.ldb + C) * 2u; }
    const size_t kstep = (size_t)(BK * 2);
    const size_t hstepA = (size_t)HALF * g.lda * 2, hstepB = (size_t)HALF * g.ldb * 2;
    const size_t tstepA = 2 * hstepA, tstepB = 2 * hstepB;
    const unsigned ldsw = (unsigned)wid * 1024u;
    const int aoff = lds_byte(wr * 64 + fr, fq * 8), boff = lds_byte(wc * 32 + fr, fq * 8);
#define PG8_SA(b, h) (((b) * 2 + (h)) * HTB)
#define PG8_SB(b, h) ((4 + (b) * 2 + (h)) * HTB)
#define PG8_STAGE(bufoff, gbase, voff) do { _Pragma("unroll") for (int _i = 0; _i < 2; ++_i) \
        __builtin_amdgcn_global_load_lds((const unsigned*)((const char*)(gbase) + (voff)[_i]), (PG8_LAS unsigned*)(lds + (bufoff) + ldsw + _i * 8192), 16, 0, 0); } while (0)
#define PG8_LDA(dst, b, h) do { _Pragma("unroll") for (int m = 0; m < 4; ++m) _Pragma("unroll") for (int k = 0; k < 2; ++k) dst[m][k] = *(const PG8_LAS bf16x8*)(lds + PG8_SA(b, h) + aoff + m * 2048 + k * 1024); } while (0)
#define PG8_LDB(dst, b, h) do { _Pragma("unroll") for (int n = 0; n < 2; ++n) _Pragma("unroll") for (int k = 0; k < 2; ++k) dst[n][k] = *(const PG8_LAS bf16x8*)(lds + PG8_SB(b, h) + boff + n * 2048 + k * 1024); } while (0)
#define PG8_MMA(ai, bj, At, Bt) do { __builtin_amdgcn_s_setprio(1); _Pragma("unroll") for (int m = 0; m < 4; ++m) _Pragma("unroll") for (int n = 0; n < 2; ++n) _Pragma("unroll") for (int k = 0; k < 2; ++k) \
        acc[ai][bj][m][n] = Epi::SWAP ? __builtin_amdgcn_mfma_f32_16x16x32_bf16(At[m][k], Bt[n][k], acc[ai][bj][m][n], 0, 0, 0) : __builtin_amdgcn_mfma_f32_16x16x32_bf16(Bt[n][k], At[m][k], acc[ai][bj][m][n], 0, 0, 0); __builtin_amdgcn_s_setprio(0); } while (0)
#define PG8_WAIT_V(n) asm volatile("s_waitcnt vmcnt(" #n ")" ::: "memory")
#define PG8_WAIT_L(n) asm volatile("s_waitcnt lgkmcnt(" #n ")" ::: "memory")
#define PG8_BAR __builtin_amdgcn_s_barrier()
#define PG8_SCHED __builtin_amdgcn_sched_barrier(0)
    Unit cur, nxt; int ui = 0;
    if (!S.next(0, cur)) return;
    f32x4 acc[2][2][4][2];
#pragma unroll
    for (int a = 0; a < 2; ++a)
#pragma unroll
        for (int b = 0; b < 2; ++b)
#pragma unroll
            for (int m = 0; m < 4; ++m)
#pragma unroll
                for (int n = 0; n < 2; ++n) acc[a][b][m][n] = (f32x4){0.f, 0.f, 0.f, 0.f};
    bf16x8 At[4][2], B0[2][2], B1[2][2];
    const char* cA = (const char*)g.A + (size_t)cur.pm * tstepA + (size_t)(cur.pn >> g.a_pn_shift) * g.a_pn_stride; const char* cB = (const char*)g.Bt + (size_t)cur.pn * tstepB;
    S.a_ready(cur);
    PG8_STAGE(PG8_SB(0, 0), cB, voffB); PG8_STAGE(PG8_SA(0, 0), cA, voffA); PG8_STAGE(PG8_SB(0, 1), cB + hstepB, voffB); PG8_STAGE(PG8_SA(0, 1), cA + hstepA, voffA);
    if (wr == 1) PG8_BAR;
    PG8_WAIT_V(4); PG8_BAR;
    PG8_STAGE(PG8_SB(1, 0), cB + kstep, voffB); PG8_STAGE(PG8_SA(1, 0), cA + kstep, voffA); PG8_STAGE(PG8_SB(1, 1), cB + hstepB + kstep, voffB);
    PG8_WAIT_V(6); PG8_BAR;
    PG8_STAMP();
    for (;;) {
        const bool has_next = S.next(ui + 1, nxt);
        const char* nA = has_next ? (const char*)g.A + (size_t)nxt.pm * tstepA + (size_t)(nxt.pn >> g.a_pn_shift) * g.a_pn_stride : cA; const char* nB = has_next ? (const char*)g.Bt + (size_t)nxt.pn * tstepB : cB;
#pragma unroll 1
        for (int t = 0; t < nt; t += 2) {
            const bool last = (t == nt - 2);
            const char* a1 = cA + (size_t)(t + 1) * kstep;
            const char* a2 = last ? nA : cA + (size_t)(t + 2) * kstep; const char* b2 = last ? nB : cB + (size_t)(t + 2) * kstep;
            const char* a3 = a2 + kstep; const char* b3 = b2 + kstep;
            if (last && has_next) S.a_ready(nxt);
            PG8_LDB(B0, 0, 0); PG8_SCHED; PG8_LDA(At, 0, 0); PG8_STAGE(PG8_SA(1, 1), a1 + hstepA, voffA);
            PG8_WAIT_L(8); PG8_BAR; PG8_WAIT_L(0); PG8_MMA(0, 0, At, B0); PG8_BAR; PG8_SCHED;
            PG8_LDB(B1, 0, 1); PG8_STAGE(PG8_SB(0, 0), b2, voffB);
            PG8_BAR; PG8_WAIT_L(0); PG8_MMA(0, 1, At, B1); PG8_BAR;
            PG8_LDA(At, 0, 1); PG8_STAGE(PG8_SA(0, 0), a2, voffA);
            PG8_BAR; PG8_WAIT_L(0); PG8_MMA(1, 0, At, B0); PG8_BAR; PG8_SCHED;
            PG8_STAGE(PG8_SB(0, 1), b2 + hstepB, voffB);
            PG8_WAIT_V(6); PG8_BAR; PG8_MMA(1, 1, At, B1); PG8_BAR;
            PG8_LDB(B0, 1, 0); PG8_SCHED; PG8_LDA(At, 1, 0); PG8_STAGE(PG8_SA(0, 1), a2 + hstepA, voffA);
            PG8_WAIT_L(8); PG8_BAR; PG8_WAIT_L(0); PG8_MMA(0, 0, At, B0); PG8_BAR; PG8_SCHED;
            PG8_LDB(B1, 1, 1); PG8_STAGE(PG8_SB(1, 0), b3, voffB);
            PG8_BAR; PG8_WAIT_L(0); PG8_MMA(0, 1, At, B1); PG8_BAR;
            PG8_LDA(At, 1, 1); PG8_STAGE(PG8_SA(1, 0), a3, voffA);
            PG8_BAR; PG8_WAIT_L(0); PG8_MMA(1, 0, At, B0); PG8_BAR; PG8_SCHED;
            PG8_STAGE(PG8_SB(1, 1), b3 + hstepB, voffB);
            PG8_WAIT_V(6); PG8_BAR; PG8_MMA(1, 1, At, B1); PG8_BAR;
        }
        PG8_STAMP();
        if constexpr (!Epi::AFTER_DRAIN) { E(acc, cur, wr, wc, fr, fq); S.done(cur); }
        PG8_STAMP();
        if (!has_next) break;
#pragma unroll
        for (int a = 0; a < 2; ++a)
#pragma unroll
            for (int b = 0; b < 2; ++b)
#pragma unroll
                for (int m = 0; m < 4; ++m)
#pragma unroll
                    for (int n = 0; n < 2; ++n) acc[a][b][m][n] = (f32x4){0.f, 0.f, 0.f, 0.f};
        cur = nxt; cA = nA; cB = nB; ++ui;
    }
    PG8_WAIT_V(0);
    if (wr == 0) PG8_BAR;
    PG8_BAR;
    if constexpr (Epi::AFTER_DRAIN) { E.fused(acc, cur, wr, wc, fr, fq, lds, wid, lane); S.done(cur); }
    PG8_STAMP();
    if (STAMP && wid == 0) { stamps[lane] = lane < nts ? (((unsigned long long)(unsigned)ts_hi << 32) | (unsigned)ts_lo) : 0ull;
        if (lane == 62) stamps[62] = rt_entry; if (lane == 63) stamps[63] = (unsigned long long)wall_clock64(); }
#undef PG8_STAMP
#undef PG8_SA
#undef PG8_SB
#undef PG8_STAGE
#undef PG8_LDA
#undef PG8_LDB
#undef PG8_MMA
#undef PG8_WAIT_V
#undef PG8_WAIT_L
#undef PG8_BAR
#undef PG8_SCHED
}
}
using pg8::Unit;

struct EpiBf16 {
    static constexpr bool PERM = true, AFTER_DRAIN = false, SWAP = false;
    bf16_t* O; int ldc;
    __device__ __forceinline__ void operator()(const f32x4 (&acc)[2][2][4][2], const Unit& u, int wr, int wc, int fr, int fq) const {
        const int row0 = u.pm * 256 + wr * 64 + fr, col0 = u.pn * 256 + wc * 32 + 8 * fq;
#pragma unroll
        for (int ai = 0; ai < 2; ++ai)
#pragma unroll
            for (int m = 0; m < 4; ++m) { bf16_t* rowp = O + (size_t)(row0 + ai * 128 + m * 16) * ldc + col0;
#pragma unroll
                for (int bj = 0; bj < 2; ++bj) { const f32x4 v0 = acc[ai][bj][m][0], v1 = acc[ai][bj][m][1];
                    u32x4 o; o.x = cvt_pk_bf16(v0[0], v0[1]); o.y = cvt_pk_bf16(v0[2], v0[3]); o.z = cvt_pk_bf16(v1[0], v1[1]); o.w = cvt_pk_bf16(v1[2], v1[3]);
                    *(u32x4*)(rowp + bj * 128) = o; } }
    }
};
struct EpiLruIn {
    static constexpr bool PERM = true, AFTER_DRAIN = false, SWAP = false;
    bf16_t* XB; bf16_t* YG;
    __device__ __forceinline__ void operator()(const f32x4 (&acc)[2][2][4][2], const Unit& u, int wr, int wc, int fr, int fq) const {
        const bool isy = u.pn >= 4;
        bf16_t* O = isy ? YG : XB;
        const int row0 = u.pm * 256 + wr * 64 + fr, col0 = (u.pn & 3) * 256 + wc * 32 + 8 * fq;
#pragma unroll
        for (int ai = 0; ai < 2; ++ai)
#pragma unroll
            for (int m = 0; m < 4; ++m) { bf16_t* rowp = O + (size_t)(row0 + ai * 128 + m * 16) * 1024 + col0;
#pragma unroll
                for (int bj = 0; bj < 2; ++bj) { f32x4 v0 = acc[ai][bj][m][0], v1 = acc[ai][bj][m][1];
                    if (isy) {
#pragma unroll
                        for (int i = 0; i < 4; ++i) { v0[i] = gelu_tanh(v0[i]); v1[i] = gelu_tanh(v1[i]); } }
                    u32x4 o; o.x = cvt_pk_bf16(v0[0], v0[1]); o.y = cvt_pk_bf16(v0[2], v0[3]); o.z = cvt_pk_bf16(v1[0], v1[1]); o.w = cvt_pk_bf16(v1[2], v1[3]);
                    *(u32x4*)(rowp + bj * 128) = o; } }
    }
};
struct EpiGates {
    static constexpr bool PERM = true, AFTER_DRAIN = false, SWAP = false;
    bf16_t* LOGA; bf16_t* BTERM; const bf16_t* XC; const float* b_a; const float* b_x; const float* lam;
    __device__ __forceinline__ void operator()(const f32x4 (&acc)[2][2][4][2], const Unit& u, int wr, int wc, int fr_, int fq) const {
        int fr = fr_; asm volatile("" : "+v"(fr));
        const int nblk = u.pn >> 2, uu = u.pn & 3, d = uu >> 1, jh = uu & 1;
        const int colbase = nblk * 256 + jh * 128 + wc * 32 + 8 * fq;
        const unsigned off0 = (unsigned)(u.pm * 256 + wr * 64 + fr) * 1024u + (unsigned)colbase;
        const bf16_t* xcp = XC; bf16_t* lap = LOGA + (size_t)d * T * 1024; bf16_t* btp = BTERM + (size_t)d * T * 1024;
        const float* bap = b_a + d * 1024; const float* bxp = b_x + d * 1024; const float* lmp = lam + d * 1024;
#pragma unroll
        for (int ai = 0; ai < 2; ++ai)
#pragma unroll
            for (int m = 0; m < 4; ++m) { const unsigned off = off0 + (unsigned)(ai * 128 + m * 16) * 1024u;
                asm volatile("" ::: "memory"); __builtin_amdgcn_sched_barrier(0);
                const u32x4 xr = *(const u32x4*)(xcp + off);
                const float xv[8] = {bflo(xr.x), bfhi(xr.x), bflo(xr.y), bfhi(xr.y), bflo(xr.z), bfhi(xr.z), bflo(xr.w), bfhi(xr.w)};
                unsigned o1[4], o2[4];
#pragma unroll
                for (int n = 0; n < 2; ++n) { const f32x4 ba = *(const f32x4*)(bap + (unsigned)(colbase + 4 * n)), bx = *(const f32x4*)(bxp + (unsigned)(colbase + 4 * n)), lm = *(const f32x4*)(lmp + (unsigned)(colbase + 4 * n));
                    float la[4], bt[4];
#pragma unroll
                    for (int i = 0; i < 4; ++i) { const float r = sigmoidf_(acc[ai][0][m][n][i] + ba[i]), ig = sigmoidf_(acc[ai][1][m][n][i] + bx[i]);
                        const float l = -8.f * fast_log(1.f + fast_exp(-lm[i])) * r; const float mult = __builtin_sqrtf(fmaxf(1.f - fast_exp(2.f * l), 0.f));
                        la[i] = l; bt[i] = mult * ig * xv[n * 4 + i]; }
                    o1[n * 2] = cvt_pk_bf16(la[0], la[1]); o1[n * 2 + 1] = cvt_pk_bf16(la[2], la[3]); o2[n * 2] = cvt_pk_bf16(bt[0], bt[1]); o2[n * 2 + 1] = cvt_pk_bf16(bt[2], bt[3]); }
                *(u32x4*)(lap + off) = (u32x4){o1[0], o1[1], o1[2], o1[3]}; *(u32x4*)(btp + off) = (u32x4){o2[0], o2[1], o2[2], o2[3]}; }
    }
};
struct EpiResid {
    static constexpr bool PERM = false, AFTER_DRAIN = false, SWAP = false;
    const float* xin; float* xout; const float* gate; bool dry;
    __device__ __forceinline__ void operator()(const f32x4 (&acc)[2][2][4][2], const Unit& u, int wr, int wc, int fr, int fq) const {
        const int row0 = u.pm * 256 + wr * 64 + fr, col0 = u.pn * 256 + wc * 32 + 4 * fq;
        const float* gp = gate + ((u.pm * 256) >> 13) * 6144 + col0;
        f32x4 gv[2][2];
#pragma unroll
        for (int bj = 0; bj < 2; ++bj)
#pragma unroll
            for (int n = 0; n < 2; ++n) gv[bj][n] = *(const f32x4*)(gp + bj * 128 + n * 16);
#pragma unroll
        for (int ai = 0; ai < 2; ++ai)
#pragma unroll
            for (int m = 0; m < 4; ++m) { const size_t off = (size_t)(row0 + ai * 128 + m * 16) * 1024 + col0;
#pragma unroll
                for (int bj = 0; bj < 2; ++bj)
#pragma unroll
                    for (int n = 0; n < 2; ++n) { const f32x4 xv = *(const f32x4*)(xin + off + bj * 128 + n * 16);
                        if (!dry) *(f32x4*)(xout + off + bj * 128 + n * 16) = xv + gv[bj][n] * acc[ai][bj][m][n]; } }
    }
};
struct EpiF32 {
    static constexpr bool PERM = false, AFTER_DRAIN = false, SWAP = false;
    float* C; int ldc;
    __device__ __forceinline__ void operator()(const f32x4 (&acc)[2][2][4][2], const Unit& u, int wr, int wc, int fr_, int fq) const {
        int fr = fr_; asm volatile("" : "+v"(fr));
        const int row0 = u.pm * 256 + wr * 64 + fr, col0 = u.pn * 256 + wc * 32 + 4 * fq;
#pragma unroll
        for (int ai = 0; ai < 2; ++ai)
#pragma unroll
            for (int m = 0; m < 4; ++m) { float* rowp = C + (size_t)(row0 + ai * 128 + m * 16) * ldc + col0;
#pragma unroll
                for (int bj = 0; bj < 2; ++bj)
#pragma unroll
                    for (int n = 0; n < 2; ++n) *(f32x4*)(rowp + bj * 128 + n * 16) = acc[ai][bj][m][n]; }
    }
};

struct Params {
    const float *x, *c, *w_ada, *b_ada, *norm_g, *hg_w_in, *hg_lb, *hg_norm_g, *hg_w_out, *lru_w_in, *lru_conv_w, *lru_conv_b,
        *lru_w_a, *lru_b_a, *lru_w_x, *lru_b_x, *lru_lam, *lru_w_out, *peer_w_q, *peer_keys, *peer_u, *peer_v, *final_g;
    float* out; unsigned char* ws; int ph_lo, ph_hi; unsigned rep_mask; int pad_;
};

typedef const __attribute__((address_space(4))) Params* KP;

template <class Epi>
__device__ __forceinline__ void run_gemm(LAS unsigned char* lds, const bf16_t* A, const bf16_t* Bt, int N, int K, int lda, int ldb, int a_pn_shift, int a_pn_stride, const Epi& E) {
    pg8::Gemm g; g.A = A; g.Bt = Bt; g.M = T; g.N = N; g.K = K; g.lda = lda; g.ldb = ldb; g.a_pn_shift = a_pn_shift; g.a_pn_stride = a_pn_stride;
    LAUNDER_IDS
    pg8::StaticOrder S; S.init(T, N, (int)gridDim.x, bidL); (void)tidL;
    pg8::gemm_phase<Epi, pg8::StaticOrder, false>(lds, g, S, E, nullptr);
    __syncthreads();
}

__device__ __forceinline__ void transpose_tile(const float* __restrict__ src, int ld_src, bf16_t* dst, int ld_dst, LAS float* tile, int tid) {
#pragma unroll
    for (int it = 0; it < 2; ++it) { const int r = (tid >> 4) + 32 * it, c4 = (tid & 15) * 4;
        const f32x4 v = *(const f32x4*)(src + (size_t)r * ld_src + c4);
        tile[r * 65 + c4 + 0] = v[0]; tile[r * 65 + c4 + 1] = v[1]; tile[r * 65 + c4 + 2] = v[2]; tile[r * 65 + c4 + 3] = v[3]; }
    __syncthreads();
    { const int n = tid >> 3, kc = tid & 7; const LAS float* s = tile + (kc * 8) * 65 + n;
        u32x4 o; o.x = cvt_pk_bf16(s[0], s[65]); o.y = cvt_pk_bf16(s[2 * 65], s[3 * 65]); o.z = cvt_pk_bf16(s[4 * 65], s[5 * 65]); o.w = cvt_pk_bf16(s[6 * 65], s[7 * 65]);
        *(u32x4*)(dst + (size_t)n * ld_dst + kc * 8) = o; }
    __syncthreads();
}

__device__ __forceinline__ void phase0(KP p, LAS unsigned char* lds) {
    LAUNDER_IDS
    const int tid = tidL, wave = tid >> 6, lane = tid & 63;
    unsigned char* ws = p->ws;
    LAS float* tile = (LAS float*)lds;
    constexpr int I_HGIN = 16 * 80, I_SQ = 16 * 16, I_LRIN = 16 * 32, I_G = 16;
    constexpr int N_A = 2 * I_HGIN + 2 * I_SQ + 2 * I_LRIN + 2 * I_SQ + 32 * I_G;
    for (int it = bidL; it < N_A; it += gridDim.x) {
        int r = it;
        if (r < 2 * I_HGIN) { const int j = r / I_HGIN, q = r % I_HGIN, kb = q / 80, nb = q % 80;
            transpose_tile(p->hg_w_in + (size_t)j * 1024 * 5120 + (size_t)kb * 64 * 5120 + nb * 64, 5120, (bf16_t*)(ws + WS_HGWIN) + (size_t)j * 5120 * 1024 + (size_t)nb * 64 * 1024 + kb * 64, 1024, tile, tid); continue; }
        r -= 2 * I_HGIN;
        if (r < 2 * I_SQ) { const int j = r / I_SQ, q = r % I_SQ, kb = q / 16, nb = q % 16;
            transpose_tile(p->hg_w_out + (size_t)j * 1024 * 1024 + (size_t)kb * 64 * 1024 + nb * 64, 1024, (bf16_t*)(ws + WS_HGWOUT) + (size_t)j * 1024 * 1024 + (size_t)nb * 64 * 1024 + kb * 64, 1024, tile, tid); continue; }
        r -= 2 * I_SQ;
        if (r < 2 * I_LRIN) { const int j = r / I_LRIN, q = r % I_LRIN, kb = q / 32, nb = q % 32;
            transpose_tile(p->lru_w_in + (size_t)j * 1024 * 2048 + (size_t)kb * 64 * 2048 + nb * 64, 2048, (bf16_t*)(ws + WS_LRWIN) + (size_t)j * 2048 * 1024 + (size_t)nb * 64 * 1024 + kb * 64, 1024, tile, tid); continue; }
        r -= 2 * I_LRIN;
        if (r < 2 * I_SQ) { const int j = r / I_SQ, q = r % I_SQ, kb = q / 16, nb = q % 16;
            transpose_tile(p->lru_w_out + (size_t)j * 1024 * 1024 + (size_t)kb * 64 * 1024 + nb * 64, 1024, (bf16_t*)(ws + WS_LRWOUT) + (size_t)j * 1024 * 1024 + (size_t)nb * 64 * 1024 + kb * 64, 1024, tile, tid); continue; }
        r -= 2 * I_SQ;
        { const int mat = r / I_G, q = r % I_G, kb = q / 4, nb = q % 4;
            const int nblk = mat & 3, gate = (mat >> 2) & 1, d = (mat >> 3) & 1, l = mat >> 4;
            const float* src = (gate ? p->lru_w_x : p->lru_w_a) + (size_t)((l * 2 + d) * 4 + nblk) * 65536 + (size_t)kb * 64 * 256 + nb * 64;
            const int n0 = nb * 64, jh = n0 >> 7;
            bf16_t* dst = (bf16_t*)(ws + WS_LRWG) + (size_t)l * 4 * 1024 * 256 + (size_t)nblk * 1024 * 256 + (size_t)((d * 2 + jh) * 256 + gate * 128 + (n0 & 127)) * 256 + kb * 64;
            transpose_tile(src, 256, dst, 256, tile, tid); }
    }
    {
        LAS bf16_t* KA = (LAS bf16_t*)lds;
        LAS bf16_t* WB = (LAS bf16_t*)(lds + 128 * 136 * 2);
        const int l15 = lane & 15, lq = lane >> 4;
        for (int it = bidL; it < 1024; it += gridDim.x) {
            const int l = it >> 8, hp = (it >> 4) & 15, dt = it & 15;
            const float* kp = p->peer_keys + ((size_t)l * 16 + hp) * 16384;
            const float* wp = p->peer_w_q + (size_t)l * 1024 * 2048 + (size_t)(dt * 64) * 2048 + hp * 128;
            f32x4 kv[8], wv[4];
#pragma unroll
            for (int q = 0; q < 8; ++q) kv[q] = *(const f32x4*)(kp + (tid + 512 * q) * 4);
#pragma unroll
            for (int q = 0; q < 4; ++q) { const int e = (tid + 512 * q) * 4; wv[q] = *(const f32x4*)(wp + (size_t)(e >> 7) * 2048 + (e & 127)); }
#pragma unroll
            for (int q = 0; q < 8; ++q) { const int e = (tid + 512 * q) * 4; *(LAS u32x2*)(KA + (e >> 7) * 136 + (e & 127)) = (u32x2){cvt_pk_bf16(kv[q][0], kv[q][1]), cvt_pk_bf16(kv[q][2], kv[q][3])}; }
#pragma unroll
            for (int q = 0; q < 4; ++q) { const int e = (tid + 512 * q) * 4; *(LAS u32x2*)(WB + (e >> 7) * 136 + (e & 127)) = (u32x2){cvt_pk_bf16(wv[q][0], wv[q][1]), cvt_pk_bf16(wv[q][2], wv[q][3])}; }
            __syncthreads();
            const int rt = wave & 3, ct0 = (wave >> 2) * 4;
            f32x4 acc[4];
#pragma unroll
            for (int c = 0; c < 4; ++c) acc[c] = (f32x4){0.f, 0.f, 0.f, 0.f};
#pragma unroll
            for (int ks = 0; ks < 4; ++ks) { const bf16x8 av = *(const LAS bf16x8*)(WB + (rt * 16 + l15) * 136 + ks * 32 + lq * 8);
#pragma unroll
                for (int c = 0; c < 4; ++c) { const bf16x8 bv = *(const LAS bf16x8*)(KA + ((ct0 + c) * 16 + l15) * 136 + ks * 32 + lq * 8);
                    acc[c] = __builtin_amdgcn_mfma_f32_16x16x32_bf16(av, bv, acc[c], 0, 0, 0); } }
#pragma unroll
            for (int c = 0; c < 4; ++c) { bf16_t* op = (bf16_t*)(ws + WS_WQK) + (size_t)l * 2048 * 1024 + (size_t)(hp * 128 + (ct0 + c) * 16 + l15) * 1024 + dt * 64 + rt * 16 + lq * 4;
                *(u32x2*)op = (u32x2){pk_bf16_rne(acc[c][0], acc[c][1]), pk_bf16_rne(acc[c][2], acc[c][3])}; }
            __syncthreads();
        }
    }
    {
        LAS float* condL = (LAS float*)lds;
        LAS float* red = (LAS float*)(lds + 8192);
        for (int i = tid; i < 2048; i += NTHR) condL[i] = silu_(p->c[i]);
        __syncthreads();
        for (int it = bidL; it < 4 * 48; it += gridDim.x) {
            const int l = it / 48, col0 = (it % 48) * 128;
            const float* wp = p->w_ada + (size_t)l * 1024 * 6144 + col0 + 2 * lane;
            float a00 = 0.f, a01 = 0.f, a10 = 0.f, a11 = 0.f;
#pragma unroll 8
            for (int kk = 0; kk < 128; ++kk) { const int k = wave * 128 + kk; const f32x2 w = *(const f32x2*)(wp + (size_t)k * 6144);
                const float c0 = condL[k], c1 = condL[1024 + k];
                a00 += c0 * w[0]; a01 += c0 * w[1]; a10 += c1 * w[0]; a11 += c1 * w[1]; }
            red[(wave * 2 + 0) * 128 + 2 * lane] = a00; red[(wave * 2 + 0) * 128 + 2 * lane + 1] = a01;
            red[(wave * 2 + 1) * 128 + 2 * lane] = a10; red[(wave * 2 + 1) * 128 + 2 * lane + 1] = a11;
            __syncthreads();
            if (tid < 256) { const int b = tid >> 7, cc = tid & 127; float s = 0.f;
#pragma unroll
                for (int w = 0; w < 8; ++w) s += red[(w * 2 + b) * 128 + cc];
                ((float*)(ws + WS_MOD))[((size_t)l * 2 + b) * 6144 + col0 + cc] = s + p->b_ada[(size_t)l * 6144 + col0 + cc]; }
            __syncthreads();
        }
    }
    {
        const int nw = gridDim.x * NWAVE;
        for (int row0 = bidL * NWAVE + wave; row0 < 2 * 65536; row0 += 4 * nw) {
            f32x4 v[4][4];
#pragma unroll
            for (int rr = 0; rr < 4; ++rr) { const int row = row0 + rr * nw; const int tb = row >> 16, r = row & 65535;
                const float* src = (tb ? p->peer_v : p->peer_u) + (size_t)r * 1024 + 4 * lane;
#pragma unroll
                for (int jx = 0; jx < 4; ++jx) v[rr][jx] = __builtin_nontemporal_load((const f32x4*)(src + 256 * jx)); }
#pragma unroll
            for (int rr = 0; rr < 4; ++rr) { const int row = row0 + rr * nw; const int tb = row >> 16, r = row & 65535;
                float am = 0.f;
#pragma unroll
                for (int jx = 0; jx < 4; ++jx) am = fmaxf(am, fmaxf(fmaxf(fabsf(v[rr][jx][0]), fabsf(v[rr][jx][1])), fmaxf(fabsf(v[rr][jx][2]), fabsf(v[rr][jx][3]))));
                am = wave_max(am);
                const float sc = am > 0.f ? am * (1.f / 6.f) : 1.f, inv = am > 0.f ? 6.f / am : 1.f;
                unsigned char* dst = ws + (tb ? WS_VTAB : WS_UTAB) + (size_t)r * 512 + 2 * lane;
#pragma unroll
                for (int jx = 0; jx < 4; ++jx) { unsigned w = __builtin_amdgcn_cvt_scalef32_pk_fp4_f32(0u, v[rr][jx][0] * inv, v[rr][jx][1] * inv, 1.0f, 0);
                    w = __builtin_amdgcn_cvt_scalef32_pk_fp4_f32(w, v[rr][jx][2] * inv, v[rr][jx][3] * inv, 1.0f, 1);
                    *(unsigned short*)(dst + 128 * jx) = (unsigned short)(w & 0xffffu); }
                if (lane == 0) ((float*)(ws + (tb ? WS_VSC : WS_USC)))[r] = sc; }
        }
    }
}

__device__ __forceinline__ void phase_rms(const float* xin, const float* gain, const float* shift, const float* scale, bf16_t* hout, unsigned char* h8out) {
    LAUNDER_IDS
    const int tid = tidL, wave = tid >> 6, lane = tid & 63;
    const int nw = gridDim.x * NWAVE;
    for (int row0 = bidL * NWAVE + wave; row0 < T; row0 += 2 * nw) {
        f32x4 v[2][4]; float ss[2];
#pragma unroll
        for (int rr = 0; rr < 2; ++rr) { const int row = min(row0 + rr * nw, T - 1); const float* xr = xin + (size_t)row * 1024 + lane * 4;
#pragma unroll
            for (int j = 0; j < 4; ++j) v[rr][j] = *(const f32x4*)(xr + j * 256); }
#pragma unroll
        for (int rr = 0; rr < 2; ++rr) { float a = 0.f;
#pragma unroll
            for (int j = 0; j < 4; ++j) a += v[rr][j][0] * v[rr][j][0] + v[rr][j][1] * v[rr][j][1] + v[rr][j][2] * v[rr][j][2] + v[rr][j][3] * v[rr][j][3];
            ss[rr] = a; }
#pragma unroll
        for (int o = 1; o < 64; o <<= 1) { ss[0] += __shfl_xor(ss[0], o); ss[1] += __shfl_xor(ss[1], o); }
#pragma unroll
        for (int rr = 0; rr < 2; ++rr) { const int row = row0 + rr * nw; if (row >= T) continue; const int b = row >> 13;
            const float inv = __builtin_amdgcn_rsqf(ss[rr] * (1.f / 1024.f) + EPS);
#pragma unroll
            for (int j = 0; j < 4; ++j) { const int col = j * 256 + lane * 4;
                const f32x4 g = *(const f32x4*)(gain + col), sh = *(const f32x4*)(shift + b * 6144 + col), sc = *(const f32x4*)(scale + b * 6144 + col);
                const f32x4 y = (v[rr][j] * inv) * g * (1.f + sc) + sh;
                u32x2 o; o.x = cvt_pk_bf16(y[0], y[1]); o.y = cvt_pk_bf16(y[2], y[3]);
                *(u32x2*)(hout + (size_t)row * 1024 + col) = o;
                if (h8out) { int w8 = __builtin_amdgcn_cvt_pk_fp8_f32(y[0], y[1], 0, false); w8 = __builtin_amdgcn_cvt_pk_fp8_f32(y[2], y[3], w8, true); *(int*)(h8out + (size_t)row * 1024 + col) = w8; } } }
    }
}

constexpr int LROW = 136;
__device__ __forceinline__ float hg_lower_bound(const float* hg_lb, int j, int col) {
    if (j == 0) return 0.f;
    const float l0 = hg_lb[col], l1 = hg_lb[1024 + col];
    return fast_rcp(1.f + fast_exp(l0 - l1));
}
__device__ __forceinline__ f32x4 mfma16(bf16x8 a, bf16x8 b, f32x4 c) { return __builtin_amdgcn_mfma_f32_16x16x32_bf16(a, b, c, 0, 0, 0); }

__device__ __forceinline__ void load_v_regs(const bf16_t* proj, u32x4 (&vr)[4], int t0, int dir, int h, int tid) {
#pragma unroll
    for (int it = 0; it < 4; ++it) { const int idx = tid + 512 * it, tau = idx & 127, cv = idx >> 7;
        const int tok = dir ? t0 + 127 - tau : t0 + tau;
        vr[it] = *(const u32x4*)(proj + (size_t)tok * 5120 + 3072 + h * 128 + cv * 8); }
}
__device__ __forceinline__ void store_vt(LAS bf16_t* VT, const u32x4 (&vr)[4], int tid) {
#pragma unroll
    for (int it = 0; it < 4; ++it) { const int idx = tid + 512 * it, tau = idx & 127, cv = idx >> 7; const u32x4 v = vr[it];
        LAS bf16_t* d = VT + (cv * 8) * LROW + tau;
        d[0 * LROW] = (bf16_t)(v.x & 0xffff); d[1 * LROW] = (bf16_t)(v.x >> 16); d[2 * LROW] = (bf16_t)(v.y & 0xffff); d[3 * LROW] = (bf16_t)(v.y >> 16);
        d[4 * LROW] = (bf16_t)(v.z & 0xffff); d[5 * LROW] = (bf16_t)(v.z >> 16); d[6 * LROW] = (bf16_t)(v.w & 0xffff); d[7 * LROW] = (bf16_t)(v.w >> 16); }
}
__device__ __forceinline__ void load_tile_regs(const bf16_t* proj, u32x4 (&r)[4], int t0, int dir, int col0, int tid) {
#pragma unroll
    for (int it = 0; it < 4; ++it) { const int idx = tid + 512 * it, tau = idx >> 4, c16 = idx & 15;
        const int tok = dir ? t0 + 127 - tau : t0 + tau;
        r[it] = *(const u32x4*)(proj + (size_t)tok * 5120 + col0 + c16 * 8); }
}
__device__ __forceinline__ void store_tile(LAS bf16_t* TL, const u32x4 (&r)[4], int tid) {
#pragma unroll
    for (int it = 0; it < 4; ++it) { const int idx = tid + 512 * it, tau = idx >> 4, c16 = idx & 15; *(LAS u32x4*)(TL + tau * LROW + c16 * 8) = r[it]; }
}

__device__ __forceinline__ void hg_pass_a(KP p, LAS unsigned char* lds, int j) {
    LAUNDER_IDS
    const bf16_t* proj = (const bf16_t*)(p->ws + WS_PROJ);
    bf16_t* KVh = (bf16_t*)(p->ws + WS_KV); float* DEC = (float*)(p->ws + WS_DEC);
    LAS bf16_t* VT = (LAS bf16_t*)lds; LAS bf16_t* KT = (LAS bf16_t*)(lds + 34816); LAS float* TOT = (LAS float*)(lds + 69632); LAS bf16_t* ZT = (LAS bf16_t*)(lds + 71680);
    for (int u = bidL; u < 2048; u += gridDim.x) {
        int tid = tidL; asm volatile("" : "+v"(tid));
        const int wave = tid >> 6, lane = tid & 63;
        const int seq = u >> 6, c = u & 63, dir = seq & 1, h = (seq >> 1) & 7, b = seq >> 4;
        const int t0 = b * SEQ + c * 128;
        const int dk = tid & 127, g = tid >> 7;
        const float lb = hg_lower_bound(p->hg_lb, j, h * 128 + dk);
        float lcs[32], kks[32]; float lc = 0.f;
        { u32x4 zr[4], vr[4];
            load_tile_regs(proj, zr, t0, dir, 1024 * (1 + dir) + h * 128, tid); load_v_regs(proj, vr, t0, dir, h, tid);
            store_tile(ZT, zr, tid); store_vt(VT, vr, tid); }
        __syncthreads();
#pragma unroll
        for (int q = 0; q < 32; ++q) { const int tau = 32 * g + q;
            const float z = bf2f(ZT[tau * LROW + dk]);
            const float f = lb + (1.f - lb) * sigmoidf_(z);
            lc += fast_log(f); lcs[q] = lc; kks[q] = 1.f - f; }
        TOT[g * 128 + dk] = lc;
        __syncthreads();
        float rg = 0.f, total = 0.f;
#pragma unroll
        for (int gg = 0; gg < 4; ++gg) { const float tv = TOT[gg * 128 + dk]; total += tv; if (gg < g) rg += tv; }
        const float base = total - rg;
#pragma unroll
        for (int q8 = 0; q8 < 4; ++q8) { unsigned w[4];
#pragma unroll
            for (int e = 0; e < 4; ++e) { const int q = q8 * 8 + e * 2;
                w[e] = cvt_pk_bf16(kks[q] * fast_exp(base - lcs[q]), kks[q + 1] * fast_exp(base - lcs[q + 1])); }
            u32x4 o; o.x = w[0]; o.y = w[1]; o.z = w[2]; o.w = w[3];
            *(LAS u32x4*)(KT + dk * LROW + 32 * g + q8 * 8) = o; }
        if (g == 0) DEC[(size_t)u * 128 + dk] = fast_exp(total);
        __syncthreads();
        f32x4 acc[2][4];
#pragma unroll
        for (int a = 0; a < 2; ++a)
#pragma unroll
            for (int bb = 0; bb < 4; ++bb) acc[a][bb] = (f32x4){0.f, 0.f, 0.f, 0.f};
        const int l15 = lane & 15, lq = lane >> 4;
#pragma unroll
        for (int ks = 0; ks < 4; ++ks) {
            bf16x8 af[2], bfr[4];
#pragma unroll
            for (int a = 0; a < 2; ++a) af[a] = *(const LAS bf16x8*)(VT + (((wave & 3) * 2 + a) * 16 + l15) * LROW + ks * 32 + lq * 8);
#pragma unroll
            for (int bb = 0; bb < 4; ++bb) bfr[bb] = *(const LAS bf16x8*)(KT + (((wave >> 2) * 4 + bb) * 16 + l15) * LROW + ks * 32 + lq * 8);
#pragma unroll
            for (int a = 0; a < 2; ++a)
#pragma unroll
                for (int bb = 0; bb < 4; ++bb) acc[a][bb] = mfma16(bfr[bb], af[a], acc[a][bb]);
        }
        bf16_t* kvp = KVh + (size_t)u * 16384;
#pragma unroll
        for (int a = 0; a < 2; ++a)
#pragma unroll
            for (int bb = 0; bb < 4; ++bb) *(u32x2*)(kvp + (((wave & 3) * 2 + a) * 16 + l15) * 128 + ((wave >> 2) * 4 + bb) * 16 + lq * 4) = (u32x2){pk_bf16_rne(acc[a][bb][0], acc[a][bb][1]), pk_bf16_rne(acc[a][bb][2], acc[a][bb][3])};
        __syncthreads();
    }
}

__device__ __forceinline__ void hg_pass_b(KP p) {
    LAUNDER_IDS
    const bf16_t* KVh = (const bf16_t*)(p->ws + WS_KV); const float* DEC = (const float*)(p->ws + WS_DEC);
    bf16_t* SIN = (bf16_t*)(p->ws + WS_SIN);
    for (int e = bidL * NTHR + tidL; e < 131072; e += gridDim.x * NTHR) {
    const int seq = e >> 12, i4 = e & 4095, dir = seq & 1, dk = (i4 * 4) & 127;
    f32x4 S = {0.f, 0.f, 0.f, 0.f};
#pragma unroll 16
    for (int step = 0; step < 64; ++step) {
        const int c = dir ? 63 - step : step; const size_t u = (size_t)seq * 64 + c;
        const u32x2 kvr = *(const u32x2*)(KVh + u * 16384 + i4 * 4); const f32x4 kv = (f32x4){bflo(kvr.x), bfhi(kvr.x), bflo(kvr.y), bfhi(kvr.y)}; const f32x4 dc = *(const f32x4*)(DEC + u * 128 + dk);
        u32x2 o; o.x = cvt_pk_bf16(S[0], S[1]); o.y = cvt_pk_bf16(S[2], S[3]);
        *(u32x2*)(SIN + u * 16384 + i4 * 4) = o;
        S = dc * S + kv;
    }
    }
}

__device__ __forceinline__ void hg_pass_c(KP p, LAS unsigned char* lds, int j) {
    LAUNDER_IDS
    const bf16_t* proj = (const bf16_t*)(p->ws + WS_PROJ);
    const bf16_t* SIN = (const bf16_t*)(p->ws + WS_SIN);
    bf16_t* OB = (bf16_t*)(p->ws + WS_OB);
    LAS bf16_t* QT = (LAS bf16_t*)lds; LAS bf16_t* QI = (LAS bf16_t*)(lds + 34816); LAS bf16_t* KT = (LAS bf16_t*)(lds + 69632);
    LAS bf16_t* VT = (LAS bf16_t*)(lds + 104448); LAS bf16_t* PI = (LAS bf16_t*)(lds + 139264); LAS float* TOT = (LAS float*)(lds + 147968);
    LAS float* OSUM = (LAS float*)(lds + 69632);
    for (int u = bidL; u < 1024; u += gridDim.x) {
        int tid = tidL; asm volatile("" : "+v"(tid));
        const int wave = tid >> 6, lane = tid & 63, l15 = lane & 15, lq = lane >> 4;
        const int c = u & 63, h = (u >> 6) & 7, b = u >> 9;
        const int t0 = b * SEQ + c * 128;
        const int dk = tid & 127, g = tid >> 7;
        const float lb = hg_lower_bound(p->hg_lb, j, h * 128 + dk);
        const int tt = wave & 1, dvt0 = (wave >> 1) * 2;
        f32x4 oacc[2][4][2];
#pragma unroll
        for (int dir = 0; dir < 2; ++dir) {
            const size_t su = ((size_t)((b * 8 + h) * 2 + dir) * 64 + c);
            unsigned k0p[16]; float lc = 0.f; float kprev = 0.f;
            u32x4 vr[4];
            { u32x4 zr[4], qr[4];
                load_tile_regs(proj, zr, t0, dir, 1024 * (1 + dir) + h * 128, tid); load_tile_regs(proj, qr, t0, dir, h * 128, tid); load_v_regs(proj, vr, t0, dir, h, tid);
                __syncthreads();
                store_tile(KT, zr, tid); store_tile(VT, qr, tid); }
            __syncthreads();
#pragma unroll
            for (int q = 0; q < 32; ++q) { const int tau = 32 * g + q;
                const float z = bf2f(KT[tau * LROW + dk]), qv = bf2f(VT[tau * LROW + dk]);
                const float f = lb + (1.f - lb) * sigmoidf_(z);
                lc += fast_log(f);
                const float el = fast_exp(fmaxf(lc, -80.f));
                QT[tau * LROW + dk] = f2bf(qv * el);
                const float kcur = (1.f - f) * fast_rcp(el);
                if (q & 1) k0p[q >> 1] = cvt_pk_bf16(kprev, kcur); else kprev = kcur; }
            TOT[g * 128 + dk] = lc;
            __syncthreads();
            float r[4]; { float run = 0.f;
#pragma unroll
                for (int gg = 0; gg < 4; ++gg) { r[gg] = run; run += TOT[gg * 128 + dk]; } }
            float rg = 0.f;
#pragma unroll
            for (int gg = 0; gg < 4; ++gg) if (gg == g) rg = r[gg];
            { const float eg = fast_exp(rg);
#pragma unroll
                for (int q = 0; q < 32; ++q) QI[(32 * g + q) * LROW + dk] = f2bf(bf2f(QT[(32 * g + q) * LROW + dk]) * eg); }
            store_vt(VT, vr, tid);
            bf16x8 sfr[2][4];
#pragma unroll
            for (int n = 0; n < 2; ++n)
#pragma unroll
                for (int ks = 0; ks < 4; ++ks) sfr[n][ks] = *(const bf16x8*)(SIN + su * 16384 + (size_t)((dvt0 + n) * 16 + l15) * 128 + ks * 32 + lq * 8);
#pragma unroll
            for (int i = 0; i < 4; ++i) {
                if (g <= i) { const float e = fast_exp(r[i] - rg);
#pragma unroll
                    for (int q = 0; q < 32; ++q) KT[(32 * g + q) * LROW + dk] = f2bf(((q & 1) ? bfhi(k0p[q >> 1]) : bflo(k0p[q >> 1])) * e); }
                __syncthreads();
                for (int tl = wave; tl < 4 * (i + 1); tl += 8) { const int sm = tl >> 1, tn = tl & 1;
                    f32x4 a4 = {0.f, 0.f, 0.f, 0.f};
#pragma unroll
                    for (int ks = 0; ks < 4; ++ks) { const bf16x8 af = *(const LAS bf16x8*)(KT + (sm * 16 + l15) * LROW + ks * 32 + lq * 8);
                        const bf16x8 bq = *(const LAS bf16x8*)(QT + (32 * i + tn * 16 + l15) * LROW + ks * 32 + lq * 8);
                        a4 = mfma16(af, bq, a4); }
                    const int tloc = tn * 16 + l15, s0 = sm * 16 + lq * 4, tg = 32 * i + tloc;
                    u32x2 o; o.x = cvt_pk_bf16(s0 + 0 <= tg ? a4[0] : 0.f, s0 + 1 <= tg ? a4[1] : 0.f); o.y = cvt_pk_bf16(s0 + 2 <= tg ? a4[2] : 0.f, s0 + 3 <= tg ? a4[3] : 0.f);
                    *(LAS u32x2*)(PI + tloc * LROW + s0) = o; }
                __syncthreads();
                f32x4 a0 = {0.f, 0.f, 0.f, 0.f}, a1 = {0.f, 0.f, 0.f, 0.f};
                for (int ks = 0; ks <= i; ++ks) { const bf16x8 af = *(const LAS bf16x8*)(PI + (tt * 16 + l15) * LROW + ks * 32 + lq * 8);
                    const bf16x8 b0 = *(const LAS bf16x8*)(VT + ((dvt0 + 0) * 16 + l15) * LROW + ks * 32 + lq * 8);
                    const bf16x8 b1 = *(const LAS bf16x8*)(VT + ((dvt0 + 1) * 16 + l15) * LROW + ks * 32 + lq * 8);
                    a0 = mfma16(af, b0, a0); a1 = mfma16(af, b1, a1); }
#pragma unroll
                for (int ks = 0; ks < 4; ++ks) { const bf16x8 af = *(const LAS bf16x8*)(QI + (32 * i + tt * 16 + l15) * LROW + ks * 32 + lq * 8);
                    a0 = mfma16(af, sfr[0][ks], a0); a1 = mfma16(af, sfr[1][ks], a1); }
                oacc[dir][i][0] = a0; oacc[dir][i][1] = a1;
            }
        }
        __syncthreads();
#pragma unroll
        for (int i = 0; i < 4; ++i)
#pragma unroll
            for (int n = 0; n < 2; ++n)
#pragma unroll
                for (int rr = 0; rr < 4; ++rr) OSUM[(32 * i + tt * 16 + lq * 4 + rr) * 132 + (dvt0 + n) * 16 + l15] = oacc[0][i][n][rr];
        __syncthreads();
#pragma unroll
        for (int i = 0; i < 4; ++i)
#pragma unroll
            for (int n = 0; n < 2; ++n)
#pragma unroll
                for (int rr = 0; rr < 4; ++rr) OSUM[(127 - (32 * i + tt * 16 + lq * 4 + rr)) * 132 + (dvt0 + n) * 16 + l15] += oacc[1][i][n][rr];
        __syncthreads();
        { const int row = tid >> 2, part = tid & 3; const int tok = t0 + row;
            float ov[32]; float ss = 0.f;
#pragma unroll
            for (int q = 0; q < 8; ++q) { const f32x4 v = *(const LAS f32x4*)(OSUM + row * 132 + part * 32 + q * 4);
                ov[q * 4 + 0] = v[0]; ov[q * 4 + 1] = v[1]; ov[q * 4 + 2] = v[2]; ov[q * 4 + 3] = v[3]; ss += v[0] * v[0] + v[1] * v[1] + v[2] * v[2] + v[3] * v[3]; }
            ss += __shfl_xor(ss, 1); ss += __shfl_xor(ss, 2);
            const float inv = __builtin_amdgcn_rsqf(ss * (1.f / 128.f) + EPS);
            const int col = h * 128 + part * 32;
            const bf16_t* gp = proj + (size_t)tok * 5120 + 4096 + col; const float* ng = p->hg_norm_g + j * 1024 + col;
#pragma unroll
            for (int q = 0; q < 4; ++q) { const u32x4 gr = *(const u32x4*)(gp + q * 8);
                const float gv[8] = {bflo(gr.x), bfhi(gr.x), bflo(gr.y), bfhi(gr.y), bflo(gr.z), bfhi(gr.z), bflo(gr.w), bfhi(gr.w)};
                float y[8];
#pragma unroll
                for (int e = 0; e < 8; ++e) y[e] = ov[q * 8 + e] * inv * ng[q * 8 + e] * silu_(gv[e]);
                u32x4 o; o.x = cvt_pk_bf16(y[0], y[1]); o.y = cvt_pk_bf16(y[2], y[3]); o.z = cvt_pk_bf16(y[4], y[5]); o.w = cvt_pk_bf16(y[6], y[7]);
                *(u32x4*)(OB + (size_t)tok * 1024 + col + q * 8) = o; }
        }
        __syncthreads();
    }
}

__device__ __forceinline__ void lru_conv(KP p, int l) {
    LAUNDER_IDS
    const bf16_t* XB = (const bf16_t*)(p->ws + WS_XB); bf16_t* XC = (bf16_t*)(p->ws + WS_XC);
    const float* cw = p->lru_conv_w + (size_t)l * 4 * 1024; const float* cb = p->lru_conv_b + (size_t)l * 1024;
    const int gs = gridDim.x * NTHR;
    for (int it = bidL * NTHR + tidL; it < T * 128; it += gs) {
        const int tok = it >> 7, c8 = (it & 127) * 8, s = tok & (SEQ - 1);
        float acc[8];
        { const f32x4 b0 = *(const f32x4*)(cb + c8), b1 = *(const f32x4*)(cb + c8 + 4);
            acc[0] = b0[0]; acc[1] = b0[1]; acc[2] = b0[2]; acc[3] = b0[3]; acc[4] = b1[0]; acc[5] = b1[1]; acc[6] = b1[2]; acc[7] = b1[3]; }
#pragma unroll
        for (int jj = 0; jj < 4; ++jj) { const int ts = s + jj - 2;
            if (ts >= 0 && ts < SEQ) { const u32x4 xr = *(const u32x4*)(XB + (size_t)(tok + jj - 2) * 1024 + c8);
                const f32x4 w0 = *(const f32x4*)(cw + jj * 1024 + c8), w1 = *(const f32x4*)(cw + jj * 1024 + c8 + 4);
                acc[0] += bflo(xr.x) * w0[0]; acc[1] += bfhi(xr.x) * w0[1]; acc[2] += bflo(xr.y) * w0[2]; acc[3] += bfhi(xr.y) * w0[3];
                acc[4] += bflo(xr.z) * w1[0]; acc[5] += bfhi(xr.z) * w1[1]; acc[6] += bflo(xr.w) * w1[2]; acc[7] += bfhi(xr.w) * w1[3]; } }
        u32x4 o; o.x = cvt_pk_bf16(acc[0], acc[1]); o.y = cvt_pk_bf16(acc[2], acc[3]); o.z = cvt_pk_bf16(acc[4], acc[5]); o.w = cvt_pk_bf16(acc[6], acc[7]);
        *(u32x4*)(XC + (size_t)tok * 1024 + c8) = o;
    }
}
__device__ __forceinline__ void lru_scan1(KP p, LAS unsigned char* lds) {
    LAUNDER_IDS
    const bf16_t* LOGA = (const bf16_t*)(p->ws + WS_LOGA); const bf16_t* BT = (const bf16_t*)(p->ws + WS_BTERM);
    float* CP = (float*)(p->ws + WS_CP); float* CH = (float*)(p->ws + WS_CH);
    LAS float* XP = (LAS float*)lds; LAS float* XH = (LAS float*)(lds + 16384);
    for (int u = bidL; u < 1024; u += gridDim.x) {
        int tid = tidL; asm volatile("" : "+v"(tid));
        const int ts = tid >> 7, c8 = (tid & 127) * 8;
        const int chunk = u & 255, dir = (u >> 8) & 1, b = u >> 9;
        const size_t base = ((size_t)dir * T + b * SEQ + chunk * 32) * 1024 + c8;
        u32x4 lw[8], bw[8];
#pragma unroll
        for (int q = 0; q < 8; ++q) { const int t = dir ? 31 - (ts * 8 + q) : ts * 8 + q; lw[q] = *(const u32x4*)(LOGA + base + (size_t)t * 1024); bw[q] = *(const u32x4*)(BT + base + (size_t)t * 1024); }
        float h[8], sl[8];
#pragma unroll
        for (int i = 0; i < 8; ++i) { h[i] = 0.f; sl[i] = 0.f; }
#pragma unroll
        for (int q = 0; q < 8; ++q) {
#pragma unroll
            for (int w = 0; w < 4; ++w) { const float l0 = bflo(lw[q][w]), l1 = bfhi(lw[q][w]);
                h[2 * w] = fast_exp(l0) * h[2 * w] + bflo(bw[q][w]); h[2 * w + 1] = fast_exp(l1) * h[2 * w + 1] + bfhi(bw[q][w]); sl[2 * w] += l0; sl[2 * w + 1] += l1; } }
        *(LAS f32x4*)(XP + ts * 1024 + c8) = (f32x4){fast_exp(sl[0]), fast_exp(sl[1]), fast_exp(sl[2]), fast_exp(sl[3])};
        *(LAS f32x4*)(XP + ts * 1024 + c8 + 4) = (f32x4){fast_exp(sl[4]), fast_exp(sl[5]), fast_exp(sl[6]), fast_exp(sl[7])};
        *(LAS f32x4*)(XH + ts * 1024 + c8) = (f32x4){h[0], h[1], h[2], h[3]}; *(LAS f32x4*)(XH + ts * 1024 + c8 + 4) = (f32x4){h[4], h[5], h[6], h[7]};
        __syncthreads();
        { const int ch = 2 * tid; float P0 = 1.f, P1 = 1.f, H0 = 0.f, H1 = 0.f;
#pragma unroll
            for (int s2 = 0; s2 < 4; ++s2) { const f32x2 pp = *(const LAS f32x2*)(XP + s2 * 1024 + ch), hh = *(const LAS f32x2*)(XH + s2 * 1024 + ch);
                H0 = pp[0] * H0 + hh[0]; H1 = pp[1] * H1 + hh[1]; P0 *= pp[0]; P1 *= pp[1]; }
            const size_t o = ((size_t)(b * 2 + dir) * 256 + chunk) * 1024 + ch;
            *(f32x2*)(CP + o) = (f32x2){P0, P1}; *(f32x2*)(CH + o) = (f32x2){H0, H1}; }
        __syncthreads();
    }
}
__device__ __forceinline__ void lru_scan2(KP p) {
    LAUNDER_IDS
    const float* CP = (const float*)(p->ws + WS_CP); const float* CH = (const float*)(p->ws + WS_CH); float* HIN = (float*)(p->ws + WS_HIN);
    const int wave = tidL >> 6, lane = tidL & 63;
    for (int item = bidL * NWAVE + wave; item < 4096; item += gridDim.x * NWAVE) {
        const int ch = item & 1023, bd = item >> 10, dir = bd & 1;
        float pp[4], hh[4]; float Pl = 1.f, Hl = 0.f;
#pragma unroll
        for (int q = 0; q < 4; ++q) { const int ci = 4 * lane + q, chunk = dir ? 255 - ci : ci; const size_t o = ((size_t)bd * 256 + chunk) * 1024 + ch;
            pp[q] = CP[o]; hh[q] = CH[o]; Hl = pp[q] * Hl + hh[q]; Pl *= pp[q]; }
#pragma unroll
        for (int off = 1; off < 64; off <<= 1) { const float Pp = __shfl_up(Pl, off), Hp = __shfl_up(Hl, off);
            if (lane >= off) { Hl = Pl * Hp + Hl; Pl = Pl * Pp; } }
        float carry = __shfl_up(Hl, 1); if (lane == 0) carry = 0.f;
#pragma unroll
        for (int q = 0; q < 4; ++q) { const int ci = 4 * lane + q, chunk = dir ? 255 - ci : ci; const size_t o = ((size_t)bd * 256 + chunk) * 1024 + ch;
            HIN[o] = carry; carry = pp[q] * carry + hh[q]; }
    }
}
__device__ __forceinline__ void lru_scan3(KP p, LAS unsigned char* lds) {
    LAUNDER_IDS
    const bf16_t* LOGA = (const bf16_t*)(p->ws + WS_LOGA); const bf16_t* BT = (const bf16_t*)(p->ws + WS_BTERM); const bf16_t* YG = (const bf16_t*)(p->ws + WS_YG);
    const float* HIN = (const float*)(p->ws + WS_HIN); bf16_t* OB = (bf16_t*)(p->ws + WS_OB);
    LAS float* XP = (LAS float*)lds; LAS float* XH = (LAS float*)(lds + 16384);
    for (int u = bidL; u < 512; u += gridDim.x) {
        int tid = tidL; asm volatile("" : "+v"(tid));
        const int ts = tid >> 7, c8 = (tid & 127) * 8;
        const int chunk = u & 255, b = u >> 8;
        const size_t base = ((size_t)b * SEQ + chunk * 32 + ts * 8) * 1024 + c8;
        unsigned hsp[8][4];
#pragma unroll
        for (int dir = 0; dir < 2; ++dir) {
            u32x4 lw[8], bw[8];
#pragma unroll
            for (int q = 0; q < 8; ++q) { lw[q] = *(const u32x4*)(LOGA + (size_t)dir * T * 1024 + base + (size_t)q * 1024); bw[q] = *(const u32x4*)(BT + (size_t)dir * T * 1024 + base + (size_t)q * 1024); }
            const f32x4 hi0 = *(const f32x4*)(HIN + ((size_t)(b * 2 + dir) * 256 + chunk) * 1024 + c8), hi1 = *(const f32x4*)(HIN + ((size_t)(b * 2 + dir) * 256 + chunk) * 1024 + c8 + 4);
            float h[8], sl[8];
#pragma unroll
            for (int i = 0; i < 8; ++i) { h[i] = 0.f; sl[i] = 0.f; }
#pragma unroll
            for (int qq = 0; qq < 8; ++qq) { const int q = dir ? 7 - qq : qq;
#pragma unroll
                for (int w = 0; w < 4; ++w) { const float l0 = bflo(lw[q][w]), l1 = bfhi(lw[q][w]);
                    h[2 * w] = fast_exp(l0) * h[2 * w] + bflo(bw[q][w]); h[2 * w + 1] = fast_exp(l1) * h[2 * w + 1] + bfhi(bw[q][w]); sl[2 * w] += l0; sl[2 * w + 1] += l1; } }
            __syncthreads();
            *(LAS f32x4*)(XP + ts * 1024 + c8) = (f32x4){fast_exp(sl[0]), fast_exp(sl[1]), fast_exp(sl[2]), fast_exp(sl[3])};
            *(LAS f32x4*)(XP + ts * 1024 + c8 + 4) = (f32x4){fast_exp(sl[4]), fast_exp(sl[5]), fast_exp(sl[6]), fast_exp(sl[7])};
            *(LAS f32x4*)(XH + ts * 1024 + c8) = (f32x4){h[0], h[1], h[2], h[3]}; *(LAS f32x4*)(XH + ts * 1024 + c8 + 4) = (f32x4){h[4], h[5], h[6], h[7]};
            __syncthreads();
            h[0] = hi0[0]; h[1] = hi0[1]; h[2] = hi0[2]; h[3] = hi0[3]; h[4] = hi1[0]; h[5] = hi1[1]; h[6] = hi1[2]; h[7] = hi1[3];
#pragma unroll
            for (int s3 = 0; s3 < 3; ++s3) { const int sr = dir ? 3 - s3 : s3; const bool use = dir ? (sr > ts) : (sr < ts);
                const f32x4 p0 = *(const LAS f32x4*)(XP + sr * 1024 + c8), p1 = *(const LAS f32x4*)(XP + sr * 1024 + c8 + 4), q0 = *(const LAS f32x4*)(XH + sr * 1024 + c8), q1 = *(const LAS f32x4*)(XH + sr * 1024 + c8 + 4);
                if (use) { h[0] = p0[0] * h[0] + q0[0]; h[1] = p0[1] * h[1] + q0[1]; h[2] = p0[2] * h[2] + q0[2]; h[3] = p0[3] * h[3] + q0[3];
                    h[4] = p1[0] * h[4] + q1[0]; h[5] = p1[1] * h[5] + q1[1]; h[6] = p1[2] * h[6] + q1[2]; h[7] = p1[3] * h[7] + q1[3]; } }
#pragma unroll
            for (int qq = 0; qq < 8; ++qq) { const int q = dir ? 7 - qq : qq;
                u32x4 yw; if (dir) yw = *(const u32x4*)(YG + base + (size_t)q * 1024);
                unsigned ow[4];
#pragma unroll
                for (int w = 0; w < 4; ++w) { h[2 * w] = fast_exp(bflo(lw[q][w])) * h[2 * w] + bflo(bw[q][w]); h[2 * w + 1] = fast_exp(bfhi(lw[q][w])) * h[2 * w + 1] + bfhi(bw[q][w]);
                    if (dir == 0) hsp[q][w] = cvt_pk_bf16(h[2 * w], h[2 * w + 1]);
                    else ow[w] = cvt_pk_bf16((bflo(hsp[q][w]) + h[2 * w]) * bflo(yw[w]), (bfhi(hsp[q][w]) + h[2 * w + 1]) * bfhi(yw[w])); }
                if (dir) *(u32x4*)(OB + base + (size_t)q * 1024) = (u32x4){ow[0], ow[1], ow[2], ow[3]}; }
        }
        __syncthreads();
    }
}

__device__ const unsigned char STAIR[64] = {
    0x00, 0x01, 0x02, 0x03, 0x04, 0x05, 0x06, 0x07, 0x08, 0x09, 0x0a, 0x0b, 0x0c, 0x0d, 0x0e, 0x0f,
    0x10, 0x11, 0x12, 0x13, 0x14, 0x15, 0x16, 0x17, 0x20, 0x21, 0x22, 0x23, 0x24, 0x30, 0x31, 0x32,
    0x33, 0x40, 0x41, 0x42, 0x50, 0x51, 0x60, 0x61, 0x70, 0x71, 0x80, 0x90, 0xa0, 0xb0, 0xc0, 0xd0,
    0xe0, 0xf0, 0, 0, 0, 0, 0, 0, 0, 0, 0, 0, 0, 0, 0, 0};
__device__ __forceinline__ unsigned mono_key(float f) { const unsigned b = __float_as_uint(f); return b ^ ((b >> 31) ? 0xffffffffu : 0x80000000u); }

__device__ __forceinline__ float inv_mono(unsigned k) { return __uint_as_float(k ^ ((k >> 31) ? 0x80000000u : 0xffffffffu)); }
#define TK_CE(A, B) do { const unsigned hi_ = max(A, B), lo_ = min(A, B); A = hi_; B = lo_; } while (0)
#define TK_SORT16(N) do { _Pragma("unroll") for (int k_ = 2; k_ <= 16; k_ <<= 1) { _Pragma("unroll") for (int j_ = k_ >> 1; j_ > 0; j_ >>= 1) { _Pragma("unroll") for (int i_ = 0; i_ < 16; ++i_) { \
    const int l_ = i_ ^ j_; if (l_ > i_) { if ((i_ & k_) == 0) TK_CE(N[i_], N[l_]); else TK_CE(N[l_], N[i_]); } } } } } while (0)
#define TK_MERGE16(L, N) do { _Pragma("unroll") for (int i_ = 0; i_ < 16; ++i_) L[i_] = max(L[i_], N[15 - i_]); \
    _Pragma("unroll") for (int j_ = 8; j_ > 0; j_ >>= 1) { _Pragma("unroll") for (int i_ = 0; i_ < 16; ++i_) { const int l_ = i_ ^ j_; if (l_ > i_) TK_CE(L[i_], L[l_]); } } } while (0)
#define TK_INSERT(L, x) do { _Pragma("unroll") for (int q_ = 0; q_ < 16; ++q_) { const unsigned hi_ = max(L[q_], x); x = min(L[q_], x); L[q_] = hi_; } } while (0)
__device__ __forceinline__ void peer_topk(KP p, LAS unsigned char* lds) {
    LAUNDER_IDS
    (void)bidL;
    const int tid = tidL, wave = tid >> 6, lane = tid & 63;
    const bf16_t* SCh = (const bf16_t*)(p->ws + WS_SCORES);
    LAS float* TB = (LAS float*)(lds + 32768 + wave * 8704);
    int* TOPI = (int*)(p->ws + WS_TOPI); float* TOPG = (float*)(p->ws + WS_TOPG);
    LAS unsigned char* IX = lds + wave * 2048 + lane * 32;
    for (int item = bidL * NWAVE + wave; item < 2048; item += gridDim.x * NWAVE) {
        const int tg = item >> 3, hd = item & 7, tok = tg * 64 + lane;
        float V[2][16];
#pragma unroll
        for (int half = 0; half < 2; ++half) {
            unsigned L[16];
#pragma unroll
            for (int q = 0; q < 16; ++q) L[q] = 0u;
            const bf16_t* scb = SCh + (size_t)(tg * 64 + (lane >> 2)) * 2048 + hd * 256 + half * 128 + (lane & 3) * 8;
            u32x4 nx[4];
#pragma unroll
            for (int i = 0; i < 4; ++i) nx[i] = *(const u32x4*)(scb + (size_t)(16 * i) * 2048);
#pragma unroll 1
            for (int ch = 0; ch < 4; ++ch) {
#pragma unroll
                for (int i = 0; i < 4; ++i) { LAS float* d = TB + ((lane >> 2) + 16 * i) * 33 + (lane & 3) * 8;
                    d[0] = bflo(nx[i].x); d[1] = bfhi(nx[i].x); d[2] = bflo(nx[i].y); d[3] = bfhi(nx[i].y); d[4] = bflo(nx[i].z); d[5] = bfhi(nx[i].z); d[6] = bflo(nx[i].w); d[7] = bfhi(nx[i].w); }
                asm volatile("s_waitcnt lgkmcnt(0)" ::: "memory");
                const int cn = ch < 3 ? ch + 1 : ch;
#pragma unroll
                for (int i = 0; i < 4; ++i) nx[i] = *(const u32x4*)(scb + (size_t)(16 * i) * 2048 + 32 * cn);
#pragma unroll
                for (int sb = 0; sb < 2; ++sb) {
                    float cur[16];
#pragma unroll
                    for (int i = 0; i < 16; ++i) cur[i] = TB[lane * 33 + sb * 16 + i];
                    asm volatile("s_waitcnt lgkmcnt(0)" ::: "memory");
                    unsigned NK[16];
#pragma unroll
                    for (int i = 0; i < 16; ++i) NK[i] = (mono_key(cur[i]) & ~0x7fu) | (unsigned)(ch * 32 + sb * 16 + i);
                    TK_SORT16(NK); TK_MERGE16(L, NK);
                }
            }
            u32x4 w0, w1;
            w0.x = (L[0] & 0x7f) | ((L[1] & 0x7f) << 8) | ((L[2] & 0x7f) << 16) | ((L[3] & 0x7f) << 24); w0.y = (L[4] & 0x7f) | ((L[5] & 0x7f) << 8) | ((L[6] & 0x7f) << 16) | ((L[7] & 0x7f) << 24);
            w0.z = (L[8] & 0x7f) | ((L[9] & 0x7f) << 8) | ((L[10] & 0x7f) << 16) | ((L[11] & 0x7f) << 24); w0.w = (L[12] & 0x7f) | ((L[13] & 0x7f) << 8) | ((L[14] & 0x7f) << 16) | ((L[15] & 0x7f) << 24);
            *(LAS u32x4*)(IX + half * 16) = w0;
#pragma unroll
            for (int q = 0; q < 16; ++q) V[half][q] = inv_mono(L[q]);
        }
        unsigned C[16];
#pragma unroll
        for (int q = 0; q < 16; ++q) C[q] = 0u;
#pragma unroll
        for (int i = 0; i < 16; ++i)
#pragma unroll
            for (int jj = 0; jj < 16; ++jj) if ((i + 1) * (jj + 1) <= 16) { unsigned x = (mono_key(V[0][i] + V[1][jj]) & ~0xffu) | (unsigned)(i * 16 + jj); TK_INSERT(C, x); }
        asm volatile("s_waitcnt lgkmcnt(0)" ::: "memory");
        const float s0 = inv_mono(C[0] & ~0xffu);
        float e[16]; float sum = 0.f; int ids[16];
#pragma unroll
        for (int q = 0; q < 16; ++q) { e[q] = fast_exp(inv_mono(C[q] & ~0xffu) - s0); sum += e[q];
            const unsigned code = C[q] & 0xffu; ids[q] = (int)IX[code >> 4] * 128 + (int)IX[16 + (code & 15u)]; }
        const float rs = fast_rcp(sum);
        int* ip = TOPI + (size_t)tok * 128 + hd * 16; float* gp = TOPG + (size_t)tok * 128 + hd * 16;
#pragma unroll
        for (int q = 0; q < 4; ++q) { *(u32x4*)(ip + 4 * q) = (u32x4){(unsigned)ids[4 * q], (unsigned)ids[4 * q + 1], (unsigned)ids[4 * q + 2], (unsigned)ids[4 * q + 3]};
            *(f32x4*)(gp + 4 * q) = (f32x4){e[4 * q] * rs, e[4 * q + 1] * rs, e[4 * q + 2] * rs, e[4 * q + 3] * rs}; }
        asm volatile("s_waitcnt lgkmcnt(0)" ::: "memory");
    }
}

__device__ __forceinline__ void peer_gather(KP p, int l, bool dry) {
    LAUNDER_IDS
    const int wave = tidL >> 6, lane = tidL & 63;
    const bf16_t* HB = (const bf16_t*)(p->ws + WS_HBUF); bf16_t* HBW = (bf16_t*)(p->ws + WS_HBUF);
    const int* TOPI = (const int*)(p->ws + WS_TOPI); const float* TOPG = (const float*)(p->ws + WS_TOPG);
    const unsigned char* UA = p->ws + WS_UTAB + (size_t)l * 16384 * 512; const unsigned char* V8 = p->ws + WS_VTAB + (size_t)l * 16384 * 512 + 8 * lane; const unsigned char* H8 = p->ws + WS_HB8;
    const float* USC = (const float*)(p->ws + WS_USC) + l * 16384; const float* VSC = (const float*)(p->ws + WS_VSC) + l * 16384;
    float* XRES = (float*)(p->ws + WS_XRES); const float* MOD = (const float*)(p->ws + WS_MOD);
    for (int tok = bidL * NWAVE + wave; tok < T; tok += gridDim.x * NWAVE) {
        const int b = tok >> 13;
        const int gq = lane >> 4, jq = lane & 15;
        v8i hb[8];
#pragma unroll
        for (int sidx = 0; sidx < 8; ++sidx) { const u32x4 lo = *(const u32x4*)(H8 + (size_t)tok * 1024 + 128 * sidx + 16 * gq), hi = *(const u32x4*)(H8 + (size_t)tok * 1024 + 128 * sidx + 64 + 16 * gq);
            hb[sidx] = (v8i){(int)lo.x, (int)lo.y, (int)lo.z, (int)lo.w, (int)hi.x, (int)hi.y, (int)hi.z, (int)hi.w}; }
        const int id0 = TOPI[(size_t)tok * 128 + lane], id1 = TOPI[(size_t)tok * 128 + 64 + lane];
        const float g0 = TOPG[(size_t)tok * 128 + lane], g1 = TOPG[(size_t)tok * 128 + 64 + lane];
        f32x2 acc2[8];
#pragma unroll
        for (int i = 0; i < 8; ++i) acc2[i] = (f32x2){0.f, 0.f};
        const int ke = 4 * gq + (jq & 3);
#pragma unroll 1
        for (int e0 = 0; e0 < 128; e0 += 16) {
            const int ida = __shfl(e0 < 64 ? id0 : id1, (e0 + jq) & 63) & 16383;
            const unsigned char* ua_p = UA + (size_t)ida * 512 + 16 * gq;
            u32x4 ua[8];
#pragma unroll
            for (int sidx = 0; sidx < 8; ++sidx) ua[sidx] = *(const u32x4*)(ua_p + 64 * sidx);
            u32x2 vq[16];
#pragma unroll
            for (int k = 0; k < 16; ++k) { const int id = __builtin_amdgcn_readlane(e0 < 64 ? id0 : id1, (e0 + k) & 63) & 16383; vq[k] = *(const u32x2*)(V8 + (size_t)id * 512); }
            const int idk = __shfl(e0 < 64 ? id0 : id1, (e0 + ke) & 63) & 16383; const float gl = __shfl(e0 < 64 ? g0 : g1, (e0 + ke) & 63);
            const float sul = USC[idk], svl = VSC[idk];
            f32x4 dacc = {0.f, 0.f, 0.f, 0.f};
#pragma unroll
            for (int sidx = 0; sidx < 8; ++sidx) { const v8i av = (v8i){(int)ua[sidx].x, (int)ua[sidx].y, (int)ua[sidx].z, (int)ua[sidx].w, 0, 0, 0, 0};
                dacc = __builtin_amdgcn_mfma_scale_f32_16x16x128_f8f6f4(av, hb[sidx], dacc, 4, 0, 0, 0x7f7f7f7f, 0, 0x7f7f7f7f); }
            const int jr = jq & 3;
            const float r = jr == 0 ? dacc[0] : jr == 1 ? dacc[1] : jr == 2 ? dacc[2] : dacc[3];
            const float cfl = gl * gelu_tanh(r * sul) * svl;
#pragma unroll
            for (int k = 0; k < 16; ++k) { const float cf = __uint_as_float(__builtin_amdgcn_readlane(__float_as_uint(cfl), 16 * (k >> 2) + (k & 3)));
                const f32x2 cf2 = (f32x2){cf, cf};
#pragma unroll
                for (int w = 0; w < 2; ++w) {
                    acc2[4 * w + 0] = __builtin_amdgcn_cvt_scalef32_pk_f32_fp4(vq[k][w], 1.0f, 0) * cf2 + acc2[4 * w + 0]; acc2[4 * w + 1] = __builtin_amdgcn_cvt_scalef32_pk_f32_fp4(vq[k][w], 1.0f, 1) * cf2 + acc2[4 * w + 1];
                    acc2[4 * w + 2] = __builtin_amdgcn_cvt_scalef32_pk_f32_fp4(vq[k][w], 1.0f, 2) * cf2 + acc2[4 * w + 2]; acc2[4 * w + 3] = __builtin_amdgcn_cvt_scalef32_pk_f32_fp4(vq[k][w], 1.0f, 3) * cf2 + acc2[4 * w + 3]; } }
        }
        const float* g2 = MOD + ((size_t)l * 2 + b) * 6144 + 5 * 1024 + 16 * lane;
        float* xrow = XRES + (size_t)tok * 1024 + 16 * lane;
        float xn[16]; float ss = 0.f;
#pragma unroll
        for (int q = 0; q < 4; ++q) { const f32x4 xr = *(const f32x4*)(xrow + 4 * q), gg = *(const f32x4*)(g2 + 4 * q);
            const float a0 = acc2[2 * q][0], a1 = acc2[2 * q][1], a2 = acc2[2 * q + 1][0], a3 = acc2[2 * q + 1][1];
            xn[4 * q + 0] = xr[0] + gg[0] * a0; xn[4 * q + 1] = xr[1] + gg[1] * a1; xn[4 * q + 2] = xr[2] + gg[2] * a2; xn[4 * q + 3] = xr[3] + gg[3] * a3; }
#pragma unroll
        for (int i = 0; i < 16; ++i) ss += xn[i] * xn[i];
        const float inv = __builtin_amdgcn_rsqf(wave_sum(ss) * (1.f / 1024.f) + EPS);
        if (dry) { if (inv == 123.456f) p->out[tok] = inv; continue; }
        if (l < DEPTH - 1) {
            const float* gain = p->norm_g + (size_t)(l + 1) * 2 * 1024 + 16 * lane; const float* sh = MOD + ((size_t)(l + 1) * 2 + b) * 6144 + 16 * lane; const float* sc = sh + 1024;
            float y[16];
#pragma unroll
            for (int q = 0; q < 4; ++q) { const f32x4 gn = *(const f32x4*)(gain + 4 * q), s1 = *(const f32x4*)(sh + 4 * q), c1 = *(const f32x4*)(sc + 4 * q);
                *(f32x4*)(xrow + 4 * q) = (f32x4){xn[4 * q], xn[4 * q + 1], xn[4 * q + 2], xn[4 * q + 3]};
#pragma unroll
                for (int i = 0; i < 4; ++i) y[4 * q + i] = (xn[4 * q + i] * inv) * gn[i] * (1.f + c1[i]) + s1[i]; }
            u32x4 o0, o1; o0.x = cvt_pk_bf16(y[0], y[1]); o0.y = cvt_pk_bf16(y[2], y[3]); o0.z = cvt_pk_bf16(y[4], y[5]); o0.w = cvt_pk_bf16(y[6], y[7]);
            o1.x = cvt_pk_bf16(y[8], y[9]); o1.y = cvt_pk_bf16(y[10], y[11]); o1.z = cvt_pk_bf16(y[12], y[13]); o1.w = cvt_pk_bf16(y[14], y[15]);
            *(u32x4*)(HBW + (size_t)tok * 1024 + 16 * lane) = o0; *(u32x4*)(HBW + (size_t)tok * 1024 + 16 * lane + 8) = o1;
        } else {
            const float* fg = p->final_g + 16 * lane; float* orow = p->out + (size_t)tok * 1024 + 16 * lane;
#pragma unroll
            for (int q = 0; q < 4; ++q) { const f32x4 gn = *(const f32x4*)(fg + 4 * q); f32x4 o;
#pragma unroll
                for (int i = 0; i < 4; ++i) o[i] = (xn[4 * q + i] * inv) * gn[i];
                *(f32x4*)(orow + 4 * q) = o; }
        }
    }
}

#define XB_TMO      128
#define XB_XCNT(j)  (256  + 64 * (j))
#define XB_XSUB(j)  (1280 + 64 * (j))
#define XB_XGEN(j)  (2304 + 64 * (j))
#define XB_TOP      3328
#define XB_TOPGEN   3392
#define XCD_BAR_WORDS 3456
#define XB_SPIN_CAP (1u << 18)

__device__ __forceinline__ unsigned xb_ld(unsigned* p)              { return __hip_atomic_load(p, __ATOMIC_RELAXED, __HIP_MEMORY_SCOPE_AGENT); }
__device__ __forceinline__ unsigned xb_add(unsigned* p, unsigned v) { return __hip_atomic_fetch_add(p, v, __ATOMIC_RELAXED, __HIP_MEMORY_SCOPE_AGENT); }
__device__ __forceinline__ unsigned xb_xcc_id() { return (unsigned)__builtin_amdgcn_s_getreg((3 << 11) | 20) & 0xFu; }
#define XB_SPIN(cond, bar) do { unsigned _sp = 0; while (cond) { __builtin_amdgcn_s_sleep(1); \
    if ((++_sp & 255u) == 0u) { if (xb_ld(&(bar)[XB_TMO])) break; if (_sp > XB_SPIN_CAP) { atomicAdd(&(bar)[XB_TMO], 1u); break; } } } } while (0)

struct XcdBarrier {
    unsigned* bar; unsigned x;
    volatile LAS unsigned* st;
};

__device__ __forceinline__ XcdBarrier xcd_barrier_post(unsigned* bar, volatile LAS unsigned* st) {
    XcdBarrier b; b.bar = bar; b.x = xb_xcc_id(); b.st = st;
    if (threadIdx.x == 0) (void)xb_add(&bar[XB_XCNT(b.x)], 1u);
    return b;
}
__device__ __forceinline__ void xcd_barrier_complete(unsigned* bar, unsigned x, unsigned& nloc, unsigned& nx) {
    const unsigned G = gridDim.x * gridDim.y * gridDim.z;
    unsigned sum, cnt, mine, sp = 0u;
    for (;;) {
        sum = 0u; cnt = 0u; mine = 0u;
#pragma unroll
        for (unsigned j = 0; j < 16; ++j) { const unsigned c = xb_ld(&bar[XB_XCNT(j)]); sum += c; cnt += (c > 0u) ? 1u : 0u; mine = (j == x) ? c : mine; }
        if (sum == G) break;
        __builtin_amdgcn_s_sleep(1);
        if ((++sp & 255u) == 0u) { if (xb_ld(&bar[XB_TMO])) break; if (sp > XB_SPIN_CAP) { atomicAdd(&bar[XB_TMO], 1u); break; } }
    }
    nloc = mine > 0u ? mine : 1u; nx = cnt > 0u ? cnt : 1u;
}

__device__ __forceinline__ void xcd_barrier(const XcdBarrier& b) {
    asm volatile("s_waitcnt vmcnt(0)" ::: "memory");
    __syncthreads();
    if (threadIdx.x == 0) {
        unsigned* bar = b.bar;
        __builtin_amdgcn_s_waitcnt(0);
        unsigned nloc = b.st[0], nx = b.st[1];
        if (nloc == 0u) { xcd_barrier_complete(bar, b.x, nloc, nx); b.st[0] = nloc; b.st[1] = nx; }
        const unsigned old = xb_add(&bar[XB_XSUB(b.x)], 1u);
        const unsigned gen = old / nloc;
        if (old + 1u == (gen + 1u) * nloc) {
            __builtin_amdgcn_fence(__ATOMIC_RELEASE, "agent");
            asm volatile("s_waitcnt vmcnt(0)" ::: "memory");
            const unsigned og = xb_add(&bar[XB_TOP], 1u);
            const unsigned tg = og / nx;
            if (og + 1u == (tg + 1u) * nx) xb_add(&bar[XB_TOPGEN], 1u);
            else XB_SPIN(xb_ld(&bar[XB_TOPGEN]) == tg, bar);
            __builtin_amdgcn_fence(__ATOMIC_ACQUIRE, "agent");
            xb_add(&bar[XB_XGEN(b.x)], 1u);
            asm volatile("s_waitcnt vmcnt(0)" ::: "memory");
        } else {
            XB_SPIN(xb_ld(&bar[XB_XGEN(b.x)]) == gen, bar);
            __builtin_amdgcn_fence(__ATOMIC_ACQUIRE, "agent");
            asm volatile("s_waitcnt vmcnt(0)" ::: "memory");
        }
    }
    __syncthreads();
}

#ifndef OPMASK
#define OPMASK 0xFFFFFFFFu
#endif
#define EN(o) ((OPMASK >> (o)) & 1u)
enum { OP_P0 = 0, OP_RMS1, OP_HG_IN, OP_HG_A, OP_HG_B, OP_HG_C, OP_MIX_OUT, OP_LR_IN, OP_LR_CONV, OP_LR_G, OP_LR_S1, OP_LR_S2, OP_LR_S3, OP_RMS2, OP_QK, OP_TOPK, OP_GATHER };
constexpr int NPH = 42;
#define REP_MASK 0u
__device__ __forceinline__ void decode_phase(int ph, int& l, int& op) {
    if (ph == 0) { l = 0; op = OP_P0; return; }
    if (ph == 1) { l = 0; op = OP_RMS1; return; }
    int q = ph - 2;
    if (q < 9) { l = 0; } else if (q < 20) { l = 1; q -= 9; } else if (q < 29) { l = 2; q -= 20; } else { l = 3; q -= 29; }
    if ((l & 1) == 0) { op = q == 0 ? OP_HG_IN : q == 1 ? OP_HG_A : q == 2 ? OP_HG_B : q == 3 ? OP_HG_C : q == 4 ? OP_MIX_OUT : q == 5 ? OP_RMS2 : q == 6 ? OP_QK : q == 7 ? OP_TOPK : OP_GATHER; }
    else { op = q == 0 ? OP_LR_IN : q == 1 ? OP_LR_CONV : q == 2 ? OP_LR_G : q == 3 ? OP_LR_S1 : q == 4 ? OP_LR_S2 : q == 5 ? OP_LR_S3 : q == 6 ? OP_MIX_OUT : q == 7 ? OP_RMS2 : q == 8 ? OP_QK : q == 9 ? OP_TOPK : OP_GATHER; }
}

__global__ __launch_bounds__(512, 2) void mk_fwd(Params p_arg) {
    extern __shared__ __attribute__((aligned(16))) unsigned char shm[];
    LAS unsigned char* lds = (LAS unsigned char*)shm;
    cg::grid_group grid = cg::this_grid();
    unsigned long long kpv = (unsigned long long)__builtin_amdgcn_kernarg_segment_ptr();
    const int ph_lo = p_arg.ph_lo, ph_hi = p_arg.ph_hi;
    volatile LAS unsigned* xst = (volatile LAS unsigned*)(lds + LDS_BYTES - 16);
    if (threadIdx.x == 0) { xst[0] = 0u; xst[1] = 0u; }
    __syncthreads();
    const XcdBarrier xb = xcd_barrier_post((unsigned*)(p_arg.ws + WS_CTL) + 1024, xst);
    for (int ph = ph_lo; ph < ph_hi; ++ph) {
        if (ph > ph_lo) { if (ph_hi > 4096) grid.sync(); else xcd_barrier(xb); }
        asm volatile("" : "+s"(kpv));
        KP p = (KP)kpv;
        unsigned char* ws = p->ws;
        const float* MOD = (const float*)(ws + WS_MOD);
        int l, op; decode_phase(ph, l, op);
        const int j = l >> 1;
        const int nrep = ((p->rep_mask >> op) & 1u) ? 2 : 1;
        for (int rep = 0; rep < nrep; ++rep) {
        const bool dry = rep + 1 < nrep;
#ifdef ONLY
        switch (ONLY) {
#else
        switch (op) {
#endif
        case OP_P0: if (EN(OP_P0)) phase0(p, lds); break;
        case OP_RMS1: if (EN(OP_RMS1)) phase_rms(p->x, p->norm_g, MOD, MOD + 1024, (bf16_t*)(ws + WS_HBUF), nullptr); break;
        case OP_HG_IN: if (EN(OP_HG_IN)) { EpiBf16 E; E.O = (bf16_t*)(ws + WS_PROJ); E.ldc = 5120;
            run_gemm(lds, (const bf16_t*)(ws + WS_HBUF), (const bf16_t*)(ws + WS_HGWIN) + (size_t)j * 5120 * 1024, 5120, 1024, 1024, 1024, 0, 0, E); } break;
        case OP_HG_A: if (EN(OP_HG_A)) hg_pass_a(p, lds, j); break;
        case OP_HG_B: if (EN(OP_HG_B)) hg_pass_b(p); break;
        case OP_HG_C: if (EN(OP_HG_C)) hg_pass_c(p, lds, j); break;
        case OP_MIX_OUT: if (EN(OP_MIX_OUT)) { EpiResid E; E.xin = (l == 0) ? p->x : (const float*)(ws + WS_XRES); E.xout = (float*)(ws + WS_XRES); E.gate = MOD + (size_t)l * 2 * 6144 + 2 * 1024; E.dry = dry;
            const bf16_t* W = (l & 1) ? (const bf16_t*)(ws + WS_LRWOUT) + (size_t)j * 1024 * 1024 : (const bf16_t*)(ws + WS_HGWOUT) + (size_t)j * 1024 * 1024;
            run_gemm(lds, (const bf16_t*)(ws + WS_OB), W, 1024, 1024, 1024, 1024, 0, 0, E); } break;
        case OP_LR_IN: if (EN(OP_LR_IN)) { EpiLruIn E; E.XB = (bf16_t*)(ws + WS_XB); E.YG = (bf16_t*)(ws + WS_YG);
            run_gemm(lds, (const bf16_t*)(ws + WS_HBUF), (const bf16_t*)(ws + WS_LRWIN) + (size_t)j * 2048 * 1024, 2048, 1024, 1024, 1024, 0, 0, E); } break;
        case OP_LR_CONV: if (EN(OP_LR_CONV)) lru_conv(p, j); break;
        case OP_LR_G: if (EN(OP_LR_G)) { EpiGates E; E.LOGA = (bf16_t*)(ws + WS_LOGA); E.BTERM = (bf16_t*)(ws + WS_BTERM); E.XC = (const bf16_t*)(ws + WS_XC);
            E.b_a = p->lru_b_a + (size_t)j * 2048; E.b_x = p->lru_b_x + (size_t)j * 2048; E.lam = p->lru_lam + (size_t)j * 2048;
            run_gemm(lds, (const bf16_t*)(ws + WS_XC), (const bf16_t*)(ws + WS_LRWG) + (size_t)j * 4 * 1024 * 256, 4096, 256, 1024, 256, 2, 512, E); } break;
        case OP_LR_S1: if (EN(OP_LR_S1)) lru_scan1(p, lds); break;
        case OP_LR_S2: if (EN(OP_LR_S2)) lru_scan2(p); break;
        case OP_LR_S3: if (EN(OP_LR_S3)) lru_scan3(p, lds); break;
        case OP_RMS2: if (EN(OP_RMS2)) phase_rms((const float*)(ws + WS_XRES), p->norm_g + ((size_t)l * 2 + 1) * 1024, MOD + (size_t)l * 2 * 6144 + 3 * 1024, MOD + (size_t)l * 2 * 6144 + 4 * 1024, (bf16_t*)(ws + WS_HBUF), ws + WS_HB8); break;
        case OP_QK: if (EN(OP_QK)) { EpiBf16 E; E.O = (bf16_t*)(ws + WS_SCORES); E.ldc = 2048;
            run_gemm(lds, (const bf16_t*)(ws + WS_HBUF), (const bf16_t*)(ws + WS_WQK) + (size_t)l * 2048 * 1024, 2048, 1024, 1024, 1024, 0, 0, E); } break;
        case OP_TOPK: if (EN(OP_TOPK)) peer_topk(p, lds); break;
        case OP_GATHER: if (EN(OP_GATHER)) peer_gather(p, l, dry); break;
        default: break;
        }
        }
    }
}

extern "C" void kernel_launch(void* const* d_in, const int* in_sizes, int n_in, void* d_out, int out_size, void* d_ws, size_t ws_size, hipStream_t stream) {
    static int grid = 0;
    if (grid == 0) {
        if (n_in != 23 || ws_size < WS_END) { fprintf(stderr, "kernel_launch: unexpected n_in %d / ws_size %zu (need %zu)\n", n_in, ws_size, (size_t)WS_END); grid = -1; return; }
        int dev = 0, cus = 0, per_cu = 0;
        hipGetDevice(&dev); hipDeviceGetAttribute(&cus, hipDeviceAttributeMultiprocessorCount, dev);
        if (hipFuncSetAttribute((const void*)mk_fwd, hipFuncAttributeMaxDynamicSharedMemorySize, LDS_BYTES) != hipSuccess) { fprintf(stderr, "kernel_launch: hipFuncSetAttribute failed\n"); grid = -1; return; }
        if (hipOccupancyMaxActiveBlocksPerMultiprocessor(&per_cu, (const void*)mk_fwd, NTHR, LDS_BYTES) != hipSuccess || per_cu < 1) { fprintf(stderr, "kernel_launch: occupancy query failed (%d)\n", per_cu); (void)hipGetLastError(); per_cu = 1; }
        grid = cus * 1;
        fprintf(stderr, "kernel_launch: cus %d per_cu %d grid %d\n", cus, per_cu, grid);
    }
    if (grid < 0) return;
    if (hipMemsetAsync((char*)d_ws + WS_CTL, 0, 65536, stream) != hipSuccess) { fprintf(stderr, "kernel_launch: memset failed\n"); return; }
    Params p{};
    const float** pp = (const float**)&p;
    for (int i = 0; i < 23; ++i) pp[i] = (const float*)d_in[i];
    p.out = (float*)d_out; p.ws = (unsigned char*)d_ws; p.ph_lo = 0; p.ph_hi = NPH; p.rep_mask = REP_MASK;
    void* args[] = {&p};
    hipError_t e = hipLaunchCooperativeKernel((const void*)mk_fwd, dim3(grid), dim3(NTHR), args, LDS_BYTES, stream);
    if (e != hipSuccess) fprintf(stderr, "kernel_launch: cooperative launch failed: %s (grid %d)\n", hipGetErrorString(e), grid);
}
```

```cpp
#include <hip/hip_runtime.h>
#include <hip/hip_cooperative_groups.h>
#include <cstdio>
#include <cstdint>
namespace cg = cooperative_groups;

#define LAS __attribute__((address_space(3)))
#define PG8_LAS __attribute__((address_space(3)))
typedef unsigned short bf16_t;
typedef short bf16x8 __attribute__((ext_vector_type(8)));
typedef float f32x4 __attribute__((ext_vector_type(4)));
typedef float f32x2 __attribute__((ext_vector_type(2)));
typedef unsigned u32x4 __attribute__((ext_vector_type(4)));
typedef unsigned u32x2 __attribute__((ext_vector_type(2)));
typedef int v8i __attribute__((ext_vector_type(8)));

constexpr int T = 16384, D = 1024, SEQ = 8192, DEPTH = 4;
constexpr float EPS = 1e-6f;
constexpr int NBLK = 256, NTHR = 512, NWAVE = 8, NGW = NBLK * NWAVE;

constexpr size_t MiB = 1u << 20;
constexpr size_t WS_CTL = 0;
constexpr size_t WS_MOD = 1 * MiB;
constexpr size_t WS_HGWIN = 2 * MiB;
constexpr size_t WS_HGWOUT = 22 * MiB;
constexpr size_t WS_LRWIN = 26 * MiB;
constexpr size_t WS_LRWG = 34 * MiB;
constexpr size_t WS_LRWOUT = 38 * MiB;
constexpr size_t WS_WQK = 42 * MiB;
constexpr size_t WS_TOPI = 58 * MiB;
constexpr size_t WS_TOPG = 66 * MiB;
constexpr size_t WS_DEC = 74 * MiB;
constexpr size_t WS_CP = 75 * MiB;
constexpr size_t WS_CH = 79 * MiB;
constexpr size_t WS_HIN = 83 * MiB;
constexpr size_t WS_USC = 87 * MiB;
constexpr size_t WS_VSC = 87 * MiB + 262144;
constexpr size_t WS_XRES = 88 * MiB;
constexpr size_t WS_HBUF = 152 * MiB;
constexpr size_t WS_OB = 184 * MiB;
constexpr size_t WS_PROJ = 216 * MiB;
constexpr size_t WS_XB = WS_PROJ, WS_YG = WS_PROJ + 32 * MiB, WS_XC = WS_PROJ + 64 * MiB, WS_LOGA = WS_PROJ + 96 * MiB;
constexpr size_t WS_SCORES = WS_PROJ;
constexpr size_t WS_KV = 376 * MiB;
constexpr size_t WS_BTERM = WS_KV;
constexpr size_t WS_SIN = 504 * MiB;
constexpr size_t WS_UTAB = 568 * MiB;
constexpr size_t WS_VTAB = 696 * MiB;
constexpr size_t WS_HB8 = 824 * MiB;
constexpr size_t WS_END = 840 * MiB;

constexpr int LDS_BYTES = 155648;

#define LAUNDER_IDS int tidL = threadIdx.x, bidL = blockIdx.x; asm volatile("" : "+v"(tidL)); asm volatile("" : "+s"(bidL));
__device__ __forceinline__ float bf2f(bf16_t b) { return __uint_as_float(((unsigned)b) << 16); }
__device__ __forceinline__ float bflo(unsigned u) { return __uint_as_float(u << 16); }
__device__ __forceinline__ float bfhi(unsigned u) { return __uint_as_float(u & 0xffff0000u); }
__device__ __forceinline__ unsigned cvt_pk_bf16(float lo, float hi) { unsigned r; asm volatile("v_cvt_pk_bf16_f32 %0, %1, %2" : "=v"(r) : "v"(lo), "v"(hi)); return r; }
__device__ __forceinline__ unsigned pk_bf16_rne(float lo, float hi) { unsigned a = __float_as_uint(lo), b = __float_as_uint(hi); a += 0x7fffu + ((a >> 16) & 1u); b += 0x7fffu + ((b >> 16) & 1u); return (a >> 16) | (b & 0xffff0000u); }
__device__ __forceinline__ bf16_t f2bf(float f) { return (bf16_t)(cvt_pk_bf16(f, 0.f) & 0xffffu); }
__device__ __forceinline__ float fast_exp(float x) { return __builtin_amdgcn_exp2f(x * 1.4426950408889634f); }
__device__ __forceinline__ float fast_log(float x) { return __builtin_amdgcn_logf(x) * 0.6931471805599453f; }
__device__ __forceinline__ float fast_rcp(float x) { return __builtin_amdgcn_rcpf(x); }
__device__ __forceinline__ float sigmoidf_(float x) { return fast_rcp(1.f + fast_exp(-x)); }
__device__ __forceinline__ float gelu_tanh(float x) { const float u = 1.5957691216057308f * (x + 0.044715f * x * x * x); return x * fast_rcp(1.f + fast_exp(-u)); }
__device__ __forceinline__ float silu_(float x) { return x * sigmoidf_(x); }
__device__ __forceinline__ float wave_sum(float v) {
#pragma unroll
    for (int o = 1; o < 64; o <<= 1) v += __shfl_xor(v, o);
    return v;
}
__device__ __forceinline__ float wave_max(float v) {
#pragma unroll
    for (int o = 1; o < 64; o <<= 1) v = fmaxf(v, __shfl_xor(v, o));
    return v;
}

namespace pg8 {
constexpr int BM = 256, BK = 64, HALF = 128, HTB = HALF * BK * 2, STAGE_BYTES = 8 * HTB, NXCD = 8, WGM = 8;
__host__ __device__ __forceinline__ int lds_byte(int r, int c) { const int st = (r >> 4) * 2 + (c >> 5), rr = r & 15, cc = c & 31, ob = rr * 64 + cc * 2; return st * 1024 + (ob ^ (((ob >> 9) & 1) << 5)); }
__host__ __device__ __forceinline__ void stage_rc(int b, int& R, int& C) { const int st = b / 1024, sb = b % 1024, swz = sb ^ (((sb >> 9) & 1) << 5); R = (st >> 1) * 16 + swz / 64; C = (st & 1) * 32 + (swz % 64) / 2; }
__host__ __device__ __forceinline__ int perm32(int rho) { const int n = rho >> 4, i = rho & 15; return 8 * (i >> 2) + 4 * n + (i & 3); }
struct Unit { int pm, pn; };
struct Gemm { const bf16_t* A; const bf16_t* Bt; int M, N, K, lda, ldb, a_pn_shift, a_pn_stride; };
struct StaticOrder {
    int nM, nN, nwg, G, c;
    __host__ __device__ void init(int M, int N, int G_, int c_) { nM = M / BM; nN = N / BM; nwg = nM * nN; G = G_; c = c_; }
    __host__ __device__ bool next(int i, Unit& u) const {
        const long L = (long)i * G + c; if (L >= nwg) return false;
        int wgid = (int)L; { const int q = nwg / NXCD, r = nwg % NXCD, xcd = wgid % NXCD, off = wgid / NXCD; wgid = (xcd < r ? xcd * (q + 1) : r * (q + 1) + (xcd - r) * q) + off; }
        const int nig = WGM * nN, gid = wgid / nig, fm = gid * WGM, gsz = (nM - fm) < WGM ? (nM - fm) : WGM;
        u.pm = fm + ((wgid % nig) % gsz); u.pn = (wgid % nig) / gsz; return true;
    }
    __device__ __forceinline__ void a_ready(const Unit&) const {}
    __device__ __forceinline__ void done(const Unit&) const {}
};
template <class Epi, class Sched, bool STAMP = false>
__device__ __forceinline__ void gemm_phase(PG8_LAS unsigned char* lds, const Gemm g, const Sched& S, const Epi& E, unsigned long long* stamps) {
    int tid = threadIdx.x; asm volatile("" : "+v"(tid)); const int wid = __builtin_amdgcn_readfirstlane(tid >> 6), lane = tid & 63, wr = wid >> 2, wc = wid & 3, fr = lane & 15, fq = lane >> 4;
    const int K = g.K, nt = K / BK;
    int ts_lo = 0, ts_hi = 0, nts = 0; const unsigned long long rt_entry = STAMP ? (unsigned long long)wall_clock64() : 0ull;
#define PG8_STAMP() do { if (STAMP && wid == 0 && nts < 64) { const unsigned long long _c = (unsigned long long)clock64(); \
        ts_lo = (lane == nts) ? (int)(unsigned)_c : ts_lo; ts_hi = (lane == nts) ? (int)(unsigned)(_c >> 32) : ts_hi; ++nts; } } while (0)
    PG8_STAMP();
    unsigned voffA[2], voffB[2];
#pragma unroll
    for (int i = 0; i < 2; ++i) { int R, C; stage_rc(tid * 16 + i * 8192, R, C); const int Rb = Epi::PERM ? ((R & ~31) + perm32(R & 31)) : R;
        voffA[i] = (unsigned)(R * g.lda + C) * 2u; voffB[i] = (unsigned)(Rb * g.ldb + C) * 2u; }
    const size_t kstep = (size_t)(BK * 2);
    const size_t hstepA = (size_t)HALF * g.lda * 2, hstepB = (size_t)HALF * g.ldb * 2;
    const size_t tstepA = 2 * hstepA, tstepB = 2 * hstepB;
    const unsigned ldsw = (unsigned)wid * 1024u;
    const int aoff = lds_byte(wr * 64 + fr, fq * 8), boff = lds_byte(wc * 32 + fr, fq * 8);
#define PG8_SA(b, h) (((b) * 2 + (h)) * HTB)
#define PG8_SB(b, h) ((4 + (b) * 2 + (h)) * HTB)
#define PG8_STAGE(bufoff, gbase, voff) do { _Pragma("unroll") for (int _i = 0; _i < 2; ++_i) \
        __builtin_amdgcn_global_load_lds((const unsigned*)((const char*)(gbase) + (voff)[_i]), (PG8_LAS unsigned*)(lds + (bufoff) + ldsw + _i * 8192), 16, 0, 0); } while (0)
#define PG8_LDA(dst, b, h) do { _Pragma("unroll") for (int m = 0; m < 4; ++m) _Pragma("unroll") for (int k = 0; k < 2; ++k) dst[m][k] = *(const PG8_LAS bf16x8*)(lds + PG8_SA(b, h) + aoff + m * 2048 + k * 1024); } while (0)
#define PG8_LDB(dst, b, h) do { _Pragma("unroll") for (int n = 0; n < 2; ++n) _Pragma("unroll") for (int k = 0; k < 2; ++k) dst[n][k] = *(const PG8_LAS bf16x8*)(lds + PG8_SB(b, h) + boff + n * 2048 + k * 1024); } while (0)
#define PG8_MMA(ai, bj, At, Bt) do { __builtin_amdgcn_s_setprio(1); _Pragma("unroll") for (int m = 0; m < 4; ++m) _Pragma("unroll") for (int n = 0; n < 2; ++n) _Pragma("unroll") for (int k = 0; k < 2; ++k) \
        acc[ai][bj][m][n] = Epi::SWAP ? __builtin_amdgcn_mfma_f32_16x16x32_bf16(At[m][k], Bt[n][k], acc[ai][bj][m][n], 0, 0, 0) : __builtin_amdgcn_mfma_f32_16x16x32_bf16(Bt[n][k], At[m][k], acc[ai][bj][m][n], 0, 0, 0); __builtin_amdgcn_s_setprio(0); } while (0)
#define PG8_WAIT_V(n) asm volatile("s_waitcnt vmcnt(" #n ")" ::: "memory")
#define PG8_WAIT_L(n) asm volatile("s_waitcnt lgkmcnt(" #n ")" ::: "memory")
#define PG8_BAR __builtin_amdgcn_s_barrier()
#define PG8_SCHED __builtin_amdgcn_sched_barrier(0)
    Unit cur, nxt; int ui = 0;
    if (!S.next(0, cur)) return;
    f32x4 acc[2][2][4][2];
#pragma unroll
    for (int a = 0; a < 2; ++a)
#pragma unroll
        for (int b = 0; b < 2; ++b)
#pragma unroll
            for (int m = 0; m < 4; ++m)
#pragma unroll
                for (int n = 0; n < 2; ++n) acc[a][b][m][n] = (f32x4){0.f, 0.f, 0.f, 0.f};
    bf16x8 At[4][2], B0[2][2], B1[2][2];
    const char* cA = (const char*)g.A + (size_t)cur.pm * tstepA + (size_t)(cur.pn >> g.a_pn_shift) * g.a_pn_stride; const char* cB = (const char*)g.Bt + (size_t)cur.pn * tstepB;
    S.a_ready(cur);
    PG8_STAGE(PG8_SB(0, 0), cB, voffB); PG8_STAGE(PG8_SA(0, 0), cA, voffA); PG8_STAGE(PG8_SB(0, 1), cB + hstepB, voffB); PG8_STAGE(PG8_SA(0, 1), cA + hstepA, voffA);
    if (wr == 1) PG8_BAR;
    PG8_WAIT_V(4); PG8_BAR;
    PG8_STAGE(PG8_SB(1, 0), cB + kstep, voffB); PG8_STAGE(PG8_SA(1, 0), cA + kstep, voffA); PG8_STAGE(PG8_SB(1, 1), cB + hstepB + kstep, voffB);
    PG8_WAIT_V(6); PG8_BAR;
    PG8_STAMP();
    for (;;) {
        const bool has_next = S.next(ui + 1, nxt);
        const char* nA = has_next ? (const char*)g.A + (size_t)nxt.pm * tstepA + (size_t)(nxt.pn >> g.a_pn_shift) * g.a_pn_stride : cA; const char* nB = has_next ? (const char*)g.Bt + (size_t)nxt.pn * tstepB : cB;
#pragma unroll 1
        for (int t = 0; t < nt; t += 2) {
            const bool last = (t == nt - 2);
            const char* a1 = cA + (size_t)(t + 1) * kstep;
            const char* a2 = last ? nA : cA + (size_t)(t + 2) * kstep; const char* b2 = last ? nB : cB + (size_t)(t + 2) * kstep;
            const char* a3 = a2 + kstep; const char* b3 = b2 + kstep;
            if (last && has_next) S.a_ready(nxt);
            PG8_LDB(B0, 0, 0); PG8_SCHED; PG8_LDA(At, 0, 0); PG8_STAGE(PG8_SA(1, 1), a1 + hstepA, voffA);
            PG8_WAIT_L(8); PG8_BAR; PG8_WAIT_L(0); PG8_MMA(0, 0, At, B0); PG8_BAR; PG8_SCHED;
            PG8_LDB(B1, 0, 1); PG8_STAGE(PG8_SB(0, 0), b2, voffB);
            PG8_BAR; PG8_WAIT_L(0); PG8_MMA(0, 1, At, B1); PG8_BAR;
            PG8_LDA(At, 0, 1); PG8_STAGE(PG8_SA(0, 0), a2, voffA);
            PG8_BAR; PG8_WAIT_L(0); PG8_MMA(1, 0, At, B0); PG8_BAR; PG8_SCHED;
            PG8_STAGE(PG8_SB(0, 1), b2 + hstepB, voffB);
            PG8_WAIT_V(6); PG8_BAR; PG8_MMA(1, 1, At, B1); PG8_BAR;
            PG8_LDB(B0, 1, 0); PG8_SCHED; PG8_LDA(At, 1, 0); PG8_STAGE(PG8_SA(0, 1), a2 + hstepA, voffA);
            PG8_WAIT_L(8); PG8_BAR; PG8_WAIT_L(0); PG8_MMA(0, 0, At, B0); PG8_BAR; PG8_SCHED;
            PG8_LDB(B1, 1, 1); PG8_STAGE(PG8_SB(1, 0), b3, voffB);
            PG8_BAR; PG8_WAIT_L(0); PG8_MMA(0, 1, At, B1); PG8_BAR;
            PG8_LDA(At, 1, 1); PG8_STAGE(PG8_SA(1, 0), a3, voffA);
            PG8_BAR; PG8_WAIT_L(0); PG8_MMA(1, 0, At, B0); PG8_BAR; PG8_SCHED;
            PG8_STAGE(PG8_SB(1, 1), b3 + hstepB, voffB);
            PG8_WAIT_V(6); PG8_BAR; PG8_MMA(1, 1, At, B1); PG8_BAR;
        }
        PG8_STAMP();
        if constexpr (!Epi::AFTER_DRAIN) { E(acc, cur, wr, wc, fr, fq); S.done(cur); }
        PG8_STAMP();
        if (!has_next) break;
#pragma unroll
        for (int a = 0; a < 2; ++a)
#pragma unroll
            for (int b = 0; b < 2; ++b)
#pragma unroll
                for (int m = 0; m < 4; ++m)
#pragma unroll
                    for (int n = 0; n < 2; ++n) acc[a][b][m][n] = (f32x4){0.f, 0.f, 0.f, 0.f};
        cur = nxt; cA = nA; cB = nB; ++ui;
    }
    PG8_WAIT_V(0);
    if (wr == 0) PG8_BAR;
    PG8_BAR;
    if constexpr (Epi::AFTER_DRAIN) { E.fused(acc, cur, wr, wc, fr, fq, lds, wid, lane); S.done(cur); }
    PG8_STAMP();
    if (STAMP && wid == 0) { stamps[lane] = lane < nts ? (((unsigned long long)(unsigned)ts_hi << 32) | (unsigned)ts_lo) : 0ull;
        if (lane == 62) stamps[62] = rt_entry; if (lane == 63) stamps[63] = (unsigned long long)wall_clock64(); }
#undef PG8_STAMP
#undef PG8_SA
#undef PG8_SB
#undef PG8_STAGE
#undef PG8_LDA
#undef PG8_LDB
#undef PG8_MMA
#undef PG8_WAIT_V
#undef PG8_WAIT_L
#undef PG8_BAR
#undef PG8_SCHED
}
}
using pg8::Unit;

struct EpiBf16 {
    static constexpr bool PERM = true, AFTER_DRAIN = false, SWAP = false;
    bf16_t* O; int ldc;
    __device__ __forceinline__ void operator()(const f32x4 (&acc)[2][2][4][2], const Unit& u, int wr, int wc, int fr, int fq) const {
        const int row0 = u.pm * 256 + wr * 64 + fr, col0 = u.pn * 256 + wc * 32 + 8 * fq;
#pragma unroll
        for (int ai = 0; ai < 2; ++ai)
#pragma unroll
            for (int m = 0; m < 4; ++m) { bf16_t* rowp = O + (size_t)(row0 + ai * 128 + m * 16) * ldc + col0;
#pragma unroll
                for (int bj = 0; bj < 2; ++bj) { const f32x4 v0 = acc[ai][bj][m][0], v1 = acc[ai][bj][m][1];
                    u32x4 o; o.x = cvt_pk_bf16(v0[0], v0[1]); o.y = cvt_pk_bf16(v0[2], v0[3]); o.z = cvt_pk_bf16(v1[0], v1[1]); o.w = cvt_pk_bf16(v1[2], v1[3]);
                    *(u32x4*)(rowp + bj * 128) = o; } }
    }
};
struct EpiLruIn {
    static constexpr bool PERM = true, AFTER_DRAIN = false, SWAP = false;
    bf16_t* XB; bf16_t* YG;
    __device__ __forceinline__ void operator()(const f32x4 (&acc)[2][2][4][2], const Unit& u, int wr, int wc, int fr, int fq) const {
        const bool isy = u.pn >= 4;
        bf16_t* O = isy ? YG : XB;
        const int row0 = u.pm * 256 + wr * 64 + fr, col0 = (u.pn & 3) * 256 + wc * 32 + 8 * fq;
#pragma unroll
        for (int ai = 0; ai < 2; ++ai)
#pragma unroll
            for (int m = 0; m < 4; ++m) { bf16_t* rowp = O + (size_t)(row0 + ai * 128 + m * 16) * 1024 + col0;
#pragma unroll
                for (int bj = 0; bj < 2; ++bj) { f32x4 v0 = acc[ai][bj][m][0], v1 = acc[ai][bj][m][1];
                    if (isy) {
#pragma unroll
                        for (int i = 0; i < 4; ++i) { v0[i] = gelu_tanh(v0[i]); v1[i] = gelu_tanh(v1[i]); } }
                    u32x4 o; o.x = cvt_pk_bf16(v0[0], v0[1]); o.y = cvt_pk_bf16(v0[2], v0[3]); o.z = cvt_pk_bf16(v1[0], v1[1]); o.w = cvt_pk_bf16(v1[2], v1[3]);
                    *(u32x4*)(rowp + bj * 128) = o; } }
    }
};
struct EpiGates {
    static constexpr bool PERM = true, AFTER_DRAIN = false, SWAP = false;
    bf16_t* LOGA; bf16_t* BTERM; const bf16_t* XC; const float* b_a; const float* b_x; const float* lam;
    __device__ __forceinline__ void operator()(const f32x4 (&acc)[2][2][4][2], const Unit& u, int wr, int wc, int fr_, int fq) const {
        int fr = fr_; asm volatile("" : "+v"(fr));
        const int nblk = u.pn >> 2, uu = u.pn & 3, d = uu >> 1, jh = uu & 1;
        const int colbase = nblk * 256 + jh * 128 + wc * 32 + 8 * fq;
        const unsigned off0 = (unsigned)(u.pm * 256 + wr * 64 + fr) * 1024u + (unsigned)colbase;
        const bf16_t* xcp = XC; bf16_t* lap = LOGA + (size_t)d * T * 1024; bf16_t* btp = BTERM + (size_t)d * T * 1024;
        const float* bap = b_a + d * 1024; const float* bxp = b_x + d * 1024; const float* lmp = lam + d * 1024;
#pragma unroll
        for (int ai = 0; ai < 2; ++ai)
#pragma unroll
            for (int m = 0; m < 4; ++m) { const unsigned off = off0 + (unsigned)(ai * 128 + m * 16) * 1024u;
                asm volatile("" ::: "memory"); __builtin_amdgcn_sched_barrier(0);
                const u32x4 xr = *(const u32x4*)(xcp + off);
                const float xv[8] = {bflo(xr.x), bfhi(xr.x), bflo(xr.y), bfhi(xr.y), bflo(xr.z), bfhi(xr.z), bflo(xr.w), bfhi(xr.w)};
                unsigned o1[4], o2[4];
#pragma unroll
                for (int n = 0; n < 2; ++n) { const f32x4 ba = *(const f32x4*)(bap + (unsigned)(colbase + 4 * n)), bx = *(const f32x4*)(bxp + (unsigned)(colbase + 4 * n)), lm = *(const f32x4*)(lmp + (unsigned)(colbase + 4 * n));
                    float la[4], bt[4];
#pragma unroll
                    for (int i = 0; i < 4; ++i) { const float r = sigmoidf_(acc[ai][0][m][n][i] + ba[i]), ig = sigmoidf_(acc[ai][1][m][n][i] + bx[i]);
                        const float l = -8.f * fast_log(1.f + fast_exp(-lm[i])) * r; const float mult = __builtin_sqrtf(fmaxf(1.f - fast_exp(2.f * l), 0.f));
                        la[i] = l; bt[i] = mult * ig * xv[n * 4 + i]; }
                    o1[n * 2] = cvt_pk_bf16(la[0], la[1]); o1[n * 2 + 1] = cvt_pk_bf16(la[2], la[3]); o2[n * 2] = cvt_pk_bf16(bt[0], bt[1]); o2[n * 2 + 1] = cvt_pk_bf16(bt[2], bt[3]); }
                *(u32x4*)(lap + off) = (u32x4){o1[0], o1[1], o1[2], o1[3]}; *(u32x4*)(btp + off) = (u32x4){o2[0], o2[1], o2[2], o2[3]}; }
    }
};
struct EpiResid {
    static constexpr bool PERM = false, AFTER_DRAIN = false, SWAP = false;
    const float* xin32; const bf16_t* xin16; bf16_t* xout; const float* gate; bool dry;
    __device__ __forceinline__ void operator()(const f32x4 (&acc)[2][2][4][2], const Unit& u, int wr, int wc, int fr, int fq) const {
        const int row0 = u.pm * 256 + wr * 64 + fr, col0 = u.pn * 256 + wc * 32 + 4 * fq;
        const float* gp = gate + ((u.pm * 256) >> 13) * 6144 + col0;
        f32x4 gv[2][2];
#pragma unroll
        for (int bj = 0; bj < 2; ++bj)
#pragma unroll
            for (int n = 0; n < 2; ++n) gv[bj][n] = *(const f32x4*)(gp + bj * 128 + n * 16);
#pragma unroll
        for (int ai = 0; ai < 2; ++ai)
#pragma unroll
            for (int m = 0; m < 4; ++m) { const size_t off = (size_t)(row0 + ai * 128 + m * 16) * 1024 + col0;
#pragma unroll
                for (int bj = 0; bj < 2; ++bj)
#pragma unroll
                    for (int n = 0; n < 2; ++n) { f32x4 xv;
                        if (xin32) xv = *(const f32x4*)(xin32 + off + bj * 128 + n * 16);
                        else { const u32x2 r = *(const u32x2*)(xin16 + off + bj * 128 + n * 16); xv = (f32x4){bflo(r.x), bfhi(r.x), bflo(r.y), bfhi(r.y)}; }
                        const f32x4 y = xv + gv[bj][n] * acc[ai][bj][m][n];
                        if (!dry) *(u32x2*)(xout + off + bj * 128 + n * 16) = (u32x2){cvt_pk_bf16(y[0], y[1]), cvt_pk_bf16(y[2], y[3])}; } }
    }
};
struct EpiF32 {
    static constexpr bool PERM = false, AFTER_DRAIN = false, SWAP = false;
    float* C; int ldc;
    __device__ __forceinline__ void operator()(const f32x4 (&acc)[2][2][4][2], const Unit& u, int wr, int wc, int fr_, int fq) const {
        int fr = fr_; asm volatile("" : "+v"(fr));
        const int row0 = u.pm * 256 + wr * 64 + fr, col0 = u.pn * 256 + wc * 32 + 4 * fq;
#pragma unroll
        for (int ai = 0; ai < 2; ++ai)
#pragma unroll
            for (int m = 0; m < 4; ++m) { float* rowp = C + (size_t)(row0 + ai * 128 + m * 16) * ldc + col0;
#pragma unroll
                for (int bj = 0; bj < 2; ++bj)
#pragma unroll
                    for (int n = 0; n < 2; ++n) *(f32x4*)(rowp + bj * 128 + n * 16) = acc[ai][bj][m][n]; }
    }
};

struct Params {
    const float *x, *c, *w_ada, *b_ada, *norm_g, *hg_w_in, *hg_lb, *hg_norm_g, *hg_w_out, *lru_w_in, *lru_conv_w, *lru_conv_b,
        *lru_w_a, *lru_b_a, *lru_w_x, *lru_b_x, *lru_lam, *lru_w_out, *peer_w_q, *peer_keys, *peer_u, *peer_v, *final_g;
    float* out; unsigned char* ws; int ph_lo, ph_hi; unsigned rep_mask; int pad_;
};

typedef const __attribute__((address_space(4))) Params* KP;

template <class Epi>
__device__ __forceinline__ void run_gemm(LAS unsigned char* lds, const bf16_t* A, const bf16_t* Bt, int N, int K, int lda, int ldb, int a_pn_shift, int a_pn_stride, const Epi& E) {
    pg8::Gemm g; g.A = A; g.Bt = Bt; g.M = T; g.N = N; g.K = K; g.lda = lda; g.ldb = ldb; g.a_pn_shift = a_pn_shift; g.a_pn_stride = a_pn_stride;
    LAUNDER_IDS
    pg8::StaticOrder S; S.init(T, N, (int)gridDim.x, bidL); (void)tidL;
    pg8::gemm_phase<Epi, pg8::StaticOrder, false>(lds, g, S, E, nullptr);
    __syncthreads();
}

__device__ __forceinline__ void transpose_tile(const float* __restrict__ src, int ld_src, bf16_t* dst, int ld_dst, LAS float* tile, int tid) {
#pragma unroll
    for (int it = 0; it < 2; ++it) { const int r = (tid >> 4) + 32 * it, c4 = (tid & 15) * 4;
        const f32x4 v = *(const f32x4*)(src + (size_t)r * ld_src + c4);
        tile[r * 65 + c4 + 0] = v[0]; tile[r * 65 + c4 + 1] = v[1]; tile[r * 65 + c4 + 2] = v[2]; tile[r * 65 + c4 + 3] = v[3]; }
    __syncthreads();
    { const int n = tid >> 3, kc = tid & 7; const LAS float* s = tile + (kc * 8) * 65 + n;
        u32x4 o; o.x = cvt_pk_bf16(s[0], s[65]); o.y = cvt_pk_bf16(s[2 * 65], s[3 * 65]); o.z = cvt_pk_bf16(s[4 * 65], s[5 * 65]); o.w = cvt_pk_bf16(s[6 * 65], s[7 * 65]);
        *(u32x4*)(dst + (size_t)n * ld_dst + kc * 8) = o; }
    __syncthreads();
}

__device__ __forceinline__ void phase0(KP p, LAS unsigned char* lds) {
    LAUNDER_IDS
    const int tid = tidL, wave = tid >> 6, lane = tid & 63;
    unsigned char* ws = p->ws;
    LAS float* tile = (LAS float*)lds;
    constexpr int I_HGIN = 16 * 80, I_SQ = 16 * 16, I_LRIN = 16 * 32, I_G = 16;
    constexpr int N_A = 2 * I_HGIN + 2 * I_SQ + 2 * I_LRIN + 2 * I_SQ + 32 * I_G;
    for (int it = bidL; it < N_A; it += gridDim.x) {
        int r = it;
        if (r < 2 * I_HGIN) { const int j = r / I_HGIN, q = r % I_HGIN, kb = q / 80, nb = q % 80;
            transpose_tile(p->hg_w_in + (size_t)j * 1024 * 5120 + (size_t)kb * 64 * 5120 + nb * 64, 5120, (bf16_t*)(ws + WS_HGWIN) + (size_t)j * 5120 * 1024 + (size_t)nb * 64 * 1024 + kb * 64, 1024, tile, tid); continue; }
        r -= 2 * I_HGIN;
        if (r < 2 * I_SQ) { const int j = r / I_SQ, q = r % I_SQ, kb = q / 16, nb = q % 16;
            transpose_tile(p->hg_w_out + (size_t)j * 1024 * 1024 + (size_t)kb * 64 * 1024 + nb * 64, 1024, (bf16_t*)(ws + WS_HGWOUT) + (size_t)j * 1024 * 1024 + (size_t)nb * 64 * 1024 + kb * 64, 1024, tile, tid); continue; }
        r -= 2 * I_SQ;
        if (r < 2 * I_LRIN) { const int j = r / I_LRIN, q = r % I_LRIN, kb = q / 32, nb = q % 32;
            transpose_tile(p->lru_w_in + (size_t)j * 1024 * 2048 + (size_t)kb * 64 * 2048 + nb * 64, 2048, (bf16_t*)(ws + WS_LRWIN) + (size_t)j * 2048 * 1024 + (size_t)nb * 64 * 1024 + kb * 64, 1024, tile, tid); continue; }
        r -= 2 * I_LRIN;
        if (r < 2 * I_SQ) { const int j = r / I_SQ, q = r % I_SQ, kb = q / 16, nb = q % 16;
            transpose_tile(p->lru_w_out + (size_t)j * 1024 * 1024 + (size_t)kb * 64 * 1024 + nb * 64, 1024, (bf16_t*)(ws + WS_LRWOUT) + (size_t)j * 1024 * 1024 + (size_t)nb * 64 * 1024 + kb * 64, 1024, tile, tid); continue; }
        r -= 2 * I_SQ;
        { const int mat = r / I_G, q = r % I_G, kb = q / 4, nb = q % 4;
            const int nblk = mat & 3, gate = (mat >> 2) & 1, d = (mat >> 3) & 1, l = mat >> 4;
            const float* src = (gate ? p->lru_w_x : p->lru_w_a) + (size_t)((l * 2 + d) * 4 + nblk) * 65536 + (size_t)kb * 64 * 256 + nb * 64;
            const int n0 = nb * 64, jh = n0 >> 7;
            bf16_t* dst = (bf16_t*)(ws + WS_LRWG) + (size_t)l * 4 * 1024 * 256 + (size_t)nblk * 1024 * 256 + (size_t)((d * 2 + jh) * 256 + gate * 128 + (n0 & 127)) * 256 + kb * 64;
            transpose_tile(src, 256, dst, 256, tile, tid); }
    }
    {
        LAS bf16_t* KA = (LAS bf16_t*)lds;
        LAS bf16_t* WB = (LAS bf16_t*)(lds + 128 * 136 * 2);
        const int l15 = lane & 15, lq = lane >> 4;
        for (int it = bidL; it < 1024; it += gridDim.x) {
            const int l = it >> 8, hp = (it >> 4) & 15, dt = it & 15;
            const float* kp = p->peer_keys + ((size_t)l * 16 + hp) * 16384;
            const float* wp = p->peer_w_q + (size_t)l * 1024 * 2048 + (size_t)(dt * 64) * 2048 + hp * 128;
            f32x4 kv[8], wv[4];
#pragma unroll
            for (int q = 0; q < 8; ++q) kv[q] = *(const f32x4*)(kp + (tid + 512 * q) * 4);
#pragma unroll
            for (int q = 0; q < 4; ++q) { const int e = (tid + 512 * q) * 4; wv[q] = *(const f32x4*)(wp + (size_t)(e >> 7) * 2048 + (e & 127)); }
#pragma unroll
            for (int q = 0; q < 8; ++q) { const int e = (tid + 512 * q) * 4; *(LAS u32x2*)(KA + (e >> 7) * 136 + (e & 127)) = (u32x2){cvt_pk_bf16(kv[q][0], kv[q][1]), cvt_pk_bf16(kv[q][2], kv[q][3])}; }
#pragma unroll
            for (int q = 0; q < 4; ++q) { const int e = (tid + 512 * q) * 4; *(LAS u32x2*)(WB + (e >> 7) * 136 + (e & 127)) = (u32x2){cvt_pk_bf16(wv[q][0], wv[q][1]), cvt_pk_bf16(wv[q][2], wv[q][3])}; }
            __syncthreads();
            const int rt = wave & 3, ct0 = (wave >> 2) * 4;
            f32x4 acc[4];
#pragma unroll
            for (int c = 0; c < 4; ++c) acc[c] = (f32x4){0.f, 0.f, 0.f, 0.f};
#pragma unroll
            for (int ks = 0; ks < 4; ++ks) { const bf16x8 av = *(const LAS bf16x8*)(WB + (rt * 16 + l15) * 136 + ks * 32 + lq * 8);
#pragma unroll
                for (int c = 0; c < 4; ++c) { const bf16x8 bv = *(const LAS bf16x8*)(KA + ((ct0 + c) * 16 + l15) * 136 + ks * 32 + lq * 8);
                    acc[c] = __builtin_amdgcn_mfma_f32_16x16x32_bf16(av, bv, acc[c], 0, 0, 0); } }
#pragma unroll
            for (int c = 0; c < 4; ++c) { bf16_t* op = (bf16_t*)(ws + WS_WQK) + (size_t)l * 2048 * 1024 + (size_t)(hp * 128 + (ct0 + c) * 16 + l15) * 1024 + dt * 64 + rt * 16 + lq * 4;
                *(u32x2*)op = (u32x2){pk_bf16_rne(acc[c][0], acc[c][1]), pk_bf16_rne(acc[c][2], acc[c][3])}; }
            __syncthreads();
        }
    }
    {
        LAS float* condL = (LAS float*)lds;
        LAS float* red = (LAS float*)(lds + 8192);
        for (int i = tid; i < 2048; i += NTHR) condL[i] = silu_(p->c[i]);
        __syncthreads();
        for (int it = bidL; it < 4 * 48; it += gridDim.x) {
            const int l = it / 48, col0 = (it % 48) * 128;
            const float* wp = p->w_ada + (size_t)l * 1024 * 6144 + col0 + 2 * lane;
            float a00 = 0.f, a01 = 0.f, a10 = 0.f, a11 = 0.f;
#pragma unroll 8
            for (int kk = 0; kk < 128; ++kk) { const int k = wave * 128 + kk; const f32x2 w = *(const f32x2*)(wp + (size_t)k * 6144);
                const float c0 = condL[k], c1 = condL[1024 + k];
                a00 += c0 * w[0]; a01 += c0 * w[1]; a10 += c1 * w[0]; a11 += c1 * w[1]; }
            red[(wave * 2 + 0) * 128 + 2 * lane] = a00; red[(wave * 2 + 0) * 128 + 2 * lane + 1] = a01;
            red[(wave * 2 + 1) * 128 + 2 * lane] = a10; red[(wave * 2 + 1) * 128 + 2 * lane + 1] = a11;
            __syncthreads();
            if (tid < 256) { const int b = tid >> 7, cc = tid & 127; float s = 0.f;
#pragma unroll
                for (int w = 0; w < 8; ++w) s += red[(w * 2 + b) * 128 + cc];
                ((float*)(ws + WS_MOD))[((size_t)l * 2 + b) * 6144 + col0 + cc] = s + p->b_ada[(size_t)l * 6144 + col0 + cc]; }
            __syncthreads();
        }
    }
    {
        const int nw = gridDim.x * NWAVE;
        for (int row0 = bidL * NWAVE + wave; row0 < 2 * 65536; row0 += 4 * nw) {
            f32x4 v[4][4];
#pragma unroll
            for (int rr = 0; rr < 4; ++rr) { const int row = row0 + rr * nw; const int tb = row >> 16, r = row & 65535;
                const float* src = (tb ? p->peer_v : p->peer_u) + (size_t)r * 1024 + 4 * lane;
#pragma unroll
                for (int jx = 0; jx < 4; ++jx) v[rr][jx] = __builtin_nontemporal_load((const f32x4*)(src + 256 * jx)); }
#pragma unroll
            for (int rr = 0; rr < 4; ++rr) { const int row = row0 + rr * nw; const int tb = row >> 16, r = row & 65535;
                float am = 0.f;
#pragma unroll
                for (int jx = 0; jx < 4; ++jx) am = fmaxf(am, fmaxf(fmaxf(fabsf(v[rr][jx][0]), fabsf(v[rr][jx][1])), fmaxf(fabsf(v[rr][jx][2]), fabsf(v[rr][jx][3]))));
                am = wave_max(am);
                const float sc = am > 0.f ? am * (1.f / 6.f) : 1.f, inv = am > 0.f ? 6.f / am : 1.f;
                unsigned char* dst = ws + (tb ? WS_VTAB : WS_UTAB) + (size_t)r * 512 + 2 * lane;
#pragma unroll
                for (int jx = 0; jx < 4; ++jx) { unsigned w = __builtin_amdgcn_cvt_scalef32_pk_fp4_f32(0u, v[rr][jx][0] * inv, v[rr][jx][1] * inv, 1.0f, 0);
                    w = __builtin_amdgcn_cvt_scalef32_pk_fp4_f32(w, v[rr][jx][2] * inv, v[rr][jx][3] * inv, 1.0f, 1);
                    *(unsigned short*)(dst + 128 * jx) = (unsigned short)(w & 0xffffu); }
                if (lane == 0) ((float*)(ws + (tb ? WS_VSC : WS_USC)))[r] = sc; }
        }
    }
}

__device__ __forceinline__ void phase_rms(const float* xin, const bf16_t* xin16, const float* gain, const float* shift, const float* scale, bf16_t* hout, unsigned char* h8out) {
    LAUNDER_IDS
    const int tid = tidL, wave = tid >> 6, lane = tid & 63;
    const int nw = gridDim.x * NWAVE;
    for (int row0 = bidL * NWAVE + wave; row0 < T; row0 += 2 * nw) {
        f32x4 v[2][4]; float ss[2];
#pragma unroll
        for (int rr = 0; rr < 2; ++rr) { const int row = min(row0 + rr * nw, T - 1);
            if (xin) { const float* xr = xin + (size_t)row * 1024 + lane * 4;
#pragma unroll
                for (int j = 0; j < 4; ++j) v[rr][j] = *(const f32x4*)(xr + j * 256); }
            else { const bf16_t* xr = xin16 + (size_t)row * 1024 + lane * 4;
#pragma unroll
                for (int j = 0; j < 4; ++j) { const u32x2 r = *(const u32x2*)(xr + j * 256); v[rr][j] = (f32x4){bflo(r.x), bfhi(r.x), bflo(r.y), bfhi(r.y)}; } } }
#pragma unroll
        for (int rr = 0; rr < 2; ++rr) { float a = 0.f;
#pragma unroll
            for (int j = 0; j < 4; ++j) a += v[rr][j][0] * v[rr][j][0] + v[rr][j][1] * v[rr][j][1] + v[rr][j][2] * v[rr][j][2] + v[rr][j][3] * v[rr][j][3];
            ss[rr] = a; }
#pragma unroll
        for (int o = 1; o < 64; o <<= 1) { ss[0] += __shfl_xor(ss[0], o); ss[1] += __shfl_xor(ss[1], o); }
#pragma unroll
        for (int rr = 0; rr < 2; ++rr) { const int row = row0 + rr * nw; if (row >= T) continue; const int b = row >> 13;
            const float inv = __builtin_amdgcn_rsqf(ss[rr] * (1.f / 1024.f) + EPS);
#pragma unroll
            for (int j = 0; j < 4; ++j) { const int col = j * 256 + lane * 4;
                const f32x4 g = *(const f32x4*)(gain + col), sh = *(const f32x4*)(shift + b * 6144 + col), sc = *(const f32x4*)(scale + b * 6144 + col);
                const f32x4 y = (v[rr][j] * inv) * g * (1.f + sc) + sh;
                u32x2 o; o.x = cvt_pk_bf16(y[0], y[1]); o.y = cvt_pk_bf16(y[2], y[3]);
                *(u32x2*)(hout + (size_t)row * 1024 + col) = o;
                if (h8out) { int w8 = __builtin_amdgcn_cvt_pk_fp8_f32(y[0], y[1], 0, false); w8 = __builtin_amdgcn_cvt_pk_fp8_f32(y[2], y[3], w8, true); *(int*)(h8out + (size_t)row * 1024 + col) = w8; } } }
    }
}

constexpr int LROW = 136;
__device__ __forceinline__ float hg_lower_bound(const float* hg_lb, int j, int col) {
    if (j == 0) return 0.f;
    const float l0 = hg_lb[col], l1 = hg_lb[1024 + col];
    return fast_rcp(1.f + fast_exp(l0 - l1));
}
__device__ __forceinline__ f32x4 mfma16(bf16x8 a, bf16x8 b, f32x4 c) { return __builtin_amdgcn_mfma_f32_16x16x32_bf16(a, b, c, 0, 0, 0); }

__device__ __forceinline__ void load_v_regs(const bf16_t* proj, u32x4 (&vr)[4], int t0, int dir, int h, int tid) {
#pragma unroll
    for (int it = 0; it < 4; ++it) { const int idx = tid + 512 * it, tau = idx & 127, cv = idx >> 7;
        const int tok = dir ? t0 + 127 - tau : t0 + tau;
        vr[it] = *(const u32x4*)(proj + (size_t)tok * 5120 + 3072 + h * 128 + cv * 8); }
}
__device__ __forceinline__ void store_vt(LAS bf16_t* VT, const u32x4 (&vr)[4], int tid) {
#pragma unroll
    for (int it = 0; it < 4; ++it) { const int idx = tid + 512 * it, tau = idx & 127, cv = idx >> 7; const u32x4 v = vr[it];
        LAS bf16_t* d = VT + (cv * 8) * LROW + tau;
        d[0 * LROW] = (bf16_t)(v.x & 0xffff); d[1 * LROW] = (bf16_t)(v.x >> 16); d[2 * LROW] = (bf16_t)(v.y & 0xffff); d[3 * LROW] = (bf16_t)(v.y >> 16);
        d[4 * LROW] = (bf16_t)(v.z & 0xffff); d[5 * LROW] = (bf16_t)(v.z >> 16); d[6 * LROW] = (bf16_t)(v.w & 0xffff); d[7 * LROW] = (bf16_t)(v.w >> 16); }
}
__device__ __forceinline__ void load_tile_regs(const bf16_t* proj, u32x4 (&r)[4], int t0, int dir, int col0, int tid) {
#pragma unroll
    for (int it = 0; it < 4; ++it) { const int idx = tid + 512 * it, tau = idx >> 4, c16 = idx & 15;
        const int tok = dir ? t0 + 127 - tau : t0 + tau;
        r[it] = *(const u32x4*)(proj + (size_t)tok * 5120 + col0 + c16 * 8); }
}
__device__ __forceinline__ void store_tile(LAS bf16_t* TL, const u32x4 (&r)[4], int tid) {
#pragma unroll
    for (int it = 0; it < 4; ++it) { const int idx = tid + 512 * it, tau = idx >> 4, c16 = idx & 15; *(LAS u32x4*)(TL + tau * LROW + c16 * 8) = r[it]; }
}

__device__ __forceinline__ void hg_pass_a(KP p, LAS unsigned char* lds, int j) {
    LAUNDER_IDS
    const bf16_t* proj = (const bf16_t*)(p->ws + WS_PROJ);
    bf16_t* KVh = (bf16_t*)(p->ws + WS_KV); float* DEC = (float*)(p->ws + WS_DEC);
    LAS bf16_t* VT = (LAS bf16_t*)lds; LAS bf16_t* KT = (LAS bf16_t*)(lds + 34816); LAS float* TOT = (LAS float*)(lds + 69632); LAS bf16_t* ZT = (LAS bf16_t*)(lds + 71680);
    for (int u = bidL; u < 2048; u += gridDim.x) {
        int tid = tidL; asm volatile("" : "+v"(tid));
        const int wave = tid >> 6, lane = tid & 63;
        const int seq = u >> 6, c = u & 63, dir = seq & 1, h = (seq >> 1) & 7, b = seq >> 4;
        const int t0 = b * SEQ + c * 128;
        const int dk = tid & 127, g = tid >> 7;
        const float lb = hg_lower_bound(p->hg_lb, j, h * 128 + dk);
        float lcs[32], kks[32]; float lc = 0.f;
        { u32x4 zr[4], vr[4];
            load_tile_regs(proj, zr, t0, dir, 1024 * (1 + dir) + h * 128, tid); load_v_regs(proj, vr, t0, dir, h, tid);
            store_tile(ZT, zr, tid); store_vt(VT, vr, tid); }
        __syncthreads();
#pragma unroll
        for (int q = 0; q < 32; ++q) { const int tau = 32 * g + q;
            const float z = bf2f(ZT[tau * LROW + dk]);
            const float f = lb + (1.f - lb) * sigmoidf_(z);
            lc += fast_log(f); lcs[q] = lc; kks[q] = 1.f - f; }
        TOT[g * 128 + dk] = lc;
        __syncthreads();
        float rg = 0.f, total = 0.f;
#pragma unroll
        for (int gg = 0; gg < 4; ++gg) { const float tv = TOT[gg * 128 + dk]; total += tv; if (gg < g) rg += tv; }
        const float base = total - rg;
#pragma unroll
        for (int q8 = 0; q8 < 4; ++q8) { unsigned w[4];
#pragma unroll
            for (int e = 0; e < 4; ++e) { const int q = q8 * 8 + e * 2;
                w[e] = cvt_pk_bf16(kks[q] * fast_exp(base - lcs[q]), kks[q + 1] * fast_exp(base - lcs[q + 1])); }
            u32x4 o; o.x = w[0]; o.y = w[1]; o.z = w[2]; o.w = w[3];
            *(LAS u32x4*)(KT + dk * LROW + 32 * g + q8 * 8) = o; }
        if (g == 0) DEC[(size_t)u * 128 + dk] = fast_exp(total);
        __syncthreads();
        f32x4 acc[2][4];
#pragma unroll
        for (int a = 0; a < 2; ++a)
#pragma unroll
            for (int bb = 0; bb < 4; ++bb) acc[a][bb] = (f32x4){0.f, 0.f, 0.f, 0.f};
        const int l15 = lane & 15, lq = lane >> 4;
#pragma unroll
        for (int ks = 0; ks < 4; ++ks) {
            bf16x8 af[2], bfr[4];
#pragma unroll
            for (int a = 0; a < 2; ++a) af[a] = *(const LAS bf16x8*)(VT + (((wave & 3) * 2 + a) * 16 + l15) * LROW + ks * 32 + lq * 8);
#pragma unroll
            for (int bb = 0; bb < 4; ++bb) bfr[bb] = *(const LAS bf16x8*)(KT + (((wave >> 2) * 4 + bb) * 16 + l15) * LROW + ks * 32 + lq * 8);
#pragma unroll
            for (int a = 0; a < 2; ++a)
#pragma unroll
                for (int bb = 0; bb < 4; ++bb) acc[a][bb] = mfma16(bfr[bb], af[a], acc[a][bb]);
        }
        bf16_t* kvp = KVh + (size_t)u * 16384;
#pragma unroll
        for (int a = 0; a < 2; ++a)
#pragma unroll
            for (int bb = 0; bb < 4; ++bb) *(u32x2*)(kvp + (((wave & 3) * 2 + a) * 16 + l15) * 128 + ((wave >> 2) * 4 + bb) * 16 + lq * 4) = (u32x2){pk_bf16_rne(acc[a][bb][0], acc[a][bb][1]), pk_bf16_rne(acc[a][bb][2], acc[a][bb][3])};
        __syncthreads();
    }
}

__device__ __forceinline__ void hg_pass_b(KP p) {
    LAUNDER_IDS
    const bf16_t* KVh = (const bf16_t*)(p->ws + WS_KV); const float* DEC = (const float*)(p->ws + WS_DEC);
    bf16_t* SIN = (bf16_t*)(p->ws + WS_SIN);
    for (int e = bidL * NTHR + tidL; e < 131072; e += gridDim.x * NTHR) {
    const int seq = e >> 12, i4 = e & 4095, dir = seq & 1, dk = (i4 * 4) & 127;
    f32x4 S = {0.f, 0.f, 0.f, 0.f};
#pragma unroll 16
    for (int step = 0; step < 64; ++step) {
        const int c = dir ? 63 - step : step; const size_t u = (size_t)seq * 64 + c;
        const u32x2 kvr = *(const u32x2*)(KVh + u * 16384 + i4 * 4); const f32x4 kv = (f32x4){bflo(kvr.x), bfhi(kvr.x), bflo(kvr.y), bfhi(kvr.y)}; const f32x4 dc = *(const f32x4*)(DEC + u * 128 + dk);
        u32x2 o; o.x = cvt_pk_bf16(S[0], S[1]); o.y = cvt_pk_bf16(S[2], S[3]);
        *(u32x2*)(SIN + u * 16384 + i4 * 4) = o;
        S = dc * S + kv;
    }
    }
}

__device__ __forceinline__ void hg_pass_c(KP p, LAS unsigned char* lds, int j) {
    LAUNDER_IDS
    const bf16_t* proj = (const bf16_t*)(p->ws + WS_PROJ);
    const bf16_t* SIN = (const bf16_t*)(p->ws + WS_SIN);
    bf16_t* OB = (bf16_t*)(p->ws + WS_OB);
    LAS bf16_t* QT = (LAS bf16_t*)lds; LAS bf16_t* QI = (LAS bf16_t*)(lds + 34816); LAS bf16_t* KT = (LAS bf16_t*)(lds + 69632);
    LAS bf16_t* VT = (LAS bf16_t*)(lds + 104448); LAS bf16_t* PI = (LAS bf16_t*)(lds + 139264); LAS float* TOT = (LAS float*)(lds + 147968);
    LAS float* OSUM = (LAS float*)(lds + 69632);
    for (int u = bidL; u < 1024; u += gridDim.x) {
        int tid = tidL; asm volatile("" : "+v"(tid));
        const int wave = tid >> 6, lane = tid & 63, l15 = lane & 15, lq = lane >> 4;
        const int c = u & 63, h = (u >> 6) & 7, b = u >> 9;
        const int t0 = b * SEQ + c * 128;
        const int dk = tid & 127, g = tid >> 7;
        const float lb = hg_lower_bound(p->hg_lb, j, h * 128 + dk);
        const int tt = wave & 1, dvt0 = (wave >> 1) * 2;
        f32x4 oacc[2][4][2];
#pragma unroll
        for (int dir = 0; dir < 2; ++dir) {
            const size_t su = ((size_t)((b * 8 + h) * 2 + dir) * 64 + c);
            unsigned k0p[16]; float lc = 0.f; float kprev = 0.f;
            u32x4 vr[4];
            { u32x4 zr[4], qr[4];
                load_tile_regs(proj, zr, t0, dir, 1024 * (1 + dir) + h * 128, tid); load_tile_regs(proj, qr, t0, dir, h * 128, tid); load_v_regs(proj, vr, t0, dir, h, tid);
                __syncthreads();
                store_tile(KT, zr, tid); store_tile(VT, qr, tid); }
            __syncthreads();
#pragma unroll
            for (int q = 0; q < 32; ++q) { const int tau = 32 * g + q;
                const float z = bf2f(KT[tau * LROW + dk]), qv = bf2f(VT[tau * LROW + dk]);
                const float f = lb + (1.f - lb) * sigmoidf_(z);
                lc += fast_log(f);
                const float el = fast_exp(fmaxf(lc, -80.f));
                QT[tau * LROW + dk] = f2bf(qv * el);
                const float kcur = (1.f - f) * fast_rcp(el);
                if (q & 1) k0p[q >> 1] = cvt_pk_bf16(kprev, kcur); else kprev = kcur; }
            TOT[g * 128 + dk] = lc;
            __syncthreads();
            float r[4]; { float run = 0.f;
#pragma unroll
                for (int gg = 0; gg < 4; ++gg) { r[gg] = run; run += TOT[gg * 128 + dk]; } }
            float rg = 0.f;
#pragma unroll
            for (int gg = 0; gg < 4; ++gg) if (gg == g) rg = r[gg];
            { const float eg = fast_exp(rg);
#pragma unroll
                for (int q = 0; q < 32; ++q) QI[(32 * g + q) * LROW + dk] = f2bf(bf2f(QT[(32 * g + q) * LROW + dk]) * eg); }
            store_vt(VT, vr, tid);
            bf16x8 sfr[2][4];
#pragma unroll
            for (int n = 0; n < 2; ++n)
#pragma unroll
                for (int ks = 0; ks < 4; ++ks) sfr[n][ks] = *(const bf16x8*)(SIN + su * 16384 + (size_t)((dvt0 + n) * 16 + l15) * 128 + ks * 32 + lq * 8);
#pragma unroll
            for (int i = 0; i < 4; ++i) {
                if (g <= i) { const float e = fast_exp(r[i] - rg);
#pragma unroll
                    for (int q = 0; q < 32; ++q) KT[(32 * g + q) * LROW + dk] = f2bf(((q & 1) ? bfhi(k0p[q >> 1]) : bflo(k0p[q >> 1])) * e); }
                __syncthreads();
                for (int tl = wave; tl < 4 * (i + 1); tl += 8) { const int sm = tl >> 1, tn = tl & 1;
                    f32x4 a4 = {0.f, 0.f, 0.f, 0.f};
#pragma unroll
                    for (int ks = 0; ks < 4; ++ks) { const bf16x8 af = *(const LAS bf16x8*)(KT + (sm * 16 + l15) * LROW + ks * 32 + lq * 8);
                        const bf16x8 bq = *(const LAS bf16x8*)(QT + (32 * i + tn * 16 + l15) * LROW + ks * 32 + lq * 8);
                        a4 = mfma16(af, bq, a4); }
                    const int tloc = tn * 16 + l15, s0 = sm * 16 + lq * 4, tg = 32 * i + tloc;
                    u32x2 o; o.x = cvt_pk_bf16(s0 + 0 <= tg ? a4[0] : 0.f, s0 + 1 <= tg ? a4[1] : 0.f); o.y = cvt_pk_bf16(s0 + 2 <= tg ? a4[2] : 0.f, s0 + 3 <= tg ? a4[3] : 0.f);
                    *(LAS u32x2*)(PI + tloc * LROW + s0) = o; }
                __syncthreads();
                f32x4 a0 = {0.f, 0.f, 0.f, 0.f}, a1 = {0.f, 0.f, 0.f, 0.f};
                for (int ks = 0; ks <= i; ++ks) { const bf16x8 af = *(const LAS bf16x8*)(PI + (tt * 16 + l15) * LROW + ks * 32 + lq * 8);
                    const bf16x8 b0 = *(const LAS bf16x8*)(VT + ((dvt0 + 0) * 16 + l15) * LROW + ks * 32 + lq * 8);
                    const bf16x8 b1 = *(const LAS bf16x8*)(VT + ((dvt0 + 1) * 16 + l15) * LROW + ks * 32 + lq * 8);
                    a0 = mfma16(af, b0, a0); a1 = mfma16(af, b1, a1); }
#pragma unroll
                for (int ks = 0; ks < 4; ++ks) { const bf16x8 af = *(const LAS bf16x8*)(QI + (32 * i + tt * 16 + l15) * LROW + ks * 32 + lq * 8);
                    a0 = mfma16(af, sfr[0][ks], a0); a1 = mfma16(af, sfr[1][ks], a1); }
                oacc[dir][i][0] = a0; oacc[dir][i][1] = a1;
            }
        }
        __syncthreads();
#pragma unroll
        for (int i = 0; i < 4; ++i)
#pragma unroll
            for (int n = 0; n < 2; ++n)
#pragma unroll
                for (int rr = 0; rr < 4; ++rr) OSUM[(32 * i + tt * 16 + lq * 4 + rr) * 132 + (dvt0 + n) * 16 + l15] = oacc[0][i][n][rr];
        __syncthreads();
#pragma unroll
        for (int i = 0; i < 4; ++i)
#pragma unroll
            for (int n = 0; n < 2; ++n)
#pragma unroll
                for (int rr = 0; rr < 4; ++rr) OSUM[(127 - (32 * i + tt * 16 + lq * 4 + rr)) * 132 + (dvt0 + n) * 16 + l15] += oacc[1][i][n][rr];
        __syncthreads();
        { const int row = tid >> 2, part = tid & 3; const int tok = t0 + row;
            float ov[32]; float ss = 0.f;
#pragma unroll
            for (int q = 0; q < 8; ++q) { const f32x4 v = *(const LAS f32x4*)(OSUM + row * 132 + part * 32 + q * 4);
                ov[q * 4 + 0] = v[0]; ov[q * 4 + 1] = v[1]; ov[q * 4 + 2] = v[2]; ov[q * 4 + 3] = v[3]; ss += v[0] * v[0] + v[1] * v[1] + v[2] * v[2] + v[3] * v[3]; }
            ss += __shfl_xor(ss, 1); ss += __shfl_xor(ss, 2);
            const float inv = __builtin_amdgcn_rsqf(ss * (1.f / 128.f) + EPS);
            const int col = h * 128 + part * 32;
            const bf16_t* gp = proj + (size_t)tok * 5120 + 4096 + col; const float* ng = p->hg_norm_g + j * 1024 + col;
#pragma unroll
            for (int q = 0; q < 4; ++q) { const u32x4 gr = *(const u32x4*)(gp + q * 8);
                const float gv[8] = {bflo(gr.x), bfhi(gr.x), bflo(gr.y), bfhi(gr.y), bflo(gr.z), bfhi(gr.z), bflo(gr.w), bfhi(gr.w)};
                float y[8];
#pragma unroll
                for (int e = 0; e < 8; ++e) y[e] = ov[q * 8 + e] * inv * ng[q * 8 + e] * silu_(gv[e]);
                u32x4 o; o.x = cvt_pk_bf16(y[0], y[1]); o.y = cvt_pk_bf16(y[2], y[3]); o.z = cvt_pk_bf16(y[4], y[5]); o.w = cvt_pk_bf16(y[6], y[7]);
                *(u32x4*)(OB + (size_t)tok * 1024 + col + q * 8) = o; }
        }
        __syncthreads();
    }
}

__device__ __forceinline__ void lru_conv(KP p, int l) {
    LAUNDER_IDS
    const bf16_t* XB = (const bf16_t*)(p->ws + WS_XB); bf16_t* XC = (bf16_t*)(p->ws + WS_XC);
    const float* cw = p->lru_conv_w + (size_t)l * 4 * 1024; const float* cb = p->lru_conv_b + (size_t)l * 1024;
    const int gs = gridDim.x * NTHR;
    for (int it = bidL * NTHR + tidL; it < T * 128; it += gs) {
        const int tok = it >> 7, c8 = (it & 127) * 8, s = tok & (SEQ - 1);
        float acc[8];
        { const f32x4 b0 = *(const f32x4*)(cb + c8), b1 = *(const f32x4*)(cb + c8 + 4);
            acc[0] = b0[0]; acc[1] = b0[1]; acc[2] = b0[2]; acc[3] = b0[3]; acc[4] = b1[0]; acc[5] = b1[1]; acc[6] = b1[2]; acc[7] = b1[3]; }
#pragma unroll
        for (int jj = 0; jj < 4; ++jj) { const int ts = s + jj - 2;
            if (ts >= 0 && ts < SEQ) { const u32x4 xr = *(const u32x4*)(XB + (size_t)(tok + jj - 2) * 1024 + c8);
                const f32x4 w0 = *(const f32x4*)(cw + jj * 1024 + c8), w1 = *(const f32x4*)(cw + jj * 1024 + c8 + 4);
                acc[0] += bflo(xr.x) * w0[0]; acc[1] += bfhi(xr.x) * w0[1]; acc[2] += bflo(xr.y) * w0[2]; acc[3] += bfhi(xr.y) * w0[3];
                acc[4] += bflo(xr.z) * w1[0]; acc[5] += bfhi(xr.z) * w1[1]; acc[6] += bflo(xr.w) * w1[2]; acc[7] += bfhi(xr.w) * w1[3]; } }
        u32x4 o; o.x = cvt_pk_bf16(acc[0], acc[1]); o.y = cvt_pk_bf16(acc[2], acc[3]); o.z = cvt_pk_bf16(acc[4], acc[5]); o.w = cvt_pk_bf16(acc[6], acc[7]);
        *(u32x4*)(XC + (size_t)tok * 1024 + c8) = o;
    }
}
__device__ __forceinline__ void lru_scan1(KP p, LAS unsigned char* lds) {
    LAUNDER_IDS
    const bf16_t* LOGA = (const bf16_t*)(p->ws + WS_LOGA); const bf16_t* BT = (const bf16_t*)(p->ws + WS_BTERM);
    float* CP = (float*)(p->ws + WS_CP); float* CH = (float*)(p->ws + WS_CH);
    LAS float* XP = (LAS float*)lds; LAS float* XH = (LAS float*)(lds + 16384);
    for (int u = bidL; u < 1024; u += gridDim.x) {
        int tid = tidL; asm volatile("" : "+v"(tid));
        const int ts = tid >> 7, c8 = (tid & 127) * 8;
        const int chunk = u & 255, dir = (u >> 8) & 1, b = u >> 9;
        const size_t base = ((size_t)dir * T + b * SEQ + chunk * 32) * 1024 + c8;
        u32x4 lw[8], bw[8];
#pragma unroll
        for (int q = 0; q < 8; ++q) { const int t = dir ? 31 - (ts * 8 + q) : ts * 8 + q; lw[q] = *(const u32x4*)(LOGA + base + (size_t)t * 1024); bw[q] = *(const u32x4*)(BT + base + (size_t)t * 1024); }
        float h[8], sl[8];
#pragma unroll
        for (int i = 0; i < 8; ++i) { h[i] = 0.f; sl[i] = 0.f; }
#pragma unroll
        for (int q = 0; q < 8; ++q) {
#pragma unroll
            for (int w = 0; w < 4; ++w) { const float l0 = bflo(lw[q][w]), l1 = bfhi(lw[q][w]);
                h[2 * w] = fast_exp(l0) * h[2 * w] + bflo(bw[q][w]); h[2 * w + 1] = fast_exp(l1) * h[2 * w + 1] + bfhi(bw[q][w]); sl[2 * w] += l0; sl[2 * w + 1] += l1; } }
        *(LAS f32x4*)(XP + ts * 1024 + c8) = (f32x4){fast_exp(sl[0]), fast_exp(sl[1]), fast_exp(sl[2]), fast_exp(sl[3])};
        *(LAS f32x4*)(XP + ts * 1024 + c8 + 4) = (f32x4){fast_exp(sl[4]), fast_exp(sl[5]), fast_exp(sl[6]), fast_exp(sl[7])};
        *(LAS f32x4*)(XH + ts * 1024 + c8) = (f32x4){h[0], h[1], h[2], h[3]}; *(LAS f32x4*)(XH + ts * 1024 + c8 + 4) = (f32x4){h[4], h[5], h[6], h[7]};
        __syncthreads();
        { const int ch = 2 * tid; float P0 = 1.f, P1 = 1.f, H0 = 0.f, H1 = 0.f;
#pragma unroll
            for (int s2 = 0; s2 < 4; ++s2) { const f32x2 pp = *(const LAS f32x2*)(XP + s2 * 1024 + ch), hh = *(const LAS f32x2*)(XH + s2 * 1024 + ch);
                H0 = pp[0] * H0 + hh[0]; H1 = pp[1] * H1 + hh[1]; P0 *= pp[0]; P1 *= pp[1]; }
            const size_t o = ((size_t)(b * 2 + dir) * 256 + chunk) * 1024 + ch;
            *(f32x2*)(CP + o) = (f32x2){P0, P1}; *(f32x2*)(CH + o) = (f32x2){H0, H1}; }
        __syncthreads();
    }
}
__device__ __forceinline__ void lru_scan2(KP p) {
    LAUNDER_IDS
    const float* CP = (const float*)(p->ws + WS_CP); const float* CH = (const float*)(p->ws + WS_CH); float* HIN = (float*)(p->ws + WS_HIN);
    const int wave = tidL >> 6, lane = tidL & 63;
    for (int item = bidL * NWAVE + wave; item < 4096; item += gridDim.x * NWAVE) {
        const int ch = item & 1023, bd = item >> 10, dir = bd & 1;
        float pp[4], hh[4]; float Pl = 1.f, Hl = 0.f;
#pragma unroll
        for (int q = 0; q < 4; ++q) { const int ci = 4 * lane + q, chunk = dir ? 255 - ci : ci; const size_t o = ((size_t)bd * 256 + chunk) * 1024 + ch;
            pp[q] = CP[o]; hh[q] = CH[o]; Hl = pp[q] * Hl + hh[q]; Pl *= pp[q]; }
#pragma unroll
        for (int off = 1; off < 64; off <<= 1) { const float Pp = __shfl_up(Pl, off), Hp = __shfl_up(Hl, off);
            if (lane >= off) { Hl = Pl * Hp + Hl; Pl = Pl * Pp; } }
        float carry = __shfl_up(Hl, 1); if (lane == 0) carry = 0.f;
#pragma unroll
        for (int q = 0; q < 4; ++q) { const int ci = 4 * lane + q, chunk = dir ? 255 - ci : ci; const size_t o = ((size_t)bd * 256 + chunk) * 1024 + ch;
            HIN[o] = carry; carry = pp[q] * carry + hh[q]; }
    }
}
__device__ __forceinline__ void lru_scan3(KP p, LAS unsigned char* lds) {
    LAUNDER_IDS
    const bf16_t* LOGA = (const bf16_t*)(p->ws + WS_LOGA); const bf16_t* BT = (const bf16_t*)(p->ws + WS_BTERM); const bf16_t* YG = (const bf16_t*)(p->ws + WS_YG);
    const float* HIN = (const float*)(p->ws + WS_HIN); bf16_t* OB = (bf16_t*)(p->ws + WS_OB);
    LAS float* XP = (LAS float*)lds; LAS float* XH = (LAS float*)(lds + 16384);
    for (int u = bidL; u < 512; u += gridDim.x) {
        int tid = tidL; asm volatile("" : "+v"(tid));
        const int ts = tid >> 7, c8 = (tid & 127) * 8;
        const int chunk = u & 255, b = u >> 8;
        const size_t base = ((size_t)b * SEQ + chunk * 32 + ts * 8) * 1024 + c8;
        unsigned hsp[8][4];
#pragma unroll
        for (int dir = 0; dir < 2; ++dir) {
            u32x4 lw[8], bw[8];
#pragma unroll
            for (int q = 0; q < 8; ++q) { lw[q] = *(const u32x4*)(LOGA + (size_t)dir * T * 1024 + base + (size_t)q * 1024); bw[q] = *(const u32x4*)(BT + (size_t)dir * T * 1024 + base + (size_t)q * 1024); }
            const f32x4 hi0 = *(const f32x4*)(HIN + ((size_t)(b * 2 + dir) * 256 + chunk) * 1024 + c8), hi1 = *(const f32x4*)(HIN + ((size_t)(b * 2 + dir) * 256 + chunk) * 1024 + c8 + 4);
            float h[8], sl[8];
#pragma unroll
            for (int i = 0; i < 8; ++i) { h[i] = 0.f; sl[i] = 0.f; }
#pragma unroll
            for (int qq = 0; qq < 8; ++qq) { const int q = dir ? 7 - qq : qq;
#pragma unroll
                for (int w = 0; w < 4; ++w) { const float l0 = bflo(lw[q][w]), l1 = bfhi(lw[q][w]);
                    h[2 * w] = fast_exp(l0) * h[2 * w] + bflo(bw[q][w]); h[2 * w + 1] = fast_exp(l1) * h[2 * w + 1] + bfhi(bw[q][w]); sl[2 * w] += l0; sl[2 * w + 1] += l1; } }
            __syncthreads();
            *(LAS f32x4*)(XP + ts * 1024 + c8) = (f32x4){fast_exp(sl[0]), fast_exp(sl[1]), fast_exp(sl[2]), fast_exp(sl[3])};
            *(LAS f32x4*)(XP + ts * 1024 + c8 + 4) = (f32x4){fast_exp(sl[4]), fast_exp(sl[5]), fast_exp(sl[6]), fast_exp(sl[7])};
            *(LAS f32x4*)(XH + ts * 1024 + c8) = (f32x4){h[0], h[1], h[2], h[3]}; *(LAS f32x4*)(XH + ts * 1024 + c8 + 4) = (f32x4){h[4], h[5], h[6], h[7]};
            __syncthreads();
            h[0] = hi0[0]; h[1] = hi0[1]; h[2] = hi0[2]; h[3] = hi0[3]; h[4] = hi1[0]; h[5] = hi1[1]; h[6] = hi1[2]; h[7] = hi1[3];
#pragma unroll
            for (int s3 = 0; s3 < 3; ++s3) { const int sr = dir ? 3 - s3 : s3; const bool use = dir ? (sr > ts) : (sr < ts);
                const f32x4 p0 = *(const LAS f32x4*)(XP + sr * 1024 + c8), p1 = *(const LAS f32x4*)(XP + sr * 1024 + c8 + 4), q0 = *(const LAS f32x4*)(XH + sr * 1024 + c8), q1 = *(const LAS f32x4*)(XH + sr * 1024 + c8 + 4);
                if (use) { h[0] = p0[0] * h[0] + q0[0]; h[1] = p0[1] * h[1] + q0[1]; h[2] = p0[2] * h[2] + q0[2]; h[3] = p0[3] * h[3] + q0[3];
                    h[4] = p1[0] * h[4] + q1[0]; h[5] = p1[1] * h[5] + q1[1]; h[6] = p1[2] * h[6] + q1[2]; h[7] = p1[3] * h[7] + q1[3]; } }
#pragma unroll
            for (int qq = 0; qq < 8; ++qq) { const int q = dir ? 7 - qq : qq;
                u32x4 yw; if (dir) yw = *(const u32x4*)(YG + base + (size_t)q * 1024);
                unsigned ow[4];
#pragma unroll
                for (int w = 0; w < 4; ++w) { h[2 * w] = fast_exp(bflo(lw[q][w])) * h[2 * w] + bflo(bw[q][w]); h[2 * w + 1] = fast_exp(bfhi(lw[q][w])) * h[2 * w + 1] + bfhi(bw[q][w]);
                    if (dir == 0) hsp[q][w] = cvt_pk_bf16(h[2 * w], h[2 * w + 1]);
                    else ow[w] = cvt_pk_bf16((bflo(hsp[q][w]) + h[2 * w]) * bflo(yw[w]), (bfhi(hsp[q][w]) + h[2 * w + 1]) * bfhi(yw[w])); }
                if (dir) *(u32x4*)(OB + base + (size_t)q * 1024) = (u32x4){ow[0], ow[1], ow[2], ow[3]}; }
        }
        __syncthreads();
    }
}

__device__ const unsigned char STAIR[64] = {
    0x00, 0x01, 0x02, 0x03, 0x04, 0x05, 0x06, 0x07, 0x08, 0x09, 0x0a, 0x0b, 0x0c, 0x0d, 0x0e, 0x0f,
    0x10, 0x11, 0x12, 0x13, 0x14, 0x15, 0x16, 0x17, 0x20, 0x21, 0x22, 0x23, 0x24, 0x30, 0x31, 0x32,
    0x33, 0x40, 0x41, 0x42, 0x50, 0x51, 0x60, 0x61, 0x70, 0x71, 0x80, 0x90, 0xa0, 0xb0, 0xc0, 0xd0,
    0xe0, 0xf0, 0, 0, 0, 0, 0, 0, 0, 0, 0, 0, 0, 0, 0, 0};
__device__ __forceinline__ unsigned mono_key(float f) { const unsigned b = __float_as_uint(f); return b ^ ((b >> 31) ? 0xffffffffu : 0x80000000u); }

__device__ __forceinline__ float inv_mono(unsigned k) { return __uint_as_float(k ^ ((k >> 31) ? 0x80000000u : 0xffffffffu)); }
#define TK_CE(A, B) do { const unsigned hi_ = max(A, B), lo_ = min(A, B); A = hi_; B = lo_; } while (0)
#define TK_SORT16(N) do { _Pragma("unroll") for (int k_ = 2; k_ <= 16; k_ <<= 1) { _Pragma("unroll") for (int j_ = k_ >> 1; j_ > 0; j_ >>= 1) { _Pragma("unroll") for (int i_ = 0; i_ < 16; ++i_) { \
    const int l_ = i_ ^ j_; if (l_ > i_) { if ((i_ & k_) == 0) TK_CE(N[i_], N[l_]); else TK_CE(N[l_], N[i_]); } } } } } while (0)
#define TK_MERGE16(L, N) do { _Pragma("unroll") for (int i_ = 0; i_ < 16; ++i_) L[i_] = max(L[i_], N[15 - i_]); \
    _Pragma("unroll") for (int j_ = 8; j_ > 0; j_ >>= 1) { _Pragma("unroll") for (int i_ = 0; i_ < 16; ++i_) { const int l_ = i_ ^ j_; if (l_ > i_) TK_CE(L[i_], L[l_]); } } } while (0)
#define TK_INSERT(L, x) do { _Pragma("unroll") for (int q_ = 0; q_ < 16; ++q_) { const unsigned hi_ = max(L[q_], x); x = min(L[q_], x); L[q_] = hi_; } } while (0)
__device__ __forceinline__ void peer_topk(KP p, LAS unsigned char* lds) {
    LAUNDER_IDS
    (void)bidL;
    const int tid = tidL, wave = tid >> 6, lane = tid & 63;
    const bf16_t* SCh = (const bf16_t*)(p->ws + WS_SCORES);
    LAS float* TB = (LAS float*)(lds + 32768 + wave * 8704);
    int* TOPI = (int*)(p->ws + WS_TOPI); float* TOPG = (float*)(p->ws + WS_TOPG);
    LAS unsigned char* IX = lds + wave * 2048 + lane * 32;
    for (int item = bidL * NWAVE + wave; item < 2048; item += gridDim.x * NWAVE) {
        const int tg = item >> 3, hd = item & 7, tok = tg * 64 + lane;
        float V[2][16];
#pragma unroll
        for (int half = 0; half < 2; ++half) {
            unsigned L[16];
#pragma unroll
            for (int q = 0; q < 16; ++q) L[q] = 0u;
            const bf16_t* scb = SCh + (size_t)(tg * 64 + (lane >> 2)) * 2048 + hd * 256 + half * 128 + (lane & 3) * 8;
            u32x4 nx[4];
#pragma unroll
            for (int i = 0; i < 4; ++i) nx[i] = *(const u32x4*)(scb + (size_t)(16 * i) * 2048);
#pragma unroll 1
            for (int ch = 0; ch < 4; ++ch) {
#pragma unroll
                for (int i = 0; i < 4; ++i) { LAS float* d = TB + ((lane >> 2) + 16 * i) * 33 + (lane & 3) * 8;
                    d[0] = bflo(nx[i].x); d[1] = bfhi(nx[i].x); d[2] = bflo(nx[i].y); d[3] = bfhi(nx[i].y); d[4] = bflo(nx[i].z); d[5] = bfhi(nx[i].z); d[6] = bflo(nx[i].w); d[7] = bfhi(nx[i].w); }
                asm volatile("s_waitcnt lgkmcnt(0)" ::: "memory");
                const int cn = ch < 3 ? ch + 1 : ch;
#pragma unroll
                for (int i = 0; i < 4; ++i) nx[i] = *(const u32x4*)(scb + (size_t)(16 * i) * 2048 + 32 * cn);
#pragma unroll
                for (int sb = 0; sb < 2; ++sb) {
                    float cur[16];
#pragma unroll
                    for (int i = 0; i < 16; ++i) cur[i] = TB[lane * 33 + sb * 16 + i];
                    asm volatile("s_waitcnt lgkmcnt(0)" ::: "memory");
                    unsigned NK[16];
#pragma unroll
                    for (int i = 0; i < 16; ++i) NK[i] = (mono_key(cur[i]) & ~0x7fu) | (unsigned)(ch * 32 + sb * 16 + i);
                    TK_SORT16(NK); TK_MERGE16(L, NK);
                }
            }
            u32x4 w0, w1;
            w0.x = (L[0] & 0x7f) | ((L[1] & 0x7f) << 8) | ((L[2] & 0x7f) << 16) | ((L[3] & 0x7f) << 24); w0.y = (L[4] & 0x7f) | ((L[5] & 0x7f) << 8) | ((L[6] & 0x7f) << 16) | ((L[7] & 0x7f) << 24);
            w0.z = (L[8] & 0x7f) | ((L[9] & 0x7f) << 8) | ((L[10] & 0x7f) << 16) | ((L[11] & 0x7f) << 24); w0.w = (L[12] & 0x7f) | ((L[13] & 0x7f) << 8) | ((L[14] & 0x7f) << 16) | ((L[15] & 0x7f) << 24);
            *(LAS u32x4*)(IX + half * 16) = w0;
#pragma unroll
            for (int q = 0; q < 16; ++q) V[half][q] = inv_mono(L[q]);
        }
        unsigned C[16];
#pragma unroll
        for (int q = 0; q < 16; ++q) C[q] = 0u;
#pragma unroll
        for (int i = 0; i < 16; ++i)
#pragma unroll
            for (int jj = 0; jj < 16; ++jj) if ((i + 1) * (jj + 1) <= 16) { unsigned x = (mono_key(V[0][i] + V[1][jj]) & ~0xffu) | (unsigned)(i * 16 + jj); TK_INSERT(C, x); }
        asm volatile("s_waitcnt lgkmcnt(0)" ::: "memory");
        const float s0 = inv_mono(C[0] & ~0xffu);
        float e[16]; float sum = 0.f; int ids[16];
#pragma unroll
        for (int q = 0; q < 16; ++q) { e[q] = fast_exp(inv_mono(C[q] & ~0xffu) - s0); sum += e[q];
            const unsigned code = C[q] & 0xffu; ids[q] = (int)IX[code >> 4] * 128 + (int)IX[16 + (code & 15u)]; }
        const float rs = fast_rcp(sum);
        int* ip = TOPI + (size_t)tok * 128 + hd * 16; float* gp = TOPG + (size_t)tok * 128 + hd * 16;
#pragma unroll
        for (int q = 0; q < 4; ++q) { *(u32x4*)(ip + 4 * q) = (u32x4){(unsigned)ids[4 * q], (unsigned)ids[4 * q + 1], (unsigned)ids[4 * q + 2], (unsigned)ids[4 * q + 3]};
            *(f32x4*)(gp + 4 * q) = (f32x4){e[4 * q] * rs, e[4 * q + 1] * rs, e[4 * q + 2] * rs, e[4 * q + 3] * rs}; }
        asm volatile("s_waitcnt lgkmcnt(0)" ::: "memory");
    }
}

__device__ __forceinline__ void peer_gather(KP p, int l, bool dry) {
    LAUNDER_IDS
    const int wave = tidL >> 6, lane = tidL & 63;
    const bf16_t* HB = (const bf16_t*)(p->ws + WS_HBUF); bf16_t* HBW = (bf16_t*)(p->ws + WS_HBUF);
    const int* TOPI = (const int*)(p->ws + WS_TOPI); const float* TOPG = (const float*)(p->ws + WS_TOPG);
    const unsigned char* UA = p->ws + WS_UTAB + (size_t)l * 16384 * 512; const unsigned char* V8 = p->ws + WS_VTAB + (size_t)l * 16384 * 512 + 8 * lane; const unsigned char* H8 = p->ws + WS_HB8;
    const float* USC = (const float*)(p->ws + WS_USC) + l * 16384; const float* VSC = (const float*)(p->ws + WS_VSC) + l * 16384;
    bf16_t* XRES = (bf16_t*)(p->ws + WS_XRES); const float* MOD = (const float*)(p->ws + WS_MOD);
    for (int tok = bidL * NWAVE + wave; tok < T; tok += gridDim.x * NWAVE) {
        const int b = tok >> 13;
        const int gq = lane >> 4, jq = lane & 15;
        v8i hb[8];
#pragma unroll
        for (int sidx = 0; sidx < 8; ++sidx) { const u32x4 lo = *(const u32x4*)(H8 + (size_t)tok * 1024 + 128 * sidx + 16 * gq), hi = *(const u32x4*)(H8 + (size_t)tok * 1024 + 128 * sidx + 64 + 16 * gq);
            hb[sidx] = (v8i){(int)lo.x, (int)lo.y, (int)lo.z, (int)lo.w, (int)hi.x, (int)hi.y, (int)hi.z, (int)hi.w}; }
        const int id0 = TOPI[(size_t)tok * 128 + lane], id1 = TOPI[(size_t)tok * 128 + 64 + lane];
        const float g0 = TOPG[(size_t)tok * 128 + lane], g1 = TOPG[(size_t)tok * 128 + 64 + lane];
        f32x2 acc2[8];
#pragma unroll
        for (int i = 0; i < 8; ++i) acc2[i] = (f32x2){0.f, 0.f};
        const int ke = 4 * gq + (jq & 3);
#pragma unroll 1
        for (int e0 = 0; e0 < 128; e0 += 16) {
            const int ida = __shfl(e0 < 64 ? id0 : id1, (e0 + jq) & 63) & 16383;
            const unsigned char* ua_p = UA + (size_t)ida * 512 + 16 * gq;
            u32x4 ua[8];
#pragma unroll
            for (int sidx = 0; sidx < 8; ++sidx) ua[sidx] = *(const u32x4*)(ua_p + 64 * sidx);
            u32x2 vq[16];
#pragma unroll
            for (int k = 0; k < 16; ++k) { const int id = __builtin_amdgcn_readlane(e0 < 64 ? id0 : id1, (e0 + k) & 63) & 16383; vq[k] = *(const u32x2*)(V8 + (size_t)id * 512); }
            const int idk = __shfl(e0 < 64 ? id0 : id1, (e0 + ke) & 63) & 16383; const float gl = __shfl(e0 < 64 ? g0 : g1, (e0 + ke) & 63);
            const float sul = USC[idk], svl = VSC[idk];
            f32x4 dacc = {0.f, 0.f, 0.f, 0.f};
#pragma unroll
            for (int sidx = 0; sidx < 8; ++sidx) { const v8i av = (v8i){(int)ua[sidx].x, (int)ua[sidx].y, (int)ua[sidx].z, (int)ua[sidx].w, 0, 0, 0, 0};
                dacc = __builtin_amdgcn_mfma_scale_f32_16x16x128_f8f6f4(av, hb[sidx], dacc, 4, 0, 0, 0x7f7f7f7f, 0, 0x7f7f7f7f); }
            const int jr = jq & 3;
            const float r = jr == 0 ? dacc[0] : jr == 1 ? dacc[1] : jr == 2 ? dacc[2] : dacc[3];
            const float cfl = gl * gelu_tanh(r * sul) * svl;
#pragma unroll
            for (int k = 0; k < 16; ++k) { const float cf = __uint_as_float(__builtin_amdgcn_readlane(__float_as_uint(cfl), 16 * (k >> 2) + (k & 3)));
                const f32x2 cf2 = (f32x2){cf, cf};
#pragma unroll
                for (int w = 0; w < 2; ++w) {
                    acc2[4 * w + 0] = __builtin_amdgcn_cvt_scalef32_pk_f32_fp4(vq[k][w], 1.0f, 0) * cf2 + acc2[4 * w + 0]; acc2[4 * w + 1] = __builtin_amdgcn_cvt_scalef32_pk_f32_fp4(vq[k][w], 1.0f, 1) * cf2 + acc2[4 * w + 1];
                    acc2[4 * w + 2] = __builtin_amdgcn_cvt_scalef32_pk_f32_fp4(vq[k][w], 1.0f, 2) * cf2 + acc2[4 * w + 2]; acc2[4 * w + 3] = __builtin_amdgcn_cvt_scalef32_pk_f32_fp4(vq[k][w], 1.0f, 3) * cf2 + acc2[4 * w + 3]; } }
        }
        const float* g2 = MOD + ((size_t)l * 2 + b) * 6144 + 5 * 1024 + 16 * lane;
        bf16_t* xrow = XRES + (size_t)tok * 1024 + 16 * lane;
        float xn[16]; float ss = 0.f;
        const u32x4 xr0 = *(const u32x4*)xrow, xr1 = *(const u32x4*)(xrow + 8);
        const float xrf[16] = {bflo(xr0.x), bfhi(xr0.x), bflo(xr0.y), bfhi(xr0.y), bflo(xr0.z), bfhi(xr0.z), bflo(xr0.w), bfhi(xr0.w), bflo(xr1.x), bfhi(xr1.x), bflo(xr1.y), bfhi(xr1.y), bflo(xr1.z), bfhi(xr1.z), bflo(xr1.w), bfhi(xr1.w)};
#pragma unroll
        for (int q = 0; q < 4; ++q) { const f32x4 xr = (f32x4){xrf[4 * q], xrf[4 * q + 1], xrf[4 * q + 2], xrf[4 * q + 3]}, gg = *(const f32x4*)(g2 + 4 * q);
            const float a0 = acc2[2 * q][0], a1 = acc2[2 * q][1], a2 = acc2[2 * q + 1][0], a3 = acc2[2 * q + 1][1];
            xn[4 * q + 0] = xr[0] + gg[0] * a0; xn[4 * q + 1] = xr[1] + gg[1] * a1; xn[4 * q + 2] = xr[2] + gg[2] * a2; xn[4 * q + 3] = xr[3] + gg[3] * a3; }
#pragma unroll
        for (int i = 0; i < 16; ++i) ss += xn[i] * xn[i];
        const float inv = __builtin_amdgcn_rsqf(wave_sum(ss) * (1.f / 1024.f) + EPS);
        if (dry) { if (inv == 123.456f) p->out[tok] = inv; continue; }
        if (l < DEPTH - 1) {
            const float* gain = p->norm_g + (size_t)(l + 1) * 2 * 1024 + 16 * lane; const float* sh = MOD + ((size_t)(l + 1) * 2 + b) * 6144 + 16 * lane; const float* sc = sh + 1024;
            float y[16];
#pragma unroll
            for (int q = 0; q < 4; ++q) { const f32x4 gn = *(const f32x4*)(gain + 4 * q), s1 = *(const f32x4*)(sh + 4 * q), c1 = *(const f32x4*)(sc + 4 * q);
#pragma unroll
                for (int i = 0; i < 4; ++i) y[4 * q + i] = (xn[4 * q + i] * inv) * gn[i] * (1.f + c1[i]) + s1[i]; }
            { u32x4 x0, x1; x0.x = cvt_pk_bf16(xn[0], xn[1]); x0.y = cvt_pk_bf16(xn[2], xn[3]); x0.z = cvt_pk_bf16(xn[4], xn[5]); x0.w = cvt_pk_bf16(xn[6], xn[7]);
                x1.x = cvt_pk_bf16(xn[8], xn[9]); x1.y = cvt_pk_bf16(xn[10], xn[11]); x1.z = cvt_pk_bf16(xn[12], xn[13]); x1.w = cvt_pk_bf16(xn[14], xn[15]);
                *(u32x4*)xrow = x0; *(u32x4*)(xrow + 8) = x1; }
            u32x4 o0, o1; o0.x = cvt_pk_bf16(y[0], y[1]); o0.y = cvt_pk_bf16(y[2], y[3]); o0.z = cvt_pk_bf16(y[4], y[5]); o0.w = cvt_pk_bf16(y[6], y[7]);
            o1.x = cvt_pk_bf16(y[8], y[9]); o1.y = cvt_pk_bf16(y[10], y[11]); o1.z = cvt_pk_bf16(y[12], y[13]); o1.w = cvt_pk_bf16(y[14], y[15]);
            *(u32x4*)(HBW + (size_t)tok * 1024 + 16 * lane) = o0; *(u32x4*)(HBW + (size_t)tok * 1024 + 16 * lane + 8) = o1;
        } else {
            const float* fg = p->final_g + 16 * lane; float* orow = p->out + (size_t)tok * 1024 + 16 * lane;
#pragma unroll
            for (int q = 0; q < 4; ++q) { const f32x4 gn = *(const f32x4*)(fg + 4 * q); f32x4 o;
#pragma unroll
                for (int i = 0; i < 4; ++i) o[i] = (xn[4 * q + i] * inv) * gn[i];
                *(f32x4*)(orow + 4 * q) = o; }
        }
    }
}

#define XB_TMO      128
#define XB_XCNT(j)  (256  + 64 * (j))
#define XB_XSUB(j)  (1280 + 64 * (j))
#define XB_XGEN(j)  (2304 + 64 * (j))
#define XB_TOP      3328
#define XB_TOPGEN   3392
#define XCD_BAR_WORDS 3456
#define XB_SPIN_CAP (1u << 18)

__device__ __forceinline__ unsigned xb_ld(unsigned* p)              { return __hip_atomic_load(p, __ATOMIC_RELAXED, __HIP_MEMORY_SCOPE_AGENT); }
__device__ __forceinline__ unsigned xb_add(unsigned* p, unsigned v) { return __hip_atomic_fetch_add(p, v, __ATOMIC_RELAXED, __HIP_MEMORY_SCOPE_AGENT); }
__device__ __forceinline__ unsigned xb_xcc_id() { return (unsigned)__builtin_amdgcn_s_getreg((3 << 11) | 20) & 0xFu; }
#define XB_SPIN(cond, bar) do { unsigned _sp = 0; while (cond) { __builtin_amdgcn_s_sleep(1); \
    if ((++_sp & 255u) == 0u) { if (xb_ld(&(bar)[XB_TMO])) break; if (_sp > XB_SPIN_CAP) { atomicAdd(&(bar)[XB_TMO], 1u); break; } } } } while (0)

struct XcdBarrier {
    unsigned* bar; unsigned x;
    volatile LAS unsigned* st;
};

__device__ __forceinline__ XcdBarrier xcd_barrier_post(unsigned* bar, volatile LAS unsigned* st) {
    XcdBarrier b; b.bar = bar; b.x = xb_xcc_id(); b.st = st;
    if (threadIdx.x == 0) (void)xb_add(&bar[XB_XCNT(b.x)], 1u);
    return b;
}
__device__ __forceinline__ void xcd_barrier_complete(unsigned* bar, unsigned x, unsigned& nloc, unsigned& nx) {
    const unsigned G = gridDim.x * gridDim.y * gridDim.z;
    unsigned sum, cnt, mine, sp = 0u;
    for (;;) {
        sum = 0u; cnt = 0u; mine = 0u;
#pragma unroll
        for (unsigned j = 0; j < 16; ++j) { const unsigned c = xb_ld(&bar[XB_XCNT(j)]); sum += c; cnt += (c > 0u) ? 1u : 0u; mine = (j == x) ? c : mine; }
        if (sum == G) break;
        __builtin_amdgcn_s_sleep(1);
        if ((++sp & 255u) == 0u) { if (xb_ld(&bar[XB_TMO])) break; if (sp > XB_SPIN_CAP) { atomicAdd(&bar[XB_TMO], 1u); break; } }
    }
    nloc = mine > 0u ? mine : 1u; nx = cnt > 0u ? cnt : 1u;
}

__device__ __forceinline__ void xcd_barrier(const XcdBarrier& b) {
    asm volatile("s_waitcnt vmcnt(0)" ::: "memory");
    __syncthreads();
    if (threadIdx.x == 0) {
        unsigned* bar = b.bar;
        __builtin_amdgcn_s_waitcnt(0);
        unsigned nloc = b.st[0], nx = b.st[1];
        if (nloc == 0u) { xcd_barrier_complete(bar, b.x, nloc, nx); b.st[0] = nloc; b.st[1] = nx; }
        const unsigned old = xb_add(&bar[XB_XSUB(b.x)], 1u);
        const unsigned gen = old / nloc;
        if (old + 1u == (gen + 1u) * nloc) {
            __builtin_amdgcn_fence(__ATOMIC_RELEASE, "agent");
            asm volatile("s_waitcnt vmcnt(0)" ::: "memory");
            const unsigned og = xb_add(&bar[XB_TOP], 1u);
            const unsigned tg = og / nx;
            if (og + 1u == (tg + 1u) * nx) xb_add(&bar[XB_TOPGEN], 1u);
            else XB_SPIN(xb_ld(&bar[XB_TOPGEN]) == tg, bar);
            __builtin_amdgcn_fence(__ATOMIC_ACQUIRE, "agent");
            xb_add(&bar[XB_XGEN(b.x)], 1u);
            asm volatile("s_waitcnt vmcnt(0)" ::: "memory");
        } else {
            XB_SPIN(xb_ld(&bar[XB_XGEN(b.x)]) == gen, bar);
            __builtin_amdgcn_fence(__ATOMIC_ACQUIRE, "agent");
            asm volatile("s_waitcnt vmcnt(0)" ::: "memory");
        }
    }
    __syncthreads();
}

#ifndef OPMASK
#define OPMASK 0xFFFFFFFFu
#endif
#define EN(o) ((OPMASK >> (o)) & 1u)
enum { OP_P0 = 0, OP_RMS1, OP_HG_IN, OP_HG_A, OP_HG_B, OP_HG_C, OP_MIX_OUT, OP_LR_IN, OP_LR_CONV, OP_LR_G, OP_LR_S1, OP_LR_S2, OP_LR_S3, OP_RMS2, OP_QK, OP_TOPK, OP_GATHER };
constexpr int NPH = 42;
#define REP_MASK 0u
__device__ __forceinline__ void decode_phase(int ph, int& l, int& op) {
    if (ph == 0) { l = 0; op = OP_P0; return; }
    if (ph == 1) { l = 0; op = OP_RMS1; return; }
    int q = ph - 2;
    if (q < 9) { l = 0; } else if (q < 20) { l = 1; q -= 9; } else if (q < 29) { l = 2; q -= 20; } else { l = 3; q -= 29; }
    if ((l & 1) == 0) { op = q == 0 ? OP_HG_IN : q == 1 ? OP_HG_A : q == 2 ? OP_HG_B : q == 3 ? OP_HG_C : q == 4 ? OP_MIX_OUT : q == 5 ? OP_RMS2 : q == 6 ? OP_QK : q == 7 ? OP_TOPK : OP_GATHER; }
    else { op = q == 0 ? OP_LR_IN : q == 1 ? OP_LR_CONV : q == 2 ? OP_LR_G : q == 3 ? OP_LR_S1 : q == 4 ? OP_LR_S2 : q == 5 ? OP_LR_S3 : q == 6 ? OP_MIX_OUT : q == 7 ? OP_RMS2 : q == 8 ? OP_QK : q == 9 ? OP_TOPK : OP_GATHER; }
}

__global__ __launch_bounds__(512, 2) void mk_fwd(Params p_arg) {
    extern __shared__ __attribute__((aligned(16))) unsigned char shm[];
    LAS unsigned char* lds = (LAS unsigned char*)shm;
    cg::grid_group grid = cg::this_grid();
    unsigned long long kpv = (unsigned long long)__builtin_amdgcn_kernarg_segment_ptr();
    const int ph_lo = p_arg.ph_lo, ph_hi = p_arg.ph_hi;
    volatile LAS unsigned* xst = (volatile LAS unsigned*)(lds + LDS_BYTES - 16);
    if (threadIdx.x == 0) { xst[0] = 0u; xst[1] = 0u; }
    __syncthreads();
    const XcdBarrier xb = xcd_barrier_post((unsigned*)(p_arg.ws + WS_CTL) + 1024, xst);
    for (int ph = ph_lo; ph < ph_hi; ++ph) {
        if (ph > ph_lo) { if (ph_hi > 4096) grid.sync(); else xcd_barrier(xb); }
        asm volatile("" : "+s"(kpv));
        KP p = (KP)kpv;
        unsigned char* ws = p->ws;
        const float* MOD = (const float*)(ws + WS_MOD);
        int l, op; decode_phase(ph, l, op);
        const int j = l >> 1;
        const int nrep = ((p->rep_mask >> op) & 1u) ? 2 : 1;
        for (int rep = 0; rep < nrep; ++rep) {
        const bool dry = rep + 1 < nrep;
#ifdef ONLY
        switch (ONLY) {
#else
        switch (op) {
#endif
        case OP_P0: if (EN(OP_P0)) phase0(p, lds); break;
        case OP_RMS1: if (EN(OP_RMS1)) phase_rms(p->x, nullptr, p->norm_g, MOD, MOD + 1024, (bf16_t*)(ws + WS_HBUF), nullptr); break;
        case OP_HG_IN: if (EN(OP_HG_IN)) { EpiBf16 E; E.O = (bf16_t*)(ws + WS_PROJ); E.ldc = 5120;
            run_gemm(lds, (const bf16_t*)(ws + WS_HBUF), (const bf16_t*)(ws + WS_HGWIN) + (size_t)j * 5120 * 1024, 5120, 1024, 1024, 1024, 0, 0, E); } break;
        case OP_HG_A: if (EN(OP_HG_A)) hg_pass_a(p, lds, j); break;
        case OP_HG_B: if (EN(OP_HG_B)) hg_pass_b(p); break;
        case OP_HG_C: if (EN(OP_HG_C)) hg_pass_c(p, lds, j); break;
        case OP_MIX_OUT: if (EN(OP_MIX_OUT)) { EpiResid E; E.xin32 = (l == 0) ? p->x : nullptr; E.xin16 = (const bf16_t*)(ws + WS_XRES); E.xout = (bf16_t*)(ws + WS_XRES); E.gate = MOD + (size_t)l * 2 * 6144 + 2 * 1024; E.dry = dry;
            const bf16_t* W = (l & 1) ? (const bf16_t*)(ws + WS_LRWOUT) + (size_t)j * 1024 * 1024 : (const bf16_t*)(ws + WS_HGWOUT) + (size_t)j * 1024 * 1024;
            run_gemm(lds, (const bf16_t*)(ws + WS_OB), W, 1024, 1024, 1024, 1024, 0, 0, E); } break;
        case OP_LR_IN: if (EN(OP_LR_IN)) { EpiLruIn E; E.XB = (bf16_t*)(ws + WS_XB); E.YG = (bf16_t*)(ws + WS_YG);
            run_gemm(lds, (const bf16_t*)(ws + WS_HBUF), (const bf16_t*)(ws + WS_LRWIN) + (size_t)j * 2048 * 1024, 2048, 1024, 1024, 1024, 0, 0, E); } break;
        case OP_LR_CONV: if (EN(OP_LR_CONV)) lru_conv(p, j); break;
        case OP_LR_G: if (EN(OP_LR_G)) { EpiGates E; E.LOGA = (bf16_t*)(ws + WS_LOGA); E.BTERM = (bf16_t*)(ws + WS_BTERM); E.XC = (const bf16_t*)(ws + WS_XC);
            E.b_a = p->lru_b_a + (size_t)j * 2048; E.b_x = p->lru_b_x + (size_t)j * 2048; E.lam = p->lru_lam + (size_t)j * 2048;
            run_gemm(lds, (const bf16_t*)(ws + WS_XC), (const bf16_t*)(ws + WS_LRWG) + (size_t)j * 4 * 1024 * 256, 4096, 256, 1024, 256, 2, 512, E); } break;
        case OP_LR_S1: if (EN(OP_LR_S1)) lru_scan1(p, lds); break;
        case OP_LR_S2: if (EN(OP_LR_S2)) lru_scan2(p); break;
        case OP_LR_S3: if (EN(OP_LR_S3)) lru_scan3(p, lds); break;
        case OP_RMS2: if (EN(OP_RMS2)) phase_rms(nullptr, (const bf16_t*)(ws + WS_XRES), p->norm_g + ((size_t)l * 2 + 1) * 1024, MOD + (size_t)l * 2 * 6144 + 3 * 1024, MOD + (size_t)l * 2 * 6144 + 4 * 1024, (bf16_t*)(ws + WS_HBUF), ws + WS_HB8); break;
        case OP_QK: if (EN(OP_QK)) { EpiBf16 E; E.O = (bf16_t*)(ws + WS_SCORES); E.ldc = 2048;
            run_gemm(lds, (const bf16_t*)(ws + WS_HBUF), (const bf16_t*)(ws + WS_WQK) + (size_t)l * 2048 * 1024, 2048, 1024, 1024, 1024, 0, 0, E); } break;
        case OP_TOPK: if (EN(OP_TOPK)) peer_topk(p, lds); break;
        case OP_GATHER: if (EN(OP_GATHER)) peer_gather(p, l, dry); break;
        default: break;
        }
        }
    }
}

extern "C" void kernel_launch(void* const* d_in, const int* in_sizes, int n_in, void* d_out, int out_size, void* d_ws, size_t ws_size, hipStream_t stream) {
    static int grid = 0;
    if (grid == 0) {
        if (n_in != 23 || ws_size < WS_END) { fprintf(stderr, "kernel_launch: unexpected n_in %d / ws_size %zu (need %zu)\n", n_in, ws_size, (size_t)WS_END); grid = -1; return; }
        int dev = 0, cus = 0, per_cu = 0;
        hipGetDevice(&dev); hipDeviceGetAttribute(&cus, hipDeviceAttributeMultiprocessorCount, dev);
        if (hipFuncSetAttribute((const void*)mk_fwd, hipFuncAttributeMaxDynamicSharedMemorySize, LDS_BYTES) != hipSuccess) { fprintf(stderr, "kernel_launch: hipFuncSetAttribute failed\n"); grid = -1; return; }
        if (hipOccupancyMaxActiveBlocksPerMultiprocessor(&per_cu, (const void*)mk_fwd, NTHR, LDS_BYTES) != hipSuccess || per_cu < 1) { fprintf(stderr, "kernel_launch: occupancy query failed (%d)\n", per_cu); (void)hipGetLastError(); per_cu = 1; }
        grid = cus * 1;
        fprintf(stderr, "kernel_launch: cus %d per_cu %d grid %d\n", cus, per_cu, grid);
    }
    if (grid < 0) return;
    if (hipMemsetAsync((char*)d_ws + WS_CTL, 0, 65536, stream) != hipSuccess) { fprintf(stderr, "kernel_launch: memset failed\n"); return; }
    Params p{};
    const float** pp = (const float**)&p;
    for (int i = 0; i < 23; ++i) pp[i] = (const float*)d_in[i];
    p.out = (float*)d_out; p.ws = (unsigned char*)d_ws; p.ph_lo = 0; p.ph_hi = NPH; p.rep_mask = REP_MASK;
    void* args[] = {&p};
    hipError_t e = hipLaunchCooperativeKernel((const void*)mk_fwd, dim3(grid), dim3(NTHR), args, LDS_BYTES, stream);
    if (e != hipSuccess) fprintf(stderr, "kernel_launch: cooperative launch failed: %s (grid %d)\n", hipGetErrorString(e), grid);
}
```
